# Optimizing an MI355X kernel written in HIP

```python
import jax, jax.numpy as jnp
from jax import lax
import numpy as np

D_MODEL = 2048
BATCH = 4
SEQ = 4096
DEPTH = 1

LRU_WIDTH = D_MODEL // 2
LRU_BLOCKS = 8
LRU_BLOCK = LRU_WIDTH // LRU_BLOCKS
CONV_WIDTH = 4
LRU_C = 8.0
ATTN_HEAD_DIM = 64
ATTN_Q_HEADS = (D_MODEL - LRU_WIDTH) // ATTN_HEAD_DIM
ATTN_KV_HEADS = 2
ATTN_GROUP = ATTN_Q_HEADS // ATTN_KV_HEADS
WINDOW = 128
ATTN_BLOCK = 128
ROPE_THETA = 500000.0
ROPE_DIM = ATTN_HEAD_DIM // 4
Q_WIDTH = ATTN_Q_HEADS * ATTN_HEAD_DIM
KV_WIDTH = ATTN_KV_HEADS * ATTN_HEAD_DIM
MIX_IN = 2 * LRU_WIDTH + Q_WIDTH + 2 * KV_WIDTH
MIX_WIDTH = LRU_WIDTH + Q_WIDTH
PEER_HEADS = 8
PEER_N_KEYS = 128
PEER_N_EXPERTS = PEER_N_KEYS * PEER_N_KEYS
PEER_QUERY_DIM = 256
PEER_HALF = PEER_QUERY_DIM // 2
PEER_TOPK = 16
PEER_TOKEN_CHUNK = 128
NORM_EPS = 1e-6

kernel_name = 'hymba_rglru_swa_sink_peer_adaln'


def rms_norm(x, g):
    xf = x.astype(jnp.float32)
    y = xf * lax.rsqrt(jnp.mean(xf * xf, axis=-1, keepdims=True) + NORM_EPS)
    return (y * g.astype(jnp.float32)).astype(x.dtype)


def modulate(xn, shift, scale):
    return xn * (1.0 + scale[:, None, :]) + shift[:, None, :]


def partial_rope(t, positions):
    half = ROPE_DIM // 2
    inv_freq = jnp.power(ROPE_THETA, -2.0 * jnp.arange(half, dtype=jnp.float32) / ROPE_DIM)
    ang = positions.astype(jnp.float32)[..., None] * inv_freq
    cos = jnp.cos(ang)[:, :, None, :]
    sin = jnp.sin(ang)[:, :, None, :]
    rot = t[..., :ROPE_DIM].astype(jnp.float32)
    x1, x2 = rot[..., :half], rot[..., half:]
    rotated = jnp.concatenate([x1 * cos - x2 * sin, x2 * cos + x1 * sin], axis=-1)
    return jnp.concatenate([rotated.astype(t.dtype), t[..., ROPE_DIM:]], axis=-1)


def rg_lru_group(x_in, conv_w, conv_b, gate_a_w, gate_a_b, gate_x_w, gate_x_b, lam):
    B, S, _ = x_in.shape
    xp = jnp.pad(x_in, ((0, 0), (CONV_WIDTH - 1, 0), (0, 0)))
    xc = conv_b
    for k in range(CONV_WIDTH):
        xc = xc + conv_w[k] * xp[:, k:k + S]
    xb = xc.reshape(B, S, LRU_BLOCKS, LRU_BLOCK)
    r = jax.nn.sigmoid(jnp.einsum('bshi,hij->bshj', xb, gate_a_w).reshape(B, S, LRU_WIDTH) + gate_a_b)
    i = jax.nn.sigmoid(jnp.einsum('bshi,hij->bshj', xb, gate_x_w).reshape(B, S, LRU_WIDTH) + gate_x_b)
    log_a = -LRU_C * r.astype(jnp.float32) * jax.nn.softplus(-lam.astype(jnp.float32))
    a = jnp.exp(log_a)
    b = jnp.sqrt(-jnp.expm1(2.0 * log_a)) * (i * xc).astype(jnp.float32)

    def combine(left, right):
        a_l, b_l = left
        a_r, b_r = right
        return a_l * a_r, a_r * b_l + b_r

    _, h = lax.associative_scan(combine, (a, b), axis=1)
    return h.astype(x_in.dtype)


def sliding_window_attention(q, k, v, sinks):
    B, S, HQ, HD = q.shape
    nblk = S // ATTN_BLOCK
    qb = q.reshape(B, nblk, ATTN_BLOCK, ATTN_KV_HEADS, ATTN_GROUP, HD)

    def band(t):
        tp = jnp.pad(t, ((0, 0), (ATTN_BLOCK, 0), (0, 0), (0, 0)))
        tb = tp.reshape(B, nblk + 1, ATTN_BLOCK, ATTN_KV_HEADS, HD)
        return jnp.concatenate([tb[:, :-1], tb[:, 1:]], axis=2)

    kb, vb = band(k), band(v)
    scores = jnp.einsum('bnqhgd,bnkhd->bnhgqk', qb, kb).astype(jnp.float32) * (HD ** -0.5)
    q_i = jnp.arange(ATTN_BLOCK)[:, None]
    k_j = jnp.arange(2 * ATTN_BLOCK)[None, :]
    rel = q_i + ATTN_BLOCK - k_j
    key_pos = jnp.arange(nblk)[:, None, None] * ATTN_BLOCK + k_j[None] - ATTN_BLOCK
    valid = (rel >= 0) & (rel < WINDOW) & (key_pos >= 0)
    scores = jnp.where(valid[None, :, None, None], scores, -jnp.inf)
    sink = jnp.broadcast_to(sinks.astype(jnp.float32).reshape(1, 1, ATTN_KV_HEADS, ATTN_GROUP, 1, 1),
                            scores.shape[:-1] + (1,))
    probs = jax.nn.softmax(jnp.concatenate([scores, sink], axis=-1), axis=-1)[..., :-1]
    out = jnp.einsum('bnhgqk,bnkhd->bnqhgd', probs.astype(v.dtype), vb)
    return out.reshape(B, S, HQ * HD)


def peer_ffn(t, w_q, sub_keys, u_tab, v_tab):
    B, S, D = t.shape
    T = B * S
    tf = t.reshape(T, D)
    q = (tf @ w_q).reshape(T, PEER_HEADS, 2, PEER_HALF).astype(jnp.float32)
    s = jnp.einsum('thpd,hpnd->thpn', q, sub_keys.astype(jnp.float32))
    sv, si = lax.top_k(s, PEER_TOPK)
    cand_s = (sv[:, :, 0, :, None] + sv[:, :, 1, None, :]).reshape(T, PEER_HEADS, PEER_TOPK * PEER_TOPK)
    cand_i = (si[:, :, 0, :, None] * PEER_N_KEYS + si[:, :, 1, None, :]).reshape(T, PEER_HEADS, PEER_TOPK * PEER_TOPK)
    top_s, pos = lax.top_k(cand_s, PEER_TOPK)
    idx = jnp.take_along_axis(cand_i, pos, axis=-1)
    g = jax.nn.softmax(top_s, axis=-1)
    nch = T // PEER_TOKEN_CHUNK

    def expert_chunk(args):
        xc, ic, gc = args
        u = u_tab[ic]
        act = jax.nn.gelu(jnp.einsum('cd,chkd->chk', xc, u).astype(jnp.float32))
        w = (gc * act).astype(xc.dtype)
        return jnp.einsum('chk,chkd->cd', w, v_tab[ic])

    out = lax.map(expert_chunk, (tf.reshape(nch, PEER_TOKEN_CHUNK, D),
                                 idx.reshape(nch, PEER_TOKEN_CHUNK, PEER_HEADS, PEER_TOPK),
                                 g.reshape(nch, PEER_TOKEN_CHUNK, PEER_HEADS, PEER_TOPK)))
    return out.reshape(B, S, D)


def hybrid_layer(x, c, positions, w_ada, b_ada, norm1_g, w_in, conv_w, conv_b,
                 gate_a_w, gate_a_b, gate_x_w, gate_x_b, lam, q_norm_g, k_norm_g, sinks,
                 out_norm_lru_g, out_norm_attn_g, w_out, norm2_g, peer_w_q, peer_sub_keys,
                 peer_u, peer_v):
    B, S, _ = x.shape
    ada = jax.nn.silu(c) @ w_ada + b_ada
    sh1, sc1, g1, sh2, sc2, g2 = jnp.split(ada, 6, axis=-1)

    h = modulate(rms_norm(x, norm1_g), sh1, sc1)
    proj = h @ w_in
    splits = np.cumsum([LRU_WIDTH, LRU_WIDTH, Q_WIDTH, KV_WIDTH]).tolist()
    x_lru, y_lru, q, k, v = jnp.split(proj, splits, axis=-1)
    lru = rg_lru_group(x_lru, conv_w, conv_b, gate_a_w, gate_a_b, gate_x_w, gate_x_b, lam)
    lru = lru * jax.nn.gelu(y_lru)
    q = q.reshape(B, S, ATTN_Q_HEADS, ATTN_HEAD_DIM)
    k = k.reshape(B, S, ATTN_KV_HEADS, ATTN_HEAD_DIM)
    v = v.reshape(B, S, ATTN_KV_HEADS, ATTN_HEAD_DIM)
    q = partial_rope(rms_norm(q, q_norm_g), positions)
    k = partial_rope(rms_norm(k, k_norm_g), positions)
    attn = sliding_window_attention(q, k, v, sinks)
    mixed = jnp.concatenate([rms_norm(lru, out_norm_lru_g), rms_norm(attn, out_norm_attn_g)], axis=-1)
    x = x + g1[:, None, :] * (mixed @ w_out)

    h2 = modulate(rms_norm(x, norm2_g), sh2, sc2)
    x = x + g2[:, None, :] * peer_ffn(h2, peer_w_q, peer_sub_keys, peer_u, peer_v)
    return x


def setup_inputs(seed: int = 0) -> dict:
    key = jax.random.key(seed)
    ks = jax.random.split(key, 32)
    f32 = jnp.float32
    L, D = DEPTH, D_MODEL

    def nrm(k, shape, scale):
        return jax.random.normal(k, shape, f32) * scale

    def gain(k, shape):
        return 1.0 + 0.02 * jax.random.normal(k, shape, f32)

    a_c = jax.random.uniform(ks[10], (L, LRU_WIDTH), f32, minval=0.9, maxval=0.999)
    a0 = a_c ** (1.0 / LRU_C)
    lru_lambda = jnp.log(a0) - jnp.log1p(-a0)
    offsets = jax.random.randint(ks[3], (BATCH, 1), 0, 1024, dtype=jnp.int32)
    positions = offsets + jnp.arange(SEQ, dtype=jnp.int32)[None, :]
    return {
        'x': nrm(ks[0], (BATCH, SEQ, D), 1.0),
        'c': nrm(ks[1], (BATCH, D), 1.0),
        'positions': positions,
        'w_ada': nrm(ks[2], (L, D, 6 * D), 0.5 * D ** -0.5),
        'b_ada': nrm(ks[4], (L, 6 * D), 0.02),
        'norm1_g': gain(ks[5], (L, D)),
        'w_in': nrm(ks[6], (L, D, MIX_IN), D ** -0.5),
        'conv_w': nrm(ks[7], (L, CONV_WIDTH, LRU_WIDTH), CONV_WIDTH ** -0.5),
        'conv_b': nrm(ks[8], (L, LRU_WIDTH), 0.02),
        'lru_gate_a_w': nrm(ks[9], (L, LRU_BLOCKS, LRU_BLOCK, LRU_BLOCK), LRU_BLOCK ** -0.5),
        'lru_gate_a_b': nrm(ks[11], (L, LRU_WIDTH), 0.02),
        'lru_gate_x_w': nrm(ks[12], (L, LRU_BLOCKS, LRU_BLOCK, LRU_BLOCK), LRU_BLOCK ** -0.5),
        'lru_gate_x_b': nrm(ks[13], (L, LRU_WIDTH), 0.02),
        'lru_lambda': lru_lambda,
        'q_norm_g': gain(ks[14], (L, ATTN_HEAD_DIM)),
        'k_norm_g': gain(ks[15], (L, ATTN_HEAD_DIM)),
        'attn_sinks': nrm(ks[16], (L, ATTN_Q_HEADS), 0.5),
        'out_norm_lru_g': gain(ks[17], (L, LRU_WIDTH)),
        'out_norm_attn_g': gain(ks[18], (L, Q_WIDTH)),
        'w_out': nrm(ks[19], (L, MIX_WIDTH, D), MIX_WIDTH ** -0.5),
        'norm2_g': gain(ks[20], (L, D)),
        'peer_w_q': nrm(ks[21], (L, D, PEER_HEADS * PEER_QUERY_DIM), D ** -0.5),
        'peer_sub_keys': nrm(ks[22], (L, PEER_HEADS, 2, PEER_N_KEYS, PEER_HALF), PEER_HALF ** -0.5),
        'peer_u': nrm(ks[23], (L, PEER_N_EXPERTS, D), D ** -0.5),
        'peer_v': nrm(ks[24], (L, PEER_N_EXPERTS, D), PEER_HEADS ** -0.5),
    }


def reference(x, c, positions, w_ada, b_ada, norm1_g, w_in, conv_w, conv_b,
              lru_gate_a_w, lru_gate_a_b, lru_gate_x_w, lru_gate_x_b, lru_lambda,
              q_norm_g, k_norm_g, attn_sinks, out_norm_lru_g, out_norm_attn_g, w_out,
              norm2_g, peer_w_q, peer_sub_keys, peer_u, peer_v):
    for l in range(DEPTH):
        x = hybrid_layer(x, c, positions, w_ada[l], b_ada[l], norm1_g[l], w_in[l], conv_w[l], conv_b[l],
                         lru_gate_a_w[l], lru_gate_a_b[l], lru_gate_x_w[l], lru_gate_x_b[l], lru_lambda[l],
                         q_norm_g[l], k_norm_g[l], attn_sinks[l], out_norm_lru_g[l], out_norm_attn_g[l],
                         w_out[l], norm2_g[l], peer_w_q[l], peer_sub_keys[l], peer_u[l], peer_v[l])
    return x
```

```cpp
#include <hip/hip_runtime.h>
#include <cstdio>
#include <cstdint>
namespace pg8 {
#define PG8_LAS __attribute__((address_space(3)))
typedef unsigned short bf16_t;
typedef short bf16x8 __attribute__((ext_vector_type(8)));
typedef float f32x4 __attribute__((ext_vector_type(4)));
typedef unsigned u32x4 __attribute__((ext_vector_type(4)));
constexpr int BM = 256, BK = 64, HALF = 128, HTB = HALF * BK * 2  , STAGE_BYTES = 8 * HTB, NXCD = 8, WGM = 8;

__host__ __device__ __forceinline__ int lds_byte(int r, int c) { const int st = (r >> 4) * 2 + (c >> 5), rr = r & 15, cc = c & 31, ob = rr * 64 + cc * 2; return st * 1024 + (ob ^ (((ob >> 9) & 1) << 5)); }
__host__ __device__ __forceinline__ void stage_rc(int b, int& R, int& C) { const int st = b / 1024, sb = b % 1024, swz = sb ^ (((sb >> 9) & 1) << 5); R = (st >> 1) * 16 + swz / 64; C = (st & 1) * 32 + (swz % 64) / 2; }
__host__ __device__ __forceinline__ int perm32(int rho) { const int n = rho >> 4, i = rho & 15; return 8 * (i >> 2) + 4 * n + (i & 3); }

struct Unit { int pm, pn; };
struct Gemm { const bf16_t* A; const bf16_t* Bt; int M, N, K; };

struct StaticOrder {
    int nM, nN, nwg, G, c;
    __host__ __device__ void init(int M, int N, int G_, int c_) { nM = M / BM; nN = N / BM; nwg = nM * nN; G = G_; c = c_; }
    __host__ __device__ bool next(int i, Unit& u) const {
        const long L = (long)i * G + c; if (L >= nwg) return false;
        int wgid = (int)L; { const int q = nwg / NXCD, r = nwg % NXCD, xcd = wgid % NXCD, off = wgid / NXCD; wgid = (xcd < r ? xcd * (q + 1) : r * (q + 1) + (xcd - r) * q) + off; }
        const int nig = WGM * nN, gid = wgid / nig, fm = gid * WGM, gsz = (nM - fm) < WGM ? (nM - fm) : WGM;
        u.pm = fm + ((wgid % nig) % gsz); u.pn = (wgid % nig) / gsz; return true;
    }
    __device__ __forceinline__ void a_ready(const Unit&) const {}
    __device__ __forceinline__ void done(const Unit&) const {}
};

__device__ __forceinline__ unsigned cvt_pk_bf16(float lo, float hi) { unsigned r; asm volatile("v_cvt_pk_bf16_f32 %0, %1, %2" : "=v"(r) : "v"(lo), "v"(hi)); return r; }
struct EpiStoreBf16 {
    static constexpr bool PERM = true, AFTER_DRAIN = false;
    bf16_t* O; int ldc;
    __device__ __forceinline__ void operator()(const f32x4 (&acc)[2][2][4][2], const Unit& u, int wr, int wc, int fr, int fq) const {
        const int row0 = u.pm * BM + wr * 64 + fr; const int col0 = u.pn * BM + wc * 32 + 8 * fq;
#pragma unroll
        for (int ai = 0; ai < 2; ++ai)
#pragma unroll
            for (int m = 0; m < 4; ++m) { bf16_t* rowp = O + (size_t)(row0 + ai * HALF + m * 16) * ldc + col0;
#pragma unroll
                for (int bj = 0; bj < 2; ++bj) { const f32x4 v0 = acc[ai][bj][m][0], v1 = acc[ai][bj][m][1];
                    u32x4 w; w.x = cvt_pk_bf16(v0[0], v0[1]); w.y = cvt_pk_bf16(v0[2], v0[3]); w.z = cvt_pk_bf16(v1[0], v1[1]); w.w = cvt_pk_bf16(v1[2], v1[3]);
                    *(u32x4*)(rowp + bj * HALF) = w; } }
    }
};
struct EpiResid {
    static constexpr bool PERM = false, AFTER_DRAIN = false;
    const float* base; float* out; int ldc; const float* gate; int gstride; int rows_per_batch;
    __device__ __forceinline__ void operator()(const f32x4 (&acc)[2][2][4][2], const Unit& u, int wr, int wc, int fr, int fq) const {
        const int b = (u.pm * BM) / rows_per_batch; const float* g = gate + (size_t)b * gstride;
        const int col0 = u.pn * BM + wc * 32 + 4 * fq;
        f32x4 gv[2][2];
#pragma unroll
        for (int bj = 0; bj < 2; ++bj)
#pragma unroll
            for (int n = 0; n < 2; ++n) gv[bj][n] = *(const f32x4*)(g + col0 + bj * HALF + n * 16);
#pragma unroll
        for (int ai = 0; ai < 2; ++ai)
#pragma unroll
            for (int m = 0; m < 4; ++m) { const size_t off = (size_t)(u.pm * BM + ai * HALF + wr * 64 + m * 16 + fr) * ldc + col0;
#pragma unroll
                for (int bj = 0; bj < 2; ++bj)
#pragma unroll
                    for (int n = 0; n < 2; ++n) { const f32x4 bs = *(const f32x4*)(base + off + bj * HALF + n * 16);
                        *(f32x4*)(out + off + bj * HALF + n * 16) = bs + gv[bj][n] * acc[ai][bj][m][n]; }
                if (m & 1) asm volatile("" ::: "memory"); }
    }
};

template <class Epi, class Sched, bool ALIGN_EPI = false, bool SP2 = false>
__device__ __forceinline__ void gemm_phase(PG8_LAS unsigned char* lds, const Gemm g, const Sched& S, const Epi& E) {
    const int tid = threadIdx.x, wid = __builtin_amdgcn_readfirstlane(tid >> 6), lane = tid & 63, wr = wid >> 2, wc = wid & 3, fr = lane & 15, fq = lane >> 4;
    const int K = g.K, nt = K / BK;
    unsigned voffA[2], voffB[2];
#pragma unroll
    for (int i = 0; i < 2; ++i) { int R, C; stage_rc(tid * 16 + i * 8192, R, C); const int Rb = Epi::PERM ? ((R & ~31) + perm32(R & 31)) : R;
        voffA[i] = (unsigned)(R * K + C) * 2u; voffB[i] = (unsigned)(Rb * K + C) * 2u; }
    const size_t kstep = (size_t)(BK * 2);
    const size_t hstep = (size_t)HALF * K * 2;
    const size_t tstep = 2 * hstep;
    const unsigned ldsw = (unsigned)wid * 1024u;
    const int aoff = lds_byte(wr * 64 + fr, fq * 8), boff = lds_byte(wc * 32 + fr, fq * 8);
#define PG8_SA(b, h) (((b) * 2 + (h)) * HTB)
#define PG8_SB(b, h) ((4 + (b) * 2 + (h)) * HTB)
#define PG8_STAGE(bufoff, gbase, voff) do { _Pragma("unroll") for (int _i = 0; _i < 2; ++_i) \
        __builtin_amdgcn_global_load_lds((const unsigned*)((const char*)(gbase) + (voff)[_i]), (PG8_LAS unsigned*)(lds + (bufoff) + ldsw + _i * 8192), 16, 0, 0); } while (0)
#define PG8_LDA(dst, b, h) do { _Pragma("unroll") for (int m = 0; m < 4; ++m) _Pragma("unroll") for (int k = 0; k < 2; ++k) dst[m][k] = *(const PG8_LAS bf16x8*)(lds + PG8_SA(b, h) + aoff + m * 2048 + k * 1024); } while (0)
#define PG8_LDB(dst, b, h) do { _Pragma("unroll") for (int n = 0; n < 2; ++n) _Pragma("unroll") for (int k = 0; k < 2; ++k) dst[n][k] = *(const PG8_LAS bf16x8*)(lds + PG8_SB(b, h) + boff + n * 2048 + k * 1024); } while (0)
#define PG8_MMA(ai, bj, At, Bt) do { __builtin_amdgcn_s_setprio(1); _Pragma("unroll") for (int m = 0; m < 4; ++m) _Pragma("unroll") for (int n = 0; n < 2; ++n) _Pragma("unroll") for (int k = 0; k < 2; ++k) \
        acc[ai][bj][m][n] = __builtin_amdgcn_mfma_f32_16x16x32_bf16(Bt[n][k], At[m][k], acc[ai][bj][m][n], 0, 0, 0); __builtin_amdgcn_s_setprio(0); } while (0)
#define PG8_WAIT_V(n) asm volatile("s_waitcnt vmcnt(" #n ")" ::: "memory")
#define PG8_WAIT_L(n) asm volatile("s_waitcnt lgkmcnt(" #n ")" ::: "memory")
#define PG8_BAR __builtin_amdgcn_s_barrier()
#define PG8_SCHED __builtin_amdgcn_sched_barrier(0)
    Unit cur, nxt; int ui = 0;
    if (!S.next(0, cur)) return;
    f32x4 acc[2][2][4][2];
#pragma unroll
    for (int a = 0; a < 2; ++a)
#pragma unroll
        for (int b = 0; b < 2; ++b)
#pragma unroll
            for (int m = 0; m < 4; ++m)
#pragma unroll
                for (int n = 0; n < 2; ++n) acc[a][b][m][n] = (f32x4){0.f, 0.f, 0.f, 0.f};
    bf16x8 At[4][2], B0[2][2], B1[2][2];
    const char* cA = (const char*)g.A + (size_t)cur.pm * tstep; const char* cB = (const char*)g.Bt + (size_t)cur.pn * tstep;
    S.a_ready(cur);
    if constexpr (SP2) {
        PG8_STAGE(PG8_SB(0, 0), cB, voffB); PG8_STAGE(PG8_SB(0, 1), cB + hstep, voffB); PG8_STAGE(PG8_SA(0, 0), cA, voffA); PG8_STAGE(PG8_SA(0, 1), cA + hstep, voffA);
        if (wr == 1) PG8_BAR;
        PG8_WAIT_V(2); PG8_BAR;
        PG8_STAGE(PG8_SB(1, 0), cB + kstep, voffB); PG8_STAGE(PG8_SA(1, 0), cA + kstep, voffA); PG8_STAGE(PG8_SB(1, 1), cB + hstep + kstep, voffB);
        PG8_WAIT_V(6); PG8_BAR;
    } else {
        PG8_STAGE(PG8_SB(0, 0), cB, voffB); PG8_STAGE(PG8_SA(0, 0), cA, voffA); PG8_STAGE(PG8_SB(0, 1), cB + hstep, voffB); PG8_STAGE(PG8_SA(0, 1), cA + hstep, voffA);
        if (wr == 1) PG8_BAR;
        PG8_WAIT_V(4); PG8_BAR;
        PG8_STAGE(PG8_SB(1, 0), cB + kstep, voffB); PG8_STAGE(PG8_SA(1, 0), cA + kstep, voffA); PG8_STAGE(PG8_SB(1, 1), cB + hstep + kstep, voffB);
        PG8_WAIT_V(6); PG8_BAR;
    }
    for (;;) {
        const bool has_next = S.next(ui + 1, nxt);
        const char* nA = has_next ? (const char*)g.A + (size_t)nxt.pm * tstep : cA; const char* nB = has_next ? (const char*)g.Bt + (size_t)nxt.pn * tstep : cB;
        for (int t = 0; t < nt; t += 2) {
            const bool last = (t == nt - 2);
            const char* a1 = cA + (size_t)(t + 1) * kstep;
            const char* a2 = last ? nA : cA + (size_t)(t + 2) * kstep; const char* b2 = last ? nB : cB + (size_t)(t + 2) * kstep;
            const char* a3 = a2 + kstep; const char* b3 = b2 + kstep;
            if (last && has_next) S.a_ready(nxt);
            if constexpr (SP2) {
            PG8_LDB(B0, 0, 0); PG8_LDB(B1, 0, 1); PG8_SCHED; PG8_LDA(At, 0, 0); PG8_STAGE(PG8_SA(1, 1), a1 + hstep, voffA);
            PG8_WAIT_V(8); PG8_WAIT_L(0); PG8_BAR; PG8_MMA(0, 0, At, B0); PG8_MMA(0, 1, At, B1); PG8_BAR; PG8_SCHED;
            PG8_LDA(At, 0, 1); PG8_STAGE(PG8_SB(0, 0), b2, voffB); PG8_STAGE(PG8_SB(0, 1), b2 + hstep, voffB); PG8_STAGE(PG8_SA(0, 0), a2, voffA);
            PG8_WAIT_V(8); PG8_WAIT_L(0); PG8_BAR; PG8_MMA(1, 0, At, B0); PG8_MMA(1, 1, At, B1); PG8_BAR; PG8_SCHED;
            PG8_LDB(B0, 1, 0); PG8_LDB(B1, 1, 1); PG8_SCHED; PG8_LDA(At, 1, 0); PG8_STAGE(PG8_SA(0, 1), a2 + hstep, voffA);
            PG8_WAIT_V(8); PG8_WAIT_L(0); PG8_BAR; PG8_MMA(0, 0, At, B0); PG8_MMA(0, 1, At, B1); PG8_BAR; PG8_SCHED;
            PG8_LDA(At, 1, 1); PG8_STAGE(PG8_SB(1, 0), b3, voffB); PG8_STAGE(PG8_SB(1, 1), b3 + hstep, voffB); PG8_STAGE(PG8_SA(1, 0), a3, voffA);
            PG8_WAIT_V(8); PG8_WAIT_L(0); PG8_BAR; PG8_MMA(1, 0, At, B0); PG8_MMA(1, 1, At, B1); PG8_BAR; PG8_SCHED;
            } else {
            PG8_LDB(B0, 0, 0); PG8_SCHED; PG8_LDA(At, 0, 0); PG8_STAGE(PG8_SA(1, 1), a1 + hstep, voffA);
            PG8_WAIT_L(8); PG8_BAR; PG8_WAIT_L(0); PG8_MMA(0, 0, At, B0); PG8_BAR; PG8_SCHED;
            PG8_LDB(B1, 0, 1); PG8_STAGE(PG8_SB(0, 0), b2, voffB);
            PG8_BAR; PG8_WAIT_L(0); PG8_MMA(0, 1, At, B1); PG8_BAR;
            PG8_LDA(At, 0, 1); PG8_STAGE(PG8_SA(0, 0), a2, voffA);
            PG8_BAR; PG8_WAIT_L(0); PG8_MMA(1, 0, At, B0); PG8_BAR; PG8_SCHED;
            PG8_STAGE(PG8_SB(0, 1), b2 + hstep, voffB);
            PG8_WAIT_V(6); PG8_BAR; PG8_MMA(1, 1, At, B1); PG8_BAR;
            PG8_LDB(B0, 1, 0); PG8_SCHED; PG8_LDA(At, 1, 0); PG8_STAGE(PG8_SA(0, 1), a2 + hstep, voffA);
            PG8_WAIT_L(8); PG8_BAR; PG8_WAIT_L(0); PG8_MMA(0, 0, At, B0); PG8_BAR; PG8_SCHED;
            PG8_LDB(B1, 1, 1); PG8_STAGE(PG8_SB(1, 0), b3, voffB);
            PG8_BAR; PG8_WAIT_L(0); PG8_MMA(0, 1, At, B1); PG8_BAR;
            PG8_LDA(At, 1, 1); PG8_STAGE(PG8_SA(1, 0), a3, voffA);
            PG8_BAR; PG8_WAIT_L(0); PG8_MMA(1, 0, At, B0); PG8_BAR; PG8_SCHED;
            PG8_STAGE(PG8_SB(1, 1), b3 + hstep, voffB);
            PG8_WAIT_V(6); PG8_BAR; PG8_MMA(1, 1, At, B1); PG8_BAR;
            }
        }
        if constexpr (ALIGN_EPI) { if (wr == 0) PG8_BAR; }
        if constexpr (!Epi::AFTER_DRAIN) { E(acc, cur, wr, wc, fr, fq); S.done(cur); }
        if (!has_next) break;
#pragma unroll
        for (int a = 0; a < 2; ++a)
#pragma unroll
            for (int b = 0; b < 2; ++b)
#pragma unroll
                for (int m = 0; m < 4; ++m)
#pragma unroll
                    for (int n = 0; n < 2; ++n) acc[a][b][m][n] = (f32x4){0.f, 0.f, 0.f, 0.f};
        cur = nxt; cA = nA; cB = nB; ++ui;
        if constexpr (ALIGN_EPI) { if (wr == 1) PG8_BAR; }
    }
    PG8_WAIT_V(0);
    if constexpr (!ALIGN_EPI) { if (wr == 0) PG8_BAR; }
    PG8_BAR;
    if constexpr (Epi::AFTER_DRAIN) { E.fused(acc, cur, wr, wc, fr, fq, lds, wid, lane); S.done(cur); }
#undef PG8_SA
#undef PG8_SB
#undef PG8_STAGE
#undef PG8_LDA
#undef PG8_LDB
#undef PG8_MMA
#undef PG8_WAIT_V
#undef PG8_WAIT_L
#undef PG8_BAR
#undef PG8_SCHED
}
}

constexpr int NWAVES = 8;
#ifndef MK_N_LAUNCHES
#define MK_N_LAUNCHES 10
#endif
constexpr int N_PHASES = 10;
constexpr int N_LAUNCHES = MK_N_LAUNCHES;

constexpr int BATCH = 4, SEQ = 4096, D = 2048, M = BATCH * SEQ;
constexpr int LRU_W = 1024, LRU_HEADS = 8, LRU_BLK = 128;
constexpr int HD = 64, HQ = 16, HKV = 2, GRP = 8;
constexpr int MIX_IN = 3328;
constexpr int C_Y = 1024, C_Q = 2048, C_K = 3072, C_V = 3200;
constexpr int ADA_W = 6 * D;
constexpr int PH = 8, PKEYS = 128, PHALF = 128, PTOPK = 16, NEXP = 16384;
constexpr float EPS = 1e-6f;

constexpr size_t MiB = 1u << 20;
constexpr size_t WS_CTL = 0, CTL_ZERO_BYTES = 1 * MiB;
constexpr size_t WS_ADA = 1 * MiB;
constexpr size_t WS_ROPE = 2 * MiB;
constexpr size_t WS_WIN = 4 * MiB;
constexpr size_t WS_WOUT = 17 * MiB;
constexpr size_t WS_WQ = 25 * MiB;
constexpr size_t WS_WGA = 33 * MiB;
constexpr size_t WS_WGX = 33 * MiB + 256 * 1024;
constexpr size_t WS_SK = 33 * MiB + 512 * 1024;
constexpr size_t WS_IDX = 34 * MiB;
constexpr size_t WS_GW = 42 * MiB;
constexpr size_t WS_U = 50 * MiB;
constexpr size_t WS_V = 114 * MiB;
constexpr size_t WS_XH = 178 * MiB;
constexpr size_t WS_PROJ = 242 * MiB;
constexpr size_t WS_HL = 346 * MiB;
constexpr size_t WS_PA = 410 * MiB;
constexpr size_t WS_END = 474 * MiB;
constexpr int CW_BAR = 4096;

constexpr int RING_BYTES = 131072;
constexpr int LDSCTL_OFF = RING_BYTES, MISC_OFF = LDSCTL_OFF + 320;
constexpr int LDS_BYTES = 147456;

#define GAS __attribute__((address_space(1)))
#define LAS __attribute__((address_space(3)))
typedef unsigned short bf16;
typedef unsigned v4u __attribute__((ext_vector_type(4)));
typedef unsigned v2u __attribute__((ext_vector_type(2)));
typedef float f32x4 __attribute__((ext_vector_type(4)));
typedef float f32x2 __attribute__((ext_vector_type(2)));
typedef float f32x16 __attribute__((ext_vector_type(16)));
typedef short bf16x8 __attribute__((ext_vector_type(8)));
typedef __bf16 bf16x2v __attribute__((ext_vector_type(2)));
#define LDS_WAIT() asm volatile("s_waitcnt lgkmcnt(0)" ::: "memory")
#define VM_WAIT() asm volatile("s_waitcnt vmcnt(0)" ::: "memory")
__device__ __forceinline__ unsigned f2bf(float f) { unsigned u = __builtin_bit_cast(unsigned, f); return (u + 0x7fffu + ((u >> 16) & 1u)) >> 16; }
__device__ __forceinline__ unsigned pk2(float lo, float hi) { return f2bf(lo) | (f2bf(hi) << 16); }
__device__ __forceinline__ float bflo(unsigned u) { return __builtin_bit_cast(float, u << 16); }
__device__ __forceinline__ float bfhi(unsigned u) { return __builtin_bit_cast(float, u & 0xffff0000u); }
__device__ __forceinline__ float bf1(bf16 h) { return __builtin_bit_cast(float, (unsigned)h << 16); }
__device__ __forceinline__ float dot2bf(unsigned a, unsigned b, float acc) { return __builtin_amdgcn_fdot2_f32_bf16(__builtin_bit_cast(bf16x2v, a), __builtin_bit_cast(bf16x2v, b), acc, false); }
__device__ __forceinline__ float sigmoidf_(float x) { return 1.0f / (1.0f + __expf(-x)); }
__device__ __forceinline__ float gelu_tanh(float x) {
    const float z = 1.5957691216057308f * (x + 0.044715f * x * x * x);
    return x / (1.0f + __expf(-z));
}
__device__ __forceinline__ float wave_sum(float v) {
#pragma unroll
    for (int o = 1; o < 64; o <<= 1) v += __shfl_xor(v, o);
    return v;
}

#define XB_TMO      128
#define XB_XCNT(j)  (256  + 64 * (j))
#define XB_XSUB(j)  (1280 + 64 * (j))
#define XB_XGEN(j)  (2304 + 64 * (j))
#define XB_TOP      3328
#define XB_TOPGEN   3392
#define XCD_BAR_WORDS 3456
#define XB_SPIN_CAP (1u << 18)
__device__ __forceinline__ unsigned xb_ld(unsigned* p)              { return __hip_atomic_load(p, __ATOMIC_RELAXED, __HIP_MEMORY_SCOPE_AGENT); }
__device__ __forceinline__ unsigned xb_add(unsigned* p, unsigned v) { return __hip_atomic_fetch_add(p, v, __ATOMIC_RELAXED, __HIP_MEMORY_SCOPE_AGENT); }
__device__ __forceinline__ unsigned xb_xcc_id() { return (unsigned)__builtin_amdgcn_s_getreg((3 << 11) | 20) & 0xFu; }
#define XB_SPIN(cond, bar) do { unsigned _sp = 0; while (cond) { __builtin_amdgcn_s_sleep(1); \
    if ((++_sp & 255u) == 0u) { if (xb_ld(&(bar)[XB_TMO])) break; if (_sp > XB_SPIN_CAP) { atomicAdd(&(bar)[XB_TMO], 1u); break; } } } } while (0)
struct XcdBarrier { unsigned* bar; unsigned x; volatile LAS unsigned* st; };
__device__ __forceinline__ XcdBarrier xcd_barrier_post(unsigned* bar, volatile LAS unsigned* st) {
    XcdBarrier b; b.bar = bar; b.x = xb_xcc_id(); b.st = st;
    if (threadIdx.x == 0) (void)xb_add(&bar[XB_XCNT(b.x)], 1u);
    return b;
}
__device__ __forceinline__ void xcd_barrier_complete(unsigned* bar, unsigned x, unsigned& nloc, unsigned& nx) {
    const unsigned G = gridDim.x * gridDim.y * gridDim.z;
    unsigned sum, cnt, mine, sp = 0u;
    for (;;) {
        sum = 0u; cnt = 0u; mine = 0u;
#pragma unroll
        for (unsigned j = 0; j < 16; ++j) { const unsigned c = xb_ld(&bar[XB_XCNT(j)]); sum += c; cnt += (c > 0u) ? 1u : 0u; mine = (j == x) ? c : mine; }
        if (sum == G) break;
        __builtin_amdgcn_s_sleep(1);
        if ((++sp & 255u) == 0u) { if (xb_ld(&bar[XB_TMO])) break; if (sp > XB_SPIN_CAP) { atomicAdd(&bar[XB_TMO], 1u); break; } }
    }
    nloc = mine > 0u ? mine : 1u; nx = cnt > 0u ? cnt : 1u;
}
__device__ __forceinline__ void xcd_barrier(const XcdBarrier& b) {
    asm volatile("s_waitcnt vmcnt(0)" ::: "memory");
    __syncthreads();
    if (threadIdx.x == 0) {
        unsigned* bar = b.bar;
        __builtin_amdgcn_s_waitcnt(0);
        unsigned nloc = b.st[0], nx = b.st[1];
        if (nloc == 0u) { xcd_barrier_complete(bar, b.x, nloc, nx); b.st[0] = nloc; b.st[1] = nx; }
        const unsigned old = xb_add(&bar[XB_XSUB(b.x)], 1u);
        const unsigned gen = old / nloc;
        if (old + 1u == (gen + 1u) * nloc) {
            __builtin_amdgcn_fence(__ATOMIC_RELEASE, "agent");
            asm volatile("s_waitcnt vmcnt(0)" ::: "memory");
            const unsigned og = xb_add(&bar[XB_TOP], 1u);
            const unsigned tg = og / nx;
            if (og + 1u == (tg + 1u) * nx) xb_add(&bar[XB_TOPGEN], 1u);
            else XB_SPIN(xb_ld(&bar[XB_TOPGEN]) == tg, bar);
            __builtin_amdgcn_fence(__ATOMIC_ACQUIRE, "agent");
            xb_add(&bar[XB_XGEN(b.x)], 1u);
            asm volatile("s_waitcnt vmcnt(0)" ::: "memory");
        } else {
            XB_SPIN(xb_ld(&bar[XB_XGEN(b.x)]) == gen, bar);
            __builtin_amdgcn_fence(__ATOMIC_ACQUIRE, "agent");
            asm volatile("s_waitcnt vmcnt(0)" ::: "memory");
        }
    }
    __syncthreads();
}

typedef const __attribute__((address_space(4))) unsigned char* kaptr_t;
struct Frame { LAS unsigned char* lds; int tid, lane, wave, G, bid; kaptr_t ka; };
template <class T> __device__ __forceinline__ T* ka_ptr(const Frame& F, int byte_off) { typedef T* tp; return *(const __attribute__((address_space(4))) tp*)(F.ka + byte_off); }
__device__ __forceinline__ const float* P_x(const Frame& F) { return ka_ptr<const float>(F, 0); }
__device__ __forceinline__ const float* P_c(const Frame& F) { return ka_ptr<const float>(F, 8); }
__device__ __forceinline__ const int* P_pos(const Frame& F) { return ka_ptr<const int>(F, 16); }
__device__ __forceinline__ const float* P_w_ada(const Frame& F) { return ka_ptr<const float>(F, 24); }
__device__ __forceinline__ const float* P_b_ada(const Frame& F) { return ka_ptr<const float>(F, 32); }
__device__ __forceinline__ const float* P_norm1_g(const Frame& F) { return ka_ptr<const float>(F, 40); }
__device__ __forceinline__ const float* P_w_in(const Frame& F) { return ka_ptr<const float>(F, 48); }
__device__ __forceinline__ const float* P_conv_w(const Frame& F) { return ka_ptr<const float>(F, 56); }
__device__ __forceinline__ const float* P_conv_b(const Frame& F) { return ka_ptr<const float>(F, 64); }
__device__ __forceinline__ const float* P_ga_w(const Frame& F) { return ka_ptr<const float>(F, 72); }
__device__ __forceinline__ const float* P_ga_b(const Frame& F) { return ka_ptr<const float>(F, 80); }
__device__ __forceinline__ const float* P_gx_w(const Frame& F) { return ka_ptr<const float>(F, 88); }
__device__ __forceinline__ const float* P_gx_b(const Frame& F) { return ka_ptr<const float>(F, 96); }
__device__ __forceinline__ const float* P_lam(const Frame& F) { return ka_ptr<const float>(F, 104); }
__device__ __forceinline__ const float* P_qn_g(const Frame& F) { return ka_ptr<const float>(F, 112); }
__device__ __forceinline__ const float* P_kn_g(const Frame& F) { return ka_ptr<const float>(F, 120); }
__device__ __forceinline__ const float* P_sinks(const Frame& F) { return ka_ptr<const float>(F, 128); }
__device__ __forceinline__ const float* P_on_lru_g(const Frame& F) { return ka_ptr<const float>(F, 136); }
__device__ __forceinline__ const float* P_on_attn_g(const Frame& F) { return ka_ptr<const float>(F, 144); }
__device__ __forceinline__ const float* P_w_out(const Frame& F) { return ka_ptr<const float>(F, 152); }
__device__ __forceinline__ const float* P_norm2_g(const Frame& F) { return ka_ptr<const float>(F, 160); }
__device__ __forceinline__ const float* P_w_pq(const Frame& F) { return ka_ptr<const float>(F, 168); }
__device__ __forceinline__ const float* P_sub_keys(const Frame& F) { return ka_ptr<const float>(F, 176); }
__device__ __forceinline__ const float* P_pu(const Frame& F) { return ka_ptr<const float>(F, 184); }
__device__ __forceinline__ const float* P_pv(const Frame& F) { return ka_ptr<const float>(F, 192); }
__device__ __forceinline__ float* P_out(const Frame& F) { return ka_ptr<float>(F, 200); }
__device__ __forceinline__ unsigned char* P_ws(const Frame& F) { return ka_ptr<unsigned char>(F, 208); }
__device__ __forceinline__ float* P_ADA(const Frame& F) { return (float*)(P_ws(F) + WS_ADA); }
__device__ __forceinline__ float* P_ROPE(const Frame& F) { return (float*)(P_ws(F) + WS_ROPE); }
__device__ __forceinline__ float* P_HL(const Frame& F) { return (float*)(P_ws(F) + WS_HL); }
__device__ __forceinline__ float* P_PA(const Frame& F) { return (float*)(P_ws(F) + WS_PA); }
__device__ __forceinline__ float* P_GW(const Frame& F) { return (float*)(P_ws(F) + WS_GW); }
__device__ __forceinline__ int* P_IDX(const Frame& F) { return (int*)(P_ws(F) + WS_IDX); }
__device__ __forceinline__ bf16* P_WIN(const Frame& F) { return (bf16*)(P_ws(F) + WS_WIN); }
__device__ __forceinline__ bf16* P_WOUT(const Frame& F) { return (bf16*)(P_ws(F) + WS_WOUT); }
__device__ __forceinline__ bf16* P_WQ(const Frame& F) { return (bf16*)(P_ws(F) + WS_WQ); }
__device__ __forceinline__ bf16* P_WGA(const Frame& F) { return (bf16*)(P_ws(F) + WS_WGA); }
__device__ __forceinline__ bf16* P_WGX(const Frame& F) { return (bf16*)(P_ws(F) + WS_WGX); }
__device__ __forceinline__ bf16* P_SK(const Frame& F) { return (bf16*)(P_ws(F) + WS_SK); }
__device__ __forceinline__ bf16* P_U(const Frame& F) { return (bf16*)(P_ws(F) + WS_U); }
__device__ __forceinline__ bf16* P_V(const Frame& F) { return (bf16*)(P_ws(F) + WS_V); }
__device__ __forceinline__ bf16* P_XH(const Frame& F) { return (bf16*)(P_ws(F) + WS_XH); }
__device__ __forceinline__ bf16* P_PROJ(const Frame& F) { return (bf16*)(P_ws(F) + WS_PROJ); }

__device__ __forceinline__ void p0_transpose_item(const float* W, int K, int N, bf16* WT, LAS float* scr, int item, int lane) {
    const int nblk = N / 32, kb = item / nblk, nb = item % nblk, k0 = 64 * kb, n0 = 32 * nb;
#pragma unroll 8
    for (int i = 0; i < 32; ++i) { const int kk = 2 * i + (lane >> 5); scr[kk * 33 + (lane & 31)] = W[(size_t)(k0 + kk) * N + n0 + (lane & 31)]; }
    LDS_WAIT(); asm volatile("" ::: "memory");
    const int c = lane & 7;
#pragma unroll
    for (int j = 0; j < 4; ++j) { const int n = (lane >> 3) + 8 * j; const LAS float* s = scr + (8 * c) * 33 + n;
        v4u o; o.x = pk2(s[0 * 33], s[1 * 33]); o.y = pk2(s[2 * 33], s[3 * 33]); o.z = pk2(s[4 * 33], s[5 * 33]); o.w = pk2(s[6 * 33], s[7 * 33]);
        *(v4u*)(WT + (size_t)(n0 + n) * K + k0 + 8 * c) = o; }
    LDS_WAIT(); asm volatile("" ::: "memory");
}
__device__ __forceinline__ void p0_convert(const float* src, bf16* dst, size_t n8, size_t gtid, size_t gthreads) {
    for (size_t i = gtid; i < n8; i += gthreads) {
        const f32x4 a = *(const f32x4*)(src + 8 * i), b = *(const f32x4*)(src + 8 * i + 4);
        v4u o; o.x = pk2(a.x, a.y); o.y = pk2(a.z, a.w); o.z = pk2(b.x, b.y); o.w = pk2(b.z, b.w);
        *(v4u*)(dst + 8 * i) = o;
    }
}
__device__ __forceinline__ void p0_prologue(Frame& F) {
    {
        LAS float* sc = (LAS float*)F.lds;
        LAS float* red = sc + 4 * D;
        for (int i = F.tid; i < 4 * D; i += 512) { const float v = P_c(F)[i]; sc[i] = v / (1.0f + __expf(-v)); }
        __syncthreads();
        for (int cg = F.bid; cg < ADA_W / 64; cg += F.G) {
            const int n0 = cg * 64, k0 = F.wave * 256;
            const float* wp = P_w_ada(F) + (size_t)k0 * ADA_W + n0 + F.lane;
            float a0 = 0.f, a1 = 0.f, a2 = 0.f, a3 = 0.f;
#pragma unroll 16
            for (int k = 0; k < 256; ++k) { const float w = wp[(size_t)k * ADA_W]; const int kk = k0 + k;
                a0 += sc[kk] * w; a1 += sc[D + kk] * w; a2 += sc[2 * D + kk] * w; a3 += sc[3 * D + kk] * w; }
            red[(F.wave * 4 + 0) * 64 + F.lane] = a0; red[(F.wave * 4 + 1) * 64 + F.lane] = a1;
            red[(F.wave * 4 + 2) * 64 + F.lane] = a2; red[(F.wave * 4 + 3) * 64 + F.lane] = a3;
            __syncthreads();
            if (F.tid < 256) { const int b = F.tid >> 6, l = F.tid & 63; float s = 0.f;
#pragma unroll
                for (int w = 0; w < 8; ++w) s += red[(w * 4 + b) * 64 + l];
                P_ADA(F)[(size_t)b * ADA_W + n0 + l] = s + P_b_ada(F)[n0 + l]; }
            __syncthreads();
        }
        __syncthreads();
    }
    {
        LAS float* scr = (LAS float*)(F.lds + F.wave * 16384);
        const int gw = F.bid * NWAVES + F.wave, NGW = F.G * NWAVES;
        constexpr int I_IN = (D / 64) * (MIX_IN / 32), I_SQ = (D / 64) * (D / 32), I_G = (LRU_BLK / 64) * (LRU_BLK / 32);
        constexpr int NITEMS = I_IN + 2 * I_SQ + 16 * I_G;
        for (int it = gw; it < NITEMS; it += NGW) {
            int r = it;
            if (r < I_IN) { p0_transpose_item(P_w_in(F), D, MIX_IN, P_WIN(F), scr, r, F.lane); continue; } r -= I_IN;
            if (r < I_SQ) { p0_transpose_item(P_w_out(F), D, D, P_WOUT(F), scr, r, F.lane); continue; } r -= I_SQ;
            if (r < I_SQ) { p0_transpose_item(P_w_pq(F), D, D, P_WQ(F), scr, r, F.lane); continue; } r -= I_SQ;
            const int g = r / I_G, ri = r % I_G, hd = g & 7;
            if (g < 8) p0_transpose_item(P_ga_w(F) + (size_t)hd * 16384, LRU_BLK, LRU_BLK, P_WGA(F) + (size_t)hd * 16384, scr, ri, F.lane);
            else       p0_transpose_item(P_gx_w(F) + (size_t)hd * 16384, LRU_BLK, LRU_BLK, P_WGX(F) + (size_t)hd * 16384, scr, ri, F.lane);
        }
    }
    {
        const size_t gtid = (size_t)F.bid * 512 + F.tid, gth = (size_t)F.G * 512;
        p0_convert(P_sub_keys(F), P_SK(F), (size_t)PH * 2 * PKEYS * PHALF / 8, gtid, gth);
        p0_convert(P_pu(F), P_U(F), (size_t)NEXP * D / 8, gtid, gth);
        p0_convert(P_pv(F), P_V(F), (size_t)NEXP * D / 8, gtid, gth);
    }
}

__device__ __forceinline__ void modnorm_row(const float* xrow, const float* gain, const float* shift, const float* scale, bf16* orow, int lane) {
    f32x4 v[8]; float s = 0.f;
#pragma unroll
    for (int j = 0; j < 8; ++j) { v[j] = *(const f32x4*)(xrow + 4 * lane + 256 * j); s += (v[j].x * v[j].x + v[j].y * v[j].y) + (v[j].z * v[j].z + v[j].w * v[j].w); }
    const float rstd = 1.0f / sqrtf(wave_sum(s) * (1.0f / D) + EPS);
#pragma unroll
    for (int j = 0; j < 8; ++j) {
        const int c = 4 * lane + 256 * j;
        const f32x4 g = *(const f32x4*)(gain + c), sh = *(const f32x4*)(shift + c), sc = *(const f32x4*)(scale + c);
        const f32x4 y = (v[j] * rstd) * g * (sc + 1.0f) + sh;
        v2u o; o.x = pk2(y.x, y.y); o.y = pk2(y.z, y.w);
        *(v2u*)(orow + c) = o;
    }
}
__device__ __forceinline__ void p1_phase(Frame& F) {
    const int gw = F.bid * NWAVES + F.wave, NGW = F.G * NWAVES;
    for (int m = gw; m < M; m += NGW) { const int b = m / SEQ; const float* ada = P_ADA(F) + (size_t)b * ADA_W;
        modnorm_row(P_x(F) + (size_t)m * D, P_norm1_g(F), ada, ada + D, P_XH(F) + (size_t)m * D, F.lane); }
    const float invf[8] = {1.0f, 1.9392274e-01f, 3.7606031e-02f, 7.2926646e-03f, 1.4142136e-03f, 2.7424819e-04f, 5.3182961e-05f, 1.0313386e-05f};
    for (int i = F.bid * 512 + F.tid; i < M * 8; i += F.G * 512) { const int m = i >> 3, k = i & 7;
        float f = invf[0];
#pragma unroll
        for (int q = 1; q < 8; ++q) f = (k == q) ? invf[q] : f;
        const float ang = (float)P_pos(F)[m] * f; float sn, cs; sincosf(ang, &sn, &cs);
        P_ROPE(F)[(size_t)m * 16 + k] = cs; P_ROPE(F)[(size_t)m * 16 + 8 + k] = sn; }
}
__device__ __forceinline__ void p6_phase(Frame& F) {
    const int gw = F.bid * NWAVES + F.wave, NGW = F.G * NWAVES;
    for (int m = gw; m < M; m += NGW) { const int b = m / SEQ; const float* ada = P_ADA(F) + (size_t)b * ADA_W;
        modnorm_row(P_out(F) + (size_t)m * D, P_norm2_g(F), ada + 3 * D, ada + 4 * D, P_XH(F) + (size_t)m * D, F.lane); }
}

#define MFMA32(a, b, c) __builtin_amdgcn_mfma_f32_32x32x16_bf16((a), (b), (c), 0, 0, 0)
#define MFMA16(a, b, c) __builtin_amdgcn_mfma_f32_16x16x32_bf16((a), (b), (c), 0, 0, 0)
constexpr int KS_STRIDE = 72;
constexpr int VT_STRIDE = 264;
constexpr int ATT_KS_OFF = 0, ATT_VT_OFF = 256 * KS_STRIDE * 2;
static_assert(ATT_VT_OFF + 64 * VT_STRIDE * 2 <= RING_BYTES, "attention LDS");

__device__ __forceinline__ void attn_unit(Frame& F, int b, int g, int n) {
    LAS bf16* Ks = (LAS bf16*)(F.lds + ATT_KS_OFF);
    LAS bf16* VT = (LAS bf16*)(F.lds + ATT_VT_OFF);
    const int tid = F.tid, lane = F.lane;
    {
        const int kb = tid >> 1, hf = tid & 1; const int t = n * 128 - 128 + kb;
        float kv[32]; v4u vraw[4];
        if (t >= 0) {
            const bf16* kp = P_PROJ(F) + (size_t)(b * SEQ + t) * MIX_IN + C_K + g * HD + 32 * hf;
            const bf16* vp = P_PROJ(F) + (size_t)(b * SEQ + t) * MIX_IN + C_V + g * HD + 32 * hf;
#pragma unroll
            for (int q = 0; q < 4; ++q) { const v4u r = *(const v4u*)(kp + 8 * q); vraw[q] = *(const v4u*)(vp + 8 * q);
                kv[8 * q + 0] = bflo(r.x); kv[8 * q + 1] = bfhi(r.x); kv[8 * q + 2] = bflo(r.y); kv[8 * q + 3] = bfhi(r.y);
                kv[8 * q + 4] = bflo(r.z); kv[8 * q + 5] = bfhi(r.z); kv[8 * q + 6] = bflo(r.w); kv[8 * q + 7] = bfhi(r.w); }
        } else {
#pragma unroll
            for (int q = 0; q < 4; ++q) vraw[q] = (v4u){0u, 0u, 0u, 0u};
#pragma unroll
            for (int q = 0; q < 32; ++q) kv[q] = 0.f;
        }
        float ss = 0.f;
#pragma unroll
        for (int q = 0; q < 32; ++q) ss += kv[q] * kv[q];
        ss += __shfl_xor(ss, 1);
        const float rstd = 1.0f / sqrtf(ss * (1.0f / HD) + EPS);
#pragma unroll
        for (int q = 0; q < 32; ++q) kv[q] = kv[q] * rstd * P_kn_g(F)[32 * hf + q];
        if (hf == 0 && t >= 0) {
            const float* rp = P_ROPE(F) + (size_t)(b * SEQ + t) * 16;
#pragma unroll
            for (int i = 0; i < 8; ++i) { const float cs = rp[i], sn = rp[8 + i]; const float x1 = kv[i], x2 = kv[8 + i];
                kv[i] = x1 * cs - x2 * sn; kv[8 + i] = x2 * cs + x1 * sn; }
        }
#pragma unroll
        for (int q = 0; q < 4; ++q) { v4u o; o.x = pk2(kv[8 * q], kv[8 * q + 1]); o.y = pk2(kv[8 * q + 2], kv[8 * q + 3]); o.z = pk2(kv[8 * q + 4], kv[8 * q + 5]); o.w = pk2(kv[8 * q + 6], kv[8 * q + 7]);
            *(LAS v4u*)(Ks + kb * KS_STRIDE + 32 * hf + 8 * q) = o; }
#pragma unroll
        for (int q = 0; q < 4; ++q) { const unsigned w[4] = {vraw[q].x, vraw[q].y, vraw[q].z, vraw[q].w};
#pragma unroll
            for (int e = 0; e < 4; ++e) { const int d = 32 * hf + 8 * q + 2 * e;
                VT[d * VT_STRIDE + kb] = (bf16)(w[e] & 0xffffu); VT[(d + 1) * VT_STRIDE + kb] = (bf16)(w[e] >> 16); } }
    }
    __syncthreads();
    const int hq = g * GRP + F.wave, r = lane & 31, hh = lane >> 5;
    const float sink = P_sinks(F)[hq];
    for (int qi = 0; qi < 4; ++qi) {
        const int tq = n * 128 + 32 * qi + r;
        bf16x8 qf[4];
        {
            const bf16* qp = P_PROJ(F) + (size_t)(b * SEQ + tq) * MIX_IN + C_Q + hq * HD + 8 * hh;
            float qv[4][8]; float ss = 0.f;
#pragma unroll
            for (int ks = 0; ks < 4; ++ks) { const v4u rr = *(const v4u*)(qp + 16 * ks);
                qv[ks][0] = bflo(rr.x); qv[ks][1] = bfhi(rr.x); qv[ks][2] = bflo(rr.y); qv[ks][3] = bfhi(rr.y);
                qv[ks][4] = bflo(rr.z); qv[ks][5] = bfhi(rr.z); qv[ks][6] = bflo(rr.w); qv[ks][7] = bfhi(rr.w);
#pragma unroll
                for (int j = 0; j < 8; ++j) ss += qv[ks][j] * qv[ks][j]; }
            ss += __shfl_xor(ss, 32);
            const float rstd = 1.0f / sqrtf(ss * (1.0f / HD) + EPS);
#pragma unroll
            for (int ks = 0; ks < 4; ++ks)
#pragma unroll
                for (int j = 0; j < 8; ++j) qv[ks][j] = qv[ks][j] * rstd * P_qn_g(F)[16 * ks + 8 * hh + j];
            const float* rp = P_ROPE(F) + (size_t)(b * SEQ + tq) * 16;
#pragma unroll
            for (int j = 0; j < 8; ++j) { const float mine = qv[0][j], other = __shfl_xor(mine, 32); const float cs = rp[j], sn = rp[8 + j];
                qv[0][j] = hh == 0 ? (mine * cs - other * sn) : (mine * cs + other * sn); }
#pragma unroll
            for (int ks = 0; ks < 4; ++ks) { v4u o; o.x = pk2(qv[ks][0] * 0.125f, qv[ks][1] * 0.125f); o.y = pk2(qv[ks][2] * 0.125f, qv[ks][3] * 0.125f);
                o.z = pk2(qv[ks][4] * 0.125f, qv[ks][5] * 0.125f); o.w = pk2(qv[ks][6] * 0.125f, qv[ks][7] * 0.125f); qf[ks] = __builtin_bit_cast(bf16x8, o); }
        }
        f32x16 s[5];
#pragma unroll
        for (int kj = 0; kj < 5; ++kj) {
            f32x16 acc;
#pragma unroll
            for (int i = 0; i < 16; ++i) acc[i] = 0.f;
            const LAS bf16* kp = Ks + (32 * (qi + kj) + r) * KS_STRIDE + 8 * hh;
#pragma unroll
            for (int ks = 0; ks < 4; ++ks) { const bf16x8 kf = *(const LAS bf16x8*)(kp + 16 * ks); acc = MFMA32(kf, qf[ks], acc); }
            s[kj] = acc;
        }
        float mx = sink;
#pragma unroll
        for (int kj = 0; kj < 5; ++kj)
#pragma unroll
            for (int i = 0; i < 16; ++i) { const int kt = (i & 3) + 8 * (i >> 2) + 4 * hh; const int kbi = 32 * (qi + kj) + kt;
                bool valid = (n * 128 + kbi - 128) >= 0;
                if (kj == 0) valid = valid && (kt > r);
                if (kj == 4) valid = valid && (kt <= r);
                s[kj][i] = valid ? s[kj][i] : -INFINITY; mx = fmaxf(mx, s[kj][i]); }
        mx = fmaxf(mx, __shfl_xor(mx, 32));
        float l = 0.f;
#pragma unroll
        for (int kj = 0; kj < 5; ++kj)
#pragma unroll
            for (int i = 0; i < 16; ++i) { const float p = __expf(s[kj][i] - mx); s[kj][i] = p; l += p; }
        l += __shfl_xor(l, 32);
        l += __expf(sink - mx);
        const float inv = 1.0f / l;
        f32x16 o0, o1;
#pragma unroll
        for (int i = 0; i < 16; ++i) { o0[i] = 0.f; o1[i] = 0.f; }
#pragma unroll
        for (int kj = 0; kj < 5; ++kj)
#pragma unroll
            for (int st = 0; st < 2; ++st) {
                v4u pa; pa.x = pk2(s[kj][8 * st + 0] * inv, s[kj][8 * st + 1] * inv); pa.y = pk2(s[kj][8 * st + 2] * inv, s[kj][8 * st + 3] * inv);
                pa.z = pk2(s[kj][8 * st + 4] * inv, s[kj][8 * st + 5] * inv); pa.w = pk2(s[kj][8 * st + 6] * inv, s[kj][8 * st + 7] * inv);
                const bf16x8 pf = __builtin_bit_cast(bf16x8, pa);
                const int kb0 = 32 * (qi + kj) + 16 * st + 4 * hh;
                const LAS bf16* v0p = VT + r * VT_STRIDE + kb0; const LAS bf16* v1p = VT + (32 + r) * VT_STRIDE + kb0;
                const v2u a0 = *(const LAS v2u*)v0p, a1 = *(const LAS v2u*)(v0p + 8), b0 = *(const LAS v2u*)v1p, b1 = *(const LAS v2u*)(v1p + 8);
                const v4u vb0 = {a0.x, a0.y, a1.x, a1.y}, vb1 = {b0.x, b0.y, b1.x, b1.y};
                o0 = MFMA32(pf, __builtin_bit_cast(bf16x8, vb0), o0);
                o1 = MFMA32(pf, __builtin_bit_cast(bf16x8, vb1), o1);
            }
#pragma unroll
        for (int i = 0; i < 16; ++i) { const int qr = (i & 3) + 8 * (i >> 2) + 4 * hh; const int tok = n * 128 + 32 * qi + qr;
            bf16* op = P_XH(F) + (size_t)(b * SEQ + tok) * D + LRU_W + hq * HD + r;
            op[0] = (bf16)f2bf(o0[i]); op[32] = (bf16)f2bf(o1[i]); }
    }
    __syncthreads();
}

constexpr int LCH = 64;
constexpr int XC_STRIDE = 136;
constexpr int LRU_XCB_OFF = 0, LRU_XCF_OFF = LCH * XC_STRIDE * 2  , LRU_A_OFF = LRU_XCF_OFF + LCH * 128 * 4, LRU_B_OFF = LRU_A_OFF + LCH * 128 * 4, LRU_SE_OFF = LRU_B_OFF + LCH * 128 * 4;
static_assert(LRU_SE_OFF + 2 * 4 * 128 * 4 <= RING_BYTES, "LRU LDS");
__device__ __forceinline__ void lru_unit(Frame& F, int b, int hd, int ch) {
    LAS bf16* XCb = (LAS bf16*)(F.lds + LRU_XCB_OFF);
    LAS float* XCF = (LAS float*)(F.lds + LRU_XCF_OFF);
    LAS float* As = (LAS float*)(F.lds + LRU_A_OFF);
    LAS float* Bs = (LAS float*)(F.lds + LRU_B_OFF);
    LAS float* SEh = (LAS float*)(F.lds + LRU_SE_OFF);
    LAS float* SEp = SEh + 4 * 128;
    const int tid = F.tid, lane = F.lane;
    const int c = tid & 127, sub = tid >> 7, col = hd * LRU_BLK + c;
    const int t0 = ch * LCH;
    {
        const float w0 = P_conv_w(F)[col], w1 = P_conv_w(F)[LRU_W + col], w2 = P_conv_w(F)[2 * LRU_W + col], w3 = P_conv_w(F)[3 * LRU_W + col], cb = P_conv_b(F)[col];
        const bf16* xp = P_PROJ(F) + (size_t)(b * SEQ) * MIX_IN + col;
        const int ts = t0 + sub * 16;
        float xm3 = (ts - 3 >= 0) ? bf1(xp[(size_t)(ts - 3) * MIX_IN]) : 0.f;
        float xm2 = (ts - 2 >= 0) ? bf1(xp[(size_t)(ts - 2) * MIX_IN]) : 0.f;
        float xm1 = (ts - 1 >= 0) ? bf1(xp[(size_t)(ts - 1) * MIX_IN]) : 0.f;
#pragma unroll
        for (int i = 0; i < 16; ++i) { const float x0 = bf1(xp[(size_t)(ts + i) * MIX_IN]);
            const float xc = cb + w0 * xm3 + w1 * xm2 + w2 * xm1 + w3 * x0;
            const int tl = sub * 16 + i;
            XCF[tl * 128 + c] = xc; XCb[tl * XC_STRIDE + c] = (bf16)f2bf(xc);
            xm3 = xm2; xm2 = xm1; xm1 = x0; }
    }
    __syncthreads();
    {
        const int fr = lane & 15, fq = lane >> 4, j = 16 * F.wave + fr, jc = hd * LRU_BLK + j;
        bf16x8 wa[4], wx[4];
        const bf16* wap = P_WGA(F) + (size_t)hd * 16384 + (size_t)j * 128 + 8 * fq;
        const bf16* wxp = P_WGX(F) + (size_t)hd * 16384 + (size_t)j * 128 + 8 * fq;
#pragma unroll
        for (int ks = 0; ks < 4; ++ks) { wa[ks] = *(const bf16x8*)(wap + 32 * ks); wx[ks] = *(const bf16x8*)(wxp + 32 * ks); }
        const float ba = P_ga_b(F)[jc], bx = P_gx_b(F)[jc];
        const float lamv = P_lam(F)[jc];
        const float sp = log1pf(__expf(-lamv));
#pragma unroll
        for (int mt = 0; mt < 4; ++mt) {
            f32x4 ra = {0.f, 0.f, 0.f, 0.f}, rx = {0.f, 0.f, 0.f, 0.f};
            const LAS bf16* ap = XCb + (16 * mt + fr) * XC_STRIDE + 8 * fq;
#pragma unroll
            for (int ks = 0; ks < 4; ++ks) { const bf16x8 af = *(const LAS bf16x8*)(ap + 32 * ks); ra = MFMA16(af, wa[ks], ra); rx = MFMA16(af, wx[ks], rx); }
#pragma unroll
            for (int e = 0; e < 4; ++e) { const int tl = 16 * mt + 4 * fq + e;
                const float rg = sigmoidf_(ra[e] + ba), ig = sigmoidf_(rx[e] + bx);
                const float la = -8.0f * rg * sp; const float a = __expf(la);
                const float mult = sqrtf(-expm1f(2.0f * la));
                As[tl * 128 + j] = a; Bs[tl * 128 + j] = mult * ig * XCF[tl * 128 + j]; }
        }
    }
    __syncthreads();
    {
        float h = 0.f, P = 1.f;
#pragma unroll
        for (int i = 0; i < 16; ++i) { const int tl = sub * 16 + i; const float a = As[tl * 128 + c], bq = Bs[tl * 128 + c];
            h = a * h + bq; P *= a; Bs[tl * 128 + c] = h; As[tl * 128 + c] = P; }
        SEh[sub * 128 + c] = h; SEp[sub * 128 + c] = P;
    }
    __syncthreads();
    {
        float carry = 0.f, pp = 1.f;
        for (int s2 = 0; s2 < sub; ++s2) { carry = SEh[s2 * 128 + c] + SEp[s2 * 128 + c] * carry; pp *= SEp[s2 * 128 + c]; }
        float* hl = P_HL(F) + (size_t)(b * SEQ + t0 + sub * 16) * LRU_W + col;
        float* pa = P_PA(F) + (size_t)(b * SEQ + t0 + sub * 16) * LRU_W + col;
#pragma unroll
        for (int i = 0; i < 16; ++i) { const int tl = sub * 16 + i;
            hl[(size_t)i * LRU_W] = Bs[tl * 128 + c] + As[tl * 128 + c] * carry; pa[(size_t)i * LRU_W] = As[tl * 128 + c] * pp; }
    }
    __syncthreads();
}
constexpr int N_ATT_UNITS = BATCH * HKV * (SEQ / 128);
constexpr int N_LRU_UNITS = BATCH * LRU_HEADS * (SEQ / LCH);
__device__ __forceinline__ void p3_phase(Frame& F) {
    for (int u = F.bid; u < N_ATT_UNITS + N_LRU_UNITS; u += F.G) {
        if (u < N_ATT_UNITS) attn_unit(F, u >> 6, (u >> 5) & 1, u & 31);
        else { const int v = u - N_ATT_UNITS; lru_unit(F, v >> 9, (v >> 6) & 7, v & 63); }
    }
}

__device__ __forceinline__ void p4_unit(Frame& F, int b, int ch) {
    LAS float* CAR = (LAS float*)F.lds;
    const int tid = F.tid, lane = F.lane;
    {
        f32x2 carry = {0.f, 0.f};
        for (int c2 = 0; c2 < ch; ++c2) { const size_t row = (size_t)(b * SEQ + c2 * LCH + LCH - 1) * LRU_W + 2 * tid;
            const f32x2 hl = *(const f32x2*)(P_HL(F) + row), pa = *(const f32x2*)(P_PA(F) + row);
            carry = hl + pa * carry; }
        CAR[2 * tid] = carry.x; CAR[2 * tid + 1] = carry.y;
    }
    __syncthreads();
    for (int i = 0; i < 8; ++i) {
        const size_t m = (size_t)b * SEQ + ch * LCH + F.wave * 8 + i;
        f32x4 val[4]; float ss = 0.f;
#pragma unroll
        for (int j = 0; j < 4; ++j) { const int c = 4 * lane + 256 * j;
            const f32x4 hl = *(const f32x4*)(P_HL(F) + m * LRU_W + c), pa = *(const f32x4*)(P_PA(F) + m * LRU_W + c), car = *(const LAS f32x4*)(CAR + c);
            const v2u yr = *(const v2u*)(P_PROJ(F) + m * MIX_IN + C_Y + c);
            const f32x4 h = hl + pa * car;
            f32x4 v; v.x = h.x * gelu_tanh(bflo(yr.x)); v.y = h.y * gelu_tanh(bfhi(yr.x)); v.z = h.z * gelu_tanh(bflo(yr.y)); v.w = h.w * gelu_tanh(bfhi(yr.y));
            val[j] = v; ss += (v.x * v.x + v.y * v.y) + (v.z * v.z + v.w * v.w); }
        float rstd = 1.0f / sqrtf(wave_sum(ss) * (1.0f / LRU_W) + EPS);
#pragma unroll
        for (int j = 0; j < 4; ++j) { const int c = 4 * lane + 256 * j; const f32x4 g = *(const f32x4*)(P_on_lru_g(F) + c); const f32x4 y = val[j] * rstd * g;
            v2u o; o.x = pk2(y.x, y.y); o.y = pk2(y.z, y.w); *(v2u*)(P_XH(F) + m * D + c) = o; }
        ss = 0.f;
#pragma unroll
        for (int j = 0; j < 4; ++j) { const int c = 4 * lane + 256 * j; const v2u ar = *(const v2u*)(P_XH(F) + m * D + LRU_W + c);
            f32x4 v; v.x = bflo(ar.x); v.y = bfhi(ar.x); v.z = bflo(ar.y); v.w = bfhi(ar.y); val[j] = v; ss += (v.x * v.x + v.y * v.y) + (v.z * v.z + v.w * v.w); }
        rstd = 1.0f / sqrtf(wave_sum(ss) * (1.0f / LRU_W) + EPS);
#pragma unroll
        for (int j = 0; j < 4; ++j) { const int c = 4 * lane + 256 * j; const f32x4 g = *(const f32x4*)(P_on_attn_g(F) + c); const f32x4 y = val[j] * rstd * g;
            v2u o; o.x = pk2(y.x, y.y); o.y = pk2(y.z, y.w); *(v2u*)(P_XH(F) + m * D + LRU_W + c) = o; }
    }
    __syncthreads();
}
__device__ __forceinline__ void p4_phase(Frame& F) {
    for (int u = F.bid; u < BATCH * (SEQ / LCH); u += F.G) p4_unit(F, u >> 6, u & 63);
}

__device__ __forceinline__ int f2key(float f) { const int b = __builtin_bit_cast(int, f); return b ^ ((b >> 31) & 0x7fffffff); }
__device__ __forceinline__ float key2f(int k) { const int b = k ^ ((k >> 31) & 0x7fffffff); return __builtin_bit_cast(float, b); }
__device__ __forceinline__ void ins16(int (&L)[16], int x) {
#pragma unroll
    for (int j = 0; j < 16; ++j) { const int hi = max(L[j], x); x = min(L[j], x); L[j] = hi; }
}
constexpr int INT_LOWEST = (int)0x80000000;
__device__ __forceinline__ void p8_item(Frame& F, int tt, int hd, LAS int* lut  ) {
    const int lane = F.lane, r = lane & 31, hh = lane >> 5;
    const bf16* QP = P_PROJ(F);
    int V[2][16];
#pragma unroll
    for (int p = 0; p < 2; ++p) {
        bf16x8 qf[8];
        const char* qb = (const char*)(QP + (size_t)(32 * tt) * D + hd * 256 + p * 128);
        const unsigned qoff = (unsigned)(r * D + 8 * hh) * 2u;
#pragma unroll
        for (int ks = 0; ks < 8; ++ks) qf[ks] = *(const bf16x8*)(qb + qoff + 32 * ks);
        int L[16];
#pragma unroll
        for (int j = 0; j < 16; ++j) L[j] = INT_LOWEST;
        const char* skb = (const char*)(P_SK(F) + (size_t)((hd * 2 + p) * PKEYS) * PHALF);
        const unsigned skoff = (unsigned)(r * PHALF + 8 * hh) * 2u;
#pragma unroll 1
        for (int kt = 0; kt < 4; ++kt) {
            f32x16 acc;
#pragma unroll
            for (int i = 0; i < 16; ++i) acc[i] = 0.f;
            const char* skt = skb + (size_t)(32 * kt) * PHALF * 2;
#pragma unroll
            for (int ks = 0; ks < 8; ++ks) { const bf16x8 kf = *(const bf16x8*)(skt + skoff + 32 * ks); acc = MFMA32(kf, qf[ks], acc); }
            const int kbase = 32 * kt + 4 * hh;
#pragma unroll
            for (int i = 0; i < 16; ++i) { const int kidx = (i & 3) + 8 * (i >> 2);
                const int key = (f2key(acc[i]) & ~0x7f) | (kbase + kidx);
                ins16(L, key); }
        }
        int O[16];
#pragma unroll
        for (int j = 0; j < 16; ++j) O[j] = __shfl_xor(L[j], 32);
#pragma unroll
        for (int j = 0; j < 16; ++j) ins16(L, O[j]);
#pragma unroll
        for (int j = 0; j < 16; ++j) V[p][j] = L[j];
    }
#pragma unroll
    for (int j = 0; j < 16; ++j) { lut[lane * 33 + j] = V[0][j] & 0x7f; lut[lane * 33 + 16 + j] = V[1][j] & 0x7f; }
    float v0[16], v1[16];
#pragma unroll
    for (int j = 0; j < 16; ++j) { v0[j] = key2f(V[0][j] & ~0x7f); v1[j] = key2f(V[1][j] & ~0x7f); }
    int C[16];
#pragma unroll
    for (int j = 0; j < 16; ++j) C[j] = INT_LOWEST;
#pragma unroll
    for (int i = 0; i < 16; ++i)
#pragma unroll
        for (int j = 0; j < 16; ++j)
            if ((i + 1) * (j + 1) <= 16) { const int key = (f2key(v0[i] + v1[j]) & ~0xff) | (i * 16 + j); ins16(C, key); }
    float sv[16]; float den = 0.f;
    const float mx = key2f(C[0] & ~0xff);
#pragma unroll
    for (int e = 0; e < 16; ++e) { sv[e] = __expf(key2f(C[e] & ~0xff) - mx); den += sv[e]; }
    const float inv = 1.0f / den;
    LDS_WAIT(); asm volatile("" ::: "memory");
    int idx[16];
#pragma unroll
    for (int e = 0; e < 16; ++e) { const int pi = (C[e] >> 4) & 15, pj = C[e] & 15; idx[e] = lut[lane * 33 + pi] * PKEYS + lut[lane * 33 + 16 + pj]; }
    if (hh == 0) {
        int* ip = P_IDX(F) + (size_t)(32 * tt + r) * 128 + hd * 16; float* gp = P_GW(F) + (size_t)(32 * tt + r) * 128 + hd * 16;
#pragma unroll
        for (int q = 0; q < 4; ++q) { *(v4u*)(ip + 4 * q) = (v4u){(unsigned)idx[4 * q], (unsigned)idx[4 * q + 1], (unsigned)idx[4 * q + 2], (unsigned)idx[4 * q + 3]};
            *(f32x4*)(gp + 4 * q) = (f32x4){sv[4 * q] * inv, sv[4 * q + 1] * inv, sv[4 * q + 2] * inv, sv[4 * q + 3] * inv}; }
    }
    LDS_WAIT(); asm volatile("" ::: "memory");
}
__device__ __forceinline__ void p8_phase(Frame& F) {
    LAS int* lut = (LAS int*)(F.lds + F.wave * (64 * 33 * 4));
    const int gw = F.bid * NWAVES + F.wave, NGW = F.G * NWAVES;
    for (int it = gw; it < (M / 32) * PH; it += NGW) p8_item(F, it >> 3, it & 7, lut);
}

__device__ __forceinline__ void p9_token(Frame& F, int m) {
    const int lane = F.lane;
    unsigned hq[16];
    {
        const bf16* hp = P_XH(F) + (size_t)m * D + 8 * lane;
#pragma unroll
        for (int j = 0; j < 4; ++j) { const v4u r = *(const v4u*)(hp + 512 * j); hq[4 * j] = r.x; hq[4 * j + 1] = r.y; hq[4 * j + 2] = r.z; hq[4 * j + 3] = r.w; }
    }
    const int ix0 = P_IDX(F)[(size_t)m * 128 + lane], ix1 = P_IDX(F)[(size_t)m * 128 + 64 + lane];
    const float gw0 = P_GW(F)[(size_t)m * 128 + lane], gw1 = P_GW(F)[(size_t)m * 128 + 64 + lane];
    float acc[32];
#pragma unroll
    for (int e = 0; e < 32; ++e) acc[e] = 0.f;
    for (int g = 0; g < 32; ++g) {
        int id[4]; float gg[4];
#pragma unroll
        for (int k = 0; k < 4; ++k) { const int pk = 4 * g + k;
            id[k] = (pk < 64) ? __builtin_amdgcn_readlane(ix0, pk & 63) : __builtin_amdgcn_readlane(ix1, pk & 63);
            gg[k] = __builtin_bit_cast(float, (pk < 64) ? __builtin_amdgcn_readlane(__builtin_bit_cast(int, gw0), pk & 63) : __builtin_amdgcn_readlane(__builtin_bit_cast(int, gw1), pk & 63)); }
        v4u ur[4][4], vr[4][4];
#pragma unroll
        for (int k = 0; k < 4; ++k) { const bf16* up = P_U(F) + (size_t)id[k] * D + 8 * lane; const bf16* vp = P_V(F) + (size_t)id[k] * D + 8 * lane;
#pragma unroll
            for (int j = 0; j < 4; ++j) { ur[k][j] = *(const v4u*)(up + 512 * j); vr[k][j] = *(const v4u*)(vp + 512 * j); } }
        float w[4];
#pragma unroll
        for (int k = 0; k < 4; ++k) { float d0 = 0.f, d1 = 0.f, d2 = 0.f, d3 = 0.f;
#pragma unroll
            for (int j = 0; j < 4; ++j) { d0 = dot2bf(ur[k][j].x, hq[4 * j], d0); d1 = dot2bf(ur[k][j].y, hq[4 * j + 1], d1); d2 = dot2bf(ur[k][j].z, hq[4 * j + 2], d2); d3 = dot2bf(ur[k][j].w, hq[4 * j + 3], d3); }
            const float a = wave_sum((d0 + d1) + (d2 + d3));
            w[k] = gg[k] * gelu_tanh(a); }
#pragma unroll
        for (int k = 0; k < 4; ++k) { const unsigned wb = f2bf(w[k]); const unsigned wlo = wb, whi = wb << 16;
#pragma unroll
            for (int j = 0; j < 4; ++j) { const unsigned q[4] = {vr[k][j].x, vr[k][j].y, vr[k][j].z, vr[k][j].w};
#pragma unroll
                for (int e = 0; e < 4; ++e) { acc[8 * j + 2 * e] = dot2bf(q[e], wlo, acc[8 * j + 2 * e]); acc[8 * j + 2 * e + 1] = dot2bf(q[e], whi, acc[8 * j + 2 * e + 1]); } } }
    }
    const int b = m / SEQ; const float* g2 = P_ADA(F) + (size_t)b * ADA_W + 5 * D;
    float* op = P_out(F) + (size_t)m * D + 8 * lane;
#pragma unroll
    for (int j = 0; j < 4; ++j)
#pragma unroll
        for (int q = 0; q < 2; ++q) { const f32x4 x1 = *(const f32x4*)(op + 512 * j + 4 * q); const f32x4 gv = *(const f32x4*)(g2 + 8 * lane + 512 * j + 4 * q);
            const f32x4 a = {acc[8 * j + 4 * q], acc[8 * j + 4 * q + 1], acc[8 * j + 4 * q + 2], acc[8 * j + 4 * q + 3]};
            *(f32x4*)(op + 512 * j + 4 * q) = x1 + gv * a; }
}
__device__ __forceinline__ void p9_phase(Frame& F) {
    const int gw = F.bid * NWAVES + F.wave, NGW = F.G * NWAVES;
    for (int m = gw; m < M; m += NGW) p9_token(F, m);
}

struct Args { const void* in[25]; float* out; unsigned char* ws; int ph_lo, ph_hi; };
__global__ void __launch_bounds__(NWAVES * 64, 2) hymba_fwd(Args args) {
    extern __shared__ __attribute__((aligned(16))) unsigned char lds_raw[];
    Frame F;
    F.lds = (LAS unsigned char*)lds_raw;
    F.tid = threadIdx.x; F.lane = F.tid & 63; F.wave = __builtin_amdgcn_readfirstlane(F.tid >> 6);
    F.G = gridDim.x; F.bid = blockIdx.x;
    F.ka = (kaptr_t)__builtin_amdgcn_kernarg_segment_ptr();
    static_assert(sizeof(Args) == 224, "kernarg byte offsets used by ka_ptr");
    for (int u = F.tid; u < (LDS_BYTES - LDSCTL_OFF) / 4; u += NWAVES * 64) ((LAS unsigned*)(F.lds + LDSCTL_OFF))[u] = 0u;
    __syncthreads();
    volatile LAS unsigned* MISC = (volatile LAS unsigned*)(F.lds + MISC_OFF);
    XcdBarrier bar; bar.bar = (unsigned*)(P_ws(F) + WS_CTL) + CW_BAR; bar.x = 0; bar.st = nullptr;
    const int lo = args.ph_lo, hi = args.ph_hi;
    if (hi - lo > 1) bar = xcd_barrier_post((unsigned*)(P_ws(F) + WS_CTL) + CW_BAR, MISC + 8);
#define IN(k) (lo <= (k) && (k) < hi)
#define SEAM(k) do { if (IN(k) && IN((k) + 1)) xcd_barrier(bar); } while (0)

    if (IN(0)) { p0_prologue(F); } SEAM(0);
    if (IN(1)) { p1_phase(F); } SEAM(1);
    if (IN(2)) {
        pg8::Gemm g{P_XH(F), P_WIN(F), M, MIX_IN, D}; pg8::StaticOrder S; S.init(M, MIX_IN, F.G, F.bid);
        pg8::EpiStoreBf16 E{P_PROJ(F), MIX_IN};
        pg8::gemm_phase<pg8::EpiStoreBf16, pg8::StaticOrder, true, true>(F.lds, g, S, E);
    } SEAM(2);
    if (IN(3)) { p3_phase(F); } SEAM(3);
    if (IN(4)) { p4_phase(F); } SEAM(4);
    if (IN(5)) {
        pg8::Gemm g{P_XH(F), P_WOUT(F), M, D, D}; pg8::StaticOrder S; S.init(M, D, F.G, F.bid);
        pg8::EpiResid E{P_x(F), P_out(F), D, P_ADA(F) + 2 * D, ADA_W, SEQ};
        pg8::gemm_phase<pg8::EpiResid, pg8::StaticOrder, true, true>(F.lds, g, S, E);
    } SEAM(5);
    if (IN(6)) { p6_phase(F); } SEAM(6);
    if (IN(7)) {
        pg8::Gemm g{P_XH(F), P_WQ(F), M, D, D}; pg8::StaticOrder S; S.init(M, D, F.G, F.bid);
        pg8::EpiStoreBf16 E{P_PROJ(F), D};
        pg8::gemm_phase<pg8::EpiStoreBf16, pg8::StaticOrder, true, true>(F.lds, g, S, E);
    } SEAM(7);
    if (IN(8)) { p8_phase(F); } SEAM(8);
    if (IN(9)) { p9_phase(F); }
#undef IN
#undef SEAM
}

extern "C" void kernel_launch(void* const* d_in, const int* in_sizes, int n_in, void* d_out, int out_size, void* d_ws, size_t ws_size, hipStream_t stream) {
    static int grid = 0;
    if (grid == 0) {
        if (n_in != 25 || in_sizes[0] != M * D || out_size != M * D || ws_size < WS_END) {
            fprintf(stderr, "kernel_launch: built for 25 inputs, x/out of %d floats, >= %zu bytes of workspace; got n_in %d, in0 %d, out %d, ws %zu; nothing launched\n", M * D, (size_t)WS_END, n_in, n_in > 0 ? in_sizes[0] : -1, out_size, ws_size);
            grid = -1; return; }
        int dev = 0, cus = 0, per_cu = 0;
        if (hipGetDevice(&dev) != hipSuccess || hipDeviceGetAttribute(&cus, hipDeviceAttributeMultiprocessorCount, dev) != hipSuccess) { fprintf(stderr, "kernel_launch: device query failed\n"); grid = -1; return; }
        if (hipFuncSetAttribute((const void*)hymba_fwd, hipFuncAttributeMaxDynamicSharedMemorySize, LDS_BYTES) != hipSuccess) { fprintf(stderr, "kernel_launch: hipFuncSetAttribute failed\n"); grid = -1; return; }
        if (hipOccupancyMaxActiveBlocksPerMultiprocessor(&per_cu, (const void*)hymba_fwd, NWAVES * 64, LDS_BYTES) != hipSuccess || per_cu < 1) {
            fprintf(stderr, "kernel_launch: occupancy query reports %d workgroups per CU; need 1\n", per_cu); (void)hipGetLastError(); grid = -1; return; }
        grid = cus;
    }
    if (grid < 0) return;
    if (hipMemsetAsync((char*)d_ws + WS_CTL, 0, CTL_ZERO_BYTES, stream) != hipSuccess) { fprintf(stderr, "kernel_launch: memset failed\n"); return; }
    Args a{};
    for (int i = 0; i < 25; ++i) a.in[i] = d_in[i];
    a.out = (float*)d_out; a.ws = (unsigned char*)d_ws;
    if (N_LAUNCHES == 1) {
        a.ph_lo = 0; a.ph_hi = N_PHASES;
        void* kargs[] = {&a};
        const hipError_t le = hipLaunchCooperativeKernel((const void*)hymba_fwd, dim3(grid), dim3(NWAVES * 64), kargs, LDS_BYTES, stream);
        if (le != hipSuccess) fprintf(stderr, "kernel_launch: cooperative launch failed: %s (grid %d)\n", hipGetErrorName(le), grid);
    } else {
        for (int li = 0; li < N_PHASES; ++li) { a.ph_lo = li; a.ph_hi = li + 1;
            hipLaunchKernelGGL(hymba_fwd, dim3(grid), dim3(NWAVES * 64), LDS_BYTES, stream, a);
            const hipError_t le = hipPeekAtLastError();
            if (le != hipSuccess) { fprintf(stderr, "kernel_launch: launch %d failed: %s\n", li, hipGetErrorName(le)); break; } }
    }
}
```

```cpp
#include <hip/hip_runtime.h>
#include <cstdio>
#include <cstdint>
namespace pg8 {
#define PG8_LAS __attribute__((address_space(3)))
typedef unsigned short bf16_t;
typedef short bf16x8 __attribute__((ext_vector_type(8)));
typedef float f32x4 __attribute__((ext_vector_type(4)));
typedef unsigned u32x4 __attribute__((ext_vector_type(4)));
constexpr int BM = 256, BK = 64, HALF = 128, HTB = HALF * BK * 2  , STAGE_BYTES = 8 * HTB, NXCD = 8, WGM = 8;

__host__ __device__ __forceinline__ int lds_byte(int r, int c) { const int st = (r >> 4) * 2 + (c >> 5), rr = r & 15, cc = c & 31, ob = rr * 64 + cc * 2; return st * 1024 + (ob ^ (((ob >> 9) & 1) << 5)); }
__host__ __device__ __forceinline__ void stage_rc(int b, int& R, int& C) { const int st = b / 1024, sb = b % 1024, swz = sb ^ (((sb >> 9) & 1) << 5); R = (st >> 1) * 16 + swz / 64; C = (st & 1) * 32 + (swz % 64) / 2; }
__host__ __device__ __forceinline__ int perm32(int rho) { const int n = rho >> 4, i = rho & 15; return 8 * (i >> 2) + 4 * n + (i & 3); }

struct Unit { int pm, pn; };
struct Gemm { const bf16_t* A; const bf16_t* Bt; int M, N, K; };

struct StaticOrder {
    int nM, nN, nwg, G, c;
    __host__ __device__ void init(int M, int N, int G_, int c_) { nM = M / BM; nN = N / BM; nwg = nM * nN; G = G_; c = c_; }
    __host__ __device__ bool next(int i, Unit& u) const {
        const long L = (long)i * G + c; if (L >= nwg) return false;
        int wgid = (int)L; { const int q = nwg / NXCD, r = nwg % NXCD, xcd = wgid % NXCD, off = wgid / NXCD; wgid = (xcd < r ? xcd * (q + 1) : r * (q + 1) + (xcd - r) * q) + off; }
        const int nig = WGM * nN, gid = wgid / nig, fm = gid * WGM, gsz = (nM - fm) < WGM ? (nM - fm) : WGM;
        u.pm = fm + ((wgid % nig) % gsz); u.pn = (wgid % nig) / gsz; return true;
    }
    __device__ __forceinline__ void a_ready(const Unit&) const {}
    __device__ __forceinline__ void done(const Unit&) const {}
};

__device__ __forceinline__ unsigned cvt_pk_bf16(float lo, float hi) { unsigned r; asm volatile("v_cvt_pk_bf16_f32 %0, %1, %2" : "=v"(r) : "v"(lo), "v"(hi)); return r; }
struct EpiStoreBf16 {
    static constexpr bool PERM = true, AFTER_DRAIN = false;
    bf16_t* O; int ldc;
    __device__ __forceinline__ void operator()(const f32x4 (&acc)[2][2][4][2], const Unit& u, int wr, int wc, int fr, int fq) const {
        const int row0 = u.pm * BM + wr * 64 + fr; const int col0 = u.pn * BM + wc * 32 + 8 * fq;
#pragma unroll
        for (int ai = 0; ai < 2; ++ai)
#pragma unroll
            for (int m = 0; m < 4; ++m) { bf16_t* rowp = O + (size_t)(row0 + ai * HALF + m * 16) * ldc + col0;
#pragma unroll
                for (int bj = 0; bj < 2; ++bj) { const f32x4 v0 = acc[ai][bj][m][0], v1 = acc[ai][bj][m][1];
                    u32x4 w; w.x = cvt_pk_bf16(v0[0], v0[1]); w.y = cvt_pk_bf16(v0[2], v0[3]); w.z = cvt_pk_bf16(v1[0], v1[1]); w.w = cvt_pk_bf16(v1[2], v1[3]);
                    *(u32x4*)(rowp + bj * HALF) = w; } }
    }
};
struct EpiResid {
    static constexpr bool PERM = false, AFTER_DRAIN = false;
    const float* base; float* out; int ldc; const float* gate; int gstride; int rows_per_batch;
    __device__ __forceinline__ void operator()(const f32x4 (&acc)[2][2][4][2], const Unit& u, int wr, int wc, int fr, int fq) const {
        const int b = (u.pm * BM) / rows_per_batch; const float* g = gate + (size_t)b * gstride;
        const int col0 = u.pn * BM + wc * 32 + 4 * fq;
        f32x4 gv[2][2];
#pragma unroll
        for (int bj = 0; bj < 2; ++bj)
#pragma unroll
            for (int n = 0; n < 2; ++n) gv[bj][n] = *(const f32x4*)(g + col0 + bj * HALF + n * 16);
#pragma unroll
        for (int ai = 0; ai < 2; ++ai)
#pragma unroll
            for (int m = 0; m < 4; ++m) { const size_t off = (size_t)(u.pm * BM + ai * HALF + wr * 64 + m * 16 + fr) * ldc + col0;
#pragma unroll
                for (int bj = 0; bj < 2; ++bj)
#pragma unroll
                    for (int n = 0; n < 2; ++n) { const f32x4 bs = *(const f32x4*)(base + off + bj * HALF + n * 16);
                        *(f32x4*)(out + off + bj * HALF + n * 16) = bs + gv[bj][n] * acc[ai][bj][m][n]; }
                if (m & 1) asm volatile("" ::: "memory"); }
    }
};

template <class Epi, class Sched, bool ALIGN_EPI = false, bool SP2 = false>
__device__ __forceinline__ void gemm_phase(PG8_LAS unsigned char* lds, const Gemm g, const Sched& S, const Epi& E) {
    const int tid = threadIdx.x, wid = __builtin_amdgcn_readfirstlane(tid >> 6), lane = tid & 63, wr = wid >> 2, wc = wid & 3, fr = lane & 15, fq = lane >> 4;
    const int K = g.K, nt = K / BK;
    unsigned voffA[2], voffB[2];
#pragma unroll
    for (int i = 0; i < 2; ++i) { int R, C; stage_rc(tid * 16 + i * 8192, R, C); const int Rb = Epi::PERM ? ((R & ~31) + perm32(R & 31)) : R;
        voffA[i] = (unsigned)(R * K + C) * 2u; voffB[i] = (unsigned)(Rb * K + C) * 2u; }
    const size_t kstep = (size_t)(BK * 2);
    const size_t hstep = (size_t)HALF * K * 2;
    const size_t tstep = 2 * hstep;
    const unsigned ldsw = (unsigned)wid * 1024u;
    const int aoff = lds_byte(wr * 64 + fr, fq * 8), boff = lds_byte(wc * 32 + fr, fq * 8);
#define PG8_SA(b, h) (((b) * 2 + (h)) * HTB)
#define PG8_SB(b, h) ((4 + (b) * 2 + (h)) * HTB)
#define PG8_STAGE(bufoff, gbase, voff) do { _Pragma("unroll") for (int _i = 0; _i < 2; ++_i) \
        __builtin_amdgcn_global_load_lds((const unsigned*)((const char*)(gbase) + (voff)[_i]), (PG8_LAS unsigned*)(lds + (bufoff) + ldsw + _i * 8192), 16, 0, 0); } while (0)
#define PG8_LDA(dst, b, h) do { _Pragma("unroll") for (int m = 0; m < 4; ++m) _Pragma("unroll") for (int k = 0; k < 2; ++k) dst[m][k] = *(const PG8_LAS bf16x8*)(lds + PG8_SA(b, h) + aoff + m * 2048 + k * 1024); } while (0)
#define PG8_LDB(dst, b, h) do { _Pragma("unroll") for (int n = 0; n < 2; ++n) _Pragma("unroll") for (int k = 0; k < 2; ++k) dst[n][k] = *(const PG8_LAS bf16x8*)(lds + PG8_SB(b, h) + boff + n * 2048 + k * 1024); } while (0)
#define PG8_MMA(ai, bj, At, Bt) do { __builtin_amdgcn_s_setprio(1); _Pragma("unroll") for (int m = 0; m < 4; ++m) _Pragma("unroll") for (int n = 0; n < 2; ++n) _Pragma("unroll") for (int k = 0; k < 2; ++k) \
        acc[ai][bj][m][n] = __builtin_amdgcn_mfma_f32_16x16x32_bf16(Bt[n][k], At[m][k], acc[ai][bj][m][n], 0, 0, 0); __builtin_amdgcn_s_setprio(0); } while (0)
#define PG8_WAIT_V(n) asm volatile("s_waitcnt vmcnt(" #n ")" ::: "memory")
#define PG8_WAIT_L(n) asm volatile("s_waitcnt lgkmcnt(" #n ")" ::: "memory")
#define PG8_BAR __builtin_amdgcn_s_barrier()
#define PG8_SCHED __builtin_amdgcn_sched_barrier(0)
    Unit cur, nxt; int ui = 0;
    if (!S.next(0, cur)) return;
    f32x4 acc[2][2][4][2];
#pragma unroll
    for (int a = 0; a < 2; ++a)
#pragma unroll
        for (int b = 0; b < 2; ++b)
#pragma unroll
            for (int m = 0; m < 4; ++m)
#pragma unroll
                for (int n = 0; n < 2; ++n) acc[a][b][m][n] = (f32x4){0.f, 0.f, 0.f, 0.f};
    bf16x8 At[4][2], B0[2][2], B1[2][2];
    const char* cA = (const char*)g.A + (size_t)cur.pm * tstep; const char* cB = (const char*)g.Bt + (size_t)cur.pn * tstep;
    S.a_ready(cur);
    if constexpr (SP2) {
        PG8_STAGE(PG8_SB(0, 0), cB, voffB); PG8_STAGE(PG8_SB(0, 1), cB + hstep, voffB); PG8_STAGE(PG8_SA(0, 0), cA, voffA); PG8_STAGE(PG8_SA(0, 1), cA + hstep, voffA);
        if (wr == 1) PG8_BAR;
        PG8_WAIT_V(2); PG8_BAR;
        PG8_STAGE(PG8_SB(1, 0), cB + kstep, voffB); PG8_STAGE(PG8_SA(1, 0), cA + kstep, voffA); PG8_STAGE(PG8_SB(1, 1), cB + hstep + kstep, voffB);
        PG8_WAIT_V(6); PG8_BAR;
    } else {
        PG8_STAGE(PG8_SB(0, 0), cB, voffB); PG8_STAGE(PG8_SA(0, 0), cA, voffA); PG8_STAGE(PG8_SB(0, 1), cB + hstep, voffB); PG8_STAGE(PG8_SA(0, 1), cA + hstep, voffA);
        if (wr == 1) PG8_BAR;
        PG8_WAIT_V(4); PG8_BAR;
        PG8_STAGE(PG8_SB(1, 0), cB + kstep, voffB); PG8_STAGE(PG8_SA(1, 0), cA + kstep, voffA); PG8_STAGE(PG8_SB(1, 1), cB + hstep + kstep, voffB);
        PG8_WAIT_V(6); PG8_BAR;
    }
    for (;;) {
        const bool has_next = S.next(ui + 1, nxt);
        const char* nA = has_next ? (const char*)g.A + (size_t)nxt.pm * tstep : cA; const char* nB = has_next ? (const char*)g.Bt + (size_t)nxt.pn * tstep : cB;
        for (int t = 0; t < nt; t += 2) {
            const bool last = (t == nt - 2);
            const char* a1 = cA + (size_t)(t + 1) * kstep;
            const char* a2 = last ? nA : cA + (size_t)(t + 2) * kstep; const char* b2 = last ? nB : cB + (size_t)(t + 2) * kstep;
            const char* a3 = a2 + kstep; const char* b3 = b2 + kstep;
            if (last && has_next) S.a_ready(nxt);
            if constexpr (SP2) {
            PG8_LDB(B0, 0, 0); PG8_LDB(B1, 0, 1); PG8_SCHED; PG8_LDA(At, 0, 0); PG8_STAGE(PG8_SA(1, 1), a1 + hstep, voffA);
            PG8_WAIT_V(8); PG8_WAIT_L(0); PG8_BAR; PG8_MMA(0, 0, At, B0); PG8_MMA(0, 1, At, B1); PG8_BAR; PG8_SCHED;
            PG8_LDA(At, 0, 1); PG8_STAGE(PG8_SB(0, 0), b2, voffB); PG8_STAGE(PG8_SB(0, 1), b2 + hstep, voffB); PG8_STAGE(PG8_SA(0, 0), a2, voffA);
            PG8_WAIT_V(8); PG8_WAIT_L(0); PG8_BAR; PG8_MMA(1, 0, At, B0); PG8_MMA(1, 1, At, B1); PG8_BAR; PG8_SCHED;
            PG8_LDB(B0, 1, 0); PG8_LDB(B1, 1, 1); PG8_SCHED; PG8_LDA(At, 1, 0); PG8_STAGE(PG8_SA(0, 1), a2 + hstep, voffA);
            PG8_WAIT_V(8); PG8_WAIT_L(0); PG8_BAR; PG8_MMA(0, 0, At, B0); PG8_MMA(0, 1, At, B1); PG8_BAR; PG8_SCHED;
            PG8_LDA(At, 1, 1); PG8_STAGE(PG8_SB(1, 0), b3, voffB); PG8_STAGE(PG8_SB(1, 1), b3 + hstep, voffB); PG8_STAGE(PG8_SA(1, 0), a3, voffA);
            PG8_WAIT_V(8); PG8_WAIT_L(0); PG8_BAR; PG8_MMA(1, 0, At, B0); PG8_MMA(1, 1, At, B1); PG8_BAR; PG8_SCHED;
            } else {
            PG8_LDB(B0, 0, 0); PG8_SCHED; PG8_LDA(At, 0, 0); PG8_STAGE(PG8_SA(1, 1), a1 + hstep, voffA);
            PG8_WAIT_L(8); PG8_BAR; PG8_WAIT_L(0); PG8_MMA(0, 0, At, B0); PG8_BAR; PG8_SCHED;
            PG8_LDB(B1, 0, 1); PG8_STAGE(PG8_SB(0, 0), b2, voffB);
            PG8_BAR; PG8_WAIT_L(0); PG8_MMA(0, 1, At, B1); PG8_BAR;
            PG8_LDA(At, 0, 1); PG8_STAGE(PG8_SA(0, 0), a2, voffA);
            PG8_BAR; PG8_WAIT_L(0); PG8_MMA(1, 0, At, B0); PG8_BAR; PG8_SCHED;
            PG8_STAGE(PG8_SB(0, 1), b2 + hstep, voffB);
            PG8_WAIT_V(6); PG8_BAR; PG8_MMA(1, 1, At, B1); PG8_BAR;
            PG8_LDB(B0, 1, 0); PG8_SCHED; PG8_LDA(At, 1, 0); PG8_STAGE(PG8_SA(0, 1), a2 + hstep, voffA);
            PG8_WAIT_L(8); PG8_BAR; PG8_WAIT_L(0); PG8_MMA(0, 0, At, B0); PG8_BAR; PG8_SCHED;
            PG8_LDB(B1, 1, 1); PG8_STAGE(PG8_SB(1, 0), b3, voffB);
            PG8_BAR; PG8_WAIT_L(0); PG8_MMA(0, 1, At, B1); PG8_BAR;
            PG8_LDA(At, 1, 1); PG8_STAGE(PG8_SA(1, 0), a3, voffA);
            PG8_BAR; PG8_WAIT_L(0); PG8_MMA(1, 0, At, B0); PG8_BAR; PG8_SCHED;
            PG8_STAGE(PG8_SB(1, 1), b3 + hstep, voffB);
            PG8_WAIT_V(6); PG8_BAR; PG8_MMA(1, 1, At, B1); PG8_BAR;
            }
        }
        if constexpr (ALIGN_EPI) { if (wr == 0) PG8_BAR; }
        if constexpr (!Epi::AFTER_DRAIN) { E(acc, cur, wr, wc, fr, fq); S.done(cur); }
        if (!has_next) break;
#pragma unroll
        for (int a = 0; a < 2; ++a)
#pragma unroll
            for (int b = 0; b < 2; ++b)
#pragma unroll
                for (int m = 0; m < 4; ++m)
#pragma unroll
                    for (int n = 0; n < 2; ++n) acc[a][b][m][n] = (f32x4){0.f, 0.f, 0.f, 0.f};
        cur = nxt; cA = nA; cB = nB; ++ui;
        if constexpr (ALIGN_EPI) { if (wr == 1) PG8_BAR; }
    }
    PG8_WAIT_V(0);
    if constexpr (!ALIGN_EPI) { if (wr == 0) PG8_BAR; }
    PG8_BAR;
    if constexpr (Epi::AFTER_DRAIN) { E.fused(acc, cur, wr, wc, fr, fq, lds, wid, lane); S.done(cur); }
#undef PG8_SA
#undef PG8_SB
#undef PG8_STAGE
#undef PG8_LDA
#undef PG8_LDB
#undef PG8_MMA
#undef PG8_WAIT_V
#undef PG8_WAIT_L
#undef PG8_BAR
#undef PG8_SCHED
}
}

constexpr int NWAVES = 8;
#ifndef MK_N_LAUNCHES
#define MK_N_LAUNCHES 1
#endif
constexpr int N_PHASES = 10;
constexpr int N_LAUNCHES = MK_N_LAUNCHES;

constexpr int BATCH = 4, SEQ = 4096, D = 2048, M = BATCH * SEQ;
constexpr int LRU_W = 1024, LRU_HEADS = 8, LRU_BLK = 128;
constexpr int HD = 64, HQ = 16, HKV = 2, GRP = 8;
constexpr int MIX_IN = 3328;
constexpr int C_Y = 1024, C_Q = 2048, C_K = 3072, C_V = 3200;
constexpr int ADA_W = 6 * D;
constexpr int PH = 8, PKEYS = 128, PHALF = 128, PTOPK = 16, NEXP = 16384;
constexpr float EPS = 1e-6f;

constexpr size_t MiB = 1u << 20;
constexpr size_t WS_CTL = 0, CTL_ZERO_BYTES = 1 * MiB;
constexpr size_t WS_ADA = 1 * MiB;
constexpr size_t WS_ROPE = 2 * MiB;
constexpr size_t WS_WIN = 4 * MiB;
constexpr size_t WS_WOUT = 17 * MiB;
constexpr size_t WS_WQ = 25 * MiB;
constexpr size_t WS_WGA = 33 * MiB;
constexpr size_t WS_WGX = 33 * MiB + 256 * 1024;
constexpr size_t WS_SK = 33 * MiB + 512 * 1024;
constexpr size_t WS_IDX = 34 * MiB;
constexpr size_t WS_GW = 42 * MiB;
constexpr size_t WS_U = 50 * MiB;
constexpr size_t WS_V = 114 * MiB;
constexpr size_t WS_XH = 178 * MiB;
constexpr size_t WS_PROJ = 242 * MiB;
constexpr size_t WS_HL = 346 * MiB;
constexpr size_t WS_PA = 410 * MiB;
constexpr size_t WS_END = 474 * MiB;
constexpr int CW_BAR = 4096;

constexpr int RING_BYTES = 131072;
constexpr int LDSCTL_OFF = RING_BYTES, MISC_OFF = LDSCTL_OFF + 320;
constexpr int LDS_BYTES = 147456;

#define GAS __attribute__((address_space(1)))
#define LAS __attribute__((address_space(3)))
typedef unsigned short bf16;
typedef unsigned v4u __attribute__((ext_vector_type(4)));
typedef unsigned v2u __attribute__((ext_vector_type(2)));
typedef float f32x4 __attribute__((ext_vector_type(4)));
typedef float f32x2 __attribute__((ext_vector_type(2)));
typedef float f32x16 __attribute__((ext_vector_type(16)));
typedef short bf16x8 __attribute__((ext_vector_type(8)));
typedef __bf16 bf16x2v __attribute__((ext_vector_type(2)));
#define LDS_WAIT() asm volatile("s_waitcnt lgkmcnt(0)" ::: "memory")
#define VM_WAIT() asm volatile("s_waitcnt vmcnt(0)" ::: "memory")
__device__ __forceinline__ unsigned f2bf(float f) { unsigned u = __builtin_bit_cast(unsigned, f); return (u + 0x7fffu + ((u >> 16) & 1u)) >> 16; }
__device__ __forceinline__ unsigned pk2(float lo, float hi) { return f2bf(lo) | (f2bf(hi) << 16); }
__device__ __forceinline__ float bflo(unsigned u) { return __builtin_bit_cast(float, u << 16); }
__device__ __forceinline__ float bfhi(unsigned u) { return __builtin_bit_cast(float, u & 0xffff0000u); }
__device__ __forceinline__ float bf1(bf16 h) { return __builtin_bit_cast(float, (unsigned)h << 16); }
__device__ __forceinline__ float dot2bf(unsigned a, unsigned b, float acc) { return __builtin_amdgcn_fdot2_f32_bf16(__builtin_bit_cast(bf16x2v, a), __builtin_bit_cast(bf16x2v, b), acc, false); }
__device__ __forceinline__ float sigmoidf_(float x) { return 1.0f / (1.0f + __expf(-x)); }
__device__ __forceinline__ float gelu_tanh(float x) {
    const float z = 1.5957691216057308f * (x + 0.044715f * x * x * x);
    return x / (1.0f + __expf(-z));
}
__device__ __forceinline__ float wave_sum(float v) {
#pragma unroll
    for (int o = 1; o < 64; o <<= 1) v += __shfl_xor(v, o);
    return v;
}

#define XB_TMO      128
#define XB_XCNT(j)  (256  + 64 * (j))
#define XB_XSUB(j)  (1280 + 64 * (j))
#define XB_XGEN(j)  (2304 + 64 * (j))
#define XB_TOP      3328
#define XB_TOPGEN   3392
#define XCD_BAR_WORDS 3456
#define XB_SPIN_CAP (1u << 18)
__device__ __forceinline__ unsigned xb_ld(unsigned* p)              { return __hip_atomic_load(p, __ATOMIC_RELAXED, __HIP_MEMORY_SCOPE_AGENT); }
__device__ __forceinline__ unsigned xb_add(unsigned* p, unsigned v) { return __hip_atomic_fetch_add(p, v, __ATOMIC_RELAXED, __HIP_MEMORY_SCOPE_AGENT); }
__device__ __forceinline__ unsigned xb_xcc_id() { return (unsigned)__builtin_amdgcn_s_getreg((3 << 11) | 20) & 0xFu; }
#define XB_SPIN(cond, bar) do { unsigned _sp = 0; while (cond) { __builtin_amdgcn_s_sleep(1); \
    if ((++_sp & 255u) == 0u) { if (xb_ld(&(bar)[XB_TMO])) break; if (_sp > XB_SPIN_CAP) { atomicAdd(&(bar)[XB_TMO], 1u); break; } } } } while (0)
struct XcdBarrier { unsigned* bar; unsigned x; volatile LAS unsigned* st; };
__device__ __forceinline__ XcdBarrier xcd_barrier_post(unsigned* bar, volatile LAS unsigned* st) {
    XcdBarrier b; b.bar = bar; b.x = xb_xcc_id(); b.st = st;
    if (threadIdx.x == 0) (void)xb_add(&bar[XB_XCNT(b.x)], 1u);
    return b;
}
__device__ __forceinline__ void xcd_barrier_complete(unsigned* bar, unsigned x, unsigned& nloc, unsigned& nx) {
    const unsigned G = gridDim.x * gridDim.y * gridDim.z;
    unsigned sum, cnt, mine, sp = 0u;
    for (;;) {
        sum = 0u; cnt = 0u; mine = 0u;
#pragma unroll
        for (unsigned j = 0; j < 16; ++j) { const unsigned c = xb_ld(&bar[XB_XCNT(j)]); sum += c; cnt += (c > 0u) ? 1u : 0u; mine = (j == x) ? c : mine; }
        if (sum == G) break;
        __builtin_amdgcn_s_sleep(1);
        if ((++sp & 255u) == 0u) { if (xb_ld(&bar[XB_TMO])) break; if (sp > XB_SPIN_CAP) { atomicAdd(&bar[XB_TMO], 1u); break; } }
    }
    nloc = mine > 0u ? mine : 1u; nx = cnt > 0u ? cnt : 1u;
}
__device__ __forceinline__ void xcd_barrier(const XcdBarrier& b) {
    asm volatile("s_waitcnt vmcnt(0)" ::: "memory");
    __syncthreads();
    if (threadIdx.x == 0) {
        unsigned* bar = b.bar;
        __builtin_amdgcn_s_waitcnt(0);
        unsigned nloc = b.st[0], nx = b.st[1];
        if (nloc == 0u) { xcd_barrier_complete(bar, b.x, nloc, nx); b.st[0] = nloc; b.st[1] = nx; }
        const unsigned old = xb_add(&bar[XB_XSUB(b.x)], 1u);
        const unsigned gen = old / nloc;
        if (old + 1u == (gen + 1u) * nloc) {
            __builtin_amdgcn_fence(__ATOMIC_RELEASE, "agent");
            asm volatile("s_waitcnt vmcnt(0)" ::: "memory");
            const unsigned og = xb_add(&bar[XB_TOP], 1u);
            const unsigned tg = og / nx;
            if (og + 1u == (tg + 1u) * nx) xb_add(&bar[XB_TOPGEN], 1u);
            else XB_SPIN(xb_ld(&bar[XB_TOPGEN]) == tg, bar);
            __builtin_amdgcn_fence(__ATOMIC_ACQUIRE, "agent");
            xb_add(&bar[XB_XGEN(b.x)], 1u);
            asm volatile("s_waitcnt vmcnt(0)" ::: "memory");
        } else {
            XB_SPIN(xb_ld(&bar[XB_XGEN(b.x)]) == gen, bar);
            __builtin_amdgcn_fence(__ATOMIC_ACQUIRE, "agent");
            asm volatile("s_waitcnt vmcnt(0)" ::: "memory");
        }
    }
    __syncthreads();
}

typedef const __attribute__((address_space(4))) unsigned char* kaptr_t;
struct Frame { LAS unsigned char* lds; int tid, lane, wave, G, bid; kaptr_t ka; };
template <class T> __device__ __forceinline__ T* ka_ptr(const Frame& F, int byte_off) { typedef T* tp; return *(const __attribute__((address_space(4))) tp*)(F.ka + byte_off); }
__device__ __forceinline__ const float* P_x(const Frame& F) { return ka_ptr<const float>(F, 0); }
__device__ __forceinline__ const float* P_c(const Frame& F) { return ka_ptr<const float>(F, 8); }
__device__ __forceinline__ const int* P_pos(const Frame& F) { return ka_ptr<const int>(F, 16); }
__device__ __forceinline__ const float* P_w_ada(const Frame& F) { return ka_ptr<const float>(F, 24); }
__device__ __forceinline__ const float* P_b_ada(const Frame& F) { return ka_ptr<const float>(F, 32); }
__device__ __forceinline__ const float* P_norm1_g(const Frame& F) { return ka_ptr<const float>(F, 40); }
__device__ __forceinline__ const float* P_w_in(const Frame& F) { return ka_ptr<const float>(F, 48); }
__device__ __forceinline__ const float* P_conv_w(const Frame& F) { return ka_ptr<const float>(F, 56); }
__device__ __forceinline__ const float* P_conv_b(const Frame& F) { return ka_ptr<const float>(F, 64); }
__device__ __forceinline__ const float* P_ga_w(const Frame& F) { return ka_ptr<const float>(F, 72); }
__device__ __forceinline__ const float* P_ga_b(const Frame& F) { return ka_ptr<const float>(F, 80); }
__device__ __forceinline__ const float* P_gx_w(const Frame& F) { return ka_ptr<const float>(F, 88); }
__device__ __forceinline__ const float* P_gx_b(const Frame& F) { return ka_ptr<const float>(F, 96); }
__device__ __forceinline__ const float* P_lam(const Frame& F) { return ka_ptr<const float>(F, 104); }
__device__ __forceinline__ const float* P_qn_g(const Frame& F) { return ka_ptr<const float>(F, 112); }
__device__ __forceinline__ const float* P_kn_g(const Frame& F) { return ka_ptr<const float>(F, 120); }
__device__ __forceinline__ const float* P_sinks(const Frame& F) { return ka_ptr<const float>(F, 128); }
__device__ __forceinline__ const float* P_on_lru_g(const Frame& F) { return ka_ptr<const float>(F, 136); }
__device__ __forceinline__ const float* P_on_attn_g(const Frame& F) { return ka_ptr<const float>(F, 144); }
__device__ __forceinline__ const float* P_w_out(const Frame& F) { return ka_ptr<const float>(F, 152); }
__device__ __forceinline__ const float* P_norm2_g(const Frame& F) { return ka_ptr<const float>(F, 160); }
__device__ __forceinline__ const float* P_w_pq(const Frame& F) { return ka_ptr<const float>(F, 168); }
__device__ __forceinline__ const float* P_sub_keys(const Frame& F) { return ka_ptr<const float>(F, 176); }
__device__ __forceinline__ const float* P_pu(const Frame& F) { return ka_ptr<const float>(F, 184); }
__device__ __forceinline__ const float* P_pv(const Frame& F) { return ka_ptr<const float>(F, 192); }
__device__ __forceinline__ float* P_out(const Frame& F) { return ka_ptr<float>(F, 200); }
__device__ __forceinline__ unsigned char* P_ws(const Frame& F) { return ka_ptr<unsigned char>(F, 208); }
__device__ __forceinline__ float* P_ADA(const Frame& F) { return (float*)(P_ws(F) + WS_ADA); }
__device__ __forceinline__ float* P_ROPE(const Frame& F) { return (float*)(P_ws(F) + WS_ROPE); }
__device__ __forceinline__ float* P_HL(const Frame& F) { return (float*)(P_ws(F) + WS_HL); }
__device__ __forceinline__ float* P_PA(const Frame& F) { return (float*)(P_ws(F) + WS_PA); }
__device__ __forceinline__ float* P_GW(const Frame& F) { return (float*)(P_ws(F) + WS_GW); }
__device__ __forceinline__ int* P_IDX(const Frame& F) { return (int*)(P_ws(F) + WS_IDX); }
__device__ __forceinline__ bf16* P_WIN(const Frame& F) { return (bf16*)(P_ws(F) + WS_WIN); }
__device__ __forceinline__ bf16* P_WOUT(const Frame& F) { return (bf16*)(P_ws(F) + WS_WOUT); }
__device__ __forceinline__ bf16* P_WQ(const Frame& F) { return (bf16*)(P_ws(F) + WS_WQ); }
__device__ __forceinline__ bf16* P_WGA(const Frame& F) { return (bf16*)(P_ws(F) + WS_WGA); }
__device__ __forceinline__ bf16* P_WGX(const Frame& F) { return (bf16*)(P_ws(F) + WS_WGX); }
__device__ __forceinline__ bf16* P_SK(const Frame& F) { return (bf16*)(P_ws(F) + WS_SK); }
__device__ __forceinline__ bf16* P_U(const Frame& F) { return (bf16*)(P_ws(F) + WS_U); }
__device__ __forceinline__ bf16* P_V(const Frame& F) { return (bf16*)(P_ws(F) + WS_V); }
__device__ __forceinline__ bf16* P_XH(const Frame& F) { return (bf16*)(P_ws(F) + WS_XH); }
__device__ __forceinline__ bf16* P_PROJ(const Frame& F) { return (bf16*)(P_ws(F) + WS_PROJ); }

__device__ __forceinline__ void p0_transpose_item(const float* W, int K, int N, bf16* WT, LAS float* scr, int item, int lane) {
    const int nblk = N / 32, kb = item / nblk, nb = item % nblk, k0 = 64 * kb, n0 = 32 * nb;
#pragma unroll 8
    for (int i = 0; i < 32; ++i) { const int kk = 2 * i + (lane >> 5); scr[kk * 33 + (lane & 31)] = W[(size_t)(k0 + kk) * N + n0 + (lane & 31)]; }
    LDS_WAIT(); asm volatile("" ::: "memory");
    const int c = lane & 7;
#pragma unroll
    for (int j = 0; j < 4; ++j) { const int n = (lane >> 3) + 8 * j; const LAS float* s = scr + (8 * c) * 33 + n;
        v4u o; o.x = pk2(s[0 * 33], s[1 * 33]); o.y = pk2(s[2 * 33], s[3 * 33]); o.z = pk2(s[4 * 33], s[5 * 33]); o.w = pk2(s[6 * 33], s[7 * 33]);
        *(v4u*)(WT + (size_t)(n0 + n) * K + k0 + 8 * c) = o; }
    LDS_WAIT(); asm volatile("" ::: "memory");
}
__device__ __forceinline__ void p0_convert(const float* src, bf16* dst, size_t n8, size_t gtid, size_t gthreads) {
    for (size_t i = gtid; i < n8; i += gthreads) {
        const f32x4 a = *(const f32x4*)(src + 8 * i), b = *(const f32x4*)(src + 8 * i + 4);
        v4u o; o.x = pk2(a.x, a.y); o.y = pk2(a.z, a.w); o.z = pk2(b.x, b.y); o.w = pk2(b.z, b.w);
        *(v4u*)(dst + 8 * i) = o;
    }
}
__device__ __forceinline__ void p0_prologue(Frame& F) {
    {
        LAS float* sc = (LAS float*)F.lds;
        LAS float* red = sc + 4 * D;
        for (int i = F.tid; i < 4 * D; i += 512) { const float v = P_c(F)[i]; sc[i] = v / (1.0f + __expf(-v)); }
        __syncthreads();
        for (int cg = F.bid; cg < ADA_W / 64; cg += F.G) {
            const int n0 = cg * 64, k0 = F.wave * 256;
            const float* wp = P_w_ada(F) + (size_t)k0 * ADA_W + n0 + F.lane;
            float a0 = 0.f, a1 = 0.f, a2 = 0.f, a3 = 0.f;
#pragma unroll 16
            for (int k = 0; k < 256; ++k) { const float w = wp[(size_t)k * ADA_W]; const int kk = k0 + k;
                a0 += sc[kk] * w; a1 += sc[D + kk] * w; a2 += sc[2 * D + kk] * w; a3 += sc[3 * D + kk] * w; }
            red[(F.wave * 4 + 0) * 64 + F.lane] = a0; red[(F.wave * 4 + 1) * 64 + F.lane] = a1;
            red[(F.wave * 4 + 2) * 64 + F.lane] = a2; red[(F.wave * 4 + 3) * 64 + F.lane] = a3;
            __syncthreads();
            if (F.tid < 256) { const int b = F.tid >> 6, l = F.tid & 63; float s = 0.f;
#pragma unroll
                for (int w = 0; w < 8; ++w) s += red[(w * 4 + b) * 64 + l];
                P_ADA(F)[(size_t)b * ADA_W + n0 + l] = s + P_b_ada(F)[n0 + l]; }
            __syncthreads();
        }
        __syncthreads();
    }
    {
        LAS float* scr = (LAS float*)(F.lds + F.wave * 16384);
        const int gw = F.bid * NWAVES + F.wave, NGW = F.G * NWAVES;
        constexpr int I_IN = (D / 64) * (MIX_IN / 32), I_SQ = (D / 64) * (D / 32), I_G = (LRU_BLK / 64) * (LRU_BLK / 32);
        constexpr int NITEMS = I_IN + 2 * I_SQ + 16 * I_G;
        for (int it = gw; it < NITEMS; it += NGW) {
            int r = it;
            if (r < I_IN) { p0_transpose_item(P_w_in(F), D, MIX_IN, P_WIN(F), scr, r, F.lane); continue; } r -= I_IN;
            if (r < I_SQ) { p0_transpose_item(P_w_out(F), D, D, P_WOUT(F), scr, r, F.lane); continue; } r -= I_SQ;
            if (r < I_SQ) { p0_transpose_item(P_w_pq(F), D, D, P_WQ(F), scr, r, F.lane); continue; } r -= I_SQ;
            const int g = r / I_G, ri = r % I_G, hd = g & 7;
            if (g < 8) p0_transpose_item(P_ga_w(F) + (size_t)hd * 16384, LRU_BLK, LRU_BLK, P_WGA(F) + (size_t)hd * 16384, scr, ri, F.lane);
            else       p0_transpose_item(P_gx_w(F) + (size_t)hd * 16384, LRU_BLK, LRU_BLK, P_WGX(F) + (size_t)hd * 16384, scr, ri, F.lane);
        }
    }
    {
        const size_t gtid = (size_t)F.bid * 512 + F.tid, gth = (size_t)F.G * 512;
        p0_convert(P_sub_keys(F), P_SK(F), (size_t)PH * 2 * PKEYS * PHALF / 8, gtid, gth);
        p0_convert(P_pu(F), P_U(F), (size_t)NEXP * D / 8, gtid, gth);
        p0_convert(P_pv(F), P_V(F), (size_t)NEXP * D / 8, gtid, gth);
    }
}

__device__ __forceinline__ void modnorm_row(const float* xrow, const float* gain, const float* shift, const float* scale, bf16* orow, int lane) {
    f32x4 v[8]; float s = 0.f;
#pragma unroll
    for (int j = 0; j < 8; ++j) { v[j] = *(const f32x4*)(xrow + 4 * lane + 256 * j); s += (v[j].x * v[j].x + v[j].y * v[j].y) + (v[j].z * v[j].z + v[j].w * v[j].w); }
    const float rstd = 1.0f / sqrtf(wave_sum(s) * (1.0f / D) + EPS);
#pragma unroll
    for (int j = 0; j < 8; ++j) {
        const int c = 4 * lane + 256 * j;
        const f32x4 g = *(const f32x4*)(gain + c), sh = *(const f32x4*)(shift + c), sc = *(const f32x4*)(scale + c);
        const f32x4 y = (v[j] * rstd) * g * (sc + 1.0f) + sh;
        v2u o; o.x = pk2(y.x, y.y); o.y = pk2(y.z, y.w);
        *(v2u*)(orow + c) = o;
    }
}
__device__ __forceinline__ void p1_phase(Frame& F) {
    const int gw = F.bid * NWAVES + F.wave, NGW = F.G * NWAVES;
    for (int m = gw; m < M; m += NGW) { const int b = m / SEQ; const float* ada = P_ADA(F) + (size_t)b * ADA_W;
        modnorm_row(P_x(F) + (size_t)m * D, P_norm1_g(F), ada, ada + D, P_XH(F) + (size_t)m * D, F.lane); }
    const float invf[8] = {1.0f, 1.9392274e-01f, 3.7606031e-02f, 7.2926646e-03f, 1.4142136e-03f, 2.7424819e-04f, 5.3182961e-05f, 1.0313386e-05f};
    for (int i = F.bid * 512 + F.tid; i < M * 8; i += F.G * 512) { const int m = i >> 3, k = i & 7;
        float f = invf[0];
#pragma unroll
        for (int q = 1; q < 8; ++q) f = (k == q) ? invf[q] : f;
        const float ang = (float)P_pos(F)[m] * f; float sn, cs; sincosf(ang, &sn, &cs);
        P_ROPE(F)[(size_t)m * 16 + k] = cs; P_ROPE(F)[(size_t)m * 16 + 8 + k] = sn; }
}
__device__ __forceinline__ void p6_phase(Frame& F) {
    const int gw = F.bid * NWAVES + F.wave, NGW = F.G * NWAVES;
    for (int m = gw; m < M; m += NGW) { const int b = m / SEQ; const float* ada = P_ADA(F) + (size_t)b * ADA_W;
        modnorm_row(P_out(F) + (size_t)m * D, P_norm2_g(F), ada + 3 * D, ada + 4 * D, P_XH(F) + (size_t)m * D, F.lane); }
}

#define MFMA32(a, b, c) __builtin_amdgcn_mfma_f32_32x32x16_bf16((a), (b), (c), 0, 0, 0)
#define MFMA16(a, b, c) __builtin_amdgcn_mfma_f32_16x16x32_bf16((a), (b), (c), 0, 0, 0)
constexpr int KS_STRIDE = 72;
constexpr int VT_STRIDE = 264;
constexpr int ATT_KS_OFF = 0, ATT_VT_OFF = 256 * KS_STRIDE * 2;
static_assert(ATT_VT_OFF + 64 * VT_STRIDE * 2 <= RING_BYTES, "attention LDS");

__device__ __forceinline__ void attn_unit(Frame& F, int b, int g, int n) {
    LAS bf16* Ks = (LAS bf16*)(F.lds + ATT_KS_OFF);
    LAS bf16* VT = (LAS bf16*)(F.lds + ATT_VT_OFF);
    const int tid = F.tid, lane = F.lane;
    {
        const int kb = tid >> 1, hf = tid & 1; const int t = n * 128 - 128 + kb;
        float kv[32]; v4u vraw[4];
        if (t >= 0) {
            const bf16* kp = P_PROJ(F) + (size_t)(b * SEQ + t) * MIX_IN + C_K + g * HD + 32 * hf;
            const bf16* vp = P_PROJ(F) + (size_t)(b * SEQ + t) * MIX_IN + C_V + g * HD + 32 * hf;
#pragma unroll
            for (int q = 0; q < 4; ++q) { const v4u r = *(const v4u*)(kp + 8 * q); vraw[q] = *(const v4u*)(vp + 8 * q);
                kv[8 * q + 0] = bflo(r.x); kv[8 * q + 1] = bfhi(r.x); kv[8 * q + 2] = bflo(r.y); kv[8 * q + 3] = bfhi(r.y);
                kv[8 * q + 4] = bflo(r.z); kv[8 * q + 5] = bfhi(r.z); kv[8 * q + 6] = bflo(r.w); kv[8 * q + 7] = bfhi(r.w); }
        } else {
#pragma unroll
            for (int q = 0; q < 4; ++q) vraw[q] = (v4u){0u, 0u, 0u, 0u};
#pragma unroll
            for (int q = 0; q < 32; ++q) kv[q] = 0.f;
        }
        float ss = 0.f;
#pragma unroll
        for (int q = 0; q < 32; ++q) ss += kv[q] * kv[q];
        ss += __shfl_xor(ss, 1);
        const float rstd = 1.0f / sqrtf(ss * (1.0f / HD) + EPS);
#pragma unroll
        for (int q = 0; q < 32; ++q) kv[q] = kv[q] * rstd * P_kn_g(F)[32 * hf + q];
        if (hf == 0 && t >= 0) {
            const float* rp = P_ROPE(F) + (size_t)(b * SEQ + t) * 16;
#pragma unroll
            for (int i = 0; i < 8; ++i) { const float cs = rp[i], sn = rp[8 + i]; const float x1 = kv[i], x2 = kv[8 + i];
                kv[i] = x1 * cs - x2 * sn; kv[8 + i] = x2 * cs + x1 * sn; }
        }
#pragma unroll
        for (int q = 0; q < 4; ++q) { v4u o; o.x = pk2(kv[8 * q], kv[8 * q + 1]); o.y = pk2(kv[8 * q + 2], kv[8 * q + 3]); o.z = pk2(kv[8 * q + 4], kv[8 * q + 5]); o.w = pk2(kv[8 * q + 6], kv[8 * q + 7]);
            *(LAS v4u*)(Ks + kb * KS_STRIDE + 32 * hf + 8 * q) = o; }
#pragma unroll
        for (int q = 0; q < 4; ++q) { const unsigned w[4] = {vraw[q].x, vraw[q].y, vraw[q].z, vraw[q].w};
#pragma unroll
            for (int e = 0; e < 4; ++e) { const int d = 32 * hf + 8 * q + 2 * e;
                VT[d * VT_STRIDE + kb] = (bf16)(w[e] & 0xffffu); VT[(d + 1) * VT_STRIDE + kb] = (bf16)(w[e] >> 16); } }
    }
    __syncthreads();
    const int hq = g * GRP + F.wave, r = lane & 31, hh = lane >> 5;
    const float sink = P_sinks(F)[hq];
    for (int qi = 0; qi < 4; ++qi) {
        const int tq = n * 128 + 32 * qi + r;
        bf16x8 qf[4];
        {
            const bf16* qp = P_PROJ(F) + (size_t)(b * SEQ + tq) * MIX_IN + C_Q + hq * HD + 8 * hh;
            float qv[4][8]; float ss = 0.f;
#pragma unroll
            for (int ks = 0; ks < 4; ++ks) { const v4u rr = *(const v4u*)(qp + 16 * ks);
                qv[ks][0] = bflo(rr.x); qv[ks][1] = bfhi(rr.x); qv[ks][2] = bflo(rr.y); qv[ks][3] = bfhi(rr.y);
                qv[ks][4] = bflo(rr.z); qv[ks][5] = bfhi(rr.z); qv[ks][6] = bflo(rr.w); qv[ks][7] = bfhi(rr.w);
#pragma unroll
                for (int j = 0; j < 8; ++j) ss += qv[ks][j] * qv[ks][j]; }
            ss += __shfl_xor(ss, 32);
            const float rstd = 1.0f / sqrtf(ss * (1.0f / HD) + EPS);
#pragma unroll
            for (int ks = 0; ks < 4; ++ks)
#pragma unroll
                for (int j = 0; j < 8; ++j) qv[ks][j] = qv[ks][j] * rstd * P_qn_g(F)[16 * ks + 8 * hh + j];
            const float* rp = P_ROPE(F) + (size_t)(b * SEQ + tq) * 16;
#pragma unroll
            for (int j = 0; j < 8; ++j) { const float mine = qv[0][j], other = __shfl_xor(mine, 32); const float cs = rp[j], sn = rp[8 + j];
                qv[0][j] = hh == 0 ? (mine * cs - other * sn) : (mine * cs + other * sn); }
#pragma unroll
            for (int ks = 0; ks < 4; ++ks) { v4u o; o.x = pk2(qv[ks][0] * 0.125f, qv[ks][1] * 0.125f); o.y = pk2(qv[ks][2] * 0.125f, qv[ks][3] * 0.125f);
                o.z = pk2(qv[ks][4] * 0.125f, qv[ks][5] * 0.125f); o.w = pk2(qv[ks][6] * 0.125f, qv[ks][7] * 0.125f); qf[ks] = __builtin_bit_cast(bf16x8, o); }
        }
        f32x16 s[5];
#pragma unroll
        for (int kj = 0; kj < 5; ++kj) {
            f32x16 acc;
#pragma unroll
            for (int i = 0; i < 16; ++i) acc[i] = 0.f;
            const LAS bf16* kp = Ks + (32 * (qi + kj) + r) * KS_STRIDE + 8 * hh;
#pragma unroll
            for (int ks = 0; ks < 4; ++ks) { const bf16x8 kf = *(const LAS bf16x8*)(kp + 16 * ks); acc = MFMA32(kf, qf[ks], acc); }
            s[kj] = acc;
        }
        float mx = sink;
#pragma unroll
        for (int kj = 0; kj < 5; ++kj)
#pragma unroll
            for (int i = 0; i < 16; ++i) { const int kt = (i & 3) + 8 * (i >> 2) + 4 * hh; const int kbi = 32 * (qi + kj) + kt;
                bool valid = (n * 128 + kbi - 128) >= 0;
                if (kj == 0) valid = valid && (kt > r);
                if (kj == 4) valid = valid && (kt <= r);
                s[kj][i] = valid ? s[kj][i] : -INFINITY; mx = fmaxf(mx, s[kj][i]); }
        mx = fmaxf(mx, __shfl_xor(mx, 32));
        float l = 0.f;
#pragma unroll
        for (int kj = 0; kj < 5; ++kj)
#pragma unroll
            for (int i = 0; i < 16; ++i) { const float p = __expf(s[kj][i] - mx); s[kj][i] = p; l += p; }
        l += __shfl_xor(l, 32);
        l += __expf(sink - mx);
        const float inv = 1.0f / l;
        f32x16 o0, o1;
#pragma unroll
        for (int i = 0; i < 16; ++i) { o0[i] = 0.f; o1[i] = 0.f; }
#pragma unroll
        for (int kj = 0; kj < 5; ++kj)
#pragma unroll
            for (int st = 0; st < 2; ++st) {
                v4u pa; pa.x = pk2(s[kj][8 * st + 0] * inv, s[kj][8 * st + 1] * inv); pa.y = pk2(s[kj][8 * st + 2] * inv, s[kj][8 * st + 3] * inv);
                pa.z = pk2(s[kj][8 * st + 4] * inv, s[kj][8 * st + 5] * inv); pa.w = pk2(s[kj][8 * st + 6] * inv, s[kj][8 * st + 7] * inv);
                const bf16x8 pf = __builtin_bit_cast(bf16x8, pa);
                const int kb0 = 32 * (qi + kj) + 16 * st + 4 * hh;
                const LAS bf16* v0p = VT + r * VT_STRIDE + kb0; const LAS bf16* v1p = VT + (32 + r) * VT_STRIDE + kb0;
                const v2u a0 = *(const LAS v2u*)v0p, a1 = *(const LAS v2u*)(v0p + 8), b0 = *(const LAS v2u*)v1p, b1 = *(const LAS v2u*)(v1p + 8);
                const v4u vb0 = {a0.x, a0.y, a1.x, a1.y}, vb1 = {b0.x, b0.y, b1.x, b1.y};
                o0 = MFMA32(pf, __builtin_bit_cast(bf16x8, vb0), o0);
                o1 = MFMA32(pf, __builtin_bit_cast(bf16x8, vb1), o1);
            }
#pragma unroll
        for (int i = 0; i < 16; ++i) { const int qr = (i & 3) + 8 * (i >> 2) + 4 * hh; const int tok = n * 128 + 32 * qi + qr;
            bf16* op = P_XH(F) + (size_t)(b * SEQ + tok) * D + LRU_W + hq * HD + r;
            op[0] = (bf16)f2bf(o0[i]); op[32] = (bf16)f2bf(o1[i]); }
    }
    __syncthreads();
}

constexpr int LCH = 64;
constexpr int XC_STRIDE = 136;
constexpr int LRU_XCB_OFF = 0, LRU_XCF_OFF = LCH * XC_STRIDE * 2  , LRU_A_OFF = LRU_XCF_OFF + LCH * 128 * 4, LRU_B_OFF = LRU_A_OFF + LCH * 128 * 4, LRU_SE_OFF = LRU_B_OFF + LCH * 128 * 4;
static_assert(LRU_SE_OFF + 2 * 4 * 128 * 4 <= RING_BYTES, "LRU LDS");
__device__ __forceinline__ void lru_unit(Frame& F, int b, int hd, int ch) {
    LAS bf16* XCb = (LAS bf16*)(F.lds + LRU_XCB_OFF);
    LAS float* XCF = (LAS float*)(F.lds + LRU_XCF_OFF);
    LAS float* As = (LAS float*)(F.lds + LRU_A_OFF);
    LAS float* Bs = (LAS float*)(F.lds + LRU_B_OFF);
    LAS float* SEh = (LAS float*)(F.lds + LRU_SE_OFF);
    LAS float* SEp = SEh + 4 * 128;
    const int tid = F.tid, lane = F.lane;
    const int c = tid & 127, sub = tid >> 7, col = hd * LRU_BLK + c;
    const int t0 = ch * LCH;
    {
        const float w0 = P_conv_w(F)[col], w1 = P_conv_w(F)[LRU_W + col], w2 = P_conv_w(F)[2 * LRU_W + col], w3 = P_conv_w(F)[3 * LRU_W + col], cb = P_conv_b(F)[col];
        const bf16* xp = P_PROJ(F) + (size_t)(b * SEQ) * MIX_IN + col;
        const int ts = t0 + sub * 16;
        float xm3 = (ts - 3 >= 0) ? bf1(xp[(size_t)(ts - 3) * MIX_IN]) : 0.f;
        float xm2 = (ts - 2 >= 0) ? bf1(xp[(size_t)(ts - 2) * MIX_IN]) : 0.f;
        float xm1 = (ts - 1 >= 0) ? bf1(xp[(size_t)(ts - 1) * MIX_IN]) : 0.f;
#pragma unroll
        for (int i = 0; i < 16; ++i) { const float x0 = bf1(xp[(size_t)(ts + i) * MIX_IN]);
            const float xc = cb + w0 * xm3 + w1 * xm2 + w2 * xm1 + w3 * x0;
            const int tl = sub * 16 + i;
            XCF[tl * 128 + c] = xc; XCb[tl * XC_STRIDE + c] = (bf16)f2bf(xc);
            xm3 = xm2; xm2 = xm1; xm1 = x0; }
    }
    __syncthreads();
    {
        const int fr = lane & 15, fq = lane >> 4, j = 16 * F.wave + fr, jc = hd * LRU_BLK + j;
        bf16x8 wa[4], wx[4];
        const bf16* wap = P_WGA(F) + (size_t)hd * 16384 + (size_t)j * 128 + 8 * fq;
        const bf16* wxp = P_WGX(F) + (size_t)hd * 16384 + (size_t)j * 128 + 8 * fq;
#pragma unroll
        for (int ks = 0; ks < 4; ++ks) { wa[ks] = *(const bf16x8*)(wap + 32 * ks); wx[ks] = *(const bf16x8*)(wxp + 32 * ks); }
        const float ba = P_ga_b(F)[jc], bx = P_gx_b(F)[jc];
        const float lamv = P_lam(F)[jc];
        const float sp = log1pf(__expf(-lamv));
#pragma unroll
        for (int mt = 0; mt < 4; ++mt) {
            f32x4 ra = {0.f, 0.f, 0.f, 0.f}, rx = {0.f, 0.f, 0.f, 0.f};
            const LAS bf16* ap = XCb + (16 * mt + fr) * XC_STRIDE + 8 * fq;
#pragma unroll
            for (int ks = 0; ks < 4; ++ks) { const bf16x8 af = *(const LAS bf16x8*)(ap + 32 * ks); ra = MFMA16(af, wa[ks], ra); rx = MFMA16(af, wx[ks], rx); }
#pragma unroll
            for (int e = 0; e < 4; ++e) { const int tl = 16 * mt + 4 * fq + e;
                const float rg = sigmoidf_(ra[e] + ba), ig = sigmoidf_(rx[e] + bx);
                const float la = -8.0f * rg * sp; const float a = __expf(la);
                const float mult = sqrtf(-expm1f(2.0f * la));
                As[tl * 128 + j] = a; Bs[tl * 128 + j] = mult * ig * XCF[tl * 128 + j]; }
        }
    }
    __syncthreads();
    {
        float h = 0.f, P = 1.f;
#pragma unroll
        for (int i = 0; i < 16; ++i) { const int tl = sub * 16 + i; const float a = As[tl * 128 + c], bq = Bs[tl * 128 + c];
            h = a * h + bq; P *= a; Bs[tl * 128 + c] = h; As[tl * 128 + c] = P; }
        SEh[sub * 128 + c] = h; SEp[sub * 128 + c] = P;
    }
    __syncthreads();
    {
        float carry = 0.f, pp = 1.f;
        for (int s2 = 0; s2 < sub; ++s2) { carry = SEh[s2 * 128 + c] + SEp[s2 * 128 + c] * carry; pp *= SEp[s2 * 128 + c]; }
        float* hl = P_HL(F) + (size_t)(b * SEQ + t0 + sub * 16) * LRU_W + col;
        float* pa = P_PA(F) + (size_t)(b * SEQ + t0 + sub * 16) * LRU_W + col;
#pragma unroll
        for (int i = 0; i < 16; ++i) { const int tl = sub * 16 + i;
            hl[(size_t)i * LRU_W] = Bs[tl * 128 + c] + As[tl * 128 + c] * carry; pa[(size_t)i * LRU_W] = As[tl * 128 + c] * pp; }
    }
    __syncthreads();
}
constexpr int N_ATT_UNITS = BATCH * HKV * (SEQ / 128);
constexpr int N_LRU_UNITS = BATCH * LRU_HEADS * (SEQ / LCH);
__device__ __forceinline__ void p3_phase(Frame& F) {
    for (int u = F.bid; u < N_ATT_UNITS + N_LRU_UNITS; u += F.G) {
        if (u < N_ATT_UNITS) attn_unit(F, u >> 6, (u >> 5) & 1, u & 31);
        else { const int v = u - N_ATT_UNITS; lru_unit(F, v >> 9, (v >> 6) & 7, v & 63); }
    }
}

__device__ __forceinline__ void p4_unit(Frame& F, int b, int ch) {
    LAS float* CAR = (LAS float*)F.lds;
    const int tid = F.tid, lane = F.lane;
    {
        f32x2 carry = {0.f, 0.f};
        for (int c2 = 0; c2 < ch; ++c2) { const size_t row = (size_t)(b * SEQ + c2 * LCH + LCH - 1) * LRU_W + 2 * tid;
            const f32x2 hl = *(const f32x2*)(P_HL(F) + row), pa = *(const f32x2*)(P_PA(F) + row);
            carry = hl + pa * carry; }
        CAR[2 * tid] = carry.x; CAR[2 * tid + 1] = carry.y;
    }
    __syncthreads();
    for (int i = 0; i < 8; ++i) {
        const size_t m = (size_t)b * SEQ + ch * LCH + F.wave * 8 + i;
        f32x4 val[4]; float ss = 0.f;
#pragma unroll
        for (int j = 0; j < 4; ++j) { const int c = 4 * lane + 256 * j;
            const f32x4 hl = *(const f32x4*)(P_HL(F) + m * LRU_W + c), pa = *(const f32x4*)(P_PA(F) + m * LRU_W + c), car = *(const LAS f32x4*)(CAR + c);
            const v2u yr = *(const v2u*)(P_PROJ(F) + m * MIX_IN + C_Y + c);
            const f32x4 h = hl + pa * car;
            f32x4 v; v.x = h.x * gelu_tanh(bflo(yr.x)); v.y = h.y * gelu_tanh(bfhi(yr.x)); v.z = h.z * gelu_tanh(bflo(yr.y)); v.w = h.w * gelu_tanh(bfhi(yr.y));
            val[j] = v; ss += (v.x * v.x + v.y * v.y) + (v.z * v.z + v.w * v.w); }
        float rstd = 1.0f / sqrtf(wave_sum(ss) * (1.0f / LRU_W) + EPS);
#pragma unroll
        for (int j = 0; j < 4; ++j) { const int c = 4 * lane + 256 * j; const f32x4 g = *(const f32x4*)(P_on_lru_g(F) + c); const f32x4 y = val[j] * rstd * g;
            v2u o; o.x = pk2(y.x, y.y); o.y = pk2(y.z, y.w); *(v2u*)(P_XH(F) + m * D + c) = o; }
        ss = 0.f;
#pragma unroll
        for (int j = 0; j < 4; ++j) { const int c = 4 * lane + 256 * j; const v2u ar = *(const v2u*)(P_XH(F) + m * D + LRU_W + c);
            f32x4 v; v.x = bflo(ar.x); v.y = bfhi(ar.x); v.z = bflo(ar.y); v.w = bfhi(ar.y); val[j] = v; ss += (v.x * v.x + v.y * v.y) + (v.z * v.z + v.w * v.w); }
        rstd = 1.0f / sqrtf(wave_sum(ss) * (1.0f / LRU_W) + EPS);
#pragma unroll
        for (int j = 0; j < 4; ++j) { const int c = 4 * lane + 256 * j; const f32x4 g = *(const f32x4*)(P_on_attn_g(F) + c); const f32x4 y = val[j] * rstd * g;
            v2u o; o.x = pk2(y.x, y.y); o.y = pk2(y.z, y.w); *(v2u*)(P_XH(F) + m * D + LRU_W + c) = o; }
    }
    __syncthreads();
}
__device__ __forceinline__ void p4_phase(Frame& F) {
    for (int u = F.bid; u < BATCH * (SEQ / LCH); u += F.G) p4_unit(F, u >> 6, u & 63);
}

__device__ __forceinline__ int f2key(float f) { const int b = __builtin_bit_cast(int, f); return b ^ ((b >> 31) & 0x7fffffff); }
__device__ __forceinline__ float key2f(int k) { const int b = k ^ ((k >> 31) & 0x7fffffff); return __builtin_bit_cast(float, b); }
__device__ __forceinline__ void ins16(int (&L)[16], int x) {
#pragma unroll
    for (int j = 0; j < 16; ++j) { const int hi = max(L[j], x); x = min(L[j], x); L[j] = hi; }
}
constexpr int INT_LOWEST = (int)0x80000000;
__device__ __forceinline__ void p8_item(Frame& F, int tt, int hd, LAS int* lut  ) {
    const int lane = F.lane, r = lane & 31, hh = lane >> 5;
    const bf16* QP = P_PROJ(F);
    int V[2][16];
#pragma unroll
    for (int p = 0; p < 2; ++p) {
        bf16x8 qf[8];
        const char* qb = (const char*)(QP + (size_t)(32 * tt) * D + hd * 256 + p * 128);
        const unsigned qoff = (unsigned)(r * D + 8 * hh) * 2u;
#pragma unroll
        for (int ks = 0; ks < 8; ++ks) qf[ks] = *(const bf16x8*)(qb + qoff + 32 * ks);
        int L[16];
#pragma unroll
        for (int j = 0; j < 16; ++j) L[j] = INT_LOWEST;
        const char* skb = (const char*)(P_SK(F) + (size_t)((hd * 2 + p) * PKEYS) * PHALF);
        const unsigned skoff = (unsigned)(r * PHALF + 8 * hh) * 2u;
#pragma unroll 1
        for (int kt = 0; kt < 4; ++kt) {
            f32x16 acc;
#pragma unroll
            for (int i = 0; i < 16; ++i) acc[i] = 0.f;
            const char* skt = skb + (size_t)(32 * kt) * PHALF * 2;
#pragma unroll
            for (int ks = 0; ks < 8; ++ks) { const bf16x8 kf = *(const bf16x8*)(skt + skoff + 32 * ks); acc = MFMA32(kf, qf[ks], acc); }
            const int kbase = 32 * kt + 4 * hh;
#pragma unroll
            for (int i = 0; i < 16; ++i) { const int kidx = (i & 3) + 8 * (i >> 2);
                const int key = (f2key(acc[i]) & ~0x7f) | (kbase + kidx);
                ins16(L, key); }
        }
        int O[16];
#pragma unroll
        for (int j = 0; j < 16; ++j) O[j] = __shfl_xor(L[j], 32);
#pragma unroll
        for (int j = 0; j < 16; ++j) ins16(L, O[j]);
#pragma unroll
        for (int j = 0; j < 16; ++j) V[p][j] = L[j];
    }
#pragma unroll
    for (int j = 0; j < 16; ++j) { lut[lane * 33 + j] = V[0][j] & 0x7f; lut[lane * 33 + 16 + j] = V[1][j] & 0x7f; }
    float v0[16], v1[16];
#pragma unroll
    for (int j = 0; j < 16; ++j) { v0[j] = key2f(V[0][j] & ~0x7f); v1[j] = key2f(V[1][j] & ~0x7f); }
    int C[16];
#pragma unroll
    for (int j = 0; j < 16; ++j) C[j] = INT_LOWEST;
#pragma unroll
    for (int i = 0; i < 16; ++i)
#pragma unroll
        for (int j = 0; j < 16; ++j)
            if ((i + 1) * (j + 1) <= 16) { const int key = (f2key(v0[i] + v1[j]) & ~0xff) | (i * 16 + j); ins16(C, key); }
    float sv[16]; float den = 0.f;
    const float mx = key2f(C[0] & ~0xff);
#pragma unroll
    for (int e = 0; e < 16; ++e) { sv[e] = __expf(key2f(C[e] & ~0xff) - mx); den += sv[e]; }
    const float inv = 1.0f / den;
    LDS_WAIT(); asm volatile("" ::: "memory");
    int idx[16];
#pragma unroll
    for (int e = 0; e < 16; ++e) { const int pi = (C[e] >> 4) & 15, pj = C[e] & 15; idx[e] = lut[lane * 33 + pi] * PKEYS + lut[lane * 33 + 16 + pj]; }
    if (hh == 0) {
        int* ip = P_IDX(F) + (size_t)(32 * tt + r) * 128 + hd * 16; float* gp = P_GW(F) + (size_t)(32 * tt + r) * 128 + hd * 16;
#pragma unroll
        for (int q = 0; q < 4; ++q) { *(v4u*)(ip + 4 * q) = (v4u){(unsigned)idx[4 * q], (unsigned)idx[4 * q + 1], (unsigned)idx[4 * q + 2], (unsigned)idx[4 * q + 3]};
            *(f32x4*)(gp + 4 * q) = (f32x4){sv[4 * q] * inv, sv[4 * q + 1] * inv, sv[4 * q + 2] * inv, sv[4 * q + 3] * inv}; }
    }
    LDS_WAIT(); asm volatile("" ::: "memory");
}
__device__ __forceinline__ void p8_phase(Frame& F) {
    LAS int* lut = (LAS int*)(F.lds + F.wave * (64 * 33 * 4));
    const int gw = F.bid * NWAVES + F.wave, NGW = F.G * NWAVES;
    for (int it = gw; it < (M / 32) * PH; it += NGW) p8_item(F, it >> 3, it & 7, lut);
}

__device__ __forceinline__ void p9_token(Frame& F, int m) {
    const int lane = F.lane;
    unsigned hq[16];
    {
        const bf16* hp = P_XH(F) + (size_t)m * D + 8 * lane;
#pragma unroll
        for (int j = 0; j < 4; ++j) { const v4u r = *(const v4u*)(hp + 512 * j); hq[4 * j] = r.x; hq[4 * j + 1] = r.y; hq[4 * j + 2] = r.z; hq[4 * j + 3] = r.w; }
    }
    const int ix0 = P_IDX(F)[(size_t)m * 128 + lane], ix1 = P_IDX(F)[(size_t)m * 128 + 64 + lane];
    const float gw0 = P_GW(F)[(size_t)m * 128 + lane], gw1 = P_GW(F)[(size_t)m * 128 + 64 + lane];
    float acc[32];
#pragma unroll
    for (int e = 0; e < 32; ++e) acc[e] = 0.f;
    for (int g = 0; g < 32; ++g) {
        int id[4]; float gg[4];
#pragma unroll
        for (int k = 0; k < 4; ++k) { const int pk = 4 * g + k;
            id[k] = (pk < 64) ? __builtin_amdgcn_readlane(ix0, pk & 63) : __builtin_amdgcn_readlane(ix1, pk & 63);
            gg[k] = __builtin_bit_cast(float, (pk < 64) ? __builtin_amdgcn_readlane(__builtin_bit_cast(int, gw0), pk & 63) : __builtin_amdgcn_readlane(__builtin_bit_cast(int, gw1), pk & 63)); }
        v4u ur[4][4], vr[4][4];
#pragma unroll
        for (int k = 0; k < 4; ++k) { const bf16* up = P_U(F) + (size_t)id[k] * D + 8 * lane; const bf16* vp = P_V(F) + (size_t)id[k] * D + 8 * lane;
#pragma unroll
            for (int j = 0; j < 4; ++j) { ur[k][j] = *(const v4u*)(up + 512 * j); vr[k][j] = *(const v4u*)(vp + 512 * j); } }
        float w[4];
#pragma unroll
        for (int k = 0; k < 4; ++k) { float d0 = 0.f, d1 = 0.f, d2 = 0.f, d3 = 0.f;
#pragma unroll
            for (int j = 0; j < 4; ++j) { d0 = dot2bf(ur[k][j].x, hq[4 * j], d0); d1 = dot2bf(ur[k][j].y, hq[4 * j + 1], d1); d2 = dot2bf(ur[k][j].z, hq[4 * j + 2], d2); d3 = dot2bf(ur[k][j].w, hq[4 * j + 3], d3); }
            const float a = wave_sum((d0 + d1) + (d2 + d3));
            w[k] = gg[k] * gelu_tanh(a); }
#pragma unroll
        for (int k = 0; k < 4; ++k) { const unsigned wb = f2bf(w[k]); const unsigned wlo = wb, whi = wb << 16;
#pragma unroll
            for (int j = 0; j < 4; ++j) { const unsigned q[4] = {vr[k][j].x, vr[k][j].y, vr[k][j].z, vr[k][j].w};
#pragma unroll
                for (int e = 0; e < 4; ++e) { acc[8 * j + 2 * e] = dot2bf(q[e], wlo, acc[8 * j + 2 * e]); acc[8 * j + 2 * e + 1] = dot2bf(q[e], whi, acc[8 * j + 2 * e + 1]); } } }
    }
    const int b = m / SEQ; const float* g2 = P_ADA(F) + (size_t)b * ADA_W + 5 * D;
    float* op = P_out(F) + (size_t)m * D + 8 * lane;
#pragma unroll
    for (int j = 0; j < 4; ++j)
#pragma unroll
        for (int q = 0; q < 2; ++q) { const f32x4 x1 = *(const f32x4*)(op + 512 * j + 4 * q); const f32x4 gv = *(const f32x4*)(g2 + 8 * lane + 512 * j + 4 * q);
            const f32x4 a = {acc[8 * j + 4 * q], acc[8 * j + 4 * q + 1], acc[8 * j + 4 * q + 2], acc[8 * j + 4 * q + 3]};
            *(f32x4*)(op + 512 * j + 4 * q) = x1 + gv * a; }
}
__device__ __forceinline__ void p9_phase(Frame& F) {
    const int gw = F.bid * NWAVES + F.wave, NGW = F.G * NWAVES;
    for (int m = gw; m < M; m += NGW) p9_token(F, m);
}

struct Args { const void* in[25]; float* out; unsigned char* ws; int ph_lo, ph_hi; };
__global__ void __launch_bounds__(NWAVES * 64, 2) hymba_fwd(Args args) {
    extern __shared__ __attribute__((aligned(16))) unsigned char lds_raw[];
    Frame F;
    F.lds = (LAS unsigned char*)lds_raw;
    F.tid = threadIdx.x; F.lane = F.tid & 63; F.wave = __builtin_amdgcn_readfirstlane(F.tid >> 6);
    F.G = gridDim.x; F.bid = blockIdx.x;
    F.ka = (kaptr_t)__builtin_amdgcn_kernarg_segment_ptr();
    static_assert(sizeof(Args) == 224, "kernarg byte offsets used by ka_ptr");
    for (int u = F.tid; u < (LDS_BYTES - LDSCTL_OFF) / 4; u += NWAVES * 64) ((LAS unsigned*)(F.lds + LDSCTL_OFF))[u] = 0u;
    __syncthreads();
    volatile LAS unsigned* MISC = (volatile LAS unsigned*)(F.lds + MISC_OFF);
    XcdBarrier bar; bar.bar = (unsigned*)(P_ws(F) + WS_CTL) + CW_BAR; bar.x = 0; bar.st = nullptr;
    const int lo = args.ph_lo, hi = args.ph_hi;
    if (hi - lo > 1) bar = xcd_barrier_post((unsigned*)(P_ws(F) + WS_CTL) + CW_BAR, MISC + 8);
#define IN(k) (lo <= (k) && (k) < hi)
#define SEAM(k) do { if (IN(k) && IN((k) + 1)) xcd_barrier(bar); } while (0)

    if (IN(0)) { p0_prologue(F); } SEAM(0);
    if (IN(1)) { p1_phase(F); } SEAM(1);
    if (IN(2)) {
        pg8::Gemm g{P_XH(F), P_WIN(F), M, MIX_IN, D}; pg8::StaticOrder S; S.init(M, MIX_IN, F.G, F.bid);
        pg8::EpiStoreBf16 E{P_PROJ(F), MIX_IN};
        pg8::gemm_phase<pg8::EpiStoreBf16, pg8::StaticOrder, true, true>(F.lds, g, S, E);
    } SEAM(2);
    if (IN(3)) { p3_phase(F); } SEAM(3);
    if (IN(4)) { p4_phase(F); } SEAM(4);
    if (IN(5)) {
        pg8::Gemm g{P_XH(F), P_WOUT(F), M, D, D}; pg8::StaticOrder S; S.init(M, D, F.G, F.bid);
        pg8::EpiResid E{P_x(F), P_out(F), D, P_ADA(F) + 2 * D, ADA_W, SEQ};
        pg8::gemm_phase<pg8::EpiResid, pg8::StaticOrder, true, true>(F.lds, g, S, E);
    } SEAM(5);
    if (IN(6)) { p6_phase(F); } SEAM(6);
    if (IN(7)) {
        pg8::Gemm g{P_XH(F), P_WQ(F), M, D, D}; pg8::StaticOrder S; S.init(M, D, F.G, F.bid);
        pg8::EpiStoreBf16 E{P_PROJ(F), D};
        pg8::gemm_phase<pg8::EpiStoreBf16, pg8::StaticOrder, true, true>(F.lds, g, S, E);
    } SEAM(7);
    if (IN(8)) { p8_phase(F); } SEAM(8);
    if (IN(9)) { p9_phase(F); }
#undef IN
#undef SEAM
}

extern "C" void kernel_launch(void* const* d_in, const int* in_sizes, int n_in, void* d_out, int out_size, void* d_ws, size_t ws_size, hipStream_t stream) {
    static int grid = 0;
    if (grid == 0) {
        if (n_in != 25 || in_sizes[0] != M * D || out_size != M * D || ws_size < WS_END) {
            fprintf(stderr, "kernel_launch: built for 25 inputs, x/out of %d floats, >= %zu bytes of workspace; got n_in %d, in0 %d, out %d, ws %zu; nothing launched\n", M * D, (size_t)WS_END, n_in, n_in > 0 ? in_sizes[0] : -1, out_size, ws_size);
            grid = -1; return; }
        int dev = 0, cus = 0, per_cu = 0;
        if (hipGetDevice(&dev) != hipSuccess || hipDeviceGetAttribute(&cus, hipDeviceAttributeMultiprocessorCount, dev) != hipSuccess) { fprintf(stderr, "kernel_launch: device query failed\n"); grid = -1; return; }
        if (hipFuncSetAttribute((const void*)hymba_fwd, hipFuncAttributeMaxDynamicSharedMemorySize, LDS_BYTES) != hipSuccess) { fprintf(stderr, "kernel_launch: hipFuncSetAttribute failed\n"); grid = -1; return; }
        if (hipOccupancyMaxActiveBlocksPerMultiprocessor(&per_cu, (const void*)hymba_fwd, NWAVES * 64, LDS_BYTES) != hipSuccess || per_cu < 1) {
            fprintf(stderr, "kernel_launch: occupancy query reports %d workgroups per CU; need 1\n", per_cu); (void)hipGetLastError(); grid = -1; return; }
        grid = cus;
    }
    if (grid < 0) return;
    if (hipMemsetAsync((char*)d_ws + WS_CTL, 0, CTL_ZERO_BYTES, stream) != hipSuccess) { fprintf(stderr, "kernel_launch: memset failed\n"); return; }
    Args a{};
    for (int i = 0; i < 25; ++i) a.in[i] = d_in[i];
    a.out = (float*)d_out; a.ws = (unsigned char*)d_ws;
    if (N_LAUNCHES == 1) {
        a.ph_lo = 0; a.ph_hi = N_PHASES;
        void* kargs[] = {&a};
        const hipError_t le = hipLaunchCooperativeKernel((const void*)hymba_fwd, dim3(grid), dim3(NWAVES * 64), kargs, LDS_BYTES, stream);
        if (le != hipSuccess) fprintf(stderr, "kernel_launch: cooperative launch failed: %s (grid %d)\n", hipGetErrorName(le), grid);
    } else {
        for (int li = 0; li < N_PHASES; ++li) { a.ph_lo = li; a.ph_hi = li + 1;
            hipLaunchKernelGGL(hymba_fwd, dim3(grid), dim3(NWAVES * 64), LDS_BYTES, stream, a);
            const hipError_t le = hipPeekAtLastError();
            if (le != hipSuccess) { fprintf(stderr, "kernel_launch: launch %d failed: %s\n", li, hipGetErrorName(le)); break; } }
    }
}
```

```cpp
#include <hip/hip_runtime.h>
#include <cstdio>
#include <cstdint>
namespace pg8 {
#define PG8_LAS __attribute__((address_space(3)))
typedef unsigned short bf16_t;
typedef short bf16x8 __attribute__((ext_vector_type(8)));
typedef float f32x4 __attribute__((ext_vector_type(4)));
typedef unsigned u32x4 __attribute__((ext_vector_type(4)));
constexpr int BM = 256, BK = 64, HALF = 128, HTB = HALF * BK * 2  , STAGE_BYTES = 8 * HTB, NXCD = 8, WGM = 8;

__host__ __device__ __forceinline__ int lds_byte(int r, int c) { const int st = (r >> 4) * 2 + (c >> 5), rr = r & 15, cc = c & 31, ob = rr * 64 + cc * 2; return st * 1024 + (ob ^ (((ob >> 9) & 1) << 5)); }
__host__ __device__ __forceinline__ void stage_rc(int b, int& R, int& C) { const int st = b / 1024, sb = b % 1024, swz = sb ^ (((sb >> 9) & 1) << 5); R = (st >> 1) * 16 + swz / 64; C = (st & 1) * 32 + (swz % 64) / 2; }
__host__ __device__ __forceinline__ int perm32(int rho) { const int n = rho >> 4, i = rho & 15; return 8 * (i >> 2) + 4 * n + (i & 3); }

struct Unit { int pm, pn; };
struct Gemm { const bf16_t* A; const bf16_t* Bt; int M, N, K; };

struct StaticOrder {
    int nM, nN, nwg, G, c;
    __host__ __device__ void init(int M, int N, int G_, int c_) { nM = M / BM; nN = N / BM; nwg = nM * nN; G = G_; c = c_; }
    __host__ __device__ bool next(int i, Unit& u) const {
        const long L = (long)i * G + c; if (L >= nwg) return false;
        int wgid = (int)L; { const int q = nwg / NXCD, r = nwg % NXCD, xcd = wgid % NXCD, off = wgid / NXCD; wgid = (xcd < r ? xcd * (q + 1) : r * (q + 1) + (xcd - r) * q) + off; }
        const int nig = WGM * nN, gid = wgid / nig, fm = gid * WGM, gsz = (nM - fm) < WGM ? (nM - fm) : WGM;
        u.pm = fm + ((wgid % nig) % gsz); u.pn = (wgid % nig) / gsz; return true;
    }
    __device__ __forceinline__ void a_ready(const Unit&) const {}
    __device__ __forceinline__ void done(const Unit&) const {}
};

__device__ __forceinline__ unsigned cvt_pk_bf16(float lo, float hi) { unsigned r; asm volatile("v_cvt_pk_bf16_f32 %0, %1, %2" : "=v"(r) : "v"(lo), "v"(hi)); return r; }
struct EpiStoreBf16 {
    static constexpr bool PERM = true, AFTER_DRAIN = false;
    bf16_t* O; int ldc;
    __device__ __forceinline__ void operator()(const f32x4 (&acc)[2][2][4][2], const Unit& u, int wr, int wc, int fr, int fq) const {
        const int row0 = u.pm * BM + wr * 64 + fr; const int col0 = u.pn * BM + wc * 32 + 8 * fq;
#pragma unroll
        for (int ai = 0; ai < 2; ++ai)
#pragma unroll
            for (int m = 0; m < 4; ++m) { bf16_t* rowp = O + (size_t)(row0 + ai * HALF + m * 16) * ldc + col0;
#pragma unroll
                for (int bj = 0; bj < 2; ++bj) { const f32x4 v0 = acc[ai][bj][m][0], v1 = acc[ai][bj][m][1];
                    u32x4 w; w.x = cvt_pk_bf16(v0[0], v0[1]); w.y = cvt_pk_bf16(v0[2], v0[3]); w.z = cvt_pk_bf16(v1[0], v1[1]); w.w = cvt_pk_bf16(v1[2], v1[3]);
                    *(u32x4*)(rowp + bj * HALF) = w; } }
    }
};
struct EpiResid {
    static constexpr bool PERM = false, AFTER_DRAIN = false;
    const float* base; float* out; int ldc; const float* gate; int gstride; int rows_per_batch;
    __device__ __forceinline__ void operator()(const f32x4 (&acc)[2][2][4][2], const Unit& u, int wr, int wc, int fr, int fq) const {
        const int b = (u.pm * BM) / rows_per_batch; const float* g = gate + (size_t)b * gstride;
        const int col0 = u.pn * BM + wc * 32 + 4 * fq;
        f32x4 gv[2][2];
#pragma unroll
        for (int bj = 0; bj < 2; ++bj)
#pragma unroll
            for (int n = 0; n < 2; ++n) gv[bj][n] = *(const f32x4*)(g + col0 + bj * HALF + n * 16);
#pragma unroll
        for (int ai = 0; ai < 2; ++ai)
#pragma unroll
            for (int m = 0; m < 4; ++m) { const size_t off = (size_t)(u.pm * BM + ai * HALF + wr * 64 + m * 16 + fr) * ldc + col0;
#pragma unroll
                for (int bj = 0; bj < 2; ++bj)
#pragma unroll
                    for (int n = 0; n < 2; ++n) { const f32x4 bs = *(const f32x4*)(base + off + bj * HALF + n * 16);
                        *(f32x4*)(out + off + bj * HALF + n * 16) = bs + gv[bj][n] * acc[ai][bj][m][n]; }
                if (m & 1) asm volatile("" ::: "memory"); }
    }
};

template <class Epi, class Sched, bool ALIGN_EPI = false, bool SP2 = false>
__device__ __forceinline__ void gemm_phase(PG8_LAS unsigned char* lds, const Gemm g, const Sched& S, const Epi& E) {
    const int tid = threadIdx.x, wid = __builtin_amdgcn_readfirstlane(tid >> 6), lane = tid & 63, wr = wid >> 2, wc = wid & 3, fr = lane & 15, fq = lane >> 4;
    const int K = g.K, nt = K / BK;
    unsigned voffA[2], voffB[2];
#pragma unroll
    for (int i = 0; i < 2; ++i) { int R, C; stage_rc(tid * 16 + i * 8192, R, C); const int Rb = Epi::PERM ? ((R & ~31) + perm32(R & 31)) : R;
        voffA[i] = (unsigned)(R * K + C) * 2u; voffB[i] = (unsigned)(Rb * K + C) * 2u; }
    const size_t kstep = (size_t)(BK * 2);
    const size_t hstep = (size_t)HALF * K * 2;
    const size_t tstep = 2 * hstep;
    const unsigned ldsw = (unsigned)wid * 1024u;
    const int aoff = lds_byte(wr * 64 + fr, fq * 8), boff = lds_byte(wc * 32 + fr, fq * 8);
#define PG8_SA(b, h) (((b) * 2 + (h)) * HTB)
#define PG8_SB(b, h) ((4 + (b) * 2 + (h)) * HTB)
#define PG8_STAGE(bufoff, gbase, voff) do { _Pragma("unroll") for (int _i = 0; _i < 2; ++_i) \
        __builtin_amdgcn_global_load_lds((const unsigned*)((const char*)(gbase) + (voff)[_i]), (PG8_LAS unsigned*)(lds + (bufoff) + ldsw + _i * 8192), 16, 0, 0); } while (0)
#define PG8_LDA(dst, b, h) do { _Pragma("unroll") for (int m = 0; m < 4; ++m) _Pragma("unroll") for (int k = 0; k < 2; ++k) dst[m][k] = *(const PG8_LAS bf16x8*)(lds + PG8_SA(b, h) + aoff + m * 2048 + k * 1024); } while (0)
#define PG8_LDB(dst, b, h) do { _Pragma("unroll") for (int n = 0; n < 2; ++n) _Pragma("unroll") for (int k = 0; k < 2; ++k) dst[n][k] = *(const PG8_LAS bf16x8*)(lds + PG8_SB(b, h) + boff + n * 2048 + k * 1024); } while (0)
#define PG8_MMA(ai, bj, At, Bt) do { __builtin_amdgcn_s_setprio(1); _Pragma("unroll") for (int m = 0; m < 4; ++m) _Pragma("unroll") for (int n = 0; n < 2; ++n) _Pragma("unroll") for (int k = 0; k < 2; ++k) \
        acc[ai][bj][m][n] = __builtin_amdgcn_mfma_f32_16x16x32_bf16(Bt[n][k], At[m][k], acc[ai][bj][m][n], 0, 0, 0); __builtin_amdgcn_s_setprio(0); } while (0)
#define PG8_WAIT_V(n) asm volatile("s_waitcnt vmcnt(" #n ")" ::: "memory")
#define PG8_WAIT_L(n) asm volatile("s_waitcnt lgkmcnt(" #n ")" ::: "memory")
#define PG8_BAR __builtin_amdgcn_s_barrier()
#define PG8_SCHED __builtin_amdgcn_sched_barrier(0)
    Unit cur, nxt; int ui = 0;
    if (!S.next(0, cur)) return;
    f32x4 acc[2][2][4][2];
#pragma unroll
    for (int a = 0; a < 2; ++a)
#pragma unroll
        for (int b = 0; b < 2; ++b)
#pragma unroll
            for (int m = 0; m < 4; ++m)
#pragma unroll
                for (int n = 0; n < 2; ++n) acc[a][b][m][n] = (f32x4){0.f, 0.f, 0.f, 0.f};
    bf16x8 At[4][2], B0[2][2], B1[2][2];
    const char* cA = (const char*)g.A + (size_t)cur.pm * tstep; const char* cB = (const char*)g.Bt + (size_t)cur.pn * tstep;
    S.a_ready(cur);
    if constexpr (SP2) {
        PG8_STAGE(PG8_SB(0, 0), cB, voffB); PG8_STAGE(PG8_SB(0, 1), cB + hstep, voffB); PG8_STAGE(PG8_SA(0, 0), cA, voffA); PG8_STAGE(PG8_SA(0, 1), cA + hstep, voffA);
        if (wr == 1) PG8_BAR;
        PG8_WAIT_V(2); PG8_BAR;
        PG8_STAGE(PG8_SB(1, 0), cB + kstep, voffB); PG8_STAGE(PG8_SA(1, 0), cA + kstep, voffA); PG8_STAGE(PG8_SB(1, 1), cB + hstep + kstep, voffB);
        PG8_WAIT_V(6); PG8_BAR;
    } else {
        PG8_STAGE(PG8_SB(0, 0), cB, voffB); PG8_STAGE(PG8_SA(0, 0), cA, voffA); PG8_STAGE(PG8_SB(0, 1), cB + hstep, voffB); PG8_STAGE(PG8_SA(0, 1), cA + hstep, voffA);
        if (wr == 1) PG8_BAR;
        PG8_WAIT_V(4); PG8_BAR;
        PG8_STAGE(PG8_SB(1, 0), cB + kstep, voffB); PG8_STAGE(PG8_SA(1, 0), cA + kstep, voffA); PG8_STAGE(PG8_SB(1, 1), cB + hstep + kstep, voffB);
        PG8_WAIT_V(6); PG8_BAR;
    }
    for (;;) {
        const bool has_next = S.next(ui + 1, nxt);
        const char* nA = has_next ? (const char*)g.A + (size_t)nxt.pm * tstep : cA; const char* nB = has_next ? (const char*)g.Bt + (size_t)nxt.pn * tstep : cB;
        for (int t = 0; t < nt; t += 2) {
            const bool last = (t == nt - 2);
            const char* a1 = cA + (size_t)(t + 1) * kstep;
            const char* a2 = last ? nA : cA + (size_t)(t + 2) * kstep; const char* b2 = last ? nB : cB + (size_t)(t + 2) * kstep;
            const char* a3 = a2 + kstep; const char* b3 = b2 + kstep;
            if (last && has_next) S.a_ready(nxt);
            if constexpr (SP2) {
            PG8_LDB(B0, 0, 0); PG8_LDB(B1, 0, 1); PG8_SCHED; PG8_LDA(At, 0, 0); PG8_STAGE(PG8_SA(1, 1), a1 + hstep, voffA);
            PG8_WAIT_V(8); PG8_WAIT_L(0); PG8_BAR; PG8_MMA(0, 0, At, B0); PG8_MMA(0, 1, At, B1); PG8_BAR; PG8_SCHED;
            PG8_LDA(At, 0, 1); PG8_STAGE(PG8_SB(0, 0), b2, voffB); PG8_STAGE(PG8_SB(0, 1), b2 + hstep, voffB); PG8_STAGE(PG8_SA(0, 0), a2, voffA);
            PG8_WAIT_V(8); PG8_WAIT_L(0); PG8_BAR; PG8_MMA(1, 0, At, B0); PG8_MMA(1, 1, At, B1); PG8_BAR; PG8_SCHED;
            PG8_LDB(B0, 1, 0); PG8_LDB(B1, 1, 1); PG8_SCHED; PG8_LDA(At, 1, 0); PG8_STAGE(PG8_SA(0, 1), a2 + hstep, voffA);
            PG8_WAIT_V(8); PG8_WAIT_L(0); PG8_BAR; PG8_MMA(0, 0, At, B0); PG8_MMA(0, 1, At, B1); PG8_BAR; PG8_SCHED;
            PG8_LDA(At, 1, 1); PG8_STAGE(PG8_SB(1, 0), b3, voffB); PG8_STAGE(PG8_SB(1, 1), b3 + hstep, voffB); PG8_STAGE(PG8_SA(1, 0), a3, voffA);
            PG8_WAIT_V(8); PG8_WAIT_L(0); PG8_BAR; PG8_MMA(1, 0, At, B0); PG8_MMA(1, 1, At, B1); PG8_BAR; PG8_SCHED;
            } else {
            PG8_LDB(B0, 0, 0); PG8_SCHED; PG8_LDA(At, 0, 0); PG8_STAGE(PG8_SA(1, 1), a1 + hstep, voffA);
            PG8_WAIT_L(8); PG8_BAR; PG8_WAIT_L(0); PG8_MMA(0, 0, At, B0); PG8_BAR; PG8_SCHED;
            PG8_LDB(B1, 0, 1); PG8_STAGE(PG8_SB(0, 0), b2, voffB);
            PG8_BAR; PG8_WAIT_L(0); PG8_MMA(0, 1, At, B1); PG8_BAR;
            PG8_LDA(At, 0, 1); PG8_STAGE(PG8_SA(0, 0), a2, voffA);
            PG8_BAR; PG8_WAIT_L(0); PG8_MMA(1, 0, At, B0); PG8_BAR; PG8_SCHED;
            PG8_STAGE(PG8_SB(0, 1), b2 + hstep, voffB);
            PG8_WAIT_V(6); PG8_BAR; PG8_MMA(1, 1, At, B1); PG8_BAR;
            PG8_LDB(B0, 1, 0); PG8_SCHED; PG8_LDA(At, 1, 0); PG8_STAGE(PG8_SA(0, 1), a2 + hstep, voffA);
            PG8_WAIT_L(8); PG8_BAR; PG8_WAIT_L(0); PG8_MMA(0, 0, At, B0); PG8_BAR; PG8_SCHED;
            PG8_LDB(B1, 1, 1); PG8_STAGE(PG8_SB(1, 0), b3, voffB);
            PG8_BAR; PG8_WAIT_L(0); PG8_MMA(0, 1, At, B1); PG8_BAR;
            PG8_LDA(At, 1, 1); PG8_STAGE(PG8_SA(1, 0), a3, voffA);
            PG8_BAR; PG8_WAIT_L(0); PG8_MMA(1, 0, At, B0); PG8_BAR; PG8_SCHED;
            PG8_STAGE(PG8_SB(1, 1), b3 + hstep, voffB);
            PG8_WAIT_V(6); PG8_BAR; PG8_MMA(1, 1, At, B1); PG8_BAR;
            }
        }
        if constexpr (ALIGN_EPI) { if (wr == 0) PG8_BAR; }
        if constexpr (!Epi::AFTER_DRAIN) { E(acc, cur, wr, wc, fr, fq); S.done(cur); }
        if (!has_next) break;
#pragma unroll
        for (int a = 0; a < 2; ++a)
#pragma unroll
            for (int b = 0; b < 2; ++b)
#pragma unroll
                for (int m = 0; m < 4; ++m)
#pragma unroll
                    for (int n = 0; n < 2; ++n) acc[a][b][m][n] = (f32x4){0.f, 0.f, 0.f, 0.f};
        cur = nxt; cA = nA; cB = nB; ++ui;
        if constexpr (ALIGN_EPI) { if (wr == 1) PG8_BAR; }
    }
    PG8_WAIT_V(0);
    if constexpr (!ALIGN_EPI) { if (wr == 0) PG8_BAR; }
    PG8_BAR;
    if constexpr (Epi::AFTER_DRAIN) { E.fused(acc, cur, wr, wc, fr, fq, lds, wid, lane); S.done(cur); }
#undef PG8_SA
#undef PG8_SB
#undef PG8_STAGE
#undef PG8_LDA
#undef PG8_LDB
#undef PG8_MMA
#undef PG8_WAIT_V
#undef PG8_WAIT_L
#undef PG8_BAR
#undef PG8_SCHED
}
}

constexpr int NWAVES = 8;
#ifndef MK_N_LAUNCHES
#define MK_N_LAUNCHES 1
#endif
constexpr int N_PHASES = 10;
constexpr int N_LAUNCHES = MK_N_LAUNCHES;

constexpr int BATCH = 4, SEQ = 4096, D = 2048, M = BATCH * SEQ;
constexpr int LRU_W = 1024, LRU_HEADS = 8, LRU_BLK = 128;
constexpr int HD = 64, HQ = 16, HKV = 2, GRP = 8;
constexpr int MIX_IN = 3328;
constexpr int C_Y = 1024, C_Q = 2048, C_K = 3072, C_V = 3200;
constexpr int ADA_W = 6 * D;
constexpr int PH = 8, PKEYS = 128, PHALF = 128, PTOPK = 16, NEXP = 16384;
constexpr float EPS = 1e-6f;

constexpr size_t MiB = 1u << 20;
constexpr size_t WS_CTL = 0, CTL_ZERO_BYTES = 1 * MiB;
constexpr size_t WS_ADA = 1 * MiB;
constexpr size_t WS_ROPE = 2 * MiB;
constexpr size_t WS_WIN = 4 * MiB;
constexpr size_t WS_WOUT = 17 * MiB;
constexpr size_t WS_WQ = 25 * MiB;
constexpr size_t WS_WGA = 33 * MiB;
constexpr size_t WS_WGX = 33 * MiB + 256 * 1024;
constexpr size_t WS_SK = 33 * MiB + 512 * 1024;
constexpr size_t WS_IDX = 34 * MiB;
constexpr size_t WS_GW = 42 * MiB;
constexpr size_t WS_U = 50 * MiB;
constexpr size_t WS_V = 82 * MiB;
constexpr size_t WS_USC = 1 * MiB + 512 * 1024;
constexpr size_t WS_VSC = 1 * MiB + 768 * 1024;
constexpr size_t WS_XH = 178 * MiB;
constexpr size_t WS_PROJ = 242 * MiB;
constexpr size_t WS_HL = 346 * MiB;
constexpr size_t WS_PA = 410 * MiB;
constexpr size_t WS_END = 474 * MiB;
constexpr int CW_BAR = 4096;

constexpr int RING_BYTES = 131072;
constexpr int LDSCTL_OFF = RING_BYTES, MISC_OFF = LDSCTL_OFF + 320;
constexpr int LDS_BYTES = 147456;

#define GAS __attribute__((address_space(1)))
#define LAS __attribute__((address_space(3)))
typedef unsigned short bf16;
typedef unsigned v4u __attribute__((ext_vector_type(4)));
typedef unsigned v2u __attribute__((ext_vector_type(2)));
typedef float f32x4 __attribute__((ext_vector_type(4)));
typedef float f32x2 __attribute__((ext_vector_type(2)));
typedef float f32x16 __attribute__((ext_vector_type(16)));
typedef short bf16x8 __attribute__((ext_vector_type(8)));
typedef __bf16 bf16x2v __attribute__((ext_vector_type(2)));
#define LDS_WAIT() asm volatile("s_waitcnt lgkmcnt(0)" ::: "memory")
#define VM_WAIT() asm volatile("s_waitcnt vmcnt(0)" ::: "memory")
__device__ __forceinline__ unsigned f2bf(float f) { unsigned u = __builtin_bit_cast(unsigned, f); return (u + 0x7fffu + ((u >> 16) & 1u)) >> 16; }
__device__ __forceinline__ unsigned pk2(float lo, float hi) { return f2bf(lo) | (f2bf(hi) << 16); }
__device__ __forceinline__ float bflo(unsigned u) { return __builtin_bit_cast(float, u << 16); }
__device__ __forceinline__ float bfhi(unsigned u) { return __builtin_bit_cast(float, u & 0xffff0000u); }
__device__ __forceinline__ float bf1(bf16 h) { return __builtin_bit_cast(float, (unsigned)h << 16); }
__device__ __forceinline__ float dot2bf(unsigned a, unsigned b, float acc) { return __builtin_amdgcn_fdot2_f32_bf16(__builtin_bit_cast(bf16x2v, a), __builtin_bit_cast(bf16x2v, b), acc, false); }
__device__ __forceinline__ float sigmoidf_(float x) { return 1.0f / (1.0f + __expf(-x)); }
__device__ __forceinline__ float gelu_tanh(float x) {
    const float z = 1.5957691216057308f * (x + 0.044715f * x * x * x);
    return x / (1.0f + __expf(-z));
}
__device__ __forceinline__ float wave_sum(float v) {
#pragma unroll
    for (int o = 1; o < 64; o <<= 1) v += __shfl_xor(v, o);
    return v;
}

#define XB_TMO      128
#define XB_XCNT(j)  (256  + 64 * (j))
#define XB_XSUB(j)  (1280 + 64 * (j))
#define XB_XGEN(j)  (2304 + 64 * (j))
#define XB_TOP      3328
#define XB_TOPGEN   3392
#define XCD_BAR_WORDS 3456
#define XB_SPIN_CAP (1u << 18)
__device__ __forceinline__ unsigned xb_ld(unsigned* p)              { return __hip_atomic_load(p, __ATOMIC_RELAXED, __HIP_MEMORY_SCOPE_AGENT); }
__device__ __forceinline__ unsigned xb_add(unsigned* p, unsigned v) { return __hip_atomic_fetch_add(p, v, __ATOMIC_RELAXED, __HIP_MEMORY_SCOPE_AGENT); }
__device__ __forceinline__ unsigned xb_xcc_id() { return (unsigned)__builtin_amdgcn_s_getreg((3 << 11) | 20) & 0xFu; }
#define XB_SPIN(cond, bar) do { unsigned _sp = 0; while (cond) { __builtin_amdgcn_s_sleep(1); \
    if ((++_sp & 255u) == 0u) { if (xb_ld(&(bar)[XB_TMO])) break; if (_sp > XB_SPIN_CAP) { atomicAdd(&(bar)[XB_TMO], 1u); break; } } } } while (0)
struct XcdBarrier { unsigned* bar; unsigned x; volatile LAS unsigned* st; };
__device__ __forceinline__ XcdBarrier xcd_barrier_post(unsigned* bar, volatile LAS unsigned* st) {
    XcdBarrier b; b.bar = bar; b.x = xb_xcc_id(); b.st = st;
    if (threadIdx.x == 0) (void)xb_add(&bar[XB_XCNT(b.x)], 1u);
    return b;
}
__device__ __forceinline__ void xcd_barrier_complete(unsigned* bar, unsigned x, unsigned& nloc, unsigned& nx) {
    const unsigned G = gridDim.x * gridDim.y * gridDim.z;
    unsigned sum, cnt, mine, sp = 0u;
    for (;;) {
        sum = 0u; cnt = 0u; mine = 0u;
#pragma unroll
        for (unsigned j = 0; j < 16; ++j) { const unsigned c = xb_ld(&bar[XB_XCNT(j)]); sum += c; cnt += (c > 0u) ? 1u : 0u; mine = (j == x) ? c : mine; }
        if (sum == G) break;
        __builtin_amdgcn_s_sleep(1);
        if ((++sp & 255u) == 0u) { if (xb_ld(&bar[XB_TMO])) break; if (sp > XB_SPIN_CAP) { atomicAdd(&bar[XB_TMO], 1u); break; } }
    }
    nloc = mine > 0u ? mine : 1u; nx = cnt > 0u ? cnt : 1u;
}
__device__ __forceinline__ void xcd_barrier(const XcdBarrier& b) {
    asm volatile("s_waitcnt vmcnt(0)" ::: "memory");
    __syncthreads();
    if (threadIdx.x == 0) {
        unsigned* bar = b.bar;
        __builtin_amdgcn_s_waitcnt(0);
        unsigned nloc = b.st[0], nx = b.st[1];
        if (nloc == 0u) { xcd_barrier_complete(bar, b.x, nloc, nx); b.st[0] = nloc; b.st[1] = nx; }
        const unsigned old = xb_add(&bar[XB_XSUB(b.x)], 1u);
        const unsigned gen = old / nloc;
        if (old + 1u == (gen + 1u) * nloc) {
            __builtin_amdgcn_fence(__ATOMIC_RELEASE, "agent");
            asm volatile("s_waitcnt vmcnt(0)" ::: "memory");
            const unsigned og = xb_add(&bar[XB_TOP], 1u);
            const unsigned tg = og / nx;
            if (og + 1u == (tg + 1u) * nx) xb_add(&bar[XB_TOPGEN], 1u);
            else XB_SPIN(xb_ld(&bar[XB_TOPGEN]) == tg, bar);
            __builtin_amdgcn_fence(__ATOMIC_ACQUIRE, "agent");
            xb_add(&bar[XB_XGEN(b.x)], 1u);
            asm volatile("s_waitcnt vmcnt(0)" ::: "memory");
        } else {
            XB_SPIN(xb_ld(&bar[XB_XGEN(b.x)]) == gen, bar);
            __builtin_amdgcn_fence(__ATOMIC_ACQUIRE, "agent");
            asm volatile("s_waitcnt vmcnt(0)" ::: "memory");
        }
    }
    __syncthreads();
}

typedef const __attribute__((address_space(4))) unsigned char* kaptr_t;
struct Frame { LAS unsigned char* lds; int tid, lane, wave, G, bid; kaptr_t ka; };
template <class T> __device__ __forceinline__ T* ka_ptr(const Frame& F, int byte_off) { typedef T* tp; return *(const __attribute__((address_space(4))) tp*)(F.ka + byte_off); }
__device__ __forceinline__ const float* P_x(const Frame& F) { return ka_ptr<const float>(F, 0); }
__device__ __forceinline__ const float* P_c(const Frame& F) { return ka_ptr<const float>(F, 8); }
__device__ __forceinline__ const int* P_pos(const Frame& F) { return ka_ptr<const int>(F, 16); }
__device__ __forceinline__ const float* P_w_ada(const Frame& F) { return ka_ptr<const float>(F, 24); }
__device__ __forceinline__ const float* P_b_ada(const Frame& F) { return ka_ptr<const float>(F, 32); }
__device__ __forceinline__ const float* P_norm1_g(const Frame& F) { return ka_ptr<const float>(F, 40); }
__device__ __forceinline__ const float* P_w_in(const Frame& F) { return ka_ptr<const float>(F, 48); }
__device__ __forceinline__ const float* P_conv_w(const Frame& F) { return ka_ptr<const float>(F, 56); }
__device__ __forceinline__ const float* P_conv_b(const Frame& F) { return ka_ptr<const float>(F, 64); }
__device__ __forceinline__ const float* P_ga_w(const Frame& F) { return ka_ptr<const float>(F, 72); }
__device__ __forceinline__ const float* P_ga_b(const Frame& F) { return ka_ptr<const float>(F, 80); }
__device__ __forceinline__ const float* P_gx_w(const Frame& F) { return ka_ptr<const float>(F, 88); }
__device__ __forceinline__ const float* P_gx_b(const Frame& F) { return ka_ptr<const float>(F, 96); }
__device__ __forceinline__ const float* P_lam(const Frame& F) { return ka_ptr<const float>(F, 104); }
__device__ __forceinline__ const float* P_qn_g(const Frame& F) { return ka_ptr<const float>(F, 112); }
__device__ __forceinline__ const float* P_kn_g(const Frame& F) { return ka_ptr<const float>(F, 120); }
__device__ __forceinline__ const float* P_sinks(const Frame& F) { return ka_ptr<const float>(F, 128); }
__device__ __forceinline__ const float* P_on_lru_g(const Frame& F) { return ka_ptr<const float>(F, 136); }
__device__ __forceinline__ const float* P_on_attn_g(const Frame& F) { return ka_ptr<const float>(F, 144); }
__device__ __forceinline__ const float* P_w_out(const Frame& F) { return ka_ptr<const float>(F, 152); }
__device__ __forceinline__ const float* P_norm2_g(const Frame& F) { return ka_ptr<const float>(F, 160); }
__device__ __forceinline__ const float* P_w_pq(const Frame& F) { return ka_ptr<const float>(F, 168); }
__device__ __forceinline__ const float* P_sub_keys(const Frame& F) { return ka_ptr<const float>(F, 176); }
__device__ __forceinline__ const float* P_pu(const Frame& F) { return ka_ptr<const float>(F, 184); }
__device__ __forceinline__ const float* P_pv(const Frame& F) { return ka_ptr<const float>(F, 192); }
__device__ __forceinline__ float* P_out(const Frame& F) { return ka_ptr<float>(F, 200); }
__device__ __forceinline__ unsigned char* P_ws(const Frame& F) { return ka_ptr<unsigned char>(F, 208); }
__device__ __forceinline__ float* P_ADA(const Frame& F) { return (float*)(P_ws(F) + WS_ADA); }
__device__ __forceinline__ float* P_ROPE(const Frame& F) { return (float*)(P_ws(F) + WS_ROPE); }
__device__ __forceinline__ float* P_HL(const Frame& F) { return (float*)(P_ws(F) + WS_HL); }
__device__ __forceinline__ float* P_PA(const Frame& F) { return (float*)(P_ws(F) + WS_PA); }
__device__ __forceinline__ float* P_GW(const Frame& F) { return (float*)(P_ws(F) + WS_GW); }
__device__ __forceinline__ int* P_IDX(const Frame& F) { return (int*)(P_ws(F) + WS_IDX); }
__device__ __forceinline__ bf16* P_WIN(const Frame& F) { return (bf16*)(P_ws(F) + WS_WIN); }
__device__ __forceinline__ bf16* P_WOUT(const Frame& F) { return (bf16*)(P_ws(F) + WS_WOUT); }
__device__ __forceinline__ bf16* P_WQ(const Frame& F) { return (bf16*)(P_ws(F) + WS_WQ); }
__device__ __forceinline__ bf16* P_WGA(const Frame& F) { return (bf16*)(P_ws(F) + WS_WGA); }
__device__ __forceinline__ bf16* P_WGX(const Frame& F) { return (bf16*)(P_ws(F) + WS_WGX); }
__device__ __forceinline__ bf16* P_SK(const Frame& F) { return (bf16*)(P_ws(F) + WS_SK); }
__device__ __forceinline__ unsigned char* P_U(const Frame& F) { return (unsigned char*)(P_ws(F) + WS_U); }
__device__ __forceinline__ float* P_USC(const Frame& F) { return (float*)(P_ws(F) + WS_USC); }
__device__ __forceinline__ float* P_VSC(const Frame& F) { return (float*)(P_ws(F) + WS_VSC); }
__device__ __forceinline__ unsigned char* P_V(const Frame& F) { return (unsigned char*)(P_ws(F) + WS_V); }
__device__ __forceinline__ bf16* P_XH(const Frame& F) { return (bf16*)(P_ws(F) + WS_XH); }
__device__ __forceinline__ bf16* P_PROJ(const Frame& F) { return (bf16*)(P_ws(F) + WS_PROJ); }

__device__ __forceinline__ void p0_transpose_item(const float* W, int K, int N, bf16* WT, LAS float* scr, int item, int lane) {
    const int nblk = N / 32, kb = item / nblk, nb = item % nblk, k0 = 64 * kb, n0 = 32 * nb;
#pragma unroll 8
    for (int i = 0; i < 32; ++i) { const int kk = 2 * i + (lane >> 5); scr[kk * 33 + (lane & 31)] = W[(size_t)(k0 + kk) * N + n0 + (lane & 31)]; }
    LDS_WAIT(); asm volatile("" ::: "memory");
    const int c = lane & 7;
#pragma unroll
    for (int j = 0; j < 4; ++j) { const int n = (lane >> 3) + 8 * j; const LAS float* s = scr + (8 * c) * 33 + n;
        v4u o; o.x = pk2(s[0 * 33], s[1 * 33]); o.y = pk2(s[2 * 33], s[3 * 33]); o.z = pk2(s[4 * 33], s[5 * 33]); o.w = pk2(s[6 * 33], s[7 * 33]);
        *(v4u*)(WT + (size_t)(n0 + n) * K + k0 + 8 * c) = o; }
    LDS_WAIT(); asm volatile("" ::: "memory");
}
__device__ __forceinline__ void p0_convert(const float* src, bf16* dst, size_t n8, size_t gtid, size_t gthreads) {
    for (size_t i = gtid; i < n8; i += gthreads) {
        const f32x4 a = *(const f32x4*)(src + 8 * i), b = *(const f32x4*)(src + 8 * i + 4);
        v4u o; o.x = pk2(a.x, a.y); o.y = pk2(a.z, a.w); o.z = pk2(b.x, b.y); o.w = pk2(b.z, b.w);
        *(v4u*)(dst + 8 * i) = o;
    }
}
__device__ __forceinline__ void p0_prologue(Frame& F) {
    {
        LAS float* sc = (LAS float*)F.lds;
        LAS float* red = sc + 4 * D;
        for (int i = F.tid; i < 4 * D; i += 512) { const float v = P_c(F)[i]; sc[i] = v / (1.0f + __expf(-v)); }
        __syncthreads();
        for (int cg = F.bid; cg < ADA_W / 64; cg += F.G) {
            const int n0 = cg * 64, k0 = F.wave * 256;
            const float* wp = P_w_ada(F) + (size_t)k0 * ADA_W + n0 + F.lane;
            float a0 = 0.f, a1 = 0.f, a2 = 0.f, a3 = 0.f;
#pragma unroll 16
            for (int k = 0; k < 256; ++k) { const float w = wp[(size_t)k * ADA_W]; const int kk = k0 + k;
                a0 += sc[kk] * w; a1 += sc[D + kk] * w; a2 += sc[2 * D + kk] * w; a3 += sc[3 * D + kk] * w; }
            red[(F.wave * 4 + 0) * 64 + F.lane] = a0; red[(F.wave * 4 + 1) * 64 + F.lane] = a1;
            red[(F.wave * 4 + 2) * 64 + F.lane] = a2; red[(F.wave * 4 + 3) * 64 + F.lane] = a3;
            __syncthreads();
            if (F.tid < 256) { const int b = F.tid >> 6, l = F.tid & 63; float s = 0.f;
#pragma unroll
                for (int w = 0; w < 8; ++w) s += red[(w * 4 + b) * 64 + l];
                P_ADA(F)[(size_t)b * ADA_W + n0 + l] = s + P_b_ada(F)[n0 + l]; }
            __syncthreads();
        }
        __syncthreads();
    }
    {
        LAS float* scr = (LAS float*)(F.lds + F.wave * 16384);
        const int gw = F.bid * NWAVES + F.wave, NGW = F.G * NWAVES;
        constexpr int I_IN = (D / 64) * (MIX_IN / 32), I_SQ = (D / 64) * (D / 32), I_G = (LRU_BLK / 64) * (LRU_BLK / 32);
        constexpr int NITEMS = I_IN + 2 * I_SQ + 16 * I_G;
        for (int it = gw; it < NITEMS; it += NGW) {
            int r = it;
            if (r < I_IN) { p0_transpose_item(P_w_in(F), D, MIX_IN, P_WIN(F), scr, r, F.lane); continue; } r -= I_IN;
            if (r < I_SQ) { p0_transpose_item(P_w_out(F), D, D, P_WOUT(F), scr, r, F.lane); continue; } r -= I_SQ;
            if (r < I_SQ) { p0_transpose_item(P_w_pq(F), D, D, P_WQ(F), scr, r, F.lane); continue; } r -= I_SQ;
            const int g = r / I_G, ri = r % I_G, hd = g & 7;
            if (g < 8) p0_transpose_item(P_ga_w(F) + (size_t)hd * 16384, LRU_BLK, LRU_BLK, P_WGA(F) + (size_t)hd * 16384, scr, ri, F.lane);
            else       p0_transpose_item(P_gx_w(F) + (size_t)hd * 16384, LRU_BLK, LRU_BLK, P_WGX(F) + (size_t)hd * 16384, scr, ri, F.lane);
        }
    }
    {
        const size_t gtid = (size_t)F.bid * 512 + F.tid, gth = (size_t)F.G * 512;
        p0_convert(P_sub_keys(F), P_SK(F), (size_t)PH * 2 * PKEYS * PHALF / 8, gtid, gth);
    }
    {
        const int gw = F.bid * NWAVES + F.wave, NGW = F.G * NWAVES;
        for (int rr = gw; rr < 2 * NEXP; rr += NGW) {
            const int tbl = rr >= NEXP, row = rr - tbl * NEXP;
            const float* srcp = (tbl ? P_pv(F) : P_pu(F)) + (size_t)row * D;
            unsigned char* dstp = (tbl ? P_V(F) : P_U(F)) + (size_t)row * D;
            f32x4 v[8]; float mx = 0.f;
#pragma unroll
            for (int j = 0; j < 8; ++j) { v[j] = *(const f32x4*)(srcp + 4 * F.lane + 256 * j);
                mx = fmaxf(fmaxf(mx, fmaxf(fabsf(v[j].x), fabsf(v[j].y))), fmaxf(fabsf(v[j].z), fabsf(v[j].w))); }
#pragma unroll
            for (int o = 1; o < 64; o <<= 1) mx = fmaxf(mx, __shfl_xor(mx, o));
            const float s = fmaxf(mx, 1e-30f) * (1.0f / 224.0f), inv = 1.0f / s;
#pragma unroll
            for (int j = 0; j < 8; ++j) { int t = __builtin_amdgcn_cvt_pk_fp8_f32(v[j].x * inv, v[j].y * inv, 0, false);
                t = __builtin_amdgcn_cvt_pk_fp8_f32(v[j].z * inv, v[j].w * inv, t, true);
                *(int*)(dstp + 4 * F.lane + 256 * j) = t; }
            if (F.lane == 0) (tbl ? P_VSC(F) : P_USC(F))[row] = s;
        }
    }
}

__device__ __forceinline__ void modnorm_row(const float* xrow, const float* gain, const float* shift, const float* scale, bf16* orow, int lane) {
    f32x4 v[8]; float s = 0.f;
#pragma unroll
    for (int j = 0; j < 8; ++j) { v[j] = *(const f32x4*)(xrow + 4 * lane + 256 * j); s += (v[j].x * v[j].x + v[j].y * v[j].y) + (v[j].z * v[j].z + v[j].w * v[j].w); }
    const float rstd = 1.0f / sqrtf(wave_sum(s) * (1.0f / D) + EPS);
#pragma unroll
    for (int j = 0; j < 8; ++j) {
        const int c = 4 * lane + 256 * j;
        const f32x4 g = *(const f32x4*)(gain + c), sh = *(const f32x4*)(shift + c), sc = *(const f32x4*)(scale + c);
        const f32x4 y = (v[j] * rstd) * g * (sc + 1.0f) + sh;
        v2u o; o.x = pk2(y.x, y.y); o.y = pk2(y.z, y.w);
        *(v2u*)(orow + c) = o;
    }
}
__device__ __forceinline__ void p1_phase(Frame& F) {
    const int gw = F.bid * NWAVES + F.wave, NGW = F.G * NWAVES;
    for (int m = gw; m < M; m += NGW) { const int b = m / SEQ; const float* ada = P_ADA(F) + (size_t)b * ADA_W;
        modnorm_row(P_x(F) + (size_t)m * D, P_norm1_g(F), ada, ada + D, P_XH(F) + (size_t)m * D, F.lane); }
    const float invf[8] = {1.0f, 1.9392274e-01f, 3.7606031e-02f, 7.2926646e-03f, 1.4142136e-03f, 2.7424819e-04f, 5.3182961e-05f, 1.0313386e-05f};
    for (int i = F.bid * 512 + F.tid; i < M * 8; i += F.G * 512) { const int m = i >> 3, k = i & 7;
        float f = invf[0];
#pragma unroll
        for (int q = 1; q < 8; ++q) f = (k == q) ? invf[q] : f;
        const float ang = (float)P_pos(F)[m] * f; float sn, cs; sincosf(ang, &sn, &cs);
        P_ROPE(F)[(size_t)m * 16 + k] = cs; P_ROPE(F)[(size_t)m * 16 + 8 + k] = sn; }
}
__device__ __forceinline__ void p6_phase(Frame& F) {
    const int gw = F.bid * NWAVES + F.wave, NGW = F.G * NWAVES;
    for (int m = gw; m < M; m += NGW) { const int b = m / SEQ; const float* ada = P_ADA(F) + (size_t)b * ADA_W;
        modnorm_row(P_out(F) + (size_t)m * D, P_norm2_g(F), ada + 3 * D, ada + 4 * D, P_XH(F) + (size_t)m * D, F.lane); }
}

#define MFMA32(a, b, c) __builtin_amdgcn_mfma_f32_32x32x16_bf16((a), (b), (c), 0, 0, 0)
#define MFMA16(a, b, c) __builtin_amdgcn_mfma_f32_16x16x32_bf16((a), (b), (c), 0, 0, 0)
constexpr int KS_STRIDE = 72;
constexpr int VT_STRIDE = 264;
constexpr int ATT_KS_OFF = 0, ATT_VT_OFF = 256 * KS_STRIDE * 2;
static_assert(ATT_VT_OFF + 64 * VT_STRIDE * 2 <= RING_BYTES, "attention LDS");

__device__ __forceinline__ void attn_unit(Frame& F, int b, int g, int n) {
    LAS bf16* Ks = (LAS bf16*)(F.lds + ATT_KS_OFF);
    LAS bf16* VT = (LAS bf16*)(F.lds + ATT_VT_OFF);
    const int tid = F.tid, lane = F.lane;
    {
        const int kb = tid >> 1, hf = tid & 1; const int t = n * 128 - 128 + kb;
        float kv[32]; v4u vraw[4];
        if (t >= 0) {
            const bf16* kp = P_PROJ(F) + (size_t)(b * SEQ + t) * MIX_IN + C_K + g * HD + 32 * hf;
            const bf16* vp = P_PROJ(F) + (size_t)(b * SEQ + t) * MIX_IN + C_V + g * HD + 32 * hf;
#pragma unroll
            for (int q = 0; q < 4; ++q) { const v4u r = *(const v4u*)(kp + 8 * q); vraw[q] = *(const v4u*)(vp + 8 * q);
                kv[8 * q + 0] = bflo(r.x); kv[8 * q + 1] = bfhi(r.x); kv[8 * q + 2] = bflo(r.y); kv[8 * q + 3] = bfhi(r.y);
                kv[8 * q + 4] = bflo(r.z); kv[8 * q + 5] = bfhi(r.z); kv[8 * q + 6] = bflo(r.w); kv[8 * q + 7] = bfhi(r.w); }
        } else {
#pragma unroll
            for (int q = 0; q < 4; ++q) vraw[q] = (v4u){0u, 0u, 0u, 0u};
#pragma unroll
            for (int q = 0; q < 32; ++q) kv[q] = 0.f;
        }
        float ss = 0.f;
#pragma unroll
        for (int q = 0; q < 32; ++q) ss += kv[q] * kv[q];
        ss += __shfl_xor(ss, 1);
        const float rstd = 1.0f / sqrtf(ss * (1.0f / HD) + EPS);
#pragma unroll
        for (int q = 0; q < 32; ++q) kv[q] = kv[q] * rstd * P_kn_g(F)[32 * hf + q];
        if (hf == 0 && t >= 0) {
            const float* rp = P_ROPE(F) + (size_t)(b * SEQ + t) * 16;
#pragma unroll
            for (int i = 0; i < 8; ++i) { const float cs = rp[i], sn = rp[8 + i]; const float x1 = kv[i], x2 = kv[8 + i];
                kv[i] = x1 * cs - x2 * sn; kv[8 + i] = x2 * cs + x1 * sn; }
        }
#pragma unroll
        for (int q = 0; q < 4; ++q) { v4u o; o.x = pk2(kv[8 * q], kv[8 * q + 1]); o.y = pk2(kv[8 * q + 2], kv[8 * q + 3]); o.z = pk2(kv[8 * q + 4], kv[8 * q + 5]); o.w = pk2(kv[8 * q + 6], kv[8 * q + 7]);
            *(LAS v4u*)(Ks + kb * KS_STRIDE + 32 * hf + 8 * q) = o; }
#pragma unroll
        for (int q = 0; q < 4; ++q) { const unsigned w[4] = {vraw[q].x, vraw[q].y, vraw[q].z, vraw[q].w};
#pragma unroll
            for (int e = 0; e < 4; ++e) { const int d = 32 * hf + 8 * q + 2 * e;
                VT[d * VT_STRIDE + kb] = (bf16)(w[e] & 0xffffu); VT[(d + 1) * VT_STRIDE + kb] = (bf16)(w[e] >> 16); } }
    }
    __syncthreads();
    const int hq = g * GRP + F.wave, r = lane & 31, hh = lane >> 5;
    const float sink = P_sinks(F)[hq];
    for (int qi = 0; qi < 4; ++qi) {
        const int tq = n * 128 + 32 * qi + r;
        bf16x8 qf[4];
        {
            const bf16* qp = P_PROJ(F) + (size_t)(b * SEQ + tq) * MIX_IN + C_Q + hq * HD + 8 * hh;
            float qv[4][8]; float ss = 0.f;
#pragma unroll
            for (int ks = 0; ks < 4; ++ks) { const v4u rr = *(const v4u*)(qp + 16 * ks);
                qv[ks][0] = bflo(rr.x); qv[ks][1] = bfhi(rr.x); qv[ks][2] = bflo(rr.y); qv[ks][3] = bfhi(rr.y);
                qv[ks][4] = bflo(rr.z); qv[ks][5] = bfhi(rr.z); qv[ks][6] = bflo(rr.w); qv[ks][7] = bfhi(rr.w);
#pragma unroll
                for (int j = 0; j < 8; ++j) ss += qv[ks][j] * qv[ks][j]; }
            ss += __shfl_xor(ss, 32);
            const float rstd = 1.0f / sqrtf(ss * (1.0f / HD) + EPS);
#pragma unroll
            for (int ks = 0; ks < 4; ++ks)
#pragma unroll
                for (int j = 0; j < 8; ++j) qv[ks][j] = qv[ks][j] * rstd * P_qn_g(F)[16 * ks + 8 * hh + j];
            const float* rp = P_ROPE(F) + (size_t)(b * SEQ + tq) * 16;
#pragma unroll
            for (int j = 0; j < 8; ++j) { const float mine = qv[0][j], other = __shfl_xor(mine, 32); const float cs = rp[j], sn = rp[8 + j];
                qv[0][j] = hh == 0 ? (mine * cs - other * sn) : (mine * cs + other * sn); }
#pragma unroll
            for (int ks = 0; ks < 4; ++ks) { v4u o; o.x = pk2(qv[ks][0] * 0.125f, qv[ks][1] * 0.125f); o.y = pk2(qv[ks][2] * 0.125f, qv[ks][3] * 0.125f);
                o.z = pk2(qv[ks][4] * 0.125f, qv[ks][5] * 0.125f); o.w = pk2(qv[ks][6] * 0.125f, qv[ks][7] * 0.125f); qf[ks] = __builtin_bit_cast(bf16x8, o); }
        }
        f32x16 s[5];
#pragma unroll
        for (int kj = 0; kj < 5; ++kj) {
            f32x16 acc;
#pragma unroll
            for (int i = 0; i < 16; ++i) acc[i] = 0.f;
            const LAS bf16* kp = Ks + (32 * (qi + kj) + r) * KS_STRIDE + 8 * hh;
#pragma unroll
            for (int ks = 0; ks < 4; ++ks) { const bf16x8 kf = *(const LAS bf16x8*)(kp + 16 * ks); acc = MFMA32(kf, qf[ks], acc); }
            s[kj] = acc;
        }
        float mx = sink;
#pragma unroll
        for (int kj = 0; kj < 5; ++kj)
#pragma unroll
            for (int i = 0; i < 16; ++i) { const int kt = (i & 3) + 8 * (i >> 2) + 4 * hh; const int kbi = 32 * (qi + kj) + kt;
                bool valid = (n * 128 + kbi - 128) >= 0;
                if (kj == 0) valid = valid && (kt > r);
                if (kj == 4) valid = valid && (kt <= r);
                s[kj][i] = valid ? s[kj][i] : -INFINITY; mx = fmaxf(mx, s[kj][i]); }
        mx = fmaxf(mx, __shfl_xor(mx, 32));
        float l = 0.f;
#pragma unroll
        for (int kj = 0; kj < 5; ++kj)
#pragma unroll
            for (int i = 0; i < 16; ++i) { const float p = __expf(s[kj][i] - mx); s[kj][i] = p; l += p; }
        l += __shfl_xor(l, 32);
        l += __expf(sink - mx);
        const float inv = 1.0f / l;
        f32x16 o0, o1;
#pragma unroll
        for (int i = 0; i < 16; ++i) { o0[i] = 0.f; o1[i] = 0.f; }
#pragma unroll
        for (int kj = 0; kj < 5; ++kj)
#pragma unroll
            for (int st = 0; st < 2; ++st) {
                v4u pa; pa.x = pk2(s[kj][8 * st + 0] * inv, s[kj][8 * st + 1] * inv); pa.y = pk2(s[kj][8 * st + 2] * inv, s[kj][8 * st + 3] * inv);
                pa.z = pk2(s[kj][8 * st + 4] * inv, s[kj][8 * st + 5] * inv); pa.w = pk2(s[kj][8 * st + 6] * inv, s[kj][8 * st + 7] * inv);
                const bf16x8 pf = __builtin_bit_cast(bf16x8, pa);
                const int kb0 = 32 * (qi + kj) + 16 * st + 4 * hh;
                const LAS bf16* v0p = VT + r * VT_STRIDE + kb0; const LAS bf16* v1p = VT + (32 + r) * VT_STRIDE + kb0;
                const v2u a0 = *(const LAS v2u*)v0p, a1 = *(const LAS v2u*)(v0p + 8), b0 = *(const LAS v2u*)v1p, b1 = *(const LAS v2u*)(v1p + 8);
                const v4u vb0 = {a0.x, a0.y, a1.x, a1.y}, vb1 = {b0.x, b0.y, b1.x, b1.y};
                o0 = MFMA32(pf, __builtin_bit_cast(bf16x8, vb0), o0);
                o1 = MFMA32(pf, __builtin_bit_cast(bf16x8, vb1), o1);
            }
#pragma unroll
        for (int i = 0; i < 16; ++i) { const int qr = (i & 3) + 8 * (i >> 2) + 4 * hh; const int tok = n * 128 + 32 * qi + qr;
            bf16* op = P_XH(F) + (size_t)(b * SEQ + tok) * D + LRU_W + hq * HD + r;
            op[0] = (bf16)f2bf(o0[i]); op[32] = (bf16)f2bf(o1[i]); }
    }
    __syncthreads();
}

constexpr int LCH = 64;
constexpr int XC_STRIDE = 136;
constexpr int LRU_XCB_OFF = 0, LRU_XCF_OFF = LCH * XC_STRIDE * 2  , LRU_A_OFF = LRU_XCF_OFF + LCH * 128 * 4, LRU_B_OFF = LRU_A_OFF + LCH * 128 * 4, LRU_SE_OFF = LRU_B_OFF + LCH * 128 * 4;
static_assert(LRU_SE_OFF + 2 * 4 * 128 * 4 <= RING_BYTES, "LRU LDS");
__device__ __forceinline__ void lru_unit(Frame& F, int b, int hd, int ch) {
    LAS bf16* XCb = (LAS bf16*)(F.lds + LRU_XCB_OFF);
    LAS float* XCF = (LAS float*)(F.lds + LRU_XCF_OFF);
    LAS float* As = (LAS float*)(F.lds + LRU_A_OFF);
    LAS float* Bs = (LAS float*)(F.lds + LRU_B_OFF);
    LAS float* SEh = (LAS float*)(F.lds + LRU_SE_OFF);
    LAS float* SEp = SEh + 4 * 128;
    const int tid = F.tid, lane = F.lane;
    const int c = tid & 127, sub = tid >> 7, col = hd * LRU_BLK + c;
    const int t0 = ch * LCH;
    {
        const float w0 = P_conv_w(F)[col], w1 = P_conv_w(F)[LRU_W + col], w2 = P_conv_w(F)[2 * LRU_W + col], w3 = P_conv_w(F)[3 * LRU_W + col], cb = P_conv_b(F)[col];
        const bf16* xp = P_PROJ(F) + (size_t)(b * SEQ) * MIX_IN + col;
        const int ts = t0 + sub * 16;
        float xm3 = (ts - 3 >= 0) ? bf1(xp[(size_t)(ts - 3) * MIX_IN]) : 0.f;
        float xm2 = (ts - 2 >= 0) ? bf1(xp[(size_t)(ts - 2) * MIX_IN]) : 0.f;
        float xm1 = (ts - 1 >= 0) ? bf1(xp[(size_t)(ts - 1) * MIX_IN]) : 0.f;
#pragma unroll
        for (int i = 0; i < 16; ++i) { const float x0 = bf1(xp[(size_t)(ts + i) * MIX_IN]);
            const float xc = cb + w0 * xm3 + w1 * xm2 + w2 * xm1 + w3 * x0;
            const int tl = sub * 16 + i;
            XCF[tl * 128 + c] = xc; XCb[tl * XC_STRIDE + c] = (bf16)f2bf(xc);
            xm3 = xm2; xm2 = xm1; xm1 = x0; }
    }
    __syncthreads();
    {
        const int fr = lane & 15, fq = lane >> 4, j = 16 * F.wave + fr, jc = hd * LRU_BLK + j;
        bf16x8 wa[4], wx[4];
        const bf16* wap = P_WGA(F) + (size_t)hd * 16384 + (size_t)j * 128 + 8 * fq;
        const bf16* wxp = P_WGX(F) + (size_t)hd * 16384 + (size_t)j * 128 + 8 * fq;
#pragma unroll
        for (int ks = 0; ks < 4; ++ks) { wa[ks] = *(const bf16x8*)(wap + 32 * ks); wx[ks] = *(const bf16x8*)(wxp + 32 * ks); }
        const float ba = P_ga_b(F)[jc], bx = P_gx_b(F)[jc];
        const float lamv = P_lam(F)[jc];
        const float sp = log1pf(__expf(-lamv));
#pragma unroll
        for (int mt = 0; mt < 4; ++mt) {
            f32x4 ra = {0.f, 0.f, 0.f, 0.f}, rx = {0.f, 0.f, 0.f, 0.f};
            const LAS bf16* ap = XCb + (16 * mt + fr) * XC_STRIDE + 8 * fq;
#pragma unroll
            for (int ks = 0; ks < 4; ++ks) { const bf16x8 af = *(const LAS bf16x8*)(ap + 32 * ks); ra = MFMA16(af, wa[ks], ra); rx = MFMA16(af, wx[ks], rx); }
#pragma unroll
            for (int e = 0; e < 4; ++e) { const int tl = 16 * mt + 4 * fq + e;
                const float rg = sigmoidf_(ra[e] + ba), ig = sigmoidf_(rx[e] + bx);
                const float la = -8.0f * rg * sp; const float a = __expf(la);
                const float mult = sqrtf(-expm1f(2.0f * la));
                As[tl * 128 + j] = a; Bs[tl * 128 + j] = mult * ig * XCF[tl * 128 + j]; }
        }
    }
    __syncthreads();
    {
        float h = 0.f, P = 1.f;
#pragma unroll
        for (int i = 0; i < 16; ++i) { const int tl = sub * 16 + i; const float a = As[tl * 128 + c], bq = Bs[tl * 128 + c];
            h = a * h + bq; P *= a; Bs[tl * 128 + c] = h; As[tl * 128 + c] = P; }
        SEh[sub * 128 + c] = h; SEp[sub * 128 + c] = P;
    }
    __syncthreads();
    {
        float carry = 0.f, pp = 1.f;
        for (int s2 = 0; s2 < sub; ++s2) { carry = SEh[s2 * 128 + c] + SEp[s2 * 128 + c] * carry; pp *= SEp[s2 * 128 + c]; }
        float* hl = P_HL(F) + (size_t)(b * SEQ + t0 + sub * 16) * LRU_W + col;
        float* pa = P_PA(F) + (size_t)(b * SEQ + t0 + sub * 16) * LRU_W + col;
#pragma unroll
        for (int i = 0; i < 16; ++i) { const int tl = sub * 16 + i;
            hl[(size_t)i * LRU_W] = Bs[tl * 128 + c] + As[tl * 128 + c] * carry; pa[(size_t)i * LRU_W] = As[tl * 128 + c] * pp; }
    }
    __syncthreads();
}
constexpr int N_ATT_UNITS = BATCH * HKV * (SEQ / 128);
constexpr int N_LRU_UNITS = BATCH * LRU_HEADS * (SEQ / LCH);
__device__ __forceinline__ void p3_phase(Frame& F) {
    for (int u = F.bid; u < N_ATT_UNITS + N_LRU_UNITS; u += F.G) {
        if (u < N_ATT_UNITS) attn_unit(F, u >> 6, (u >> 5) & 1, u & 31);
        else { const int v = u - N_ATT_UNITS; lru_unit(F, v >> 9, (v >> 6) & 7, v & 63); }
    }
}

__device__ __forceinline__ void p4_unit(Frame& F, int b, int ch) {
    LAS float* CAR = (LAS float*)F.lds;
    const int tid = F.tid, lane = F.lane;
    {
        f32x2 carry = {0.f, 0.f};
        for (int c2 = 0; c2 < ch; ++c2) { const size_t row = (size_t)(b * SEQ + c2 * LCH + LCH - 1) * LRU_W + 2 * tid;
            const f32x2 hl = *(const f32x2*)(P_HL(F) + row), pa = *(const f32x2*)(P_PA(F) + row);
            carry = hl + pa * carry; }
        CAR[2 * tid] = carry.x; CAR[2 * tid + 1] = carry.y;
    }
    __syncthreads();
    for (int i = 0; i < 8; ++i) {
        const size_t m = (size_t)b * SEQ + ch * LCH + F.wave * 8 + i;
        f32x4 val[4]; float ss = 0.f;
#pragma unroll
        for (int j = 0; j < 4; ++j) { const int c = 4 * lane + 256 * j;
            const f32x4 hl = *(const f32x4*)(P_HL(F) + m * LRU_W + c), pa = *(const f32x4*)(P_PA(F) + m * LRU_W + c), car = *(const LAS f32x4*)(CAR + c);
            const v2u yr = *(const v2u*)(P_PROJ(F) + m * MIX_IN + C_Y + c);
            const f32x4 h = hl + pa * car;
            f32x4 v; v.x = h.x * gelu_tanh(bflo(yr.x)); v.y = h.y * gelu_tanh(bfhi(yr.x)); v.z = h.z * gelu_tanh(bflo(yr.y)); v.w = h.w * gelu_tanh(bfhi(yr.y));
            val[j] = v; ss += (v.x * v.x + v.y * v.y) + (v.z * v.z + v.w * v.w); }
        float rstd = 1.0f / sqrtf(wave_sum(ss) * (1.0f / LRU_W) + EPS);
#pragma unroll
        for (int j = 0; j < 4; ++j) { const int c = 4 * lane + 256 * j; const f32x4 g = *(const f32x4*)(P_on_lru_g(F) + c); const f32x4 y = val[j] * rstd * g;
            v2u o; o.x = pk2(y.x, y.y); o.y = pk2(y.z, y.w); *(v2u*)(P_XH(F) + m * D + c) = o; }
        ss = 0.f;
#pragma unroll
        for (int j = 0; j < 4; ++j) { const int c = 4 * lane + 256 * j; const v2u ar = *(const v2u*)(P_XH(F) + m * D + LRU_W + c);
            f32x4 v; v.x = bflo(ar.x); v.y = bfhi(ar.x); v.z = bflo(ar.y); v.w = bfhi(ar.y); val[j] = v; ss += (v.x * v.x + v.y * v.y) + (v.z * v.z + v.w * v.w); }
        rstd = 1.0f / sqrtf(wave_sum(ss) * (1.0f / LRU_W) + EPS);
#pragma unroll
        for (int j = 0; j < 4; ++j) { const int c = 4 * lane + 256 * j; const f32x4 g = *(const f32x4*)(P_on_attn_g(F) + c); const f32x4 y = val[j] * rstd * g;
            v2u o; o.x = pk2(y.x, y.y); o.y = pk2(y.z, y.w); *(v2u*)(P_XH(F) + m * D + LRU_W + c) = o; }
    }
    __syncthreads();
}
__device__ __forceinline__ void p4_phase(Frame& F) {
    for (int u = F.bid; u < BATCH * (SEQ / LCH); u += F.G) p4_unit(F, u >> 6, u & 63);
}

__device__ __forceinline__ int f2key(float f) { const int b = __builtin_bit_cast(int, f); return b ^ ((b >> 31) & 0x7fffffff); }
__device__ __forceinline__ float key2f(int k) { const int b = k ^ ((k >> 31) & 0x7fffffff); return __builtin_bit_cast(float, b); }
__device__ __forceinline__ void ins16(int (&L)[16], int x) {
#pragma unroll
    for (int j = 0; j < 16; ++j) { const int hi = max(L[j], x); x = min(L[j], x); L[j] = hi; }
}
constexpr int INT_LOWEST = (int)0x80000000;
__device__ __forceinline__ void p8_item(Frame& F, int tt, int hd, LAS int* lut  ) {
    const int lane = F.lane, r = lane & 31, hh = lane >> 5;
    const bf16* QP = P_PROJ(F);
    int V[2][16];
#pragma unroll
    for (int p = 0; p < 2; ++p) {
        bf16x8 qf[8];
        const char* qb = (const char*)(QP + (size_t)(32 * tt) * D + hd * 256 + p * 128);
        const unsigned qoff = (unsigned)(r * D + 8 * hh) * 2u;
#pragma unroll
        for (int ks = 0; ks < 8; ++ks) qf[ks] = *(const bf16x8*)(qb + qoff + 32 * ks);
        int L[16];
#pragma unroll
        for (int j = 0; j < 16; ++j) L[j] = INT_LOWEST;
        const char* skb = (const char*)(P_SK(F) + (size_t)((hd * 2 + p) * PKEYS) * PHALF);
        const unsigned skoff = (unsigned)(r * PHALF + 8 * hh) * 2u;
#pragma unroll 1
        for (int kt = 0; kt < 4; ++kt) {
            f32x16 acc;
#pragma unroll
            for (int i = 0; i < 16; ++i) acc[i] = 0.f;
            const char* skt = skb + (size_t)(32 * kt) * PHALF * 2;
#pragma unroll
            for (int ks = 0; ks < 8; ++ks) { const bf16x8 kf = *(const bf16x8*)(skt + skoff + 32 * ks); acc = MFMA32(kf, qf[ks], acc); }
            const int kbase = 32 * kt + 4 * hh;
#pragma unroll
            for (int i = 0; i < 16; ++i) { const int kidx = (i & 3) + 8 * (i >> 2);
                const int key = (f2key(acc[i]) & ~0x7f) | (kbase + kidx);
                ins16(L, key); }
        }
        int O[16];
#pragma unroll
        for (int j = 0; j < 16; ++j) O[j] = __shfl_xor(L[j], 32);
#pragma unroll
        for (int j = 0; j < 16; ++j) ins16(L, O[j]);
#pragma unroll
        for (int j = 0; j < 16; ++j) V[p][j] = L[j];
    }
#pragma unroll
    for (int j = 0; j < 16; ++j) { lut[lane * 33 + j] = V[0][j] & 0x7f; lut[lane * 33 + 16 + j] = V[1][j] & 0x7f; }
    float v0[16], v1[16];
#pragma unroll
    for (int j = 0; j < 16; ++j) { v0[j] = key2f(V[0][j] & ~0x7f); v1[j] = key2f(V[1][j] & ~0x7f); }
    int C[16];
#pragma unroll
    for (int j = 0; j < 16; ++j) C[j] = INT_LOWEST;
#pragma unroll
    for (int i = 0; i < 16; ++i)
#pragma unroll
        for (int j = 0; j < 16; ++j)
            if ((i + 1) * (j + 1) <= 16) { const int key = (f2key(v0[i] + v1[j]) & ~0xff) | (i * 16 + j); ins16(C, key); }
    float sv[16]; float den = 0.f;
    const float mx = key2f(C[0] & ~0xff);
#pragma unroll
    for (int e = 0; e < 16; ++e) { sv[e] = __expf(key2f(C[e] & ~0xff) - mx); den += sv[e]; }
    const float inv = 1.0f / den;
    LDS_WAIT(); asm volatile("" ::: "memory");
    int idx[16];
#pragma unroll
    for (int e = 0; e < 16; ++e) { const int pi = (C[e] >> 4) & 15, pj = C[e] & 15; idx[e] = lut[lane * 33 + pi] * PKEYS + lut[lane * 33 + 16 + pj]; }
    if (hh == 0) {
        int* ip = P_IDX(F) + (size_t)(32 * tt + r) * 128 + hd * 16; float* gp = P_GW(F) + (size_t)(32 * tt + r) * 128 + hd * 16;
#pragma unroll
        for (int q = 0; q < 4; ++q) { *(v4u*)(ip + 4 * q) = (v4u){(unsigned)idx[4 * q], (unsigned)idx[4 * q + 1], (unsigned)idx[4 * q + 2], (unsigned)idx[4 * q + 3]};
            *(f32x4*)(gp + 4 * q) = (f32x4){sv[4 * q] * inv, sv[4 * q + 1] * inv, sv[4 * q + 2] * inv, sv[4 * q + 3] * inv}; }
    }
    LDS_WAIT(); asm volatile("" ::: "memory");
}
__device__ __forceinline__ void p8_phase(Frame& F) {
    LAS int* lut = (LAS int*)(F.lds + F.wave * (64 * 33 * 4));
    const int gw = F.bid * NWAVES + F.wave, NGW = F.G * NWAVES;
    for (int it = gw; it < (M / 32) * PH; it += NGW) p8_item(F, it >> 3, it & 7, lut);
}

__device__ __forceinline__ void p9_token(Frame& F, int m, bool dry) {
    const int lane = F.lane;
    float h2[32];
    {
        const bf16* hp = P_XH(F) + (size_t)m * D + 16 * lane;
#pragma unroll
        for (int j = 0; j < 2; ++j)
#pragma unroll
            for (int q = 0; q < 2; ++q) { const v4u r = *(const v4u*)(hp + 1024 * j + 8 * q); const int o = 16 * j + 8 * q;
                h2[o] = bflo(r.x); h2[o + 1] = bfhi(r.x); h2[o + 2] = bflo(r.y); h2[o + 3] = bfhi(r.y); h2[o + 4] = bflo(r.z); h2[o + 5] = bfhi(r.z); h2[o + 6] = bflo(r.w); h2[o + 7] = bfhi(r.w); }
    }
    const int ix0 = P_IDX(F)[(size_t)m * 128 + lane], ix1 = P_IDX(F)[(size_t)m * 128 + 64 + lane];
    const float gw0 = P_GW(F)[(size_t)m * 128 + lane], gw1 = P_GW(F)[(size_t)m * 128 + 64 + lane];
    const unsigned char* U8 = P_U(F); const unsigned char* V8 = P_V(F);
    const float* USC = P_USC(F); const float* VSC = P_VSC(F);
    float acc[32];
#pragma unroll
    for (int e = 0; e < 32; ++e) acc[e] = 0.f;
    const int myp = (lane >> 4) & 3;
    const unsigned loff = 16u * (unsigned)lane;
#pragma unroll 1
    for (int g = 0; g < 32; ++g) {
        const int ixv = (g < 16) ? ix0 : ix1; const float gwv = (g < 16) ? gw0 : gw1; const int lbase = (4 * g) & 63;
        const int myidx = __shfl(ixv, lbase + myp); const float mygw = __shfl(gwv, lbase + myp);
        const float us = USC[myidx], vs = VSC[myidx];
        v4u ur[4][2], vr[4][2];
#pragma unroll
        for (int k = 0; k < 4; ++k) { const int id = __builtin_amdgcn_readlane(ixv, lbase + k);
            const unsigned char* up = U8 + (size_t)id * D; const unsigned char* vp = V8 + (size_t)id * D;
            ur[k][0] = *(const v4u*)(up + loff); ur[k][1] = *(const v4u*)(up + loff + 1024); vr[k][0] = *(const v4u*)(vp + loff); vr[k][1] = *(const v4u*)(vp + loff + 1024); }
        float d[4];
#pragma unroll
        for (int k = 0; k < 4; ++k) { float a0 = 0.f, a1 = 0.f, a2 = 0.f, a3 = 0.f;
#pragma unroll
            for (int j = 0; j < 2; ++j) { const unsigned w4[4] = {ur[k][j].x, ur[k][j].y, ur[k][j].z, ur[k][j].w};
#pragma unroll
                for (int w = 0; w < 4; ++w) { const f32x2 lo = __builtin_amdgcn_cvt_pk_f32_fp8((int)w4[w], false), hi = __builtin_amdgcn_cvt_pk_f32_fp8((int)w4[w], true); const int o = 16 * j + 4 * w;
                    a0 = fmaf(lo.x, h2[o], a0); a1 = fmaf(lo.y, h2[o + 1], a1); a2 = fmaf(hi.x, h2[o + 2], a2); a3 = fmaf(hi.y, h2[o + 3], a3); } }
            d[k] = (a0 + a1) + (a2 + a3); }
        float r2[2], r1;
        { const bool up = (lane & 32) != 0;
#pragma unroll
          for (int i = 0; i < 2; ++i) { const float send = up ? d[i] : d[2 + i], keep = up ? d[2 + i] : d[i]; r2[i] = keep + __shfl_xor(send, 32); } }
        { const bool up = (lane & 16) != 0; const float send = up ? r2[0] : r2[1], keep = up ? r2[1] : r2[0]; r1 = keep + __shfl_xor(send, 16); }
        r1 += __shfl_xor(r1, 8); r1 += __shfl_xor(r1, 4); r1 += __shfl_xor(r1, 2); r1 += __shfl_xor(r1, 1);
        const float wl = mygw * gelu_tanh(r1 * us) * vs;
#pragma unroll
        for (int k = 0; k < 4; ++k) { const float wk = __builtin_bit_cast(float, __builtin_amdgcn_readlane(__builtin_bit_cast(int, wl), 16 * k));
#pragma unroll
            for (int j = 0; j < 2; ++j) { const unsigned w4[4] = {vr[k][j].x, vr[k][j].y, vr[k][j].z, vr[k][j].w};
#pragma unroll
                for (int w = 0; w < 4; ++w) { const f32x2 lo = __builtin_amdgcn_cvt_pk_f32_fp8((int)w4[w], false), hi = __builtin_amdgcn_cvt_pk_f32_fp8((int)w4[w], true); const int o = 16 * j + 4 * w;
                    acc[o] = fmaf(lo.x, wk, acc[o]); acc[o + 1] = fmaf(lo.y, wk, acc[o + 1]); acc[o + 2] = fmaf(hi.x, wk, acc[o + 2]); acc[o + 3] = fmaf(hi.y, wk, acc[o + 3]); } } }
    }
    const int b = m / SEQ; const float* g2 = P_ADA(F) + (size_t)b * ADA_W + 5 * D + 16 * lane;
    float* op = P_out(F) + (size_t)m * D + 16 * lane;
#pragma unroll
    for (int j = 0; j < 2; ++j)
#pragma unroll
        for (int q = 0; q < 4; ++q) { const f32x4 x1 = *(const f32x4*)(op + 1024 * j + 4 * q); const f32x4 gv = *(const f32x4*)(g2 + 1024 * j + 4 * q);
            const f32x4 a = {acc[16 * j + 4 * q], acc[16 * j + 4 * q + 1], acc[16 * j + 4 * q + 2], acc[16 * j + 4 * q + 3]};
            if (!dry) *(f32x4*)(op + 1024 * j + 4 * q) = x1 + gv * a; else asm volatile("" :: "v"(a[0] + a[1] + a[2] + a[3])); }
}
__device__ __forceinline__ void p9_phase(Frame& F, bool dry) {
    const int gw = F.bid * NWAVES + F.wave, NGW = F.G * NWAVES;
    for (int m = gw; m < M; m += NGW) p9_token(F, m, dry);
}

struct Args { const void* in[25]; float* out; unsigned char* ws; int ph_lo, ph_hi; };
__global__ void __launch_bounds__(NWAVES * 64, 2) hymba_fwd(Args args) {
    extern __shared__ __attribute__((aligned(16))) unsigned char lds_raw[];
    Frame F;
    F.lds = (LAS unsigned char*)lds_raw;
    F.tid = threadIdx.x; F.lane = F.tid & 63; F.wave = __builtin_amdgcn_readfirstlane(F.tid >> 6);
    F.G = gridDim.x; F.bid = blockIdx.x;
    F.ka = (kaptr_t)__builtin_amdgcn_kernarg_segment_ptr();
    static_assert(sizeof(Args) == 224, "kernarg byte offsets used by ka_ptr");
    for (int u = F.tid; u < (LDS_BYTES - LDSCTL_OFF) / 4; u += NWAVES * 64) ((LAS unsigned*)(F.lds + LDSCTL_OFF))[u] = 0u;
    __syncthreads();
    volatile LAS unsigned* MISC = (volatile LAS unsigned*)(F.lds + MISC_OFF);
    XcdBarrier bar; bar.bar = (unsigned*)(P_ws(F) + WS_CTL) + CW_BAR; bar.x = 0; bar.st = nullptr;
    const int lo = args.ph_lo, hi = args.ph_hi;
    if (hi - lo > 1) bar = xcd_barrier_post((unsigned*)(P_ws(F) + WS_CTL) + CW_BAR, MISC + 8);
#define IN(k) (lo <= (k) && (k) < hi)
#define SEAM(k) do { if (IN(k) && IN((k) + 1)) xcd_barrier(bar); } while (0)

#ifndef PROBE_MASK
#define PROBE_MASK 0
#endif
#define REP(k) for (int rep_ = 0; rep_ < (((PROBE_MASK >> (k)) & 1) ? 2 : 1); ++rep_)
#define REPSYNC(k) do { if (((PROBE_MASK >> (k)) & 1) && rep_ == 0) xcd_barrier(bar); } while (0)
    if (IN(0)) { REP(0) { p0_prologue(F); REPSYNC(0); } } SEAM(0);
    if (IN(1)) { REP(1) { p1_phase(F); REPSYNC(1); } } SEAM(1);
    if (IN(2)) REP(2) {
        pg8::Gemm g{P_XH(F), P_WIN(F), M, MIX_IN, D}; pg8::StaticOrder S; S.init(M, MIX_IN, F.G, F.bid);
        pg8::EpiStoreBf16 E{P_PROJ(F), MIX_IN};
        pg8::gemm_phase<pg8::EpiStoreBf16, pg8::StaticOrder, true, true>(F.lds, g, S, E); REPSYNC(2);
    } SEAM(2);
    if (IN(3)) { REP(3) { p3_phase(F); REPSYNC(3); } } SEAM(3);
    if (IN(4)) { p4_phase(F); } SEAM(4);
    if (IN(5)) REP(5) {
        pg8::Gemm g{P_XH(F), P_WOUT(F), M, D, D}; pg8::StaticOrder S; S.init(M, D, F.G, F.bid);
        pg8::EpiResid E{P_x(F), P_out(F), D, P_ADA(F) + 2 * D, ADA_W, SEQ};
        pg8::gemm_phase<pg8::EpiResid, pg8::StaticOrder, true, true>(F.lds, g, S, E); REPSYNC(5);
    } SEAM(5);
    if (IN(6)) { REP(6) { p6_phase(F); REPSYNC(6); } } SEAM(6);
    if (IN(7)) REP(7) {
        pg8::Gemm g{P_XH(F), P_WQ(F), M, D, D}; pg8::StaticOrder S; S.init(M, D, F.G, F.bid);
        pg8::EpiStoreBf16 E{P_PROJ(F), D};
        pg8::gemm_phase<pg8::EpiStoreBf16, pg8::StaticOrder, true, true>(F.lds, g, S, E); REPSYNC(7);
    } SEAM(7);
    if (IN(8)) { REP(8) { p8_phase(F); REPSYNC(8); } } SEAM(8);
    if (IN(9)) { REP(9) { p9_phase(F, ((PROBE_MASK >> 9) & 1) && rep_ == 0); REPSYNC(9); } }
#undef IN
#undef SEAM
}

extern "C" void kernel_launch(void* const* d_in, const int* in_sizes, int n_in, void* d_out, int out_size, void* d_ws, size_t ws_size, hipStream_t stream) {
    static int grid = 0;
    if (grid == 0) {
        if (n_in != 25 || in_sizes[0] != M * D || out_size != M * D || ws_size < WS_END) {
            fprintf(stderr, "kernel_launch: built for 25 inputs, x/out of %d floats, >= %zu bytes of workspace; got n_in %d, in0 %d, out %d, ws %zu; nothing launched\n", M * D, (size_t)WS_END, n_in, n_in > 0 ? in_sizes[0] : -1, out_size, ws_size);
            grid = -1; return; }
        int dev = 0, cus = 0, per_cu = 0;
        if (hipGetDevice(&dev) != hipSuccess || hipDeviceGetAttribute(&cus, hipDeviceAttributeMultiprocessorCount, dev) != hipSuccess) { fprintf(stderr, "kernel_launch: device query failed\n"); grid = -1; return; }
        if (hipFuncSetAttribute((const void*)hymba_fwd, hipFuncAttributeMaxDynamicSharedMemorySize, LDS_BYTES) != hipSuccess) { fprintf(stderr, "kernel_launch: hipFuncSetAttribute failed\n"); grid = -1; return; }
        if (hipOccupancyMaxActiveBlocksPerMultiprocessor(&per_cu, (const void*)hymba_fwd, NWAVES * 64, LDS_BYTES) != hipSuccess || per_cu < 1) {
            fprintf(stderr, "kernel_launch: occupancy query reports %d workgroups per CU; need 1\n", per_cu); (void)hipGetLastError(); grid = -1; return; }
        grid = cus;
    }
    if (grid < 0) return;
    if (hipMemsetAsync((char*)d_ws + WS_CTL, 0, CTL_ZERO_BYTES, stream) != hipSuccess) { fprintf(stderr, "kernel_launch: memset failed\n"); return; }
    Args a{};
    for (int i = 0; i < 25; ++i) a.in[i] = d_in[i];
    a.out = (float*)d_out; a.ws = (unsigned char*)d_ws;
    if (N_LAUNCHES == 1) {
        a.ph_lo = 0; a.ph_hi = N_PHASES;
        void* kargs[] = {&a};
        const hipError_t le = hipLaunchCooperativeKernel((const void*)hymba_fwd, dim3(grid), dim3(NWAVES * 64), kargs, LDS_BYTES, stream);
        if (le != hipSuccess) fprintf(stderr, "kernel_launch: cooperative launch failed: %s (grid %d)\n", hipGetErrorName(le), grid);
    } else {
        for (int li = 0; li < N_PHASES; ++li) { a.ph_lo = li; a.ph_hi = li + 1;
            hipLaunchKernelGGL(hymba_fwd, dim3(grid), dim3(NWAVES * 64), LDS_BYTES, stream, a);
            const hipError_t le = hipPeekAtLastError();
            if (le != hipSuccess) { fprintf(stderr, "kernel_launch: launch %d failed: %s\n", li, hipGetErrorName(le)); break; } }
    }
}
```

```cpp
#include <hip/hip_runtime.h>
#include <cstdio>
#include <cstdint>
namespace pg8 {
#define PG8_LAS __attribute__((address_space(3)))
typedef unsigned short bf16_t;
typedef short bf16x8 __attribute__((ext_vector_type(8)));
typedef float f32x4 __attribute__((ext_vector_type(4)));
typedef unsigned u32x4 __attribute__((ext_vector_type(4)));
constexpr int BM = 256, BK = 64, HALF = 128, HTB = HALF * BK * 2  , STAGE_BYTES = 8 * HTB, NXCD = 8, WGM = 8;

__host__ __device__ __forceinline__ int lds_byte(int r, int c) { const int st = (r >> 4) * 2 + (c >> 5), rr = r & 15, cc = c & 31, ob = rr * 64 + cc * 2; return st * 1024 + (ob ^ (((ob >> 9) & 1) << 5)); }
__host__ __device__ __forceinline__ void stage_rc(int b, int& R, int& C) { const int st = b / 1024, sb = b % 1024, swz = sb ^ (((sb >> 9) & 1) << 5); R = (st >> 1) * 16 + swz / 64; C = (st & 1) * 32 + (swz % 64) / 2; }
__host__ __device__ __forceinline__ int perm32(int rho) { const int n = rho >> 4, i = rho & 15; return 8 * (i >> 2) + 4 * n + (i & 3); }

struct Unit { int pm, pn; };
struct Gemm { const bf16_t* A; const bf16_t* Bt; int M, N, K; };

struct StaticOrder {
    int nM, nN, nwg, G, c;
    __host__ __device__ void init(int M, int N, int G_, int c_) { nM = M / BM; nN = N / BM; nwg = nM * nN; G = G_; c = c_; }
    __host__ __device__ bool next(int i, Unit& u) const {
        const long L = (long)i * G + c; if (L >= nwg) return false;
        int wgid = (int)L; { const int q = nwg / NXCD, r = nwg % NXCD, xcd = wgid % NXCD, off = wgid / NXCD; wgid = (xcd < r ? xcd * (q + 1) : r * (q + 1) + (xcd - r) * q) + off; }
        const int nig = WGM * nN, gid = wgid / nig, fm = gid * WGM, gsz = (nM - fm) < WGM ? (nM - fm) : WGM;
        u.pm = fm + ((wgid % nig) % gsz); u.pn = (wgid % nig) / gsz; return true;
    }
    __device__ __forceinline__ void a_ready(const Unit&) const {}
    __device__ __forceinline__ void done(const Unit&) const {}
};

__device__ __forceinline__ unsigned cvt_pk_bf16(float lo, float hi) { unsigned r; asm volatile("v_cvt_pk_bf16_f32 %0, %1, %2" : "=v"(r) : "v"(lo), "v"(hi)); return r; }
struct EpiStoreBf16 {
    static constexpr bool PERM = true, AFTER_DRAIN = false;
    bf16_t* O; int ldc;
    __device__ __forceinline__ void operator()(const f32x4 (&acc)[2][2][4][2], const Unit& u, int wr, int wc, int fr, int fq) const {
        const int row0 = u.pm * BM + wr * 64 + fr; const int col0 = u.pn * BM + wc * 32 + 8 * fq;
#pragma unroll
        for (int ai = 0; ai < 2; ++ai)
#pragma unroll
            for (int m = 0; m < 4; ++m) { bf16_t* rowp = O + (size_t)(row0 + ai * HALF + m * 16) * ldc + col0;
#pragma unroll
                for (int bj = 0; bj < 2; ++bj) { const f32x4 v0 = acc[ai][bj][m][0], v1 = acc[ai][bj][m][1];
                    u32x4 w; w.x = cvt_pk_bf16(v0[0], v0[1]); w.y = cvt_pk_bf16(v0[2], v0[3]); w.z = cvt_pk_bf16(v1[0], v1[1]); w.w = cvt_pk_bf16(v1[2], v1[3]);
                    *(u32x4*)(rowp + bj * HALF) = w; } }
    }
};
struct EpiResid {
    static constexpr bool PERM = false, AFTER_DRAIN = false;
    const float* base; float* out; int ldc; const float* gate; int gstride; int rows_per_batch;
    __device__ __forceinline__ void operator()(const f32x4 (&acc)[2][2][4][2], const Unit& u, int wr, int wc, int fr, int fq) const {
        const int b = (u.pm * BM) / rows_per_batch; const float* g = gate + (size_t)b * gstride;
        const int col0 = u.pn * BM + wc * 32 + 4 * fq;
        f32x4 gv[2][2];
#pragma unroll
        for (int bj = 0; bj < 2; ++bj)
#pragma unroll
            for (int n = 0; n < 2; ++n) gv[bj][n] = *(const f32x4*)(g + col0 + bj * HALF + n * 16);
#pragma unroll
        for (int ai = 0; ai < 2; ++ai)
#pragma unroll
            for (int m = 0; m < 4; ++m) { const size_t off = (size_t)(u.pm * BM + ai * HALF + wr * 64 + m * 16 + fr) * ldc + col0;
#pragma unroll
                for (int bj = 0; bj < 2; ++bj)
#pragma unroll
                    for (int n = 0; n < 2; ++n) { const f32x4 bs = *(const f32x4*)(base + off + bj * HALF + n * 16);
                        *(f32x4*)(out + off + bj * HALF + n * 16) = bs + gv[bj][n] * acc[ai][bj][m][n]; }
                if (m & 1) asm volatile("" ::: "memory"); }
    }
};

template <class Epi, class Sched, bool ALIGN_EPI = false, bool SP2 = false>
__device__ __forceinline__ void gemm_phase(PG8_LAS unsigned char* lds, const Gemm g, const Sched& S, const Epi& E) {
    const int tid = threadIdx.x, wid = __builtin_amdgcn_readfirstlane(tid >> 6), lane = tid & 63, wr = wid >> 2, wc = wid & 3, fr = lane & 15, fq = lane >> 4;
    const int K = g.K, nt = K / BK;
    unsigned voffA[2], voffB[2];
#pragma unroll
    for (int i = 0; i < 2; ++i) { int R, C; stage_rc(tid * 16 + i * 8192, R, C); const int Rb = Epi::PERM ? ((R & ~31) + perm32(R & 31)) : R;
        voffA[i] = (unsigned)(R * K + C) * 2u; voffB[i] = (unsigned)(Rb * K + C) * 2u; }
    const size_t kstep = (size_t)(BK * 2);
    const size_t hstep = (size_t)HALF * K * 2;
    const size_t tstep = 2 * hstep;
    const unsigned ldsw = (unsigned)wid * 1024u;
    const int aoff = lds_byte(wr * 64 + fr, fq * 8), boff = lds_byte(wc * 32 + fr, fq * 8);
#define PG8_SA(b, h) (((b) * 2 + (h)) * HTB)
#define PG8_SB(b, h) ((4 + (b) * 2 + (h)) * HTB)
#define PG8_STAGE(bufoff, gbase, voff) do { _Pragma("unroll") for (int _i = 0; _i < 2; ++_i) \
        __builtin_amdgcn_global_load_lds((const unsigned*)((const char*)(gbase) + (voff)[_i]), (PG8_LAS unsigned*)(lds + (bufoff) + ldsw + _i * 8192), 16, 0, 0); } while (0)
#define PG8_LDA(dst, b, h) do { _Pragma("unroll") for (int m = 0; m < 4; ++m) _Pragma("unroll") for (int k = 0; k < 2; ++k) dst[m][k] = *(const PG8_LAS bf16x8*)(lds + PG8_SA(b, h) + aoff + m * 2048 + k * 1024); } while (0)
#define PG8_LDB(dst, b, h) do { _Pragma("unroll") for (int n = 0; n < 2; ++n) _Pragma("unroll") for (int k = 0; k < 2; ++k) dst[n][k] = *(const PG8_LAS bf16x8*)(lds + PG8_SB(b, h) + boff + n * 2048 + k * 1024); } while (0)
#define PG8_MMA(ai, bj, At, Bt) do { __builtin_amdgcn_s_setprio(1); _Pragma("unroll") for (int m = 0; m < 4; ++m) _Pragma("unroll") for (int n = 0; n < 2; ++n) _Pragma("unroll") for (int k = 0; k < 2; ++k) \
        acc[ai][bj][m][n] = __builtin_amdgcn_mfma_f32_16x16x32_bf16(Bt[n][k], At[m][k], acc[ai][bj][m][n], 0, 0, 0); __builtin_amdgcn_s_setprio(0); } while (0)
#define PG8_WAIT_V(n) asm volatile("s_waitcnt vmcnt(" #n ")" ::: "memory")
#define PG8_WAIT_L(n) asm volatile("s_waitcnt lgkmcnt(" #n ")" ::: "memory")
#define PG8_BAR __builtin_amdgcn_s_barrier()
#define PG8_SCHED __builtin_amdgcn_sched_barrier(0)
    Unit cur, nxt; int ui = 0;
    if (!S.next(0, cur)) return;
    f32x4 acc[2][2][4][2];
#pragma unroll
    for (int a = 0; a < 2; ++a)
#pragma unroll
        for (int b = 0; b < 2; ++b)
#pragma unroll
            for (int m = 0; m < 4; ++m)
#pragma unroll
                for (int n = 0; n < 2; ++n) acc[a][b][m][n] = (f32x4){0.f, 0.f, 0.f, 0.f};
    bf16x8 At[4][2], B0[2][2], B1[2][2];
    const char* cA = (const char*)g.A + (size_t)cur.pm * tstep; const char* cB = (const char*)g.Bt + (size_t)cur.pn * tstep;
    S.a_ready(cur);
    if constexpr (SP2) {
        PG8_STAGE(PG8_SB(0, 0), cB, voffB); PG8_STAGE(PG8_SB(0, 1), cB + hstep, voffB); PG8_STAGE(PG8_SA(0, 0), cA, voffA); PG8_STAGE(PG8_SA(0, 1), cA + hstep, voffA);
        if (wr == 1) PG8_BAR;
        PG8_WAIT_V(2); PG8_BAR;
        PG8_STAGE(PG8_SB(1, 0), cB + kstep, voffB); PG8_STAGE(PG8_SA(1, 0), cA + kstep, voffA); PG8_STAGE(PG8_SB(1, 1), cB + hstep + kstep, voffB);
        PG8_WAIT_V(6); PG8_BAR;
    } else {
        PG8_STAGE(PG8_SB(0, 0), cB, voffB); PG8_STAGE(PG8_SA(0, 0), cA, voffA); PG8_STAGE(PG8_SB(0, 1), cB + hstep, voffB); PG8_STAGE(PG8_SA(0, 1), cA + hstep, voffA);
        if (wr == 1) PG8_BAR;
        PG8_WAIT_V(4); PG8_BAR;
        PG8_STAGE(PG8_SB(1, 0), cB + kstep, voffB); PG8_STAGE(PG8_SA(1, 0), cA + kstep, voffA); PG8_STAGE(PG8_SB(1, 1), cB + hstep + kstep, voffB);
        PG8_WAIT_V(6); PG8_BAR;
    }
    for (;;) {
        const bool has_next = S.next(ui + 1, nxt);
        const char* nA = has_next ? (const char*)g.A + (size_t)nxt.pm * tstep : cA; const char* nB = has_next ? (const char*)g.Bt + (size_t)nxt.pn * tstep : cB;
        for (int t = 0; t < nt; t += 2) {
            const bool last = (t == nt - 2);
            const char* a1 = cA + (size_t)(t + 1) * kstep;
            const char* a2 = last ? nA : cA + (size_t)(t + 2) * kstep; const char* b2 = last ? nB : cB + (size_t)(t + 2) * kstep;
            const char* a3 = a2 + kstep; const char* b3 = b2 + kstep;
            if (last && has_next) S.a_ready(nxt);
            if constexpr (SP2) {
            PG8_LDB(B0, 0, 0); PG8_LDB(B1, 0, 1); PG8_SCHED; PG8_LDA(At, 0, 0); PG8_STAGE(PG8_SA(1, 1), a1 + hstep, voffA);
            PG8_WAIT_V(8); PG8_WAIT_L(0); PG8_BAR; PG8_MMA(0, 0, At, B0); PG8_MMA(0, 1, At, B1); PG8_BAR; PG8_SCHED;
            PG8_LDA(At, 0, 1); PG8_STAGE(PG8_SB(0, 0), b2, voffB); PG8_STAGE(PG8_SB(0, 1), b2 + hstep, voffB); PG8_STAGE(PG8_SA(0, 0), a2, voffA);
            PG8_WAIT_V(8); PG8_WAIT_L(0); PG8_BAR; PG8_MMA(1, 0, At, B0); PG8_MMA(1, 1, At, B1); PG8_BAR; PG8_SCHED;
            PG8_LDB(B0, 1, 0); PG8_LDB(B1, 1, 1); PG8_SCHED; PG8_LDA(At, 1, 0); PG8_STAGE(PG8_SA(0, 1), a2 + hstep, voffA);
            PG8_WAIT_V(8); PG8_WAIT_L(0); PG8_BAR; PG8_MMA(0, 0, At, B0); PG8_MMA(0, 1, At, B1); PG8_BAR; PG8_SCHED;
            PG8_LDA(At, 1, 1); PG8_STAGE(PG8_SB(1, 0), b3, voffB); PG8_STAGE(PG8_SB(1, 1), b3 + hstep, voffB); PG8_STAGE(PG8_SA(1, 0), a3, voffA);
            PG8_WAIT_V(8); PG8_WAIT_L(0); PG8_BAR; PG8_MMA(1, 0, At, B0); PG8_MMA(1, 1, At, B1); PG8_BAR; PG8_SCHED;
            } else {
            PG8_LDB(B0, 0, 0); PG8_SCHED; PG8_LDA(At, 0, 0); PG8_STAGE(PG8_SA(1, 1), a1 + hstep, voffA);
            PG8_WAIT_L(8); PG8_BAR; PG8_WAIT_L(0); PG8_MMA(0, 0, At, B0); PG8_BAR; PG8_SCHED;
            PG8_LDB(B1, 0, 1); PG8_STAGE(PG8_SB(0, 0), b2, voffB);
            PG8_BAR; PG8_WAIT_L(0); PG8_MMA(0, 1, At, B1); PG8_BAR;
            PG8_LDA(At, 0, 1); PG8_STAGE(PG8_SA(0, 0), a2, voffA);
            PG8_BAR; PG8_WAIT_L(0); PG8_MMA(1, 0, At, B0); PG8_BAR; PG8_SCHED;
            PG8_STAGE(PG8_SB(0, 1), b2 + hstep, voffB);
            PG8_WAIT_V(6); PG8_BAR; PG8_MMA(1, 1, At, B1); PG8_BAR;
            PG8_LDB(B0, 1, 0); PG8_SCHED; PG8_LDA(At, 1, 0); PG8_STAGE(PG8_SA(0, 1), a2 + hstep, voffA);
            PG8_WAIT_L(8); PG8_BAR; PG8_WAIT_L(0); PG8_MMA(0, 0, At, B0); PG8_BAR; PG8_SCHED;
            PG8_LDB(B1, 1, 1); PG8_STAGE(PG8_SB(1, 0), b3, voffB);
            PG8_BAR; PG8_WAIT_L(0); PG8_MMA(0, 1, At, B1); PG8_BAR;
            PG8_LDA(At, 1, 1); PG8_STAGE(PG8_SA(1, 0), a3, voffA);
            PG8_BAR; PG8_WAIT_L(0); PG8_MMA(1, 0, At, B0); PG8_BAR; PG8_SCHED;
            PG8_STAGE(PG8_SB(1, 1), b3 + hstep, voffB);
            PG8_WAIT_V(6); PG8_BAR; PG8_MMA(1, 1, At, B1); PG8_BAR;
            }
        }
        if constexpr (ALIGN_EPI) { if (wr == 0) PG8_BAR; }
        if constexpr (!Epi::AFTER_DRAIN) { E(acc, cur, wr, wc, fr, fq); S.done(cur); }
        if (!has_next) break;
#pragma unroll
        for (int a = 0; a < 2; ++a)
#pragma unroll
            for (int b = 0; b < 2; ++b)
#pragma unroll
                for (int m = 0; m < 4; ++m)
#pragma unroll
                    for (int n = 0; n < 2; ++n) acc[a][b][m][n] = (f32x4){0.f, 0.f, 0.f, 0.f};
        cur = nxt; cA = nA; cB = nB; ++ui;
        if constexpr (ALIGN_EPI) { if (wr == 1) PG8_BAR; }
    }
    PG8_WAIT_V(0);
    if constexpr (!ALIGN_EPI) { if (wr == 0) PG8_BAR; }
    PG8_BAR;
    if constexpr (Epi::AFTER_DRAIN) { E.fused(acc, cur, wr, wc, fr, fq, lds, wid, lane); S.done(cur); }
#undef PG8_SA
#undef PG8_SB
#undef PG8_STAGE
#undef PG8_LDA
#undef PG8_LDB
#undef PG8_MMA
#undef PG8_WAIT_V
#undef PG8_WAIT_L
#undef PG8_BAR
#undef PG8_SCHED
}
}

constexpr int NWAVES = 8;
#ifndef MK_N_LAUNCHES
#define MK_N_LAUNCHES 1
#endif
constexpr int N_PHASES = 12;
constexpr int N_LAUNCHES = MK_N_LAUNCHES;

constexpr int BATCH = 4, SEQ = 4096, D = 2048, M = BATCH * SEQ;
constexpr int LRU_W = 1024, LRU_HEADS = 8, LRU_BLK = 128;
constexpr int HD = 64, HQ = 16, HKV = 2, GRP = 8;
constexpr int MIX_IN = 3328;
constexpr int C_Y = 1024, C_Q = 2048, C_K = 3072, C_V = 3200;
constexpr int ADA_W = 6 * D;
constexpr int PH = 8, PKEYS = 128, PHALF = 128, PTOPK = 16, NEXP = 16384;
constexpr float EPS = 1e-6f;

constexpr size_t MiB = 1u << 20;
constexpr size_t WS_CTL = 0, CTL_ZERO_BYTES = 1 * MiB;
constexpr size_t WS_ADA = 1 * MiB;
constexpr size_t WS_ROPE = 2 * MiB;
constexpr size_t WS_WIN = 4 * MiB;
constexpr size_t WS_WOUT = 17 * MiB;
constexpr size_t WS_WQ = 25 * MiB;
constexpr size_t WS_WGA = 33 * MiB;
constexpr size_t WS_WGX = 33 * MiB + 256 * 1024;
constexpr size_t WS_SK = 33 * MiB + 512 * 1024;
constexpr size_t WS_IDX = 34 * MiB;
constexpr size_t WS_GW = 42 * MiB;
constexpr size_t WS_U = 50 * MiB;
constexpr size_t WS_V = 82 * MiB;
constexpr size_t WS_USC = 1 * MiB + 512 * 1024;
constexpr size_t WS_VSC = 1 * MiB + 768 * 1024;
constexpr size_t WS_XH = 178 * MiB;
constexpr size_t WS_PROJ = 242 * MiB;
constexpr size_t WS_HL = 346 * MiB;
constexpr size_t WS_PA = 410 * MiB;
constexpr size_t WS_PART = WS_HL;
constexpr size_t WS_W = WS_PROJ + 64 * MiB;
constexpr size_t WS_END = 474 * MiB;
constexpr int CW_BAR = 4096;

constexpr int RING_BYTES = 131072;
constexpr int LDSCTL_OFF = RING_BYTES, MISC_OFF = LDSCTL_OFF + 320;
constexpr int LDS_BYTES = 147456;

#define GAS __attribute__((address_space(1)))
#define LAS __attribute__((address_space(3)))
typedef unsigned short bf16;
typedef unsigned v4u __attribute__((ext_vector_type(4)));
typedef unsigned v2u __attribute__((ext_vector_type(2)));
typedef float f32x4 __attribute__((ext_vector_type(4)));
typedef float f32x2 __attribute__((ext_vector_type(2)));
typedef float f32x16 __attribute__((ext_vector_type(16)));
typedef short bf16x8 __attribute__((ext_vector_type(8)));
typedef __bf16 bf16x2v __attribute__((ext_vector_type(2)));
#define LDS_WAIT() asm volatile("s_waitcnt lgkmcnt(0)" ::: "memory")
#define VM_WAIT() asm volatile("s_waitcnt vmcnt(0)" ::: "memory")
__device__ __forceinline__ unsigned f2bf(float f) { unsigned u = __builtin_bit_cast(unsigned, f); return (u + 0x7fffu + ((u >> 16) & 1u)) >> 16; }
__device__ __forceinline__ unsigned pk2(float lo, float hi) { return f2bf(lo) | (f2bf(hi) << 16); }
__device__ __forceinline__ float bflo(unsigned u) { return __builtin_bit_cast(float, u << 16); }
__device__ __forceinline__ float bfhi(unsigned u) { return __builtin_bit_cast(float, u & 0xffff0000u); }
__device__ __forceinline__ float bf1(bf16 h) { return __builtin_bit_cast(float, (unsigned)h << 16); }
__device__ __forceinline__ float dot2bf(unsigned a, unsigned b, float acc) { return __builtin_amdgcn_fdot2_f32_bf16(__builtin_bit_cast(bf16x2v, a), __builtin_bit_cast(bf16x2v, b), acc, false); }
__device__ __forceinline__ float sigmoidf_(float x) { return 1.0f / (1.0f + __expf(-x)); }
__device__ __forceinline__ float gelu_tanh(float x) {
    const float z = 1.5957691216057308f * (x + 0.044715f * x * x * x);
    return x / (1.0f + __expf(-z));
}
__device__ __forceinline__ float wave_sum(float v) {
#pragma unroll
    for (int o = 1; o < 64; o <<= 1) v += __shfl_xor(v, o);
    return v;
}

#define XB_TMO      128
#define XB_XCNT(j)  (256  + 64 * (j))
#define XB_XSUB(j)  (1280 + 64 * (j))
#define XB_XGEN(j)  (2304 + 64 * (j))
#define XB_TOP      3328
#define XB_TOPGEN   3392
#define XCD_BAR_WORDS 3456
#define XB_SPIN_CAP (1u << 18)
__device__ __forceinline__ unsigned xb_ld(unsigned* p)              { return __hip_atomic_load(p, __ATOMIC_RELAXED, __HIP_MEMORY_SCOPE_AGENT); }
__device__ __forceinline__ unsigned xb_add(unsigned* p, unsigned v) { return __hip_atomic_fetch_add(p, v, __ATOMIC_RELAXED, __HIP_MEMORY_SCOPE_AGENT); }
__device__ __forceinline__ unsigned xb_xcc_id() { return (unsigned)__builtin_amdgcn_s_getreg((3 << 11) | 20) & 0xFu; }
#define XB_SPIN(cond, bar) do { unsigned _sp = 0; while (cond) { __builtin_amdgcn_s_sleep(1); \
    if ((++_sp & 255u) == 0u) { if (xb_ld(&(bar)[XB_TMO])) break; if (_sp > XB_SPIN_CAP) { atomicAdd(&(bar)[XB_TMO], 1u); break; } } } } while (0)
struct XcdBarrier { unsigned* bar; unsigned x; volatile LAS unsigned* st; };
__device__ __forceinline__ XcdBarrier xcd_barrier_post(unsigned* bar, volatile LAS unsigned* st) {
    XcdBarrier b; b.bar = bar; b.x = xb_xcc_id(); b.st = st;
    if (threadIdx.x == 0) (void)xb_add(&bar[XB_XCNT(b.x)], 1u);
    return b;
}
__device__ __forceinline__ void xcd_barrier_complete(unsigned* bar, unsigned x, unsigned& nloc, unsigned& nx) {
    const unsigned G = gridDim.x * gridDim.y * gridDim.z;
    unsigned sum, cnt, mine, sp = 0u;
    for (;;) {
        sum = 0u; cnt = 0u; mine = 0u;
#pragma unroll
        for (unsigned j = 0; j < 16; ++j) { const unsigned c = xb_ld(&bar[XB_XCNT(j)]); sum += c; cnt += (c > 0u) ? 1u : 0u; mine = (j == x) ? c : mine; }
        if (sum == G) break;
        __builtin_amdgcn_s_sleep(1);
        if ((++sp & 255u) == 0u) { if (xb_ld(&bar[XB_TMO])) break; if (sp > XB_SPIN_CAP) { atomicAdd(&bar[XB_TMO], 1u); break; } }
    }
    nloc = mine > 0u ? mine : 1u; nx = cnt > 0u ? cnt : 1u;
}
__device__ __forceinline__ void xcd_barrier(const XcdBarrier& b) {
    asm volatile("s_waitcnt vmcnt(0)" ::: "memory");
    __syncthreads();
    if (threadIdx.x == 0) {
        unsigned* bar = b.bar;
        __builtin_amdgcn_s_waitcnt(0);
        unsigned nloc = b.st[0], nx = b.st[1];
        if (nloc == 0u) { xcd_barrier_complete(bar, b.x, nloc, nx); b.st[0] = nloc; b.st[1] = nx; }
        const unsigned old = xb_add(&bar[XB_XSUB(b.x)], 1u);
        const unsigned gen = old / nloc;
        if (old + 1u == (gen + 1u) * nloc) {
            __builtin_amdgcn_fence(__ATOMIC_RELEASE, "agent");
            asm volatile("s_waitcnt vmcnt(0)" ::: "memory");
            const unsigned og = xb_add(&bar[XB_TOP], 1u);
            const unsigned tg = og / nx;
            if (og + 1u == (tg + 1u) * nx) xb_add(&bar[XB_TOPGEN], 1u);
            else XB_SPIN(xb_ld(&bar[XB_TOPGEN]) == tg, bar);
            __builtin_amdgcn_fence(__ATOMIC_ACQUIRE, "agent");
            xb_add(&bar[XB_XGEN(b.x)], 1u);
            asm volatile("s_waitcnt vmcnt(0)" ::: "memory");
        } else {
            XB_SPIN(xb_ld(&bar[XB_XGEN(b.x)]) == gen, bar);
            __builtin_amdgcn_fence(__ATOMIC_ACQUIRE, "agent");
            asm volatile("s_waitcnt vmcnt(0)" ::: "memory");
        }
    }
    __syncthreads();
}

typedef const __attribute__((address_space(4))) unsigned char* kaptr_t;
struct Frame { LAS unsigned char* lds; int tid, lane, wave, G, bid; kaptr_t ka; };
template <class T> __device__ __forceinline__ T* ka_ptr(const Frame& F, int byte_off) { typedef T* tp; return *(const __attribute__((address_space(4))) tp*)(F.ka + byte_off); }
__device__ __forceinline__ const float* P_x(const Frame& F) { return ka_ptr<const float>(F, 0); }
__device__ __forceinline__ const float* P_c(const Frame& F) { return ka_ptr<const float>(F, 8); }
__device__ __forceinline__ const int* P_pos(const Frame& F) { return ka_ptr<const int>(F, 16); }
__device__ __forceinline__ const float* P_w_ada(const Frame& F) { return ka_ptr<const float>(F, 24); }
__device__ __forceinline__ const float* P_b_ada(const Frame& F) { return ka_ptr<const float>(F, 32); }
__device__ __forceinline__ const float* P_norm1_g(const Frame& F) { return ka_ptr<const float>(F, 40); }
__device__ __forceinline__ const float* P_w_in(const Frame& F) { return ka_ptr<const float>(F, 48); }
__device__ __forceinline__ const float* P_conv_w(const Frame& F) { return ka_ptr<const float>(F, 56); }
__device__ __forceinline__ const float* P_conv_b(const Frame& F) { return ka_ptr<const float>(F, 64); }
__device__ __forceinline__ const float* P_ga_w(const Frame& F) { return ka_ptr<const float>(F, 72); }
__device__ __forceinline__ const float* P_ga_b(const Frame& F) { return ka_ptr<const float>(F, 80); }
__device__ __forceinline__ const float* P_gx_w(const Frame& F) { return ka_ptr<const float>(F, 88); }
__device__ __forceinline__ const float* P_gx_b(const Frame& F) { return ka_ptr<const float>(F, 96); }
__device__ __forceinline__ const float* P_lam(const Frame& F) { return ka_ptr<const float>(F, 104); }
__device__ __forceinline__ const float* P_qn_g(const Frame& F) { return ka_ptr<const float>(F, 112); }
__device__ __forceinline__ const float* P_kn_g(const Frame& F) { return ka_ptr<const float>(F, 120); }
__device__ __forceinline__ const float* P_sinks(const Frame& F) { return ka_ptr<const float>(F, 128); }
__device__ __forceinline__ const float* P_on_lru_g(const Frame& F) { return ka_ptr<const float>(F, 136); }
__device__ __forceinline__ const float* P_on_attn_g(const Frame& F) { return ka_ptr<const float>(F, 144); }
__device__ __forceinline__ const float* P_w_out(const Frame& F) { return ka_ptr<const float>(F, 152); }
__device__ __forceinline__ const float* P_norm2_g(const Frame& F) { return ka_ptr<const float>(F, 160); }
__device__ __forceinline__ const float* P_w_pq(const Frame& F) { return ka_ptr<const float>(F, 168); }
__device__ __forceinline__ const float* P_sub_keys(const Frame& F) { return ka_ptr<const float>(F, 176); }
__device__ __forceinline__ const float* P_pu(const Frame& F) { return ka_ptr<const float>(F, 184); }
__device__ __forceinline__ const float* P_pv(const Frame& F) { return ka_ptr<const float>(F, 192); }
__device__ __forceinline__ float* P_out(const Frame& F) { return ka_ptr<float>(F, 200); }
__device__ __forceinline__ unsigned char* P_ws(const Frame& F) { return ka_ptr<unsigned char>(F, 208); }
__device__ __forceinline__ float* P_ADA(const Frame& F) { return (float*)(P_ws(F) + WS_ADA); }
__device__ __forceinline__ float* P_ROPE(const Frame& F) { return (float*)(P_ws(F) + WS_ROPE); }
__device__ __forceinline__ float* P_HL(const Frame& F) { return (float*)(P_ws(F) + WS_HL); }
__device__ __forceinline__ float* P_PA(const Frame& F) { return (float*)(P_ws(F) + WS_PA); }
__device__ __forceinline__ float* P_GW(const Frame& F) { return (float*)(P_ws(F) + WS_GW); }
__device__ __forceinline__ int* P_IDX(const Frame& F) { return (int*)(P_ws(F) + WS_IDX); }
__device__ __forceinline__ bf16* P_WIN(const Frame& F) { return (bf16*)(P_ws(F) + WS_WIN); }
__device__ __forceinline__ bf16* P_WOUT(const Frame& F) { return (bf16*)(P_ws(F) + WS_WOUT); }
__device__ __forceinline__ bf16* P_WQ(const Frame& F) { return (bf16*)(P_ws(F) + WS_WQ); }
__device__ __forceinline__ bf16* P_WGA(const Frame& F) { return (bf16*)(P_ws(F) + WS_WGA); }
__device__ __forceinline__ bf16* P_WGX(const Frame& F) { return (bf16*)(P_ws(F) + WS_WGX); }
__device__ __forceinline__ bf16* P_SK(const Frame& F) { return (bf16*)(P_ws(F) + WS_SK); }
__device__ __forceinline__ unsigned char* P_U(const Frame& F) { return (unsigned char*)(P_ws(F) + WS_U); }
__device__ __forceinline__ float* P_PART(const Frame& F) { return (float*)(P_ws(F) + WS_PART); }
__device__ __forceinline__ float* P_W(const Frame& F) { return (float*)(P_ws(F) + WS_W); }
__device__ __forceinline__ float* P_USC(const Frame& F) { return (float*)(P_ws(F) + WS_USC); }
__device__ __forceinline__ float* P_VSC(const Frame& F) { return (float*)(P_ws(F) + WS_VSC); }
__device__ __forceinline__ unsigned char* P_V(const Frame& F) { return (unsigned char*)(P_ws(F) + WS_V); }
__device__ __forceinline__ bf16* P_XH(const Frame& F) { return (bf16*)(P_ws(F) + WS_XH); }
__device__ __forceinline__ bf16* P_PROJ(const Frame& F) { return (bf16*)(P_ws(F) + WS_PROJ); }

__device__ __forceinline__ void p0_transpose_item(const float* W, int K, int N, bf16* WT, LAS float* scr, int item, int lane) {
    const int nblk = N / 32, kb = item / nblk, nb = item % nblk, k0 = 64 * kb, n0 = 32 * nb;
#pragma unroll 8
    for (int i = 0; i < 32; ++i) { const int kk = 2 * i + (lane >> 5); scr[kk * 33 + (lane & 31)] = W[(size_t)(k0 + kk) * N + n0 + (lane & 31)]; }
    LDS_WAIT(); asm volatile("" ::: "memory");
    const int c = lane & 7;
#pragma unroll
    for (int j = 0; j < 4; ++j) { const int n = (lane >> 3) + 8 * j; const LAS float* s = scr + (8 * c) * 33 + n;
        v4u o; o.x = pk2(s[0 * 33], s[1 * 33]); o.y = pk2(s[2 * 33], s[3 * 33]); o.z = pk2(s[4 * 33], s[5 * 33]); o.w = pk2(s[6 * 33], s[7 * 33]);
        *(v4u*)(WT + (size_t)(n0 + n) * K + k0 + 8 * c) = o; }
    LDS_WAIT(); asm volatile("" ::: "memory");
}
__device__ __forceinline__ void p0_convert(const float* src, bf16* dst, size_t n8, size_t gtid, size_t gthreads) {
    for (size_t i = gtid; i < n8; i += gthreads) {
        const f32x4 a = *(const f32x4*)(src + 8 * i), b = *(const f32x4*)(src + 8 * i + 4);
        v4u o; o.x = pk2(a.x, a.y); o.y = pk2(a.z, a.w); o.z = pk2(b.x, b.y); o.w = pk2(b.z, b.w);
        *(v4u*)(dst + 8 * i) = o;
    }
}
__device__ __forceinline__ void p0_prologue(Frame& F) {
    {
        LAS float* sc = (LAS float*)F.lds;
        LAS float* red = sc + 4 * D;
        for (int i = F.tid; i < 4 * D; i += 512) { const float v = P_c(F)[i]; sc[i] = v / (1.0f + __expf(-v)); }
        __syncthreads();
        for (int cg = F.bid; cg < ADA_W / 64; cg += F.G) {
            const int n0 = cg * 64, k0 = F.wave * 256;
            const float* wp = P_w_ada(F) + (size_t)k0 * ADA_W + n0 + F.lane;
            float a0 = 0.f, a1 = 0.f, a2 = 0.f, a3 = 0.f;
#pragma unroll 16
            for (int k = 0; k < 256; ++k) { const float w = wp[(size_t)k * ADA_W]; const int kk = k0 + k;
                a0 += sc[kk] * w; a1 += sc[D + kk] * w; a2 += sc[2 * D + kk] * w; a3 += sc[3 * D + kk] * w; }
            red[(F.wave * 4 + 0) * 64 + F.lane] = a0; red[(F.wave * 4 + 1) * 64 + F.lane] = a1;
            red[(F.wave * 4 + 2) * 64 + F.lane] = a2; red[(F.wave * 4 + 3) * 64 + F.lane] = a3;
            __syncthreads();
            if (F.tid < 256) { const int b = F.tid >> 6, l = F.tid & 63; float s = 0.f;
#pragma unroll
                for (int w = 0; w < 8; ++w) s += red[(w * 4 + b) * 64 + l];
                P_ADA(F)[(size_t)b * ADA_W + n0 + l] = s + P_b_ada(F)[n0 + l]; }
            __syncthreads();
        }
        __syncthreads();
    }
    {
        LAS float* scr = (LAS float*)(F.lds + F.wave * 16384);
        const int gw = F.bid * NWAVES + F.wave, NGW = F.G * NWAVES;
        constexpr int I_IN = (D / 64) * (MIX_IN / 32), I_SQ = (D / 64) * (D / 32), I_G = (LRU_BLK / 64) * (LRU_BLK / 32);
        constexpr int NITEMS = I_IN + 2 * I_SQ + 16 * I_G;
        for (int it = gw; it < NITEMS; it += NGW) {
            int r = it;
            if (r < I_IN) { p0_transpose_item(P_w_in(F), D, MIX_IN, P_WIN(F), scr, r, F.lane); continue; } r -= I_IN;
            if (r < I_SQ) { p0_transpose_item(P_w_out(F), D, D, P_WOUT(F), scr, r, F.lane); continue; } r -= I_SQ;
            if (r < I_SQ) { p0_transpose_item(P_w_pq(F), D, D, P_WQ(F), scr, r, F.lane); continue; } r -= I_SQ;
            const int g = r / I_G, ri = r % I_G, hd = g & 7;
            if (g < 8) p0_transpose_item(P_ga_w(F) + (size_t)hd * 16384, LRU_BLK, LRU_BLK, P_WGA(F) + (size_t)hd * 16384, scr, ri, F.lane);
            else       p0_transpose_item(P_gx_w(F) + (size_t)hd * 16384, LRU_BLK, LRU_BLK, P_WGX(F) + (size_t)hd * 16384, scr, ri, F.lane);
        }
    }
    {
        const size_t gtid = (size_t)F.bid * 512 + F.tid, gth = (size_t)F.G * 512;
        p0_convert(P_sub_keys(F), P_SK(F), (size_t)PH * 2 * PKEYS * PHALF / 8, gtid, gth);
    }
    {
        const int gw = F.bid * NWAVES + F.wave, NGW = F.G * NWAVES;
        for (int rr = gw; rr < 2 * NEXP; rr += NGW) {
            const int tbl = rr >= NEXP, row = rr - tbl * NEXP;
            const float* srcp = (tbl ? P_pv(F) : P_pu(F)) + (size_t)row * D;
            unsigned char* dstp = (tbl ? P_V(F) : P_U(F)) + (size_t)row * D;
            f32x4 v[8]; float mx = 0.f;
#pragma unroll
            for (int j = 0; j < 8; ++j) { v[j] = *(const f32x4*)(srcp + 4 * F.lane + 256 * j);
                mx = fmaxf(fmaxf(mx, fmaxf(fabsf(v[j].x), fabsf(v[j].y))), fmaxf(fabsf(v[j].z), fabsf(v[j].w))); }
#pragma unroll
            for (int o = 1; o < 64; o <<= 1) mx = fmaxf(mx, __shfl_xor(mx, o));
            const float s = fmaxf(mx, 1e-30f) * (1.0f / 224.0f), inv = 1.0f / s;
#pragma unroll
            for (int j = 0; j < 8; ++j) { int t = __builtin_amdgcn_cvt_pk_fp8_f32(v[j].x * inv, v[j].y * inv, 0, false);
                t = __builtin_amdgcn_cvt_pk_fp8_f32(v[j].z * inv, v[j].w * inv, t, true);
                *(int*)(dstp + 4 * F.lane + 256 * j) = t; }
            if (F.lane == 0) (tbl ? P_VSC(F) : P_USC(F))[row] = s;
        }
    }
}

__device__ __forceinline__ void modnorm_rows4(const float* xrow, const float* gain, const float* shift, const float* scale, bf16* orow, int lane) {
    f32x4 v[4][8]; float s[4];
#pragma unroll
    for (int r = 0; r < 4; ++r) { s[r] = 0.f;
#pragma unroll
        for (int j = 0; j < 8; ++j) v[r][j] = *(const f32x4*)(xrow + (size_t)r * D + 4 * lane + 256 * j); }
#pragma unroll
    for (int r = 0; r < 4; ++r)
#pragma unroll
        for (int j = 0; j < 8; ++j) s[r] += (v[r][j].x * v[r][j].x + v[r][j].y * v[r][j].y) + (v[r][j].z * v[r][j].z + v[r][j].w * v[r][j].w);
#pragma unroll
    for (int o = 1; o < 64; o <<= 1) {
#pragma unroll
        for (int r = 0; r < 4; ++r) s[r] += __shfl_xor(s[r], o); }
    float rstd[4];
#pragma unroll
    for (int r = 0; r < 4; ++r) rstd[r] = 1.0f / sqrtf(s[r] * (1.0f / D) + EPS);
#pragma unroll
    for (int j = 0; j < 8; ++j) {
        const int c = 4 * lane + 256 * j;
        const f32x4 g = *(const f32x4*)(gain + c), sh = *(const f32x4*)(shift + c), sc = *(const f32x4*)(scale + c);
        const f32x4 gm = g * (sc + 1.0f);
#pragma unroll
        for (int r = 0; r < 4; ++r) { const f32x4 y = (v[r][j] * rstd[r]) * gm + sh;
            v2u o; o.x = pk2(y.x, y.y); o.y = pk2(y.z, y.w);
            *(v2u*)(orow + (size_t)r * D + c) = o; }
    }
}
__device__ __forceinline__ void p1_phase(Frame& F) {
    const int gw = F.bid * NWAVES + F.wave, NGW = F.G * NWAVES;
    for (int m = 4 * gw; m < M; m += 4 * NGW) { const int b = m / SEQ; const float* ada = P_ADA(F) + (size_t)b * ADA_W;
        modnorm_rows4(P_x(F) + (size_t)m * D, P_norm1_g(F), ada, ada + D, P_XH(F) + (size_t)m * D, F.lane); }
    const float invf[8] = {1.0f, 1.9392274e-01f, 3.7606031e-02f, 7.2926646e-03f, 1.4142136e-03f, 2.7424819e-04f, 5.3182961e-05f, 1.0313386e-05f};
    for (int i = F.bid * 512 + F.tid; i < M * 8; i += F.G * 512) { const int m = i >> 3, k = i & 7;
        float f = invf[0];
#pragma unroll
        for (int q = 1; q < 8; ++q) f = (k == q) ? invf[q] : f;
        const float ang = (float)P_pos(F)[m] * f; float sn, cs; sincosf(ang, &sn, &cs);
        P_ROPE(F)[(size_t)m * 16 + k] = cs; P_ROPE(F)[(size_t)m * 16 + 8 + k] = sn; }
}
__device__ __forceinline__ void p6_phase(Frame& F) {
    const int gw = F.bid * NWAVES + F.wave, NGW = F.G * NWAVES;
    for (int m = 4 * gw; m < M; m += 4 * NGW) { const int b = m / SEQ; const float* ada = P_ADA(F) + (size_t)b * ADA_W;
        modnorm_rows4(P_out(F) + (size_t)m * D, P_norm2_g(F), ada + 3 * D, ada + 4 * D, P_XH(F) + (size_t)m * D, F.lane); }
}

#define MFMA32(a, b, c) __builtin_amdgcn_mfma_f32_32x32x16_bf16((a), (b), (c), 0, 0, 0)
#define MFMA16(a, b, c) __builtin_amdgcn_mfma_f32_16x16x32_bf16((a), (b), (c), 0, 0, 0)
constexpr int KS_STRIDE = 72;
constexpr int VT_STRIDE = 264;
constexpr int ATT_KS_OFF = 0, ATT_VT_OFF = 256 * KS_STRIDE * 2;
static_assert(ATT_VT_OFF + 64 * VT_STRIDE * 2 <= RING_BYTES, "attention LDS");

__device__ __forceinline__ void attn_unit(Frame& F, int b, int g, int n) {
    LAS bf16* Ks = (LAS bf16*)(F.lds + ATT_KS_OFF);
    LAS bf16* VT = (LAS bf16*)(F.lds + ATT_VT_OFF);
    const int tid = F.tid, lane = F.lane;
    {
        const int kb = tid >> 1, hf = tid & 1; const int t = n * 128 - 128 + kb;
        float kv[32]; v4u vraw[4];
        if (t >= 0) {
            const bf16* kp = P_PROJ(F) + (size_t)(b * SEQ + t) * MIX_IN + C_K + g * HD + 32 * hf;
            const bf16* vp = P_PROJ(F) + (size_t)(b * SEQ + t) * MIX_IN + C_V + g * HD + 32 * hf;
#pragma unroll
            for (int q = 0; q < 4; ++q) { const v4u r = *(const v4u*)(kp + 8 * q); vraw[q] = *(const v4u*)(vp + 8 * q);
                kv[8 * q + 0] = bflo(r.x); kv[8 * q + 1] = bfhi(r.x); kv[8 * q + 2] = bflo(r.y); kv[8 * q + 3] = bfhi(r.y);
                kv[8 * q + 4] = bflo(r.z); kv[8 * q + 5] = bfhi(r.z); kv[8 * q + 6] = bflo(r.w); kv[8 * q + 7] = bfhi(r.w); }
        } else {
#pragma unroll
            for (int q = 0; q < 4; ++q) vraw[q] = (v4u){0u, 0u, 0u, 0u};
#pragma unroll
            for (int q = 0; q < 32; ++q) kv[q] = 0.f;
        }
        float ss = 0.f;
#pragma unroll
        for (int q = 0; q < 32; ++q) ss += kv[q] * kv[q];
        ss += __shfl_xor(ss, 1);
        const float rstd = 1.0f / sqrtf(ss * (1.0f / HD) + EPS);
#pragma unroll
        for (int q = 0; q < 32; ++q) kv[q] = kv[q] * rstd * P_kn_g(F)[32 * hf + q];
        if (hf == 0 && t >= 0) {
            const float* rp = P_ROPE(F) + (size_t)(b * SEQ + t) * 16;
#pragma unroll
            for (int i = 0; i < 8; ++i) { const float cs = rp[i], sn = rp[8 + i]; const float x1 = kv[i], x2 = kv[8 + i];
                kv[i] = x1 * cs - x2 * sn; kv[8 + i] = x2 * cs + x1 * sn; }
        }
#pragma unroll
        for (int q = 0; q < 4; ++q) { v4u o; o.x = pk2(kv[8 * q], kv[8 * q + 1]); o.y = pk2(kv[8 * q + 2], kv[8 * q + 3]); o.z = pk2(kv[8 * q + 4], kv[8 * q + 5]); o.w = pk2(kv[8 * q + 6], kv[8 * q + 7]);
            *(LAS v4u*)(Ks + kb * KS_STRIDE + 32 * hf + 8 * q) = o; }
#pragma unroll
        for (int q = 0; q < 4; ++q) { const unsigned w[4] = {vraw[q].x, vraw[q].y, vraw[q].z, vraw[q].w};
#pragma unroll
            for (int e = 0; e < 4; ++e) { const int d = 32 * hf + 8 * q + 2 * e;
                VT[d * VT_STRIDE + kb] = (bf16)(w[e] & 0xffffu); VT[(d + 1) * VT_STRIDE + kb] = (bf16)(w[e] >> 16); } }
    }
    __syncthreads();
    const int hq = g * GRP + F.wave, r = lane & 31, hh = lane >> 5;
    const float sink = P_sinks(F)[hq];
    for (int qi = 0; qi < 4; ++qi) {
        const int tq = n * 128 + 32 * qi + r;
        bf16x8 qf[4];
        {
            const bf16* qp = P_PROJ(F) + (size_t)(b * SEQ + tq) * MIX_IN + C_Q + hq * HD + 8 * hh;
            float qv[4][8]; float ss = 0.f;
#pragma unroll
            for (int ks = 0; ks < 4; ++ks) { const v4u rr = *(const v4u*)(qp + 16 * ks);
                qv[ks][0] = bflo(rr.x); qv[ks][1] = bfhi(rr.x); qv[ks][2] = bflo(rr.y); qv[ks][3] = bfhi(rr.y);
                qv[ks][4] = bflo(rr.z); qv[ks][5] = bfhi(rr.z); qv[ks][6] = bflo(rr.w); qv[ks][7] = bfhi(rr.w);
#pragma unroll
                for (int j = 0; j < 8; ++j) ss += qv[ks][j] * qv[ks][j]; }
            ss += __shfl_xor(ss, 32);
            const float rstd = 1.0f / sqrtf(ss * (1.0f / HD) + EPS);
#pragma unroll
            for (int ks = 0; ks < 4; ++ks)
#pragma unroll
                for (int j = 0; j < 8; ++j) qv[ks][j] = qv[ks][j] * rstd * P_qn_g(F)[16 * ks + 8 * hh + j];
            const float* rp = P_ROPE(F) + (size_t)(b * SEQ + tq) * 16;
#pragma unroll
            for (int j = 0; j < 8; ++j) { const float mine = qv[0][j], other = __shfl_xor(mine, 32); const float cs = rp[j], sn = rp[8 + j];
                qv[0][j] = hh == 0 ? (mine * cs - other * sn) : (mine * cs + other * sn); }
#pragma unroll
            for (int ks = 0; ks < 4; ++ks) { v4u o; o.x = pk2(qv[ks][0] * 0.125f, qv[ks][1] * 0.125f); o.y = pk2(qv[ks][2] * 0.125f, qv[ks][3] * 0.125f);
                o.z = pk2(qv[ks][4] * 0.125f, qv[ks][5] * 0.125f); o.w = pk2(qv[ks][6] * 0.125f, qv[ks][7] * 0.125f); qf[ks] = __builtin_bit_cast(bf16x8, o); }
        }
        f32x16 s[5];
#pragma unroll
        for (int kj = 0; kj < 5; ++kj) {
            f32x16 acc;
#pragma unroll
            for (int i = 0; i < 16; ++i) acc[i] = 0.f;
            const LAS bf16* kp = Ks + (32 * (qi + kj) + r) * KS_STRIDE + 8 * hh;
#pragma unroll
            for (int ks = 0; ks < 4; ++ks) { const bf16x8 kf = *(const LAS bf16x8*)(kp + 16 * ks); acc = MFMA32(kf, qf[ks], acc); }
            s[kj] = acc;
        }
        float mx = sink;
#pragma unroll
        for (int kj = 0; kj < 5; ++kj)
#pragma unroll
            for (int i = 0; i < 16; ++i) { const int kt = (i & 3) + 8 * (i >> 2) + 4 * hh; const int kbi = 32 * (qi + kj) + kt;
                bool valid = (n * 128 + kbi - 128) >= 0;
                if (kj == 0) valid = valid && (kt > r);
                if (kj == 4) valid = valid && (kt <= r);
                s[kj][i] = valid ? s[kj][i] : -INFINITY; mx = fmaxf(mx, s[kj][i]); }
        mx = fmaxf(mx, __shfl_xor(mx, 32));
        float l = 0.f;
#pragma unroll
        for (int kj = 0; kj < 5; ++kj)
#pragma unroll
            for (int i = 0; i < 16; ++i) { const float p = __expf(s[kj][i] - mx); s[kj][i] = p; l += p; }
        l += __shfl_xor(l, 32);
        l += __expf(sink - mx);
        const float inv = 1.0f / l;
        f32x16 o0, o1;
#pragma unroll
        for (int i = 0; i < 16; ++i) { o0[i] = 0.f; o1[i] = 0.f; }
#pragma unroll
        for (int kj = 0; kj < 5; ++kj)
#pragma unroll
            for (int st = 0; st < 2; ++st) {
                v4u pa; pa.x = pk2(s[kj][8 * st + 0] * inv, s[kj][8 * st + 1] * inv); pa.y = pk2(s[kj][8 * st + 2] * inv, s[kj][8 * st + 3] * inv);
                pa.z = pk2(s[kj][8 * st + 4] * inv, s[kj][8 * st + 5] * inv); pa.w = pk2(s[kj][8 * st + 6] * inv, s[kj][8 * st + 7] * inv);
                const bf16x8 pf = __builtin_bit_cast(bf16x8, pa);
                const int kb0 = 32 * (qi + kj) + 16 * st + 4 * hh;
                const LAS bf16* v0p = VT + r * VT_STRIDE + kb0; const LAS bf16* v1p = VT + (32 + r) * VT_STRIDE + kb0;
                const v2u a0 = *(const LAS v2u*)v0p, a1 = *(const LAS v2u*)(v0p + 8), b0 = *(const LAS v2u*)v1p, b1 = *(const LAS v2u*)(v1p + 8);
                const v4u vb0 = {a0.x, a0.y, a1.x, a1.y}, vb1 = {b0.x, b0.y, b1.x, b1.y};
                o0 = MFMA32(pf, __builtin_bit_cast(bf16x8, vb0), o0);
                o1 = MFMA32(pf, __builtin_bit_cast(bf16x8, vb1), o1);
            }
#pragma unroll
        for (int i = 0; i < 16; ++i) { const int qr = (i & 3) + 8 * (i >> 2) + 4 * hh; const int tok = n * 128 + 32 * qi + qr;
            bf16* op = P_XH(F) + (size_t)(b * SEQ + tok) * D + LRU_W + hq * HD + r;
            op[0] = (bf16)f2bf(o0[i]); op[32] = (bf16)f2bf(o1[i]); }
    }
    __syncthreads();
}

constexpr int LCH = 64;
constexpr int XC_STRIDE = 136;
constexpr int LRU_XCB_OFF = 0, LRU_XCF_OFF = LCH * XC_STRIDE * 2  , LRU_A_OFF = LRU_XCF_OFF + LCH * 128 * 4, LRU_B_OFF = LRU_A_OFF + LCH * 128 * 4, LRU_SE_OFF = LRU_B_OFF + LCH * 128 * 4;
static_assert(LRU_SE_OFF + 2 * 4 * 128 * 4 <= RING_BYTES, "LRU LDS");
__device__ __forceinline__ void lru_unit(Frame& F, int b, int hd, int ch) {
    LAS bf16* XCb = (LAS bf16*)(F.lds + LRU_XCB_OFF);
    LAS float* XCF = (LAS float*)(F.lds + LRU_XCF_OFF);
    LAS float* As = (LAS float*)(F.lds + LRU_A_OFF);
    LAS float* Bs = (LAS float*)(F.lds + LRU_B_OFF);
    LAS float* SEh = (LAS float*)(F.lds + LRU_SE_OFF);
    LAS float* SEp = SEh + 4 * 128;
    const int tid = F.tid, lane = F.lane;
    const int c = tid & 127, sub = tid >> 7, col = hd * LRU_BLK + c;
    const int t0 = ch * LCH;
    {
        const float w0 = P_conv_w(F)[col], w1 = P_conv_w(F)[LRU_W + col], w2 = P_conv_w(F)[2 * LRU_W + col], w3 = P_conv_w(F)[3 * LRU_W + col], cb = P_conv_b(F)[col];
        const bf16* xp = P_PROJ(F) + (size_t)(b * SEQ) * MIX_IN + col;
        const int ts = t0 + sub * 16;
        float xm3 = (ts - 3 >= 0) ? bf1(xp[(size_t)(ts - 3) * MIX_IN]) : 0.f;
        float xm2 = (ts - 2 >= 0) ? bf1(xp[(size_t)(ts - 2) * MIX_IN]) : 0.f;
        float xm1 = (ts - 1 >= 0) ? bf1(xp[(size_t)(ts - 1) * MIX_IN]) : 0.f;
#pragma unroll
        for (int i = 0; i < 16; ++i) { const float x0 = bf1(xp[(size_t)(ts + i) * MIX_IN]);
            const float xc = cb + w0 * xm3 + w1 * xm2 + w2 * xm1 + w3 * x0;
            const int tl = sub * 16 + i;
            XCF[tl * 128 + c] = xc; XCb[tl * XC_STRIDE + c] = (bf16)f2bf(xc);
            xm3 = xm2; xm2 = xm1; xm1 = x0; }
    }
    __syncthreads();
    {
        const int fr = lane & 15, fq = lane >> 4, j = 16 * F.wave + fr, jc = hd * LRU_BLK + j;
        bf16x8 wa[4], wx[4];
        const bf16* wap = P_WGA(F) + (size_t)hd * 16384 + (size_t)j * 128 + 8 * fq;
        const bf16* wxp = P_WGX(F) + (size_t)hd * 16384 + (size_t)j * 128 + 8 * fq;
#pragma unroll
        for (int ks = 0; ks < 4; ++ks) { wa[ks] = *(const bf16x8*)(wap + 32 * ks); wx[ks] = *(const bf16x8*)(wxp + 32 * ks); }
        const float ba = P_ga_b(F)[jc], bx = P_gx_b(F)[jc];
        const float lamv = P_lam(F)[jc];
        const float sp = log1pf(__expf(-lamv));
#pragma unroll
        for (int mt = 0; mt < 4; ++mt) {
            f32x4 ra = {0.f, 0.f, 0.f, 0.f}, rx = {0.f, 0.f, 0.f, 0.f};
            const LAS bf16* ap = XCb + (16 * mt + fr) * XC_STRIDE + 8 * fq;
#pragma unroll
            for (int ks = 0; ks < 4; ++ks) { const bf16x8 af = *(const LAS bf16x8*)(ap + 32 * ks); ra = MFMA16(af, wa[ks], ra); rx = MFMA16(af, wx[ks], rx); }
#pragma unroll
            for (int e = 0; e < 4; ++e) { const int tl = 16 * mt + 4 * fq + e;
                const float rg = sigmoidf_(ra[e] + ba), ig = sigmoidf_(rx[e] + bx);
                const float la = -8.0f * rg * sp; const float a = __expf(la);
                const float mult = sqrtf(-expm1f(2.0f * la));
                As[tl * 128 + j] = a; Bs[tl * 128 + j] = mult * ig * XCF[tl * 128 + j]; }
        }
    }
    __syncthreads();
    {
        float h = 0.f, P = 1.f;
#pragma unroll
        for (int i = 0; i < 16; ++i) { const int tl = sub * 16 + i; const float a = As[tl * 128 + c], bq = Bs[tl * 128 + c];
            h = a * h + bq; P *= a; Bs[tl * 128 + c] = h; As[tl * 128 + c] = P; }
        SEh[sub * 128 + c] = h; SEp[sub * 128 + c] = P;
    }
    __syncthreads();
    {
        float carry = 0.f, pp = 1.f;
        for (int s2 = 0; s2 < sub; ++s2) { carry = SEh[s2 * 128 + c] + SEp[s2 * 128 + c] * carry; pp *= SEp[s2 * 128 + c]; }
        float* hl = P_HL(F) + (size_t)(b * SEQ + t0 + sub * 16) * LRU_W + col;
        float* pa = P_PA(F) + (size_t)(b * SEQ + t0 + sub * 16) * LRU_W + col;
#pragma unroll
        for (int i = 0; i < 16; ++i) { const int tl = sub * 16 + i;
            hl[(size_t)i * LRU_W] = Bs[tl * 128 + c] + As[tl * 128 + c] * carry; pa[(size_t)i * LRU_W] = As[tl * 128 + c] * pp; }
    }
    __syncthreads();
}
constexpr int N_ATT_UNITS = BATCH * HKV * (SEQ / 128);
constexpr int N_LRU_UNITS = BATCH * LRU_HEADS * (SEQ / LCH);
__device__ __forceinline__ void p3_phase(Frame& F) {
    for (int u = F.bid; u < N_ATT_UNITS + N_LRU_UNITS; u += F.G) {
        if (u < N_ATT_UNITS) attn_unit(F, u >> 6, (u >> 5) & 1, u & 31);
        else { const int v = u - N_ATT_UNITS; lru_unit(F, v >> 9, (v >> 6) & 7, v & 63); }
    }
}

__device__ __forceinline__ void p4_unit(Frame& F, int b, int ch) {
    LAS float* CAR = (LAS float*)F.lds;
    const int tid = F.tid, lane = F.lane;
    {
        f32x2 carry = {0.f, 0.f};
        const float* hlb = P_HL(F) + (size_t)(b * SEQ + LCH - 1) * LRU_W + 2 * tid; const float* pab = P_PA(F) + (size_t)(b * SEQ + LCH - 1) * LRU_W + 2 * tid;
        int c2 = 0;
        for (; c2 + 8 <= ch; c2 += 8) { f32x2 hl[8], pa[8];
#pragma unroll
            for (int q = 0; q < 8; ++q) { hl[q] = *(const f32x2*)(hlb + (size_t)(c2 + q) * LCH * LRU_W); pa[q] = *(const f32x2*)(pab + (size_t)(c2 + q) * LCH * LRU_W); }
#pragma unroll
            for (int q = 0; q < 8; ++q) carry = hl[q] + pa[q] * carry; }
        for (; c2 < ch; ++c2) { const f32x2 hl = *(const f32x2*)(hlb + (size_t)c2 * LCH * LRU_W), pa = *(const f32x2*)(pab + (size_t)c2 * LCH * LRU_W); carry = hl + pa * carry; }
        CAR[2 * tid] = carry.x; CAR[2 * tid + 1] = carry.y;
    }
    __syncthreads();
    const float* gl = P_on_lru_g(F); const float* ga = P_on_attn_g(F);
    for (int i = 0; i < 8; i += 2) {
        const size_t m0 = (size_t)b * SEQ + ch * LCH + F.wave * 8 + i;
        f32x4 hl[2][4], pa[2][4]; v2u yr[2][4], ar[2][4];
#pragma unroll
        for (int t = 0; t < 2; ++t)
#pragma unroll
            for (int j = 0; j < 4; ++j) { const int c = 4 * lane + 256 * j; const size_t m = m0 + t;
                hl[t][j] = *(const f32x4*)(P_HL(F) + m * LRU_W + c); pa[t][j] = *(const f32x4*)(P_PA(F) + m * LRU_W + c);
                yr[t][j] = *(const v2u*)(P_PROJ(F) + m * MIX_IN + C_Y + c); ar[t][j] = *(const v2u*)(P_XH(F) + m * D + LRU_W + c); }
        f32x4 vl[2][4], va[2][4]; float sl[2] = {0.f, 0.f}, sa[2] = {0.f, 0.f};
#pragma unroll
        for (int t = 0; t < 2; ++t)
#pragma unroll
            for (int j = 0; j < 4; ++j) { const int c = 4 * lane + 256 * j; const f32x4 car = *(const LAS f32x4*)(CAR + c);
                const f32x4 h = hl[t][j] + pa[t][j] * car;
                f32x4 v; v.x = h.x * gelu_tanh(bflo(yr[t][j].x)); v.y = h.y * gelu_tanh(bfhi(yr[t][j].x)); v.z = h.z * gelu_tanh(bflo(yr[t][j].y)); v.w = h.w * gelu_tanh(bfhi(yr[t][j].y));
                vl[t][j] = v; sl[t] += (v.x * v.x + v.y * v.y) + (v.z * v.z + v.w * v.w);
                f32x4 a; a.x = bflo(ar[t][j].x); a.y = bfhi(ar[t][j].x); a.z = bflo(ar[t][j].y); a.w = bfhi(ar[t][j].y);
                va[t][j] = a; sa[t] += (a.x * a.x + a.y * a.y) + (a.z * a.z + a.w * a.w); }
#pragma unroll
        for (int o = 1; o < 64; o <<= 1) { sl[0] += __shfl_xor(sl[0], o); sl[1] += __shfl_xor(sl[1], o); sa[0] += __shfl_xor(sa[0], o); sa[1] += __shfl_xor(sa[1], o); }
#pragma unroll
        for (int t = 0; t < 2; ++t) { const float rl = 1.0f / sqrtf(sl[t] * (1.0f / LRU_W) + EPS), ra = 1.0f / sqrtf(sa[t] * (1.0f / LRU_W) + EPS); const size_t m = m0 + t;
#pragma unroll
            for (int j = 0; j < 4; ++j) { const int c = 4 * lane + 256 * j; const f32x4 g1v = *(const f32x4*)(gl + c), g2v = *(const f32x4*)(ga + c);
                const f32x4 y = vl[t][j] * rl * g1v, z = va[t][j] * ra * g2v;
                v2u o; o.x = pk2(y.x, y.y); o.y = pk2(y.z, y.w); *(v2u*)(P_XH(F) + m * D + c) = o;
                v2u p; p.x = pk2(z.x, z.y); p.y = pk2(z.z, z.w); *(v2u*)(P_XH(F) + m * D + LRU_W + c) = p; } }
    }
    __syncthreads();
}
__device__ __forceinline__ void p4_phase(Frame& F) {
    for (int u = F.bid; u < BATCH * (SEQ / LCH); u += F.G) p4_unit(F, u >> 6, u & 63);
}

__device__ __forceinline__ int f2key(float f) { const int b = __builtin_bit_cast(int, f); return b ^ ((b >> 31) & 0x7fffffff); }
__device__ __forceinline__ float key2f(int k) { const int b = k ^ ((k >> 31) & 0x7fffffff); return __builtin_bit_cast(float, b); }
__device__ __forceinline__ void ins16(int (&L)[16], int x) {
#pragma unroll
    for (int j = 0; j < 16; ++j) { const int hi = max(L[j], x); x = min(L[j], x); L[j] = hi; }
}
constexpr int INT_LOWEST = (int)0x80000000;
__device__ __forceinline__ void p8_item(Frame& F, int tt, int hd, LAS int* lut  ) {
    const int lane = F.lane, r = lane & 31, hh = lane >> 5;
    const bf16* QP = P_PROJ(F);
    int V[2][16];
#pragma unroll
    for (int p = 0; p < 2; ++p) {
        bf16x8 qf[8];
        const char* qb = (const char*)(QP + (size_t)(32 * tt) * D + hd * 256 + p * 128);
        const unsigned qoff = (unsigned)(r * D + 8 * hh) * 2u;
#pragma unroll
        for (int ks = 0; ks < 8; ++ks) qf[ks] = *(const bf16x8*)(qb + qoff + 32 * ks);
        int L[16];
#pragma unroll
        for (int j = 0; j < 16; ++j) L[j] = INT_LOWEST;
        const char* skb = (const char*)(P_SK(F) + (size_t)((hd * 2 + p) * PKEYS) * PHALF);
        const unsigned skoff = (unsigned)(r * PHALF + 8 * hh) * 2u;
#pragma unroll 1
        for (int kt = 0; kt < 4; ++kt) {
            f32x16 acc;
#pragma unroll
            for (int i = 0; i < 16; ++i) acc[i] = 0.f;
            const char* skt = skb + (size_t)(32 * kt) * PHALF * 2;
#pragma unroll
            for (int ks = 0; ks < 8; ++ks) { const bf16x8 kf = *(const bf16x8*)(skt + skoff + 32 * ks); acc = MFMA32(kf, qf[ks], acc); }
            const int kbase = 32 * kt + 4 * hh;
#pragma unroll
            for (int i = 0; i < 16; ++i) { const int kidx = (i & 3) + 8 * (i >> 2);
                const int key = (f2key(acc[i]) & ~0x7f) | (kbase + kidx);
                ins16(L, key); }
        }
        int O[16];
#pragma unroll
        for (int j = 0; j < 16; ++j) O[j] = __shfl_xor(L[j], 32);
#pragma unroll
        for (int j = 0; j < 16; ++j) ins16(L, O[j]);
#pragma unroll
        for (int j = 0; j < 16; ++j) V[p][j] = L[j];
    }
#pragma unroll
    for (int j = 0; j < 16; ++j) { lut[lane * 33 + j] = V[0][j] & 0x7f; lut[lane * 33 + 16 + j] = V[1][j] & 0x7f; }
    float v0[16], v1[16];
#pragma unroll
    for (int j = 0; j < 16; ++j) { v0[j] = key2f(V[0][j] & ~0x7f); v1[j] = key2f(V[1][j] & ~0x7f); }
    int C[16];
#pragma unroll
    for (int j = 0; j < 16; ++j) C[j] = INT_LOWEST;
#pragma unroll
    for (int i = 0; i < 16; ++i)
#pragma unroll
        for (int j = 0; j < 16; ++j)
            if ((i + 1) * (j + 1) <= 16) { const int key = (f2key(v0[i] + v1[j]) & ~0xff) | (i * 16 + j); ins16(C, key); }
    float sv[16]; float den = 0.f;
    const float mx = key2f(C[0] & ~0xff);
#pragma unroll
    for (int e = 0; e < 16; ++e) { sv[e] = __expf(key2f(C[e] & ~0xff) - mx); den += sv[e]; }
    const float inv = 1.0f / den;
    LDS_WAIT(); asm volatile("" ::: "memory");
    int idx[16];
#pragma unroll
    for (int e = 0; e < 16; ++e) { const int pi = (C[e] >> 4) & 15, pj = C[e] & 15; idx[e] = lut[lane * 33 + pi] * PKEYS + lut[lane * 33 + 16 + pj]; }
    if (hh == 0) {
        int* ip = P_IDX(F) + (size_t)(32 * tt + r) * 128 + hd * 16; float* gp = P_GW(F) + (size_t)(32 * tt + r) * 128 + hd * 16;
#pragma unroll
        for (int q = 0; q < 4; ++q) { *(v4u*)(ip + 4 * q) = (v4u){(unsigned)idx[4 * q], (unsigned)idx[4 * q + 1], (unsigned)idx[4 * q + 2], (unsigned)idx[4 * q + 3]};
            *(f32x4*)(gp + 4 * q) = (f32x4){sv[4 * q] * inv, sv[4 * q + 1] * inv, sv[4 * q + 2] * inv, sv[4 * q + 3] * inv}; }
    }
    LDS_WAIT(); asm volatile("" ::: "memory");
}
__device__ __forceinline__ void p8_phase(Frame& F) {
    LAS int* lut = (LAS int*)(F.lds + F.wave * (64 * 33 * 4));
    const int gw = F.bid * NWAVES + F.wave, NGW = F.G * NWAVES;
    for (int it = gw; it < (M / 32) * PH; it += NGW) p8_item(F, it >> 3, it & 7, lut);
}

template <int CTRL> __device__ __forceinline__ float dpp_f(float x) { return __builtin_bit_cast(float, __builtin_amdgcn_mov_dpp(__builtin_bit_cast(int, x), CTRL, 0xf, 0xf, true)); }
__device__ __forceinline__ float sum8(float v) {
    v += dpp_f<0xB1>(v);
    v += dpp_f<0x4E>(v);
    v += dpp_f<0x141>(v);
    return v;
}
__device__ __forceinline__ void dec16(const v4u r, float (&f)[16]) {
    const unsigned w4[4] = {r.x, r.y, r.z, r.w};
#pragma unroll
    for (int w = 0; w < 4; ++w) { const f32x2 lo = __builtin_amdgcn_cvt_pk_f32_fp8((int)w4[w], false), hi = __builtin_amdgcn_cvt_pk_f32_fp8((int)w4[w], true);
        f[4 * w] = lo.x; f[4 * w + 1] = lo.y; f[4 * w + 2] = hi.x; f[4 * w + 3] = hi.y; }
}
__device__ __forceinline__ void p9u_item(Frame& F, int s, int tb) {
    const int lane = F.lane, gi = lane >> 3, c8 = lane & 7;
    const unsigned char* U8 = P_U(F);
    const unsigned loff = (unsigned)(128 * s + 16 * c8);
    const int* idxb = P_IDX(F) + (size_t)(64 * tb) * 128 + 8 * gi;
    const bf16* hb = P_XH(F) + (size_t)(64 * tb) * D + 128 * s + 16 * c8;
    float* pb = P_PART(F) + ((size_t)s * M + 64 * tb) * 128 + lane;
    v4u nI[4], nH[2];
    nI[0] = *(const v4u*)(idxb); nI[1] = *(const v4u*)(idxb + 4); nI[2] = *(const v4u*)(idxb + 64); nI[3] = *(const v4u*)(idxb + 68);
    nH[0] = *(const v4u*)(hb); nH[1] = *(const v4u*)(hb + 8);
#pragma unroll 1
    for (int t = 0; t < 64; ++t) {
        const v4u cI[4] = {nI[0], nI[1], nI[2], nI[3]}; const v4u cH[2] = {nH[0], nH[1]};
        { const int tn = (t + 1 < 64) ? t + 1 : 63; const int* ip = idxb + (size_t)tn * 128; const bf16* hp = hb + (size_t)tn * D;
          nI[0] = *(const v4u*)(ip); nI[1] = *(const v4u*)(ip + 4); nI[2] = *(const v4u*)(ip + 64); nI[3] = *(const v4u*)(ip + 68);
          nH[0] = *(const v4u*)(hp); nH[1] = *(const v4u*)(hp + 8); }
        const unsigned idx[16] = {cI[0].x, cI[0].y, cI[0].z, cI[0].w, cI[1].x, cI[1].y, cI[1].z, cI[1].w, cI[2].x, cI[2].y, cI[2].z, cI[2].w, cI[3].x, cI[3].y, cI[3].z, cI[3].w};
        v4u row[16];
#pragma unroll
        for (int i = 0; i < 16; ++i) row[i] = *(const v4u*)(U8 + ((idx[i] << 11) + loff));
        float h2[16];
        h2[0] = bflo(cH[0].x); h2[1] = bfhi(cH[0].x); h2[2] = bflo(cH[0].y); h2[3] = bfhi(cH[0].y); h2[4] = bflo(cH[0].z); h2[5] = bfhi(cH[0].z); h2[6] = bflo(cH[0].w); h2[7] = bfhi(cH[0].w);
        h2[8] = bflo(cH[1].x); h2[9] = bfhi(cH[1].x); h2[10] = bflo(cH[1].y); h2[11] = bfhi(cH[1].y); h2[12] = bflo(cH[1].z); h2[13] = bfhi(cH[1].z); h2[14] = bflo(cH[1].w); h2[15] = bfhi(cH[1].w);
        float res0 = 0.f, res1 = 0.f;
#pragma unroll
        for (int i = 0; i < 16; ++i) { float f[16]; dec16(row[i], f);
            float a0 = f[0] * h2[0], a1 = f[1] * h2[1], a2 = f[2] * h2[2], a3 = f[3] * h2[3];
#pragma unroll
            for (int e = 4; e < 16; e += 4) { a0 = fmaf(f[e], h2[e], a0); a1 = fmaf(f[e + 1], h2[e + 1], a1); a2 = fmaf(f[e + 2], h2[e + 2], a2); a3 = fmaf(f[e + 3], h2[e + 3], a3); }
            const float tot = sum8((a0 + a1) + (a2 + a3));
            if (i < 8) res0 = (c8 == (i & 7)) ? tot : res0; else res1 = (c8 == (i & 7)) ? tot : res1; }
        pb[(size_t)t * 128] = res0; pb[(size_t)t * 128 + 64] = res1;
    }
}
__device__ __forceinline__ void p9v_item(Frame& F, int s, int tb) {
    const int lane = F.lane, gi = lane >> 3, c8 = lane & 7;
    const unsigned char* V8 = P_V(F);
    const unsigned loff = (unsigned)(128 * s + 16 * c8);
    const int* idxb = P_IDX(F) + (size_t)(64 * tb) * 128 + 8 * gi;
    const float* wb = P_W(F) + (size_t)(64 * tb) * 128 + 8 * gi;
    const int b = (64 * tb) / SEQ;
    const int wcol = 128 * s + 16 * c8 + 4 * (gi & 3);
    const f32x4 g2 = *(const f32x4*)(P_ADA(F) + (size_t)b * ADA_W + 5 * D + wcol);
    float* ob = P_out(F) + (size_t)(64 * tb) * D + wcol;
    v4u nI[4]; f32x4 nW[4];
    nI[0] = *(const v4u*)(idxb); nI[1] = *(const v4u*)(idxb + 4); nI[2] = *(const v4u*)(idxb + 64); nI[3] = *(const v4u*)(idxb + 68);
    nW[0] = *(const f32x4*)(wb); nW[1] = *(const f32x4*)(wb + 4); nW[2] = *(const f32x4*)(wb + 64); nW[3] = *(const f32x4*)(wb + 68);
#pragma unroll 1
    for (int t = 0; t < 64; ++t) {
        const v4u cI[4] = {nI[0], nI[1], nI[2], nI[3]}; const f32x4 cW[4] = {nW[0], nW[1], nW[2], nW[3]};
        { const int tn = (t + 1 < 64) ? t + 1 : 63; const int* ip = idxb + (size_t)tn * 128; const float* wp = wb + (size_t)tn * 128;
          nI[0] = *(const v4u*)(ip); nI[1] = *(const v4u*)(ip + 4); nI[2] = *(const v4u*)(ip + 64); nI[3] = *(const v4u*)(ip + 68);
          nW[0] = *(const f32x4*)(wp); nW[1] = *(const f32x4*)(wp + 4); nW[2] = *(const f32x4*)(wp + 64); nW[3] = *(const f32x4*)(wp + 68); }
        const unsigned idx[16] = {cI[0].x, cI[0].y, cI[0].z, cI[0].w, cI[1].x, cI[1].y, cI[1].z, cI[1].w, cI[2].x, cI[2].y, cI[2].z, cI[2].w, cI[3].x, cI[3].y, cI[3].z, cI[3].w};
        const float wv[16] = {cW[0].x, cW[0].y, cW[0].z, cW[0].w, cW[1].x, cW[1].y, cW[1].z, cW[1].w, cW[2].x, cW[2].y, cW[2].z, cW[2].w, cW[3].x, cW[3].y, cW[3].z, cW[3].w};
        v4u row[16];
#pragma unroll
        for (int i = 0; i < 16; ++i) row[i] = *(const v4u*)(V8 + ((idx[i] << 11) + loff));
        const f32x4 x1 = *(const f32x4*)(ob + (size_t)t * D);
        float acc[16];
#pragma unroll
        for (int e = 0; e < 16; ++e) acc[e] = 0.f;
#pragma unroll
        for (int i = 0; i < 16; ++i) { float f[16]; dec16(row[i], f);
#pragma unroll
            for (int e = 0; e < 16; ++e) acc[e] = fmaf(f[e], wv[i], acc[e]); }
#pragma unroll
        for (int e = 0; e < 16; ++e) { float v = acc[e]; v += __shfl_xor(v, 8); v += __shfl_xor(v, 16); v += __shfl_xor(v, 32); acc[e] = v; }
        const int q = gi & 3;
        f32x4 a;
        a.x = q == 0 ? acc[0] : q == 1 ? acc[4] : q == 2 ? acc[8] : acc[12];
        a.y = q == 0 ? acc[1] : q == 1 ? acc[5] : q == 2 ? acc[9] : acc[13];
        a.z = q == 0 ? acc[2] : q == 1 ? acc[6] : q == 2 ? acc[10] : acc[14];
        a.w = q == 0 ? acc[3] : q == 1 ? acc[7] : q == 2 ? acc[11] : acc[15];
        if (gi < 4) *(f32x4*)(ob + (size_t)t * D) = x1 + g2 * a;
    }
}
__device__ __forceinline__ void p9u_phase(Frame& F) {
    const int x = F.bid & 7, rank = F.bid >> 3, nr = F.G >> 3;
    for (int h = 0; h < 2; ++h)
        for (int tb = rank * NWAVES + F.wave; tb < M / 64; tb += nr * NWAVES) p9u_item(F, 2 * x + h, tb);
}
__device__ __forceinline__ void p9v_phase(Frame& F) {
    const int x = F.bid & 7, rank = F.bid >> 3, nr = F.G >> 3;
    for (int h = 0; h < 2; ++h)
        for (int tb = rank * NWAVES + F.wave; tb < M / 64; tb += nr * NWAVES) p9v_item(F, 2 * x + h, tb);
}
__device__ __forceinline__ void p9w_phase(Frame& F) {
    const float* part = P_PART(F); const int* idxp = P_IDX(F); const float* gwp = P_GW(F); const float* usc = P_USC(F); const float* vsc = P_VSC(F); float* wp = P_W(F);
    for (int it = F.bid * 512 + F.tid; it < M * 128; it += F.G * 512) {
        float a = 0.f;
#pragma unroll
        for (int s = 0; s < 16; ++s) a += part[(size_t)s * M * 128 + it];
        const int idx = idxp[it];
        wp[it] = gwp[it] * gelu_tanh(a * usc[idx]) * vsc[idx];
    }
}

struct Args { const void* in[25]; float* out; unsigned char* ws; int ph_lo, ph_hi; };
__global__ void __launch_bounds__(NWAVES * 64, 2) hymba_fwd(Args args) {
    extern __shared__ __attribute__((aligned(16))) unsigned char lds_raw[];
    Frame F;
    F.lds = (LAS unsigned char*)lds_raw;
    F.tid = threadIdx.x; F.lane = F.tid & 63; F.wave = __builtin_amdgcn_readfirstlane(F.tid >> 6);
    F.G = gridDim.x; F.bid = blockIdx.x;
    F.ka = (kaptr_t)__builtin_amdgcn_kernarg_segment_ptr();
    static_assert(sizeof(Args) == 224, "kernarg byte offsets used by ka_ptr");
    for (int u = F.tid; u < (LDS_BYTES - LDSCTL_OFF) / 4; u += NWAVES * 64) ((LAS unsigned*)(F.lds + LDSCTL_OFF))[u] = 0u;
    __syncthreads();
    volatile LAS unsigned* MISC = (volatile LAS unsigned*)(F.lds + MISC_OFF);
    XcdBarrier bar; bar.bar = (unsigned*)(P_ws(F) + WS_CTL) + CW_BAR; bar.x = 0; bar.st = nullptr;
    const int lo = args.ph_lo, hi = args.ph_hi;
    if (hi - lo > 1) bar = xcd_barrier_post((unsigned*)(P_ws(F) + WS_CTL) + CW_BAR, MISC + 8);
#define IN(k) (lo <= (k) && (k) < hi)
#ifndef PROBE_STAMP
#define PROBE_STAMP -1
#define PROBE_DIV 5.0f
#endif
#define STAMP(k) do { if (PROBE_STAMP >= 0 && F.bid == 0 && F.tid == 0) ((unsigned long long*)(P_ws(F) + WS_CTL + 64))[(k)] = __builtin_amdgcn_s_memrealtime(); } while (0)
#define SEAM(k) do { if (IN(k) && IN((k) + 1)) xcd_barrier(bar); STAMP((k) + 1); } while (0)
    STAMP(0);

#ifndef PROBE_MASK
#define PROBE_MASK 0
#endif
#define REP(k) for (int rep_ = 0; rep_ < (((PROBE_MASK >> (k)) & 1) ? 2 : 1); ++rep_)
#define REPSYNC(k) do { if (((PROBE_MASK >> (k)) & 1) && rep_ == 0) xcd_barrier(bar); } while (0)
    if (IN(0)) { REP(0) { p0_prologue(F); REPSYNC(0); } } SEAM(0);
    if (IN(1)) { REP(1) { p1_phase(F); REPSYNC(1); } } SEAM(1);
    if (IN(2)) REP(2) {
        pg8::Gemm g{P_XH(F), P_WIN(F), M, MIX_IN, D}; pg8::StaticOrder S; S.init(M, MIX_IN, F.G, F.bid);
        pg8::EpiStoreBf16 E{P_PROJ(F), MIX_IN};
        pg8::gemm_phase<pg8::EpiStoreBf16, pg8::StaticOrder, true, true>(F.lds, g, S, E); REPSYNC(2);
    } SEAM(2);
    if (IN(3)) { REP(3) { p3_phase(F); REPSYNC(3); } } SEAM(3);
    if (IN(4)) { p4_phase(F); } SEAM(4);
    if (IN(5)) REP(5) {
        pg8::Gemm g{P_XH(F), P_WOUT(F), M, D, D}; pg8::StaticOrder S; S.init(M, D, F.G, F.bid);
        pg8::EpiResid E{P_x(F), P_out(F), D, P_ADA(F) + 2 * D, ADA_W, SEQ};
        pg8::gemm_phase<pg8::EpiResid, pg8::StaticOrder, true, true>(F.lds, g, S, E); REPSYNC(5);
    } SEAM(5);
    if (IN(6)) { REP(6) { p6_phase(F); REPSYNC(6); } } SEAM(6);
    if (IN(7)) REP(7) {
        pg8::Gemm g{P_XH(F), P_WQ(F), M, D, D}; pg8::StaticOrder S; S.init(M, D, F.G, F.bid);
        pg8::EpiStoreBf16 E{P_PROJ(F), D};
        pg8::gemm_phase<pg8::EpiStoreBf16, pg8::StaticOrder, true, true>(F.lds, g, S, E); REPSYNC(7);
    } SEAM(7);
    if (IN(8)) { REP(8) { p8_phase(F); REPSYNC(8); } } SEAM(8);
    if (IN(9)) { p9u_phase(F); } SEAM(9);
    if (IN(10)) { p9w_phase(F); } SEAM(10);
    if (IN(11)) { p9v_phase(F); }
    if (PROBE_STAMP >= 0) {
        __syncthreads(); STAMP(12); VM_WAIT(); __syncthreads();
        if (F.bid == 0 && F.tid == 0) { const unsigned long long* ts = (const unsigned long long*)(P_ws(F) + WS_CTL + 64);
            const float us = (float)(ts[PROBE_STAMP + 1] - ts[PROBE_STAMP]) * 0.01f; P_out(F)[0] += us * (1.0f / PROBE_DIV); }
    }
#undef IN
#undef SEAM
}

extern "C" void kernel_launch(void* const* d_in, const int* in_sizes, int n_in, void* d_out, int out_size, void* d_ws, size_t ws_size, hipStream_t stream) {
    static int grid = 0;
    if (grid == 0) {
        if (n_in != 25 || in_sizes[0] != M * D || out_size != M * D || ws_size < WS_END) {
            fprintf(stderr, "kernel_launch: built for 25 inputs, x/out of %d floats, >= %zu bytes of workspace; got n_in %d, in0 %d, out %d, ws %zu; nothing launched\n", M * D, (size_t)WS_END, n_in, n_in > 0 ? in_sizes[0] : -1, out_size, ws_size);
            grid = -1; return; }
        int dev = 0, cus = 0, per_cu = 0;
        if (hipGetDevice(&dev) != hipSuccess || hipDeviceGetAttribute(&cus, hipDeviceAttributeMultiprocessorCount, dev) != hipSuccess) { fprintf(stderr, "kernel_launch: device query failed\n"); grid = -1; return; }
        if (hipFuncSetAttribute((const void*)hymba_fwd, hipFuncAttributeMaxDynamicSharedMemorySize, LDS_BYTES) != hipSuccess) { fprintf(stderr, "kernel_launch: hipFuncSetAttribute failed\n"); grid = -1; return; }
        if (hipOccupancyMaxActiveBlocksPerMultiprocessor(&per_cu, (const void*)hymba_fwd, NWAVES * 64, LDS_BYTES) != hipSuccess || per_cu < 1) {
            fprintf(stderr, "kernel_launch: occupancy query reports %d workgroups per CU; need 1\n", per_cu); (void)hipGetLastError(); grid = -1; return; }
        grid = cus;
        if (grid % 8 != 0 || (M / 64) % (grid / 8 * NWAVES) != 0) { fprintf(stderr, "kernel_launch: grid %d not supported (needs a multiple of 8 dividing the token blocks)\n", grid); grid = -1; return; }
    }
    if (grid < 0) return;
    if (hipMemsetAsync((char*)d_ws + WS_CTL, 0, CTL_ZERO_BYTES, stream) != hipSuccess) { fprintf(stderr, "kernel_launch: memset failed\n"); return; }
    Args a{};
    for (int i = 0; i < 25; ++i) a.in[i] = d_in[i];
    a.out = (float*)d_out; a.ws = (unsigned char*)d_ws;
    if (N_LAUNCHES == 1) {
        a.ph_lo = 0; a.ph_hi = N_PHASES;
        void* kargs[] = {&a};
        const hipError_t le = hipLaunchCooperativeKernel((const void*)hymba_fwd, dim3(grid), dim3(NWAVES * 64), kargs, LDS_BYTES, stream);
        if (le != hipSuccess) fprintf(stderr, "kernel_launch: cooperative launch failed: %s (grid %d)\n", hipGetErrorName(le), grid);
    } else {
#ifndef PROBE_TWICE
#define PROBE_TWICE 0
#endif
        for (int li = 0; li < N_PHASES; ++li) { a.ph_lo = li; a.ph_hi = li + 1;
            if ((PROBE_TWICE >> li) & 1) hipLaunchKernelGGL(hymba_fwd, dim3(grid), dim3(NWAVES * 64), LDS_BYTES, stream, a);
            hipLaunchKernelGGL(hymba_fwd, dim3(grid), dim3(NWAVES * 64), LDS_BYTES, stream, a);
            const hipError_t le = hipPeekAtLastError();
            if (le != hipSuccess) { fprintf(stderr, "kernel_launch: launch %d failed: %s\n", li, hipGetErrorName(le)); break; } }
    }
}
```

```cpp
#include <hip/hip_runtime.h>
#include <cstdio>
#include <cstdint>
namespace pg8 {
#define PG8_LAS __attribute__((address_space(3)))
typedef unsigned short bf16_t;
typedef short bf16x8 __attribute__((ext_vector_type(8)));
typedef float f32x4 __attribute__((ext_vector_type(4)));
typedef unsigned u32x4 __attribute__((ext_vector_type(4)));
constexpr int BM = 256, BK = 64, HALF = 128, HTB = HALF * BK * 2  , STAGE_BYTES = 8 * HTB, NXCD = 8, WGM = 8;

__host__ __device__ __forceinline__ int lds_byte(int r, int c) { const int st = (r >> 4) * 2 + (c >> 5), rr = r & 15, cc = c & 31, ob = rr * 64 + cc * 2; return st * 1024 + (ob ^ (((ob >> 9) & 1) << 5)); }
__host__ __device__ __forceinline__ void stage_rc(int b, int& R, int& C) { const int st = b / 1024, sb = b % 1024, swz = sb ^ (((sb >> 9) & 1) << 5); R = (st >> 1) * 16 + swz / 64; C = (st & 1) * 32 + (swz % 64) / 2; }
__host__ __device__ __forceinline__ int perm32(int rho) { const int n = rho >> 4, i = rho & 15; return 8 * (i >> 2) + 4 * n + (i & 3); }

struct Unit { int pm, pn; };
struct Gemm { const bf16_t* A; const bf16_t* Bt; int M, N, K; };

struct StaticOrder {
    int nM, nN, nwg, G, c;
    __host__ __device__ void init(int M, int N, int G_, int c_) { nM = M / BM; nN = N / BM; nwg = nM * nN; G = G_; c = c_; }
    __host__ __device__ bool next(int i, Unit& u) const {
        const long L = (long)i * G + c; if (L >= nwg) return false;
        int wgid = (int)L; { const int q = nwg / NXCD, r = nwg % NXCD, xcd = wgid % NXCD, off = wgid / NXCD; wgid = (xcd < r ? xcd * (q + 1) : r * (q + 1) + (xcd - r) * q) + off; }
        const int nig = WGM * nN, gid = wgid / nig, fm = gid * WGM, gsz = (nM - fm) < WGM ? (nM - fm) : WGM;
        u.pm = fm + ((wgid % nig) % gsz); u.pn = (wgid % nig) / gsz; return true;
    }
    __device__ __forceinline__ void a_ready(const Unit&) const {}
    __device__ __forceinline__ void done(const Unit&) const {}
};

__device__ __forceinline__ unsigned cvt_pk_bf16(float lo, float hi) { unsigned r; asm volatile("v_cvt_pk_bf16_f32 %0, %1, %2" : "=v"(r) : "v"(lo), "v"(hi)); return r; }
struct EpiStoreBf16 {
    static constexpr bool PERM = true, AFTER_DRAIN = false;
    bf16_t* O; int ldc;
    __device__ __forceinline__ void operator()(const f32x4 (&acc)[2][2][4][2], const Unit& u, int wr, int wc, int fr, int fq) const {
        const int row0 = u.pm * BM + wr * 64 + fr; const int col0 = u.pn * BM + wc * 32 + 8 * fq;
#pragma unroll
        for (int ai = 0; ai < 2; ++ai)
#pragma unroll
            for (int m = 0; m < 4; ++m) { bf16_t* rowp = O + (size_t)(row0 + ai * HALF + m * 16) * ldc + col0;
#pragma unroll
                for (int bj = 0; bj < 2; ++bj) { const f32x4 v0 = acc[ai][bj][m][0], v1 = acc[ai][bj][m][1];
                    u32x4 w; w.x = cvt_pk_bf16(v0[0], v0[1]); w.y = cvt_pk_bf16(v0[2], v0[3]); w.z = cvt_pk_bf16(v1[0], v1[1]); w.w = cvt_pk_bf16(v1[2], v1[3]);
                    *(u32x4*)(rowp + bj * HALF) = w; } }
    }
};
struct EpiResid {
    static constexpr bool PERM = false, AFTER_DRAIN = false;
    const float* base; float* out; int ldc; const float* gate; int gstride; int rows_per_batch;
    __device__ __forceinline__ void operator()(const f32x4 (&acc)[2][2][4][2], const Unit& u, int wr, int wc, int fr, int fq) const {
        const int b = (u.pm * BM) / rows_per_batch; const float* g = gate + (size_t)b * gstride;
        const int col0 = u.pn * BM + wc * 32 + 4 * fq;
        f32x4 gv[2][2];
#pragma unroll
        for (int bj = 0; bj < 2; ++bj)
#pragma unroll
            for (int n = 0; n < 2; ++n) gv[bj][n] = *(const f32x4*)(g + col0 + bj * HALF + n * 16);
#pragma unroll
        for (int ai = 0; ai < 2; ++ai)
#pragma unroll
            for (int m = 0; m < 4; ++m) { const size_t off = (size_t)(u.pm * BM + ai * HALF + wr * 64 + m * 16 + fr) * ldc + col0;
#pragma unroll
                for (int bj = 0; bj < 2; ++bj)
#pragma unroll
                    for (int n = 0; n < 2; ++n) { const f32x4 bs = *(const f32x4*)(base + off + bj * HALF + n * 16);
                        *(f32x4*)(out + off + bj * HALF + n * 16) = bs + gv[bj][n] * acc[ai][bj][m][n]; }
                if (m & 1) asm volatile("" ::: "memory"); }
    }
};

template <class Epi, class Sched, bool ALIGN_EPI = false, bool SP2 = false>
__device__ __forceinline__ void gemm_phase(PG8_LAS unsigned char* lds, const Gemm g, const Sched& S, const Epi& E) {
    const int tid = threadIdx.x, wid = __builtin_amdgcn_readfirstlane(tid >> 6), lane = tid & 63, wr = wid >> 2, wc = wid & 3, fr = lane & 15, fq = lane >> 4;
    const int K = g.K, nt = K / BK;
    unsigned voffA[2], voffB[2];
#pragma unroll
    for (int i = 0; i < 2; ++i) { int R, C; stage_rc(tid * 16 + i * 8192, R, C); const int Rb = Epi::PERM ? ((R & ~31) + perm32(R & 31)) : R;
        voffA[i] = (unsigned)(R * K + C) * 2u; voffB[i] = (unsigned)(Rb * K + C) * 2u; }
    const size_t kstep = (size_t)(BK * 2);
    const size_t hstep = (size_t)HALF * K * 2;
    const size_t tstep = 2 * hstep;
    const unsigned ldsw = (unsigned)wid * 1024u;
    const int aoff = lds_byte(wr * 64 + fr, fq * 8), boff = lds_byte(wc * 32 + fr, fq * 8);
#define PG8_SA(b, h) (((b) * 2 + (h)) * HTB)
#define PG8_SB(b, h) ((4 + (b) * 2 + (h)) * HTB)
#define PG8_STAGE(bufoff, gbase, voff) do { _Pragma("unroll") for (int _i = 0; _i < 2; ++_i) \
        __builtin_amdgcn_global_load_lds((const unsigned*)((const char*)(gbase) + (voff)[_i]), (PG8_LAS unsigned*)(lds + (bufoff) + ldsw + _i * 8192), 16, 0, 0); } while (0)
#define PG8_LDA(dst, b, h) do { _Pragma("unroll") for (int m = 0; m < 4; ++m) _Pragma("unroll") for (int k = 0; k < 2; ++k) dst[m][k] = *(const PG8_LAS bf16x8*)(lds + PG8_SA(b, h) + aoff + m * 2048 + k * 1024); } while (0)
#define PG8_LDB(dst, b, h) do { _Pragma("unroll") for (int n = 0; n < 2; ++n) _Pragma("unroll") for (int k = 0; k < 2; ++k) dst[n][k] = *(const PG8_LAS bf16x8*)(lds + PG8_SB(b, h) + boff + n * 2048 + k * 1024); } while (0)
#define PG8_MMA(ai, bj, At, Bt) do { __builtin_amdgcn_s_setprio(1); _Pragma("unroll") for (int m = 0; m < 4; ++m) _Pragma("unroll") for (int n = 0; n < 2; ++n) _Pragma("unroll") for (int k = 0; k < 2; ++k) \
        acc[ai][bj][m][n] = __builtin_amdgcn_mfma_f32_16x16x32_bf16(Bt[n][k], At[m][k], acc[ai][bj][m][n], 0, 0, 0); __builtin_amdgcn_s_setprio(0); } while (0)
#define PG8_WAIT_V(n) asm volatile("s_waitcnt vmcnt(" #n ")" ::: "memory")
#define PG8_WAIT_L(n) asm volatile("s_waitcnt lgkmcnt(" #n ")" ::: "memory")
#define PG8_BAR __builtin_amdgcn_s_barrier()
#define PG8_SCHED __builtin_amdgcn_sched_barrier(0)
    Unit cur, nxt; int ui = 0;
    if (!S.next(0, cur)) return;
    f32x4 acc[2][2][4][2];
#pragma unroll
    for (int a = 0; a < 2; ++a)
#pragma unroll
        for (int b = 0; b < 2; ++b)
#pragma unroll
            for (int m = 0; m < 4; ++m)
#pragma unroll
                for (int n = 0; n < 2; ++n) acc[a][b][m][n] = (f32x4){0.f, 0.f, 0.f, 0.f};
    bf16x8 At[4][2], B0[2][2], B1[2][2];
    const char* cA = (const char*)g.A + (size_t)cur.pm * tstep; const char* cB = (const char*)g.Bt + (size_t)cur.pn * tstep;
    S.a_ready(cur);
    if constexpr (SP2) {
        PG8_STAGE(PG8_SB(0, 0), cB, voffB); PG8_STAGE(PG8_SB(0, 1), cB + hstep, voffB); PG8_STAGE(PG8_SA(0, 0), cA, voffA); PG8_STAGE(PG8_SA(0, 1), cA + hstep, voffA);
        if (wr == 1) PG8_BAR;
        PG8_WAIT_V(2); PG8_BAR;
        PG8_STAGE(PG8_SB(1, 0), cB + kstep, voffB); PG8_STAGE(PG8_SA(1, 0), cA + kstep, voffA); PG8_STAGE(PG8_SB(1, 1), cB + hstep + kstep, voffB);
        PG8_WAIT_V(6); PG8_BAR;
    } else {
        PG8_STAGE(PG8_SB(0, 0), cB, voffB); PG8_STAGE(PG8_SA(0, 0), cA, voffA); PG8_STAGE(PG8_SB(0, 1), cB + hstep, voffB); PG8_STAGE(PG8_SA(0, 1), cA + hstep, voffA);
        if (wr == 1) PG8_BAR;
        PG8_WAIT_V(4); PG8_BAR;
        PG8_STAGE(PG8_SB(1, 0), cB + kstep, voffB); PG8_STAGE(PG8_SA(1, 0), cA + kstep, voffA); PG8_STAGE(PG8_SB(1, 1), cB + hstep + kstep, voffB);
        PG8_WAIT_V(6); PG8_BAR;
    }
    for (;;) {
        const bool has_next = S.next(ui + 1, nxt);
        const char* nA = has_next ? (const char*)g.A + (size_t)nxt.pm * tstep : cA; const char* nB = has_next ? (const char*)g.Bt + (size_t)nxt.pn * tstep : cB;
        for (int t = 0; t < nt; t += 2) {
            const bool last = (t == nt - 2);
            const char* a1 = cA + (size_t)(t + 1) * kstep;
            const char* a2 = last ? nA : cA + (size_t)(t + 2) * kstep; const char* b2 = last ? nB : cB + (size_t)(t + 2) * kstep;
            const char* a3 = a2 + kstep; const char* b3 = b2 + kstep;
            if (last && has_next) S.a_ready(nxt);
            if constexpr (SP2) {
            PG8_LDB(B0, 0, 0); PG8_LDB(B1, 0, 1); PG8_SCHED; PG8_LDA(At, 0, 0); PG8_STAGE(PG8_SA(1, 1), a1 + hstep, voffA);
            PG8_WAIT_V(8); PG8_WAIT_L(0); PG8_BAR; PG8_MMA(0, 0, At, B0); PG8_MMA(0, 1, At, B1); PG8_BAR; PG8_SCHED;
            PG8_LDA(At, 0, 1); PG8_STAGE(PG8_SB(0, 0), b2, voffB); PG8_STAGE(PG8_SB(0, 1), b2 + hstep, voffB); PG8_STAGE(PG8_SA(0, 0), a2, voffA);
            PG8_WAIT_V(8); PG8_WAIT_L(0); PG8_BAR; PG8_MMA(1, 0, At, B0); PG8_MMA(1, 1, At, B1); PG8_BAR; PG8_SCHED;
            PG8_LDB(B0, 1, 0); PG8_LDB(B1, 1, 1); PG8_SCHED; PG8_LDA(At, 1, 0); PG8_STAGE(PG8_SA(0, 1), a2 + hstep, voffA);
            PG8_WAIT_V(8); PG8_WAIT_L(0); PG8_BAR; PG8_MMA(0, 0, At, B0); PG8_MMA(0, 1, At, B1); PG8_BAR; PG8_SCHED;
            PG8_LDA(At, 1, 1); PG8_STAGE(PG8_SB(1, 0), b3, voffB); PG8_STAGE(PG8_SB(1, 1), b3 + hstep, voffB); PG8_STAGE(PG8_SA(1, 0), a3, voffA);
            PG8_WAIT_V(8); PG8_WAIT_L(0); PG8_BAR; PG8_MMA(1, 0, At, B0); PG8_MMA(1, 1, At, B1); PG8_BAR; PG8_SCHED;
            } else {
            PG8_LDB(B0, 0, 0); PG8_SCHED; PG8_LDA(At, 0, 0); PG8_STAGE(PG8_SA(1, 1), a1 + hstep, voffA);
            PG8_WAIT_L(8); PG8_BAR; PG8_WAIT_L(0); PG8_MMA(0, 0, At, B0); PG8_BAR; PG8_SCHED;
            PG8_LDB(B1, 0, 1); PG8_STAGE(PG8_SB(0, 0), b2, voffB);
            PG8_BAR; PG8_WAIT_L(0); PG8_MMA(0, 1, At, B1); PG8_BAR;
            PG8_LDA(At, 0, 1); PG8_STAGE(PG8_SA(0, 0), a2, voffA);
            PG8_BAR; PG8_WAIT_L(0); PG8_MMA(1, 0, At, B0); PG8_BAR; PG8_SCHED;
            PG8_STAGE(PG8_SB(0, 1), b2 + hstep, voffB);
            PG8_WAIT_V(6); PG8_BAR; PG8_MMA(1, 1, At, B1); PG8_BAR;
            PG8_LDB(B0, 1, 0); PG8_SCHED; PG8_LDA(At, 1, 0); PG8_STAGE(PG8_SA(0, 1), a2 + hstep, voffA);
            PG8_WAIT_L(8); PG8_BAR; PG8_WAIT_L(0); PG8_MMA(0, 0, At, B0); PG8_BAR; PG8_SCHED;
            PG8_LDB(B1, 1, 1); PG8_STAGE(PG8_SB(1, 0), b3, voffB);
            PG8_BAR; PG8_WAIT_L(0); PG8_MMA(0, 1, At, B1); PG8_BAR;
            PG8_LDA(At, 1, 1); PG8_STAGE(PG8_SA(1, 0), a3, voffA);
            PG8_BAR; PG8_WAIT_L(0); PG8_MMA(1, 0, At, B0); PG8_BAR; PG8_SCHED;
            PG8_STAGE(PG8_SB(1, 1), b3 + hstep, voffB);
            PG8_WAIT_V(6); PG8_BAR; PG8_MMA(1, 1, At, B1); PG8_BAR;
            }
        }
        if constexpr (ALIGN_EPI) { if (wr == 0) PG8_BAR; }
        if constexpr (!Epi::AFTER_DRAIN) { E(acc, cur, wr, wc, fr, fq); S.done(cur); }
        if (!has_next) break;
#pragma unroll
        for (int a = 0; a < 2; ++a)
#pragma unroll
            for (int b = 0; b < 2; ++b)
#pragma unroll
                for (int m = 0; m < 4; ++m)
#pragma unroll
                    for (int n = 0; n < 2; ++n) acc[a][b][m][n] = (f32x4){0.f, 0.f, 0.f, 0.f};
        cur = nxt; cA = nA; cB = nB; ++ui;
        if constexpr (ALIGN_EPI) { if (wr == 1) PG8_BAR; }
    }
    PG8_WAIT_V(0);
    if constexpr (!ALIGN_EPI) { if (wr == 0) PG8_BAR; }
    PG8_BAR;
    if constexpr (Epi::AFTER_DRAIN) { E.fused(acc, cur, wr, wc, fr, fq, lds, wid, lane); S.done(cur); }
#undef PG8_SA
#undef PG8_SB
#undef PG8_STAGE
#undef PG8_LDA
#undef PG8_LDB
#undef PG8_MMA
#undef PG8_WAIT_V
#undef PG8_WAIT_L
#undef PG8_BAR
#undef PG8_SCHED
}
}

constexpr int NWAVES = 8;
#ifndef MK_N_LAUNCHES
#define MK_N_LAUNCHES 1
#endif
constexpr int N_PHASES = 12;
constexpr int N_LAUNCHES = MK_N_LAUNCHES;

constexpr int BATCH = 4, SEQ = 4096, D = 2048, M = BATCH * SEQ;
constexpr int LRU_W = 1024, LRU_HEADS = 8, LRU_BLK = 128;
constexpr int HD = 64, HQ = 16, HKV = 2, GRP = 8;
constexpr int MIX_IN = 3328;
constexpr int C_Y = 1024, C_Q = 2048, C_K = 3072, C_V = 3200;
constexpr int ADA_W = 6 * D;
constexpr int PH = 8, PKEYS = 128, PHALF = 128, PTOPK = 16, NEXP = 16384;
constexpr float EPS = 1e-6f;

constexpr size_t MiB = 1u << 20;
constexpr size_t WS_CTL = 0, CTL_ZERO_BYTES = 1 * MiB;
constexpr size_t WS_ADA = 1 * MiB;
constexpr size_t WS_ROPE = 2 * MiB;
constexpr size_t WS_WIN = 4 * MiB;
constexpr size_t WS_WOUT = 17 * MiB;
constexpr size_t WS_WQ = 25 * MiB;
constexpr size_t WS_WGA = 33 * MiB;
constexpr size_t WS_WGX = 33 * MiB + 256 * 1024;
constexpr size_t WS_SK = 33 * MiB + 512 * 1024;
constexpr size_t WS_IDX = 34 * MiB;
constexpr size_t WS_GW = 42 * MiB;
constexpr size_t WS_U = 50 * MiB;
constexpr size_t WS_V = 82 * MiB;
constexpr size_t WS_USC = 1 * MiB + 512 * 1024;
constexpr size_t WS_VSC = 1 * MiB + 768 * 1024;
constexpr size_t WS_XH = 178 * MiB;
constexpr size_t WS_PROJ = 242 * MiB;
constexpr size_t WS_HL = 346 * MiB;
constexpr size_t WS_PA = 410 * MiB;
constexpr size_t WS_PART = WS_HL;
constexpr size_t WS_W = WS_PROJ + 64 * MiB;
constexpr size_t WS_END = 474 * MiB;
constexpr int CW_BAR = 4096;

constexpr int RING_BYTES = 131072;
constexpr int LDSCTL_OFF = RING_BYTES, MISC_OFF = LDSCTL_OFF + 320;
constexpr int LDS_BYTES = 147456;

#define GAS __attribute__((address_space(1)))
#define LAS __attribute__((address_space(3)))
typedef unsigned short bf16;
typedef unsigned v4u __attribute__((ext_vector_type(4)));
typedef unsigned v2u __attribute__((ext_vector_type(2)));
typedef float f32x4 __attribute__((ext_vector_type(4)));
typedef float f32x2 __attribute__((ext_vector_type(2)));
typedef float f32x16 __attribute__((ext_vector_type(16)));
typedef short bf16x8 __attribute__((ext_vector_type(8)));
typedef __bf16 bf16x2v __attribute__((ext_vector_type(2)));
#define LDS_WAIT() asm volatile("s_waitcnt lgkmcnt(0)" ::: "memory")
#define VM_WAIT() asm volatile("s_waitcnt vmcnt(0)" ::: "memory")
__device__ __forceinline__ unsigned f2bf(float f) { unsigned u = __builtin_bit_cast(unsigned, f); return (u + 0x7fffu + ((u >> 16) & 1u)) >> 16; }
__device__ __forceinline__ unsigned pk2(float lo, float hi) { return f2bf(lo) | (f2bf(hi) << 16); }
__device__ __forceinline__ float bflo(unsigned u) { return __builtin_bit_cast(float, u << 16); }
__device__ __forceinline__ float bfhi(unsigned u) { return __builtin_bit_cast(float, u & 0xffff0000u); }
__device__ __forceinline__ float bf1(bf16 h) { return __builtin_bit_cast(float, (unsigned)h << 16); }
__device__ __forceinline__ float dot2bf(unsigned a, unsigned b, float acc) { return __builtin_amdgcn_fdot2_f32_bf16(__builtin_bit_cast(bf16x2v, a), __builtin_bit_cast(bf16x2v, b), acc, false); }
__device__ __forceinline__ float sigmoidf_(float x) { return 1.0f / (1.0f + __expf(-x)); }
__device__ __forceinline__ float gelu_tanh(float x) {
    const float z = 1.5957691216057308f * (x + 0.044715f * x * x * x);
    return x / (1.0f + __expf(-z));
}
__device__ __forceinline__ float wave_sum(float v) {
#pragma unroll
    for (int o = 1; o < 64; o <<= 1) v += __shfl_xor(v, o);
    return v;
}

#define XB_TMO      128
#define XB_XCNT(j)  (256  + 64 * (j))
#define XB_XSUB(j)  (1280 + 64 * (j))
#define XB_XGEN(j)  (2304 + 64 * (j))
#define XB_TOP      3328
#define XB_TOPGEN   3392
#define XCD_BAR_WORDS 3456
#define XB_SPIN_CAP (1u << 18)
__device__ __forceinline__ unsigned xb_ld(unsigned* p)              { return __hip_atomic_load(p, __ATOMIC_RELAXED, __HIP_MEMORY_SCOPE_AGENT); }
__device__ __forceinline__ unsigned xb_add(unsigned* p, unsigned v) { return __hip_atomic_fetch_add(p, v, __ATOMIC_RELAXED, __HIP_MEMORY_SCOPE_AGENT); }
__device__ __forceinline__ unsigned xb_xcc_id() { return (unsigned)__builtin_amdgcn_s_getreg((3 << 11) | 20) & 0xFu; }
#define XB_SPIN(cond, bar) do { unsigned _sp = 0; while (cond) { __builtin_amdgcn_s_sleep(1); \
    if ((++_sp & 255u) == 0u) { if (xb_ld(&(bar)[XB_TMO])) break; if (_sp > XB_SPIN_CAP) { atomicAdd(&(bar)[XB_TMO], 1u); break; } } } } while (0)
struct XcdBarrier { unsigned* bar; unsigned x; volatile LAS unsigned* st; };
__device__ __forceinline__ XcdBarrier xcd_barrier_post(unsigned* bar, volatile LAS unsigned* st) {
    XcdBarrier b; b.bar = bar; b.x = xb_xcc_id(); b.st = st;
    if (threadIdx.x == 0) (void)xb_add(&bar[XB_XCNT(b.x)], 1u);
    return b;
}
__device__ __forceinline__ void xcd_barrier_complete(unsigned* bar, unsigned x, unsigned& nloc, unsigned& nx) {
    const unsigned G = gridDim.x * gridDim.y * gridDim.z;
    unsigned sum, cnt, mine, sp = 0u;
    for (;;) {
        sum = 0u; cnt = 0u; mine = 0u;
#pragma unroll
        for (unsigned j = 0; j < 16; ++j) { const unsigned c = xb_ld(&bar[XB_XCNT(j)]); sum += c; cnt += (c > 0u) ? 1u : 0u; mine = (j == x) ? c : mine; }
        if (sum == G) break;
        __builtin_amdgcn_s_sleep(1);
        if ((++sp & 255u) == 0u) { if (xb_ld(&bar[XB_TMO])) break; if (sp > XB_SPIN_CAP) { atomicAdd(&bar[XB_TMO], 1u); break; } }
    }
    nloc = mine > 0u ? mine : 1u; nx = cnt > 0u ? cnt : 1u;
}
__device__ __forceinline__ void xcd_barrier(const XcdBarrier& b) {
    asm volatile("s_waitcnt vmcnt(0)" ::: "memory");
    __syncthreads();
    if (threadIdx.x == 0) {
        unsigned* bar = b.bar;
        __builtin_amdgcn_s_waitcnt(0);
        unsigned nloc = b.st[0], nx = b.st[1];
        if (nloc == 0u) { xcd_barrier_complete(bar, b.x, nloc, nx); b.st[0] = nloc; b.st[1] = nx; }
        const unsigned old = xb_add(&bar[XB_XSUB(b.x)], 1u);
        const unsigned gen = old / nloc;
        if (old + 1u == (gen + 1u) * nloc) {
            __builtin_amdgcn_fence(__ATOMIC_RELEASE, "agent");
            asm volatile("s_waitcnt vmcnt(0)" ::: "memory");
            const unsigned og = xb_add(&bar[XB_TOP], 1u);
            const unsigned tg = og / nx;
            if (og + 1u == (tg + 1u) * nx) xb_add(&bar[XB_TOPGEN], 1u);
            else XB_SPIN(xb_ld(&bar[XB_TOPGEN]) == tg, bar);
            __builtin_amdgcn_fence(__ATOMIC_ACQUIRE, "agent");
            xb_add(&bar[XB_XGEN(b.x)], 1u);
            asm volatile("s_waitcnt vmcnt(0)" ::: "memory");
        } else {
            XB_SPIN(xb_ld(&bar[XB_XGEN(b.x)]) == gen, bar);
            __builtin_amdgcn_fence(__ATOMIC_ACQUIRE, "agent");
            asm volatile("s_waitcnt vmcnt(0)" ::: "memory");
        }
    }
    __syncthreads();
}

typedef const __attribute__((address_space(4))) unsigned char* kaptr_t;
struct Frame { LAS unsigned char* lds; int tid, lane, wave, G, bid; kaptr_t ka; };
template <class T> __device__ __forceinline__ T* ka_ptr(const Frame& F, int byte_off) { typedef T* tp; return *(const __attribute__((address_space(4))) tp*)(F.ka + byte_off); }
__device__ __forceinline__ const float* P_x(const Frame& F) { return ka_ptr<const float>(F, 0); }
__device__ __forceinline__ const float* P_c(const Frame& F) { return ka_ptr<const float>(F, 8); }
__device__ __forceinline__ const int* P_pos(const Frame& F) { return ka_ptr<const int>(F, 16); }
__device__ __forceinline__ const float* P_w_ada(const Frame& F) { return ka_ptr<const float>(F, 24); }
__device__ __forceinline__ const float* P_b_ada(const Frame& F) { return ka_ptr<const float>(F, 32); }
__device__ __forceinline__ const float* P_norm1_g(const Frame& F) { return ka_ptr<const float>(F, 40); }
__device__ __forceinline__ const float* P_w_in(const Frame& F) { return ka_ptr<const float>(F, 48); }
__device__ __forceinline__ const float* P_conv_w(const Frame& F) { return ka_ptr<const float>(F, 56); }
__device__ __forceinline__ const float* P_conv_b(const Frame& F) { return ka_ptr<const float>(F, 64); }
__device__ __forceinline__ const float* P_ga_w(const Frame& F) { return ka_ptr<const float>(F, 72); }
__device__ __forceinline__ const float* P_ga_b(const Frame& F) { return ka_ptr<const float>(F, 80); }
__device__ __forceinline__ const float* P_gx_w(const Frame& F) { return ka_ptr<const float>(F, 88); }
__device__ __forceinline__ const float* P_gx_b(const Frame& F) { return ka_ptr<const float>(F, 96); }
__device__ __forceinline__ const float* P_lam(const Frame& F) { return ka_ptr<const float>(F, 104); }
__device__ __forceinline__ const float* P_qn_g(const Frame& F) { return ka_ptr<const float>(F, 112); }
__device__ __forceinline__ const float* P_kn_g(const Frame& F) { return ka_ptr<const float>(F, 120); }
__device__ __forceinline__ const float* P_sinks(const Frame& F) { return ka_ptr<const float>(F, 128); }
__device__ __forceinline__ const float* P_on_lru_g(const Frame& F) { return ka_ptr<const float>(F, 136); }
__device__ __forceinline__ const float* P_on_attn_g(const Frame& F) { return ka_ptr<const float>(F, 144); }
__device__ __forceinline__ const float* P_w_out(const Frame& F) { return ka_ptr<const float>(F, 152); }
__device__ __forceinline__ const float* P_norm2_g(const Frame& F) { return ka_ptr<const float>(F, 160); }
__device__ __forceinline__ const float* P_w_pq(const Frame& F) { return ka_ptr<const float>(F, 168); }
__device__ __forceinline__ const float* P_sub_keys(const Frame& F) { return ka_ptr<const float>(F, 176); }
__device__ __forceinline__ const float* P_pu(const Frame& F) { return ka_ptr<const float>(F, 184); }
__device__ __forceinline__ const float* P_pv(const Frame& F) { return ka_ptr<const float>(F, 192); }
__device__ __forceinline__ float* P_out(const Frame& F) { return ka_ptr<float>(F, 200); }
__device__ __forceinline__ unsigned char* P_ws(const Frame& F) { return ka_ptr<unsigned char>(F, 208); }
__device__ __forceinline__ float* P_ADA(const Frame& F) { return (float*)(P_ws(F) + WS_ADA); }
__device__ __forceinline__ float* P_ROPE(const Frame& F) { return (float*)(P_ws(F) + WS_ROPE); }
__device__ __forceinline__ float* P_HL(const Frame& F) { return (float*)(P_ws(F) + WS_HL); }
__device__ __forceinline__ float* P_PA(const Frame& F) { return (float*)(P_ws(F) + WS_PA); }
__device__ __forceinline__ float* P_GW(const Frame& F) { return (float*)(P_ws(F) + WS_GW); }
__device__ __forceinline__ unsigned short* P_IDX(const Frame& F) { return (unsigned short*)(P_ws(F) + WS_IDX); }
__device__ __forceinline__ bf16* P_WIN(const Frame& F) { return (bf16*)(P_ws(F) + WS_WIN); }
__device__ __forceinline__ bf16* P_WOUT(const Frame& F) { return (bf16*)(P_ws(F) + WS_WOUT); }
__device__ __forceinline__ bf16* P_WQ(const Frame& F) { return (bf16*)(P_ws(F) + WS_WQ); }
__device__ __forceinline__ bf16* P_WGA(const Frame& F) { return (bf16*)(P_ws(F) + WS_WGA); }
__device__ __forceinline__ bf16* P_WGX(const Frame& F) { return (bf16*)(P_ws(F) + WS_WGX); }
__device__ __forceinline__ bf16* P_SK(const Frame& F) { return (bf16*)(P_ws(F) + WS_SK); }
__device__ __forceinline__ unsigned char* P_U(const Frame& F) { return (unsigned char*)(P_ws(F) + WS_U); }
__device__ __forceinline__ float* P_PART(const Frame& F) { return (float*)(P_ws(F) + WS_PART); }
__device__ __forceinline__ bf16* P_W(const Frame& F) { return (bf16*)(P_ws(F) + WS_W); }
__device__ __forceinline__ float* P_USC(const Frame& F) { return (float*)(P_ws(F) + WS_USC); }
__device__ __forceinline__ float* P_VSC(const Frame& F) { return (float*)(P_ws(F) + WS_VSC); }
__device__ __forceinline__ unsigned char* P_V(const Frame& F) { return (unsigned char*)(P_ws(F) + WS_V); }
__device__ __forceinline__ bf16* P_XH(const Frame& F) { return (bf16*)(P_ws(F) + WS_XH); }
__device__ __forceinline__ bf16* P_PROJ(const Frame& F) { return (bf16*)(P_ws(F) + WS_PROJ); }

__device__ __forceinline__ void p0_transpose_item(const float* W, int K, int N, bf16* WT, LAS float* scr, int item, int lane) {
    const int nblk = N / 32, kb = item / nblk, nb = item % nblk, k0 = 64 * kb, n0 = 32 * nb;
#pragma unroll 8
    for (int i = 0; i < 32; ++i) { const int kk = 2 * i + (lane >> 5); scr[kk * 33 + (lane & 31)] = W[(size_t)(k0 + kk) * N + n0 + (lane & 31)]; }
    LDS_WAIT(); asm volatile("" ::: "memory");
    const int c = lane & 7;
#pragma unroll
    for (int j = 0; j < 4; ++j) { const int n = (lane >> 3) + 8 * j; const LAS float* s = scr + (8 * c) * 33 + n;
        v4u o; o.x = pk2(s[0 * 33], s[1 * 33]); o.y = pk2(s[2 * 33], s[3 * 33]); o.z = pk2(s[4 * 33], s[5 * 33]); o.w = pk2(s[6 * 33], s[7 * 33]);
        *(v4u*)(WT + (size_t)(n0 + n) * K + k0 + 8 * c) = o; }
    LDS_WAIT(); asm volatile("" ::: "memory");
}
__device__ __forceinline__ void p0_convert(const float* src, bf16* dst, size_t n8, size_t gtid, size_t gthreads) {
    for (size_t i = gtid; i < n8; i += gthreads) {
        const f32x4 a = *(const f32x4*)(src + 8 * i), b = *(const f32x4*)(src + 8 * i + 4);
        v4u o; o.x = pk2(a.x, a.y); o.y = pk2(a.z, a.w); o.z = pk2(b.x, b.y); o.w = pk2(b.z, b.w);
        *(v4u*)(dst + 8 * i) = o;
    }
}
__device__ __forceinline__ void p0_prologue(Frame& F) {
    {
        LAS float* sc = (LAS float*)F.lds;
        LAS float* red = sc + 4 * D;
        for (int i = F.tid; i < 4 * D; i += 512) { const float v = P_c(F)[i]; sc[i] = v / (1.0f + __expf(-v)); }
        __syncthreads();
        for (int cg = F.bid; cg < ADA_W / 64; cg += F.G) {
            const int n0 = cg * 64, k0 = F.wave * 256;
            const float* wp = P_w_ada(F) + (size_t)k0 * ADA_W + n0 + F.lane;
            float a0 = 0.f, a1 = 0.f, a2 = 0.f, a3 = 0.f;
#pragma unroll 16
            for (int k = 0; k < 256; ++k) { const float w = wp[(size_t)k * ADA_W]; const int kk = k0 + k;
                a0 += sc[kk] * w; a1 += sc[D + kk] * w; a2 += sc[2 * D + kk] * w; a3 += sc[3 * D + kk] * w; }
            red[(F.wave * 4 + 0) * 64 + F.lane] = a0; red[(F.wave * 4 + 1) * 64 + F.lane] = a1;
            red[(F.wave * 4 + 2) * 64 + F.lane] = a2; red[(F.wave * 4 + 3) * 64 + F.lane] = a3;
            __syncthreads();
            if (F.tid < 256) { const int b = F.tid >> 6, l = F.tid & 63; float s = 0.f;
#pragma unroll
                for (int w = 0; w < 8; ++w) s += red[(w * 4 + b) * 64 + l];
                P_ADA(F)[(size_t)b * ADA_W + n0 + l] = s + P_b_ada(F)[n0 + l]; }
            __syncthreads();
        }
        __syncthreads();
    }
    {
        LAS float* scr = (LAS float*)(F.lds + F.wave * 16384);
        const int gw = F.bid * NWAVES + F.wave, NGW = F.G * NWAVES;
        constexpr int I_IN = (D / 64) * (MIX_IN / 32), I_SQ = (D / 64) * (D / 32), I_G = (LRU_BLK / 64) * (LRU_BLK / 32);
        constexpr int NITEMS = I_IN + 2 * I_SQ + 16 * I_G;
        for (int it = gw; it < NITEMS; it += NGW) {
            int r = it;
            if (r < I_IN) { p0_transpose_item(P_w_in(F), D, MIX_IN, P_WIN(F), scr, r, F.lane); continue; } r -= I_IN;
            if (r < I_SQ) { p0_transpose_item(P_w_out(F), D, D, P_WOUT(F), scr, r, F.lane); continue; } r -= I_SQ;
            if (r < I_SQ) { p0_transpose_item(P_w_pq(F), D, D, P_WQ(F), scr, r, F.lane); continue; } r -= I_SQ;
            const int g = r / I_G, ri = r % I_G, hd = g & 7;
            if (g < 8) p0_transpose_item(P_ga_w(F) + (size_t)hd * 16384, LRU_BLK, LRU_BLK, P_WGA(F) + (size_t)hd * 16384, scr, ri, F.lane);
            else       p0_transpose_item(P_gx_w(F) + (size_t)hd * 16384, LRU_BLK, LRU_BLK, P_WGX(F) + (size_t)hd * 16384, scr, ri, F.lane);
        }
    }
    {
        const size_t gtid = (size_t)F.bid * 512 + F.tid, gth = (size_t)F.G * 512;
        p0_convert(P_sub_keys(F), P_SK(F), (size_t)PH * 2 * PKEYS * PHALF / 8, gtid, gth);
    }
    {
        const int gw = F.bid * NWAVES + F.wave, NGW = F.G * NWAVES;
        for (int rr = gw; rr < 2 * NEXP; rr += NGW) {
            const int tbl = rr >= NEXP, row = rr - tbl * NEXP;
            const float* srcp = (tbl ? P_pv(F) : P_pu(F)) + (size_t)row * D;
            unsigned char* dstp = (tbl ? P_V(F) : P_U(F)) + (size_t)row * D;
            f32x4 v[8]; float mx = 0.f;
#pragma unroll
            for (int j = 0; j < 8; ++j) { v[j] = *(const f32x4*)(srcp + 4 * F.lane + 256 * j);
                mx = fmaxf(fmaxf(mx, fmaxf(fabsf(v[j].x), fabsf(v[j].y))), fmaxf(fabsf(v[j].z), fabsf(v[j].w))); }
#pragma unroll
            for (int o = 1; o < 64; o <<= 1) mx = fmaxf(mx, __shfl_xor(mx, o));
            const float s = fmaxf(mx, 1e-30f) * (1.0f / 224.0f), inv = 1.0f / s;
#pragma unroll
            for (int j = 0; j < 8; ++j) { int t = __builtin_amdgcn_cvt_pk_fp8_f32(v[j].x * inv, v[j].y * inv, 0, false);
                t = __builtin_amdgcn_cvt_pk_fp8_f32(v[j].z * inv, v[j].w * inv, t, true);
                *(int*)(dstp + 4 * F.lane + 256 * j) = t; }
            if (F.lane == 0) (tbl ? P_VSC(F) : P_USC(F))[row] = s;
        }
    }
}

__device__ __forceinline__ void modnorm_rows4(const float* xrow, const float* gain, const float* shift, const float* scale, bf16* orow, int lane) {
    f32x4 v[4][8]; float s[4];
#pragma unroll
    for (int r = 0; r < 4; ++r) { s[r] = 0.f;
#pragma unroll
        for (int j = 0; j < 8; ++j) v[r][j] = *(const f32x4*)(xrow + (size_t)r * D + 4 * lane + 256 * j); }
#pragma unroll
    for (int r = 0; r < 4; ++r)
#pragma unroll
        for (int j = 0; j < 8; ++j) s[r] += (v[r][j].x * v[r][j].x + v[r][j].y * v[r][j].y) + (v[r][j].z * v[r][j].z + v[r][j].w * v[r][j].w);
#pragma unroll
    for (int o = 1; o < 64; o <<= 1) {
#pragma unroll
        for (int r = 0; r < 4; ++r) s[r] += __shfl_xor(s[r], o); }
    float rstd[4];
#pragma unroll
    for (int r = 0; r < 4; ++r) rstd[r] = 1.0f / sqrtf(s[r] * (1.0f / D) + EPS);
#pragma unroll
    for (int j = 0; j < 8; ++j) {
        const int c = 4 * lane + 256 * j;
        const f32x4 g = *(const f32x4*)(gain + c), sh = *(const f32x4*)(shift + c), sc = *(const f32x4*)(scale + c);
        const f32x4 gm = g * (sc + 1.0f);
#pragma unroll
        for (int r = 0; r < 4; ++r) { const f32x4 y = (v[r][j] * rstd[r]) * gm + sh;
            v2u o; o.x = pk2(y.x, y.y); o.y = pk2(y.z, y.w);
            *(v2u*)(orow + (size_t)r * D + c) = o; }
    }
}
__device__ __forceinline__ void p1_phase(Frame& F) {
    const int gw = F.bid * NWAVES + F.wave, NGW = F.G * NWAVES;
    for (int m = 4 * gw; m < M; m += 4 * NGW) { const int b = m / SEQ; const float* ada = P_ADA(F) + (size_t)b * ADA_W;
        modnorm_rows4(P_x(F) + (size_t)m * D, P_norm1_g(F), ada, ada + D, P_XH(F) + (size_t)m * D, F.lane); }
    const float invf[8] = {1.0f, 1.9392274e-01f, 3.7606031e-02f, 7.2926646e-03f, 1.4142136e-03f, 2.7424819e-04f, 5.3182961e-05f, 1.0313386e-05f};
    for (int i = F.bid * 512 + F.tid; i < M * 8; i += F.G * 512) { const int m = i >> 3, k = i & 7;
        float f = invf[0];
#pragma unroll
        for (int q = 1; q < 8; ++q) f = (k == q) ? invf[q] : f;
        const float ang = (float)P_pos(F)[m] * f; float sn, cs; sincosf(ang, &sn, &cs);
        P_ROPE(F)[(size_t)m * 16 + k] = cs; P_ROPE(F)[(size_t)m * 16 + 8 + k] = sn; }
}
__device__ __forceinline__ void p6_phase(Frame& F) {
    const int gw = F.bid * NWAVES + F.wave, NGW = F.G * NWAVES;
    for (int m = 4 * gw; m < M; m += 4 * NGW) { const int b = m / SEQ; const float* ada = P_ADA(F) + (size_t)b * ADA_W;
        modnorm_rows4(P_out(F) + (size_t)m * D, P_norm2_g(F), ada + 3 * D, ada + 4 * D, P_XH(F) + (size_t)m * D, F.lane); }
}

#define MFMA32(a, b, c) __builtin_amdgcn_mfma_f32_32x32x16_bf16((a), (b), (c), 0, 0, 0)
#define MFMA16(a, b, c) __builtin_amdgcn_mfma_f32_16x16x32_bf16((a), (b), (c), 0, 0, 0)
constexpr int KS_STRIDE = 72;
constexpr int VT_STRIDE = 264;
constexpr int ATT_KS_OFF = 0, ATT_VT_OFF = 256 * KS_STRIDE * 2;
static_assert(ATT_VT_OFF + 64 * VT_STRIDE * 2 <= RING_BYTES, "attention LDS");

__device__ __forceinline__ void attn_unit(Frame& F, int b, int g, int n) {
    LAS bf16* Ks = (LAS bf16*)(F.lds + ATT_KS_OFF);
    LAS bf16* VT = (LAS bf16*)(F.lds + ATT_VT_OFF);
    const int tid = F.tid, lane = F.lane;
    {
        const int kb = tid >> 1, hf = tid & 1; const int t = n * 128 - 128 + kb;
        float kv[32]; v4u vraw[4];
        if (t >= 0) {
            const bf16* kp = P_PROJ(F) + (size_t)(b * SEQ + t) * MIX_IN + C_K + g * HD + 32 * hf;
            const bf16* vp = P_PROJ(F) + (size_t)(b * SEQ + t) * MIX_IN + C_V + g * HD + 32 * hf;
#pragma unroll
            for (int q = 0; q < 4; ++q) { const v4u r = *(const v4u*)(kp + 8 * q); vraw[q] = *(const v4u*)(vp + 8 * q);
                kv[8 * q + 0] = bflo(r.x); kv[8 * q + 1] = bfhi(r.x); kv[8 * q + 2] = bflo(r.y); kv[8 * q + 3] = bfhi(r.y);
                kv[8 * q + 4] = bflo(r.z); kv[8 * q + 5] = bfhi(r.z); kv[8 * q + 6] = bflo(r.w); kv[8 * q + 7] = bfhi(r.w); }
        } else {
#pragma unroll
            for (int q = 0; q < 4; ++q) vraw[q] = (v4u){0u, 0u, 0u, 0u};
#pragma unroll
            for (int q = 0; q < 32; ++q) kv[q] = 0.f;
        }
        float ss = 0.f;
#pragma unroll
        for (int q = 0; q < 32; ++q) ss += kv[q] * kv[q];
        ss += __shfl_xor(ss, 1);
        const float rstd = 1.0f / sqrtf(ss * (1.0f / HD) + EPS);
#pragma unroll
        for (int q = 0; q < 32; ++q) kv[q] = kv[q] * rstd * P_kn_g(F)[32 * hf + q];
        if (hf == 0 && t >= 0) {
            const float* rp = P_ROPE(F) + (size_t)(b * SEQ + t) * 16;
#pragma unroll
            for (int i = 0; i < 8; ++i) { const float cs = rp[i], sn = rp[8 + i]; const float x1 = kv[i], x2 = kv[8 + i];
                kv[i] = x1 * cs - x2 * sn; kv[8 + i] = x2 * cs + x1 * sn; }
        }
#pragma unroll
        for (int q = 0; q < 4; ++q) { v4u o; o.x = pk2(kv[8 * q], kv[8 * q + 1]); o.y = pk2(kv[8 * q + 2], kv[8 * q + 3]); o.z = pk2(kv[8 * q + 4], kv[8 * q + 5]); o.w = pk2(kv[8 * q + 6], kv[8 * q + 7]);
            *(LAS v4u*)(Ks + kb * KS_STRIDE + 32 * hf + 8 * q) = o; }
#pragma unroll
        for (int q = 0; q < 4; ++q) { const unsigned w[4] = {vraw[q].x, vraw[q].y, vraw[q].z, vraw[q].w};
#pragma unroll
            for (int e = 0; e < 4; ++e) { const int d = 32 * hf + 8 * q + 2 * e;
                VT[d * VT_STRIDE + kb] = (bf16)(w[e] & 0xffffu); VT[(d + 1) * VT_STRIDE + kb] = (bf16)(w[e] >> 16); } }
    }
    __syncthreads();
    const int hq = g * GRP + F.wave, r = lane & 31, hh = lane >> 5;
    const float sink = P_sinks(F)[hq];
    for (int qi = 0; qi < 4; ++qi) {
        const int tq = n * 128 + 32 * qi + r;
        bf16x8 qf[4];
        {
            const bf16* qp = P_PROJ(F) + (size_t)(b * SEQ + tq) * MIX_IN + C_Q + hq * HD + 8 * hh;
            float qv[4][8]; float ss = 0.f;
#pragma unroll
            for (int ks = 0; ks < 4; ++ks) { const v4u rr = *(const v4u*)(qp + 16 * ks);
                qv[ks][0] = bflo(rr.x); qv[ks][1] = bfhi(rr.x); qv[ks][2] = bflo(rr.y); qv[ks][3] = bfhi(rr.y);
                qv[ks][4] = bflo(rr.z); qv[ks][5] = bfhi(rr.z); qv[ks][6] = bflo(rr.w); qv[ks][7] = bfhi(rr.w);
#pragma unroll
                for (int j = 0; j < 8; ++j) ss += qv[ks][j] * qv[ks][j]; }
            ss += __shfl_xor(ss, 32);
            const float rstd = 1.0f / sqrtf(ss * (1.0f / HD) + EPS);
#pragma unroll
            for (int ks = 0; ks < 4; ++ks)
#pragma unroll
                for (int j = 0; j < 8; ++j) qv[ks][j] = qv[ks][j] * rstd * P_qn_g(F)[16 * ks + 8 * hh + j];
            const float* rp = P_ROPE(F) + (size_t)(b * SEQ + tq) * 16;
#pragma unroll
            for (int j = 0; j < 8; ++j) { const float mine = qv[0][j], other = __shfl_xor(mine, 32); const float cs = rp[j], sn = rp[8 + j];
                qv[0][j] = hh == 0 ? (mine * cs - other * sn) : (mine * cs + other * sn); }
#pragma unroll
            for (int ks = 0; ks < 4; ++ks) { v4u o; o.x = pk2(qv[ks][0] * 0.125f, qv[ks][1] * 0.125f); o.y = pk2(qv[ks][2] * 0.125f, qv[ks][3] * 0.125f);
                o.z = pk2(qv[ks][4] * 0.125f, qv[ks][5] * 0.125f); o.w = pk2(qv[ks][6] * 0.125f, qv[ks][7] * 0.125f); qf[ks] = __builtin_bit_cast(bf16x8, o); }
        }
        f32x16 s[5];
#pragma unroll
        for (int kj = 0; kj < 5; ++kj) {
            f32x16 acc;
#pragma unroll
            for (int i = 0; i < 16; ++i) acc[i] = 0.f;
            const LAS bf16* kp = Ks + (32 * (qi + kj) + r) * KS_STRIDE + 8 * hh;
#pragma unroll
            for (int ks = 0; ks < 4; ++ks) { const bf16x8 kf = *(const LAS bf16x8*)(kp + 16 * ks); acc = MFMA32(kf, qf[ks], acc); }
            s[kj] = acc;
        }
        float mx = sink;
#pragma unroll
        for (int kj = 0; kj < 5; ++kj)
#pragma unroll
            for (int i = 0; i < 16; ++i) { const int kt = (i & 3) + 8 * (i >> 2) + 4 * hh; const int kbi = 32 * (qi + kj) + kt;
                bool valid = (n * 128 + kbi - 128) >= 0;
                if (kj == 0) valid = valid && (kt > r);
                if (kj == 4) valid = valid && (kt <= r);
                s[kj][i] = valid ? s[kj][i] : -INFINITY; mx = fmaxf(mx, s[kj][i]); }
        mx = fmaxf(mx, __shfl_xor(mx, 32));
        float l = 0.f;
#pragma unroll
        for (int kj = 0; kj < 5; ++kj)
#pragma unroll
            for (int i = 0; i < 16; ++i) { const float p = __expf(s[kj][i] - mx); s[kj][i] = p; l += p; }
        l += __shfl_xor(l, 32);
        l += __expf(sink - mx);
        const float inv = 1.0f / l;
        f32x16 o0, o1;
#pragma unroll
        for (int i = 0; i < 16; ++i) { o0[i] = 0.f; o1[i] = 0.f; }
#pragma unroll
        for (int kj = 0; kj < 5; ++kj)
#pragma unroll
            for (int st = 0; st < 2; ++st) {
                v4u pa; pa.x = pk2(s[kj][8 * st + 0] * inv, s[kj][8 * st + 1] * inv); pa.y = pk2(s[kj][8 * st + 2] * inv, s[kj][8 * st + 3] * inv);
                pa.z = pk2(s[kj][8 * st + 4] * inv, s[kj][8 * st + 5] * inv); pa.w = pk2(s[kj][8 * st + 6] * inv, s[kj][8 * st + 7] * inv);
                const bf16x8 pf = __builtin_bit_cast(bf16x8, pa);
                const int kb0 = 32 * (qi + kj) + 16 * st + 4 * hh;
                const LAS bf16* v0p = VT + r * VT_STRIDE + kb0; const LAS bf16* v1p = VT + (32 + r) * VT_STRIDE + kb0;
                const v2u a0 = *(const LAS v2u*)v0p, a1 = *(const LAS v2u*)(v0p + 8), b0 = *(const LAS v2u*)v1p, b1 = *(const LAS v2u*)(v1p + 8);
                const v4u vb0 = {a0.x, a0.y, a1.x, a1.y}, vb1 = {b0.x, b0.y, b1.x, b1.y};
                o0 = MFMA32(pf, __builtin_bit_cast(bf16x8, vb0), o0);
                o1 = MFMA32(pf, __builtin_bit_cast(bf16x8, vb1), o1);
            }
#pragma unroll
        for (int i = 0; i < 16; ++i) { const int qr = (i & 3) + 8 * (i >> 2) + 4 * hh; const int tok = n * 128 + 32 * qi + qr;
            bf16* op = P_XH(F) + (size_t)(b * SEQ + tok) * D + LRU_W + hq * HD + r;
            op[0] = (bf16)f2bf(o0[i]); op[32] = (bf16)f2bf(o1[i]); }
    }
    __syncthreads();
}

constexpr int LCH = 64;
constexpr int XC_STRIDE = 136;
constexpr int LRU_XCB_OFF = 0, LRU_XCF_OFF = LCH * XC_STRIDE * 2  , LRU_A_OFF = LRU_XCF_OFF + LCH * 128 * 4, LRU_B_OFF = LRU_A_OFF + LCH * 128 * 4, LRU_SE_OFF = LRU_B_OFF + LCH * 128 * 4;
static_assert(LRU_SE_OFF + 2 * 4 * 128 * 4 <= RING_BYTES, "LRU LDS");
__device__ __forceinline__ void lru_block(Frame& F) {
    LAS bf16* XCb = (LAS bf16*)(F.lds + LRU_XCB_OFF);
    LAS float* XCF = (LAS float*)(F.lds + LRU_XCF_OFF);
    LAS float* As = (LAS float*)(F.lds + LRU_A_OFF);
    LAS float* Bs = (LAS float*)(F.lds + LRU_B_OFF);
    LAS float* SEh = (LAS float*)(F.lds + LRU_SE_OFF);
    LAS float* SEp = SEh + 4 * 128;
    const int tid = F.tid, lane = F.lane;
    const int hd = F.bid & 7, li = F.bid >> 3, step = F.G >> 3;
    constexpr int NQ = BATCH * (SEQ / LCH);
    if (li >= NQ) return;
    const int cg = tid & 15, tp = tid >> 4, colc = hd * LRU_BLK + 8 * cg;
    float cw[4][8], cbv[8];
#pragma unroll
    for (int k = 0; k < 4; ++k) { const f32x4 a = *(const f32x4*)(P_conv_w(F) + k * LRU_W + colc), b2 = *(const f32x4*)(P_conv_w(F) + k * LRU_W + colc + 4);
        cw[k][0] = a.x; cw[k][1] = a.y; cw[k][2] = a.z; cw[k][3] = a.w; cw[k][4] = b2.x; cw[k][5] = b2.y; cw[k][6] = b2.z; cw[k][7] = b2.w; }
    { const f32x4 a = *(const f32x4*)(P_conv_b(F) + colc), b2 = *(const f32x4*)(P_conv_b(F) + colc + 4);
      cbv[0] = a.x; cbv[1] = a.y; cbv[2] = a.z; cbv[3] = a.w; cbv[4] = b2.x; cbv[5] = b2.y; cbv[6] = b2.z; cbv[7] = b2.w; }
    const int fr = lane & 15, fq = lane >> 4, j = 16 * F.wave + fr, jc = hd * LRU_BLK + j;
    bf16x8 wa[4], wx[4];
    { const bf16* wap = P_WGA(F) + (size_t)hd * 16384 + (size_t)j * 128 + 8 * fq; const bf16* wxp = P_WGX(F) + (size_t)hd * 16384 + (size_t)j * 128 + 8 * fq;
#pragma unroll
      for (int ks = 0; ks < 4; ++ks) { wa[ks] = *(const bf16x8*)(wap + 32 * ks); wx[ks] = *(const bf16x8*)(wxp + 32 * ks); } }
    const float ba = P_ga_b(F)[jc], bx = P_gx_b(F)[jc];
    const float sp8 = -8.0f * log1pf(__expf(-P_lam(F)[jc]));
    const int c = tid & 127, sub = tid >> 7, col = hd * LRU_BLK + c;
    const bf16* xbase = P_PROJ(F) + colc;
    float* HLp = P_HL(F); float* PAp = P_PA(F);
    v4u xr[5];
#define LRU_LOAD_X(q_) do { const int b_ = (q_) >> 6, ch_ = (q_) & 63; const int tr_ = ch_ * LCH + 2 * tp - 3; \
        _Pragma("unroll") for (int r_ = 0; r_ < 5; ++r_) { const int t_ = tr_ + r_; \
            xr[r_] = (t_ >= 0) ? *(const v4u*)(xbase + (size_t)(b_ * SEQ + t_) * MIX_IN) : (v4u){0u, 0u, 0u, 0u}; } } while (0)
    LRU_LOAD_X(li);
    for (int q = li; q < NQ; q += step) {
        const int b = q >> 6, ch = q & 63, t0 = ch * LCH;
        {
            float xv[5][8];
#pragma unroll
            for (int r = 0; r < 5; ++r) { xv[r][0] = bflo(xr[r].x); xv[r][1] = bfhi(xr[r].x); xv[r][2] = bflo(xr[r].y); xv[r][3] = bfhi(xr[r].y);
                xv[r][4] = bflo(xr[r].z); xv[r][5] = bfhi(xr[r].z); xv[r][6] = bflo(xr[r].w); xv[r][7] = bfhi(xr[r].w); }
            if (q + step < NQ) LRU_LOAD_X(q + step);
#pragma unroll
            for (int tk = 0; tk < 2; ++tk) { float xc[8];
#pragma unroll
                for (int e = 0; e < 8; ++e) xc[e] = cbv[e] + cw[0][e] * xv[tk][e] + cw[1][e] * xv[tk + 1][e] + cw[2][e] * xv[tk + 2][e] + cw[3][e] * xv[tk + 3][e];
                const int tl = 2 * tp + tk;
                v4u o; o.x = pk2(xc[0], xc[1]); o.y = pk2(xc[2], xc[3]); o.z = pk2(xc[4], xc[5]); o.w = pk2(xc[6], xc[7]);
                *(LAS v4u*)(XCb + tl * XC_STRIDE + 8 * cg) = o;
                *(LAS f32x4*)(XCF + tl * 128 + 8 * cg) = (f32x4){xc[0], xc[1], xc[2], xc[3]}; *(LAS f32x4*)(XCF + tl * 128 + 8 * cg + 4) = (f32x4){xc[4], xc[5], xc[6], xc[7]}; }
        }
        __syncthreads();
#pragma unroll
        for (int mt = 0; mt < 4; ++mt) {
            f32x4 ra = {0.f, 0.f, 0.f, 0.f}, rx = {0.f, 0.f, 0.f, 0.f};
            const LAS bf16* ap = XCb + (16 * mt + fr) * XC_STRIDE + 8 * fq;
#pragma unroll
            for (int ks = 0; ks < 4; ++ks) { const bf16x8 af = *(const LAS bf16x8*)(ap + 32 * ks); ra = MFMA16(af, wa[ks], ra); rx = MFMA16(af, wx[ks], rx); }
#pragma unroll
            for (int e = 0; e < 4; ++e) { const int tl = 16 * mt + 4 * fq + e;
                const float rg = sigmoidf_(ra[e] + ba), ig = sigmoidf_(rx[e] + bx);
                const float a = __expf(rg * sp8);
                const float mult = sqrtf(fmaxf(fmaf(-a, a, 1.0f), 0.f));
                As[tl * 128 + j] = a; Bs[tl * 128 + j] = mult * ig * XCF[tl * 128 + j]; }
        }
        __syncthreads();
        float hh[16], pp[16];
        {
            float h = 0.f, P = 1.f;
#pragma unroll
            for (int i = 0; i < 16; ++i) { const int tl = sub * 16 + i; const float a = As[tl * 128 + c], bq = Bs[tl * 128 + c];
                h = a * h + bq; P *= a; hh[i] = h; pp[i] = P; }
            SEh[sub * 128 + c] = h; SEp[sub * 128 + c] = P;
        }
        __syncthreads();
        {
            float carry = 0.f, pre = 1.f;
            for (int s2 = 0; s2 < sub; ++s2) { carry = SEh[s2 * 128 + c] + SEp[s2 * 128 + c] * carry; pre *= SEp[s2 * 128 + c]; }
            float* hl = HLp + (size_t)(b * SEQ + t0 + sub * 16) * LRU_W + col;
            float* pa = PAp + (size_t)(b * SEQ + t0 + sub * 16) * LRU_W + col;
#pragma unroll
            for (int i = 0; i < 16; ++i) { hl[(size_t)i * LRU_W] = hh[i] + pp[i] * carry; pa[(size_t)i * LRU_W] = pp[i] * pre; }
        }
    }
#undef LRU_LOAD_X
    __syncthreads();
}
constexpr int N_ATT_UNITS = BATCH * HKV * (SEQ / 128);
constexpr int N_LRU_UNITS = BATCH * LRU_HEADS * (SEQ / LCH);
__device__ __forceinline__ void p3_phase(Frame& F) {
    for (int u = F.bid; u < N_ATT_UNITS; u += F.G) attn_unit(F, u >> 6, (u >> 5) & 1, u & 31);
    lru_block(F);
}

__device__ __forceinline__ void p4_unit(Frame& F, int b, int ch) {
    LAS float* CAR = (LAS float*)F.lds;
    const int tid = F.tid, lane = F.lane;
    {
        f32x2 carry = {0.f, 0.f};
        const float* hlb = P_HL(F) + (size_t)(b * SEQ + LCH - 1) * LRU_W + 2 * tid; const float* pab = P_PA(F) + (size_t)(b * SEQ + LCH - 1) * LRU_W + 2 * tid;
        int c2 = 0;
        for (; c2 + 8 <= ch; c2 += 8) { f32x2 hl[8], pa[8];
#pragma unroll
            for (int q = 0; q < 8; ++q) { hl[q] = *(const f32x2*)(hlb + (size_t)(c2 + q) * LCH * LRU_W); pa[q] = *(const f32x2*)(pab + (size_t)(c2 + q) * LCH * LRU_W); }
#pragma unroll
            for (int q = 0; q < 8; ++q) carry = hl[q] + pa[q] * carry; }
        for (; c2 < ch; ++c2) { const f32x2 hl = *(const f32x2*)(hlb + (size_t)c2 * LCH * LRU_W), pa = *(const f32x2*)(pab + (size_t)c2 * LCH * LRU_W); carry = hl + pa * carry; }
        CAR[2 * tid] = carry.x; CAR[2 * tid + 1] = carry.y;
    }
    __syncthreads();
    const float* gl = P_on_lru_g(F); const float* ga = P_on_attn_g(F);
    for (int i = 0; i < 8; i += 2) {
        const size_t m0 = (size_t)b * SEQ + ch * LCH + F.wave * 8 + i;
        f32x4 hl[2][4], pa[2][4]; v2u yr[2][4], ar[2][4];
#pragma unroll
        for (int t = 0; t < 2; ++t)
#pragma unroll
            for (int j = 0; j < 4; ++j) { const int c = 4 * lane + 256 * j; const size_t m = m0 + t;
                hl[t][j] = *(const f32x4*)(P_HL(F) + m * LRU_W + c); pa[t][j] = *(const f32x4*)(P_PA(F) + m * LRU_W + c);
                yr[t][j] = *(const v2u*)(P_PROJ(F) + m * MIX_IN + C_Y + c); ar[t][j] = *(const v2u*)(P_XH(F) + m * D + LRU_W + c); }
        f32x4 vl[2][4], va[2][4]; float sl[2] = {0.f, 0.f}, sa[2] = {0.f, 0.f};
#pragma unroll
        for (int t = 0; t < 2; ++t)
#pragma unroll
            for (int j = 0; j < 4; ++j) { const int c = 4 * lane + 256 * j; const f32x4 car = *(const LAS f32x4*)(CAR + c);
                const f32x4 h = hl[t][j] + pa[t][j] * car;
                f32x4 v; v.x = h.x * gelu_tanh(bflo(yr[t][j].x)); v.y = h.y * gelu_tanh(bfhi(yr[t][j].x)); v.z = h.z * gelu_tanh(bflo(yr[t][j].y)); v.w = h.w * gelu_tanh(bfhi(yr[t][j].y));
                vl[t][j] = v; sl[t] += (v.x * v.x + v.y * v.y) + (v.z * v.z + v.w * v.w);
                f32x4 a; a.x = bflo(ar[t][j].x); a.y = bfhi(ar[t][j].x); a.z = bflo(ar[t][j].y); a.w = bfhi(ar[t][j].y);
                va[t][j] = a; sa[t] += (a.x * a.x + a.y * a.y) + (a.z * a.z + a.w * a.w); }
#pragma unroll
        for (int o = 1; o < 64; o <<= 1) { sl[0] += __shfl_xor(sl[0], o); sl[1] += __shfl_xor(sl[1], o); sa[0] += __shfl_xor(sa[0], o); sa[1] += __shfl_xor(sa[1], o); }
#pragma unroll
        for (int t = 0; t < 2; ++t) { const float rl = 1.0f / sqrtf(sl[t] * (1.0f / LRU_W) + EPS), ra = 1.0f / sqrtf(sa[t] * (1.0f / LRU_W) + EPS); const size_t m = m0 + t;
#pragma unroll
            for (int j = 0; j < 4; ++j) { const int c = 4 * lane + 256 * j; const f32x4 g1v = *(const f32x4*)(gl + c), g2v = *(const f32x4*)(ga + c);
                const f32x4 y = vl[t][j] * rl * g1v, z = va[t][j] * ra * g2v;
                v2u o; o.x = pk2(y.x, y.y); o.y = pk2(y.z, y.w); *(v2u*)(P_XH(F) + m * D + c) = o;
                v2u p; p.x = pk2(z.x, z.y); p.y = pk2(z.z, z.w); *(v2u*)(P_XH(F) + m * D + LRU_W + c) = p; } }
    }
    __syncthreads();
}
__device__ __forceinline__ void p4_phase(Frame& F) {
    for (int u = F.bid; u < BATCH * (SEQ / LCH); u += F.G) p4_unit(F, u >> 6, u & 63);
}

__device__ __forceinline__ int f2key(float f) { const int b = __builtin_bit_cast(int, f); return b ^ ((b >> 31) & 0x7fffffff); }
__device__ __forceinline__ float key2f(int k) { const int b = k ^ ((k >> 31) & 0x7fffffff); return __builtin_bit_cast(float, b); }
__device__ __forceinline__ void ins16(int (&L)[16], int x) {
#pragma unroll
    for (int j = 0; j < 16; ++j) { const int hi = max(L[j], x); x = min(L[j], x); L[j] = hi; }
}
constexpr int INT_LOWEST = (int)0x80000000;
__device__ __forceinline__ void p8_item(Frame& F, int tt, int hd, LAS int* lut  ) {
    const int lane = F.lane, r = lane & 31, hh = lane >> 5;
    const bf16* QP = P_PROJ(F);
    int V[2][16];
#pragma unroll
    for (int p = 0; p < 2; ++p) {
        bf16x8 qf[8];
        const char* qb = (const char*)(QP + (size_t)(32 * tt) * D + hd * 256 + p * 128);
        const unsigned qoff = (unsigned)(r * D + 8 * hh) * 2u;
#pragma unroll
        for (int ks = 0; ks < 8; ++ks) qf[ks] = *(const bf16x8*)(qb + qoff + 32 * ks);
        int L[16];
#pragma unroll
        for (int j = 0; j < 16; ++j) L[j] = INT_LOWEST;
        const char* skb = (const char*)(P_SK(F) + (size_t)((hd * 2 + p) * PKEYS) * PHALF);
        const unsigned skoff = (unsigned)(r * PHALF + 8 * hh) * 2u;
#pragma unroll 1
        for (int kt = 0; kt < 4; ++kt) {
            f32x16 acc;
#pragma unroll
            for (int i = 0; i < 16; ++i) acc[i] = 0.f;
            const char* skt = skb + (size_t)(32 * kt) * PHALF * 2;
#pragma unroll
            for (int ks = 0; ks < 8; ++ks) { const bf16x8 kf = *(const bf16x8*)(skt + skoff + 32 * ks); acc = MFMA32(kf, qf[ks], acc); }
            const int kbase = 32 * kt + 4 * hh;
#pragma unroll
            for (int i = 0; i < 16; ++i) { const int kidx = (i & 3) + 8 * (i >> 2);
                const int key = (f2key(acc[i]) & ~0x7f) | (kbase + kidx);
                ins16(L, key); }
        }
        int O[16];
#pragma unroll
        for (int j = 0; j < 16; ++j) O[j] = __shfl_xor(L[j], 32);
#pragma unroll
        for (int j = 0; j < 16; ++j) ins16(L, O[j]);
#pragma unroll
        for (int j = 0; j < 16; ++j) V[p][j] = L[j];
    }
#pragma unroll
    for (int j = 0; j < 16; ++j) { lut[lane * 33 + j] = V[0][j] & 0x7f; lut[lane * 33 + 16 + j] = V[1][j] & 0x7f; }
    float v0[16], v1[16];
#pragma unroll
    for (int j = 0; j < 16; ++j) { v0[j] = key2f(V[0][j] & ~0x7f); v1[j] = key2f(V[1][j] & ~0x7f); }
    int C[16];
#pragma unroll
    for (int j = 0; j < 16; ++j) C[j] = INT_LOWEST;
#pragma unroll
    for (int i = 0; i < 16; ++i)
#pragma unroll
        for (int j = 0; j < 16; ++j)
            if ((i + 1) * (j + 1) <= 16) { const int key = (f2key(v0[i] + v1[j]) & ~0xff) | (i * 16 + j); ins16(C, key); }
    float sv[16]; float den = 0.f;
    const float mx = key2f(C[0] & ~0xff);
#pragma unroll
    for (int e = 0; e < 16; ++e) { sv[e] = __expf(key2f(C[e] & ~0xff) - mx); den += sv[e]; }
    const float inv = 1.0f / den;
    LDS_WAIT(); asm volatile("" ::: "memory");
    int idx[16];
#pragma unroll
    for (int e = 0; e < 16; ++e) { const int pi = (C[e] >> 4) & 15, pj = C[e] & 15; idx[e] = lut[lane * 33 + pi] * PKEYS + lut[lane * 33 + 16 + pj]; }
    if (hh == 0) {
        unsigned short* ip = P_IDX(F) + (size_t)(32 * tt + r) * 128 + hd * 16; float* gp = P_GW(F) + (size_t)(32 * tt + r) * 128 + hd * 16;
#pragma unroll
        for (int q = 0; q < 2; ++q) *(v4u*)(ip + 8 * q) = (v4u){(unsigned)idx[8 * q] | ((unsigned)idx[8 * q + 1] << 16), (unsigned)idx[8 * q + 2] | ((unsigned)idx[8 * q + 3] << 16),
                                                              (unsigned)idx[8 * q + 4] | ((unsigned)idx[8 * q + 5] << 16), (unsigned)idx[8 * q + 6] | ((unsigned)idx[8 * q + 7] << 16)};
#pragma unroll
        for (int q = 0; q < 4; ++q) *(f32x4*)(gp + 4 * q) = (f32x4){sv[4 * q] * inv, sv[4 * q + 1] * inv, sv[4 * q + 2] * inv, sv[4 * q + 3] * inv};
    }
    LDS_WAIT(); asm volatile("" ::: "memory");
}
__device__ __forceinline__ void p8_phase(Frame& F) {
    LAS int* lut = (LAS int*)(F.lds + F.wave * (64 * 33 * 4));
    const int gw = F.bid * NWAVES + F.wave, NGW = F.G * NWAVES;
    for (int it = gw; it < (M / 32) * PH; it += NGW) p8_item(F, it >> 3, it & 7, lut);
}

template <int CTRL> __device__ __forceinline__ float dpp_f(float x) { return __builtin_bit_cast(float, __builtin_amdgcn_mov_dpp(__builtin_bit_cast(int, x), CTRL, 0xf, 0xf, true)); }
__device__ __forceinline__ float sum8(float v) {
    v += dpp_f<0xB1>(v);
    v += dpp_f<0x4E>(v);
    v += dpp_f<0x141>(v);
    return v;
}
__device__ __forceinline__ void dec16(const v4u r, float (&f)[16]) {
    const unsigned w4[4] = {r.x, r.y, r.z, r.w};
#pragma unroll
    for (int w = 0; w < 4; ++w) { const f32x2 lo = __builtin_amdgcn_cvt_pk_f32_fp8((int)w4[w], false), hi = __builtin_amdgcn_cvt_pk_f32_fp8((int)w4[w], true);
        f[4 * w] = lo.x; f[4 * w + 1] = lo.y; f[4 * w + 2] = hi.x; f[4 * w + 3] = hi.y; }
}
__device__ __forceinline__ void row_offsets(const v4u a, const v4u b, unsigned loff, unsigned (&off)[16]) {
    const unsigned w[8] = {a.x, a.y, a.z, a.w, b.x, b.y, b.z, b.w};
#pragma unroll
    for (int q = 0; q < 8; ++q) { off[2 * q] = ((w[q] & 0xffffu) << 11) + loff; off[2 * q + 1] = ((w[q] >> 16) << 11) + loff; }
}
#define ISSUE_ROWS(dst, TBL, ia, ib) do { unsigned off_[16]; row_offsets((ia), (ib), loff, off_); \
    _Pragma("unroll") for (int i_ = 0; i_ < 16; ++i_) dst[i_] = *(const v4u*)((TBL) + off_[i_]); } while (0)

__device__ __forceinline__ void p9u_compute(const v4u (&row)[16], const v4u h0, const v4u h1, int c8, float* dst) {
    float h2[16];
    h2[0] = bflo(h0.x); h2[1] = bfhi(h0.x); h2[2] = bflo(h0.y); h2[3] = bfhi(h0.y); h2[4] = bflo(h0.z); h2[5] = bfhi(h0.z); h2[6] = bflo(h0.w); h2[7] = bfhi(h0.w);
    h2[8] = bflo(h1.x); h2[9] = bfhi(h1.x); h2[10] = bflo(h1.y); h2[11] = bfhi(h1.y); h2[12] = bflo(h1.z); h2[13] = bfhi(h1.z); h2[14] = bflo(h1.w); h2[15] = bfhi(h1.w);
    float res0 = 0.f, res1 = 0.f;
#pragma unroll
    for (int i = 0; i < 16; ++i) { float f[16]; dec16(row[i], f);
        float a0 = f[0] * h2[0], a1 = f[1] * h2[1], a2 = f[2] * h2[2], a3 = f[3] * h2[3];
#pragma unroll
        for (int e = 4; e < 16; e += 4) { a0 = fmaf(f[e], h2[e], a0); a1 = fmaf(f[e + 1], h2[e + 1], a1); a2 = fmaf(f[e + 2], h2[e + 2], a2); a3 = fmaf(f[e + 3], h2[e + 3], a3); }
        const float tot = sum8((a0 + a1) + (a2 + a3));
        if (i < 8) res0 = (c8 == (i & 7)) ? tot : res0; else res1 = (c8 == (i & 7)) ? tot : res1; }
    dst[0] = res0; dst[64] = res1;
}
__device__ __forceinline__ void p9u_item(Frame& F, int s, int tb) {
    const int lane = F.lane, gi = lane >> 3, c8 = lane & 7;
    const unsigned char* U8 = P_U(F);
    const unsigned loff = (unsigned)(128 * s + 16 * c8);
    const unsigned short* idxb = P_IDX(F) + (size_t)(64 * tb) * 128 + 8 * gi;
    const bf16* hb = P_XH(F) + (size_t)(64 * tb) * D + 128 * s + 16 * c8;
    float* pb = P_PART(F) + ((size_t)s * M + 64 * tb) * 128 + lane;
#define LOAD_META_U(I0, I1, H0, H1, tt_) do { const int tn_ = (tt_) < 64 ? (tt_) : 63; const unsigned short* ip_ = idxb + (size_t)tn_ * 128; const bf16* hp_ = hb + (size_t)tn_ * D; \
        I0 = *(const v4u*)(ip_); I1 = *(const v4u*)(ip_ + 64); H0 = *(const v4u*)(hp_); H1 = *(const v4u*)(hp_ + 8); } while (0)
    v4u aI0, aI1, aH0, aH1, bI0, bI1, bH0, bH1, cI0, cI1, cH0, cH1, dI0, dI1, dH0, dH1;
    LOAD_META_U(aI0, aI1, aH0, aH1, 0); LOAD_META_U(bI0, bI1, bH0, bH1, 1);
    v4u rowA[16], rowB[16];
    ISSUE_ROWS(rowA, U8, aI0, aI1); ISSUE_ROWS(rowB, U8, bI0, bI1);
    LOAD_META_U(cI0, cI1, cH0, cH1, 2);
#pragma unroll 1
    for (int t = 0; t < 64; t += 2) {
        p9u_compute(rowA, aH0, aH1, c8, pb + (size_t)t * 128);
        ISSUE_ROWS(rowA, U8, cI0, cI1);
        LOAD_META_U(dI0, dI1, dH0, dH1, t + 3);
        p9u_compute(rowB, bH0, bH1, c8, pb + (size_t)(t + 1) * 128);
        ISSUE_ROWS(rowB, U8, dI0, dI1);
        aH0 = cH0; aH1 = cH1; bH0 = dH0; bH1 = dH1;
        LOAD_META_U(cI0, cI1, cH0, cH1, t + 4);
    }
#undef LOAD_META_U
}
__device__ __forceinline__ void p9v_compute(const v4u (&row)[16], const v4u w0, const v4u w1, int lane, const f32x2 x1, const f32x2 g2, float* dst) {
    const unsigned ww[8] = {w0.x, w0.y, w0.z, w0.w, w1.x, w1.y, w1.z, w1.w};
    float acc[16];
#pragma unroll
    for (int e = 0; e < 16; ++e) acc[e] = 0.f;
#pragma unroll
    for (int i = 0; i < 16; ++i) { float f[16]; dec16(row[i], f); const float wv = (i & 1) ? bfhi(ww[i >> 1]) : bflo(ww[i >> 1]);
#pragma unroll
        for (int e = 0; e < 16; ++e) acc[e] = fmaf(f[e], wv, acc[e]); }
    float r8[8], r4[4], r2[2];
    { const bool up = (lane & 32) != 0;
#pragma unroll
      for (int e = 0; e < 8; ++e) { const float send = up ? acc[e] : acc[8 + e], keep = up ? acc[8 + e] : acc[e]; r8[e] = keep + __shfl_xor(send, 32); } }
    { const bool up = (lane & 16) != 0;
#pragma unroll
      for (int e = 0; e < 4; ++e) { const float send = up ? r8[e] : r8[4 + e], keep = up ? r8[4 + e] : r8[e]; r4[e] = keep + __shfl_xor(send, 16); } }
    { const bool up = (lane & 8) != 0;
#pragma unroll
      for (int e = 0; e < 2; ++e) { const float send = up ? r4[e] : r4[2 + e], keep = up ? r4[2 + e] : r4[e]; r2[e] = keep + __shfl_xor(send, 8); } }
    f32x2 o; o.x = x1.x + g2.x * r2[0]; o.y = x1.y + g2.y * r2[1];
    *(f32x2*)dst = o;
}
__device__ __forceinline__ void p9v_item(Frame& F, int s, int tb) {
    const int lane = F.lane, gi = lane >> 3, c8 = lane & 7;
    const unsigned char* V8 = P_V(F);
    const unsigned loff = (unsigned)(128 * s + 16 * c8);
    const unsigned short* idxb = P_IDX(F) + (size_t)(64 * tb) * 128 + 8 * gi;
    const int b = (64 * tb) / SEQ;
    const int wcol = 128 * s + 16 * c8 + 2 * gi;
    const f32x2 g2 = *(const f32x2*)(P_ADA(F) + (size_t)b * ADA_W + 5 * D + wcol);
    float* ob = P_out(F) + (size_t)(64 * tb) * D + wcol;
    LAS unsigned char* Wl = F.lds + F.wave * 16384;
    { const v4u* wsrc = (const v4u*)(P_W(F) + (size_t)(64 * tb) * 128); v4u tmp[16];
#pragma unroll
      for (int q = 0; q < 16; ++q) tmp[q] = wsrc[q * 64 + lane];
#pragma unroll
      for (int q = 0; q < 16; ++q) *(LAS v4u*)(Wl + (q * 64 + lane) * 16) = tmp[q]; }
    const LAS unsigned char* wl = Wl + 16 * gi;
#define LOAD_IDX(I0, I1, tt_) do { const int tn_ = (tt_) < 64 ? (tt_) : 63; const unsigned short* ip_ = idxb + (size_t)tn_ * 128; I0 = *(const v4u*)(ip_); I1 = *(const v4u*)(ip_ + 64); } while (0)
#define V_COMPUTE(ROW, tt_) do { const f32x2 x1_ = *(const f32x2*)(ob + (size_t)(tt_) * D); const v4u w0_ = *(const LAS v4u*)(wl + (tt_) * 256), w1_ = *(const LAS v4u*)(wl + (tt_) * 256 + 128); \
        p9v_compute(ROW, w0_, w1_, lane, x1_, g2, ob + (size_t)(tt_) * D); } while (0)
    v4u aI0, aI1, bI0, bI1, cI0, cI1, dI0, dI1;
    LOAD_IDX(aI0, aI1, 0); LOAD_IDX(bI0, bI1, 1);
    v4u rowA[16], rowB[16];
    ISSUE_ROWS(rowA, V8, aI0, aI1); ISSUE_ROWS(rowB, V8, bI0, bI1);
    LOAD_IDX(cI0, cI1, 2);
#pragma unroll 1
    for (int t = 0; t < 64; t += 2) {
        V_COMPUTE(rowA, t);
        ISSUE_ROWS(rowA, V8, cI0, cI1);
        LOAD_IDX(dI0, dI1, t + 3);
        V_COMPUTE(rowB, t + 1);
        ISSUE_ROWS(rowB, V8, dI0, dI1);
        LOAD_IDX(cI0, cI1, t + 4);
    }
#undef LOAD_IDX
#undef V_COMPUTE
}
__device__ __forceinline__ void p9u_phase(Frame& F) {
    const int x = F.bid & 7, rank = F.bid >> 3, nr = F.G >> 3;
    for (int h = 0; h < 2; ++h)
        for (int tb = rank * NWAVES + F.wave; tb < M / 64; tb += nr * NWAVES) p9u_item(F, 2 * x + h, tb);
}
__device__ __forceinline__ void p9v_phase(Frame& F) {
    const int x = F.bid & 7, rank = F.bid >> 3, nr = F.G >> 3;
    for (int h = 0; h < 2; ++h)
        for (int tb = rank * NWAVES + F.wave; tb < M / 64; tb += nr * NWAVES) p9v_item(F, 2 * x + h, tb);
}
__device__ __forceinline__ void p9w_phase(Frame& F) {
    const float* part = P_PART(F); const unsigned short* idxp = P_IDX(F); const float* gwp = P_GW(F); const float* usc = P_USC(F); const float* vsc = P_VSC(F); bf16* wp = P_W(F);
    for (int it = F.bid * 512 + F.tid; it < M * 128; it += F.G * 512) {
        float a = 0.f;
#pragma unroll
        for (int s = 0; s < 16; ++s) a += part[(size_t)s * M * 128 + it];
        const int idx = idxp[it];
        wp[it] = (bf16)f2bf(gwp[it] * gelu_tanh(a * usc[idx]) * vsc[idx]);
    }
}

struct Args { const void* in[25]; float* out; unsigned char* ws; int ph_lo, ph_hi; };
__global__ void __launch_bounds__(NWAVES * 64, 2) hymba_fwd(Args args) {
    extern __shared__ __attribute__((aligned(16))) unsigned char lds_raw[];
    Frame F;
    F.lds = (LAS unsigned char*)lds_raw;
    F.tid = threadIdx.x; F.lane = F.tid & 63; F.wave = __builtin_amdgcn_readfirstlane(F.tid >> 6);
    F.G = gridDim.x; F.bid = blockIdx.x;
    F.ka = (kaptr_t)__builtin_amdgcn_kernarg_segment_ptr();
    static_assert(sizeof(Args) == 224, "kernarg byte offsets used by ka_ptr");
    for (int u = F.tid; u < (LDS_BYTES - LDSCTL_OFF) / 4; u += NWAVES * 64) ((LAS unsigned*)(F.lds + LDSCTL_OFF))[u] = 0u;
    __syncthreads();
    volatile LAS unsigned* MISC = (volatile LAS unsigned*)(F.lds + MISC_OFF);
    XcdBarrier bar; bar.bar = (unsigned*)(P_ws(F) + WS_CTL) + CW_BAR; bar.x = 0; bar.st = nullptr;
    const int lo = args.ph_lo, hi = args.ph_hi;
    if (hi - lo > 1) bar = xcd_barrier_post((unsigned*)(P_ws(F) + WS_CTL) + CW_BAR, MISC + 8);
#define IN(k) (lo <= (k) && (k) < hi)
#ifndef PROBE_STAMP
#define PROBE_STAMP -1
#define PROBE_DIV 5.0f
#endif
#define STAMP(k) do { if (PROBE_STAMP >= 0 && F.bid == 0 && F.tid == 0) ((unsigned long long*)(P_ws(F) + WS_CTL + 64))[(k)] = __builtin_amdgcn_s_memrealtime(); } while (0)
#define SEAM(k) do { if (IN(k) && IN((k) + 1)) xcd_barrier(bar); STAMP((k) + 1); } while (0)
    STAMP(0);

#ifndef PROBE_MASK
#define PROBE_MASK 0
#endif
#define REP(k) for (int rep_ = 0; rep_ < (((PROBE_MASK >> (k)) & 1) ? 2 : 1); ++rep_)
#define REPSYNC(k) do { if (((PROBE_MASK >> (k)) & 1) && rep_ == 0) xcd_barrier(bar); } while (0)
    if (IN(0)) { REP(0) { p0_prologue(F); REPSYNC(0); } } SEAM(0);
    if (IN(1)) { REP(1) { p1_phase(F); REPSYNC(1); } } SEAM(1);
    if (IN(2)) REP(2) {
        pg8::Gemm g{P_XH(F), P_WIN(F), M, MIX_IN, D}; pg8::StaticOrder S; S.init(M, MIX_IN, F.G, F.bid);
        pg8::EpiStoreBf16 E{P_PROJ(F), MIX_IN};
        pg8::gemm_phase<pg8::EpiStoreBf16, pg8::StaticOrder, true, true>(F.lds, g, S, E); REPSYNC(2);
    } SEAM(2);
    if (IN(3)) { p3_phase(F); } SEAM(3);
    if (IN(4)) { p4_phase(F); } SEAM(4);
    if (IN(5)) REP(5) {
        pg8::Gemm g{P_XH(F), P_WOUT(F), M, D, D}; pg8::StaticOrder S; S.init(M, D, F.G, F.bid);
        pg8::EpiResid E{P_x(F), P_out(F), D, P_ADA(F) + 2 * D, ADA_W, SEQ};
        pg8::gemm_phase<pg8::EpiResid, pg8::StaticOrder, true, true>(F.lds, g, S, E); REPSYNC(5);
    } SEAM(5);
    if (IN(6)) { REP(6) { p6_phase(F); REPSYNC(6); } } SEAM(6);
    if (IN(7)) REP(7) {
        pg8::Gemm g{P_XH(F), P_WQ(F), M, D, D}; pg8::StaticOrder S; S.init(M, D, F.G, F.bid);
        pg8::EpiStoreBf16 E{P_PROJ(F), D};
        pg8::gemm_phase<pg8::EpiStoreBf16, pg8::StaticOrder, true, true>(F.lds, g, S, E); REPSYNC(7);
    } SEAM(7);
    if (IN(8)) { REP(8) { p8_phase(F); REPSYNC(8); } } SEAM(8);
    if (IN(9)) { p9u_phase(F); } SEAM(9);
    if (IN(10)) { p9w_phase(F); } SEAM(10);
    if (IN(11)) { p9v_phase(F); }
    if (PROBE_STAMP >= 0) {
        __syncthreads(); STAMP(12); VM_WAIT(); __syncthreads();
        if (F.bid == 0 && F.tid == 0) { const unsigned long long* ts = (const unsigned long long*)(P_ws(F) + WS_CTL + 64);
            const float us = (float)(ts[PROBE_STAMP + 1] - ts[PROBE_STAMP]) * 0.01f; P_out(F)[0] += us * (1.0f / PROBE_DIV); }
    }
#undef IN
#undef SEAM
}

extern "C" void kernel_launch(void* const* d_in, const int* in_sizes, int n_in, void* d_out, int out_size, void* d_ws, size_t ws_size, hipStream_t stream) {
    static int grid = 0;
    if (grid == 0) {
        if (n_in != 25 || in_sizes[0] != M * D || out_size != M * D || ws_size < WS_END) {
            fprintf(stderr, "kernel_launch: built for 25 inputs, x/out of %d floats, >= %zu bytes of workspace; got n_in %d, in0 %d, out %d, ws %zu; nothing launched\n", M * D, (size_t)WS_END, n_in, n_in > 0 ? in_sizes[0] : -1, out_size, ws_size);
            grid = -1; return; }
        int dev = 0, cus = 0, per_cu = 0;
        if (hipGetDevice(&dev) != hipSuccess || hipDeviceGetAttribute(&cus, hipDeviceAttributeMultiprocessorCount, dev) != hipSuccess) { fprintf(stderr, "kernel_launch: device query failed\n"); grid = -1; return; }
        if (hipFuncSetAttribute((const void*)hymba_fwd, hipFuncAttributeMaxDynamicSharedMemorySize, LDS_BYTES) != hipSuccess) { fprintf(stderr, "kernel_launch: hipFuncSetAttribute failed\n"); grid = -1; return; }
        if (hipOccupancyMaxActiveBlocksPerMultiprocessor(&per_cu, (const void*)hymba_fwd, NWAVES * 64, LDS_BYTES) != hipSuccess || per_cu < 1) {
            fprintf(stderr, "kernel_launch: occupancy query reports %d workgroups per CU; need 1\n", per_cu); (void)hipGetLastError(); grid = -1; return; }
        grid = cus;
        if (grid % 8 != 0 || (M / 64) % (grid / 8 * NWAVES) != 0) { fprintf(stderr, "kernel_launch: grid %d not supported (needs a multiple of 8 dividing the token blocks)\n", grid); grid = -1; return; }
    }
    if (grid < 0) return;
    if (hipMemsetAsync((char*)d_ws + WS_CTL, 0, CTL_ZERO_BYTES, stream) != hipSuccess) { fprintf(stderr, "kernel_launch: memset failed\n"); return; }
    Args a{};
    for (int i = 0; i < 25; ++i) a.in[i] = d_in[i];
    a.out = (float*)d_out; a.ws = (unsigned char*)d_ws;
    if (N_LAUNCHES == 1) {
        a.ph_lo = 0; a.ph_hi = N_PHASES;
        void* kargs[] = {&a};
        const hipError_t le = hipLaunchCooperativeKernel((const void*)hymba_fwd, dim3(grid), dim3(NWAVES * 64), kargs, LDS_BYTES, stream);
        if (le != hipSuccess) fprintf(stderr, "kernel_launch: cooperative launch failed: %s (grid %d)\n", hipGetErrorName(le), grid);
    } else {
#ifndef PROBE_TWICE
#define PROBE_TWICE 0
#endif
        for (int li = 0; li < N_PHASES; ++li) { a.ph_lo = li; a.ph_hi = li + 1;
            if ((PROBE_TWICE >> li) & 1) hipLaunchKernelGGL(hymba_fwd, dim3(grid), dim3(NWAVES * 64), LDS_BYTES, stream, a);
            hipLaunchKernelGGL(hymba_fwd, dim3(grid), dim3(NWAVES * 64), LDS_BYTES, stream, a);
            const hipError_t le = hipPeekAtLastError();
            if (le != hipSuccess) { fprintf(stderr, "kernel_launch: launch %d failed: %s\n", li, hipGetErrorName(le)); break; } }
    }
}
```

```cpp
#include <hip/hip_runtime.h>
#include <cstdio>
#include <cstdint>
namespace pg8 {
#define PG8_LAS __attribute__((address_space(3)))
typedef unsigned short bf16_t;
typedef short bf16x8 __attribute__((ext_vector_type(8)));
typedef float f32x4 __attribute__((ext_vector_type(4)));
typedef unsigned u32x4 __attribute__((ext_vector_type(4)));
constexpr int BM = 256, BK = 64, HALF = 128, HTB = HALF * BK * 2  , STAGE_BYTES = 8 * HTB, NXCD = 8, WGM = 8;

__host__ __device__ __forceinline__ int lds_byte(int r, int c) { const int st = (r >> 4) * 2 + (c >> 5), rr = r & 15, cc = c & 31, ob = rr * 64 + cc * 2; return st * 1024 + (ob ^ (((ob >> 9) & 1) << 5)); }
__host__ __device__ __forceinline__ void stage_rc(int b, int& R, int& C) { const int st = b / 1024, sb = b % 1024, swz = sb ^ (((sb >> 9) & 1) << 5); R = (st >> 1) * 16 + swz / 64; C = (st & 1) * 32 + (swz % 64) / 2; }
__host__ __device__ __forceinline__ int perm32(int rho) { const int n = rho >> 4, i = rho & 15; return 8 * (i >> 2) + 4 * n + (i & 3); }

struct Unit { int pm, pn; };
struct Gemm { const bf16_t* A; const bf16_t* Bt; int M, N, K; };

struct StaticOrder {
    int nM, nN, nwg, G, c;
    __host__ __device__ void init(int M, int N, int G_, int c_) { nM = M / BM; nN = N / BM; nwg = nM * nN; G = G_; c = c_; }
    __host__ __device__ bool next(int i, Unit& u) const {
        const long L = (long)i * G + c; if (L >= nwg) return false;
        int wgid = (int)L; { const int q = nwg / NXCD, r = nwg % NXCD, xcd = wgid % NXCD, off = wgid / NXCD; wgid = (xcd < r ? xcd * (q + 1) : r * (q + 1) + (xcd - r) * q) + off; }
        const int nig = WGM * nN, gid = wgid / nig, fm = gid * WGM, gsz = (nM - fm) < WGM ? (nM - fm) : WGM;
        u.pm = fm + ((wgid % nig) % gsz); u.pn = (wgid % nig) / gsz; return true;
    }
    __device__ __forceinline__ void a_ready(const Unit&) const {}
    __device__ __forceinline__ void done(const Unit&) const {}
};

__device__ __forceinline__ unsigned cvt_pk_bf16(float lo, float hi) { unsigned r; asm volatile("v_cvt_pk_bf16_f32 %0, %1, %2" : "=v"(r) : "v"(lo), "v"(hi)); return r; }
struct EpiStoreBf16 {
    static constexpr bool PERM = true, AFTER_DRAIN = false;
    bf16_t* O; int ldc;
    __device__ __forceinline__ void operator()(const f32x4 (&acc)[2][2][4][2], const Unit& u, int wr, int wc, int fr, int fq) const {
        const int row0 = u.pm * BM + wr * 64 + fr; const int col0 = u.pn * BM + wc * 32 + 8 * fq;
#pragma unroll
        for (int ai = 0; ai < 2; ++ai)
#pragma unroll
            for (int m = 0; m < 4; ++m) { bf16_t* rowp = O + (size_t)(row0 + ai * HALF + m * 16) * ldc + col0;
#pragma unroll
                for (int bj = 0; bj < 2; ++bj) { const f32x4 v0 = acc[ai][bj][m][0], v1 = acc[ai][bj][m][1];
                    u32x4 w; w.x = cvt_pk_bf16(v0[0], v0[1]); w.y = cvt_pk_bf16(v0[2], v0[3]); w.z = cvt_pk_bf16(v1[0], v1[1]); w.w = cvt_pk_bf16(v1[2], v1[3]);
                    *(u32x4*)(rowp + bj * HALF) = w; } }
    }
};
struct EpiResid {
    static constexpr bool PERM = false, AFTER_DRAIN = false;
    const float* base; float* out; int ldc; const float* gate; int gstride; int rows_per_batch;
    __device__ __forceinline__ void operator()(const f32x4 (&acc)[2][2][4][2], const Unit& u, int wr, int wc, int fr, int fq) const {
        const int b = (u.pm * BM) / rows_per_batch; const float* g = gate + (size_t)b * gstride;
        const int col0 = u.pn * BM + wc * 32 + 4 * fq;
        f32x4 gv[2][2];
#pragma unroll
        for (int bj = 0; bj < 2; ++bj)
#pragma unroll
            for (int n = 0; n < 2; ++n) gv[bj][n] = *(const f32x4*)(g + col0 + bj * HALF + n * 16);
#pragma unroll
        for (int ai = 0; ai < 2; ++ai)
#pragma unroll
            for (int m = 0; m < 4; ++m) { const size_t off = (size_t)(u.pm * BM + ai * HALF + wr * 64 + m * 16 + fr) * ldc + col0;
#pragma unroll
                for (int bj = 0; bj < 2; ++bj)
#pragma unroll
                    for (int n = 0; n < 2; ++n) { const f32x4 bs = *(const f32x4*)(base + off + bj * HALF + n * 16);
                        *(f32x4*)(out + off + bj * HALF + n * 16) = bs + gv[bj][n] * acc[ai][bj][m][n]; }
                if (m & 1) asm volatile("" ::: "memory"); }
    }
};

template <class Epi, class Sched, bool ALIGN_EPI = false, bool SP2 = false>
__device__ __forceinline__ void gemm_phase(PG8_LAS unsigned char* lds, const Gemm g, const Sched& S, const Epi& E) {
    const int tid = threadIdx.x, wid = __builtin_amdgcn_readfirstlane(tid >> 6), lane = tid & 63, wr = wid >> 2, wc = wid & 3, fr = lane & 15, fq = lane >> 4;
    const int K = g.K, nt = K / BK;
    unsigned voffA[2], voffB[2];
#pragma unroll
    for (int i = 0; i < 2; ++i) { int R, C; stage_rc(tid * 16 + i * 8192, R, C); const int Rb = Epi::PERM ? ((R & ~31) + perm32(R & 31)) : R;
        voffA[i] = (unsigned)(R * K + C) * 2u; voffB[i] = (unsigned)(Rb * K + C) * 2u; }
    const size_t kstep = (size_t)(BK * 2);
    const size_t hstep = (size_t)HALF * K * 2;
    const size_t tstep = 2 * hstep;
    const unsigned ldsw = (unsigned)wid * 1024u;
    const int aoff = lds_byte(wr * 64 + fr, fq * 8), boff = lds_byte(wc * 32 + fr, fq * 8);
#define PG8_SA(b, h) (((b) * 2 + (h)) * HTB)
#define PG8_SB(b, h) ((4 + (b) * 2 + (h)) * HTB)
#define PG8_STAGE(bufoff, gbase, voff) do { _Pragma("unroll") for (int _i = 0; _i < 2; ++_i) \
        __builtin_amdgcn_global_load_lds((const unsigned*)((const char*)(gbase) + (voff)[_i]), (PG8_LAS unsigned*)(lds + (bufoff) + ldsw + _i * 8192), 16, 0, 0); } while (0)
#define PG8_LDA(dst, b, h) do { _Pragma("unroll") for (int m = 0; m < 4; ++m) _Pragma("unroll") for (int k = 0; k < 2; ++k) dst[m][k] = *(const PG8_LAS bf16x8*)(lds + PG8_SA(b, h) + aoff + m * 2048 + k * 1024); } while (0)
#define PG8_LDB(dst, b, h) do { _Pragma("unroll") for (int n = 0; n < 2; ++n) _Pragma("unroll") for (int k = 0; k < 2; ++k) dst[n][k] = *(const PG8_LAS bf16x8*)(lds + PG8_SB(b, h) + boff + n * 2048 + k * 1024); } while (0)
#define PG8_MMA(ai, bj, At, Bt) do { __builtin_amdgcn_s_setprio(1); _Pragma("unroll") for (int m = 0; m < 4; ++m) _Pragma("unroll") for (int n = 0; n < 2; ++n) _Pragma("unroll") for (int k = 0; k < 2; ++k) \
        acc[ai][bj][m][n] = __builtin_amdgcn_mfma_f32_16x16x32_bf16(Bt[n][k], At[m][k], acc[ai][bj][m][n], 0, 0, 0); __builtin_amdgcn_s_setprio(0); } while (0)
#define PG8_WAIT_V(n) asm volatile("s_waitcnt vmcnt(" #n ")" ::: "memory")
#define PG8_WAIT_L(n) asm volatile("s_waitcnt lgkmcnt(" #n ")" ::: "memory")
#define PG8_BAR __builtin_amdgcn_s_barrier()
#define PG8_SCHED __builtin_amdgcn_sched_barrier(0)
    Unit cur, nxt; int ui = 0;
    if (!S.next(0, cur)) return;
    f32x4 acc[2][2][4][2];
#pragma unroll
    for (int a = 0; a < 2; ++a)
#pragma unroll
        for (int b = 0; b < 2; ++b)
#pragma unroll
            for (int m = 0; m < 4; ++m)
#pragma unroll
                for (int n = 0; n < 2; ++n) acc[a][b][m][n] = (f32x4){0.f, 0.f, 0.f, 0.f};
    bf16x8 At[4][2], B0[2][2], B1[2][2];
    const char* cA = (const char*)g.A + (size_t)cur.pm * tstep; const char* cB = (const char*)g.Bt + (size_t)cur.pn * tstep;
    S.a_ready(cur);
    if constexpr (SP2) {
        PG8_STAGE(PG8_SB(0, 0), cB, voffB); PG8_STAGE(PG8_SB(0, 1), cB + hstep, voffB); PG8_STAGE(PG8_SA(0, 0), cA, voffA); PG8_STAGE(PG8_SA(0, 1), cA + hstep, voffA);
        if (wr == 1) PG8_BAR;
        PG8_WAIT_V(2); PG8_BAR;
        PG8_STAGE(PG8_SB(1, 0), cB + kstep, voffB); PG8_STAGE(PG8_SA(1, 0), cA + kstep, voffA); PG8_STAGE(PG8_SB(1, 1), cB + hstep + kstep, voffB);
        PG8_WAIT_V(6); PG8_BAR;
    } else {
        PG8_STAGE(PG8_SB(0, 0), cB, voffB); PG8_STAGE(PG8_SA(0, 0), cA, voffA); PG8_STAGE(PG8_SB(0, 1), cB + hstep, voffB); PG8_STAGE(PG8_SA(0, 1), cA + hstep, voffA);
        if (wr == 1) PG8_BAR;
        PG8_WAIT_V(4); PG8_BAR;
        PG8_STAGE(PG8_SB(1, 0), cB + kstep, voffB); PG8_STAGE(PG8_SA(1, 0), cA + kstep, voffA); PG8_STAGE(PG8_SB(1, 1), cB + hstep + kstep, voffB);
        PG8_WAIT_V(6); PG8_BAR;
    }
    for (;;) {
        const bool has_next = S.next(ui + 1, nxt);
        const char* nA = has_next ? (const char*)g.A + (size_t)nxt.pm * tstep : cA; const char* nB = has_next ? (const char*)g.Bt + (size_t)nxt.pn * tstep : cB;
        for (int t = 0; t < nt; t += 2) {
            const bool last = (t == nt - 2);
            const char* a1 = cA + (size_t)(t + 1) * kstep;
            const char* a2 = last ? nA : cA + (size_t)(t + 2) * kstep; const char* b2 = last ? nB : cB + (size_t)(t + 2) * kstep;
            const char* a3 = a2 + kstep; const char* b3 = b2 + kstep;
            if (last && has_next) S.a_ready(nxt);
            if constexpr (SP2) {
            PG8_LDB(B0, 0, 0); PG8_LDB(B1, 0, 1); PG8_SCHED; PG8_LDA(At, 0, 0); PG8_STAGE(PG8_SA(1, 1), a1 + hstep, voffA);
            PG8_WAIT_V(8); PG8_WAIT_L(0); PG8_BAR; PG8_MMA(0, 0, At, B0); PG8_MMA(0, 1, At, B1); PG8_BAR; PG8_SCHED;
            PG8_LDA(At, 0, 1); PG8_STAGE(PG8_SB(0, 0), b2, voffB); PG8_STAGE(PG8_SB(0, 1), b2 + hstep, voffB); PG8_STAGE(PG8_SA(0, 0), a2, voffA);
            PG8_WAIT_V(8); PG8_WAIT_L(0); PG8_BAR; PG8_MMA(1, 0, At, B0); PG8_MMA(1, 1, At, B1); PG8_BAR; PG8_SCHED;
            PG8_LDB(B0, 1, 0); PG8_LDB(B1, 1, 1); PG8_SCHED; PG8_LDA(At, 1, 0); PG8_STAGE(PG8_SA(0, 1), a2 + hstep, voffA);
            PG8_WAIT_V(8); PG8_WAIT_L(0); PG8_BAR; PG8_MMA(0, 0, At, B0); PG8_MMA(0, 1, At, B1); PG8_BAR; PG8_SCHED;
            PG8_LDA(At, 1, 1); PG8_STAGE(PG8_SB(1, 0), b3, voffB); PG8_STAGE(PG8_SB(1, 1), b3 + hstep, voffB); PG8_STAGE(PG8_SA(1, 0), a3, voffA);
            PG8_WAIT_V(8); PG8_WAIT_L(0); PG8_BAR; PG8_MMA(1, 0, At, B0); PG8_MMA(1, 1, At, B1); PG8_BAR; PG8_SCHED;
            } else {
            PG8_LDB(B0, 0, 0); PG8_SCHED; PG8_LDA(At, 0, 0); PG8_STAGE(PG8_SA(1, 1), a1 + hstep, voffA);
            PG8_WAIT_L(8); PG8_BAR; PG8_WAIT_L(0); PG8_MMA(0, 0, At, B0); PG8_BAR; PG8_SCHED;
            PG8_LDB(B1, 0, 1); PG8_STAGE(PG8_SB(0, 0), b2, voffB);
            PG8_BAR; PG8_WAIT_L(0); PG8_MMA(0, 1, At, B1); PG8_BAR;
            PG8_LDA(At, 0, 1); PG8_STAGE(PG8_SA(0, 0), a2, voffA);
            PG8_BAR; PG8_WAIT_L(0); PG8_MMA(1, 0, At, B0); PG8_BAR; PG8_SCHED;
            PG8_STAGE(PG8_SB(0, 1), b2 + hstep, voffB);
            PG8_WAIT_V(6); PG8_BAR; PG8_MMA(1, 1, At, B1); PG8_BAR;
            PG8_LDB(B0, 1, 0); PG8_SCHED; PG8_LDA(At, 1, 0); PG8_STAGE(PG8_SA(0, 1), a2 + hstep, voffA);
            PG8_WAIT_L(8); PG8_BAR; PG8_WAIT_L(0); PG8_MMA(0, 0, At, B0); PG8_BAR; PG8_SCHED;
            PG8_LDB(B1, 1, 1); PG8_STAGE(PG8_SB(1, 0), b3, voffB);
            PG8_BAR; PG8_WAIT_L(0); PG8_MMA(0, 1, At, B1); PG8_BAR;
            PG8_LDA(At, 1, 1); PG8_STAGE(PG8_SA(1, 0), a3, voffA);
            PG8_BAR; PG8_WAIT_L(0); PG8_MMA(1, 0, At, B0); PG8_BAR; PG8_SCHED;
            PG8_STAGE(PG8_SB(1, 1), b3 + hstep, voffB);
            PG8_WAIT_V(6); PG8_BAR; PG8_MMA(1, 1, At, B1); PG8_BAR;
            }
        }
        if constexpr (ALIGN_EPI) { if (wr == 0) PG8_BAR; }
        if constexpr (!Epi::AFTER_DRAIN) { E(acc, cur, wr, wc, fr, fq); S.done(cur); }
        if (!has_next) break;
#pragma unroll
        for (int a = 0; a < 2; ++a)
#pragma unroll
            for (int b = 0; b < 2; ++b)
#pragma unroll
                for (int m = 0; m < 4; ++m)
#pragma unroll
                    for (int n = 0; n < 2; ++n) acc[a][b][m][n] = (f32x4){0.f, 0.f, 0.f, 0.f};
        cur = nxt; cA = nA; cB = nB; ++ui;
        if constexpr (ALIGN_EPI) { if (wr == 1) PG8_BAR; }
    }
    PG8_WAIT_V(0);
    if constexpr (!ALIGN_EPI) { if (wr == 0) PG8_BAR; }
    PG8_BAR;
    if constexpr (Epi::AFTER_DRAIN) { E.fused(acc, cur, wr, wc, fr, fq, lds, wid, lane); S.done(cur); }
#undef PG8_SA
#undef PG8_SB
#undef PG8_STAGE
#undef PG8_LDA
#undef PG8_LDB
#undef PG8_MMA
#undef PG8_WAIT_V
#undef PG8_WAIT_L
#undef PG8_BAR
#undef PG8_SCHED
}
}

constexpr int NWAVES = 8;
#ifndef MK_N_LAUNCHES
#define MK_N_LAUNCHES 1
#endif
constexpr int N_PHASES = 12;
constexpr int N_LAUNCHES = MK_N_LAUNCHES;

constexpr int BATCH = 4, SEQ = 4096, D = 2048, M = BATCH * SEQ;
constexpr int LRU_W = 1024, LRU_HEADS = 8, LRU_BLK = 128;
constexpr int HD = 64, HQ = 16, HKV = 2, GRP = 8;
constexpr int MIX_IN = 3328;
constexpr int C_Y = 1024, C_Q = 2048, C_K = 3072, C_V = 3200;
constexpr int ADA_W = 6 * D;
constexpr int PH = 8, PKEYS = 128, PHALF = 128, PTOPK = 16, NEXP = 16384;
constexpr float EPS = 1e-6f;

constexpr size_t MiB = 1u << 20;
constexpr size_t WS_CTL = 0, CTL_ZERO_BYTES = 1 * MiB;
constexpr size_t WS_ADA = 1 * MiB;
constexpr size_t WS_ROPE = 2 * MiB;
constexpr size_t WS_WIN = 4 * MiB;
constexpr size_t WS_WOUT = 17 * MiB;
constexpr size_t WS_WQ = 25 * MiB;
constexpr size_t WS_WGA = 33 * MiB;
constexpr size_t WS_WGX = 33 * MiB + 256 * 1024;
constexpr size_t WS_SK = 33 * MiB + 512 * 1024;
constexpr size_t WS_IDX = 34 * MiB;
constexpr size_t WS_GW = 42 * MiB;
constexpr size_t WS_U = 50 * MiB;
constexpr size_t WS_V = 82 * MiB;
constexpr size_t WS_USC = 1 * MiB + 512 * 1024;
constexpr size_t WS_VSC = 1 * MiB + 768 * 1024;
constexpr size_t WS_XH = 178 * MiB;
constexpr size_t WS_PROJ = 242 * MiB;
constexpr size_t WS_HL = 346 * MiB;
constexpr size_t WS_PA = 410 * MiB;
constexpr size_t WS_PART = WS_HL;
constexpr size_t WS_W = WS_PROJ + 64 * MiB;
constexpr size_t WS_END = 474 * MiB;
constexpr int CW_BAR = 4096;

constexpr int RING_BYTES = 131072;
constexpr int LDSCTL_OFF = RING_BYTES, MISC_OFF = LDSCTL_OFF + 320;
constexpr int LDS_BYTES = 147456;

#define GAS __attribute__((address_space(1)))
#define LAS __attribute__((address_space(3)))
typedef unsigned short bf16;
typedef unsigned v4u __attribute__((ext_vector_type(4)));
typedef unsigned v2u __attribute__((ext_vector_type(2)));
typedef float f32x4 __attribute__((ext_vector_type(4)));
typedef float f32x2 __attribute__((ext_vector_type(2)));
typedef float f32x16 __attribute__((ext_vector_type(16)));
typedef short bf16x8 __attribute__((ext_vector_type(8)));
typedef __bf16 bf16x2v __attribute__((ext_vector_type(2)));
#define LDS_WAIT() asm volatile("s_waitcnt lgkmcnt(0)" ::: "memory")
#define VM_WAIT() asm volatile("s_waitcnt vmcnt(0)" ::: "memory")
__device__ __forceinline__ unsigned f2bf(float f) { unsigned u = __builtin_bit_cast(unsigned, f); return (u + 0x7fffu + ((u >> 16) & 1u)) >> 16; }
__device__ __forceinline__ unsigned pk2(float lo, float hi) { return f2bf(lo) | (f2bf(hi) << 16); }
__device__ __forceinline__ float bflo(unsigned u) { return __builtin_bit_cast(float, u << 16); }
__device__ __forceinline__ float bfhi(unsigned u) { return __builtin_bit_cast(float, u & 0xffff0000u); }
__device__ __forceinline__ float bf1(bf16 h) { return __builtin_bit_cast(float, (unsigned)h << 16); }
__device__ __forceinline__ float dot2bf(unsigned a, unsigned b, float acc) { return __builtin_amdgcn_fdot2_f32_bf16(__builtin_bit_cast(bf16x2v, a), __builtin_bit_cast(bf16x2v, b), acc, false); }
__device__ __forceinline__ float sigmoidf_(float x) { return 1.0f / (1.0f + __expf(-x)); }
__device__ __forceinline__ float gelu_tanh(float x) {
    const float z = 1.5957691216057308f * (x + 0.044715f * x * x * x);
    return x / (1.0f + __expf(-z));
}
__device__ __forceinline__ float wave_sum(float v) {
#pragma unroll
    for (int o = 1; o < 64; o <<= 1) v += __shfl_xor(v, o);
    return v;
}

#define XB_TMO      128
#define XB_XCNT(j)  (256  + 64 * (j))
#define XB_XSUB(j)  (1280 + 64 * (j))
#define XB_XGEN(j)  (2304 + 64 * (j))
#define XB_TOP      3328
#define XB_TOPGEN   3392
#define XCD_BAR_WORDS 3456
#define XB_SPIN_CAP (1u << 18)
__device__ __forceinline__ unsigned xb_ld(unsigned* p)              { return __hip_atomic_load(p, __ATOMIC_RELAXED, __HIP_MEMORY_SCOPE_AGENT); }
__device__ __forceinline__ unsigned xb_add(unsigned* p, unsigned v) { return __hip_atomic_fetch_add(p, v, __ATOMIC_RELAXED, __HIP_MEMORY_SCOPE_AGENT); }
__device__ __forceinline__ unsigned xb_xcc_id() { return (unsigned)__builtin_amdgcn_s_getreg((3 << 11) | 20) & 0xFu; }
#define XB_SPIN(cond, bar) do { unsigned _sp = 0; while (cond) { __builtin_amdgcn_s_sleep(1); \
    if ((++_sp & 255u) == 0u) { if (xb_ld(&(bar)[XB_TMO])) break; if (_sp > XB_SPIN_CAP) { atomicAdd(&(bar)[XB_TMO], 1u); break; } } } } while (0)
struct XcdBarrier { unsigned* bar; unsigned x; volatile LAS unsigned* st; };
__device__ __forceinline__ XcdBarrier xcd_barrier_post(unsigned* bar, volatile LAS unsigned* st) {
    XcdBarrier b; b.bar = bar; b.x = xb_xcc_id(); b.st = st;
    if (threadIdx.x == 0) (void)xb_add(&bar[XB_XCNT(b.x)], 1u);
    return b;
}
__device__ __forceinline__ void xcd_barrier_complete(unsigned* bar, unsigned x, unsigned& nloc, unsigned& nx) {
    const unsigned G = gridDim.x * gridDim.y * gridDim.z;
    unsigned sum, cnt, mine, sp = 0u;
    for (;;) {
        sum = 0u; cnt = 0u; mine = 0u;
#pragma unroll
        for (unsigned j = 0; j < 16; ++j) { const unsigned c = xb_ld(&bar[XB_XCNT(j)]); sum += c; cnt += (c > 0u) ? 1u : 0u; mine = (j == x) ? c : mine; }
        if (sum == G) break;
        __builtin_amdgcn_s_sleep(1);
        if ((++sp & 255u) == 0u) { if (xb_ld(&bar[XB_TMO])) break; if (sp > XB_SPIN_CAP) { atomicAdd(&bar[XB_TMO], 1u); break; } }
    }
    nloc = mine > 0u ? mine : 1u; nx = cnt > 0u ? cnt : 1u;
}
__device__ __forceinline__ void xcd_barrier(const XcdBarrier& b) {
    asm volatile("s_waitcnt vmcnt(0)" ::: "memory");
    __syncthreads();
    if (threadIdx.x == 0) {
        unsigned* bar = b.bar;
        __builtin_amdgcn_s_waitcnt(0);
        unsigned nloc = b.st[0], nx = b.st[1];
        if (nloc == 0u) { xcd_barrier_complete(bar, b.x, nloc, nx); b.st[0] = nloc; b.st[1] = nx; }
        const unsigned old = xb_add(&bar[XB_XSUB(b.x)], 1u);
        const unsigned gen = old / nloc;
        if (old + 1u == (gen + 1u) * nloc) {
            __builtin_amdgcn_fence(__ATOMIC_RELEASE, "agent");
            asm volatile("s_waitcnt vmcnt(0)" ::: "memory");
            const unsigned og = xb_add(&bar[XB_TOP], 1u);
            const unsigned tg = og / nx;
            if (og + 1u == (tg + 1u) * nx) xb_add(&bar[XB_TOPGEN], 1u);
            else XB_SPIN(xb_ld(&bar[XB_TOPGEN]) == tg, bar);
            __builtin_amdgcn_fence(__ATOMIC_ACQUIRE, "agent");
            xb_add(&bar[XB_XGEN(b.x)], 1u);
            asm volatile("s_waitcnt vmcnt(0)" ::: "memory");
        } else {
            XB_SPIN(xb_ld(&bar[XB_XGEN(b.x)]) == gen, bar);
            __builtin_amdgcn_fence(__ATOMIC_ACQUIRE, "agent");
            asm volatile("s_waitcnt vmcnt(0)" ::: "memory");
        }
    }
    __syncthreads();
}

typedef const __attribute__((address_space(4))) unsigned char* kaptr_t;
struct Frame { LAS unsigned char* lds; int tid, lane, wave, G, bid; kaptr_t ka; };
template <class T> __device__ __forceinline__ T* ka_ptr(const Frame& F, int byte_off) { typedef T* tp; return *(const __attribute__((address_space(4))) tp*)(F.ka + byte_off); }
__device__ __forceinline__ const float* P_x(const Frame& F) { return ka_ptr<const float>(F, 0); }
__device__ __forceinline__ const float* P_c(const Frame& F) { return ka_ptr<const float>(F, 8); }
__device__ __forceinline__ const int* P_pos(const Frame& F) { return ka_ptr<const int>(F, 16); }
__device__ __forceinline__ const float* P_w_ada(const Frame& F) { return ka_ptr<const float>(F, 24); }
__device__ __forceinline__ const float* P_b_ada(const Frame& F) { return ka_ptr<const float>(F, 32); }
__device__ __forceinline__ const float* P_norm1_g(const Frame& F) { return ka_ptr<const float>(F, 40); }
__device__ __forceinline__ const float* P_w_in(const Frame& F) { return ka_ptr<const float>(F, 48); }
__device__ __forceinline__ const float* P_conv_w(const Frame& F) { return ka_ptr<const float>(F, 56); }
__device__ __forceinline__ const float* P_conv_b(const Frame& F) { return ka_ptr<const float>(F, 64); }
__device__ __forceinline__ const float* P_ga_w(const Frame& F) { return ka_ptr<const float>(F, 72); }
__device__ __forceinline__ const float* P_ga_b(const Frame& F) { return ka_ptr<const float>(F, 80); }
__device__ __forceinline__ const float* P_gx_w(const Frame& F) { return ka_ptr<const float>(F, 88); }
__device__ __forceinline__ const float* P_gx_b(const Frame& F) { return ka_ptr<const float>(F, 96); }
__device__ __forceinline__ const float* P_lam(const Frame& F) { return ka_ptr<const float>(F, 104); }
__device__ __forceinline__ const float* P_qn_g(const Frame& F) { return ka_ptr<const float>(F, 112); }
__device__ __forceinline__ const float* P_kn_g(const Frame& F) { return ka_ptr<const float>(F, 120); }
__device__ __forceinline__ const float* P_sinks(const Frame& F) { return ka_ptr<const float>(F, 128); }
__device__ __forceinline__ const float* P_on_lru_g(const Frame& F) { return ka_ptr<const float>(F, 136); }
__device__ __forceinline__ const float* P_on_attn_g(const Frame& F) { return ka_ptr<const float>(F, 144); }
__device__ __forceinline__ const float* P_w_out(const Frame& F) { return ka_ptr<const float>(F, 152); }
__device__ __forceinline__ const float* P_norm2_g(const Frame& F) { return ka_ptr<const float>(F, 160); }
__device__ __forceinline__ const float* P_w_pq(const Frame& F) { return ka_ptr<const float>(F, 168); }
__device__ __forceinline__ const float* P_sub_keys(const Frame& F) { return ka_ptr<const float>(F, 176); }
__device__ __forceinline__ const float* P_pu(const Frame& F) { return ka_ptr<const float>(F, 184); }
__device__ __forceinline__ const float* P_pv(const Frame& F) { return ka_ptr<const float>(F, 192); }
__device__ __forceinline__ float* P_out(const Frame& F) { return ka_ptr<float>(F, 200); }
__device__ __forceinline__ unsigned char* P_ws(const Frame& F) { return ka_ptr<unsigned char>(F, 208); }
__device__ __forceinline__ float* P_ADA(const Frame& F) { return (float*)(P_ws(F) + WS_ADA); }
__device__ __forceinline__ float* P_ROPE(const Frame& F) { return (float*)(P_ws(F) + WS_ROPE); }
__device__ __forceinline__ float* P_HL(const Frame& F) { return (float*)(P_ws(F) + WS_HL); }
__device__ __forceinline__ float* P_PA(const Frame& F) { return (float*)(P_ws(F) + WS_PA); }
__device__ __forceinline__ float* P_GW(const Frame& F) { return (float*)(P_ws(F) + WS_GW); }
__device__ __forceinline__ unsigned short* P_IDX(const Frame& F) { return (unsigned short*)(P_ws(F) + WS_IDX); }
__device__ __forceinline__ bf16* P_WIN(const Frame& F) { return (bf16*)(P_ws(F) + WS_WIN); }
__device__ __forceinline__ bf16* P_WOUT(const Frame& F) { return (bf16*)(P_ws(F) + WS_WOUT); }
__device__ __forceinline__ bf16* P_WQ(const Frame& F) { return (bf16*)(P_ws(F) + WS_WQ); }
__device__ __forceinline__ bf16* P_WGA(const Frame& F) { return (bf16*)(P_ws(F) + WS_WGA); }
__device__ __forceinline__ bf16* P_WGX(const Frame& F) { return (bf16*)(P_ws(F) + WS_WGX); }
__device__ __forceinline__ bf16* P_SK(const Frame& F) { return (bf16*)(P_ws(F) + WS_SK); }
__device__ __forceinline__ unsigned char* P_U(const Frame& F) { return (unsigned char*)(P_ws(F) + WS_U); }
__device__ __forceinline__ float* P_PART(const Frame& F) { return (float*)(P_ws(F) + WS_PART); }
__device__ __forceinline__ bf16* P_W(const Frame& F) { return (bf16*)(P_ws(F) + WS_W); }
__device__ __forceinline__ float* P_USC(const Frame& F) { return (float*)(P_ws(F) + WS_USC); }
__device__ __forceinline__ float* P_VSC(const Frame& F) { return (float*)(P_ws(F) + WS_VSC); }
__device__ __forceinline__ unsigned char* P_V(const Frame& F) { return (unsigned char*)(P_ws(F) + WS_V); }
__device__ __forceinline__ bf16* P_XH(const Frame& F) { return (bf16*)(P_ws(F) + WS_XH); }
__device__ __forceinline__ bf16* P_PROJ(const Frame& F) { return (bf16*)(P_ws(F) + WS_PROJ); }

__device__ __forceinline__ void p0_transpose_item(const float* W, int K, int N, bf16* WT, LAS float* scr, int item, int lane) {
    const int nblk = N / 32, kb = item / nblk, nb = item % nblk, k0 = 64 * kb, n0 = 32 * nb;
#pragma unroll 8
    for (int i = 0; i < 32; ++i) { const int kk = 2 * i + (lane >> 5); scr[kk * 33 + (lane & 31)] = W[(size_t)(k0 + kk) * N + n0 + (lane & 31)]; }
    LDS_WAIT(); asm volatile("" ::: "memory");
    const int c = lane & 7;
#pragma unroll
    for (int j = 0; j < 4; ++j) { const int n = (lane >> 3) + 8 * j; const LAS float* s = scr + (8 * c) * 33 + n;
        v4u o; o.x = pk2(s[0 * 33], s[1 * 33]); o.y = pk2(s[2 * 33], s[3 * 33]); o.z = pk2(s[4 * 33], s[5 * 33]); o.w = pk2(s[6 * 33], s[7 * 33]);
        *(v4u*)(WT + (size_t)(n0 + n) * K + k0 + 8 * c) = o; }
    LDS_WAIT(); asm volatile("" ::: "memory");
}
__device__ __forceinline__ void p0_convert(const float* src, bf16* dst, size_t n8, size_t gtid, size_t gthreads) {
    for (size_t i = gtid; i < n8; i += gthreads) {
        const f32x4 a = *(const f32x4*)(src + 8 * i), b = *(const f32x4*)(src + 8 * i + 4);
        v4u o; o.x = pk2(a.x, a.y); o.y = pk2(a.z, a.w); o.z = pk2(b.x, b.y); o.w = pk2(b.z, b.w);
        *(v4u*)(dst + 8 * i) = o;
    }
}
#ifndef QUANT_SPLIT
#define QUANT_SPLIT 14336
#endif
__device__ __forceinline__ void quant_rows(Frame& F, int r0, int r1, int w, int nw) {
    for (int rr = r0 + w; rr < r1; rr += nw) {
        const int tbl = rr >= NEXP, row = rr - tbl * NEXP;
        const float* srcp = (tbl ? P_pv(F) : P_pu(F)) + (size_t)row * D;
        unsigned char* dstp = (tbl ? P_V(F) : P_U(F)) + (size_t)row * D;
        f32x4 v[8]; float mx = 0.f;
#pragma unroll
        for (int j = 0; j < 8; ++j) { v[j] = *(const f32x4*)(srcp + 4 * F.lane + 256 * j);
            mx = fmaxf(fmaxf(mx, fmaxf(fabsf(v[j].x), fabsf(v[j].y))), fmaxf(fabsf(v[j].z), fabsf(v[j].w))); }
#pragma unroll
        for (int o = 1; o < 64; o <<= 1) mx = fmaxf(mx, __shfl_xor(mx, o));
        const float s = fmaxf(mx, 1e-30f) * (1.0f / 224.0f), inv = 1.0f / s;
#pragma unroll
        for (int j = 0; j < 8; ++j) { int t = __builtin_amdgcn_cvt_pk_fp8_f32(v[j].x * inv, v[j].y * inv, 0, false);
            t = __builtin_amdgcn_cvt_pk_fp8_f32(v[j].z * inv, v[j].w * inv, t, true);
            *(int*)(dstp + 4 * F.lane + 256 * j) = t; }
        if (F.lane == 0) (tbl ? P_VSC(F) : P_USC(F))[row] = s;
    }
}
__device__ __forceinline__ void p0_prologue(Frame& F) {
    {
        LAS float* sc = (LAS float*)F.lds;
        LAS float* red = sc + 4 * D;
        for (int i = F.tid; i < 4 * D; i += 512) { const float v = P_c(F)[i]; sc[i] = v / (1.0f + __expf(-v)); }
        __syncthreads();
        for (int cg = F.bid; cg < ADA_W / 64; cg += F.G) {
            const int n0 = cg * 64, k0 = F.wave * 256;
            const float* wp = P_w_ada(F) + (size_t)k0 * ADA_W + n0 + F.lane;
            float a0 = 0.f, a1 = 0.f, a2 = 0.f, a3 = 0.f;
#pragma unroll 16
            for (int k = 0; k < 256; ++k) { const float w = wp[(size_t)k * ADA_W]; const int kk = k0 + k;
                a0 += sc[kk] * w; a1 += sc[D + kk] * w; a2 += sc[2 * D + kk] * w; a3 += sc[3 * D + kk] * w; }
            red[(F.wave * 4 + 0) * 64 + F.lane] = a0; red[(F.wave * 4 + 1) * 64 + F.lane] = a1;
            red[(F.wave * 4 + 2) * 64 + F.lane] = a2; red[(F.wave * 4 + 3) * 64 + F.lane] = a3;
            __syncthreads();
            if (F.tid < 256) { const int b = F.tid >> 6, l = F.tid & 63; float s = 0.f;
#pragma unroll
                for (int w = 0; w < 8; ++w) s += red[(w * 4 + b) * 64 + l];
                P_ADA(F)[(size_t)b * ADA_W + n0 + l] = s + P_b_ada(F)[n0 + l]; }
            __syncthreads();
        }
        __syncthreads();
    }
    {
        LAS float* scr = (LAS float*)(F.lds + F.wave * 16384);
        const int gw = F.bid * NWAVES + F.wave, NGW = F.G * NWAVES;
        constexpr int I_IN = (D / 64) * (MIX_IN / 32), I_SQ = (D / 64) * (D / 32), I_G = (LRU_BLK / 64) * (LRU_BLK / 32);
        constexpr int NITEMS = I_IN + 2 * I_SQ + 16 * I_G;
        for (int it = gw; it < NITEMS; it += NGW) {
            int r = it;
            if (r < I_IN) { p0_transpose_item(P_w_in(F), D, MIX_IN, P_WIN(F), scr, r, F.lane); continue; } r -= I_IN;
            if (r < I_SQ) { p0_transpose_item(P_w_out(F), D, D, P_WOUT(F), scr, r, F.lane); continue; } r -= I_SQ;
            if (r < I_SQ) { p0_transpose_item(P_w_pq(F), D, D, P_WQ(F), scr, r, F.lane); continue; } r -= I_SQ;
            const int g = r / I_G, ri = r % I_G, hd = g & 7;
            if (g < 8) p0_transpose_item(P_ga_w(F) + (size_t)hd * 16384, LRU_BLK, LRU_BLK, P_WGA(F) + (size_t)hd * 16384, scr, ri, F.lane);
            else       p0_transpose_item(P_gx_w(F) + (size_t)hd * 16384, LRU_BLK, LRU_BLK, P_WGX(F) + (size_t)hd * 16384, scr, ri, F.lane);
        }
    }
    {
        const size_t gtid = (size_t)F.bid * 512 + F.tid, gth = (size_t)F.G * 512;
        p0_convert(P_sub_keys(F), P_SK(F), (size_t)PH * 2 * PKEYS * PHALF / 8, gtid, gth);
    }
    quant_rows(F, 0, QUANT_SPLIT, F.bid * NWAVES + F.wave, F.G * NWAVES);
}

__device__ __forceinline__ void modnorm_rows4(const float* xrow, const float* gain, const float* shift, const float* scale, bf16* orow, int lane) {
    f32x4 v[4][8]; float s[4];
#pragma unroll
    for (int r = 0; r < 4; ++r) { s[r] = 0.f;
#pragma unroll
        for (int j = 0; j < 8; ++j) v[r][j] = *(const f32x4*)(xrow + (size_t)r * D + 4 * lane + 256 * j); }
#pragma unroll
    for (int r = 0; r < 4; ++r)
#pragma unroll
        for (int j = 0; j < 8; ++j) s[r] += (v[r][j].x * v[r][j].x + v[r][j].y * v[r][j].y) + (v[r][j].z * v[r][j].z + v[r][j].w * v[r][j].w);
#pragma unroll
    for (int o = 1; o < 64; o <<= 1) {
#pragma unroll
        for (int r = 0; r < 4; ++r) s[r] += __shfl_xor(s[r], o); }
    float rstd[4];
#pragma unroll
    for (int r = 0; r < 4; ++r) rstd[r] = 1.0f / sqrtf(s[r] * (1.0f / D) + EPS);
#pragma unroll
    for (int j = 0; j < 8; ++j) {
        const int c = 4 * lane + 256 * j;
        const f32x4 g = *(const f32x4*)(gain + c), sh = *(const f32x4*)(shift + c), sc = *(const f32x4*)(scale + c);
        const f32x4 gm = g * (sc + 1.0f);
#pragma unroll
        for (int r = 0; r < 4; ++r) { const f32x4 y = (v[r][j] * rstd[r]) * gm + sh;
            v2u o; o.x = pk2(y.x, y.y); o.y = pk2(y.z, y.w);
            *(v2u*)(orow + (size_t)r * D + c) = o; }
    }
}
__device__ __forceinline__ void p1_phase(Frame& F) {
    const int gw = F.bid * NWAVES + F.wave, NGW = F.G * NWAVES;
    for (int m = 4 * gw; m < M; m += 4 * NGW) { const int b = m / SEQ; const float* ada = P_ADA(F) + (size_t)b * ADA_W;
        modnorm_rows4(P_x(F) + (size_t)m * D, P_norm1_g(F), ada, ada + D, P_XH(F) + (size_t)m * D, F.lane); }
    const float invf[8] = {1.0f, 1.9392274e-01f, 3.7606031e-02f, 7.2926646e-03f, 1.4142136e-03f, 2.7424819e-04f, 5.3182961e-05f, 1.0313386e-05f};
    for (int i = F.bid * 512 + F.tid; i < M * 8; i += F.G * 512) { const int m = i >> 3, k = i & 7;
        float f = invf[0];
#pragma unroll
        for (int q = 1; q < 8; ++q) f = (k == q) ? invf[q] : f;
        const float ang = (float)P_pos(F)[m] * f; float sn, cs; sincosf(ang, &sn, &cs);
        P_ROPE(F)[(size_t)m * 16 + k] = cs; P_ROPE(F)[(size_t)m * 16 + 8 + k] = sn; }
}
__device__ __forceinline__ void p6_phase(Frame& F) {
    const int gw = F.bid * NWAVES + F.wave, NGW = F.G * NWAVES;
    for (int m = 4 * gw; m < M; m += 4 * NGW) { const int b = m / SEQ; const float* ada = P_ADA(F) + (size_t)b * ADA_W;
        modnorm_rows4(P_out(F) + (size_t)m * D, P_norm2_g(F), ada + 3 * D, ada + 4 * D, P_XH(F) + (size_t)m * D, F.lane); }
}

#define MFMA32(a, b, c) __builtin_amdgcn_mfma_f32_32x32x16_bf16((a), (b), (c), 0, 0, 0)
#define MFMA16(a, b, c) __builtin_amdgcn_mfma_f32_16x16x32_bf16((a), (b), (c), 0, 0, 0)
constexpr int KS_STRIDE = 72;
constexpr int VT_STRIDE = 264;
constexpr int ATT_KS_OFF = 0, ATT_VT_OFF = 256 * KS_STRIDE * 2;
static_assert(ATT_VT_OFF + 64 * VT_STRIDE * 2 <= RING_BYTES, "attention LDS");

__device__ __forceinline__ void attn_unit(Frame& F, int b, int g, int n) {
    LAS bf16* Ks = (LAS bf16*)(F.lds + ATT_KS_OFF);
    LAS bf16* VT = (LAS bf16*)(F.lds + ATT_VT_OFF);
    const int tid = F.tid, lane = F.lane;
    {
        const int kb = tid >> 1, hf = tid & 1; const int t = n * 128 - 128 + kb;
        float kv[32]; v4u vraw[4];
        if (t >= 0) {
            const bf16* kp = P_PROJ(F) + (size_t)(b * SEQ + t) * MIX_IN + C_K + g * HD + 32 * hf;
            const bf16* vp = P_PROJ(F) + (size_t)(b * SEQ + t) * MIX_IN + C_V + g * HD + 32 * hf;
#pragma unroll
            for (int q = 0; q < 4; ++q) { const v4u r = *(const v4u*)(kp + 8 * q); vraw[q] = *(const v4u*)(vp + 8 * q);
                kv[8 * q + 0] = bflo(r.x); kv[8 * q + 1] = bfhi(r.x); kv[8 * q + 2] = bflo(r.y); kv[8 * q + 3] = bfhi(r.y);
                kv[8 * q + 4] = bflo(r.z); kv[8 * q + 5] = bfhi(r.z); kv[8 * q + 6] = bflo(r.w); kv[8 * q + 7] = bfhi(r.w); }
        } else {
#pragma unroll
            for (int q = 0; q < 4; ++q) vraw[q] = (v4u){0u, 0u, 0u, 0u};
#pragma unroll
            for (int q = 0; q < 32; ++q) kv[q] = 0.f;
        }
        float ss = 0.f;
#pragma unroll
        for (int q = 0; q < 32; ++q) ss += kv[q] * kv[q];
        ss += __shfl_xor(ss, 1);
        const float rstd = 1.0f / sqrtf(ss * (1.0f / HD) + EPS);
#pragma unroll
        for (int q = 0; q < 32; ++q) kv[q] = kv[q] * rstd * P_kn_g(F)[32 * hf + q];
        if (hf == 0 && t >= 0) {
            const float* rp = P_ROPE(F) + (size_t)(b * SEQ + t) * 16;
#pragma unroll
            for (int i = 0; i < 8; ++i) { const float cs = rp[i], sn = rp[8 + i]; const float x1 = kv[i], x2 = kv[8 + i];
                kv[i] = x1 * cs - x2 * sn; kv[8 + i] = x2 * cs + x1 * sn; }
        }
#pragma unroll
        for (int q = 0; q < 4; ++q) { v4u o; o.x = pk2(kv[8 * q], kv[8 * q + 1]); o.y = pk2(kv[8 * q + 2], kv[8 * q + 3]); o.z = pk2(kv[8 * q + 4], kv[8 * q + 5]); o.w = pk2(kv[8 * q + 6], kv[8 * q + 7]);
            *(LAS v4u*)(Ks + kb * KS_STRIDE + 32 * hf + 8 * q) = o; }
#pragma unroll
        for (int q = 0; q < 4; ++q) { const unsigned w[4] = {vraw[q].x, vraw[q].y, vraw[q].z, vraw[q].w};
#pragma unroll
            for (int e = 0; e < 4; ++e) { const int d = 32 * hf + 8 * q + 2 * e;
                VT[d * VT_STRIDE + kb] = (bf16)(w[e] & 0xffffu); VT[(d + 1) * VT_STRIDE + kb] = (bf16)(w[e] >> 16); } }
    }
    __syncthreads();
    const int hq = g * GRP + F.wave, r = lane & 31, hh = lane >> 5;
    const float sink = P_sinks(F)[hq];
    for (int qi = 0; qi < 4; ++qi) {
        const int tq = n * 128 + 32 * qi + r;
        bf16x8 qf[4];
        {
            const bf16* qp = P_PROJ(F) + (size_t)(b * SEQ + tq) * MIX_IN + C_Q + hq * HD + 8 * hh;
            float qv[4][8]; float ss = 0.f;
#pragma unroll
            for (int ks = 0; ks < 4; ++ks) { const v4u rr = *(const v4u*)(qp + 16 * ks);
                qv[ks][0] = bflo(rr.x); qv[ks][1] = bfhi(rr.x); qv[ks][2] = bflo(rr.y); qv[ks][3] = bfhi(rr.y);
                qv[ks][4] = bflo(rr.z); qv[ks][5] = bfhi(rr.z); qv[ks][6] = bflo(rr.w); qv[ks][7] = bfhi(rr.w);
#pragma unroll
                for (int j = 0; j < 8; ++j) ss += qv[ks][j] * qv[ks][j]; }
            ss += __shfl_xor(ss, 32);
            const float rstd = 1.0f / sqrtf(ss * (1.0f / HD) + EPS);
#pragma unroll
            for (int ks = 0; ks < 4; ++ks)
#pragma unroll
                for (int j = 0; j < 8; ++j) qv[ks][j] = qv[ks][j] * rstd * P_qn_g(F)[16 * ks + 8 * hh + j];
            const float* rp = P_ROPE(F) + (size_t)(b * SEQ + tq) * 16;
#pragma unroll
            for (int j = 0; j < 8; ++j) { const float mine = qv[0][j], other = __shfl_xor(mine, 32); const float cs = rp[j], sn = rp[8 + j];
                qv[0][j] = hh == 0 ? (mine * cs - other * sn) : (mine * cs + other * sn); }
#pragma unroll
            for (int ks = 0; ks < 4; ++ks) { v4u o; o.x = pk2(qv[ks][0] * 0.125f, qv[ks][1] * 0.125f); o.y = pk2(qv[ks][2] * 0.125f, qv[ks][3] * 0.125f);
                o.z = pk2(qv[ks][4] * 0.125f, qv[ks][5] * 0.125f); o.w = pk2(qv[ks][6] * 0.125f, qv[ks][7] * 0.125f); qf[ks] = __builtin_bit_cast(bf16x8, o); }
        }
        f32x16 s[5];
#pragma unroll
        for (int kj = 0; kj < 5; ++kj) {
            f32x16 acc;
#pragma unroll
            for (int i = 0; i < 16; ++i) acc[i] = 0.f;
            const LAS bf16* kp = Ks + (32 * (qi + kj) + r) * KS_STRIDE + 8 * hh;
#pragma unroll
            for (int ks = 0; ks < 4; ++ks) { const bf16x8 kf = *(const LAS bf16x8*)(kp + 16 * ks); acc = MFMA32(kf, qf[ks], acc); }
            s[kj] = acc;
        }
        float mx = sink;
#pragma unroll
        for (int kj = 0; kj < 5; ++kj)
#pragma unroll
            for (int i = 0; i < 16; ++i) { const int kt = (i & 3) + 8 * (i >> 2) + 4 * hh; const int kbi = 32 * (qi + kj) + kt;
                bool valid = (n * 128 + kbi - 128) >= 0;
                if (kj == 0) valid = valid && (kt > r);
                if (kj == 4) valid = valid && (kt <= r);
                s[kj][i] = valid ? s[kj][i] : -INFINITY; mx = fmaxf(mx, s[kj][i]); }
        mx = fmaxf(mx, __shfl_xor(mx, 32));
        float l = 0.f;
#pragma unroll
        for (int kj = 0; kj < 5; ++kj)
#pragma unroll
            for (int i = 0; i < 16; ++i) { const float p = __expf(s[kj][i] - mx); s[kj][i] = p; l += p; }
        l += __shfl_xor(l, 32);
        l += __expf(sink - mx);
        const float inv = 1.0f / l;
        f32x16 o0, o1;
#pragma unroll
        for (int i = 0; i < 16; ++i) { o0[i] = 0.f; o1[i] = 0.f; }
#pragma unroll
        for (int kj = 0; kj < 5; ++kj)
#pragma unroll
            for (int st = 0; st < 2; ++st) {
                v4u pa; pa.x = pk2(s[kj][8 * st + 0] * inv, s[kj][8 * st + 1] * inv); pa.y = pk2(s[kj][8 * st + 2] * inv, s[kj][8 * st + 3] * inv);
                pa.z = pk2(s[kj][8 * st + 4] * inv, s[kj][8 * st + 5] * inv); pa.w = pk2(s[kj][8 * st + 6] * inv, s[kj][8 * st + 7] * inv);
                const bf16x8 pf = __builtin_bit_cast(bf16x8, pa);
                const int kb0 = 32 * (qi + kj) + 16 * st + 4 * hh;
                const LAS bf16* v0p = VT + r * VT_STRIDE + kb0; const LAS bf16* v1p = VT + (32 + r) * VT_STRIDE + kb0;
                const v2u a0 = *(const LAS v2u*)v0p, a1 = *(const LAS v2u*)(v0p + 8), b0 = *(const LAS v2u*)v1p, b1 = *(const LAS v2u*)(v1p + 8);
                const v4u vb0 = {a0.x, a0.y, a1.x, a1.y}, vb1 = {b0.x, b0.y, b1.x, b1.y};
                o0 = MFMA32(pf, __builtin_bit_cast(bf16x8, vb0), o0);
                o1 = MFMA32(pf, __builtin_bit_cast(bf16x8, vb1), o1);
            }
#pragma unroll
        for (int i = 0; i < 16; ++i) { const int qr = (i & 3) + 8 * (i >> 2) + 4 * hh; const int tok = n * 128 + 32 * qi + qr;
            bf16* op = P_XH(F) + (size_t)(b * SEQ + tok) * D + LRU_W + hq * HD + r;
            op[0] = (bf16)f2bf(o0[i]); op[32] = (bf16)f2bf(o1[i]); }
    }
    __syncthreads();
}

constexpr int LCH = 64;
constexpr int XC_STRIDE = 136;
constexpr int LRU_XCB_OFF = 0, LRU_XCF_OFF = LCH * XC_STRIDE * 2  , LRU_A_OFF = LRU_XCF_OFF + LCH * 128 * 4, LRU_B_OFF = LRU_A_OFF + LCH * 128 * 4, LRU_SE_OFF = LRU_B_OFF + LCH * 128 * 4;
static_assert(LRU_SE_OFF + 2 * 4 * 128 * 4 <= RING_BYTES, "LRU LDS");
__device__ __forceinline__ void lru_block(Frame& F) {
    LAS bf16* XCb = (LAS bf16*)(F.lds + LRU_XCB_OFF);
    LAS float* XCF = (LAS float*)(F.lds + LRU_XCF_OFF);
    LAS float* As = (LAS float*)(F.lds + LRU_A_OFF);
    LAS float* Bs = (LAS float*)(F.lds + LRU_B_OFF);
    LAS float* SEh = (LAS float*)(F.lds + LRU_SE_OFF);
    LAS float* SEp = SEh + 4 * 128;
    const int tid = F.tid, lane = F.lane;
    const int hd = F.bid & 7, li = F.bid >> 3, step = F.G >> 3;
    constexpr int NQ = BATCH * (SEQ / LCH);
    if (li >= NQ) return;
    const int cg = tid & 15, tp = tid >> 4, colc = hd * LRU_BLK + 8 * cg;
    float cw[4][8], cbv[8];
#pragma unroll
    for (int k = 0; k < 4; ++k) { const f32x4 a = *(const f32x4*)(P_conv_w(F) + k * LRU_W + colc), b2 = *(const f32x4*)(P_conv_w(F) + k * LRU_W + colc + 4);
        cw[k][0] = a.x; cw[k][1] = a.y; cw[k][2] = a.z; cw[k][3] = a.w; cw[k][4] = b2.x; cw[k][5] = b2.y; cw[k][6] = b2.z; cw[k][7] = b2.w; }
    { const f32x4 a = *(const f32x4*)(P_conv_b(F) + colc), b2 = *(const f32x4*)(P_conv_b(F) + colc + 4);
      cbv[0] = a.x; cbv[1] = a.y; cbv[2] = a.z; cbv[3] = a.w; cbv[4] = b2.x; cbv[5] = b2.y; cbv[6] = b2.z; cbv[7] = b2.w; }
    const int fr = lane & 15, fq = lane >> 4, j = 16 * F.wave + fr, jc = hd * LRU_BLK + j;
    bf16x8 wa[4], wx[4];
    { const bf16* wap = P_WGA(F) + (size_t)hd * 16384 + (size_t)j * 128 + 8 * fq; const bf16* wxp = P_WGX(F) + (size_t)hd * 16384 + (size_t)j * 128 + 8 * fq;
#pragma unroll
      for (int ks = 0; ks < 4; ++ks) { wa[ks] = *(const bf16x8*)(wap + 32 * ks); wx[ks] = *(const bf16x8*)(wxp + 32 * ks); } }
    const float ba = P_ga_b(F)[jc], bx = P_gx_b(F)[jc];
    const float sp8 = -8.0f * log1pf(__expf(-P_lam(F)[jc]));
    const int c = tid & 127, sub = tid >> 7, col = hd * LRU_BLK + c;
    const bf16* xbase = P_PROJ(F) + colc;
    float* HLp = P_HL(F); float* PAp = P_PA(F);
    v4u xr[5];
#define LRU_LOAD_X(q_) do { const int b_ = (q_) >> 6, ch_ = (q_) & 63; const int tr_ = ch_ * LCH + 2 * tp - 3; \
        _Pragma("unroll") for (int r_ = 0; r_ < 5; ++r_) { const int t_ = tr_ + r_; \
            xr[r_] = (t_ >= 0) ? *(const v4u*)(xbase + (size_t)(b_ * SEQ + t_) * MIX_IN) : (v4u){0u, 0u, 0u, 0u}; } } while (0)
    LRU_LOAD_X(li);
    for (int q = li; q < NQ; q += step) {
        const int b = q >> 6, ch = q & 63, t0 = ch * LCH;
        {
            float xv[5][8];
#pragma unroll
            for (int r = 0; r < 5; ++r) { xv[r][0] = bflo(xr[r].x); xv[r][1] = bfhi(xr[r].x); xv[r][2] = bflo(xr[r].y); xv[r][3] = bfhi(xr[r].y);
                xv[r][4] = bflo(xr[r].z); xv[r][5] = bfhi(xr[r].z); xv[r][6] = bflo(xr[r].w); xv[r][7] = bfhi(xr[r].w); }
            if (q + step < NQ) LRU_LOAD_X(q + step);
#pragma unroll
            for (int tk = 0; tk < 2; ++tk) { float xc[8];
#pragma unroll
                for (int e = 0; e < 8; ++e) xc[e] = cbv[e] + cw[0][e] * xv[tk][e] + cw[1][e] * xv[tk + 1][e] + cw[2][e] * xv[tk + 2][e] + cw[3][e] * xv[tk + 3][e];
                const int tl = 2 * tp + tk;
                v4u o; o.x = pk2(xc[0], xc[1]); o.y = pk2(xc[2], xc[3]); o.z = pk2(xc[4], xc[5]); o.w = pk2(xc[6], xc[7]);
                *(LAS v4u*)(XCb + tl * XC_STRIDE + 8 * cg) = o;
                *(LAS f32x4*)(XCF + tl * 128 + 8 * cg) = (f32x4){xc[0], xc[1], xc[2], xc[3]}; *(LAS f32x4*)(XCF + tl * 128 + 8 * cg + 4) = (f32x4){xc[4], xc[5], xc[6], xc[7]}; }
        }
        __syncthreads();
#pragma unroll
        for (int mt = 0; mt < 4; ++mt) {
            f32x4 ra = {0.f, 0.f, 0.f, 0.f}, rx = {0.f, 0.f, 0.f, 0.f};
            const LAS bf16* ap = XCb + (16 * mt + fr) * XC_STRIDE + 8 * fq;
#pragma unroll
            for (int ks = 0; ks < 4; ++ks) { const bf16x8 af = *(const LAS bf16x8*)(ap + 32 * ks); ra = MFMA16(af, wa[ks], ra); rx = MFMA16(af, wx[ks], rx); }
#pragma unroll
            for (int e = 0; e < 4; ++e) { const int tl = 16 * mt + 4 * fq + e;
                const float rg = sigmoidf_(ra[e] + ba), ig = sigmoidf_(rx[e] + bx);
                const float a = __expf(rg * sp8);
                const float mult = sqrtf(fmaxf(fmaf(-a, a, 1.0f), 0.f));
                As[tl * 128 + j] = a; Bs[tl * 128 + j] = mult * ig * XCF[tl * 128 + j]; }
        }
        __syncthreads();
        float hh[16], pp[16];
        {
            float h = 0.f, P = 1.f;
#pragma unroll
            for (int i = 0; i < 16; ++i) { const int tl = sub * 16 + i; const float a = As[tl * 128 + c], bq = Bs[tl * 128 + c];
                h = a * h + bq; P *= a; hh[i] = h; pp[i] = P; }
            SEh[sub * 128 + c] = h; SEp[sub * 128 + c] = P;
        }
        __syncthreads();
        {
            float carry = 0.f, pre = 1.f;
            for (int s2 = 0; s2 < sub; ++s2) { carry = SEh[s2 * 128 + c] + SEp[s2 * 128 + c] * carry; pre *= SEp[s2 * 128 + c]; }
            float* hl = HLp + (size_t)(b * SEQ + t0 + sub * 16) * LRU_W + col;
            float* pa = PAp + (size_t)(b * SEQ + t0 + sub * 16) * LRU_W + col;
#pragma unroll
            for (int i = 0; i < 16; ++i) { hl[(size_t)i * LRU_W] = hh[i] + pp[i] * carry; pa[(size_t)i * LRU_W] = pp[i] * pre; }
        }
    }
#undef LRU_LOAD_X
    __syncthreads();
}
constexpr int N_ATT_UNITS = BATCH * HKV * (SEQ / 128);
constexpr int N_LRU_UNITS = BATCH * LRU_HEADS * (SEQ / LCH);
__device__ __forceinline__ void p3_phase(Frame& F) {
    for (int u = F.bid; u < N_ATT_UNITS; u += F.G) attn_unit(F, u >> 6, (u >> 5) & 1, u & 31);
    lru_block(F);
}

__device__ __forceinline__ void p4_unit(Frame& F, int b, int ch) {
    LAS float* CAR = (LAS float*)F.lds;
    const int tid = F.tid, lane = F.lane;
    {
        f32x2 carry = {0.f, 0.f};
        const float* hlb = P_HL(F) + (size_t)(b * SEQ + LCH - 1) * LRU_W + 2 * tid; const float* pab = P_PA(F) + (size_t)(b * SEQ + LCH - 1) * LRU_W + 2 * tid;
        int c2 = 0;
        for (; c2 + 8 <= ch; c2 += 8) { f32x2 hl[8], pa[8];
#pragma unroll
            for (int q = 0; q < 8; ++q) { hl[q] = *(const f32x2*)(hlb + (size_t)(c2 + q) * LCH * LRU_W); pa[q] = *(const f32x2*)(pab + (size_t)(c2 + q) * LCH * LRU_W); }
#pragma unroll
            for (int q = 0; q < 8; ++q) carry = hl[q] + pa[q] * carry; }
        for (; c2 < ch; ++c2) { const f32x2 hl = *(const f32x2*)(hlb + (size_t)c2 * LCH * LRU_W), pa = *(const f32x2*)(pab + (size_t)c2 * LCH * LRU_W); carry = hl + pa * carry; }
        CAR[2 * tid] = carry.x; CAR[2 * tid + 1] = carry.y;
    }
    __syncthreads();
    const float* gl = P_on_lru_g(F); const float* ga = P_on_attn_g(F);
    for (int i = 0; i < 8; i += 2) {
        const size_t m0 = (size_t)b * SEQ + ch * LCH + F.wave * 8 + i;
        f32x4 hl[2][4], pa[2][4]; v2u yr[2][4], ar[2][4];
#pragma unroll
        for (int t = 0; t < 2; ++t)
#pragma unroll
            for (int j = 0; j < 4; ++j) { const int c = 4 * lane + 256 * j; const size_t m = m0 + t;
                hl[t][j] = *(const f32x4*)(P_HL(F) + m * LRU_W + c); pa[t][j] = *(const f32x4*)(P_PA(F) + m * LRU_W + c);
                yr[t][j] = *(const v2u*)(P_PROJ(F) + m * MIX_IN + C_Y + c); ar[t][j] = *(const v2u*)(P_XH(F) + m * D + LRU_W + c); }
        f32x4 vl[2][4], va[2][4]; float sl[2] = {0.f, 0.f}, sa[2] = {0.f, 0.f};
#pragma unroll
        for (int t = 0; t < 2; ++t)
#pragma unroll
            for (int j = 0; j < 4; ++j) { const int c = 4 * lane + 256 * j; const f32x4 car = *(const LAS f32x4*)(CAR + c);
                const f32x4 h = hl[t][j] + pa[t][j] * car;
                f32x4 v; v.x = h.x * gelu_tanh(bflo(yr[t][j].x)); v.y = h.y * gelu_tanh(bfhi(yr[t][j].x)); v.z = h.z * gelu_tanh(bflo(yr[t][j].y)); v.w = h.w * gelu_tanh(bfhi(yr[t][j].y));
                vl[t][j] = v; sl[t] += (v.x * v.x + v.y * v.y) + (v.z * v.z + v.w * v.w);
                f32x4 a; a.x = bflo(ar[t][j].x); a.y = bfhi(ar[t][j].x); a.z = bflo(ar[t][j].y); a.w = bfhi(ar[t][j].y);
                va[t][j] = a; sa[t] += (a.x * a.x + a.y * a.y) + (a.z * a.z + a.w * a.w); }
#pragma unroll
        for (int o = 1; o < 64; o <<= 1) { sl[0] += __shfl_xor(sl[0], o); sl[1] += __shfl_xor(sl[1], o); sa[0] += __shfl_xor(sa[0], o); sa[1] += __shfl_xor(sa[1], o); }
#pragma unroll
        for (int t = 0; t < 2; ++t) { const float rl = 1.0f / sqrtf(sl[t] * (1.0f / LRU_W) + EPS), ra = 1.0f / sqrtf(sa[t] * (1.0f / LRU_W) + EPS); const size_t m = m0 + t;
#pragma unroll
            for (int j = 0; j < 4; ++j) { const int c = 4 * lane + 256 * j; const f32x4 g1v = *(const f32x4*)(gl + c), g2v = *(const f32x4*)(ga + c);
                const f32x4 y = vl[t][j] * rl * g1v, z = va[t][j] * ra * g2v;
                v2u o; o.x = pk2(y.x, y.y); o.y = pk2(y.z, y.w); *(v2u*)(P_XH(F) + m * D + c) = o;
                v2u p; p.x = pk2(z.x, z.y); p.y = pk2(z.z, z.w); *(v2u*)(P_XH(F) + m * D + LRU_W + c) = p; } }
    }
    __syncthreads();
}
__device__ __forceinline__ void p4_phase(Frame& F) {
    for (int u = F.bid; u < BATCH * (SEQ / LCH); u += F.G) p4_unit(F, u >> 6, u & 63);
}

__device__ __forceinline__ int f2key(float f) { const int b = __builtin_bit_cast(int, f); return b ^ ((b >> 31) & 0x7fffffff); }
__device__ __forceinline__ float key2f(int k) { const int b = k ^ ((k >> 31) & 0x7fffffff); return __builtin_bit_cast(float, b); }
__device__ __forceinline__ void ins16(int (&L)[16], int x) {
#pragma unroll
    for (int j = 0; j < 16; ++j) { const int hi = max(L[j], x); x = min(L[j], x); L[j] = hi; }
}
__device__ __forceinline__ void ce_desc(int& a, int& b) { const int hi = a > b ? a : b, lo = a > b ? b : a; a = hi; b = lo; }
__device__ __forceinline__ void sort16_desc(int (&a)[16]) {
#pragma unroll
    for (int k = 2; k <= 16; k <<= 1)
#pragma unroll
        for (int j = k >> 1; j > 0; j >>= 1)
#pragma unroll
            for (int i = 0; i < 16; ++i) { const int l = i ^ j; if (l > i) { if ((i & k) == 0) ce_desc(a[i], a[l]); else ce_desc(a[l], a[i]); } }
}
__device__ __forceinline__ void bitonic_merge16_desc(int (&a)[16]) {
#pragma unroll
    for (int j = 8; j > 0; j >>= 1)
#pragma unroll
        for (int i = 0; i < 16; ++i) { const int l = i ^ j; if (l > i) ce_desc(a[i], a[l]); }
}
__device__ __forceinline__ void merge_top16(int (&a)[16], const int (&b)[16]) {
#pragma unroll
    for (int i = 0; i < 16; ++i) a[i] = a[i] > b[15 - i] ? a[i] : b[15 - i];
    bitonic_merge16_desc(a);
}
constexpr int INT_LOWEST = (int)0x80000000;
__device__ __forceinline__ void p8_item(Frame& F, int tt, int hd, LAS int* lut  ) {
    const int lane = F.lane, r = lane & 31, hh = lane >> 5;
    const bf16* QP = P_PROJ(F);
    int V[2][16];
#pragma unroll
    for (int p = 0; p < 2; ++p) {
        bf16x8 qf[8];
        const char* qb = (const char*)(QP + (size_t)(32 * tt) * D + hd * 256 + p * 128);
        const unsigned qoff = (unsigned)(r * D + 8 * hh) * 2u;
#pragma unroll
        for (int ks = 0; ks < 8; ++ks) qf[ks] = *(const bf16x8*)(qb + qoff + 32 * ks);
        int L[16];
#pragma unroll
        for (int j = 0; j < 16; ++j) L[j] = INT_LOWEST;
        const char* skb = (const char*)(P_SK(F) + (size_t)((hd * 2 + p) * PKEYS) * PHALF);
        const unsigned skoff = (unsigned)(r * PHALF + 8 * hh) * 2u;
#pragma unroll 1
        for (int kt = 0; kt < 4; ++kt) {
            f32x16 acc;
#pragma unroll
            for (int i = 0; i < 16; ++i) acc[i] = 0.f;
            const char* skt = skb + (size_t)(32 * kt) * PHALF * 2;
#pragma unroll
            for (int ks = 0; ks < 8; ++ks) { const bf16x8 kf = *(const bf16x8*)(skt + skoff + 32 * ks); acc = MFMA32(kf, qf[ks], acc); }
            const int kbase = 32 * kt + 4 * hh;
            int T[16];
#pragma unroll
            for (int i = 0; i < 16; ++i) { const int kidx = (i & 3) + 8 * (i >> 2); T[i] = (f2key(acc[i]) & ~0x7f) | (kbase + kidx); }
            sort16_desc(T); merge_top16(L, T);
        }
        int O[16];
#pragma unroll
        for (int j = 0; j < 16; ++j) O[j] = __shfl_xor(L[j], 32);
        merge_top16(L, O);
#pragma unroll
        for (int j = 0; j < 16; ++j) V[p][j] = L[j];
    }
#pragma unroll
    for (int j = 0; j < 16; ++j) { lut[lane * 33 + j] = V[0][j] & 0x7f; lut[lane * 33 + 16 + j] = V[1][j] & 0x7f; }
    float v0[16], v1[16];
#pragma unroll
    for (int j = 0; j < 16; ++j) { v0[j] = key2f(V[0][j] & ~0x7f); v1[j] = key2f(V[1][j] & ~0x7f); }
    int C[16], G1[16], G2[16], G3[2];
    { int n = 0;
#pragma unroll
      for (int i = 0; i < 16; ++i)
#pragma unroll
        for (int j = 0; j < 16; ++j)
            if ((i + 1) * (j + 1) <= 16) { const int key = (f2key(v0[i] + v1[j]) & ~0xff) | (i * 16 + j);
                if (n < 16) C[n] = key; else if (n < 32) G1[n - 16] = key; else if (n < 48) G2[n - 32] = key; else G3[n - 48] = key;
                ++n; } }
    sort16_desc(C); sort16_desc(G1); sort16_desc(G2);
    merge_top16(C, G1); merge_top16(C, G2); ins16(C, G3[0]); ins16(C, G3[1]);
    float sv[16]; float den = 0.f;
    const float mx = key2f(C[0] & ~0xff);
#pragma unroll
    for (int e = 0; e < 16; ++e) { sv[e] = __expf(key2f(C[e] & ~0xff) - mx); den += sv[e]; }
    const float inv = 1.0f / den;
    LDS_WAIT(); asm volatile("" ::: "memory");
    int idx[16];
#pragma unroll
    for (int e = 0; e < 16; ++e) { const int pi = (C[e] >> 4) & 15, pj = C[e] & 15; idx[e] = lut[lane * 33 + pi] * PKEYS + lut[lane * 33 + 16 + pj]; }
    if (hh == 0) {
        unsigned short* ip = P_IDX(F) + (size_t)(32 * tt + r) * 128 + hd * 16; float* gp = P_GW(F) + (size_t)(32 * tt + r) * 128 + hd * 16;
#pragma unroll
        for (int q = 0; q < 2; ++q) *(v4u*)(ip + 8 * q) = (v4u){(unsigned)idx[8 * q] | ((unsigned)idx[8 * q + 1] << 16), (unsigned)idx[8 * q + 2] | ((unsigned)idx[8 * q + 3] << 16),
                                                              (unsigned)idx[8 * q + 4] | ((unsigned)idx[8 * q + 5] << 16), (unsigned)idx[8 * q + 6] | ((unsigned)idx[8 * q + 7] << 16)};
#pragma unroll
        for (int q = 0; q < 4; ++q) *(f32x4*)(gp + 4 * q) = (f32x4){sv[4 * q] * inv, sv[4 * q + 1] * inv, sv[4 * q + 2] * inv, sv[4 * q + 3] * inv};
    }
    LDS_WAIT(); asm volatile("" ::: "memory");
}
__device__ __forceinline__ void p8_phase(Frame& F) {
    LAS int* lut = (LAS int*)(F.lds + F.wave * (64 * 33 * 4));
    const int gw = F.bid * NWAVES + F.wave, NGW = F.G * NWAVES;
    for (int it = gw; it < (M / 32) * PH; it += NGW) p8_item(F, it >> 3, it & 7, lut);
}

template <int CTRL> __device__ __forceinline__ float dpp_f(float x) { return __builtin_bit_cast(float, __builtin_amdgcn_mov_dpp(__builtin_bit_cast(int, x), CTRL, 0xf, 0xf, true)); }
__device__ __forceinline__ float sum8(float v) {
    v += dpp_f<0xB1>(v);
    v += dpp_f<0x4E>(v);
    v += dpp_f<0x141>(v);
    return v;
}
__device__ __forceinline__ void dec16(const v4u r, float (&f)[16]) {
    const unsigned w4[4] = {r.x, r.y, r.z, r.w};
#pragma unroll
    for (int w = 0; w < 4; ++w) { const f32x2 lo = __builtin_amdgcn_cvt_pk_f32_fp8((int)w4[w], false), hi = __builtin_amdgcn_cvt_pk_f32_fp8((int)w4[w], true);
        f[4 * w] = lo.x; f[4 * w + 1] = lo.y; f[4 * w + 2] = hi.x; f[4 * w + 3] = hi.y; }
}
__device__ __forceinline__ void row_offsets(const v4u a, const v4u b, unsigned loff, unsigned (&off)[16]) {
    const unsigned w[8] = {a.x, a.y, a.z, a.w, b.x, b.y, b.z, b.w};
#pragma unroll
    for (int q = 0; q < 8; ++q) { off[2 * q] = ((w[q] & 0xffffu) << 11) + loff; off[2 * q + 1] = ((w[q] >> 16) << 11) + loff; }
}
#define ISSUE_ROWS(dst, TBL, ia, ib) do { unsigned off_[16]; row_offsets((ia), (ib), loff, off_); \
    _Pragma("unroll") for (int i_ = 0; i_ < 16; ++i_) dst[i_] = *(const v4u*)((TBL) + off_[i_]); } while (0)

__device__ __forceinline__ void p9u_compute(const v4u (&row)[16], const v4u h0, const v4u h1, int c8, float* dst) {
    float h2[16];
    h2[0] = bflo(h0.x); h2[1] = bfhi(h0.x); h2[2] = bflo(h0.y); h2[3] = bfhi(h0.y); h2[4] = bflo(h0.z); h2[5] = bfhi(h0.z); h2[6] = bflo(h0.w); h2[7] = bfhi(h0.w);
    h2[8] = bflo(h1.x); h2[9] = bfhi(h1.x); h2[10] = bflo(h1.y); h2[11] = bfhi(h1.y); h2[12] = bflo(h1.z); h2[13] = bfhi(h1.z); h2[14] = bflo(h1.w); h2[15] = bfhi(h1.w);
    float res0 = 0.f, res1 = 0.f;
#pragma unroll
    for (int i = 0; i < 16; ++i) { float f[16]; dec16(row[i], f);
        float a0 = f[0] * h2[0], a1 = f[1] * h2[1], a2 = f[2] * h2[2], a3 = f[3] * h2[3];
#pragma unroll
        for (int e = 4; e < 16; e += 4) { a0 = fmaf(f[e], h2[e], a0); a1 = fmaf(f[e + 1], h2[e + 1], a1); a2 = fmaf(f[e + 2], h2[e + 2], a2); a3 = fmaf(f[e + 3], h2[e + 3], a3); }
        const float tot = sum8((a0 + a1) + (a2 + a3));
        if (i < 8) res0 = (c8 == (i & 7)) ? tot : res0; else res1 = (c8 == (i & 7)) ? tot : res1; }
    dst[0] = res0; dst[64] = res1;
}
__device__ __forceinline__ void p9u_item(Frame& F, int s, int tb) {
    const int lane = F.lane, gi = lane >> 3, c8 = lane & 7;
    const unsigned char* U8 = P_U(F);
    const unsigned loff = (unsigned)(128 * s + 16 * c8);
    const unsigned short* idxb = P_IDX(F) + (size_t)(64 * tb) * 128 + 8 * gi;
    const bf16* hb = P_XH(F) + (size_t)(64 * tb) * D + 128 * s + 16 * c8;
    float* pb = P_PART(F) + ((size_t)s * M + 64 * tb) * 128 + lane;
#define LOAD_META_U(I0, I1, H0, H1, tt_) do { const int tn_ = (tt_) < 64 ? (tt_) : 63; const unsigned short* ip_ = idxb + (size_t)tn_ * 128; const bf16* hp_ = hb + (size_t)tn_ * D; \
        I0 = *(const v4u*)(ip_); I1 = *(const v4u*)(ip_ + 64); H0 = *(const v4u*)(hp_); H1 = *(const v4u*)(hp_ + 8); } while (0)
    v4u aI0, aI1, aH0, aH1, bI0, bI1, bH0, bH1, cI0, cI1, cH0, cH1, dI0, dI1, dH0, dH1;
    LOAD_META_U(aI0, aI1, aH0, aH1, 0); LOAD_META_U(bI0, bI1, bH0, bH1, 1);
    v4u rowA[16], rowB[16];
    ISSUE_ROWS(rowA, U8, aI0, aI1); ISSUE_ROWS(rowB, U8, bI0, bI1);
    LOAD_META_U(cI0, cI1, cH0, cH1, 2);
#pragma unroll 1
    for (int t = 0; t < 64; t += 2) {
        p9u_compute(rowA, aH0, aH1, c8, pb + (size_t)t * 128);
        ISSUE_ROWS(rowA, U8, cI0, cI1);
        LOAD_META_U(dI0, dI1, dH0, dH1, t + 3);
        p9u_compute(rowB, bH0, bH1, c8, pb + (size_t)(t + 1) * 128);
        ISSUE_ROWS(rowB, U8, dI0, dI1);
        aH0 = cH0; aH1 = cH1; bH0 = dH0; bH1 = dH1;
        LOAD_META_U(cI0, cI1, cH0, cH1, t + 4);
    }
#undef LOAD_META_U
}
__device__ __forceinline__ void p9v_compute(const v4u (&row)[16], const v4u w0, const v4u w1, int lane, const f32x2 x1, const f32x2 g2, float* dst) {
    const unsigned ww[8] = {w0.x, w0.y, w0.z, w0.w, w1.x, w1.y, w1.z, w1.w};
    float acc[16];
#pragma unroll
    for (int e = 0; e < 16; ++e) acc[e] = 0.f;
#pragma unroll
    for (int i = 0; i < 16; ++i) { float f[16]; dec16(row[i], f); const float wv = (i & 1) ? bfhi(ww[i >> 1]) : bflo(ww[i >> 1]);
#pragma unroll
        for (int e = 0; e < 16; ++e) acc[e] = fmaf(f[e], wv, acc[e]); }
    float r8[8], r4[4], r2[2];
    { const bool up = (lane & 32) != 0;
#pragma unroll
      for (int e = 0; e < 8; ++e) { const float send = up ? acc[e] : acc[8 + e], keep = up ? acc[8 + e] : acc[e]; r8[e] = keep + __shfl_xor(send, 32); } }
    { const bool up = (lane & 16) != 0;
#pragma unroll
      for (int e = 0; e < 4; ++e) { const float send = up ? r8[e] : r8[4 + e], keep = up ? r8[4 + e] : r8[e]; r4[e] = keep + __shfl_xor(send, 16); } }
    { const bool up = (lane & 8) != 0;
#pragma unroll
      for (int e = 0; e < 2; ++e) { const float send = up ? r4[e] : r4[2 + e], keep = up ? r4[2 + e] : r4[e]; r2[e] = keep + __shfl_xor(send, 8); } }
    f32x2 o; o.x = x1.x + g2.x * r2[0]; o.y = x1.y + g2.y * r2[1];
    *(f32x2*)dst = o;
}
__device__ __forceinline__ void p9v_item(Frame& F, int s, int tb) {
    const int lane = F.lane, gi = lane >> 3, c8 = lane & 7;
    const unsigned char* V8 = P_V(F);
    const unsigned loff = (unsigned)(128 * s + 16 * c8);
    const unsigned short* idxb = P_IDX(F) + (size_t)(64 * tb) * 128 + 8 * gi;
    const int b = (64 * tb) / SEQ;
    const int wcol = 128 * s + 16 * c8 + 2 * gi;
    const f32x2 g2 = *(const f32x2*)(P_ADA(F) + (size_t)b * ADA_W + 5 * D + wcol);
    float* ob = P_out(F) + (size_t)(64 * tb) * D + wcol;
    LAS unsigned char* Wl = F.lds + F.wave * 16384;
    { const v4u* wsrc = (const v4u*)(P_W(F) + (size_t)(64 * tb) * 128); v4u tmp[16];
#pragma unroll
      for (int q = 0; q < 16; ++q) tmp[q] = wsrc[q * 64 + lane];
#pragma unroll
      for (int q = 0; q < 16; ++q) *(LAS v4u*)(Wl + (q * 64 + lane) * 16) = tmp[q]; }
    const LAS unsigned char* wl = Wl + 16 * gi;
#define LOAD_IDX(I0, I1, tt_) do { const int tn_ = (tt_) < 64 ? (tt_) : 63; const unsigned short* ip_ = idxb + (size_t)tn_ * 128; I0 = *(const v4u*)(ip_); I1 = *(const v4u*)(ip_ + 64); } while (0)
#define V_COMPUTE(ROW, tt_) do { const f32x2 x1_ = *(const f32x2*)(ob + (size_t)(tt_) * D); const v4u w0_ = *(const LAS v4u*)(wl + (tt_) * 256), w1_ = *(const LAS v4u*)(wl + (tt_) * 256 + 128); \
        p9v_compute(ROW, w0_, w1_, lane, x1_, g2, ob + (size_t)(tt_) * D); } while (0)
    v4u aI0, aI1, bI0, bI1, cI0, cI1, dI0, dI1;
    LOAD_IDX(aI0, aI1, 0); LOAD_IDX(bI0, bI1, 1);
    v4u rowA[16], rowB[16];
    ISSUE_ROWS(rowA, V8, aI0, aI1); ISSUE_ROWS(rowB, V8, bI0, bI1);
    LOAD_IDX(cI0, cI1, 2);
#pragma unroll 1
    for (int t = 0; t < 64; t += 2) {
        V_COMPUTE(rowA, t);
        ISSUE_ROWS(rowA, V8, cI0, cI1);
        LOAD_IDX(dI0, dI1, t + 3);
        V_COMPUTE(rowB, t + 1);
        ISSUE_ROWS(rowB, V8, dI0, dI1);
        LOAD_IDX(cI0, cI1, t + 4);
    }
#undef LOAD_IDX
#undef V_COMPUTE
}
__device__ __forceinline__ void p9u_phase(Frame& F) {
    const int x = F.bid & 7, rank = F.bid >> 3, nr = F.G >> 3;
    for (int h = 0; h < 2; ++h)
        for (int tb = rank * NWAVES + F.wave; tb < M / 64; tb += nr * NWAVES) p9u_item(F, 2 * x + h, tb);
}
__device__ __forceinline__ void p9v_phase(Frame& F) {
    const int x = F.bid & 7, rank = F.bid >> 3, nr = F.G >> 3;
    for (int h = 0; h < 2; ++h)
        for (int tb = rank * NWAVES + F.wave; tb < M / 64; tb += nr * NWAVES) p9v_item(F, 2 * x + h, tb);
}
__device__ __forceinline__ void p9w_phase(Frame& F) {
    const float* part = P_PART(F); const unsigned short* idxp = P_IDX(F); const float* gwp = P_GW(F); const float* usc = P_USC(F); const float* vsc = P_VSC(F); bf16* wp = P_W(F);
    for (int it = F.bid * 512 + F.tid; it < M * 128; it += F.G * 512) {
        float a = 0.f;
#pragma unroll
        for (int s = 0; s < 16; ++s) a += part[(size_t)s * M * 128 + it];
        const int idx = idxp[it];
        wp[it] = (bf16)f2bf(gwp[it] * gelu_tanh(a * usc[idx]) * vsc[idx]);
    }
}

struct Args { const void* in[25]; float* out; unsigned char* ws; int ph_lo, ph_hi; };
__global__ void __launch_bounds__(NWAVES * 64, 2) hymba_fwd(Args args) {
    extern __shared__ __attribute__((aligned(16))) unsigned char lds_raw[];
    Frame F;
    F.lds = (LAS unsigned char*)lds_raw;
    F.tid = threadIdx.x; F.lane = F.tid & 63; F.wave = __builtin_amdgcn_readfirstlane(F.tid >> 6);
    F.G = gridDim.x; F.bid = blockIdx.x;
    F.ka = (kaptr_t)__builtin_amdgcn_kernarg_segment_ptr();
    static_assert(sizeof(Args) == 224, "kernarg byte offsets used by ka_ptr");
    for (int u = F.tid; u < (LDS_BYTES - LDSCTL_OFF) / 4; u += NWAVES * 64) ((LAS unsigned*)(F.lds + LDSCTL_OFF))[u] = 0u;
    __syncthreads();
    volatile LAS unsigned* MISC = (volatile LAS unsigned*)(F.lds + MISC_OFF);
    XcdBarrier bar; bar.bar = (unsigned*)(P_ws(F) + WS_CTL) + CW_BAR; bar.x = 0; bar.st = nullptr;
    const int lo = args.ph_lo, hi = args.ph_hi;
    if (hi - lo > 1) bar = xcd_barrier_post((unsigned*)(P_ws(F) + WS_CTL) + CW_BAR, MISC + 8);
#define IN(k) (lo <= (k) && (k) < hi)
#ifndef PROBE_STAMP
#define PROBE_STAMP -1
#define PROBE_DIV 5.0f
#endif
#define STAMP(k) do { if (PROBE_STAMP >= 0 && F.bid == 0 && F.tid == 0) ((unsigned long long*)(P_ws(F) + WS_CTL + 64))[(k)] = __builtin_amdgcn_s_memrealtime(); } while (0)
#define SEAM(k) do { if (IN(k) && IN((k) + 1)) xcd_barrier(bar); STAMP((k) + 1); } while (0)
    STAMP(0);

#ifndef PROBE_MASK
#define PROBE_MASK 0
#endif
#define REP(k) for (int rep_ = 0; rep_ < (((PROBE_MASK >> (k)) & 1) ? 2 : 1); ++rep_)
#define REPSYNC(k) do { if (((PROBE_MASK >> (k)) & 1) && rep_ == 0) xcd_barrier(bar); } while (0)
    if (IN(0)) { REP(0) { p0_prologue(F); REPSYNC(0); } } SEAM(0);
    if (IN(1)) { REP(1) { p1_phase(F); REPSYNC(1); } } SEAM(1);
    if (IN(2)) REP(2) {
        pg8::Gemm g{P_XH(F), P_WIN(F), M, MIX_IN, D}; pg8::StaticOrder S; S.init(M, MIX_IN, F.G, F.bid);
        pg8::EpiStoreBf16 E{P_PROJ(F), MIX_IN};
        pg8::gemm_phase<pg8::EpiStoreBf16, pg8::StaticOrder, true, true>(F.lds, g, S, E); REPSYNC(2);
        { const int nwg = (M / 256) * (MIX_IN / 256), busy = nwg % F.G;
          if (busy > 0 && F.bid >= busy) quant_rows(F, QUANT_SPLIT, 2 * NEXP, (F.bid - busy) * NWAVES + F.wave, (F.G - busy) * NWAVES);
          else if (busy == 0) quant_rows(F, QUANT_SPLIT, 2 * NEXP, F.bid * NWAVES + F.wave, F.G * NWAVES); }
    } SEAM(2);
    if (IN(3)) { p3_phase(F); } SEAM(3);
    if (IN(4)) { p4_phase(F); } SEAM(4);
    if (IN(5)) REP(5) {
        pg8::Gemm g{P_XH(F), P_WOUT(F), M, D, D}; pg8::StaticOrder S; S.init(M, D, F.G, F.bid);
        pg8::EpiResid E{P_x(F), P_out(F), D, P_ADA(F) + 2 * D, ADA_W, SEQ};
        pg8::gemm_phase<pg8::EpiResid, pg8::StaticOrder, true, true>(F.lds, g, S, E); REPSYNC(5);
    } SEAM(5);
    if (IN(6)) { REP(6) { p6_phase(F); REPSYNC(6); } } SEAM(6);
    if (IN(7)) REP(7) {
        pg8::Gemm g{P_XH(F), P_WQ(F), M, D, D}; pg8::StaticOrder S; S.init(M, D, F.G, F.bid);
        pg8::EpiStoreBf16 E{P_PROJ(F), D};
        pg8::gemm_phase<pg8::EpiStoreBf16, pg8::StaticOrder, true, true>(F.lds, g, S, E); REPSYNC(7);
    } SEAM(7);
    if (IN(8)) { REP(8) { p8_phase(F); REPSYNC(8); } } SEAM(8);
    if (IN(9)) { p9u_phase(F); } SEAM(9);
    if (IN(10)) { p9w_phase(F); } SEAM(10);
    if (IN(11)) { p9v_phase(F); }
    if (PROBE_STAMP >= 0) {
        __syncthreads(); STAMP(12); VM_WAIT(); __syncthreads();
        if (F.bid == 0 && F.tid == 0) { const unsigned long long* ts = (const unsigned long long*)(P_ws(F) + WS_CTL + 64);
            const float us = (float)(ts[PROBE_STAMP + 1] - ts[PROBE_STAMP]) * 0.01f; P_out(F)[0] += us * (1.0f / PROBE_DIV); }
    }
#undef IN
#undef SEAM
}

extern "C" void kernel_launch(void* const* d_in, const int* in_sizes, int n_in, void* d_out, int out_size, void* d_ws, size_t ws_size, hipStream_t stream) {
    static int grid = 0;
    if (grid == 0) {
        if (n_in != 25 || in_sizes[0] != M * D || out_size != M * D || ws_size < WS_END) {
            fprintf(stderr, "kernel_launch: built for 25 inputs, x/out of %d floats, >= %zu bytes of workspace; got n_in %d, in0 %d, out %d, ws %zu; nothing launched\n", M * D, (size_t)WS_END, n_in, n_in > 0 ? in_sizes[0] : -1, out_size, ws_size);
            grid = -1; return; }
        int dev = 0, cus = 0, per_cu = 0;
        if (hipGetDevice(&dev) != hipSuccess || hipDeviceGetAttribute(&cus, hipDeviceAttributeMultiprocessorCount, dev) != hipSuccess) { fprintf(stderr, "kernel_launch: device query failed\n"); grid = -1; return; }
        if (hipFuncSetAttribute((const void*)hymba_fwd, hipFuncAttributeMaxDynamicSharedMemorySize, LDS_BYTES) != hipSuccess) { fprintf(stderr, "kernel_launch: hipFuncSetAttribute failed\n"); grid = -1; return; }
        if (hipOccupancyMaxActiveBlocksPerMultiprocessor(&per_cu, (const void*)hymba_fwd, NWAVES * 64, LDS_BYTES) != hipSuccess || per_cu < 1) {
            fprintf(stderr, "kernel_launch: occupancy query reports %d workgroups per CU; need 1\n", per_cu); (void)hipGetLastError(); grid = -1; return; }
        grid = cus;
        if (grid % 8 != 0 || (M / 64) % (grid / 8 * NWAVES) != 0) { fprintf(stderr, "kernel_launch: grid %d not supported (needs a multiple of 8 dividing the token blocks)\n", grid); grid = -1; return; }
    }
    if (grid < 0) return;
    if (hipMemsetAsync((char*)d_ws + WS_CTL, 0, CTL_ZERO_BYTES, stream) != hipSuccess) { fprintf(stderr, "kernel_launch: memset failed\n"); return; }
    Args a{};
    for (int i = 0; i < 25; ++i) a.in[i] = d_in[i];
    a.out = (float*)d_out; a.ws = (unsigned char*)d_ws;
    if (N_LAUNCHES == 1) {
        a.ph_lo = 0; a.ph_hi = N_PHASES;
        void* kargs[] = {&a};
        const hipError_t le = hipLaunchCooperativeKernel((const void*)hymba_fwd, dim3(grid), dim3(NWAVES * 64), kargs, LDS_BYTES, stream);
        if (le != hipSuccess) fprintf(stderr, "kernel_launch: cooperative launch failed: %s (grid %d)\n", hipGetErrorName(le), grid);
    } else {
#ifndef PROBE_TWICE
#define PROBE_TWICE 0
#endif
        for (int li = 0; li < N_PHASES; ++li) { a.ph_lo = li; a.ph_hi = li + 1;
            if ((PROBE_TWICE >> li) & 1) hipLaunchKernelGGL(hymba_fwd, dim3(grid), dim3(NWAVES * 64), LDS_BYTES, stream, a);
            hipLaunchKernelGGL(hymba_fwd, dim3(grid), dim3(NWAVES * 64), LDS_BYTES, stream, a);
            const hipError_t le = hipPeekAtLastError();
            if (le != hipSuccess) { fprintf(stderr, "kernel_launch: launch %d failed: %s\n", li, hipGetErrorName(le)); break; } }
    }
}
```

```cpp
#include <hip/hip_runtime.h>
#include <cstdio>
#include <cstdint>
namespace pg8 {
#define PG8_LAS __attribute__((address_space(3)))
typedef unsigned short bf16_t;
typedef short bf16x8 __attribute__((ext_vector_type(8)));
typedef float f32x4 __attribute__((ext_vector_type(4)));
typedef unsigned u32x4 __attribute__((ext_vector_type(4)));
constexpr int BM = 256, BK = 64, HALF = 128, HTB = HALF * BK * 2  , STAGE_BYTES = 8 * HTB, NXCD = 8, WGM = 8;

__host__ __device__ __forceinline__ int lds_byte(int r, int c) { const int st = (r >> 4) * 2 + (c >> 5), rr = r & 15, cc = c & 31, ob = rr * 64 + cc * 2; return st * 1024 + (ob ^ (((ob >> 9) & 1) << 5)); }
__host__ __device__ __forceinline__ void stage_rc(int b, int& R, int& C) { const int st = b / 1024, sb = b % 1024, swz = sb ^ (((sb >> 9) & 1) << 5); R = (st >> 1) * 16 + swz / 64; C = (st & 1) * 32 + (swz % 64) / 2; }
__host__ __device__ __forceinline__ int perm32(int rho) { const int n = rho >> 4, i = rho & 15; return 8 * (i >> 2) + 4 * n + (i & 3); }

struct Unit { int pm, pn; };
struct Gemm { const bf16_t* A; const bf16_t* Bt; int M, N, K; };

struct StaticOrder {
    int nM, nN, nwg, G, c;
    __host__ __device__ void init(int M, int N, int G_, int c_) { nM = M / BM; nN = N / BM; nwg = nM * nN; G = G_; c = c_; }
    __host__ __device__ bool next(int i, Unit& u) const {
        const long L = (long)i * G + c; if (L >= nwg) return false;
        int wgid = (int)L; { const int q = nwg / NXCD, r = nwg % NXCD, xcd = wgid % NXCD, off = wgid / NXCD; wgid = (xcd < r ? xcd * (q + 1) : r * (q + 1) + (xcd - r) * q) + off; }
        const int nig = WGM * nN, gid = wgid / nig, fm = gid * WGM, gsz = (nM - fm) < WGM ? (nM - fm) : WGM;
        u.pm = fm + ((wgid % nig) % gsz); u.pn = (wgid % nig) / gsz; return true;
    }
    __device__ __forceinline__ void a_ready(const Unit&) const {}
    __device__ __forceinline__ void done(const Unit&) const {}
};

__device__ __forceinline__ unsigned cvt_pk_bf16(float lo, float hi) { unsigned r; asm volatile("v_cvt_pk_bf16_f32 %0, %1, %2" : "=v"(r) : "v"(lo), "v"(hi)); return r; }
struct EpiStoreBf16 {
    static constexpr bool PERM = true, AFTER_DRAIN = false;
    bf16_t* O; int ldc;
    __device__ __forceinline__ void operator()(const f32x4 (&acc)[2][2][4][2], const Unit& u, int wr, int wc, int fr, int fq) const {
        const int row0 = u.pm * BM + wr * 64 + fr; const int col0 = u.pn * BM + wc * 32 + 8 * fq;
#pragma unroll
        for (int ai = 0; ai < 2; ++ai)
#pragma unroll
            for (int m = 0; m < 4; ++m) { bf16_t* rowp = O + (size_t)(row0 + ai * HALF + m * 16) * ldc + col0;
#pragma unroll
                for (int bj = 0; bj < 2; ++bj) { const f32x4 v0 = acc[ai][bj][m][0], v1 = acc[ai][bj][m][1];
                    u32x4 w; w.x = cvt_pk_bf16(v0[0], v0[1]); w.y = cvt_pk_bf16(v0[2], v0[3]); w.z = cvt_pk_bf16(v1[0], v1[1]); w.w = cvt_pk_bf16(v1[2], v1[3]);
                    *(u32x4*)(rowp + bj * HALF) = w; } }
    }
};
struct EpiResid {
    static constexpr bool PERM = true, AFTER_DRAIN = false;
    const float* base; bf16_t* out; int ldc; const float* gate; int gstride; int rows_per_batch;
    __device__ __forceinline__ void operator()(const f32x4 (&acc)[2][2][4][2], const Unit& u, int wr, int wc, int fr, int fq) const {
        const int b = (u.pm * BM) / rows_per_batch; const float* g = gate + (size_t)b * gstride;
        const int col0 = u.pn * BM + wc * 32 + 8 * fq;
        f32x4 gv[2][2];
#pragma unroll
        for (int bj = 0; bj < 2; ++bj)
#pragma unroll
            for (int n = 0; n < 2; ++n) gv[bj][n] = *(const f32x4*)(g + col0 + bj * HALF + n * 4);
#pragma unroll
        for (int ai = 0; ai < 2; ++ai)
#pragma unroll
            for (int m = 0; m < 4; ++m) { const size_t off = (size_t)(u.pm * BM + ai * HALF + wr * 64 + m * 16 + fr) * ldc + col0;
#pragma unroll
                for (int bj = 0; bj < 2; ++bj) { const f32x4 b0 = *(const f32x4*)(base + off + bj * HALF), b1 = *(const f32x4*)(base + off + bj * HALF + 4);
                    const f32x4 v0 = b0 + gv[bj][0] * acc[ai][bj][m][0], v1 = b1 + gv[bj][1] * acc[ai][bj][m][1];
                    u32x4 w; w.x = cvt_pk_bf16(v0[0], v0[1]); w.y = cvt_pk_bf16(v0[2], v0[3]); w.z = cvt_pk_bf16(v1[0], v1[1]); w.w = cvt_pk_bf16(v1[2], v1[3]);
                    *(u32x4*)(out + off + bj * HALF) = w; }
                if (m & 1) asm volatile("" ::: "memory"); }
    }
};

template <class Epi, class Sched, bool ALIGN_EPI = false, bool SP2 = false>
__device__ __forceinline__ void gemm_phase(PG8_LAS unsigned char* lds, const Gemm g, const Sched& S, const Epi& E) {
    const int tid = threadIdx.x, wid = __builtin_amdgcn_readfirstlane(tid >> 6), lane = tid & 63, wr = wid >> 2, wc = wid & 3, fr = lane & 15, fq = lane >> 4;
    const int K = g.K, nt = K / BK;
    unsigned voffA[2], voffB[2];
#pragma unroll
    for (int i = 0; i < 2; ++i) { int R, C; stage_rc(tid * 16 + i * 8192, R, C); const int Rb = Epi::PERM ? ((R & ~31) + perm32(R & 31)) : R;
        voffA[i] = (unsigned)(R * K + C) * 2u; voffB[i] = (unsigned)(Rb * K + C) * 2u; }
    const size_t kstep = (size_t)(BK * 2);
    const size_t hstep = (size_t)HALF * K * 2;
    const size_t tstep = 2 * hstep;
    const unsigned ldsw = (unsigned)wid * 1024u;
    const int aoff = lds_byte(wr * 64 + fr, fq * 8), boff = lds_byte(wc * 32 + fr, fq * 8);
#define PG8_SA(b, h) (((b) * 2 + (h)) * HTB)
#define PG8_SB(b, h) ((4 + (b) * 2 + (h)) * HTB)
#define PG8_STAGE(bufoff, gbase, voff) do { _Pragma("unroll") for (int _i = 0; _i < 2; ++_i) \
        __builtin_amdgcn_global_load_lds((const unsigned*)((const char*)(gbase) + (voff)[_i]), (PG8_LAS unsigned*)(lds + (bufoff) + ldsw + _i * 8192), 16, 0, 0); } while (0)
#define PG8_LDA(dst, b, h) do { _Pragma("unroll") for (int m = 0; m < 4; ++m) _Pragma("unroll") for (int k = 0; k < 2; ++k) dst[m][k] = *(const PG8_LAS bf16x8*)(lds + PG8_SA(b, h) + aoff + m * 2048 + k * 1024); } while (0)
#define PG8_LDB(dst, b, h) do { _Pragma("unroll") for (int n = 0; n < 2; ++n) _Pragma("unroll") for (int k = 0; k < 2; ++k) dst[n][k] = *(const PG8_LAS bf16x8*)(lds + PG8_SB(b, h) + boff + n * 2048 + k * 1024); } while (0)
#define PG8_MMA(ai, bj, At, Bt) do { __builtin_amdgcn_s_setprio(1); _Pragma("unroll") for (int m = 0; m < 4; ++m) _Pragma("unroll") for (int n = 0; n < 2; ++n) _Pragma("unroll") for (int k = 0; k < 2; ++k) \
        acc[ai][bj][m][n] = __builtin_amdgcn_mfma_f32_16x16x32_bf16(Bt[n][k], At[m][k], acc[ai][bj][m][n], 0, 0, 0); __builtin_amdgcn_s_setprio(0); } while (0)
#define PG8_WAIT_V(n) asm volatile("s_waitcnt vmcnt(" #n ")" ::: "memory")
#define PG8_WAIT_L(n) asm volatile("s_waitcnt lgkmcnt(" #n ")" ::: "memory")
#define PG8_BAR __builtin_amdgcn_s_barrier()
#define PG8_SCHED __builtin_amdgcn_sched_barrier(0)
    Unit cur, nxt; int ui = 0;
    if (!S.next(0, cur)) return;
    f32x4 acc[2][2][4][2];
#pragma unroll
    for (int a = 0; a < 2; ++a)
#pragma unroll
        for (int b = 0; b < 2; ++b)
#pragma unroll
            for (int m = 0; m < 4; ++m)
#pragma unroll
                for (int n = 0; n < 2; ++n) acc[a][b][m][n] = (f32x4){0.f, 0.f, 0.f, 0.f};
    bf16x8 At[4][2], B0[2][2], B1[2][2];
    const char* cA = (const char*)g.A + (size_t)cur.pm * tstep; const char* cB = (const char*)g.Bt + (size_t)cur.pn * tstep;
    S.a_ready(cur);
    if constexpr (SP2) {
        PG8_STAGE(PG8_SB(0, 0), cB, voffB); PG8_STAGE(PG8_SB(0, 1), cB + hstep, voffB); PG8_STAGE(PG8_SA(0, 0), cA, voffA); PG8_STAGE(PG8_SA(0, 1), cA + hstep, voffA);
        if (wr == 1) PG8_BAR;
        PG8_WAIT_V(2); PG8_BAR;
        PG8_STAGE(PG8_SB(1, 0), cB + kstep, voffB); PG8_STAGE(PG8_SA(1, 0), cA + kstep, voffA); PG8_STAGE(PG8_SB(1, 1), cB + hstep + kstep, voffB);
        PG8_WAIT_V(6); PG8_BAR;
    } else {
        PG8_STAGE(PG8_SB(0, 0), cB, voffB); PG8_STAGE(PG8_SA(0, 0), cA, voffA); PG8_STAGE(PG8_SB(0, 1), cB + hstep, voffB); PG8_STAGE(PG8_SA(0, 1), cA + hstep, voffA);
        if (wr == 1) PG8_BAR;
        PG8_WAIT_V(4); PG8_BAR;
        PG8_STAGE(PG8_SB(1, 0), cB + kstep, voffB); PG8_STAGE(PG8_SA(1, 0), cA + kstep, voffA); PG8_STAGE(PG8_SB(1, 1), cB + hstep + kstep, voffB);
        PG8_WAIT_V(6); PG8_BAR;
    }
    for (;;) {
        const bool has_next = S.next(ui + 1, nxt);
        const char* nA = has_next ? (const char*)g.A + (size_t)nxt.pm * tstep : cA; const char* nB = has_next ? (const char*)g.Bt + (size_t)nxt.pn * tstep : cB;
        for (int t = 0; t < nt; t += 2) {
            const bool last = (t == nt - 2);
            const char* a1 = cA + (size_t)(t + 1) * kstep;
            const char* a2 = last ? nA : cA + (size_t)(t + 2) * kstep; const char* b2 = last ? nB : cB + (size_t)(t + 2) * kstep;
            const char* a3 = a2 + kstep; const char* b3 = b2 + kstep;
            if (last && has_next) S.a_ready(nxt);
            if constexpr (SP2) {
            PG8_LDB(B0, 0, 0); PG8_LDB(B1, 0, 1); PG8_SCHED; PG8_LDA(At, 0, 0); PG8_STAGE(PG8_SA(1, 1), a1 + hstep, voffA);
            PG8_WAIT_V(8); PG8_WAIT_L(0); PG8_BAR; PG8_MMA(0, 0, At, B0); PG8_MMA(0, 1, At, B1); PG8_BAR; PG8_SCHED;
            PG8_LDA(At, 0, 1); PG8_STAGE(PG8_SB(0, 0), b2, voffB); PG8_STAGE(PG8_SB(0, 1), b2 + hstep, voffB); PG8_STAGE(PG8_SA(0, 0), a2, voffA);
            PG8_WAIT_V(8); PG8_WAIT_L(0); PG8_BAR; PG8_MMA(1, 0, At, B0); PG8_MMA(1, 1, At, B1); PG8_BAR; PG8_SCHED;
            PG8_LDB(B0, 1, 0); PG8_LDB(B1, 1, 1); PG8_SCHED; PG8_LDA(At, 1, 0); PG8_STAGE(PG8_SA(0, 1), a2 + hstep, voffA);
            PG8_WAIT_V(8); PG8_WAIT_L(0); PG8_BAR; PG8_MMA(0, 0, At, B0); PG8_MMA(0, 1, At, B1); PG8_BAR; PG8_SCHED;
            PG8_LDA(At, 1, 1); PG8_STAGE(PG8_SB(1, 0), b3, voffB); PG8_STAGE(PG8_SB(1, 1), b3 + hstep, voffB); PG8_STAGE(PG8_SA(1, 0), a3, voffA);
            PG8_WAIT_V(8); PG8_WAIT_L(0); PG8_BAR; PG8_MMA(1, 0, At, B0); PG8_MMA(1, 1, At, B1); PG8_BAR; PG8_SCHED;
            } else {
            PG8_LDB(B0, 0, 0); PG8_SCHED; PG8_LDA(At, 0, 0); PG8_STAGE(PG8_SA(1, 1), a1 + hstep, voffA);
            PG8_WAIT_L(8); PG8_BAR; PG8_WAIT_L(0); PG8_MMA(0, 0, At, B0); PG8_BAR; PG8_SCHED;
            PG8_LDB(B1, 0, 1); PG8_STAGE(PG8_SB(0, 0), b2, voffB);
            PG8_BAR; PG8_WAIT_L(0); PG8_MMA(0, 1, At, B1); PG8_BAR;
            PG8_LDA(At, 0, 1); PG8_STAGE(PG8_SA(0, 0), a2, voffA);
            PG8_BAR; PG8_WAIT_L(0); PG8_MMA(1, 0, At, B0); PG8_BAR; PG8_SCHED;
            PG8_STAGE(PG8_SB(0, 1), b2 + hstep, voffB);
            PG8_WAIT_V(6); PG8_BAR; PG8_MMA(1, 1, At, B1); PG8_BAR;
            PG8_LDB(B0, 1, 0); PG8_SCHED; PG8_LDA(At, 1, 0); PG8_STAGE(PG8_SA(0, 1), a2 + hstep, voffA);
            PG8_WAIT_L(8); PG8_BAR; PG8_WAIT_L(0); PG8_MMA(0, 0, At, B0); PG8_BAR; PG8_SCHED;
            PG8_LDB(B1, 1, 1); PG8_STAGE(PG8_SB(1, 0), b3, voffB);
            PG8_BAR; PG8_WAIT_L(0); PG8_MMA(0, 1, At, B1); PG8_BAR;
            PG8_LDA(At, 1, 1); PG8_STAGE(PG8_SA(1, 0), a3, voffA);
            PG8_BAR; PG8_WAIT_L(0); PG8_MMA(1, 0, At, B0); PG8_BAR; PG8_SCHED;
            PG8_STAGE(PG8_SB(1, 1), b3 + hstep, voffB);
            PG8_WAIT_V(6); PG8_BAR; PG8_MMA(1, 1, At, B1); PG8_BAR;
            }
        }
        if constexpr (ALIGN_EPI) { if (wr == 0) PG8_BAR; }
        if constexpr (!Epi::AFTER_DRAIN) { E(acc, cur, wr, wc, fr, fq); S.done(cur); }
        if (!has_next) break;
#pragma unroll
        for (int a = 0; a < 2; ++a)
#pragma unroll
            for (int b = 0; b < 2; ++b)
#pragma unroll
                for (int m = 0; m < 4; ++m)
#pragma unroll
                    for (int n = 0; n < 2; ++n) acc[a][b][m][n] = (f32x4){0.f, 0.f, 0.f, 0.f};
        cur = nxt; cA = nA; cB = nB; ++ui;
        if constexpr (ALIGN_EPI) { if (wr == 1) PG8_BAR; }
    }
    PG8_WAIT_V(0);
    if constexpr (!ALIGN_EPI) { if (wr == 0) PG8_BAR; }
    PG8_BAR;
    if constexpr (Epi::AFTER_DRAIN) { E.fused(acc, cur, wr, wc, fr, fq, lds, wid, lane); S.done(cur); }
#undef PG8_SA
#undef PG8_SB
#undef PG8_STAGE
#undef PG8_LDA
#undef PG8_LDB
#undef PG8_MMA
#undef PG8_WAIT_V
#undef PG8_WAIT_L
#undef PG8_BAR
#undef PG8_SCHED
}
}

constexpr int NWAVES = 8;
#ifndef MK_N_LAUNCHES
#define MK_N_LAUNCHES 1
#endif
constexpr int N_PHASES = 12;
constexpr int N_LAUNCHES = MK_N_LAUNCHES;

constexpr int BATCH = 4, SEQ = 4096, D = 2048, M = BATCH * SEQ;
constexpr int LRU_W = 1024, LRU_HEADS = 8, LRU_BLK = 128;
constexpr int HD = 64, HQ = 16, HKV = 2, GRP = 8;
constexpr int MIX_IN = 3328;
constexpr int C_Y = 1024, C_Q = 2048, C_K = 3072, C_V = 3200;
constexpr int ADA_W = 6 * D;
constexpr int PH = 8, PKEYS = 128, PHALF = 128, PTOPK = 16, NEXP = 16384;
constexpr float EPS = 1e-6f;

constexpr size_t MiB = 1u << 20;
constexpr size_t WS_CTL = 0, CTL_ZERO_BYTES = 64 * 1024;
constexpr size_t WS_ADA = 1 * MiB;
constexpr size_t WS_ROPE = 2 * MiB;
constexpr size_t WS_WIN = 4 * MiB;
constexpr size_t WS_WOUT = 17 * MiB;
constexpr size_t WS_WQ = 25 * MiB;
constexpr size_t WS_WGA = 33 * MiB;
constexpr size_t WS_WGX = 33 * MiB + 256 * 1024;
constexpr size_t WS_SK = 33 * MiB + 512 * 1024;
constexpr size_t WS_IDX = 34 * MiB;
constexpr size_t WS_GW = 42 * MiB;
constexpr size_t WS_U = 50 * MiB;
constexpr size_t WS_V = 82 * MiB;
constexpr size_t WS_USC = 1 * MiB + 512 * 1024;
constexpr size_t WS_VSC = 1 * MiB + 768 * 1024;
constexpr size_t WS_X1B = 114 * MiB;
constexpr size_t WS_XH = 178 * MiB;
constexpr size_t WS_PROJ = 242 * MiB;
constexpr size_t WS_HL = 346 * MiB;
constexpr size_t WS_PA = 410 * MiB;
constexpr size_t WS_PART = WS_HL;
constexpr size_t WS_W = WS_PROJ + 64 * MiB;
constexpr size_t WS_END = 474 * MiB;
constexpr int CW_BAR = 4096;

constexpr int RING_BYTES = 131072;
constexpr int LDSCTL_OFF = RING_BYTES, MISC_OFF = LDSCTL_OFF + 320;
constexpr int LDS_BYTES = 147456;

#define GAS __attribute__((address_space(1)))
#define LAS __attribute__((address_space(3)))
typedef unsigned short bf16;
typedef unsigned v4u __attribute__((ext_vector_type(4)));
typedef unsigned v2u __attribute__((ext_vector_type(2)));
typedef float f32x4 __attribute__((ext_vector_type(4)));
typedef float f32x2 __attribute__((ext_vector_type(2)));
typedef float f32x16 __attribute__((ext_vector_type(16)));
typedef short bf16x8 __attribute__((ext_vector_type(8)));
typedef __bf16 bf16x2v __attribute__((ext_vector_type(2)));
#define LDS_WAIT() asm volatile("s_waitcnt lgkmcnt(0)" ::: "memory")
#define VM_WAIT() asm volatile("s_waitcnt vmcnt(0)" ::: "memory")
__device__ __forceinline__ unsigned f2bf(float f) { unsigned u = __builtin_bit_cast(unsigned, f); return (u + 0x7fffu + ((u >> 16) & 1u)) >> 16; }
__device__ __forceinline__ unsigned pk2(float lo, float hi) { return f2bf(lo) | (f2bf(hi) << 16); }
__device__ __forceinline__ float bflo(unsigned u) { return __builtin_bit_cast(float, u << 16); }
__device__ __forceinline__ float bfhi(unsigned u) { return __builtin_bit_cast(float, u & 0xffff0000u); }
__device__ __forceinline__ float bf1(bf16 h) { return __builtin_bit_cast(float, (unsigned)h << 16); }
__device__ __forceinline__ float dot2bf(unsigned a, unsigned b, float acc) { return __builtin_amdgcn_fdot2_f32_bf16(__builtin_bit_cast(bf16x2v, a), __builtin_bit_cast(bf16x2v, b), acc, false); }
__device__ __forceinline__ float sigmoidf_(float x) { return 1.0f / (1.0f + __expf(-x)); }
__device__ __forceinline__ float gelu_tanh(float x) {
    const float z = 1.5957691216057308f * (x + 0.044715f * x * x * x);
    return x / (1.0f + __expf(-z));
}
__device__ __forceinline__ float wave_sum(float v) {
#pragma unroll
    for (int o = 1; o < 64; o <<= 1) v += __shfl_xor(v, o);
    return v;
}

#define XB_TMO      128
#define XB_XCNT(j)  (256  + 64 * (j))
#define XB_XSUB(j)  (1280 + 64 * (j))
#define XB_XGEN(j)  (2304 + 64 * (j))
#define XB_TOP      3328
#define XB_TOPGEN   3392
#define XCD_BAR_WORDS 3456
#define XB_SPIN_CAP (1u << 18)
__device__ __forceinline__ unsigned xb_ld(unsigned* p)              { return __hip_atomic_load(p, __ATOMIC_RELAXED, __HIP_MEMORY_SCOPE_AGENT); }
__device__ __forceinline__ unsigned xb_add(unsigned* p, unsigned v) { return __hip_atomic_fetch_add(p, v, __ATOMIC_RELAXED, __HIP_MEMORY_SCOPE_AGENT); }
__device__ __forceinline__ unsigned xb_xcc_id() { return (unsigned)__builtin_amdgcn_s_getreg((3 << 11) | 20) & 0xFu; }
#define XB_SPIN(cond, bar) do { unsigned _sp = 0; while (cond) { __builtin_amdgcn_s_sleep(1); \
    if ((++_sp & 255u) == 0u) { if (xb_ld(&(bar)[XB_TMO])) break; if (_sp > XB_SPIN_CAP) { atomicAdd(&(bar)[XB_TMO], 1u); break; } } } } while (0)
struct XcdBarrier { unsigned* bar; unsigned x; volatile LAS unsigned* st; };
__device__ __forceinline__ XcdBarrier xcd_barrier_post(unsigned* bar, volatile LAS unsigned* st) {
    XcdBarrier b; b.bar = bar; b.x = xb_xcc_id(); b.st = st;
    if (threadIdx.x == 0) (void)xb_add(&bar[XB_XCNT(b.x)], 1u);
    return b;
}
__device__ __forceinline__ void xcd_barrier_complete(unsigned* bar, unsigned x, unsigned& nloc, unsigned& nx) {
    const unsigned G = gridDim.x * gridDim.y * gridDim.z;
    unsigned sum, cnt, mine, sp = 0u;
    for (;;) {
        sum = 0u; cnt = 0u; mine = 0u;
#pragma unroll
        for (unsigned j = 0; j < 16; ++j) { const unsigned c = xb_ld(&bar[XB_XCNT(j)]); sum += c; cnt += (c > 0u) ? 1u : 0u; mine = (j == x) ? c : mine; }
        if (sum == G) break;
        __builtin_amdgcn_s_sleep(1);
        if ((++sp & 255u) == 0u) { if (xb_ld(&bar[XB_TMO])) break; if (sp > XB_SPIN_CAP) { atomicAdd(&bar[XB_TMO], 1u); break; } }
    }
    nloc = mine > 0u ? mine : 1u; nx = cnt > 0u ? cnt : 1u;
}
__device__ __forceinline__ void xcd_barrier(const XcdBarrier& b) {
    asm volatile("s_waitcnt vmcnt(0)" ::: "memory");
    __syncthreads();
    if (threadIdx.x == 0) {
        unsigned* bar = b.bar;
        __builtin_amdgcn_s_waitcnt(0);
        unsigned nloc = b.st[0], nx = b.st[1];
        if (nloc == 0u) { xcd_barrier_complete(bar, b.x, nloc, nx); b.st[0] = nloc; b.st[1] = nx; }
        const unsigned old = xb_add(&bar[XB_XSUB(b.x)], 1u);
        const unsigned gen = old / nloc;
        if (old + 1u == (gen + 1u) * nloc) {
            __builtin_amdgcn_fence(__ATOMIC_RELEASE, "agent");
            asm volatile("s_waitcnt vmcnt(0)" ::: "memory");
            const unsigned og = xb_add(&bar[XB_TOP], 1u);
            const unsigned tg = og / nx;
            if (og + 1u == (tg + 1u) * nx) xb_add(&bar[XB_TOPGEN], 1u);
            else XB_SPIN(xb_ld(&bar[XB_TOPGEN]) == tg, bar);
            __builtin_amdgcn_fence(__ATOMIC_ACQUIRE, "agent");
            xb_add(&bar[XB_XGEN(b.x)], 1u);
            asm volatile("s_waitcnt vmcnt(0)" ::: "memory");
        } else {
            XB_SPIN(xb_ld(&bar[XB_XGEN(b.x)]) == gen, bar);
            __builtin_amdgcn_fence(__ATOMIC_ACQUIRE, "agent");
            asm volatile("s_waitcnt vmcnt(0)" ::: "memory");
        }
    }
    __syncthreads();
}

typedef const __attribute__((address_space(4))) unsigned char* kaptr_t;
struct Frame { LAS unsigned char* lds; int tid, lane, wave, G, bid; kaptr_t ka; };
template <class T> __device__ __forceinline__ T* ka_ptr(const Frame& F, int byte_off) { typedef T* tp; return *(const __attribute__((address_space(4))) tp*)(F.ka + byte_off); }
__device__ __forceinline__ const float* P_x(const Frame& F) { return ka_ptr<const float>(F, 0); }
__device__ __forceinline__ const float* P_c(const Frame& F) { return ka_ptr<const float>(F, 8); }
__device__ __forceinline__ const int* P_pos(const Frame& F) { return ka_ptr<const int>(F, 16); }
__device__ __forceinline__ const float* P_w_ada(const Frame& F) { return ka_ptr<const float>(F, 24); }
__device__ __forceinline__ const float* P_b_ada(const Frame& F) { return ka_ptr<const float>(F, 32); }
__device__ __forceinline__ const float* P_norm1_g(const Frame& F) { return ka_ptr<const float>(F, 40); }
__device__ __forceinline__ const float* P_w_in(const Frame& F) { return ka_ptr<const float>(F, 48); }
__device__ __forceinline__ const float* P_conv_w(const Frame& F) { return ka_ptr<const float>(F, 56); }
__device__ __forceinline__ const float* P_conv_b(const Frame& F) { return ka_ptr<const float>(F, 64); }
__device__ __forceinline__ const float* P_ga_w(const Frame& F) { return ka_ptr<const float>(F, 72); }
__device__ __forceinline__ const float* P_ga_b(const Frame& F) { return ka_ptr<const float>(F, 80); }
__device__ __forceinline__ const float* P_gx_w(const Frame& F) { return ka_ptr<const float>(F, 88); }
__device__ __forceinline__ const float* P_gx_b(const Frame& F) { return ka_ptr<const float>(F, 96); }
__device__ __forceinline__ const float* P_lam(const Frame& F) { return ka_ptr<const float>(F, 104); }
__device__ __forceinline__ const float* P_qn_g(const Frame& F) { return ka_ptr<const float>(F, 112); }
__device__ __forceinline__ const float* P_kn_g(const Frame& F) { return ka_ptr<const float>(F, 120); }
__device__ __forceinline__ const float* P_sinks(const Frame& F) { return ka_ptr<const float>(F, 128); }
__device__ __forceinline__ const float* P_on_lru_g(const Frame& F) { return ka_ptr<const float>(F, 136); }
__device__ __forceinline__ const float* P_on_attn_g(const Frame& F) { return ka_ptr<const float>(F, 144); }
__device__ __forceinline__ const float* P_w_out(const Frame& F) { return ka_ptr<const float>(F, 152); }
__device__ __forceinline__ const float* P_norm2_g(const Frame& F) { return ka_ptr<const float>(F, 160); }
__device__ __forceinline__ const float* P_w_pq(const Frame& F) { return ka_ptr<const float>(F, 168); }
__device__ __forceinline__ const float* P_sub_keys(const Frame& F) { return ka_ptr<const float>(F, 176); }
__device__ __forceinline__ const float* P_pu(const Frame& F) { return ka_ptr<const float>(F, 184); }
__device__ __forceinline__ const float* P_pv(const Frame& F) { return ka_ptr<const float>(F, 192); }
__device__ __forceinline__ float* P_out(const Frame& F) { return ka_ptr<float>(F, 200); }
__device__ __forceinline__ unsigned char* P_ws(const Frame& F) { return ka_ptr<unsigned char>(F, 208); }
__device__ __forceinline__ float* P_ADA(const Frame& F) { return (float*)(P_ws(F) + WS_ADA); }
__device__ __forceinline__ float* P_ROPE(const Frame& F) { return (float*)(P_ws(F) + WS_ROPE); }
__device__ __forceinline__ bf16* P_HL(const Frame& F) { return (bf16*)(P_ws(F) + WS_HL); }
__device__ __forceinline__ bf16* P_PA(const Frame& F) { return (bf16*)(P_ws(F) + WS_PA); }
__device__ __forceinline__ float* P_GW(const Frame& F) { return (float*)(P_ws(F) + WS_GW); }
__device__ __forceinline__ unsigned short* P_IDX(const Frame& F) { return (unsigned short*)(P_ws(F) + WS_IDX); }
__device__ __forceinline__ bf16* P_WIN(const Frame& F) { return (bf16*)(P_ws(F) + WS_WIN); }
__device__ __forceinline__ bf16* P_WOUT(const Frame& F) { return (bf16*)(P_ws(F) + WS_WOUT); }
__device__ __forceinline__ bf16* P_WQ(const Frame& F) { return (bf16*)(P_ws(F) + WS_WQ); }
__device__ __forceinline__ bf16* P_WGA(const Frame& F) { return (bf16*)(P_ws(F) + WS_WGA); }
__device__ __forceinline__ bf16* P_WGX(const Frame& F) { return (bf16*)(P_ws(F) + WS_WGX); }
__device__ __forceinline__ bf16* P_SK(const Frame& F) { return (bf16*)(P_ws(F) + WS_SK); }
__device__ __forceinline__ unsigned char* P_U(const Frame& F) { return (unsigned char*)(P_ws(F) + WS_U); }
__device__ __forceinline__ bf16* P_X1B(const Frame& F) { return (bf16*)(P_ws(F) + WS_X1B); }
__device__ __forceinline__ unsigned* P_PART(const Frame& F) { return (unsigned*)(P_ws(F) + WS_PART); }
__device__ __forceinline__ bf16* P_W(const Frame& F) { return (bf16*)(P_ws(F) + WS_W); }
__device__ __forceinline__ float* P_USC(const Frame& F) { return (float*)(P_ws(F) + WS_USC); }
__device__ __forceinline__ float* P_VSC(const Frame& F) { return (float*)(P_ws(F) + WS_VSC); }
__device__ __forceinline__ unsigned char* P_V(const Frame& F) { return (unsigned char*)(P_ws(F) + WS_V); }
__device__ __forceinline__ bf16* P_XH(const Frame& F) { return (bf16*)(P_ws(F) + WS_XH); }
__device__ __forceinline__ bf16* P_PROJ(const Frame& F) { return (bf16*)(P_ws(F) + WS_PROJ); }

__device__ __forceinline__ void p0_transpose_item(const float* W, int K, int N, bf16* WT, LAS float* scr, int item, int lane) {
    const int nblk = N / 32, kb = item / nblk, nb = item % nblk, k0 = 64 * kb, n0 = 32 * nb;
#pragma unroll 8
    for (int i = 0; i < 32; ++i) { const int kk = 2 * i + (lane >> 5); scr[kk * 33 + (lane & 31)] = W[(size_t)(k0 + kk) * N + n0 + (lane & 31)]; }
    LDS_WAIT(); asm volatile("" ::: "memory");
    const int c = lane & 7;
#pragma unroll
    for (int j = 0; j < 4; ++j) { const int n = (lane >> 3) + 8 * j; const LAS float* s = scr + (8 * c) * 33 + n;
        v4u o; o.x = pk2(s[0 * 33], s[1 * 33]); o.y = pk2(s[2 * 33], s[3 * 33]); o.z = pk2(s[4 * 33], s[5 * 33]); o.w = pk2(s[6 * 33], s[7 * 33]);
        *(v4u*)(WT + (size_t)(n0 + n) * K + k0 + 8 * c) = o; }
    LDS_WAIT(); asm volatile("" ::: "memory");
}
__device__ __forceinline__ void p0_convert(const float* src, bf16* dst, size_t n8, size_t gtid, size_t gthreads) {
    for (size_t i = gtid; i < n8; i += gthreads) {
        const f32x4 a = *(const f32x4*)(src + 8 * i), b = *(const f32x4*)(src + 8 * i + 4);
        v4u o; o.x = pk2(a.x, a.y); o.y = pk2(a.z, a.w); o.z = pk2(b.x, b.y); o.w = pk2(b.z, b.w);
        *(v4u*)(dst + 8 * i) = o;
    }
}
#ifndef QUANT_SPLIT
#define QUANT_SPLIT 14336
#endif
__device__ __forceinline__ void quant_rows(Frame& F, int r0, int r1, int w, int nw) {
    for (int rr = r0 + w; rr < r1; rr += nw) {
        const int tbl = rr >= NEXP, row = rr - tbl * NEXP;
        const float* srcp = (tbl ? P_pv(F) : P_pu(F)) + (size_t)row * D;
        unsigned char* dstp = (tbl ? P_V(F) : P_U(F)) + (size_t)row * D;
        f32x4 v[8]; float mx = 0.f;
#pragma unroll
        for (int j = 0; j < 8; ++j) { v[j] = *(const f32x4*)(srcp + 4 * F.lane + 256 * j);
            mx = fmaxf(fmaxf(mx, fmaxf(fabsf(v[j].x), fabsf(v[j].y))), fmaxf(fabsf(v[j].z), fabsf(v[j].w))); }
#pragma unroll
        for (int o = 1; o < 64; o <<= 1) mx = fmaxf(mx, __shfl_xor(mx, o));
        const float s = fmaxf(mx, 1e-30f) * (1.0f / 224.0f), inv = 1.0f / s;
#pragma unroll
        for (int j = 0; j < 8; ++j) { int t = __builtin_amdgcn_cvt_pk_fp8_f32(v[j].x * inv, v[j].y * inv, 0, false);
            t = __builtin_amdgcn_cvt_pk_fp8_f32(v[j].z * inv, v[j].w * inv, t, true);
            *(int*)(dstp + 4 * F.lane + 256 * j) = t; }
        if (F.lane == 0) (tbl ? P_VSC(F) : P_USC(F))[row] = s;
    }
}
__device__ __forceinline__ void p0_prologue(Frame& F) {
    {
        LAS float* sc = (LAS float*)F.lds;
        LAS float* red = sc + 4 * D;
        for (int i = F.tid; i < 4 * D; i += 512) { const float v = P_c(F)[i]; sc[i] = v / (1.0f + __expf(-v)); }
        __syncthreads();
        for (int cg = F.bid; cg < ADA_W / 64; cg += F.G) {
            const int n0 = cg * 64, k0 = F.wave * 256;
            const float* wp = P_w_ada(F) + (size_t)k0 * ADA_W + n0 + F.lane;
            float a0 = 0.f, a1 = 0.f, a2 = 0.f, a3 = 0.f;
#pragma unroll 16
            for (int k = 0; k < 256; ++k) { const float w = wp[(size_t)k * ADA_W]; const int kk = k0 + k;
                a0 += sc[kk] * w; a1 += sc[D + kk] * w; a2 += sc[2 * D + kk] * w; a3 += sc[3 * D + kk] * w; }
            red[(F.wave * 4 + 0) * 64 + F.lane] = a0; red[(F.wave * 4 + 1) * 64 + F.lane] = a1;
            red[(F.wave * 4 + 2) * 64 + F.lane] = a2; red[(F.wave * 4 + 3) * 64 + F.lane] = a3;
            __syncthreads();
            if (F.tid < 256) { const int b = F.tid >> 6, l = F.tid & 63; float s = 0.f;
#pragma unroll
                for (int w = 0; w < 8; ++w) s += red[(w * 4 + b) * 64 + l];
                P_ADA(F)[(size_t)b * ADA_W + n0 + l] = s + P_b_ada(F)[n0 + l]; }
            __syncthreads();
        }
        __syncthreads();
    }
    {
        LAS float* scr = (LAS float*)(F.lds + F.wave * 16384);
        const int gw = F.bid * NWAVES + F.wave, NGW = F.G * NWAVES;
        constexpr int I_IN = (D / 64) * (MIX_IN / 32), I_SQ = (D / 64) * (D / 32), I_G = (LRU_BLK / 64) * (LRU_BLK / 32);
        constexpr int NITEMS = I_IN + 2 * I_SQ + 16 * I_G;
        for (int it = gw; it < NITEMS; it += NGW) {
            int r = it;
            if (r < I_IN) { p0_transpose_item(P_w_in(F), D, MIX_IN, P_WIN(F), scr, r, F.lane); continue; } r -= I_IN;
            if (r < I_SQ) { p0_transpose_item(P_w_out(F), D, D, P_WOUT(F), scr, r, F.lane); continue; } r -= I_SQ;
            if (r < I_SQ) { p0_transpose_item(P_w_pq(F), D, D, P_WQ(F), scr, r, F.lane); continue; } r -= I_SQ;
            const int g = r / I_G, ri = r % I_G, hd = g & 7;
            if (g < 8) p0_transpose_item(P_ga_w(F) + (size_t)hd * 16384, LRU_BLK, LRU_BLK, P_WGA(F) + (size_t)hd * 16384, scr, ri, F.lane);
            else       p0_transpose_item(P_gx_w(F) + (size_t)hd * 16384, LRU_BLK, LRU_BLK, P_WGX(F) + (size_t)hd * 16384, scr, ri, F.lane);
        }
    }
    {
        const size_t gtid = (size_t)F.bid * 512 + F.tid, gth = (size_t)F.G * 512;
        p0_convert(P_sub_keys(F), P_SK(F), (size_t)PH * 2 * PKEYS * PHALF / 8, gtid, gth);
    }
    quant_rows(F, 0, QUANT_SPLIT, F.bid * NWAVES + F.wave, F.G * NWAVES);
}

template <bool BF16IN> __device__ __forceinline__ void modnorm_rows4(const void* xin, const float* gain, const float* shift, const float* scale, bf16* orow, int lane) {
    f32x4 v[4][8]; float s[4];
#pragma unroll
    for (int r = 0; r < 4; ++r) { s[r] = 0.f;
#pragma unroll
        for (int j = 0; j < 8; ++j) {
            if (BF16IN) { const v2u q = *(const v2u*)((const bf16*)xin + (size_t)r * D + 4 * lane + 256 * j); v[r][j] = (f32x4){bflo(q.x), bfhi(q.x), bflo(q.y), bfhi(q.y)}; }
            else v[r][j] = *(const f32x4*)((const float*)xin + (size_t)r * D + 4 * lane + 256 * j); } }
#pragma unroll
    for (int r = 0; r < 4; ++r)
#pragma unroll
        for (int j = 0; j < 8; ++j) s[r] += (v[r][j].x * v[r][j].x + v[r][j].y * v[r][j].y) + (v[r][j].z * v[r][j].z + v[r][j].w * v[r][j].w);
#pragma unroll
    for (int o = 1; o < 64; o <<= 1) {
#pragma unroll
        for (int r = 0; r < 4; ++r) s[r] += __shfl_xor(s[r], o); }
    float rstd[4];
#pragma unroll
    for (int r = 0; r < 4; ++r) rstd[r] = 1.0f / sqrtf(s[r] * (1.0f / D) + EPS);
#pragma unroll
    for (int j = 0; j < 8; ++j) {
        const int c = 4 * lane + 256 * j;
        const f32x4 g = *(const f32x4*)(gain + c), sh = *(const f32x4*)(shift + c), sc = *(const f32x4*)(scale + c);
        const f32x4 gm = g * (sc + 1.0f);
#pragma unroll
        for (int r = 0; r < 4; ++r) { const f32x4 y = (v[r][j] * rstd[r]) * gm + sh;
            v2u o; o.x = pk2(y.x, y.y); o.y = pk2(y.z, y.w);
            *(v2u*)(orow + (size_t)r * D + c) = o; }
    }
}
__device__ __forceinline__ void p1_phase(Frame& F) {
    const int gw = F.bid * NWAVES + F.wave, NGW = F.G * NWAVES;
    for (int m = 4 * gw; m < M; m += 4 * NGW) { const int b = m / SEQ; const float* ada = P_ADA(F) + (size_t)b * ADA_W;
        modnorm_rows4<false>(P_x(F) + (size_t)m * D, P_norm1_g(F), ada, ada + D, P_XH(F) + (size_t)m * D, F.lane); }
    const float invf[8] = {1.0f, 1.9392274e-01f, 3.7606031e-02f, 7.2926646e-03f, 1.4142136e-03f, 2.7424819e-04f, 5.3182961e-05f, 1.0313386e-05f};
    for (int i = F.bid * 512 + F.tid; i < M * 8; i += F.G * 512) { const int m = i >> 3, k = i & 7;
        float f = invf[0];
#pragma unroll
        for (int q = 1; q < 8; ++q) f = (k == q) ? invf[q] : f;
        const float ang = (float)P_pos(F)[m] * f; float sn, cs; sincosf(ang, &sn, &cs);
        P_ROPE(F)[(size_t)m * 16 + k] = cs; P_ROPE(F)[(size_t)m * 16 + 8 + k] = sn; }
}
__device__ __forceinline__ void p6_phase(Frame& F) {
    const int gw = F.bid * NWAVES + F.wave, NGW = F.G * NWAVES;
    for (int m = 4 * gw; m < M; m += 4 * NGW) { const int b = m / SEQ; const float* ada = P_ADA(F) + (size_t)b * ADA_W;
        modnorm_rows4<true>(P_X1B(F) + (size_t)m * D, P_norm2_g(F), ada + 3 * D, ada + 4 * D, P_XH(F) + (size_t)m * D, F.lane); }
}

#define MFMA32(a, b, c) __builtin_amdgcn_mfma_f32_32x32x16_bf16((a), (b), (c), 0, 0, 0)
#define MFMA16(a, b, c) __builtin_amdgcn_mfma_f32_16x16x32_bf16((a), (b), (c), 0, 0, 0)
constexpr int KS_STRIDE = 72;
constexpr int VT_STRIDE = 264;
constexpr int ATT_KS_OFF = 0, ATT_VT_OFF = 256 * KS_STRIDE * 2;
static_assert(ATT_VT_OFF + 64 * VT_STRIDE * 2 <= RING_BYTES, "attention LDS");

__device__ __forceinline__ void attn_unit(Frame& F, int b, int g, int n) {
    LAS bf16* Ks = (LAS bf16*)(F.lds + ATT_KS_OFF);
    LAS bf16* VT = (LAS bf16*)(F.lds + ATT_VT_OFF);
    const int tid = F.tid, lane = F.lane;
    {
        const int kb = tid >> 1, hf = tid & 1; const int t = n * 128 - 128 + kb;
        float kv[32]; v4u vraw[4];
        if (t >= 0) {
            const bf16* kp = P_PROJ(F) + (size_t)(b * SEQ + t) * MIX_IN + C_K + g * HD + 32 * hf;
            const bf16* vp = P_PROJ(F) + (size_t)(b * SEQ + t) * MIX_IN + C_V + g * HD + 32 * hf;
#pragma unroll
            for (int q = 0; q < 4; ++q) { const v4u r = *(const v4u*)(kp + 8 * q); vraw[q] = *(const v4u*)(vp + 8 * q);
                kv[8 * q + 0] = bflo(r.x); kv[8 * q + 1] = bfhi(r.x); kv[8 * q + 2] = bflo(r.y); kv[8 * q + 3] = bfhi(r.y);
                kv[8 * q + 4] = bflo(r.z); kv[8 * q + 5] = bfhi(r.z); kv[8 * q + 6] = bflo(r.w); kv[8 * q + 7] = bfhi(r.w); }
        } else {
#pragma unroll
            for (int q = 0; q < 4; ++q) vraw[q] = (v4u){0u, 0u, 0u, 0u};
#pragma unroll
            for (int q = 0; q < 32; ++q) kv[q] = 0.f;
        }
        float ss = 0.f;
#pragma unroll
        for (int q = 0; q < 32; ++q) ss += kv[q] * kv[q];
        ss += __shfl_xor(ss, 1);
        const float rstd = 1.0f / sqrtf(ss * (1.0f / HD) + EPS);
#pragma unroll
        for (int q = 0; q < 32; ++q) kv[q] = kv[q] * rstd * P_kn_g(F)[32 * hf + q];
        if (hf == 0 && t >= 0) {
            const float* rp = P_ROPE(F) + (size_t)(b * SEQ + t) * 16;
#pragma unroll
            for (int i = 0; i < 8; ++i) { const float cs = rp[i], sn = rp[8 + i]; const float x1 = kv[i], x2 = kv[8 + i];
                kv[i] = x1 * cs - x2 * sn; kv[8 + i] = x2 * cs + x1 * sn; }
        }
#pragma unroll
        for (int q = 0; q < 4; ++q) { v4u o; o.x = pk2(kv[8 * q], kv[8 * q + 1]); o.y = pk2(kv[8 * q + 2], kv[8 * q + 3]); o.z = pk2(kv[8 * q + 4], kv[8 * q + 5]); o.w = pk2(kv[8 * q + 6], kv[8 * q + 7]);
            *(LAS v4u*)(Ks + kb * KS_STRIDE + 32 * hf + 8 * q) = o; }
#pragma unroll
        for (int q = 0; q < 4; ++q) { const unsigned w[4] = {vraw[q].x, vraw[q].y, vraw[q].z, vraw[q].w};
#pragma unroll
            for (int e = 0; e < 4; ++e) { const int d = 32 * hf + 8 * q + 2 * e;
                VT[d * VT_STRIDE + kb] = (bf16)(w[e] & 0xffffu); VT[(d + 1) * VT_STRIDE + kb] = (bf16)(w[e] >> 16); } }
    }
    __syncthreads();
    const int hq = g * GRP + F.wave, r = lane & 31, hh = lane >> 5;
    const float sink = P_sinks(F)[hq];
    for (int qi = 0; qi < 4; ++qi) {
        const int tq = n * 128 + 32 * qi + r;
        bf16x8 qf[4];
        {
            const bf16* qp = P_PROJ(F) + (size_t)(b * SEQ + tq) * MIX_IN + C_Q + hq * HD + 8 * hh;
            float qv[4][8]; float ss = 0.f;
#pragma unroll
            for (int ks = 0; ks < 4; ++ks) { const v4u rr = *(const v4u*)(qp + 16 * ks);
                qv[ks][0] = bflo(rr.x); qv[ks][1] = bfhi(rr.x); qv[ks][2] = bflo(rr.y); qv[ks][3] = bfhi(rr.y);
                qv[ks][4] = bflo(rr.z); qv[ks][5] = bfhi(rr.z); qv[ks][6] = bflo(rr.w); qv[ks][7] = bfhi(rr.w);
#pragma unroll
                for (int j = 0; j < 8; ++j) ss += qv[ks][j] * qv[ks][j]; }
            ss += __shfl_xor(ss, 32);
            const float rstd = 1.0f / sqrtf(ss * (1.0f / HD) + EPS);
#pragma unroll
            for (int ks = 0; ks < 4; ++ks)
#pragma unroll
                for (int j = 0; j < 8; ++j) qv[ks][j] = qv[ks][j] * rstd * P_qn_g(F)[16 * ks + 8 * hh + j];
            const float* rp = P_ROPE(F) + (size_t)(b * SEQ + tq) * 16;
#pragma unroll
            for (int j = 0; j < 8; ++j) { const float mine = qv[0][j], other = __shfl_xor(mine, 32); const float cs = rp[j], sn = rp[8 + j];
                qv[0][j] = hh == 0 ? (mine * cs - other * sn) : (mine * cs + other * sn); }
#pragma unroll
            for (int ks = 0; ks < 4; ++ks) { v4u o; o.x = pk2(qv[ks][0] * 0.125f, qv[ks][1] * 0.125f); o.y = pk2(qv[ks][2] * 0.125f, qv[ks][3] * 0.125f);
                o.z = pk2(qv[ks][4] * 0.125f, qv[ks][5] * 0.125f); o.w = pk2(qv[ks][6] * 0.125f, qv[ks][7] * 0.125f); qf[ks] = __builtin_bit_cast(bf16x8, o); }
        }
        f32x16 s[5];
#pragma unroll
        for (int kj = 0; kj < 5; ++kj) {
            f32x16 acc;
#pragma unroll
            for (int i = 0; i < 16; ++i) acc[i] = 0.f;
            const LAS bf16* kp = Ks + (32 * (qi + kj) + r) * KS_STRIDE + 8 * hh;
#pragma unroll
            for (int ks = 0; ks < 4; ++ks) { const bf16x8 kf = *(const LAS bf16x8*)(kp + 16 * ks); acc = MFMA32(kf, qf[ks], acc); }
            s[kj] = acc;
        }
        float mx = sink;
#pragma unroll
        for (int kj = 0; kj < 5; ++kj)
#pragma unroll
            for (int i = 0; i < 16; ++i) { const int kt = (i & 3) + 8 * (i >> 2) + 4 * hh; const int kbi = 32 * (qi + kj) + kt;
                bool valid = (n * 128 + kbi - 128) >= 0;
                if (kj == 0) valid = valid && (kt > r);
                if (kj == 4) valid = valid && (kt <= r);
                s[kj][i] = valid ? s[kj][i] : -INFINITY; mx = fmaxf(mx, s[kj][i]); }
        mx = fmaxf(mx, __shfl_xor(mx, 32));
        float l = 0.f;
#pragma unroll
        for (int kj = 0; kj < 5; ++kj)
#pragma unroll
            for (int i = 0; i < 16; ++i) { const float p = __expf(s[kj][i] - mx); s[kj][i] = p; l += p; }
        l += __shfl_xor(l, 32);
        l += __expf(sink - mx);
        const float inv = 1.0f / l;
        f32x16 o0, o1;
#pragma unroll
        for (int i = 0; i < 16; ++i) { o0[i] = 0.f; o1[i] = 0.f; }
#pragma unroll
        for (int kj = 0; kj < 5; ++kj)
#pragma unroll
            for (int st = 0; st < 2; ++st) {
                v4u pa; pa.x = pk2(s[kj][8 * st + 0] * inv, s[kj][8 * st + 1] * inv); pa.y = pk2(s[kj][8 * st + 2] * inv, s[kj][8 * st + 3] * inv);
                pa.z = pk2(s[kj][8 * st + 4] * inv, s[kj][8 * st + 5] * inv); pa.w = pk2(s[kj][8 * st + 6] * inv, s[kj][8 * st + 7] * inv);
                const bf16x8 pf = __builtin_bit_cast(bf16x8, pa);
                const int kb0 = 32 * (qi + kj) + 16 * st + 4 * hh;
                const LAS bf16* v0p = VT + r * VT_STRIDE + kb0; const LAS bf16* v1p = VT + (32 + r) * VT_STRIDE + kb0;
                const v2u a0 = *(const LAS v2u*)v0p, a1 = *(const LAS v2u*)(v0p + 8), b0 = *(const LAS v2u*)v1p, b1 = *(const LAS v2u*)(v1p + 8);
                const v4u vb0 = {a0.x, a0.y, a1.x, a1.y}, vb1 = {b0.x, b0.y, b1.x, b1.y};
                o0 = MFMA32(pf, __builtin_bit_cast(bf16x8, vb0), o0);
                o1 = MFMA32(pf, __builtin_bit_cast(bf16x8, vb1), o1);
            }
#pragma unroll
        for (int i = 0; i < 16; ++i) { const int qr = (i & 3) + 8 * (i >> 2) + 4 * hh; const int tok = n * 128 + 32 * qi + qr;
            bf16* op = P_XH(F) + (size_t)(b * SEQ + tok) * D + LRU_W + hq * HD + r;
            op[0] = (bf16)f2bf(o0[i]); op[32] = (bf16)f2bf(o1[i]); }
    }
    __syncthreads();
}

constexpr int LCH = 64;
constexpr int XC_STRIDE = 136;
constexpr int LRU_XCB_OFF = 0, LRU_XCF_OFF = LCH * XC_STRIDE * 2  , LRU_A_OFF = LRU_XCF_OFF + LCH * 128 * 4, LRU_B_OFF = LRU_A_OFF + LCH * 128 * 4, LRU_SE_OFF = LRU_B_OFF + LCH * 128 * 4;
static_assert(LRU_SE_OFF + 2 * 4 * 128 * 4 <= RING_BYTES, "LRU LDS");
__device__ __forceinline__ void lru_block(Frame& F) {
    LAS bf16* XCb = (LAS bf16*)(F.lds + LRU_XCB_OFF);
    LAS float* XCF = (LAS float*)(F.lds + LRU_XCF_OFF);
    LAS float* As = (LAS float*)(F.lds + LRU_A_OFF);
    LAS float* Bs = (LAS float*)(F.lds + LRU_B_OFF);
    LAS float* SEh = (LAS float*)(F.lds + LRU_SE_OFF);
    LAS float* SEp = SEh + 4 * 128;
    const int tid = F.tid, lane = F.lane;
    const int hd = F.bid & 7, li = F.bid >> 3, step = F.G >> 3;
    constexpr int NQ = BATCH * (SEQ / LCH);
    if (li >= NQ) return;
    const int cg = tid & 15, tp = tid >> 4, colc = hd * LRU_BLK + 8 * cg;
    float cw[4][8], cbv[8];
#pragma unroll
    for (int k = 0; k < 4; ++k) { const f32x4 a = *(const f32x4*)(P_conv_w(F) + k * LRU_W + colc), b2 = *(const f32x4*)(P_conv_w(F) + k * LRU_W + colc + 4);
        cw[k][0] = a.x; cw[k][1] = a.y; cw[k][2] = a.z; cw[k][3] = a.w; cw[k][4] = b2.x; cw[k][5] = b2.y; cw[k][6] = b2.z; cw[k][7] = b2.w; }
    { const f32x4 a = *(const f32x4*)(P_conv_b(F) + colc), b2 = *(const f32x4*)(P_conv_b(F) + colc + 4);
      cbv[0] = a.x; cbv[1] = a.y; cbv[2] = a.z; cbv[3] = a.w; cbv[4] = b2.x; cbv[5] = b2.y; cbv[6] = b2.z; cbv[7] = b2.w; }
    const int fr = lane & 15, fq = lane >> 4, j = 16 * F.wave + fr, jc = hd * LRU_BLK + j;
    bf16x8 wa[4], wx[4];
    { const bf16* wap = P_WGA(F) + (size_t)hd * 16384 + (size_t)j * 128 + 8 * fq; const bf16* wxp = P_WGX(F) + (size_t)hd * 16384 + (size_t)j * 128 + 8 * fq;
#pragma unroll
      for (int ks = 0; ks < 4; ++ks) { wa[ks] = *(const bf16x8*)(wap + 32 * ks); wx[ks] = *(const bf16x8*)(wxp + 32 * ks); } }
    const float ba = P_ga_b(F)[jc], bx = P_gx_b(F)[jc];
    const float sp8 = -8.0f * log1pf(__expf(-P_lam(F)[jc]));
    const int c = tid & 127, sub = tid >> 7, col = hd * LRU_BLK + c;
    const bf16* xbase = P_PROJ(F) + colc;
    bf16* HLp = P_HL(F); bf16* PAp = P_PA(F);
    v4u xr[5];
#define LRU_LOAD_X(q_) do { const int b_ = (q_) >> 6, ch_ = (q_) & 63; const int tr_ = ch_ * LCH + 2 * tp - 3; \
        _Pragma("unroll") for (int r_ = 0; r_ < 5; ++r_) { const int t_ = tr_ + r_; \
            xr[r_] = (t_ >= 0) ? *(const v4u*)(xbase + (size_t)(b_ * SEQ + t_) * MIX_IN) : (v4u){0u, 0u, 0u, 0u}; } } while (0)
    LRU_LOAD_X(li);
    for (int q = li; q < NQ; q += step) {
        const int b = q >> 6, ch = q & 63, t0 = ch * LCH;
        {
            float xv[5][8];
#pragma unroll
            for (int r = 0; r < 5; ++r) { xv[r][0] = bflo(xr[r].x); xv[r][1] = bfhi(xr[r].x); xv[r][2] = bflo(xr[r].y); xv[r][3] = bfhi(xr[r].y);
                xv[r][4] = bflo(xr[r].z); xv[r][5] = bfhi(xr[r].z); xv[r][6] = bflo(xr[r].w); xv[r][7] = bfhi(xr[r].w); }
            if (q + step < NQ) LRU_LOAD_X(q + step);
#pragma unroll
            for (int tk = 0; tk < 2; ++tk) { float xc[8];
#pragma unroll
                for (int e = 0; e < 8; ++e) xc[e] = cbv[e] + cw[0][e] * xv[tk][e] + cw[1][e] * xv[tk + 1][e] + cw[2][e] * xv[tk + 2][e] + cw[3][e] * xv[tk + 3][e];
                const int tl = 2 * tp + tk;
                v4u o; o.x = pk2(xc[0], xc[1]); o.y = pk2(xc[2], xc[3]); o.z = pk2(xc[4], xc[5]); o.w = pk2(xc[6], xc[7]);
                *(LAS v4u*)(XCb + tl * XC_STRIDE + 8 * cg) = o;
                *(LAS f32x4*)(XCF + tl * 128 + 8 * cg) = (f32x4){xc[0], xc[1], xc[2], xc[3]}; *(LAS f32x4*)(XCF + tl * 128 + 8 * cg + 4) = (f32x4){xc[4], xc[5], xc[6], xc[7]}; }
        }
        __syncthreads();
#pragma unroll
        for (int mt = 0; mt < 4; ++mt) {
            f32x4 ra = {0.f, 0.f, 0.f, 0.f}, rx = {0.f, 0.f, 0.f, 0.f};
            const LAS bf16* ap = XCb + (16 * mt + fr) * XC_STRIDE + 8 * fq;
#pragma unroll
            for (int ks = 0; ks < 4; ++ks) { const bf16x8 af = *(const LAS bf16x8*)(ap + 32 * ks); ra = MFMA16(af, wa[ks], ra); rx = MFMA16(af, wx[ks], rx); }
#pragma unroll
            for (int e = 0; e < 4; ++e) { const int tl = 16 * mt + 4 * fq + e;
                const float rg = sigmoidf_(ra[e] + ba), ig = sigmoidf_(rx[e] + bx);
                const float a = __expf(rg * sp8);
                const float mult = sqrtf(fmaxf(fmaf(-a, a, 1.0f), 0.f));
                As[tl * 128 + j] = a; Bs[tl * 128 + j] = mult * ig * XCF[tl * 128 + j]; }
        }
        __syncthreads();
        float hh[16], pp[16];
        {
            float h = 0.f, P = 1.f;
#pragma unroll
            for (int i = 0; i < 16; ++i) { const int tl = sub * 16 + i; const float a = As[tl * 128 + c], bq = Bs[tl * 128 + c];
                h = a * h + bq; P *= a; hh[i] = h; pp[i] = P; }
            SEh[sub * 128 + c] = h; SEp[sub * 128 + c] = P;
        }
        __syncthreads();
        {
            float carry = 0.f, pre = 1.f;
            for (int s2 = 0; s2 < sub; ++s2) { carry = SEh[s2 * 128 + c] + SEp[s2 * 128 + c] * carry; pre *= SEp[s2 * 128 + c]; }
            bf16* hl = HLp + (size_t)(b * SEQ + t0 + sub * 16) * LRU_W + col;
            bf16* pa = PAp + (size_t)(b * SEQ + t0 + sub * 16) * LRU_W + col;
#pragma unroll
            for (int i = 0; i < 16; ++i) { hl[(size_t)i * LRU_W] = (bf16)f2bf(hh[i] + pp[i] * carry); pa[(size_t)i * LRU_W] = (bf16)f2bf(pp[i] * pre); }
        }
    }
#undef LRU_LOAD_X
    __syncthreads();
}
constexpr int N_ATT_UNITS = BATCH * HKV * (SEQ / 128);
constexpr int N_LRU_UNITS = BATCH * LRU_HEADS * (SEQ / LCH);
__device__ __forceinline__ void p3_phase(Frame& F) {
    for (int u = F.bid; u < N_ATT_UNITS; u += F.G) attn_unit(F, u >> 6, (u >> 5) & 1, u & 31);
    lru_block(F);
}

__device__ __forceinline__ void p4_unit(Frame& F, int b, int ch) {
    LAS float* CAR = (LAS float*)F.lds;
    const int tid = F.tid, lane = F.lane;
    {
        f32x2 carry = {0.f, 0.f};
        const bf16* hlb = P_HL(F) + (size_t)(b * SEQ + LCH - 1) * LRU_W + 2 * tid; const bf16* pab = P_PA(F) + (size_t)(b * SEQ + LCH - 1) * LRU_W + 2 * tid;
        int c2 = 0;
        for (; c2 + 8 <= ch; c2 += 8) { unsigned hl[8], pa[8];
#pragma unroll
            for (int q = 0; q < 8; ++q) { hl[q] = *(const unsigned*)(hlb + (size_t)(c2 + q) * LCH * LRU_W); pa[q] = *(const unsigned*)(pab + (size_t)(c2 + q) * LCH * LRU_W); }
#pragma unroll
            for (int q = 0; q < 8; ++q) { carry.x = bflo(hl[q]) + bflo(pa[q]) * carry.x; carry.y = bfhi(hl[q]) + bfhi(pa[q]) * carry.y; } }
        for (; c2 < ch; ++c2) { const unsigned hl = *(const unsigned*)(hlb + (size_t)c2 * LCH * LRU_W), pa = *(const unsigned*)(pab + (size_t)c2 * LCH * LRU_W);
            carry.x = bflo(hl) + bflo(pa) * carry.x; carry.y = bfhi(hl) + bfhi(pa) * carry.y; }
        CAR[2 * tid] = carry.x; CAR[2 * tid + 1] = carry.y;
    }
    __syncthreads();
    const float* gl = P_on_lru_g(F); const float* ga = P_on_attn_g(F);
    for (int i = 0; i < 8; i += 2) {
        const size_t m0 = (size_t)b * SEQ + ch * LCH + F.wave * 8 + i;
        v2u hl[2][4], pa[2][4]; v2u yr[2][4], ar[2][4];
#pragma unroll
        for (int t = 0; t < 2; ++t)
#pragma unroll
            for (int j = 0; j < 4; ++j) { const int c = 4 * lane + 256 * j; const size_t m = m0 + t;
                hl[t][j] = *(const v2u*)(P_HL(F) + m * LRU_W + c); pa[t][j] = *(const v2u*)(P_PA(F) + m * LRU_W + c);
                yr[t][j] = *(const v2u*)(P_PROJ(F) + m * MIX_IN + C_Y + c); ar[t][j] = *(const v2u*)(P_XH(F) + m * D + LRU_W + c); }
        f32x4 vl[2][4], va[2][4]; float sl[2] = {0.f, 0.f}, sa[2] = {0.f, 0.f};
#pragma unroll
        for (int t = 0; t < 2; ++t)
#pragma unroll
            for (int j = 0; j < 4; ++j) { const int c = 4 * lane + 256 * j; const f32x4 car = *(const LAS f32x4*)(CAR + c);
                const f32x4 hlf = {bflo(hl[t][j].x), bfhi(hl[t][j].x), bflo(hl[t][j].y), bfhi(hl[t][j].y)}, paf = {bflo(pa[t][j].x), bfhi(pa[t][j].x), bflo(pa[t][j].y), bfhi(pa[t][j].y)};
                const f32x4 h = hlf + paf * car;
                f32x4 v; v.x = h.x * gelu_tanh(bflo(yr[t][j].x)); v.y = h.y * gelu_tanh(bfhi(yr[t][j].x)); v.z = h.z * gelu_tanh(bflo(yr[t][j].y)); v.w = h.w * gelu_tanh(bfhi(yr[t][j].y));
                vl[t][j] = v; sl[t] += (v.x * v.x + v.y * v.y) + (v.z * v.z + v.w * v.w);
                f32x4 a; a.x = bflo(ar[t][j].x); a.y = bfhi(ar[t][j].x); a.z = bflo(ar[t][j].y); a.w = bfhi(ar[t][j].y);
                va[t][j] = a; sa[t] += (a.x * a.x + a.y * a.y) + (a.z * a.z + a.w * a.w); }
#pragma unroll
        for (int o = 1; o < 64; o <<= 1) { sl[0] += __shfl_xor(sl[0], o); sl[1] += __shfl_xor(sl[1], o); sa[0] += __shfl_xor(sa[0], o); sa[1] += __shfl_xor(sa[1], o); }
#pragma unroll
        for (int t = 0; t < 2; ++t) { const float rl = 1.0f / sqrtf(sl[t] * (1.0f / LRU_W) + EPS), ra = 1.0f / sqrtf(sa[t] * (1.0f / LRU_W) + EPS); const size_t m = m0 + t;
#pragma unroll
            for (int j = 0; j < 4; ++j) { const int c = 4 * lane + 256 * j; const f32x4 g1v = *(const f32x4*)(gl + c), g2v = *(const f32x4*)(ga + c);
                const f32x4 y = vl[t][j] * rl * g1v, z = va[t][j] * ra * g2v;
                v2u o; o.x = pk2(y.x, y.y); o.y = pk2(y.z, y.w); *(v2u*)(P_XH(F) + m * D + c) = o;
                v2u p; p.x = pk2(z.x, z.y); p.y = pk2(z.z, z.w); *(v2u*)(P_XH(F) + m * D + LRU_W + c) = p; } }
    }
    __syncthreads();
}
__device__ __forceinline__ void p4_phase(Frame& F) {
    for (int u = F.bid; u < BATCH * (SEQ / LCH); u += F.G) p4_unit(F, u >> 6, u & 63);
}

__device__ __forceinline__ int f2key(float f) { const int b = __builtin_bit_cast(int, f); return b ^ ((b >> 31) & 0x7fffffff); }
__device__ __forceinline__ float key2f(int k) { const int b = k ^ ((k >> 31) & 0x7fffffff); return __builtin_bit_cast(float, b); }
__device__ __forceinline__ void ins16(int (&L)[16], int x) {
#pragma unroll
    for (int j = 0; j < 16; ++j) { const int hi = max(L[j], x); x = min(L[j], x); L[j] = hi; }
}
__device__ __forceinline__ void ce_desc(int& a, int& b) { const int hi = a > b ? a : b, lo = a > b ? b : a; a = hi; b = lo; }
__device__ __forceinline__ void sort16_desc(int (&a)[16]) {
#pragma unroll
    for (int k = 2; k <= 16; k <<= 1)
#pragma unroll
        for (int j = k >> 1; j > 0; j >>= 1)
#pragma unroll
            for (int i = 0; i < 16; ++i) { const int l = i ^ j; if (l > i) { if ((i & k) == 0) ce_desc(a[i], a[l]); else ce_desc(a[l], a[i]); } }
}
__device__ __forceinline__ void bitonic_merge16_desc(int (&a)[16]) {
#pragma unroll
    for (int j = 8; j > 0; j >>= 1)
#pragma unroll
        for (int i = 0; i < 16; ++i) { const int l = i ^ j; if (l > i) ce_desc(a[i], a[l]); }
}
__device__ __forceinline__ void merge_top16(int (&a)[16], const int (&b)[16]) {
#pragma unroll
    for (int i = 0; i < 16; ++i) a[i] = a[i] > b[15 - i] ? a[i] : b[15 - i];
    bitonic_merge16_desc(a);
}
constexpr int INT_LOWEST = (int)0x80000000;
__device__ __forceinline__ void p8_item(Frame& F, int tt, int hd, LAS int* lut  ) {
    const int lane = F.lane, r = lane & 31, hh = lane >> 5;
    const bf16* QP = P_PROJ(F);
    int V[2][16];
#pragma unroll
    for (int p = 0; p < 2; ++p) {
        bf16x8 qf[8];
        const char* qb = (const char*)(QP + (size_t)(32 * tt) * D + hd * 256 + p * 128);
        const unsigned qoff = (unsigned)(r * D + 8 * hh) * 2u;
#pragma unroll
        for (int ks = 0; ks < 8; ++ks) qf[ks] = *(const bf16x8*)(qb + qoff + 32 * ks);
        int L[16];
#pragma unroll
        for (int j = 0; j < 16; ++j) L[j] = INT_LOWEST;
        const char* skb = (const char*)(P_SK(F) + (size_t)((hd * 2 + p) * PKEYS) * PHALF);
        const unsigned skoff = (unsigned)(r * PHALF + 8 * hh) * 2u;
#pragma unroll 1
        for (int kt = 0; kt < 4; ++kt) {
            f32x16 acc;
#pragma unroll
            for (int i = 0; i < 16; ++i) acc[i] = 0.f;
            const char* skt = skb + (size_t)(32 * kt) * PHALF * 2;
#pragma unroll
            for (int ks = 0; ks < 8; ++ks) { const bf16x8 kf = *(const bf16x8*)(skt + skoff + 32 * ks); acc = MFMA32(kf, qf[ks], acc); }
            const int kbase = 32 * kt + 4 * hh;
            int T[16];
#pragma unroll
            for (int i = 0; i < 16; ++i) { const int kidx = (i & 3) + 8 * (i >> 2); T[i] = (f2key(acc[i]) & ~0x7f) | (kbase + kidx); }
            sort16_desc(T); merge_top16(L, T);
        }
        int O[16];
#pragma unroll
        for (int j = 0; j < 16; ++j) O[j] = __shfl_xor(L[j], 32);
        merge_top16(L, O);
#pragma unroll
        for (int j = 0; j < 16; ++j) V[p][j] = L[j];
    }
#pragma unroll
    for (int j = 0; j < 16; ++j) { lut[lane * 33 + j] = V[0][j] & 0x7f; lut[lane * 33 + 16 + j] = V[1][j] & 0x7f; }
    float v0[16], v1[16];
#pragma unroll
    for (int j = 0; j < 16; ++j) { v0[j] = key2f(V[0][j] & ~0x7f); v1[j] = key2f(V[1][j] & ~0x7f); }
    int C[16], G1[16], G2[16], G3[2];
    { int n = 0;
#pragma unroll
      for (int i = 0; i < 16; ++i)
#pragma unroll
        for (int j = 0; j < 16; ++j)
            if ((i + 1) * (j + 1) <= 16) { const int key = (f2key(v0[i] + v1[j]) & ~0xff) | (i * 16 + j);
                if (n < 16) C[n] = key; else if (n < 32) G1[n - 16] = key; else if (n < 48) G2[n - 32] = key; else G3[n - 48] = key;
                ++n; } }
    sort16_desc(C); sort16_desc(G1); sort16_desc(G2);
    merge_top16(C, G1); merge_top16(C, G2); ins16(C, G3[0]); ins16(C, G3[1]);
    float sv[16]; float den = 0.f;
    const float mx = key2f(C[0] & ~0xff);
#pragma unroll
    for (int e = 0; e < 16; ++e) { sv[e] = __expf(key2f(C[e] & ~0xff) - mx); den += sv[e]; }
    const float inv = 1.0f / den;
    LDS_WAIT(); asm volatile("" ::: "memory");
    int idx[16];
#pragma unroll
    for (int e = 0; e < 16; ++e) { const int pi = (C[e] >> 4) & 15, pj = C[e] & 15; idx[e] = lut[lane * 33 + pi] * PKEYS + lut[lane * 33 + 16 + pj]; }
    if (hh == 0) {
        unsigned short* ip = P_IDX(F) + (size_t)(32 * tt + r) * 128 + hd * 16; float* gp = P_GW(F) + (size_t)(32 * tt + r) * 128 + hd * 16;
#pragma unroll
        for (int q = 0; q < 2; ++q) *(v4u*)(ip + 8 * q) = (v4u){(unsigned)idx[8 * q] | ((unsigned)idx[8 * q + 1] << 16), (unsigned)idx[8 * q + 2] | ((unsigned)idx[8 * q + 3] << 16),
                                                              (unsigned)idx[8 * q + 4] | ((unsigned)idx[8 * q + 5] << 16), (unsigned)idx[8 * q + 6] | ((unsigned)idx[8 * q + 7] << 16)};
#pragma unroll
        for (int q = 0; q < 4; ++q) *(f32x4*)(gp + 4 * q) = (f32x4){sv[4 * q] * inv, sv[4 * q + 1] * inv, sv[4 * q + 2] * inv, sv[4 * q + 3] * inv};
    }
    LDS_WAIT(); asm volatile("" ::: "memory");
}
__device__ __forceinline__ void p8_phase(Frame& F) {
    LAS int* lut = (LAS int*)(F.lds + F.wave * (64 * 33 * 4));
    const int gw = F.bid * NWAVES + F.wave, NGW = F.G * NWAVES;
    for (int it = gw; it < (M / 32) * PH; it += NGW) p8_item(F, it >> 3, it & 7, lut);
}

template <int CTRL> __device__ __forceinline__ float dpp_f(float x) { return __builtin_bit_cast(float, __builtin_amdgcn_mov_dpp(__builtin_bit_cast(int, x), CTRL, 0xf, 0xf, true)); }
__device__ __forceinline__ float sum8(float v) {
    v += dpp_f<0xB1>(v);
    v += dpp_f<0x4E>(v);
    v += dpp_f<0x141>(v);
    return v;
}
__device__ __forceinline__ void dec16(const v4u r, float (&f)[16]) {
    const unsigned w4[4] = {r.x, r.y, r.z, r.w};
#pragma unroll
    for (int w = 0; w < 4; ++w) { const f32x2 lo = __builtin_amdgcn_cvt_pk_f32_fp8((int)w4[w], false), hi = __builtin_amdgcn_cvt_pk_f32_fp8((int)w4[w], true);
        f[4 * w] = lo.x; f[4 * w + 1] = lo.y; f[4 * w + 2] = hi.x; f[4 * w + 3] = hi.y; }
}
__device__ __forceinline__ void row_offsets(const v4u a, const v4u b, unsigned loff, unsigned (&off)[16]) {
    const unsigned w[8] = {a.x, a.y, a.z, a.w, b.x, b.y, b.z, b.w};
#pragma unroll
    for (int q = 0; q < 8; ++q) { off[2 * q] = ((w[q] & 0xffffu) << 11) + loff; off[2 * q + 1] = ((w[q] >> 16) << 11) + loff; }
}
#define ISSUE_ROWS(dst, TBL, ia, ib) do { unsigned off_[16]; row_offsets((ia), (ib), loff, off_); \
    _Pragma("unroll") for (int i_ = 0; i_ < 16; ++i_) dst[i_] = *(const v4u*)((TBL) + off_[i_]); } while (0)

__device__ __forceinline__ void p9u_compute(const v4u (&row)[16], const v4u h0, const v4u h1, int c8, unsigned* dst) {
    float h2[16];
    h2[0] = bflo(h0.x); h2[1] = bfhi(h0.x); h2[2] = bflo(h0.y); h2[3] = bfhi(h0.y); h2[4] = bflo(h0.z); h2[5] = bfhi(h0.z); h2[6] = bflo(h0.w); h2[7] = bfhi(h0.w);
    h2[8] = bflo(h1.x); h2[9] = bfhi(h1.x); h2[10] = bflo(h1.y); h2[11] = bfhi(h1.y); h2[12] = bflo(h1.z); h2[13] = bfhi(h1.z); h2[14] = bflo(h1.w); h2[15] = bfhi(h1.w);
    float res0 = 0.f, res1 = 0.f;
#pragma unroll
    for (int i = 0; i < 16; ++i) { float f[16]; dec16(row[i], f);
        float a0 = f[0] * h2[0], a1 = f[1] * h2[1], a2 = f[2] * h2[2], a3 = f[3] * h2[3];
#pragma unroll
        for (int e = 4; e < 16; e += 4) { a0 = fmaf(f[e], h2[e], a0); a1 = fmaf(f[e + 1], h2[e + 1], a1); a2 = fmaf(f[e + 2], h2[e + 2], a2); a3 = fmaf(f[e + 3], h2[e + 3], a3); }
        const float tot = sum8((a0 + a1) + (a2 + a3));
        if (i < 8) res0 = (c8 == (i & 7)) ? tot : res0; else res1 = (c8 == (i & 7)) ? tot : res1; }
    dst[0] = pk2(res0, res1);
}
__device__ __forceinline__ void p9u_item(Frame& F, int s, int tb) {
    const int lane = F.lane, gi = lane >> 3, c8 = lane & 7;
    const unsigned char* U8 = P_U(F);
    const unsigned loff = (unsigned)(128 * s + 16 * c8);
    const unsigned short* idxb = P_IDX(F) + (size_t)(64 * tb) * 128 + 8 * gi;
    const bf16* hb = P_XH(F) + (size_t)(64 * tb) * D + 128 * s + 16 * c8;
    unsigned* pb = P_PART(F) + ((size_t)s * M + 64 * tb) * 64 + lane;
#define LOAD_META_U(I0, I1, H0, H1, tt_) do { const int tn_ = (tt_) < 64 ? (tt_) : 63; const unsigned short* ip_ = idxb + (size_t)tn_ * 128; const bf16* hp_ = hb + (size_t)tn_ * D; \
        I0 = *(const v4u*)(ip_); I1 = *(const v4u*)(ip_ + 64); H0 = *(const v4u*)(hp_); H1 = *(const v4u*)(hp_ + 8); } while (0)
    v4u aI0, aI1, aH0, aH1, bI0, bI1, bH0, bH1, cI0, cI1, cH0, cH1, dI0, dI1, dH0, dH1;
    LOAD_META_U(aI0, aI1, aH0, aH1, 0); LOAD_META_U(bI0, bI1, bH0, bH1, 1);
    v4u rowA[16], rowB[16];
    ISSUE_ROWS(rowA, U8, aI0, aI1); ISSUE_ROWS(rowB, U8, bI0, bI1);
    LOAD_META_U(cI0, cI1, cH0, cH1, 2);
#pragma unroll 1
    for (int t = 0; t < 64; t += 2) {
        p9u_compute(rowA, aH0, aH1, c8, pb + (size_t)t * 64);
        ISSUE_ROWS(rowA, U8, cI0, cI1);
        LOAD_META_U(dI0, dI1, dH0, dH1, t + 3);
        p9u_compute(rowB, bH0, bH1, c8, pb + (size_t)(t + 1) * 64);
        ISSUE_ROWS(rowB, U8, dI0, dI1);
        aH0 = cH0; aH1 = cH1; bH0 = dH0; bH1 = dH1;
        LOAD_META_U(cI0, cI1, cH0, cH1, t + 4);
    }
#undef LOAD_META_U
}
__device__ __forceinline__ void p9v_compute(const v4u (&row)[16], const v4u w0, const v4u w1, int lane, const f32x2 x1, const f32x2 g2, float* dst) {
    const unsigned ww[8] = {w0.x, w0.y, w0.z, w0.w, w1.x, w1.y, w1.z, w1.w};
    float acc[16];
#pragma unroll
    for (int e = 0; e < 16; ++e) acc[e] = 0.f;
#pragma unroll
    for (int i = 0; i < 16; ++i) { float f[16]; dec16(row[i], f); const float wv = (i & 1) ? bfhi(ww[i >> 1]) : bflo(ww[i >> 1]);
#pragma unroll
        for (int e = 0; e < 16; ++e) acc[e] = fmaf(f[e], wv, acc[e]); }
    float r8[8], r4[4], r2[2];
    { const bool up = (lane & 32) != 0;
#pragma unroll
      for (int e = 0; e < 8; ++e) { const float send = up ? acc[e] : acc[8 + e], keep = up ? acc[8 + e] : acc[e]; r8[e] = keep + __shfl_xor(send, 32); } }
    { const bool up = (lane & 16) != 0;
#pragma unroll
      for (int e = 0; e < 4; ++e) { const float send = up ? r8[e] : r8[4 + e], keep = up ? r8[4 + e] : r8[e]; r4[e] = keep + __shfl_xor(send, 16); } }
    { const bool up = (lane & 8) != 0;
#pragma unroll
      for (int e = 0; e < 2; ++e) { const float send = up ? r4[e] : r4[2 + e], keep = up ? r4[2 + e] : r4[e]; r2[e] = keep + __shfl_xor(send, 8); } }
    f32x2 o; o.x = x1.x + g2.x * r2[0]; o.y = x1.y + g2.y * r2[1];
    *(f32x2*)dst = o;
}
__device__ __forceinline__ void p9v_item(Frame& F, int s, int tb) {
    const int lane = F.lane, gi = lane >> 3, c8 = lane & 7;
    const unsigned char* V8 = P_V(F);
    const unsigned loff = (unsigned)(128 * s + 16 * c8);
    const unsigned short* idxb = P_IDX(F) + (size_t)(64 * tb) * 128 + 8 * gi;
    const int b = (64 * tb) / SEQ;
    const int wcol = 128 * s + 16 * c8 + 2 * gi;
    const f32x2 g2 = *(const f32x2*)(P_ADA(F) + (size_t)b * ADA_W + 5 * D + wcol);
    float* ob = P_out(F) + (size_t)(64 * tb) * D + wcol;
    const bf16* xb = P_X1B(F) + (size_t)(64 * tb) * D + wcol;
    LAS unsigned char* Wl = F.lds + F.wave * 16384;
    { const v4u* wsrc = (const v4u*)(P_W(F) + (size_t)(64 * tb) * 128); v4u tmp[16];
#pragma unroll
      for (int q = 0; q < 16; ++q) tmp[q] = wsrc[q * 64 + lane];
#pragma unroll
      for (int q = 0; q < 16; ++q) *(LAS v4u*)(Wl + (q * 64 + lane) * 16) = tmp[q]; }
    const LAS unsigned char* wl = Wl + 16 * gi;
#define LOAD_IDX(I0, I1, tt_) do { const int tn_ = (tt_) < 64 ? (tt_) : 63; const unsigned short* ip_ = idxb + (size_t)tn_ * 128; I0 = *(const v4u*)(ip_); I1 = *(const v4u*)(ip_ + 64); } while (0)
#define V_COMPUTE(ROW, tt_) do { const unsigned x1r_ = *(const unsigned*)(xb + (size_t)(tt_) * D); const f32x2 x1_ = {bflo(x1r_), bfhi(x1r_)}; const v4u w0_ = *(const LAS v4u*)(wl + (tt_) * 256), w1_ = *(const LAS v4u*)(wl + (tt_) * 256 + 128); \
        p9v_compute(ROW, w0_, w1_, lane, x1_, g2, ob + (size_t)(tt_) * D); } while (0)
    v4u aI0, aI1, bI0, bI1, cI0, cI1, dI0, dI1;
    LOAD_IDX(aI0, aI1, 0); LOAD_IDX(bI0, bI1, 1);
    v4u rowA[16], rowB[16];
    ISSUE_ROWS(rowA, V8, aI0, aI1); ISSUE_ROWS(rowB, V8, bI0, bI1);
    LOAD_IDX(cI0, cI1, 2);
#pragma unroll 1
    for (int t = 0; t < 64; t += 2) {
        V_COMPUTE(rowA, t);
        ISSUE_ROWS(rowA, V8, cI0, cI1);
        LOAD_IDX(dI0, dI1, t + 3);
        V_COMPUTE(rowB, t + 1);
        ISSUE_ROWS(rowB, V8, dI0, dI1);
        LOAD_IDX(cI0, cI1, t + 4);
    }
#undef LOAD_IDX
#undef V_COMPUTE
}
__device__ __forceinline__ void p9u_phase(Frame& F) {
    const int x = F.bid & 7, rank = F.bid >> 3, nr = F.G >> 3;
    for (int h = 0; h < 2; ++h)
        for (int tb = rank * NWAVES + F.wave; tb < M / 64; tb += nr * NWAVES) p9u_item(F, 2 * x + h, tb);
}
__device__ __forceinline__ void p9v_phase(Frame& F) {
    const int x = F.bid & 7, rank = F.bid >> 3, nr = F.G >> 3;
    for (int h = 0; h < 2; ++h)
        for (int tb = rank * NWAVES + F.wave; tb < M / 64; tb += nr * NWAVES) p9v_item(F, 2 * x + h, tb);
}
__device__ __forceinline__ void p9w_phase(Frame& F) {
    const unsigned* part = P_PART(F); const unsigned short* idxp = P_IDX(F); const float* gwp = P_GW(F); const float* usc = P_USC(F); const float* vsc = P_VSC(F); bf16* wp = P_W(F);
    for (int it = F.bid * 512 + F.tid; it < M * 64; it += F.G * 512) {
        float a0 = 0.f, a1 = 0.f;
#pragma unroll
        for (int s = 0; s < 16; ++s) { const unsigned w = part[(size_t)s * M * 64 + it]; a0 += bflo(w); a1 += bfhi(w); }
        const int m = it >> 6, L = it & 63; const size_t p0 = (size_t)m * 128 + L, p1 = p0 + 64;
        const int i0 = idxp[p0], i1 = idxp[p1];
        wp[p0] = (bf16)f2bf(gwp[p0] * gelu_tanh(a0 * usc[i0]) * vsc[i0]);
        wp[p1] = (bf16)f2bf(gwp[p1] * gelu_tanh(a1 * usc[i1]) * vsc[i1]);
    }
}

struct Args { const void* in[25]; float* out; unsigned char* ws; int ph_lo, ph_hi; };
__global__ void __launch_bounds__(NWAVES * 64, 2) hymba_fwd(Args args) {
    extern __shared__ __attribute__((aligned(16))) unsigned char lds_raw[];
    Frame F;
    F.lds = (LAS unsigned char*)lds_raw;
    F.tid = threadIdx.x; F.lane = F.tid & 63; F.wave = __builtin_amdgcn_readfirstlane(F.tid >> 6);
    F.G = gridDim.x; F.bid = blockIdx.x;
    F.ka = (kaptr_t)__builtin_amdgcn_kernarg_segment_ptr();
    static_assert(sizeof(Args) == 224, "kernarg byte offsets used by ka_ptr");
    for (int u = F.tid; u < (LDS_BYTES - LDSCTL_OFF) / 4; u += NWAVES * 64) ((LAS unsigned*)(F.lds + LDSCTL_OFF))[u] = 0u;
    __syncthreads();
    volatile LAS unsigned* MISC = (volatile LAS unsigned*)(F.lds + MISC_OFF);
    XcdBarrier bar; bar.bar = (unsigned*)(P_ws(F) + WS_CTL) + CW_BAR; bar.x = 0; bar.st = nullptr;
    const int lo = args.ph_lo, hi = args.ph_hi;
    if (hi - lo > 1) bar = xcd_barrier_post((unsigned*)(P_ws(F) + WS_CTL) + CW_BAR, MISC + 8);
#define IN(k) (lo <= (k) && (k) < hi)
#ifndef PROBE_STAMP
#define PROBE_STAMP -1
#define PROBE_DIV 5.0f
#endif
#define STAMP(k) do { if (PROBE_STAMP >= 0 && F.bid == 0 && F.tid == 0) ((unsigned long long*)(P_ws(F) + WS_CTL + 64))[(k)] = __builtin_amdgcn_s_memrealtime(); } while (0)
#define SEAM(k) do { if (IN(k) && IN((k) + 1)) xcd_barrier(bar); STAMP((k) + 1); } while (0)
    STAMP(0);

#ifndef PROBE_MASK
#define PROBE_MASK 0
#endif
#define REP(k) for (int rep_ = 0; rep_ < (((PROBE_MASK >> (k)) & 1) ? 2 : 1); ++rep_)
#define REPSYNC(k) do { if (((PROBE_MASK >> (k)) & 1) && rep_ == 0) xcd_barrier(bar); } while (0)
    if (IN(0)) { REP(0) { p0_prologue(F); REPSYNC(0); } } SEAM(0);
    if (IN(1)) { REP(1) { p1_phase(F); REPSYNC(1); } } SEAM(1);
    if (IN(2)) REP(2) {
        pg8::Gemm g{P_XH(F), P_WIN(F), M, MIX_IN, D}; pg8::StaticOrder S; S.init(M, MIX_IN, F.G, F.bid);
        pg8::EpiStoreBf16 E{P_PROJ(F), MIX_IN};
        pg8::gemm_phase<pg8::EpiStoreBf16, pg8::StaticOrder, true, true>(F.lds, g, S, E); REPSYNC(2);
        { const int nwg = (M / 256) * (MIX_IN / 256), busy = nwg % F.G;
          if (busy > 0 && F.bid >= busy) quant_rows(F, QUANT_SPLIT, 2 * NEXP, (F.bid - busy) * NWAVES + F.wave, (F.G - busy) * NWAVES);
          else if (busy == 0) quant_rows(F, QUANT_SPLIT, 2 * NEXP, F.bid * NWAVES + F.wave, F.G * NWAVES); }
    } SEAM(2);
    if (IN(3)) { p3_phase(F); } SEAM(3);
    if (IN(4)) { p4_phase(F); } SEAM(4);
    if (IN(5)) REP(5) {
        pg8::Gemm g{P_XH(F), P_WOUT(F), M, D, D}; pg8::StaticOrder S; S.init(M, D, F.G, F.bid);
        pg8::EpiResid E{P_x(F), P_X1B(F), D, P_ADA(F) + 2 * D, ADA_W, SEQ};
        pg8::gemm_phase<pg8::EpiResid, pg8::StaticOrder, true, true>(F.lds, g, S, E); REPSYNC(5);
    } SEAM(5);
    if (IN(6)) { REP(6) { p6_phase(F); REPSYNC(6); } } SEAM(6);
    if (IN(7)) REP(7) {
        pg8::Gemm g{P_XH(F), P_WQ(F), M, D, D}; pg8::StaticOrder S; S.init(M, D, F.G, F.bid);
        pg8::EpiStoreBf16 E{P_PROJ(F), D};
        pg8::gemm_phase<pg8::EpiStoreBf16, pg8::StaticOrder, true, true>(F.lds, g, S, E); REPSYNC(7);
    } SEAM(7);
    if (IN(8)) { REP(8) { p8_phase(F); REPSYNC(8); } } SEAM(8);
    if (IN(9)) { p9u_phase(F); } SEAM(9);
    if (IN(10)) { p9w_phase(F); } SEAM(10);
    if (IN(11)) { p9v_phase(F); }
    if (PROBE_STAMP >= 0) {
        __syncthreads(); STAMP(12); VM_WAIT(); __syncthreads();
        if (F.bid == 0 && F.tid == 0) { const unsigned long long* ts = (const unsigned long long*)(P_ws(F) + WS_CTL + 64);
            const float us = (float)(ts[PROBE_STAMP + 1] - ts[PROBE_STAMP]) * 0.01f; P_out(F)[0] += us * (1.0f / PROBE_DIV); }
    }
#undef IN
#undef SEAM
}

extern "C" void kernel_launch(void* const* d_in, const int* in_sizes, int n_in, void* d_out, int out_size, void* d_ws, size_t ws_size, hipStream_t stream) {
    static int grid = 0;
    if (grid == 0) {
        if (n_in != 25 || in_sizes[0] != M * D || out_size != M * D || ws_size < WS_END) {
            fprintf(stderr, "kernel_launch: built for 25 inputs, x/out of %d floats, >= %zu bytes of workspace; got n_in %d, in0 %d, out %d, ws %zu; nothing launched\n", M * D, (size_t)WS_END, n_in, n_in > 0 ? in_sizes[0] : -1, out_size, ws_size);
            grid = -1; return; }
        int dev = 0, cus = 0, per_cu = 0;
        if (hipGetDevice(&dev) != hipSuccess || hipDeviceGetAttribute(&cus, hipDeviceAttributeMultiprocessorCount, dev) != hipSuccess) { fprintf(stderr, "kernel_launch: device query failed\n"); grid = -1; return; }
        if (hipFuncSetAttribute((const void*)hymba_fwd, hipFuncAttributeMaxDynamicSharedMemorySize, LDS_BYTES) != hipSuccess) { fprintf(stderr, "kernel_launch: hipFuncSetAttribute failed\n"); grid = -1; return; }
        if (hipOccupancyMaxActiveBlocksPerMultiprocessor(&per_cu, (const void*)hymba_fwd, NWAVES * 64, LDS_BYTES) != hipSuccess || per_cu < 1) {
            fprintf(stderr, "kernel_launch: occupancy query reports %d workgroups per CU; need 1\n", per_cu); (void)hipGetLastError(); grid = -1; return; }
        grid = cus;
        if (grid % 8 != 0 || (M / 64) % (grid / 8 * NWAVES) != 0) { fprintf(stderr, "kernel_launch: grid %d not supported (needs a multiple of 8 dividing the token blocks)\n", grid); grid = -1; return; }
    }
    if (grid < 0) return;
    if (hipMemsetAsync((char*)d_ws + WS_CTL, 0, CTL_ZERO_BYTES, stream) != hipSuccess) { fprintf(stderr, "kernel_launch: memset failed\n"); return; }
    Args a{};
    for (int i = 0; i < 25; ++i) a.in[i] = d_in[i];
    a.out = (float*)d_out; a.ws = (unsigned char*)d_ws;
    if (N_LAUNCHES == 1) {
        a.ph_lo = 0; a.ph_hi = N_PHASES;
        void* kargs[] = {&a};
        const hipError_t le = hipLaunchCooperativeKernel((const void*)hymba_fwd, dim3(grid), dim3(NWAVES * 64), kargs, LDS_BYTES, stream);
        if (le != hipSuccess) fprintf(stderr, "kernel_launch: cooperative launch failed: %s (grid %d)\n", hipGetErrorName(le), grid);
    } else {
#ifndef PROBE_TWICE
#define PROBE_TWICE 0
#endif
        for (int li = 0; li < N_PHASES; ++li) { a.ph_lo = li; a.ph_hi = li + 1;
            if ((PROBE_TWICE >> li) & 1) hipLaunchKernelGGL(hymba_fwd, dim3(grid), dim3(NWAVES * 64), LDS_BYTES, stream, a);
            hipLaunchKernelGGL(hymba_fwd, dim3(grid), dim3(NWAVES * 64), LDS_BYTES, stream, a);
            const hipError_t le = hipPeekAtLastError();
            if (le != hipSuccess) { fprintf(stderr, "kernel_launch: launch %d failed: %s\n", li, hipGetErrorName(le)); break; } }
    }
}
```

```cpp
#include <hip/hip_runtime.h>
#include <cstdio>
#include <cstdint>
namespace pg8 {
#define PG8_LAS __attribute__((address_space(3)))
typedef unsigned short bf16_t;
typedef short bf16x8 __attribute__((ext_vector_type(8)));
typedef float f32x4 __attribute__((ext_vector_type(4)));
typedef unsigned u32x4 __attribute__((ext_vector_type(4)));
constexpr int BM = 256, BK = 64, HALF = 128, HTB = HALF * BK * 2  , STAGE_BYTES = 8 * HTB, NXCD = 8, WGM = 8;

__host__ __device__ __forceinline__ int lds_byte(int r, int c) { const int st = (r >> 4) * 2 + (c >> 5), rr = r & 15, cc = c & 31, ob = rr * 64 + cc * 2; return st * 1024 + (ob ^ (((ob >> 9) & 1) << 5)); }
__host__ __device__ __forceinline__ void stage_rc(int b, int& R, int& C) { const int st = b / 1024, sb = b % 1024, swz = sb ^ (((sb >> 9) & 1) << 5); R = (st >> 1) * 16 + swz / 64; C = (st & 1) * 32 + (swz % 64) / 2; }
__host__ __device__ __forceinline__ int perm32(int rho) { const int n = rho >> 4, i = rho & 15; return 8 * (i >> 2) + 4 * n + (i & 3); }

struct Unit { int pm, pn; };
struct Gemm { const bf16_t* A; const bf16_t* Bt; int M, N, K; };

struct StaticOrder {
    int nM, nN, nwg, G, c;
    __host__ __device__ void init(int M, int N, int G_, int c_) { nM = M / BM; nN = N / BM; nwg = nM * nN; G = G_; c = c_; }
    __host__ __device__ bool next(int i, Unit& u) const {
        const long L = (long)i * G + c; if (L >= nwg) return false;
        int wgid = (int)L; { const int q = nwg / NXCD, r = nwg % NXCD, xcd = wgid % NXCD, off = wgid / NXCD; wgid = (xcd < r ? xcd * (q + 1) : r * (q + 1) + (xcd - r) * q) + off; }
        const int nig = WGM * nN, gid = wgid / nig, fm = gid * WGM, gsz = (nM - fm) < WGM ? (nM - fm) : WGM;
        u.pm = fm + ((wgid % nig) % gsz); u.pn = (wgid % nig) / gsz; return true;
    }
    __device__ __forceinline__ void a_ready(const Unit&) const {}
    __device__ __forceinline__ void done(const Unit&) const {}
};

__device__ __forceinline__ unsigned cvt_pk_bf16(float lo, float hi) { unsigned r; asm volatile("v_cvt_pk_bf16_f32 %0, %1, %2" : "=v"(r) : "v"(lo), "v"(hi)); return r; }
struct EpiStoreBf16 {
    static constexpr bool PERM = true, AFTER_DRAIN = false;
    bf16_t* O; int ldc;
    __device__ __forceinline__ void operator()(const f32x4 (&acc)[2][2][4][2], const Unit& u, int wr, int wc, int fr, int fq) const {
        const int row0 = u.pm * BM + wr * 64 + fr; const int col0 = u.pn * BM + wc * 32 + 8 * fq;
#pragma unroll
        for (int ai = 0; ai < 2; ++ai)
#pragma unroll
            for (int m = 0; m < 4; ++m) { bf16_t* rowp = O + (size_t)(row0 + ai * HALF + m * 16) * ldc + col0;
#pragma unroll
                for (int bj = 0; bj < 2; ++bj) { const f32x4 v0 = acc[ai][bj][m][0], v1 = acc[ai][bj][m][1];
                    u32x4 w; w.x = cvt_pk_bf16(v0[0], v0[1]); w.y = cvt_pk_bf16(v0[2], v0[3]); w.z = cvt_pk_bf16(v1[0], v1[1]); w.w = cvt_pk_bf16(v1[2], v1[3]);
                    *(u32x4*)(rowp + bj * HALF) = w; } }
    }
};
struct EpiResid {
    static constexpr bool PERM = true, AFTER_DRAIN = false;
    const float* base; bf16_t* out; int ldc; const float* gate; int gstride; int rows_per_batch;
    __device__ __forceinline__ void operator()(const f32x4 (&acc)[2][2][4][2], const Unit& u, int wr, int wc, int fr, int fq) const {
        const int b = (u.pm * BM) / rows_per_batch; const float* g = gate + (size_t)b * gstride;
        const int col0 = u.pn * BM + wc * 32 + 8 * fq;
        f32x4 gv[2][2];
#pragma unroll
        for (int bj = 0; bj < 2; ++bj)
#pragma unroll
            for (int n = 0; n < 2; ++n) gv[bj][n] = *(const f32x4*)(g + col0 + bj * HALF + n * 4);
#pragma unroll
        for (int ai = 0; ai < 2; ++ai)
#pragma unroll
            for (int m = 0; m < 4; ++m) { const size_t off = (size_t)(u.pm * BM + ai * HALF + wr * 64 + m * 16 + fr) * ldc + col0;
#pragma unroll
                for (int bj = 0; bj < 2; ++bj) { const f32x4 b0 = *(const f32x4*)(base + off + bj * HALF), b1 = *(const f32x4*)(base + off + bj * HALF + 4);
                    const f32x4 v0 = b0 + gv[bj][0] * acc[ai][bj][m][0], v1 = b1 + gv[bj][1] * acc[ai][bj][m][1];
                    u32x4 w; w.x = cvt_pk_bf16(v0[0], v0[1]); w.y = cvt_pk_bf16(v0[2], v0[3]); w.z = cvt_pk_bf16(v1[0], v1[1]); w.w = cvt_pk_bf16(v1[2], v1[3]);
                    *(u32x4*)(out + off + bj * HALF) = w; }
                if (m & 1) asm volatile("" ::: "memory"); }
    }
};

template <class Epi, class Sched, bool ALIGN_EPI = false, bool SP2 = false>
__device__ __forceinline__ void gemm_phase(PG8_LAS unsigned char* lds, const Gemm g, const Sched& S, const Epi& E) {
    const int tid = threadIdx.x, wid = __builtin_amdgcn_readfirstlane(tid >> 6), lane = tid & 63, wr = wid >> 2, wc = wid & 3, fr = lane & 15, fq = lane >> 4;
    const int K = g.K, nt = K / BK;
    unsigned voffA[2], voffB[2];
#pragma unroll
    for (int i = 0; i < 2; ++i) { int R, C; stage_rc(tid * 16 + i * 8192, R, C); const int Rb = Epi::PERM ? ((R & ~31) + perm32(R & 31)) : R;
        voffA[i] = (unsigned)(R * K + C) * 2u; voffB[i] = (unsigned)(Rb * K + C) * 2u; }
    const size_t kstep = (size_t)(BK * 2);
    const size_t hstep = (size_t)HALF * K * 2;
    const size_t tstep = 2 * hstep;
    const unsigned ldsw = (unsigned)wid * 1024u;
    const int aoff = lds_byte(wr * 64 + fr, fq * 8), boff = lds_byte(wc * 32 + fr, fq * 8);
#define PG8_SA(b, h) (((b) * 2 + (h)) * HTB)
#define PG8_SB(b, h) ((4 + (b) * 2 + (h)) * HTB)
#define PG8_STAGE(bufoff, gbase, voff) do { _Pragma("unroll") for (int _i = 0; _i < 2; ++_i) \
        __builtin_amdgcn_global_load_lds((const unsigned*)((const char*)(gbase) + (voff)[_i]), (PG8_LAS unsigned*)(lds + (bufoff) + ldsw + _i * 8192), 16, 0, 0); } while (0)
#define PG8_LDA(dst, b, h) do { _Pragma("unroll") for (int m = 0; m < 4; ++m) _Pragma("unroll") for (int k = 0; k < 2; ++k) dst[m][k] = *(const PG8_LAS bf16x8*)(lds + PG8_SA(b, h) + aoff + m * 2048 + k * 1024); } while (0)
#define PG8_LDB(dst, b, h) do { _Pragma("unroll") for (int n = 0; n < 2; ++n) _Pragma("unroll") for (int k = 0; k < 2; ++k) dst[n][k] = *(const PG8_LAS bf16x8*)(lds + PG8_SB(b, h) + boff + n * 2048 + k * 1024); } while (0)
#define PG8_MMA(ai, bj, At, Bt) do { __builtin_amdgcn_s_setprio(1); _Pragma("unroll") for (int m = 0; m < 4; ++m) _Pragma("unroll") for (int n = 0; n < 2; ++n) _Pragma("unroll") for (int k = 0; k < 2; ++k) \
        acc[ai][bj][m][n] = __builtin_amdgcn_mfma_f32_16x16x32_bf16(Bt[n][k], At[m][k], acc[ai][bj][m][n], 0, 0, 0); __builtin_amdgcn_s_setprio(0); } while (0)
#define PG8_WAIT_V(n) asm volatile("s_waitcnt vmcnt(" #n ")" ::: "memory")
#define PG8_WAIT_L(n) asm volatile("s_waitcnt lgkmcnt(" #n ")" ::: "memory")
#define PG8_BAR __builtin_amdgcn_s_barrier()
#define PG8_SCHED __builtin_amdgcn_sched_barrier(0)
    Unit cur, nxt; int ui = 0;
    if (!S.next(0, cur)) return;
    f32x4 acc[2][2][4][2];
#pragma unroll
    for (int a = 0; a < 2; ++a)
#pragma unroll
        for (int b = 0; b < 2; ++b)
#pragma unroll
            for (int m = 0; m < 4; ++m)
#pragma unroll
                for (int n = 0; n < 2; ++n) acc[a][b][m][n] = (f32x4){0.f, 0.f, 0.f, 0.f};
    bf16x8 At[4][2], B0[2][2], B1[2][2];
    const char* cA = (const char*)g.A + (size_t)cur.pm * tstep; const char* cB = (const char*)g.Bt + (size_t)cur.pn * tstep;
    S.a_ready(cur);
    if constexpr (SP2) {
        PG8_STAGE(PG8_SB(0, 0), cB, voffB); PG8_STAGE(PG8_SB(0, 1), cB + hstep, voffB); PG8_STAGE(PG8_SA(0, 0), cA, voffA); PG8_STAGE(PG8_SA(0, 1), cA + hstep, voffA);
        if (wr == 1) PG8_BAR;
        PG8_WAIT_V(2); PG8_BAR;
        PG8_STAGE(PG8_SB(1, 0), cB + kstep, voffB); PG8_STAGE(PG8_SA(1, 0), cA + kstep, voffA); PG8_STAGE(PG8_SB(1, 1), cB + hstep + kstep, voffB);
        PG8_WAIT_V(6); PG8_BAR;
    } else {
        PG8_STAGE(PG8_SB(0, 0), cB, voffB); PG8_STAGE(PG8_SA(0, 0), cA, voffA); PG8_STAGE(PG8_SB(0, 1), cB + hstep, voffB); PG8_STAGE(PG8_SA(0, 1), cA + hstep, voffA);
        if (wr == 1) PG8_BAR;
        PG8_WAIT_V(4); PG8_BAR;
        PG8_STAGE(PG8_SB(1, 0), cB + kstep, voffB); PG8_STAGE(PG8_SA(1, 0), cA + kstep, voffA); PG8_STAGE(PG8_SB(1, 1), cB + hstep + kstep, voffB);
        PG8_WAIT_V(6); PG8_BAR;
    }
    for (;;) {
        const bool has_next = S.next(ui + 1, nxt);
        const char* nA = has_next ? (const char*)g.A + (size_t)nxt.pm * tstep : cA; const char* nB = has_next ? (const char*)g.Bt + (size_t)nxt.pn * tstep : cB;
        for (int t = 0; t < nt; t += 2) {
            const bool last = (t == nt - 2);
            const char* a1 = cA + (size_t)(t + 1) * kstep;
            const char* a2 = last ? nA : cA + (size_t)(t + 2) * kstep; const char* b2 = last ? nB : cB + (size_t)(t + 2) * kstep;
            const char* a3 = a2 + kstep; const char* b3 = b2 + kstep;
            if (last && has_next) S.a_ready(nxt);
            if constexpr (SP2) {
            PG8_LDB(B0, 0, 0); PG8_LDB(B1, 0, 1); PG8_SCHED; PG8_LDA(At, 0, 0); PG8_STAGE(PG8_SA(1, 1), a1 + hstep, voffA);
            PG8_WAIT_V(8); PG8_WAIT_L(0); PG8_BAR; PG8_MMA(0, 0, At, B0); PG8_MMA(0, 1, At, B1); PG8_BAR; PG8_SCHED;
            PG8_LDA(At, 0, 1); PG8_STAGE(PG8_SB(0, 0), b2, voffB); PG8_STAGE(PG8_SB(0, 1), b2 + hstep, voffB); PG8_STAGE(PG8_SA(0, 0), a2, voffA);
            PG8_WAIT_V(8); PG8_WAIT_L(0); PG8_BAR; PG8_MMA(1, 0, At, B0); PG8_MMA(1, 1, At, B1); PG8_BAR; PG8_SCHED;
            PG8_LDB(B0, 1, 0); PG8_LDB(B1, 1, 1); PG8_SCHED; PG8_LDA(At, 1, 0); PG8_STAGE(PG8_SA(0, 1), a2 + hstep, voffA);
            PG8_WAIT_V(8); PG8_WAIT_L(0); PG8_BAR; PG8_MMA(0, 0, At, B0); PG8_MMA(0, 1, At, B1); PG8_BAR; PG8_SCHED;
            PG8_LDA(At, 1, 1); PG8_STAGE(PG8_SB(1, 0), b3, voffB); PG8_STAGE(PG8_SB(1, 1), b3 + hstep, voffB); PG8_STAGE(PG8_SA(1, 0), a3, voffA);
            PG8_WAIT_V(8); PG8_WAIT_L(0); PG8_BAR; PG8_MMA(1, 0, At, B0); PG8_MMA(1, 1, At, B1); PG8_BAR; PG8_SCHED;
            } else {
            PG8_LDB(B0, 0, 0); PG8_SCHED; PG8_LDA(At, 0, 0); PG8_STAGE(PG8_SA(1, 1), a1 + hstep, voffA);
            PG8_WAIT_L(8); PG8_BAR; PG8_WAIT_L(0); PG8_MMA(0, 0, At, B0); PG8_BAR; PG8_SCHED;
            PG8_LDB(B1, 0, 1); PG8_STAGE(PG8_SB(0, 0), b2, voffB);
            PG8_BAR; PG8_WAIT_L(0); PG8_MMA(0, 1, At, B1); PG8_BAR;
            PG8_LDA(At, 0, 1); PG8_STAGE(PG8_SA(0, 0), a2, voffA);
            PG8_BAR; PG8_WAIT_L(0); PG8_MMA(1, 0, At, B0); PG8_BAR; PG8_SCHED;
            PG8_STAGE(PG8_SB(0, 1), b2 + hstep, voffB);
            PG8_WAIT_V(6); PG8_BAR; PG8_MMA(1, 1, At, B1); PG8_BAR;
            PG8_LDB(B0, 1, 0); PG8_SCHED; PG8_LDA(At, 1, 0); PG8_STAGE(PG8_SA(0, 1), a2 + hstep, voffA);
            PG8_WAIT_L(8); PG8_BAR; PG8_WAIT_L(0); PG8_MMA(0, 0, At, B0); PG8_BAR; PG8_SCHED;
            PG8_LDB(B1, 1, 1); PG8_STAGE(PG8_SB(1, 0), b3, voffB);
            PG8_BAR; PG8_WAIT_L(0); PG8_MMA(0, 1, At, B1); PG8_BAR;
            PG8_LDA(At, 1, 1); PG8_STAGE(PG8_SA(1, 0), a3, voffA);
            PG8_BAR; PG8_WAIT_L(0); PG8_MMA(1, 0, At, B0); PG8_BAR; PG8_SCHED;
            PG8_STAGE(PG8_SB(1, 1), b3 + hstep, voffB);
            PG8_WAIT_V(6); PG8_BAR; PG8_MMA(1, 1, At, B1); PG8_BAR;
            }
        }
        if constexpr (ALIGN_EPI) { if (wr == 0) PG8_BAR; }
        if constexpr (!Epi::AFTER_DRAIN) { E(acc, cur, wr, wc, fr, fq); S.done(cur); }
        if (!has_next) break;
#pragma unroll
        for (int a = 0; a < 2; ++a)
#pragma unroll
            for (int b = 0; b < 2; ++b)
#pragma unroll
                for (int m = 0; m < 4; ++m)
#pragma unroll
                    for (int n = 0; n < 2; ++n) acc[a][b][m][n] = (f32x4){0.f, 0.f, 0.f, 0.f};
        cur = nxt; cA = nA; cB = nB; ++ui;
        if constexpr (ALIGN_EPI) { if (wr == 1) PG8_BAR; }
    }
    PG8_WAIT_V(0);
    if constexpr (!ALIGN_EPI) { if (wr == 0) PG8_BAR; }
    PG8_BAR;
    if constexpr (Epi::AFTER_DRAIN) { E.fused(acc, cur, wr, wc, fr, fq, lds, wid, lane); S.done(cur); }
#undef PG8_SA
#undef PG8_SB
#undef PG8_STAGE
#undef PG8_LDA
#undef PG8_LDB
#undef PG8_MMA
#undef PG8_WAIT_V
#undef PG8_WAIT_L
#undef PG8_BAR
#undef PG8_SCHED
}
}

constexpr int NWAVES = 8;
#ifndef MK_N_LAUNCHES
#define MK_N_LAUNCHES 1
#endif
constexpr int N_PHASES = 12;
constexpr int N_LAUNCHES = MK_N_LAUNCHES;

constexpr int BATCH = 4, SEQ = 4096, D = 2048, M = BATCH * SEQ;
constexpr int LRU_W = 1024, LRU_HEADS = 8, LRU_BLK = 128;
constexpr int HD = 64, HQ = 16, HKV = 2, GRP = 8;
constexpr int MIX_IN = 3328;
constexpr int C_Y = 1024, C_Q = 2048, C_K = 3072, C_V = 3200;
constexpr int ADA_W = 6 * D;
constexpr int PH = 8, PKEYS = 128, PHALF = 128, PTOPK = 16, NEXP = 16384;
constexpr float EPS = 1e-6f;

constexpr size_t MiB = 1u << 20;
constexpr size_t WS_CTL = 0, CTL_ZERO_BYTES = 64 * 1024;
constexpr size_t WS_ADA = 1 * MiB;
constexpr size_t WS_ROPE = 2 * MiB;
constexpr size_t WS_WIN = 4 * MiB;
constexpr size_t WS_WOUT = 17 * MiB;
constexpr size_t WS_WQ = 25 * MiB;
constexpr size_t WS_WGA = 33 * MiB;
constexpr size_t WS_WGX = 33 * MiB + 256 * 1024;
constexpr size_t WS_SK = 33 * MiB + 512 * 1024;
constexpr size_t WS_IDX = 34 * MiB;
constexpr size_t WS_GW = 42 * MiB;
constexpr size_t WS_U = 50 * MiB;
constexpr size_t WS_V = 82 * MiB;
constexpr size_t WS_USC = 1 * MiB + 512 * 1024;
constexpr size_t WS_VSC = 1 * MiB + 768 * 1024;
constexpr size_t WS_X1B = 114 * MiB;
constexpr size_t WS_XH = 178 * MiB;
constexpr size_t WS_PROJ = 242 * MiB;
constexpr size_t WS_HL = 346 * MiB;
constexpr size_t WS_PA = 410 * MiB;
constexpr size_t WS_PART = WS_HL;
constexpr size_t WS_W = WS_PROJ + 64 * MiB;
constexpr size_t WS_END = 474 * MiB;
constexpr int CW_BAR = 4096;

constexpr int RING_BYTES = 131072;
constexpr int LDSCTL_OFF = RING_BYTES, MISC_OFF = LDSCTL_OFF + 320;
constexpr int LDS_BYTES = 147456;

#define GAS __attribute__((address_space(1)))
#define LAS __attribute__((address_space(3)))
typedef unsigned short bf16;
typedef unsigned v4u __attribute__((ext_vector_type(4)));
typedef unsigned v2u __attribute__((ext_vector_type(2)));
typedef float f32x4 __attribute__((ext_vector_type(4)));
typedef float f32x2 __attribute__((ext_vector_type(2)));
typedef float f32x16 __attribute__((ext_vector_type(16)));
typedef short bf16x8 __attribute__((ext_vector_type(8)));
typedef __bf16 bf16x2v __attribute__((ext_vector_type(2)));
#define LDS_WAIT() asm volatile("s_waitcnt lgkmcnt(0)" ::: "memory")
#define VM_WAIT() asm volatile("s_waitcnt vmcnt(0)" ::: "memory")
__device__ __forceinline__ unsigned f2bf(float f) { unsigned u = __builtin_bit_cast(unsigned, f); return (u + 0x7fffu + ((u >> 16) & 1u)) >> 16; }
__device__ __forceinline__ unsigned pk2(float lo, float hi) { return f2bf(lo) | (f2bf(hi) << 16); }
__device__ __forceinline__ float bflo(unsigned u) { return __builtin_bit_cast(float, u << 16); }
__device__ __forceinline__ float bfhi(unsigned u) { return __builtin_bit_cast(float, u & 0xffff0000u); }
__device__ __forceinline__ float bf1(bf16 h) { return __builtin_bit_cast(float, (unsigned)h << 16); }
__device__ __forceinline__ float dot2bf(unsigned a, unsigned b, float acc) { return __builtin_amdgcn_fdot2_f32_bf16(__builtin_bit_cast(bf16x2v, a), __builtin_bit_cast(bf16x2v, b), acc, false); }
__device__ __forceinline__ float sigmoidf_(float x) { return 1.0f / (1.0f + __expf(-x)); }
__device__ __forceinline__ float gelu_tanh(float x) {
    const float z = 1.5957691216057308f * (x + 0.044715f * x * x * x);
    return x / (1.0f + __expf(-z));
}
__device__ __forceinline__ float wave_sum(float v) {
#pragma unroll
    for (int o = 1; o < 64; o <<= 1) v += __shfl_xor(v, o);
    return v;
}

#define XB_TMO      128
#define XB_XCNT(j)  (256  + 64 * (j))
#define XB_XSUB(j)  (1280 + 64 * (j))
#define XB_XGEN(j)  (2304 + 64 * (j))
#define XB_TOP      3328
#define XB_TOPGEN   3392
#define XCD_BAR_WORDS 3456
#define XB_SPIN_CAP (1u << 18)
__device__ __forceinline__ unsigned xb_ld(unsigned* p)              { return __hip_atomic_load(p, __ATOMIC_RELAXED, __HIP_MEMORY_SCOPE_AGENT); }
__device__ __forceinline__ unsigned xb_add(unsigned* p, unsigned v) { return __hip_atomic_fetch_add(p, v, __ATOMIC_RELAXED, __HIP_MEMORY_SCOPE_AGENT); }
__device__ __forceinline__ unsigned xb_xcc_id() { return (unsigned)__builtin_amdgcn_s_getreg((3 << 11) | 20) & 0xFu; }
#define XB_SPIN(cond, bar) do { unsigned _sp = 0; while (cond) { __builtin_amdgcn_s_sleep(1); \
    if ((++_sp & 255u) == 0u) { if (xb_ld(&(bar)[XB_TMO])) break; if (_sp > XB_SPIN_CAP) { atomicAdd(&(bar)[XB_TMO], 1u); break; } } } } while (0)
struct XcdBarrier { unsigned* bar; unsigned x; volatile LAS unsigned* st; };
__device__ __forceinline__ XcdBarrier xcd_barrier_post(unsigned* bar, volatile LAS unsigned* st) {
    XcdBarrier b; b.bar = bar; b.x = xb_xcc_id(); b.st = st;
    if (threadIdx.x == 0) (void)xb_add(&bar[XB_XCNT(b.x)], 1u);
    return b;
}
__device__ __forceinline__ void xcd_barrier_complete(unsigned* bar, unsigned x, unsigned& nloc, unsigned& nx) {
    const unsigned G = gridDim.x * gridDim.y * gridDim.z;
    unsigned sum, cnt, mine, sp = 0u;
    for (;;) {
        sum = 0u; cnt = 0u; mine = 0u;
#pragma unroll
        for (unsigned j = 0; j < 16; ++j) { const unsigned c = xb_ld(&bar[XB_XCNT(j)]); sum += c; cnt += (c > 0u) ? 1u : 0u; mine = (j == x) ? c : mine; }
        if (sum == G) break;
        __builtin_amdgcn_s_sleep(1);
        if ((++sp & 255u) == 0u) { if (xb_ld(&bar[XB_TMO])) break; if (sp > XB_SPIN_CAP) { atomicAdd(&bar[XB_TMO], 1u); break; } }
    }
    nloc = mine > 0u ? mine : 1u; nx = cnt > 0u ? cnt : 1u;
}
__device__ __forceinline__ void xcd_barrier(const XcdBarrier& b) {
    asm volatile("s_waitcnt vmcnt(0)" ::: "memory");
    __syncthreads();
    if (threadIdx.x == 0) {
        unsigned* bar = b.bar;
        __builtin_amdgcn_s_waitcnt(0);
        unsigned nloc = b.st[0], nx = b.st[1];
        if (nloc == 0u) { xcd_barrier_complete(bar, b.x, nloc, nx); b.st[0] = nloc; b.st[1] = nx; }
        const unsigned old = xb_add(&bar[XB_XSUB(b.x)], 1u);
        const unsigned gen = old / nloc;
        if (old + 1u == (gen + 1u) * nloc) {
            __builtin_amdgcn_fence(__ATOMIC_RELEASE, "agent");
            asm volatile("s_waitcnt vmcnt(0)" ::: "memory");
            const unsigned og = xb_add(&bar[XB_TOP], 1u);
            const unsigned tg = og / nx;
            if (og + 1u == (tg + 1u) * nx) xb_add(&bar[XB_TOPGEN], 1u);
            else XB_SPIN(xb_ld(&bar[XB_TOPGEN]) == tg, bar);
            __builtin_amdgcn_fence(__ATOMIC_ACQUIRE, "agent");
            xb_add(&bar[XB_XGEN(b.x)], 1u);
            asm volatile("s_waitcnt vmcnt(0)" ::: "memory");
        } else {
            XB_SPIN(xb_ld(&bar[XB_XGEN(b.x)]) == gen, bar);
            __builtin_amdgcn_fence(__ATOMIC_ACQUIRE, "agent");
            asm volatile("s_waitcnt vmcnt(0)" ::: "memory");
        }
    }
    __syncthreads();
}

typedef const __attribute__((address_space(4))) unsigned char* kaptr_t;
struct Frame { LAS unsigned char* lds; int tid, lane, wave, G, bid; kaptr_t ka; };
template <class T> __device__ __forceinline__ T* ka_ptr(const Frame& F, int byte_off) { typedef T* tp; return *(const __attribute__((address_space(4))) tp*)(F.ka + byte_off); }
__device__ __forceinline__ const float* P_x(const Frame& F) { return ka_ptr<const float>(F, 0); }
__device__ __forceinline__ const float* P_c(const Frame& F) { return ka_ptr<const float>(F, 8); }
__device__ __forceinline__ const int* P_pos(const Frame& F) { return ka_ptr<const int>(F, 16); }
__device__ __forceinline__ const float* P_w_ada(const Frame& F) { return ka_ptr<const float>(F, 24); }
__device__ __forceinline__ const float* P_b_ada(const Frame& F) { return ka_ptr<const float>(F, 32); }
__device__ __forceinline__ const float* P_norm1_g(const Frame& F) { return ka_ptr<const float>(F, 40); }
__device__ __forceinline__ const float* P_w_in(const Frame& F) { return ka_ptr<const float>(F, 48); }
__device__ __forceinline__ const float* P_conv_w(const Frame& F) { return ka_ptr<const float>(F, 56); }
__device__ __forceinline__ const float* P_conv_b(const Frame& F) { return ka_ptr<const float>(F, 64); }
__device__ __forceinline__ const float* P_ga_w(const Frame& F) { return ka_ptr<const float>(F, 72); }
__device__ __forceinline__ const float* P_ga_b(const Frame& F) { return ka_ptr<const float>(F, 80); }
__device__ __forceinline__ const float* P_gx_w(const Frame& F) { return ka_ptr<const float>(F, 88); }
__device__ __forceinline__ const float* P_gx_b(const Frame& F) { return ka_ptr<const float>(F, 96); }
__device__ __forceinline__ const float* P_lam(const Frame& F) { return ka_ptr<const float>(F, 104); }
__device__ __forceinline__ const float* P_qn_g(const Frame& F) { return ka_ptr<const float>(F, 112); }
__device__ __forceinline__ const float* P_kn_g(const Frame& F) { return ka_ptr<const float>(F, 120); }
__device__ __forceinline__ const float* P_sinks(const Frame& F) { return ka_ptr<const float>(F, 128); }
__device__ __forceinline__ const float* P_on_lru_g(const Frame& F) { return ka_ptr<const float>(F, 136); }
__device__ __forceinline__ const float* P_on_attn_g(const Frame& F) { return ka_ptr<const float>(F, 144); }
__device__ __forceinline__ const float* P_w_out(const Frame& F) { return ka_ptr<const float>(F, 152); }
__device__ __forceinline__ const float* P_norm2_g(const Frame& F) { return ka_ptr<const float>(F, 160); }
__device__ __forceinline__ const float* P_w_pq(const Frame& F) { return ka_ptr<const float>(F, 168); }
__device__ __forceinline__ const float* P_sub_keys(const Frame& F) { return ka_ptr<const float>(F, 176); }
__device__ __forceinline__ const float* P_pu(const Frame& F) { return ka_ptr<const float>(F, 184); }
__device__ __forceinline__ const float* P_pv(const Frame& F) { return ka_ptr<const float>(F, 192); }
__device__ __forceinline__ float* P_out(const Frame& F) { return ka_ptr<float>(F, 200); }
__device__ __forceinline__ unsigned char* P_ws(const Frame& F) { return ka_ptr<unsigned char>(F, 208); }
__device__ __forceinline__ float* P_ADA(const Frame& F) { return (float*)(P_ws(F) + WS_ADA); }
__device__ __forceinline__ float* P_ROPE(const Frame& F) { return (float*)(P_ws(F) + WS_ROPE); }
__device__ __forceinline__ bf16* P_HL(const Frame& F) { return (bf16*)(P_ws(F) + WS_HL); }
__device__ __forceinline__ bf16* P_PA(const Frame& F) { return (bf16*)(P_ws(F) + WS_PA); }
__device__ __forceinline__ float* P_GW(const Frame& F) { return (float*)(P_ws(F) + WS_GW); }
__device__ __forceinline__ unsigned short* P_IDX(const Frame& F) { return (unsigned short*)(P_ws(F) + WS_IDX); }
__device__ __forceinline__ bf16* P_WIN(const Frame& F) { return (bf16*)(P_ws(F) + WS_WIN); }
__device__ __forceinline__ bf16* P_WOUT(const Frame& F) { return (bf16*)(P_ws(F) + WS_WOUT); }
__device__ __forceinline__ bf16* P_WQ(const Frame& F) { return (bf16*)(P_ws(F) + WS_WQ); }
__device__ __forceinline__ bf16* P_WGA(const Frame& F) { return (bf16*)(P_ws(F) + WS_WGA); }
__device__ __forceinline__ bf16* P_WGX(const Frame& F) { return (bf16*)(P_ws(F) + WS_WGX); }
__device__ __forceinline__ bf16* P_SK(const Frame& F) { return (bf16*)(P_ws(F) + WS_SK); }
__device__ __forceinline__ unsigned char* P_U(const Frame& F) { return (unsigned char*)(P_ws(F) + WS_U); }
__device__ __forceinline__ bf16* P_X1B(const Frame& F) { return (bf16*)(P_ws(F) + WS_X1B); }
__device__ __forceinline__ unsigned* P_PART(const Frame& F) { return (unsigned*)(P_ws(F) + WS_PART); }
__device__ __forceinline__ bf16* P_W(const Frame& F) { return (bf16*)(P_ws(F) + WS_W); }
__device__ __forceinline__ float* P_USC(const Frame& F) { return (float*)(P_ws(F) + WS_USC); }
__device__ __forceinline__ float* P_VSC(const Frame& F) { return (float*)(P_ws(F) + WS_VSC); }
__device__ __forceinline__ unsigned char* P_V(const Frame& F) { return (unsigned char*)(P_ws(F) + WS_V); }
__device__ __forceinline__ bf16* P_XH(const Frame& F) { return (bf16*)(P_ws(F) + WS_XH); }
__device__ __forceinline__ bf16* P_PROJ(const Frame& F) { return (bf16*)(P_ws(F) + WS_PROJ); }

__device__ __forceinline__ void p0_transpose_item(const float* W, int K, int N, bf16* WT, LAS float* scr, int item, int lane) {
    const int nblk = N / 32, kb = item / nblk, nb = item % nblk, k0 = 64 * kb, n0 = 32 * nb;
#pragma unroll 8
    for (int i = 0; i < 32; ++i) { const int kk = 2 * i + (lane >> 5); scr[kk * 33 + (lane & 31)] = W[(size_t)(k0 + kk) * N + n0 + (lane & 31)]; }
    LDS_WAIT(); asm volatile("" ::: "memory");
    const int c = lane & 7;
#pragma unroll
    for (int j = 0; j < 4; ++j) { const int n = (lane >> 3) + 8 * j; const LAS float* s = scr + (8 * c) * 33 + n;
        v4u o; o.x = pk2(s[0 * 33], s[1 * 33]); o.y = pk2(s[2 * 33], s[3 * 33]); o.z = pk2(s[4 * 33], s[5 * 33]); o.w = pk2(s[6 * 33], s[7 * 33]);
        *(v4u*)(WT + (size_t)(n0 + n) * K + k0 + 8 * c) = o; }
    LDS_WAIT(); asm volatile("" ::: "memory");
}
__device__ __forceinline__ void p0_convert(const float* src, bf16* dst, size_t n8, size_t gtid, size_t gthreads) {
    for (size_t i = gtid; i < n8; i += gthreads) {
        const f32x4 a = *(const f32x4*)(src + 8 * i), b = *(const f32x4*)(src + 8 * i + 4);
        v4u o; o.x = pk2(a.x, a.y); o.y = pk2(a.z, a.w); o.z = pk2(b.x, b.y); o.w = pk2(b.z, b.w);
        *(v4u*)(dst + 8 * i) = o;
    }
}
#ifndef QUANT_SPLIT
#define QUANT_SPLIT 14336
#endif
__device__ __forceinline__ void quant_rows(Frame& F, int r0, int r1, int w, int nw) {
    for (int rr = r0 + w; rr < r1; rr += nw) {
        const int tbl = rr >= NEXP, row = rr - tbl * NEXP;
        const float* srcp = (tbl ? P_pv(F) : P_pu(F)) + (size_t)row * D;
        unsigned char* dstp = (tbl ? P_V(F) : P_U(F)) + (size_t)row * D;
        f32x4 v[8]; float mx = 0.f;
#pragma unroll
        for (int j = 0; j < 8; ++j) { v[j] = *(const f32x4*)(srcp + 4 * F.lane + 256 * j);
            mx = fmaxf(fmaxf(mx, fmaxf(fabsf(v[j].x), fabsf(v[j].y))), fmaxf(fabsf(v[j].z), fabsf(v[j].w))); }
#pragma unroll
        for (int o = 1; o < 64; o <<= 1) mx = fmaxf(mx, __shfl_xor(mx, o));
        const float s = fmaxf(mx, 1e-30f) * (1.0f / 224.0f), inv = 1.0f / s;
#pragma unroll
        for (int j = 0; j < 8; ++j) { int t = __builtin_amdgcn_cvt_pk_fp8_f32(v[j].x * inv, v[j].y * inv, 0, false);
            t = __builtin_amdgcn_cvt_pk_fp8_f32(v[j].z * inv, v[j].w * inv, t, true);
            *(int*)(dstp + 4 * F.lane + 256 * j) = t; }
        if (F.lane == 0) (tbl ? P_VSC(F) : P_USC(F))[row] = s;
    }
}
__device__ __forceinline__ void p0_prologue(Frame& F) {
    {
        LAS float* sc = (LAS float*)F.lds;
        LAS float* red = sc + 4 * D;
        for (int i = F.tid; i < 4 * D; i += 512) { const float v = P_c(F)[i]; sc[i] = v / (1.0f + __expf(-v)); }
        __syncthreads();
        for (int cg = F.bid; cg < ADA_W / 64; cg += F.G) {
            const int n0 = cg * 64, k0 = F.wave * 256;
            const float* wp = P_w_ada(F) + (size_t)k0 * ADA_W + n0 + F.lane;
            float a0 = 0.f, a1 = 0.f, a2 = 0.f, a3 = 0.f;
#pragma unroll 16
            for (int k = 0; k < 256; ++k) { const float w = wp[(size_t)k * ADA_W]; const int kk = k0 + k;
                a0 += sc[kk] * w; a1 += sc[D + kk] * w; a2 += sc[2 * D + kk] * w; a3 += sc[3 * D + kk] * w; }
            red[(F.wave * 4 + 0) * 64 + F.lane] = a0; red[(F.wave * 4 + 1) * 64 + F.lane] = a1;
            red[(F.wave * 4 + 2) * 64 + F.lane] = a2; red[(F.wave * 4 + 3) * 64 + F.lane] = a3;
            __syncthreads();
            if (F.tid < 256) { const int b = F.tid >> 6, l = F.tid & 63; float s = 0.f;
#pragma unroll
                for (int w = 0; w < 8; ++w) s += red[(w * 4 + b) * 64 + l];
                P_ADA(F)[(size_t)b * ADA_W + n0 + l] = s + P_b_ada(F)[n0 + l]; }
            __syncthreads();
        }
        __syncthreads();
    }
    {
        LAS float* scr = (LAS float*)(F.lds + F.wave * 16384);
        const int gw = F.bid * NWAVES + F.wave, NGW = F.G * NWAVES;
        constexpr int I_IN = (D / 64) * (MIX_IN / 32), I_SQ = (D / 64) * (D / 32), I_G = (LRU_BLK / 64) * (LRU_BLK / 32);
        constexpr int NITEMS = I_IN + 2 * I_SQ + 16 * I_G;
        for (int it = gw; it < NITEMS; it += NGW) {
            int r = it;
            if (r < I_IN) { p0_transpose_item(P_w_in(F), D, MIX_IN, P_WIN(F), scr, r, F.lane); continue; } r -= I_IN;
            if (r < I_SQ) { p0_transpose_item(P_w_out(F), D, D, P_WOUT(F), scr, r, F.lane); continue; } r -= I_SQ;
            if (r < I_SQ) { p0_transpose_item(P_w_pq(F), D, D, P_WQ(F), scr, r, F.lane); continue; } r -= I_SQ;
            const int g = r / I_G, ri = r % I_G, hd = g & 7;
            if (g < 8) p0_transpose_item(P_ga_w(F) + (size_t)hd * 16384, LRU_BLK, LRU_BLK, P_WGA(F) + (size_t)hd * 16384, scr, ri, F.lane);
            else       p0_transpose_item(P_gx_w(F) + (size_t)hd * 16384, LRU_BLK, LRU_BLK, P_WGX(F) + (size_t)hd * 16384, scr, ri, F.lane);
        }
    }
    {
        const size_t gtid = (size_t)F.bid * 512 + F.tid, gth = (size_t)F.G * 512;
        p0_convert(P_sub_keys(F), P_SK(F), (size_t)PH * 2 * PKEYS * PHALF / 8, gtid, gth);
    }
    quant_rows(F, 0, QUANT_SPLIT, F.bid * NWAVES + F.wave, F.G * NWAVES);
}

template <bool BF16IN> __device__ __forceinline__ void modnorm_rows4(const void* xin, const float* gain, const float* shift, const float* scale, bf16* orow, int lane) {
    f32x4 v[4][8]; float s[4];
#pragma unroll
    for (int r = 0; r < 4; ++r) { s[r] = 0.f;
#pragma unroll
        for (int j = 0; j < 8; ++j) {
            if (BF16IN) { const v2u q = *(const v2u*)((const bf16*)xin + (size_t)r * D + 4 * lane + 256 * j); v[r][j] = (f32x4){bflo(q.x), bfhi(q.x), bflo(q.y), bfhi(q.y)}; }
            else v[r][j] = *(const f32x4*)((const float*)xin + (size_t)r * D + 4 * lane + 256 * j); } }
#pragma unroll
    for (int r = 0; r < 4; ++r)
#pragma unroll
        for (int j = 0; j < 8; ++j) s[r] += (v[r][j].x * v[r][j].x + v[r][j].y * v[r][j].y) + (v[r][j].z * v[r][j].z + v[r][j].w * v[r][j].w);
#pragma unroll
    for (int o = 1; o < 64; o <<= 1) {
#pragma unroll
        for (int r = 0; r < 4; ++r) s[r] += __shfl_xor(s[r], o); }
    float rstd[4];
#pragma unroll
    for (int r = 0; r < 4; ++r) rstd[r] = 1.0f / sqrtf(s[r] * (1.0f / D) + EPS);
#pragma unroll
    for (int j = 0; j < 8; ++j) {
        const int c = 4 * lane + 256 * j;
        const f32x4 g = *(const f32x4*)(gain + c), sh = *(const f32x4*)(shift + c), sc = *(const f32x4*)(scale + c);
        const f32x4 gm = g * (sc + 1.0f);
#pragma unroll
        for (int r = 0; r < 4; ++r) { const f32x4 y = (v[r][j] * rstd[r]) * gm + sh;
            v2u o; o.x = pk2(y.x, y.y); o.y = pk2(y.z, y.w);
            *(v2u*)(orow + (size_t)r * D + c) = o; }
    }
}
__device__ __forceinline__ void p1_phase(Frame& F) {
    const int gw = F.bid * NWAVES + F.wave, NGW = F.G * NWAVES;
    for (int m = 4 * gw; m < M; m += 4 * NGW) { const int b = m / SEQ; const float* ada = P_ADA(F) + (size_t)b * ADA_W;
        modnorm_rows4<false>(P_x(F) + (size_t)m * D, P_norm1_g(F), ada, ada + D, P_XH(F) + (size_t)m * D, F.lane); }
    const float invf[8] = {1.0f, 1.9392274e-01f, 3.7606031e-02f, 7.2926646e-03f, 1.4142136e-03f, 2.7424819e-04f, 5.3182961e-05f, 1.0313386e-05f};
    for (int i = F.bid * 512 + F.tid; i < M * 8; i += F.G * 512) { const int m = i >> 3, k = i & 7;
        float f = invf[0];
#pragma unroll
        for (int q = 1; q < 8; ++q) f = (k == q) ? invf[q] : f;
        const float ang = (float)P_pos(F)[m] * f; float sn, cs; sincosf(ang, &sn, &cs);
        P_ROPE(F)[(size_t)m * 16 + k] = cs; P_ROPE(F)[(size_t)m * 16 + 8 + k] = sn; }
}
__device__ __forceinline__ void p6_phase(Frame& F) {
    const int gw = F.bid * NWAVES + F.wave, NGW = F.G * NWAVES;
    for (int m = 4 * gw; m < M; m += 4 * NGW) { const int b = m / SEQ; const float* ada = P_ADA(F) + (size_t)b * ADA_W;
        modnorm_rows4<true>(P_X1B(F) + (size_t)m * D, P_norm2_g(F), ada + 3 * D, ada + 4 * D, P_XH(F) + (size_t)m * D, F.lane); }
}

#define MFMA32(a, b, c) __builtin_amdgcn_mfma_f32_32x32x16_bf16((a), (b), (c), 0, 0, 0)
#define MFMA16(a, b, c) __builtin_amdgcn_mfma_f32_16x16x32_bf16((a), (b), (c), 0, 0, 0)
constexpr int KS_STRIDE = 72;
constexpr int VT_STRIDE = 264;
constexpr int ATT_KS_OFF = 0, ATT_VT_OFF = 256 * KS_STRIDE * 2;
static_assert(ATT_VT_OFF + 64 * VT_STRIDE * 2 <= RING_BYTES, "attention LDS");

__device__ __forceinline__ void attn_unit(Frame& F, int b, int g, int n) {
    LAS bf16* Ks = (LAS bf16*)(F.lds + ATT_KS_OFF);
    LAS bf16* VT = (LAS bf16*)(F.lds + ATT_VT_OFF);
    const int tid = F.tid, lane = F.lane;
    {
        const int kb = tid >> 1, hf = tid & 1; const int t = n * 128 - 128 + kb;
        float kv[32]; v4u vraw[4];
        if (t >= 0) {
            const bf16* kp = P_PROJ(F) + (size_t)(b * SEQ + t) * MIX_IN + C_K + g * HD + 32 * hf;
            const bf16* vp = P_PROJ(F) + (size_t)(b * SEQ + t) * MIX_IN + C_V + g * HD + 32 * hf;
#pragma unroll
            for (int q = 0; q < 4; ++q) { const v4u r = *(const v4u*)(kp + 8 * q); vraw[q] = *(const v4u*)(vp + 8 * q);
                kv[8 * q + 0] = bflo(r.x); kv[8 * q + 1] = bfhi(r.x); kv[8 * q + 2] = bflo(r.y); kv[8 * q + 3] = bfhi(r.y);
                kv[8 * q + 4] = bflo(r.z); kv[8 * q + 5] = bfhi(r.z); kv[8 * q + 6] = bflo(r.w); kv[8 * q + 7] = bfhi(r.w); }
        } else {
#pragma unroll
            for (int q = 0; q < 4; ++q) vraw[q] = (v4u){0u, 0u, 0u, 0u};
#pragma unroll
            for (int q = 0; q < 32; ++q) kv[q] = 0.f;
        }
        float ss = 0.f;
#pragma unroll
        for (int q = 0; q < 32; ++q) ss += kv[q] * kv[q];
        ss += __shfl_xor(ss, 1);
        const float rstd = 1.0f / sqrtf(ss * (1.0f / HD) + EPS);
#pragma unroll
        for (int q = 0; q < 32; ++q) kv[q] = kv[q] * rstd * P_kn_g(F)[32 * hf + q];
        if (hf == 0 && t >= 0) {
            const float* rp = P_ROPE(F) + (size_t)(b * SEQ + t) * 16;
#pragma unroll
            for (int i = 0; i < 8; ++i) { const float cs = rp[i], sn = rp[8 + i]; const float x1 = kv[i], x2 = kv[8 + i];
                kv[i] = x1 * cs - x2 * sn; kv[8 + i] = x2 * cs + x1 * sn; }
        }
#pragma unroll
        for (int q = 0; q < 4; ++q) { v4u o; o.x = pk2(kv[8 * q], kv[8 * q + 1]); o.y = pk2(kv[8 * q + 2], kv[8 * q + 3]); o.z = pk2(kv[8 * q + 4], kv[8 * q + 5]); o.w = pk2(kv[8 * q + 6], kv[8 * q + 7]);
            *(LAS v4u*)(Ks + kb * KS_STRIDE + 32 * hf + 8 * q) = o; }
#pragma unroll
        for (int q = 0; q < 4; ++q) { const unsigned w[4] = {vraw[q].x, vraw[q].y, vraw[q].z, vraw[q].w};
#pragma unroll
            for (int e = 0; e < 4; ++e) { const int d = 32 * hf + 8 * q + 2 * e;
                VT[d * VT_STRIDE + kb] = (bf16)(w[e] & 0xffffu); VT[(d + 1) * VT_STRIDE + kb] = (bf16)(w[e] >> 16); } }
    }
    __syncthreads();
    const int hq = g * GRP + F.wave, r = lane & 31, hh = lane >> 5;
    const float sink = P_sinks(F)[hq];
    for (int qi = 0; qi < 4; ++qi) {
        const int tq = n * 128 + 32 * qi + r;
        bf16x8 qf[4];
        {
            const bf16* qp = P_PROJ(F) + (size_t)(b * SEQ + tq) * MIX_IN + C_Q + hq * HD + 8 * hh;
            float qv[4][8]; float ss = 0.f;
#pragma unroll
            for (int ks = 0; ks < 4; ++ks) { const v4u rr = *(const v4u*)(qp + 16 * ks);
                qv[ks][0] = bflo(rr.x); qv[ks][1] = bfhi(rr.x); qv[ks][2] = bflo(rr.y); qv[ks][3] = bfhi(rr.y);
                qv[ks][4] = bflo(rr.z); qv[ks][5] = bfhi(rr.z); qv[ks][6] = bflo(rr.w); qv[ks][7] = bfhi(rr.w);
#pragma unroll
                for (int j = 0; j < 8; ++j) ss += qv[ks][j] * qv[ks][j]; }
            ss += __shfl_xor(ss, 32);
            const float rstd = 1.0f / sqrtf(ss * (1.0f / HD) + EPS);
#pragma unroll
            for (int ks = 0; ks < 4; ++ks)
#pragma unroll
                for (int j = 0; j < 8; ++j) qv[ks][j] = qv[ks][j] * rstd * P_qn_g(F)[16 * ks + 8 * hh + j];
            const float* rp = P_ROPE(F) + (size_t)(b * SEQ + tq) * 16;
#pragma unroll
            for (int j = 0; j < 8; ++j) { const float mine = qv[0][j], other = __shfl_xor(mine, 32); const float cs = rp[j], sn = rp[8 + j];
                qv[0][j] = hh == 0 ? (mine * cs - other * sn) : (mine * cs + other * sn); }
#pragma unroll
            for (int ks = 0; ks < 4; ++ks) { v4u o; o.x = pk2(qv[ks][0] * 0.125f, qv[ks][1] * 0.125f); o.y = pk2(qv[ks][2] * 0.125f, qv[ks][3] * 0.125f);
                o.z = pk2(qv[ks][4] * 0.125f, qv[ks][5] * 0.125f); o.w = pk2(qv[ks][6] * 0.125f, qv[ks][7] * 0.125f); qf[ks] = __builtin_bit_cast(bf16x8, o); }
        }
        f32x16 s[5];
#pragma unroll
        for (int kj = 0; kj < 5; ++kj) {
            f32x16 acc;
#pragma unroll
            for (int i = 0; i < 16; ++i) acc[i] = 0.f;
            const LAS bf16* kp = Ks + (32 * (qi + kj) + r) * KS_STRIDE + 8 * hh;
#pragma unroll
            for (int ks = 0; ks < 4; ++ks) { const bf16x8 kf = *(const LAS bf16x8*)(kp + 16 * ks); acc = MFMA32(kf, qf[ks], acc); }
            s[kj] = acc;
        }
        float mx = sink;
#pragma unroll
        for (int kj = 0; kj < 5; ++kj)
#pragma unroll
            for (int i = 0; i < 16; ++i) { const int kt = (i & 3) + 8 * (i >> 2) + 4 * hh; const int kbi = 32 * (qi + kj) + kt;
                bool valid = (n * 128 + kbi - 128) >= 0;
                if (kj == 0) valid = valid && (kt > r);
                if (kj == 4) valid = valid && (kt <= r);
                s[kj][i] = valid ? s[kj][i] : -INFINITY; mx = fmaxf(mx, s[kj][i]); }
        mx = fmaxf(mx, __shfl_xor(mx, 32));
        float l = 0.f;
#pragma unroll
        for (int kj = 0; kj < 5; ++kj)
#pragma unroll
            for (int i = 0; i < 16; ++i) { const float p = __expf(s[kj][i] - mx); s[kj][i] = p; l += p; }
        l += __shfl_xor(l, 32);
        l += __expf(sink - mx);
        const float inv = 1.0f / l;
        f32x16 o0, o1;
#pragma unroll
        for (int i = 0; i < 16; ++i) { o0[i] = 0.f; o1[i] = 0.f; }
#pragma unroll
        for (int kj = 0; kj < 5; ++kj)
#pragma unroll
            for (int st = 0; st < 2; ++st) {
                v4u pa; pa.x = pk2(s[kj][8 * st + 0] * inv, s[kj][8 * st + 1] * inv); pa.y = pk2(s[kj][8 * st + 2] * inv, s[kj][8 * st + 3] * inv);
                pa.z = pk2(s[kj][8 * st + 4] * inv, s[kj][8 * st + 5] * inv); pa.w = pk2(s[kj][8 * st + 6] * inv, s[kj][8 * st + 7] * inv);
                const bf16x8 pf = __builtin_bit_cast(bf16x8, pa);
                const int kb0 = 32 * (qi + kj) + 16 * st + 4 * hh;
                const LAS bf16* v0p = VT + r * VT_STRIDE + kb0; const LAS bf16* v1p = VT + (32 + r) * VT_STRIDE + kb0;
                const v2u a0 = *(const LAS v2u*)v0p, a1 = *(const LAS v2u*)(v0p + 8), b0 = *(const LAS v2u*)v1p, b1 = *(const LAS v2u*)(v1p + 8);
                const v4u vb0 = {a0.x, a0.y, a1.x, a1.y}, vb1 = {b0.x, b0.y, b1.x, b1.y};
                o0 = MFMA32(pf, __builtin_bit_cast(bf16x8, vb0), o0);
                o1 = MFMA32(pf, __builtin_bit_cast(bf16x8, vb1), o1);
            }
#pragma unroll
        for (int i = 0; i < 16; ++i) { const int qr = (i & 3) + 8 * (i >> 2) + 4 * hh; const int tok = n * 128 + 32 * qi + qr;
            bf16* op = P_XH(F) + (size_t)(b * SEQ + tok) * D + LRU_W + hq * HD + r;
            op[0] = (bf16)f2bf(o0[i]); op[32] = (bf16)f2bf(o1[i]); }
    }
    __syncthreads();
}

constexpr int LCH = 64;
constexpr int XC_STRIDE = 136;
constexpr int LRU_XCB_OFF = 0, LRU_XCF_OFF = LCH * XC_STRIDE * 2  , LRU_A_OFF = LRU_XCF_OFF + LCH * 128 * 4, LRU_B_OFF = LRU_A_OFF + LCH * 128 * 4, LRU_SE_OFF = LRU_B_OFF + LCH * 128 * 4;
static_assert(LRU_SE_OFF + 2 * 4 * 128 * 4 <= RING_BYTES, "LRU LDS");
__device__ __forceinline__ void lru_block(Frame& F) {
    LAS bf16* XCb = (LAS bf16*)(F.lds + LRU_XCB_OFF);
    LAS float* XCF = (LAS float*)(F.lds + LRU_XCF_OFF);
    LAS float* As = (LAS float*)(F.lds + LRU_A_OFF);
    LAS float* Bs = (LAS float*)(F.lds + LRU_B_OFF);
    LAS float* SEh = (LAS float*)(F.lds + LRU_SE_OFF);
    LAS float* SEp = SEh + 4 * 128;
    const int tid = F.tid, lane = F.lane;
    const int hd = F.bid & 7, li = F.bid >> 3, step = F.G >> 3;
    constexpr int NQ = BATCH * (SEQ / LCH);
    if (li >= NQ) return;
    const int cg = tid & 15, tp = tid >> 4, colc = hd * LRU_BLK + 8 * cg;
    float cw[4][8], cbv[8];
#pragma unroll
    for (int k = 0; k < 4; ++k) { const f32x4 a = *(const f32x4*)(P_conv_w(F) + k * LRU_W + colc), b2 = *(const f32x4*)(P_conv_w(F) + k * LRU_W + colc + 4);
        cw[k][0] = a.x; cw[k][1] = a.y; cw[k][2] = a.z; cw[k][3] = a.w; cw[k][4] = b2.x; cw[k][5] = b2.y; cw[k][6] = b2.z; cw[k][7] = b2.w; }
    { const f32x4 a = *(const f32x4*)(P_conv_b(F) + colc), b2 = *(const f32x4*)(P_conv_b(F) + colc + 4);
      cbv[0] = a.x; cbv[1] = a.y; cbv[2] = a.z; cbv[3] = a.w; cbv[4] = b2.x; cbv[5] = b2.y; cbv[6] = b2.z; cbv[7] = b2.w; }
    const int fr = lane & 15, fq = lane >> 4, j = 16 * F.wave + fr, jc = hd * LRU_BLK + j;
    bf16x8 wa[4], wx[4];
    { const bf16* wap = P_WGA(F) + (size_t)hd * 16384 + (size_t)j * 128 + 8 * fq; const bf16* wxp = P_WGX(F) + (size_t)hd * 16384 + (size_t)j * 128 + 8 * fq;
#pragma unroll
      for (int ks = 0; ks < 4; ++ks) { wa[ks] = *(const bf16x8*)(wap + 32 * ks); wx[ks] = *(const bf16x8*)(wxp + 32 * ks); } }
    const float ba = P_ga_b(F)[jc], bx = P_gx_b(F)[jc];
    const float sp8 = -8.0f * log1pf(__expf(-P_lam(F)[jc]));
    const int c = tid & 127, sub = tid >> 7, col = hd * LRU_BLK + c;
    const bf16* xbase = P_PROJ(F) + colc;
    bf16* HLp = P_HL(F); bf16* PAp = P_PA(F);
    v4u xr[5];
#define LRU_LOAD_X(q_) do { const int b_ = (q_) >> 6, ch_ = (q_) & 63; const int tr_ = ch_ * LCH + 2 * tp - 3; \
        _Pragma("unroll") for (int r_ = 0; r_ < 5; ++r_) { const int t_ = tr_ + r_; \
            xr[r_] = (t_ >= 0) ? *(const v4u*)(xbase + (size_t)(b_ * SEQ + t_) * MIX_IN) : (v4u){0u, 0u, 0u, 0u}; } } while (0)
    LRU_LOAD_X(li);
    for (int q = li; q < NQ; q += step) {
        const int b = q >> 6, ch = q & 63, t0 = ch * LCH;
        {
            float xv[5][8];
#pragma unroll
            for (int r = 0; r < 5; ++r) { xv[r][0] = bflo(xr[r].x); xv[r][1] = bfhi(xr[r].x); xv[r][2] = bflo(xr[r].y); xv[r][3] = bfhi(xr[r].y);
                xv[r][4] = bflo(xr[r].z); xv[r][5] = bfhi(xr[r].z); xv[r][6] = bflo(xr[r].w); xv[r][7] = bfhi(xr[r].w); }
            if (q + step < NQ) LRU_LOAD_X(q + step);
#pragma unroll
            for (int tk = 0; tk < 2; ++tk) { float xc[8];
#pragma unroll
                for (int e = 0; e < 8; ++e) xc[e] = cbv[e] + cw[0][e] * xv[tk][e] + cw[1][e] * xv[tk + 1][e] + cw[2][e] * xv[tk + 2][e] + cw[3][e] * xv[tk + 3][e];
                const int tl = 2 * tp + tk;
                v4u o; o.x = pk2(xc[0], xc[1]); o.y = pk2(xc[2], xc[3]); o.z = pk2(xc[4], xc[5]); o.w = pk2(xc[6], xc[7]);
                *(LAS v4u*)(XCb + tl * XC_STRIDE + 8 * cg) = o;
                *(LAS f32x4*)(XCF + tl * 128 + 8 * cg) = (f32x4){xc[0], xc[1], xc[2], xc[3]}; *(LAS f32x4*)(XCF + tl * 128 + 8 * cg + 4) = (f32x4){xc[4], xc[5], xc[6], xc[7]}; }
        }
        __syncthreads();
#pragma unroll
        for (int mt = 0; mt < 4; ++mt) {
            f32x4 ra = {0.f, 0.f, 0.f, 0.f}, rx = {0.f, 0.f, 0.f, 0.f};
            const LAS bf16* ap = XCb + (16 * mt + fr) * XC_STRIDE + 8 * fq;
#pragma unroll
            for (int ks = 0; ks < 4; ++ks) { const bf16x8 af = *(const LAS bf16x8*)(ap + 32 * ks); ra = MFMA16(af, wa[ks], ra); rx = MFMA16(af, wx[ks], rx); }
#pragma unroll
            for (int e = 0; e < 4; ++e) { const int tl = 16 * mt + 4 * fq + e;
                const float rg = sigmoidf_(ra[e] + ba), ig = sigmoidf_(rx[e] + bx);
                const float a = __expf(rg * sp8);
                const float mult = sqrtf(fmaxf(fmaf(-a, a, 1.0f), 0.f));
                As[tl * 128 + j] = a; Bs[tl * 128 + j] = mult * ig * XCF[tl * 128 + j]; }
        }
        __syncthreads();
        float hh[16], pp[16];
        {
            float h = 0.f, P = 1.f;
#pragma unroll
            for (int i = 0; i < 16; ++i) { const int tl = sub * 16 + i; const float a = As[tl * 128 + c], bq = Bs[tl * 128 + c];
                h = a * h + bq; P *= a; hh[i] = h; pp[i] = P; }
            SEh[sub * 128 + c] = h; SEp[sub * 128 + c] = P;
        }
        __syncthreads();
        {
            float carry = 0.f, pre = 1.f;
            for (int s2 = 0; s2 < sub; ++s2) { carry = SEh[s2 * 128 + c] + SEp[s2 * 128 + c] * carry; pre *= SEp[s2 * 128 + c]; }
            bf16* hl = HLp + (size_t)(b * SEQ + t0 + sub * 16) * LRU_W + col;
            bf16* pa = PAp + (size_t)(b * SEQ + t0 + sub * 16) * LRU_W + col;
#pragma unroll
            for (int i = 0; i < 16; ++i) { hl[(size_t)i * LRU_W] = (bf16)f2bf(hh[i] + pp[i] * carry); pa[(size_t)i * LRU_W] = (bf16)f2bf(pp[i] * pre); }
        }
    }
#undef LRU_LOAD_X
    __syncthreads();
}
constexpr int N_ATT_UNITS = BATCH * HKV * (SEQ / 128);
constexpr int N_LRU_UNITS = BATCH * LRU_HEADS * (SEQ / LCH);
__device__ __forceinline__ void p3_phase(Frame& F) {
    for (int u = F.bid; u < N_ATT_UNITS; u += F.G) attn_unit(F, u >> 6, (u >> 5) & 1, u & 31);
    lru_block(F);
}

__device__ __forceinline__ void p4_unit(Frame& F, int b, int ch) {
    LAS float* CAR = (LAS float*)F.lds;
    const int tid = F.tid, lane = F.lane;
    {
        f32x2 carry = {0.f, 0.f};
        const bf16* hlb = P_HL(F) + (size_t)(b * SEQ + LCH - 1) * LRU_W + 2 * tid; const bf16* pab = P_PA(F) + (size_t)(b * SEQ + LCH - 1) * LRU_W + 2 * tid;
        int c2 = 0;
        for (; c2 + 8 <= ch; c2 += 8) { unsigned hl[8], pa[8];
#pragma unroll
            for (int q = 0; q < 8; ++q) { hl[q] = *(const unsigned*)(hlb + (size_t)(c2 + q) * LCH * LRU_W); pa[q] = *(const unsigned*)(pab + (size_t)(c2 + q) * LCH * LRU_W); }
#pragma unroll
            for (int q = 0; q < 8; ++q) { carry.x = bflo(hl[q]) + bflo(pa[q]) * carry.x; carry.y = bfhi(hl[q]) + bfhi(pa[q]) * carry.y; } }
        for (; c2 < ch; ++c2) { const unsigned hl = *(const unsigned*)(hlb + (size_t)c2 * LCH * LRU_W), pa = *(const unsigned*)(pab + (size_t)c2 * LCH * LRU_W);
            carry.x = bflo(hl) + bflo(pa) * carry.x; carry.y = bfhi(hl) + bfhi(pa) * carry.y; }
        CAR[2 * tid] = carry.x; CAR[2 * tid + 1] = carry.y;
    }
    __syncthreads();
    const float* gl = P_on_lru_g(F); const float* ga = P_on_attn_g(F);
    for (int i = 0; i < 8; i += 2) {
        const size_t m0 = (size_t)b * SEQ + ch * LCH + F.wave * 8 + i;
        v2u hl[2][4], pa[2][4]; v2u yr[2][4], ar[2][4];
#pragma unroll
        for (int t = 0; t < 2; ++t)
#pragma unroll
            for (int j = 0; j < 4; ++j) { const int c = 4 * lane + 256 * j; const size_t m = m0 + t;
                hl[t][j] = *(const v2u*)(P_HL(F) + m * LRU_W + c); pa[t][j] = *(const v2u*)(P_PA(F) + m * LRU_W + c);
                yr[t][j] = *(const v2u*)(P_PROJ(F) + m * MIX_IN + C_Y + c); ar[t][j] = *(const v2u*)(P_XH(F) + m * D + LRU_W + c); }
        f32x4 vl[2][4], va[2][4]; float sl[2] = {0.f, 0.f}, sa[2] = {0.f, 0.f};
#pragma unroll
        for (int t = 0; t < 2; ++t)
#pragma unroll
            for (int j = 0; j < 4; ++j) { const int c = 4 * lane + 256 * j; const f32x4 car = *(const LAS f32x4*)(CAR + c);
                const f32x4 hlf = {bflo(hl[t][j].x), bfhi(hl[t][j].x), bflo(hl[t][j].y), bfhi(hl[t][j].y)}, paf = {bflo(pa[t][j].x), bfhi(pa[t][j].x), bflo(pa[t][j].y), bfhi(pa[t][j].y)};
                const f32x4 h = hlf + paf * car;
                f32x4 v; v.x = h.x * gelu_tanh(bflo(yr[t][j].x)); v.y = h.y * gelu_tanh(bfhi(yr[t][j].x)); v.z = h.z * gelu_tanh(bflo(yr[t][j].y)); v.w = h.w * gelu_tanh(bfhi(yr[t][j].y));
                vl[t][j] = v; sl[t] += (v.x * v.x + v.y * v.y) + (v.z * v.z + v.w * v.w);
                f32x4 a; a.x = bflo(ar[t][j].x); a.y = bfhi(ar[t][j].x); a.z = bflo(ar[t][j].y); a.w = bfhi(ar[t][j].y);
                va[t][j] = a; sa[t] += (a.x * a.x + a.y * a.y) + (a.z * a.z + a.w * a.w); }
#pragma unroll
        for (int o = 1; o < 64; o <<= 1) { sl[0] += __shfl_xor(sl[0], o); sl[1] += __shfl_xor(sl[1], o); sa[0] += __shfl_xor(sa[0], o); sa[1] += __shfl_xor(sa[1], o); }
#pragma unroll
        for (int t = 0; t < 2; ++t) { const float rl = 1.0f / sqrtf(sl[t] * (1.0f / LRU_W) + EPS), ra = 1.0f / sqrtf(sa[t] * (1.0f / LRU_W) + EPS); const size_t m = m0 + t;
#pragma unroll
            for (int j = 0; j < 4; ++j) { const int c = 4 * lane + 256 * j; const f32x4 g1v = *(const f32x4*)(gl + c), g2v = *(const f32x4*)(ga + c);
                const f32x4 y = vl[t][j] * rl * g1v, z = va[t][j] * ra * g2v;
                v2u o; o.x = pk2(y.x, y.y); o.y = pk2(y.z, y.w); *(v2u*)(P_XH(F) + m * D + c) = o;
                v2u p; p.x = pk2(z.x, z.y); p.y = pk2(z.z, z.w); *(v2u*)(P_XH(F) + m * D + LRU_W + c) = p; } }
    }
    __syncthreads();
}
__device__ __forceinline__ void p4_phase(Frame& F) {
    for (int u = F.bid; u < BATCH * (SEQ / LCH); u += F.G) p4_unit(F, u >> 6, u & 63);
}

__device__ __forceinline__ int f2key(float f) { const int b = __builtin_bit_cast(int, f); return b ^ ((b >> 31) & 0x7fffffff); }
__device__ __forceinline__ float key2f(int k) { const int b = k ^ ((k >> 31) & 0x7fffffff); return __builtin_bit_cast(float, b); }
__device__ __forceinline__ void ins16(int (&L)[16], int x) {
#pragma unroll
    for (int j = 0; j < 16; ++j) { const int hi = max(L[j], x); x = min(L[j], x); L[j] = hi; }
}
__device__ __forceinline__ void ce_desc(int& a, int& b) { const int hi = a > b ? a : b, lo = a > b ? b : a; a = hi; b = lo; }
__device__ __forceinline__ void sort16_desc(int (&a)[16]) {
#pragma unroll
    for (int k = 2; k <= 16; k <<= 1)
#pragma unroll
        for (int j = k >> 1; j > 0; j >>= 1)
#pragma unroll
            for (int i = 0; i < 16; ++i) { const int l = i ^ j; if (l > i) { if ((i & k) == 0) ce_desc(a[i], a[l]); else ce_desc(a[l], a[i]); } }
}
__device__ __forceinline__ void bitonic_merge16_desc(int (&a)[16]) {
#pragma unroll
    for (int j = 8; j > 0; j >>= 1)
#pragma unroll
        for (int i = 0; i < 16; ++i) { const int l = i ^ j; if (l > i) ce_desc(a[i], a[l]); }
}
__device__ __forceinline__ void merge_top16(int (&a)[16], const int (&b)[16]) {
#pragma unroll
    for (int i = 0; i < 16; ++i) a[i] = a[i] > b[15 - i] ? a[i] : b[15 - i];
    bitonic_merge16_desc(a);
}
constexpr int INT_LOWEST = (int)0x80000000;
__device__ __forceinline__ void p8_item(Frame& F, int tt, int hd, LAS int* lut  ) {
    const int lane = F.lane, r = lane & 31, hh = lane >> 5;
    const bf16* QP = P_PROJ(F);
    int V[2][16];
#pragma unroll
    for (int p = 0; p < 2; ++p) {
        bf16x8 qf[8];
        const char* qb = (const char*)(QP + (size_t)(32 * tt) * D + hd * 256 + p * 128);
        const unsigned qoff = (unsigned)(r * D + 8 * hh) * 2u;
#pragma unroll
        for (int ks = 0; ks < 8; ++ks) qf[ks] = *(const bf16x8*)(qb + qoff + 32 * ks);
        int L[16];
#pragma unroll
        for (int j = 0; j < 16; ++j) L[j] = INT_LOWEST;
        const char* skb = (const char*)(P_SK(F) + (size_t)((hd * 2 + p) * PKEYS) * PHALF);
        const unsigned skoff = (unsigned)(r * PHALF + 8 * hh) * 2u;
#pragma unroll 1
        for (int kt = 0; kt < 4; ++kt) {
            f32x16 acc;
#pragma unroll
            for (int i = 0; i < 16; ++i) acc[i] = 0.f;
            const char* skt = skb + (size_t)(32 * kt) * PHALF * 2;
#pragma unroll
            for (int ks = 0; ks < 8; ++ks) { const bf16x8 kf = *(const bf16x8*)(skt + skoff + 32 * ks); acc = MFMA32(kf, qf[ks], acc); }
            const int kbase = 32 * kt + 4 * hh;
            int T[16];
#pragma unroll
            for (int i = 0; i < 16; ++i) { const int kidx = (i & 3) + 8 * (i >> 2); T[i] = (f2key(acc[i]) & ~0x7f) | (kbase + kidx); }
            sort16_desc(T); merge_top16(L, T);
        }
        int O[16];
#pragma unroll
        for (int j = 0; j < 16; ++j) O[j] = __shfl_xor(L[j], 32);
        merge_top16(L, O);
#pragma unroll
        for (int j = 0; j < 16; ++j) V[p][j] = L[j];
    }
#pragma unroll
    for (int j = 0; j < 16; ++j) { lut[lane * 33 + j] = V[0][j] & 0x7f; lut[lane * 33 + 16 + j] = V[1][j] & 0x7f; }
    float v0[16], v1[16];
#pragma unroll
    for (int j = 0; j < 16; ++j) { v0[j] = key2f(V[0][j] & ~0x7f); v1[j] = key2f(V[1][j] & ~0x7f); }
    int C[16], G1[16], G2[16], G3[2];
    { int n = 0;
#pragma unroll
      for (int i = 0; i < 16; ++i)
#pragma unroll
        for (int j = 0; j < 16; ++j)
            if ((i + 1) * (j + 1) <= 16) { const int key = (f2key(v0[i] + v1[j]) & ~0xff) | (i * 16 + j);
                if (n < 16) C[n] = key; else if (n < 32) G1[n - 16] = key; else if (n < 48) G2[n - 32] = key; else G3[n - 48] = key;
                ++n; } }
    sort16_desc(C); sort16_desc(G1); sort16_desc(G2);
    merge_top16(C, G1); merge_top16(C, G2); ins16(C, G3[0]); ins16(C, G3[1]);
    float sv[16]; float den = 0.f;
    const float mx = key2f(C[0] & ~0xff);
#pragma unroll
    for (int e = 0; e < 16; ++e) { sv[e] = __expf(key2f(C[e] & ~0xff) - mx); den += sv[e]; }
    const float inv = 1.0f / den;
    LDS_WAIT(); asm volatile("" ::: "memory");
    int idx[16];
#pragma unroll
    for (int e = 0; e < 16; ++e) { const int pi = (C[e] >> 4) & 15, pj = C[e] & 15; idx[e] = lut[lane * 33 + pi] * PKEYS + lut[lane * 33 + 16 + pj]; }
    if (hh == 0) {
        unsigned short* ip = P_IDX(F) + (size_t)(32 * tt + r) * 128 + hd * 16; float* gp = P_GW(F) + (size_t)(32 * tt + r) * 128 + hd * 16;
#pragma unroll
        for (int q = 0; q < 2; ++q) *(v4u*)(ip + 8 * q) = (v4u){(unsigned)idx[8 * q] | ((unsigned)idx[8 * q + 1] << 16), (unsigned)idx[8 * q + 2] | ((unsigned)idx[8 * q + 3] << 16),
                                                              (unsigned)idx[8 * q + 4] | ((unsigned)idx[8 * q + 5] << 16), (unsigned)idx[8 * q + 6] | ((unsigned)idx[8 * q + 7] << 16)};
#pragma unroll
        for (int q = 0; q < 4; ++q) *(f32x4*)(gp + 4 * q) = (f32x4){sv[4 * q] * inv, sv[4 * q + 1] * inv, sv[4 * q + 2] * inv, sv[4 * q + 3] * inv};
    }
    LDS_WAIT(); asm volatile("" ::: "memory");
}
__device__ __forceinline__ void p8_phase(Frame& F) {
    LAS int* lut = (LAS int*)(F.lds + F.wave * (64 * 33 * 4));
    const int gw = F.bid * NWAVES + F.wave, NGW = F.G * NWAVES;
    for (int it = gw; it < (M / 32) * PH; it += NGW) p8_item(F, it >> 3, it & 7, lut);
}

template <int CTRL> __device__ __forceinline__ float dpp_f(float x) { return __builtin_bit_cast(float, __builtin_amdgcn_mov_dpp(__builtin_bit_cast(int, x), CTRL, 0xf, 0xf, true)); }
__device__ __forceinline__ float sum8(float v) {
    v += dpp_f<0xB1>(v);
    v += dpp_f<0x4E>(v);
    v += dpp_f<0x141>(v);
    return v;
}
__device__ __forceinline__ void dec16(const v4u r, float (&f)[16]) {
    const unsigned w4[4] = {r.x, r.y, r.z, r.w};
#pragma unroll
    for (int w = 0; w < 4; ++w) { const f32x2 lo = __builtin_amdgcn_cvt_pk_f32_fp8((int)w4[w], false), hi = __builtin_amdgcn_cvt_pk_f32_fp8((int)w4[w], true);
        f[4 * w] = lo.x; f[4 * w + 1] = lo.y; f[4 * w + 2] = hi.x; f[4 * w + 3] = hi.y; }
}
__device__ __forceinline__ void row_offsets(const v4u a, const v4u b, unsigned loff, unsigned (&off)[16]) {
    const unsigned w[8] = {a.x, a.y, a.z, a.w, b.x, b.y, b.z, b.w};
#pragma unroll
    for (int q = 0; q < 8; ++q) { off[2 * q] = ((w[q] & 0xffffu) << 11) + loff; off[2 * q + 1] = ((w[q] >> 16) << 11) + loff; }
}
#define ISSUE_ROWS(dst, TBL, ia, ib) do { unsigned off_[16]; row_offsets((ia), (ib), loff, off_); \
    _Pragma("unroll") for (int i_ = 0; i_ < 16; ++i_) dst[i_] = *(const v4u*)((TBL) + off_[i_]); } while (0)

__device__ __forceinline__ void p9u_compute(const v4u (&row)[16], const v4u h0, const v4u h1, int c8, unsigned* dst) {
    f32x2 h2[8];
    h2[0] = (f32x2){bflo(h0.x), bfhi(h0.x)}; h2[1] = (f32x2){bflo(h0.y), bfhi(h0.y)}; h2[2] = (f32x2){bflo(h0.z), bfhi(h0.z)}; h2[3] = (f32x2){bflo(h0.w), bfhi(h0.w)};
    h2[4] = (f32x2){bflo(h1.x), bfhi(h1.x)}; h2[5] = (f32x2){bflo(h1.y), bfhi(h1.y)}; h2[6] = (f32x2){bflo(h1.z), bfhi(h1.z)}; h2[7] = (f32x2){bflo(h1.w), bfhi(h1.w)};
#pragma unroll
    for (int e = 0; e < 8; ++e) asm volatile("" : "+v"(h2[e]));
    float res0 = 0.f, res1 = 0.f;
#pragma unroll
    for (int i = 0; i < 16; ++i) {
        const unsigned w4[4] = {row[i].x, row[i].y, row[i].z, row[i].w};
        f32x2 a = __builtin_amdgcn_cvt_pk_f32_fp8((int)w4[0], false) * h2[0];
        f32x2 b = __builtin_amdgcn_cvt_pk_f32_fp8((int)w4[0], true) * h2[1];
#pragma unroll
        for (int w = 1; w < 4; ++w) { a = __builtin_elementwise_fma(__builtin_amdgcn_cvt_pk_f32_fp8((int)w4[w], false), h2[2 * w], a);
                                      b = __builtin_elementwise_fma(__builtin_amdgcn_cvt_pk_f32_fp8((int)w4[w], true), h2[2 * w + 1], b); }
        a = a + b;
        const float tot = sum8(a.x + a.y);
        if (i < 8) res0 = (c8 == (i & 7)) ? tot : res0; else res1 = (c8 == (i & 7)) ? tot : res1; }
    dst[0] = pk2(res0, res1);
}
__device__ __forceinline__ void p9u_item(Frame& F, int s, int tb) {
    const int lane = F.lane, gi = lane >> 3, c8 = lane & 7;
    const unsigned char* U8 = P_U(F);
    const unsigned loff = (unsigned)(128 * s + 16 * c8);
    const unsigned short* idxb = P_IDX(F) + (size_t)(64 * tb) * 128 + 8 * gi;
    const bf16* hb = P_XH(F) + (size_t)(64 * tb) * D + 128 * s + 16 * c8;
    unsigned* pb = P_PART(F) + ((size_t)s * M + 64 * tb) * 64 + lane;
#define LOAD_META_U(I0, I1, H0, H1, tt_) do { const int tn_ = (tt_) < 64 ? (tt_) : 63; const unsigned short* ip_ = idxb + (size_t)tn_ * 128; const bf16* hp_ = hb + (size_t)tn_ * D; \
        I0 = *(const v4u*)(ip_); I1 = *(const v4u*)(ip_ + 64); H0 = *(const v4u*)(hp_); H1 = *(const v4u*)(hp_ + 8); } while (0)
    v4u aI0, aI1, aH0, aH1, bI0, bI1, bH0, bH1, cI0, cI1, cH0, cH1, dI0, dI1, dH0, dH1;
    LOAD_META_U(aI0, aI1, aH0, aH1, 0); LOAD_META_U(bI0, bI1, bH0, bH1, 1); LOAD_META_U(cI0, cI1, cH0, cH1, 2);
    v4u rowA[16], rowB[16];
    ISSUE_ROWS(rowA, U8, aI0, aI1); ISSUE_ROWS(rowB, U8, bI0, bI1);
#pragma unroll 1
    for (int t = 0; t < 64; t += 2) {
        p9u_compute(rowA, aH0, aH1, c8, pb + (size_t)t * 64);
        LOAD_META_U(dI0, dI1, dH0, dH1, t + 3);
        ISSUE_ROWS(rowA, U8, cI0, cI1);
        p9u_compute(rowB, bH0, bH1, c8, pb + (size_t)(t + 1) * 64);
        aH0 = cH0; aH1 = cH1; bH0 = dH0; bH1 = dH1;
        LOAD_META_U(cI0, cI1, cH0, cH1, t + 4);
        ISSUE_ROWS(rowB, U8, dI0, dI1);
    }
#undef LOAD_META_U
}
__device__ __forceinline__ void p9v_compute(const v4u (&row)[16], const v4u w0, const v4u w1, int lane, const f32x2 x1, const f32x2 g2, float* dst) {
    const unsigned ww[8] = {w0.x, w0.y, w0.z, w0.w, w1.x, w1.y, w1.z, w1.w};
    float acc[16];
#pragma unroll
    for (int e = 0; e < 16; ++e) acc[e] = 0.f;
#pragma unroll
    for (int i = 0; i < 16; ++i) { float f[16]; dec16(row[i], f); const float wv = (i & 1) ? bfhi(ww[i >> 1]) : bflo(ww[i >> 1]);
#pragma unroll
        for (int e = 0; e < 16; ++e) acc[e] = fmaf(f[e], wv, acc[e]); }
    float r8[8], r4[4], r2[2];
    { const bool up = (lane & 32) != 0;
#pragma unroll
      for (int e = 0; e < 8; ++e) { const float send = up ? acc[e] : acc[8 + e], keep = up ? acc[8 + e] : acc[e]; r8[e] = keep + __shfl_xor(send, 32); } }
    { const bool up = (lane & 16) != 0;
#pragma unroll
      for (int e = 0; e < 4; ++e) { const float send = up ? r8[e] : r8[4 + e], keep = up ? r8[4 + e] : r8[e]; r4[e] = keep + __shfl_xor(send, 16); } }
    { const bool up = (lane & 8) != 0;
#pragma unroll
      for (int e = 0; e < 2; ++e) { const float send = up ? r4[e] : r4[2 + e], keep = up ? r4[2 + e] : r4[e]; r2[e] = keep + __shfl_xor(send, 8); } }
    f32x2 o; o.x = x1.x + g2.x * r2[0]; o.y = x1.y + g2.y * r2[1];
    *(f32x2*)dst = o;
}
__device__ __forceinline__ void p9v_item(Frame& F, int s, int tb) {
    const int lane = F.lane, gi = lane >> 3, c8 = lane & 7;
    const unsigned char* V8 = P_V(F);
    const unsigned loff = (unsigned)(128 * s + 16 * c8);
    const unsigned short* idxb = P_IDX(F) + (size_t)(64 * tb) * 128 + 8 * gi;
    const int b = (64 * tb) / SEQ;
    const int wcol = 128 * s + 16 * c8 + 2 * gi;
    const f32x2 g2 = *(const f32x2*)(P_ADA(F) + (size_t)b * ADA_W + 5 * D + wcol);
    float* ob = P_out(F) + (size_t)(64 * tb) * D + wcol;
    const bf16* xb = P_X1B(F) + (size_t)(64 * tb) * D + wcol;
    LAS unsigned char* Wl = F.lds + F.wave * 16384;
    { const v4u* wsrc = (const v4u*)(P_W(F) + (size_t)(64 * tb) * 128); v4u tmp[16];
#pragma unroll
      for (int q = 0; q < 16; ++q) tmp[q] = wsrc[q * 64 + lane];
#pragma unroll
      for (int q = 0; q < 16; ++q) *(LAS v4u*)(Wl + (q * 64 + lane) * 16) = tmp[q]; }
    const LAS unsigned char* wl = Wl + 16 * gi;
#define LOAD_IDX(I0, I1, X1, tt_) do { const int tn_ = (tt_) < 64 ? (tt_) : 63; const unsigned short* ip_ = idxb + (size_t)tn_ * 128; I0 = *(const v4u*)(ip_); I1 = *(const v4u*)(ip_ + 64); \
        X1 = *(const unsigned*)(xb + (size_t)tn_ * D); } while (0)
#define V_COMPUTE(ROW, X1, tt_) do { const f32x2 x1_ = {bflo(X1), bfhi(X1)}; const v4u w0_ = *(const LAS v4u*)(wl + (tt_) * 256), w1_ = *(const LAS v4u*)(wl + (tt_) * 256 + 128); \
        p9v_compute(ROW, w0_, w1_, lane, x1_, g2, ob + (size_t)(tt_) * D); } while (0)
    v4u aI0, aI1, bI0, bI1, cI0, cI1, dI0, dI1; unsigned aX, bX, cX, dX;
    LOAD_IDX(aI0, aI1, aX, 0); LOAD_IDX(bI0, bI1, bX, 1); LOAD_IDX(cI0, cI1, cX, 2);
    v4u rowA[16], rowB[16];
    ISSUE_ROWS(rowA, V8, aI0, aI1); ISSUE_ROWS(rowB, V8, bI0, bI1);
#pragma unroll 1
    for (int t = 0; t < 64; t += 2) {
        V_COMPUTE(rowA, aX, t);
        LOAD_IDX(dI0, dI1, dX, t + 3);
        ISSUE_ROWS(rowA, V8, cI0, cI1);
        V_COMPUTE(rowB, bX, t + 1);
        aX = cX; bX = dX;
        LOAD_IDX(cI0, cI1, cX, t + 4);
        ISSUE_ROWS(rowB, V8, dI0, dI1);
    }
#undef LOAD_IDX
#undef V_COMPUTE
}
__device__ __forceinline__ void p9u_phase(Frame& F) {
    const int x = F.bid & 7, rank = F.bid >> 3, nr = F.G >> 3;
    for (int h = 0; h < 2; ++h)
        for (int tb = rank * NWAVES + F.wave; tb < M / 64; tb += nr * NWAVES) p9u_item(F, 2 * x + h, tb);
}
__device__ __forceinline__ void p9v_phase(Frame& F) {
    const int x = F.bid & 7, rank = F.bid >> 3, nr = F.G >> 3;
    for (int h = 0; h < 2; ++h)
        for (int tb = rank * NWAVES + F.wave; tb < M / 64; tb += nr * NWAVES) p9v_item(F, 2 * x + h, tb);
}
__device__ __forceinline__ void p9w_phase(Frame& F) {
    const unsigned* part = P_PART(F); const unsigned short* idxp = P_IDX(F); const float* gwp = P_GW(F); const float* usc = P_USC(F); const float* vsc = P_VSC(F); bf16* wp = P_W(F);
    for (int it = F.bid * 512 + F.tid; it < M * 64; it += F.G * 512) {
        float a0 = 0.f, a1 = 0.f;
#pragma unroll
        for (int s = 0; s < 16; ++s) { const unsigned w = part[(size_t)s * M * 64 + it]; a0 += bflo(w); a1 += bfhi(w); }
        const int m = it >> 6, L = it & 63; const size_t p0 = (size_t)m * 128 + L, p1 = p0 + 64;
        const int i0 = idxp[p0], i1 = idxp[p1];
        wp[p0] = (bf16)f2bf(gwp[p0] * gelu_tanh(a0 * usc[i0]) * vsc[i0]);
        wp[p1] = (bf16)f2bf(gwp[p1] * gelu_tanh(a1 * usc[i1]) * vsc[i1]);
    }
}

struct Args { const void* in[25]; float* out; unsigned char* ws; int ph_lo, ph_hi; };
__global__ void __launch_bounds__(NWAVES * 64, 2) hymba_fwd(Args args) {
    extern __shared__ __attribute__((aligned(16))) unsigned char lds_raw[];
    Frame F;
    F.lds = (LAS unsigned char*)lds_raw;
    F.tid = threadIdx.x; F.lane = F.tid & 63; F.wave = __builtin_amdgcn_readfirstlane(F.tid >> 6);
    F.G = gridDim.x; F.bid = blockIdx.x;
    F.ka = (kaptr_t)__builtin_amdgcn_kernarg_segment_ptr();
    static_assert(sizeof(Args) == 224, "kernarg byte offsets used by ka_ptr");
    for (int u = F.tid; u < (LDS_BYTES - LDSCTL_OFF) / 4; u += NWAVES * 64) ((LAS unsigned*)(F.lds + LDSCTL_OFF))[u] = 0u;
    __syncthreads();
    volatile LAS unsigned* MISC = (volatile LAS unsigned*)(F.lds + MISC_OFF);
    XcdBarrier bar; bar.bar = (unsigned*)(P_ws(F) + WS_CTL) + CW_BAR; bar.x = 0; bar.st = nullptr;
    const int lo = args.ph_lo, hi = args.ph_hi;
    if (hi - lo > 1) bar = xcd_barrier_post((unsigned*)(P_ws(F) + WS_CTL) + CW_BAR, MISC + 8);
#define IN(k) (lo <= (k) && (k) < hi)
#ifndef PROBE_STAMP
#define PROBE_STAMP -1
#define PROBE_DIV 5.0f
#endif
#define STAMP(k) do { if (PROBE_STAMP >= 0 && F.bid == 0 && F.tid == 0) ((unsigned long long*)(P_ws(F) + WS_CTL + 64))[(k)] = __builtin_amdgcn_s_memrealtime(); } while (0)
#define SEAM(k) do { if (IN(k) && IN((k) + 1)) xcd_barrier(bar); STAMP((k) + 1); } while (0)
    STAMP(0);

#ifndef PROBE_MASK
#define PROBE_MASK 0
#endif
#define REP(k) for (int rep_ = 0; rep_ < (((PROBE_MASK >> (k)) & 1) ? 2 : 1); ++rep_)
#define REPSYNC(k) do { if (((PROBE_MASK >> (k)) & 1) && rep_ == 0) xcd_barrier(bar); } while (0)
    if (IN(0)) { REP(0) { p0_prologue(F); REPSYNC(0); } } SEAM(0);
    if (IN(1)) { REP(1) { p1_phase(F); REPSYNC(1); } } SEAM(1);
    if (IN(2)) REP(2) {
        pg8::Gemm g{P_XH(F), P_WIN(F), M, MIX_IN, D}; pg8::StaticOrder S; S.init(M, MIX_IN, F.G, F.bid);
        pg8::EpiStoreBf16 E{P_PROJ(F), MIX_IN};
        pg8::gemm_phase<pg8::EpiStoreBf16, pg8::StaticOrder, true, true>(F.lds, g, S, E); REPSYNC(2);
        { const int nwg = (M / 256) * (MIX_IN / 256), busy = nwg % F.G;
          if (busy > 0 && F.bid >= busy) quant_rows(F, QUANT_SPLIT, 2 * NEXP, (F.bid - busy) * NWAVES + F.wave, (F.G - busy) * NWAVES);
          else if (busy == 0) quant_rows(F, QUANT_SPLIT, 2 * NEXP, F.bid * NWAVES + F.wave, F.G * NWAVES); }
    } SEAM(2);
    if (IN(3)) { p3_phase(F); } SEAM(3);
    if (IN(4)) { p4_phase(F); } SEAM(4);
    if (IN(5)) REP(5) {
        pg8::Gemm g{P_XH(F), P_WOUT(F), M, D, D}; pg8::StaticOrder S; S.init(M, D, F.G, F.bid);
        pg8::EpiResid E{P_x(F), P_X1B(F), D, P_ADA(F) + 2 * D, ADA_W, SEQ};
        pg8::gemm_phase<pg8::EpiResid, pg8::StaticOrder, true, true>(F.lds, g, S, E); REPSYNC(5);
    } SEAM(5);
    if (IN(6)) { REP(6) { p6_phase(F); REPSYNC(6); } } SEAM(6);
    if (IN(7)) REP(7) {
        pg8::Gemm g{P_XH(F), P_WQ(F), M, D, D}; pg8::StaticOrder S; S.init(M, D, F.G, F.bid);
        pg8::EpiStoreBf16 E{P_PROJ(F), D};
        pg8::gemm_phase<pg8::EpiStoreBf16, pg8::StaticOrder, true, true>(F.lds, g, S, E); REPSYNC(7);
    } SEAM(7);
    if (IN(8)) { REP(8) { p8_phase(F); REPSYNC(8); } } SEAM(8);
    if (IN(9)) { p9u_phase(F); } SEAM(9);
    if (IN(10)) { p9w_phase(F); } SEAM(10);
    if (IN(11)) { p9v_phase(F); }
    if (PROBE_STAMP >= 0) {
        __syncthreads(); STAMP(12); VM_WAIT(); __syncthreads();
        if (F.bid == 0 && F.tid == 0) { const unsigned long long* ts = (const unsigned long long*)(P_ws(F) + WS_CTL + 64);
            const float us = (float)(ts[PROBE_STAMP + 1] - ts[PROBE_STAMP]) * 0.01f; P_out(F)[0] += us * (1.0f / PROBE_DIV); }
    }
#undef IN
#undef SEAM
}

extern "C" void kernel_launch(void* const* d_in, const int* in_sizes, int n_in, void* d_out, int out_size, void* d_ws, size_t ws_size, hipStream_t stream) {
    static int grid = 0;
    if (grid == 0) {
        if (n_in != 25 || in_sizes[0] != M * D || out_size != M * D || ws_size < WS_END) {
            fprintf(stderr, "kernel_launch: built for 25 inputs, x/out of %d floats, >= %zu bytes of workspace; got n_in %d, in0 %d, out %d, ws %zu; nothing launched\n", M * D, (size_t)WS_END, n_in, n_in > 0 ? in_sizes[0] : -1, out_size, ws_size);
            grid = -1; return; }
        int dev = 0, cus = 0, per_cu = 0;
        if (hipGetDevice(&dev) != hipSuccess || hipDeviceGetAttribute(&cus, hipDeviceAttributeMultiprocessorCount, dev) != hipSuccess) { fprintf(stderr, "kernel_launch: device query failed\n"); grid = -1; return; }
        if (hipFuncSetAttribute((const void*)hymba_fwd, hipFuncAttributeMaxDynamicSharedMemorySize, LDS_BYTES) != hipSuccess) { fprintf(stderr, "kernel_launch: hipFuncSetAttribute failed\n"); grid = -1; return; }
        if (hipOccupancyMaxActiveBlocksPerMultiprocessor(&per_cu, (const void*)hymba_fwd, NWAVES * 64, LDS_BYTES) != hipSuccess || per_cu < 1) {
            fprintf(stderr, "kernel_launch: occupancy query reports %d workgroups per CU; need 1\n", per_cu); (void)hipGetLastError(); grid = -1; return; }
        grid = cus;
        if (grid % 8 != 0 || (M / 64) % (grid / 8 * NWAVES) != 0) { fprintf(stderr, "kernel_launch: grid %d not supported (needs a multiple of 8 dividing the token blocks)\n", grid); grid = -1; return; }
    }
    if (grid < 0) return;
    if (hipMemsetAsync((char*)d_ws + WS_CTL, 0, CTL_ZERO_BYTES, stream) != hipSuccess) { fprintf(stderr, "kernel_launch: memset failed\n"); return; }
    Args a{};
    for (int i = 0; i < 25; ++i) a.in[i] = d_in[i];
    a.out = (float*)d_out; a.ws = (unsigned char*)d_ws;
    if (N_LAUNCHES == 1) {
        a.ph_lo = 0; a.ph_hi = N_PHASES;
        void* kargs[] = {&a};
        const hipError_t le = hipLaunchCooperativeKernel((const void*)hymba_fwd, dim3(grid), dim3(NWAVES * 64), kargs, LDS_BYTES, stream);
        if (le != hipSuccess) fprintf(stderr, "kernel_launch: cooperative launch failed: %s (grid %d)\n", hipGetErrorName(le), grid);
    } else {
#ifndef PROBE_TWICE
#define PROBE_TWICE 0
#endif
        for (int li = 0; li < N_PHASES; ++li) { a.ph_lo = li; a.ph_hi = li + 1;
            if ((PROBE_TWICE >> li) & 1) hipLaunchKernelGGL(hymba_fwd, dim3(grid), dim3(NWAVES * 64), LDS_BYTES, stream, a);
            hipLaunchKernelGGL(hymba_fwd, dim3(grid), dim3(NWAVES * 64), LDS_BYTES, stream, a);
            const hipError_t le = hipPeekAtLastError();
            if (le != hipSuccess) { fprintf(stderr, "kernel_launch: launch %d failed: %s\n", li, hipGetErrorName(le)); break; } }
    }
}
```

```cpp
#include <hip/hip_runtime.h>
#include <cstdio>
#include <cstdint>
namespace pg8 {
#define PG8_LAS __attribute__((address_space(3)))
typedef unsigned short bf16_t;
typedef short bf16x8 __attribute__((ext_vector_type(8)));
typedef float f32x4 __attribute__((ext_vector_type(4)));
typedef unsigned u32x4 __attribute__((ext_vector_type(4)));
constexpr int BM = 256, BK = 64, HALF = 128, HTB = HALF * BK * 2  , STAGE_BYTES = 8 * HTB, NXCD = 8, WGM = 8;

__host__ __device__ __forceinline__ int lds_byte(int r, int c) { const int st = (r >> 4) * 2 + (c >> 5), rr = r & 15, cc = c & 31, ob = rr * 64 + cc * 2; return st * 1024 + (ob ^ (((ob >> 9) & 1) << 5)); }
__host__ __device__ __forceinline__ void stage_rc(int b, int& R, int& C) { const int st = b / 1024, sb = b % 1024, swz = sb ^ (((sb >> 9) & 1) << 5); R = (st >> 1) * 16 + swz / 64; C = (st & 1) * 32 + (swz % 64) / 2; }
__host__ __device__ __forceinline__ int perm32(int rho) { const int n = rho >> 4, i = rho & 15; return 8 * (i >> 2) + 4 * n + (i & 3); }

struct Unit { int pm, pn; };
struct Gemm { const bf16_t* A; const bf16_t* Bt; int M, N, K; };

struct StaticOrder {
    int nM, nN, nwg, G, c;
    __host__ __device__ void init(int M, int N, int G_, int c_) { nM = M / BM; nN = N / BM; nwg = nM * nN; G = G_; c = c_; }
    __host__ __device__ bool next(int i, Unit& u) const {
        const long L = (long)i * G + c; if (L >= nwg) return false;
        int wgid = (int)L; { const int q = nwg / NXCD, r = nwg % NXCD, xcd = wgid % NXCD, off = wgid / NXCD; wgid = (xcd < r ? xcd * (q + 1) : r * (q + 1) + (xcd - r) * q) + off; }
        const int nig = WGM * nN, gid = wgid / nig, fm = gid * WGM, gsz = (nM - fm) < WGM ? (nM - fm) : WGM;
        u.pm = fm + ((wgid % nig) % gsz); u.pn = (wgid % nig) / gsz; return true;
    }
    __device__ __forceinline__ void a_ready(const Unit&) const {}
    __device__ __forceinline__ void done(const Unit&) const {}
};

__device__ __forceinline__ unsigned cvt_pk_bf16(float lo, float hi) { unsigned r; asm volatile("v_cvt_pk_bf16_f32 %0, %1, %2" : "=v"(r) : "v"(lo), "v"(hi)); return r; }
struct EpiStoreBf16 {
    static constexpr bool PERM = true, AFTER_DRAIN = false;
    bf16_t* O; int ldc;
    __device__ __forceinline__ void operator()(const f32x4 (&acc)[2][2][4][2], const Unit& u, int wr, int wc, int fr, int fq) const {
        const int row0 = u.pm * BM + wr * 64 + fr; const int col0 = u.pn * BM + wc * 32 + 8 * fq;
#pragma unroll
        for (int ai = 0; ai < 2; ++ai)
#pragma unroll
            for (int m = 0; m < 4; ++m) { bf16_t* rowp = O + (size_t)(row0 + ai * HALF + m * 16) * ldc + col0;
#pragma unroll
                for (int bj = 0; bj < 2; ++bj) { const f32x4 v0 = acc[ai][bj][m][0], v1 = acc[ai][bj][m][1];
                    u32x4 w; w.x = cvt_pk_bf16(v0[0], v0[1]); w.y = cvt_pk_bf16(v0[2], v0[3]); w.z = cvt_pk_bf16(v1[0], v1[1]); w.w = cvt_pk_bf16(v1[2], v1[3]);
                    *(u32x4*)(rowp + bj * HALF) = w; } }
    }
};
struct EpiGateBf16 {
    static constexpr bool PERM = true, AFTER_DRAIN = false;
    bf16_t* out; int ldc; const float* gate; int gstride; int rows_per_batch;
    __device__ __forceinline__ void operator()(const f32x4 (&acc)[2][2][4][2], const Unit& u, int wr, int wc, int fr, int fq) const {
        const int b = (u.pm * BM) / rows_per_batch; const float* g = gate + (size_t)b * gstride;
        const int col0 = u.pn * BM + wc * 32 + 8 * fq;
        f32x4 gv[2][2];
#pragma unroll
        for (int bj = 0; bj < 2; ++bj)
#pragma unroll
            for (int n = 0; n < 2; ++n) gv[bj][n] = *(const f32x4*)(g + col0 + bj * HALF + n * 4);
#pragma unroll
        for (int ai = 0; ai < 2; ++ai)
#pragma unroll
            for (int m = 0; m < 4; ++m) { bf16_t* rowp = out + (size_t)(u.pm * BM + ai * HALF + wr * 64 + m * 16 + fr) * ldc + col0;
#pragma unroll
                for (int bj = 0; bj < 2; ++bj) { const f32x4 v0 = gv[bj][0] * acc[ai][bj][m][0], v1 = gv[bj][1] * acc[ai][bj][m][1];
                    u32x4 w; w.x = cvt_pk_bf16(v0[0], v0[1]); w.y = cvt_pk_bf16(v0[2], v0[3]); w.z = cvt_pk_bf16(v1[0], v1[1]); w.w = cvt_pk_bf16(v1[2], v1[3]);
                    *(u32x4*)(rowp + bj * HALF) = w; } }
    }
};

template <class Epi, class Sched, bool ALIGN_EPI = false, bool SP2 = false>
__device__ __forceinline__ void gemm_phase(PG8_LAS unsigned char* lds, const Gemm g, const Sched& S, const Epi& E) {
    const int tid = threadIdx.x, wid = __builtin_amdgcn_readfirstlane(tid >> 6), lane = tid & 63, wr = wid >> 2, wc = wid & 3, fr = lane & 15, fq = lane >> 4;
    const int K = g.K, nt = K / BK;
    unsigned voffA[2], voffB[2];
#pragma unroll
    for (int i = 0; i < 2; ++i) { int R, C; stage_rc(tid * 16 + i * 8192, R, C); const int Rb = Epi::PERM ? ((R & ~31) + perm32(R & 31)) : R;
        voffA[i] = (unsigned)(R * K + C) * 2u; voffB[i] = (unsigned)(Rb * K + C) * 2u; }
    const size_t kstep = (size_t)(BK * 2);
    const size_t hstep = (size_t)HALF * K * 2;
    const size_t tstep = 2 * hstep;
    const unsigned ldsw = (unsigned)wid * 1024u;
    const int aoff = lds_byte(wr * 64 + fr, fq * 8), boff = lds_byte(wc * 32 + fr, fq * 8);
#define PG8_SA(b, h) (((b) * 2 + (h)) * HTB)
#define PG8_SB(b, h) ((4 + (b) * 2 + (h)) * HTB)
#define PG8_STAGE(bufoff, gbase, voff) do { _Pragma("unroll") for (int _i = 0; _i < 2; ++_i) \
        __builtin_amdgcn_global_load_lds((const unsigned*)((const char*)(gbase) + (voff)[_i]), (PG8_LAS unsigned*)(lds + (bufoff) + ldsw + _i * 8192), 16, 0, 0); } while (0)
#define PG8_LDA(dst, b, h) do { _Pragma("unroll") for (int m = 0; m < 4; ++m) _Pragma("unroll") for (int k = 0; k < 2; ++k) dst[m][k] = *(const PG8_LAS bf16x8*)(lds + PG8_SA(b, h) + aoff + m * 2048 + k * 1024); } while (0)
#define PG8_LDB(dst, b, h) do { _Pragma("unroll") for (int n = 0; n < 2; ++n) _Pragma("unroll") for (int k = 0; k < 2; ++k) dst[n][k] = *(const PG8_LAS bf16x8*)(lds + PG8_SB(b, h) + boff + n * 2048 + k * 1024); } while (0)
#define PG8_MMA(ai, bj, At, Bt) do { __builtin_amdgcn_s_setprio(1); _Pragma("unroll") for (int m = 0; m < 4; ++m) _Pragma("unroll") for (int n = 0; n < 2; ++n) _Pragma("unroll") for (int k = 0; k < 2; ++k) \
        acc[ai][bj][m][n] = __builtin_amdgcn_mfma_f32_16x16x32_bf16(Bt[n][k], At[m][k], acc[ai][bj][m][n], 0, 0, 0); __builtin_amdgcn_s_setprio(0); } while (0)
#define PG8_WAIT_V(n) asm volatile("s_waitcnt vmcnt(" #n ")" ::: "memory")
#define PG8_WAIT_L(n) asm volatile("s_waitcnt lgkmcnt(" #n ")" ::: "memory")
#define PG8_BAR __builtin_amdgcn_s_barrier()
#define PG8_SCHED __builtin_amdgcn_sched_barrier(0)
    Unit cur, nxt; int ui = 0;
    if (!S.next(0, cur)) return;
    f32x4 acc[2][2][4][2];
#pragma unroll
    for (int a = 0; a < 2; ++a)
#pragma unroll
        for (int b = 0; b < 2; ++b)
#pragma unroll
            for (int m = 0; m < 4; ++m)
#pragma unroll
                for (int n = 0; n < 2; ++n) acc[a][b][m][n] = (f32x4){0.f, 0.f, 0.f, 0.f};
    bf16x8 At[4][2], B0[2][2], B1[2][2];
    const char* cA = (const char*)g.A + (size_t)cur.pm * tstep; const char* cB = (const char*)g.Bt + (size_t)cur.pn * tstep;
    S.a_ready(cur);
    if constexpr (SP2) {
        PG8_STAGE(PG8_SB(0, 0), cB, voffB); PG8_STAGE(PG8_SB(0, 1), cB + hstep, voffB); PG8_STAGE(PG8_SA(0, 0), cA, voffA); PG8_STAGE(PG8_SA(0, 1), cA + hstep, voffA);
        if (wr == 1) PG8_BAR;
        PG8_WAIT_V(2); PG8_BAR;
        PG8_STAGE(PG8_SB(1, 0), cB + kstep, voffB); PG8_STAGE(PG8_SA(1, 0), cA + kstep, voffA); PG8_STAGE(PG8_SB(1, 1), cB + hstep + kstep, voffB);
        PG8_WAIT_V(6); PG8_BAR;
    } else {
        PG8_STAGE(PG8_SB(0, 0), cB, voffB); PG8_STAGE(PG8_SA(0, 0), cA, voffA); PG8_STAGE(PG8_SB(0, 1), cB + hstep, voffB); PG8_STAGE(PG8_SA(0, 1), cA + hstep, voffA);
        if (wr == 1) PG8_BAR;
        PG8_WAIT_V(4); PG8_BAR;
        PG8_STAGE(PG8_SB(1, 0), cB + kstep, voffB); PG8_STAGE(PG8_SA(1, 0), cA + kstep, voffA); PG8_STAGE(PG8_SB(1, 1), cB + hstep + kstep, voffB);
        PG8_WAIT_V(6); PG8_BAR;
    }
    for (;;) {
        const bool has_next = S.next(ui + 1, nxt);
        const char* nA = has_next ? (const char*)g.A + (size_t)nxt.pm * tstep : cA; const char* nB = has_next ? (const char*)g.Bt + (size_t)nxt.pn * tstep : cB;
        for (int t = 0; t < nt; t += 2) {
            const bool last = (t == nt - 2);
            const char* a1 = cA + (size_t)(t + 1) * kstep;
            const char* a2 = last ? nA : cA + (size_t)(t + 2) * kstep; const char* b2 = last ? nB : cB + (size_t)(t + 2) * kstep;
            const char* a3 = a2 + kstep; const char* b3 = b2 + kstep;
            if (last && has_next) S.a_ready(nxt);
            if constexpr (SP2) {
            PG8_LDB(B0, 0, 0); PG8_LDB(B1, 0, 1); PG8_SCHED; PG8_LDA(At, 0, 0); PG8_STAGE(PG8_SA(1, 1), a1 + hstep, voffA);
            PG8_WAIT_V(8); PG8_WAIT_L(0); PG8_BAR; PG8_MMA(0, 0, At, B0); PG8_MMA(0, 1, At, B1); PG8_BAR; PG8_SCHED;
            PG8_LDA(At, 0, 1); PG8_STAGE(PG8_SB(0, 0), b2, voffB); PG8_STAGE(PG8_SB(0, 1), b2 + hstep, voffB); PG8_STAGE(PG8_SA(0, 0), a2, voffA);
            PG8_WAIT_V(8); PG8_WAIT_L(0); PG8_BAR; PG8_MMA(1, 0, At, B0); PG8_MMA(1, 1, At, B1); PG8_BAR; PG8_SCHED;
            PG8_LDB(B0, 1, 0); PG8_LDB(B1, 1, 1); PG8_SCHED; PG8_LDA(At, 1, 0); PG8_STAGE(PG8_SA(0, 1), a2 + hstep, voffA);
            PG8_WAIT_V(8); PG8_WAIT_L(0); PG8_BAR; PG8_MMA(0, 0, At, B0); PG8_MMA(0, 1, At, B1); PG8_BAR; PG8_SCHED;
            PG8_LDA(At, 1, 1); PG8_STAGE(PG8_SB(1, 0), b3, voffB); PG8_STAGE(PG8_SB(1, 1), b3 + hstep, voffB); PG8_STAGE(PG8_SA(1, 0), a3, voffA);
            PG8_WAIT_V(8); PG8_WAIT_L(0); PG8_BAR; PG8_MMA(1, 0, At, B0); PG8_MMA(1, 1, At, B1); PG8_BAR; PG8_SCHED;
            } else {
            PG8_LDB(B0, 0, 0); PG8_SCHED; PG8_LDA(At, 0, 0); PG8_STAGE(PG8_SA(1, 1), a1 + hstep, voffA);
            PG8_WAIT_L(8); PG8_BAR; PG8_WAIT_L(0); PG8_MMA(0, 0, At, B0); PG8_BAR; PG8_SCHED;
            PG8_LDB(B1, 0, 1); PG8_STAGE(PG8_SB(0, 0), b2, voffB);
            PG8_BAR; PG8_WAIT_L(0); PG8_MMA(0, 1, At, B1); PG8_BAR;
            PG8_LDA(At, 0, 1); PG8_STAGE(PG8_SA(0, 0), a2, voffA);
            PG8_BAR; PG8_WAIT_L(0); PG8_MMA(1, 0, At, B0); PG8_BAR; PG8_SCHED;
            PG8_STAGE(PG8_SB(0, 1), b2 + hstep, voffB);
            PG8_WAIT_V(6); PG8_BAR; PG8_MMA(1, 1, At, B1); PG8_BAR;
            PG8_LDB(B0, 1, 0); PG8_SCHED; PG8_LDA(At, 1, 0); PG8_STAGE(PG8_SA(0, 1), a2 + hstep, voffA);
            PG8_WAIT_L(8); PG8_BAR; PG8_WAIT_L(0); PG8_MMA(0, 0, At, B0); PG8_BAR; PG8_SCHED;
            PG8_LDB(B1, 1, 1); PG8_STAGE(PG8_SB(1, 0), b3, voffB);
            PG8_BAR; PG8_WAIT_L(0); PG8_MMA(0, 1, At, B1); PG8_BAR;
            PG8_LDA(At, 1, 1); PG8_STAGE(PG8_SA(1, 0), a3, voffA);
            PG8_BAR; PG8_WAIT_L(0); PG8_MMA(1, 0, At, B0); PG8_BAR; PG8_SCHED;
            PG8_STAGE(PG8_SB(1, 1), b3 + hstep, voffB);
            PG8_WAIT_V(6); PG8_BAR; PG8_MMA(1, 1, At, B1); PG8_BAR;
            }
        }
        if constexpr (ALIGN_EPI) { if (wr == 0) PG8_BAR; }
        if constexpr (!Epi::AFTER_DRAIN) { E(acc, cur, wr, wc, fr, fq); S.done(cur); }
        if (!has_next) break;
#pragma unroll
        for (int a = 0; a < 2; ++a)
#pragma unroll
            for (int b = 0; b < 2; ++b)
#pragma unroll
                for (int m = 0; m < 4; ++m)
#pragma unroll
                    for (int n = 0; n < 2; ++n) acc[a][b][m][n] = (f32x4){0.f, 0.f, 0.f, 0.f};
        cur = nxt; cA = nA; cB = nB; ++ui;
        if constexpr (ALIGN_EPI) { if (wr == 1) PG8_BAR; }
    }
    PG8_WAIT_V(0);
    if constexpr (!ALIGN_EPI) { if (wr == 0) PG8_BAR; }
    PG8_BAR;
    if constexpr (Epi::AFTER_DRAIN) { E.fused(acc, cur, wr, wc, fr, fq, lds, wid, lane); S.done(cur); }
#undef PG8_SA
#undef PG8_SB
#undef PG8_STAGE
#undef PG8_LDA
#undef PG8_LDB
#undef PG8_MMA
#undef PG8_WAIT_V
#undef PG8_WAIT_L
#undef PG8_BAR
#undef PG8_SCHED
}
}

constexpr int NWAVES = 8;
#ifndef MK_N_LAUNCHES
#define MK_N_LAUNCHES 1
#endif
constexpr int N_PHASES = 12;
constexpr int N_LAUNCHES = MK_N_LAUNCHES;

constexpr int BATCH = 4, SEQ = 4096, D = 2048, M = BATCH * SEQ;
constexpr int LRU_W = 1024, LRU_HEADS = 8, LRU_BLK = 128;
constexpr int HD = 64, HQ = 16, HKV = 2, GRP = 8;
constexpr int MIX_IN = 3328;
constexpr int C_Y = 1024, C_Q = 2048, C_K = 3072, C_V = 3200;
constexpr int ADA_W = 6 * D;
constexpr int PH = 8, PKEYS = 128, PHALF = 128, PTOPK = 16, NEXP = 16384;
constexpr float EPS = 1e-6f;

constexpr size_t MiB = 1u << 20;
constexpr size_t WS_CTL = 0, CTL_ZERO_BYTES = 64 * 1024;
constexpr size_t WS_ADA = 1 * MiB;
constexpr size_t WS_ROPE = 2 * MiB;
constexpr size_t WS_WIN = 4 * MiB;
constexpr size_t WS_WOUT = 17 * MiB;
constexpr size_t WS_WQ = 25 * MiB;
constexpr size_t WS_WGA = 33 * MiB;
constexpr size_t WS_WGX = 33 * MiB + 256 * 1024;
constexpr size_t WS_SK = 33 * MiB + 512 * 1024;
constexpr size_t WS_IDX = 34 * MiB;
constexpr size_t WS_GW = 42 * MiB;
constexpr size_t WS_U = 50 * MiB;
constexpr size_t WS_V = 82 * MiB;
constexpr size_t WS_USC = 1 * MiB + 512 * 1024;
constexpr size_t WS_VSC = 1 * MiB + 768 * 1024;
constexpr size_t WS_X1B = 114 * MiB;
constexpr size_t WS_XH = 178 * MiB;
constexpr size_t WS_PROJ = 242 * MiB;
constexpr size_t WS_HL = 346 * MiB;
constexpr size_t WS_PA = 410 * MiB;
constexpr size_t WS_PART = WS_HL;
constexpr size_t WS_W = WS_PROJ + 64 * MiB;
constexpr size_t WS_WSC = WS_PROJ + 68 * MiB;
constexpr size_t WS_END = 474 * MiB;
constexpr int CW_BAR = 4096;

constexpr int RING_BYTES = 131072;
constexpr int LDSCTL_OFF = RING_BYTES, MISC_OFF = LDSCTL_OFF + 320;
constexpr int LDS_BYTES = 147456;

#define GAS __attribute__((address_space(1)))
#define LAS __attribute__((address_space(3)))
typedef unsigned short bf16;
typedef unsigned v4u __attribute__((ext_vector_type(4)));
typedef unsigned v2u __attribute__((ext_vector_type(2)));
typedef float f32x4 __attribute__((ext_vector_type(4)));
typedef float f32x2 __attribute__((ext_vector_type(2)));
typedef float f32x16 __attribute__((ext_vector_type(16)));
typedef short bf16x8 __attribute__((ext_vector_type(8)));
typedef __bf16 bf16x2v __attribute__((ext_vector_type(2)));
#define LDS_WAIT() asm volatile("s_waitcnt lgkmcnt(0)" ::: "memory")
#define VM_WAIT() asm volatile("s_waitcnt vmcnt(0)" ::: "memory")
__device__ __forceinline__ unsigned f2bf(float f) { unsigned u = __builtin_bit_cast(unsigned, f); return (u + 0x7fffu + ((u >> 16) & 1u)) >> 16; }
__device__ __forceinline__ unsigned pk2(float lo, float hi) { return f2bf(lo) | (f2bf(hi) << 16); }
__device__ __forceinline__ float bflo(unsigned u) { return __builtin_bit_cast(float, u << 16); }
__device__ __forceinline__ float bfhi(unsigned u) { return __builtin_bit_cast(float, u & 0xffff0000u); }
__device__ __forceinline__ float bf1(bf16 h) { return __builtin_bit_cast(float, (unsigned)h << 16); }
__device__ __forceinline__ float dot2bf(unsigned a, unsigned b, float acc) { return __builtin_amdgcn_fdot2_f32_bf16(__builtin_bit_cast(bf16x2v, a), __builtin_bit_cast(bf16x2v, b), acc, false); }
__device__ __forceinline__ float sigmoidf_(float x) { return 1.0f / (1.0f + __expf(-x)); }
__device__ __forceinline__ float gelu_tanh(float x) {
    const float z = 1.5957691216057308f * (x + 0.044715f * x * x * x);
    return x / (1.0f + __expf(-z));
}
__device__ __forceinline__ float wave_sum(float v) {
#pragma unroll
    for (int o = 1; o < 64; o <<= 1) v += __shfl_xor(v, o);
    return v;
}

#define XB_TMO      128
#define XB_XCNT(j)  (256  + 64 * (j))
#define XB_XSUB(j)  (1280 + 64 * (j))
#define XB_XGEN(j)  (2304 + 64 * (j))
#define XB_TOP      3328
#define XB_TOPGEN   3392
#define XCD_BAR_WORDS 3456
#define XB_SPIN_CAP (1u << 18)
__device__ __forceinline__ unsigned xb_ld(unsigned* p)              { return __hip_atomic_load(p, __ATOMIC_RELAXED, __HIP_MEMORY_SCOPE_AGENT); }
__device__ __forceinline__ unsigned xb_add(unsigned* p, unsigned v) { return __hip_atomic_fetch_add(p, v, __ATOMIC_RELAXED, __HIP_MEMORY_SCOPE_AGENT); }
__device__ __forceinline__ unsigned xb_xcc_id() { return (unsigned)__builtin_amdgcn_s_getreg((3 << 11) | 20) & 0xFu; }
#define XB_SPIN(cond, bar) do { unsigned _sp = 0; while (cond) { __builtin_amdgcn_s_sleep(1); \
    if ((++_sp & 255u) == 0u) { if (xb_ld(&(bar)[XB_TMO])) break; if (_sp > XB_SPIN_CAP) { atomicAdd(&(bar)[XB_TMO], 1u); break; } } } } while (0)
struct XcdBarrier { unsigned* bar; unsigned x; volatile LAS unsigned* st; };
__device__ __forceinline__ XcdBarrier xcd_barrier_post(unsigned* bar, volatile LAS unsigned* st) {
    XcdBarrier b; b.bar = bar; b.x = xb_xcc_id(); b.st = st;
    if (threadIdx.x == 0) (void)xb_add(&bar[XB_XCNT(b.x)], 1u);
    return b;
}
__device__ __forceinline__ void xcd_barrier_complete(unsigned* bar, unsigned x, unsigned& nloc, unsigned& nx) {
    const unsigned G = gridDim.x * gridDim.y * gridDim.z;
    unsigned sum, cnt, mine, sp = 0u;
    for (;;) {
        sum = 0u; cnt = 0u; mine = 0u;
#pragma unroll
        for (unsigned j = 0; j < 16; ++j) { const unsigned c = xb_ld(&bar[XB_XCNT(j)]); sum += c; cnt += (c > 0u) ? 1u : 0u; mine = (j == x) ? c : mine; }
        if (sum == G) break;
        __builtin_amdgcn_s_sleep(1);
        if ((++sp & 255u) == 0u) { if (xb_ld(&bar[XB_TMO])) break; if (sp > XB_SPIN_CAP) { atomicAdd(&bar[XB_TMO], 1u); break; } }
    }
    nloc = mine > 0u ? mine : 1u; nx = cnt > 0u ? cnt : 1u;
}
__device__ __forceinline__ void xcd_barrier(const XcdBarrier& b) {
    asm volatile("s_waitcnt vmcnt(0)" ::: "memory");
    __syncthreads();
    if (threadIdx.x == 0) {
        unsigned* bar = b.bar;
        __builtin_amdgcn_s_waitcnt(0);
        unsigned nloc = b.st[0], nx = b.st[1];
        if (nloc == 0u) { xcd_barrier_complete(bar, b.x, nloc, nx); b.st[0] = nloc; b.st[1] = nx; }
        const unsigned old = xb_add(&bar[XB_XSUB(b.x)], 1u);
        const unsigned gen = old / nloc;
        if (old + 1u == (gen + 1u) * nloc) {
            __builtin_amdgcn_fence(__ATOMIC_RELEASE, "agent");
            asm volatile("s_waitcnt vmcnt(0)" ::: "memory");
            const unsigned og = xb_add(&bar[XB_TOP], 1u);
            const unsigned tg = og / nx;
            if (og + 1u == (tg + 1u) * nx) xb_add(&bar[XB_TOPGEN], 1u);
            else XB_SPIN(xb_ld(&bar[XB_TOPGEN]) == tg, bar);
            __builtin_amdgcn_fence(__ATOMIC_ACQUIRE, "agent");
            xb_add(&bar[XB_XGEN(b.x)], 1u);
            asm volatile("s_waitcnt vmcnt(0)" ::: "memory");
        } else {
            XB_SPIN(xb_ld(&bar[XB_XGEN(b.x)]) == gen, bar);
            __builtin_amdgcn_fence(__ATOMIC_ACQUIRE, "agent");
            asm volatile("s_waitcnt vmcnt(0)" ::: "memory");
        }
    }
    __syncthreads();
}

typedef const __attribute__((address_space(4))) unsigned char* kaptr_t;
struct Frame { LAS unsigned char* lds; int tid, lane, wave, G, bid; kaptr_t ka; };
template <class T> __device__ __forceinline__ T* ka_ptr(const Frame& F, int byte_off) { typedef T* tp; return *(const __attribute__((address_space(4))) tp*)(F.ka + byte_off); }
__device__ __forceinline__ const float* P_x(const Frame& F) { return ka_ptr<const float>(F, 0); }
__device__ __forceinline__ const float* P_c(const Frame& F) { return ka_ptr<const float>(F, 8); }
__device__ __forceinline__ const int* P_pos(const Frame& F) { return ka_ptr<const int>(F, 16); }
__device__ __forceinline__ const float* P_w_ada(const Frame& F) { return ka_ptr<const float>(F, 24); }
__device__ __forceinline__ const float* P_b_ada(const Frame& F) { return ka_ptr<const float>(F, 32); }
__device__ __forceinline__ const float* P_norm1_g(const Frame& F) { return ka_ptr<const float>(F, 40); }
__device__ __forceinline__ const float* P_w_in(const Frame& F) { return ka_ptr<const float>(F, 48); }
__device__ __forceinline__ const float* P_conv_w(const Frame& F) { return ka_ptr<const float>(F, 56); }
__device__ __forceinline__ const float* P_conv_b(const Frame& F) { return ka_ptr<const float>(F, 64); }
__device__ __forceinline__ const float* P_ga_w(const Frame& F) { return ka_ptr<const float>(F, 72); }
__device__ __forceinline__ const float* P_ga_b(const Frame& F) { return ka_ptr<const float>(F, 80); }
__device__ __forceinline__ const float* P_gx_w(const Frame& F) { return ka_ptr<const float>(F, 88); }
__device__ __forceinline__ const float* P_gx_b(const Frame& F) { return ka_ptr<const float>(F, 96); }
__device__ __forceinline__ const float* P_lam(const Frame& F) { return ka_ptr<const float>(F, 104); }
__device__ __forceinline__ const float* P_qn_g(const Frame& F) { return ka_ptr<const float>(F, 112); }
__device__ __forceinline__ const float* P_kn_g(const Frame& F) { return ka_ptr<const float>(F, 120); }
__device__ __forceinline__ const float* P_sinks(const Frame& F) { return ka_ptr<const float>(F, 128); }
__device__ __forceinline__ const float* P_on_lru_g(const Frame& F) { return ka_ptr<const float>(F, 136); }
__device__ __forceinline__ const float* P_on_attn_g(const Frame& F) { return ka_ptr<const float>(F, 144); }
__device__ __forceinline__ const float* P_w_out(const Frame& F) { return ka_ptr<const float>(F, 152); }
__device__ __forceinline__ const float* P_norm2_g(const Frame& F) { return ka_ptr<const float>(F, 160); }
__device__ __forceinline__ const float* P_w_pq(const Frame& F) { return ka_ptr<const float>(F, 168); }
__device__ __forceinline__ const float* P_sub_keys(const Frame& F) { return ka_ptr<const float>(F, 176); }
__device__ __forceinline__ const float* P_pu(const Frame& F) { return ka_ptr<const float>(F, 184); }
__device__ __forceinline__ const float* P_pv(const Frame& F) { return ka_ptr<const float>(F, 192); }
__device__ __forceinline__ float* P_out(const Frame& F) { return ka_ptr<float>(F, 200); }
__device__ __forceinline__ unsigned char* P_ws(const Frame& F) { return ka_ptr<unsigned char>(F, 208); }
__device__ __forceinline__ float* P_ADA(const Frame& F) { return (float*)(P_ws(F) + WS_ADA); }
__device__ __forceinline__ float* P_ROPE(const Frame& F) { return (float*)(P_ws(F) + WS_ROPE); }
__device__ __forceinline__ bf16* P_HL(const Frame& F) { return (bf16*)(P_ws(F) + WS_HL); }
__device__ __forceinline__ bf16* P_PA(const Frame& F) { return (bf16*)(P_ws(F) + WS_PA); }
__device__ __forceinline__ float* P_GW(const Frame& F) { return (float*)(P_ws(F) + WS_GW); }
__device__ __forceinline__ unsigned short* P_IDX(const Frame& F) { return (unsigned short*)(P_ws(F) + WS_IDX); }
__device__ __forceinline__ bf16* P_WIN(const Frame& F) { return (bf16*)(P_ws(F) + WS_WIN); }
__device__ __forceinline__ bf16* P_WOUT(const Frame& F) { return (bf16*)(P_ws(F) + WS_WOUT); }
__device__ __forceinline__ bf16* P_WQ(const Frame& F) { return (bf16*)(P_ws(F) + WS_WQ); }
__device__ __forceinline__ bf16* P_WGA(const Frame& F) { return (bf16*)(P_ws(F) + WS_WGA); }
__device__ __forceinline__ bf16* P_WGX(const Frame& F) { return (bf16*)(P_ws(F) + WS_WGX); }
__device__ __forceinline__ bf16* P_SK(const Frame& F) { return (bf16*)(P_ws(F) + WS_SK); }
__device__ __forceinline__ unsigned char* P_U(const Frame& F) { return (unsigned char*)(P_ws(F) + WS_U); }
__device__ __forceinline__ bf16* P_X1B(const Frame& F) { return (bf16*)(P_ws(F) + WS_X1B); }
__device__ __forceinline__ unsigned* P_PART(const Frame& F) { return (unsigned*)(P_ws(F) + WS_PART); }
__device__ __forceinline__ unsigned char* P_W(const Frame& F) { return (unsigned char*)(P_ws(F) + WS_W); }
__device__ __forceinline__ float* P_WSC(const Frame& F) { return (float*)(P_ws(F) + WS_WSC); }
__device__ __forceinline__ float* P_USC(const Frame& F) { return (float*)(P_ws(F) + WS_USC); }
__device__ __forceinline__ float* P_VSC(const Frame& F) { return (float*)(P_ws(F) + WS_VSC); }
__device__ __forceinline__ unsigned char* P_V(const Frame& F) { return (unsigned char*)(P_ws(F) + WS_V); }
__device__ __forceinline__ bf16* P_XH(const Frame& F) { return (bf16*)(P_ws(F) + WS_XH); }
__device__ __forceinline__ bf16* P_PROJ(const Frame& F) { return (bf16*)(P_ws(F) + WS_PROJ); }

__device__ __forceinline__ void p0_transpose_item(const float* W, int K, int N, bf16* WT, LAS float* scr, int item, int lane) {
    const int nblk = N / 32, kb = item / nblk, nb = item % nblk, k0 = 64 * kb, n0 = 32 * nb;
#pragma unroll 8
    for (int i = 0; i < 32; ++i) { const int kk = 2 * i + (lane >> 5); scr[kk * 33 + (lane & 31)] = W[(size_t)(k0 + kk) * N + n0 + (lane & 31)]; }
    LDS_WAIT(); asm volatile("" ::: "memory");
    const int c = lane & 7;
#pragma unroll
    for (int j = 0; j < 4; ++j) { const int n = (lane >> 3) + 8 * j; const LAS float* s = scr + (8 * c) * 33 + n;
        v4u o; o.x = pk2(s[0 * 33], s[1 * 33]); o.y = pk2(s[2 * 33], s[3 * 33]); o.z = pk2(s[4 * 33], s[5 * 33]); o.w = pk2(s[6 * 33], s[7 * 33]);
        *(v4u*)(WT + (size_t)(n0 + n) * K + k0 + 8 * c) = o; }
    LDS_WAIT(); asm volatile("" ::: "memory");
}
__device__ __forceinline__ void p0_convert(const float* src, bf16* dst, size_t n8, size_t gtid, size_t gthreads) {
    for (size_t i = gtid; i < n8; i += gthreads) {
        const f32x4 a = *(const f32x4*)(src + 8 * i), b = *(const f32x4*)(src + 8 * i + 4);
        v4u o; o.x = pk2(a.x, a.y); o.y = pk2(a.z, a.w); o.z = pk2(b.x, b.y); o.w = pk2(b.z, b.w);
        *(v4u*)(dst + 8 * i) = o;
    }
}
#ifndef QUANT_SPLIT
#define QUANT_SPLIT 14336
#endif
__device__ __forceinline__ void quant_rows(Frame& F, int r0, int r1, int w, int nw) {
    for (int rr = r0 + w; rr < r1; rr += nw) {
        const int tbl = rr >= NEXP, row = rr - tbl * NEXP;
        const float* srcp = (tbl ? P_pv(F) : P_pu(F)) + (size_t)row * D;
        unsigned char* dstp = (tbl ? P_V(F) : P_U(F)) + (size_t)row * 128 + (size_t)(F.lane >> 5) * (NEXP * 128) + ((4 * F.lane) & 127);
        f32x4 v[8]; float mx = 0.f;
#pragma unroll
        for (int j = 0; j < 8; ++j) { v[j] = *(const f32x4*)(srcp + 4 * F.lane + 256 * j);
            mx = fmaxf(fmaxf(mx, fmaxf(fabsf(v[j].x), fabsf(v[j].y))), fmaxf(fabsf(v[j].z), fabsf(v[j].w))); }
#pragma unroll
        for (int o = 1; o < 64; o <<= 1) mx = fmaxf(mx, __shfl_xor(mx, o));
        const float s = fmaxf(mx, 1e-30f) * (1.0f / 224.0f), inv = 1.0f / s;
#pragma unroll
        for (int j = 0; j < 8; ++j) { int t = __builtin_amdgcn_cvt_pk_fp8_f32(v[j].x * inv, v[j].y * inv, 0, false);
            t = __builtin_amdgcn_cvt_pk_fp8_f32(v[j].z * inv, v[j].w * inv, t, true);
            *(int*)(dstp + (size_t)(2 * j) * (NEXP * 128)) = t; }
        if (F.lane == 0) (tbl ? P_VSC(F) : P_USC(F))[row] = s;
    }
}
__device__ __forceinline__ void p0_prologue(Frame& F) {
    {
        LAS float* sc = (LAS float*)F.lds;
        LAS float* red = sc + 4 * D;
        for (int i = F.tid; i < 4 * D; i += 512) { const float v = P_c(F)[i]; sc[i] = v / (1.0f + __expf(-v)); }
        __syncthreads();
        for (int cg = F.bid; cg < ADA_W / 64; cg += F.G) {
            const int n0 = cg * 64, k0 = F.wave * 256;
            const float* wp = P_w_ada(F) + (size_t)k0 * ADA_W + n0 + F.lane;
            float a0 = 0.f, a1 = 0.f, a2 = 0.f, a3 = 0.f;
#pragma unroll 16
            for (int k = 0; k < 256; ++k) { const float w = wp[(size_t)k * ADA_W]; const int kk = k0 + k;
                a0 += sc[kk] * w; a1 += sc[D + kk] * w; a2 += sc[2 * D + kk] * w; a3 += sc[3 * D + kk] * w; }
            red[(F.wave * 4 + 0) * 64 + F.lane] = a0; red[(F.wave * 4 + 1) * 64 + F.lane] = a1;
            red[(F.wave * 4 + 2) * 64 + F.lane] = a2; red[(F.wave * 4 + 3) * 64 + F.lane] = a3;
            __syncthreads();
            if (F.tid < 256) { const int b = F.tid >> 6, l = F.tid & 63; float s = 0.f;
#pragma unroll
                for (int w = 0; w < 8; ++w) s += red[(w * 4 + b) * 64 + l];
                P_ADA(F)[(size_t)b * ADA_W + n0 + l] = s + P_b_ada(F)[n0 + l]; }
            __syncthreads();
        }
        __syncthreads();
    }
    {
        LAS float* scr = (LAS float*)(F.lds + F.wave * 16384);
        const int gw = F.bid * NWAVES + F.wave, NGW = F.G * NWAVES;
        constexpr int I_IN = (D / 64) * (MIX_IN / 32), I_SQ = (D / 64) * (D / 32), I_G = (LRU_BLK / 64) * (LRU_BLK / 32);
        constexpr int NITEMS = I_IN + 2 * I_SQ + 16 * I_G;
        for (int it = gw; it < NITEMS; it += NGW) {
            int r = it;
            if (r < I_IN) { p0_transpose_item(P_w_in(F), D, MIX_IN, P_WIN(F), scr, r, F.lane); continue; } r -= I_IN;
            if (r < I_SQ) { p0_transpose_item(P_w_out(F), D, D, P_WOUT(F), scr, r, F.lane); continue; } r -= I_SQ;
            if (r < I_SQ) { p0_transpose_item(P_w_pq(F), D, D, P_WQ(F), scr, r, F.lane); continue; } r -= I_SQ;
            const int g = r / I_G, ri = r % I_G, hd = g & 7;
            if (g < 8) p0_transpose_item(P_ga_w(F) + (size_t)hd * 16384, LRU_BLK, LRU_BLK, P_WGA(F) + (size_t)hd * 16384, scr, ri, F.lane);
            else       p0_transpose_item(P_gx_w(F) + (size_t)hd * 16384, LRU_BLK, LRU_BLK, P_WGX(F) + (size_t)hd * 16384, scr, ri, F.lane);
        }
    }
    {
        const size_t gtid = (size_t)F.bid * 512 + F.tid, gth = (size_t)F.G * 512;
        p0_convert(P_sub_keys(F), P_SK(F), (size_t)PH * 2 * PKEYS * PHALF / 8, gtid, gth);
    }
    quant_rows(F, 0, QUANT_SPLIT, F.bid * NWAVES + F.wave, F.G * NWAVES);
}

template <bool RESID, int R> __device__ __forceinline__ void modnorm_rows(const float* xin, const float* gain, const float* shift, const float* scale, bf16* orow, int lane, bf16* xin2 = nullptr) {
    f32x4 v[R][8]; float s[R];
#pragma unroll
    for (int r = 0; r < R; ++r) { s[r] = 0.f;
#pragma unroll
        for (int j = 0; j < 8; ++j) {
            v[r][j] = *(const f32x4*)(xin + (size_t)r * D + 4 * lane + 256 * j);
            if (RESID) { bf16* dp = xin2 + (size_t)r * D + 4 * lane + 256 * j; const v2u q = *(const v2u*)dp; v[r][j] += (f32x4){bflo(q.x), bfhi(q.x), bflo(q.y), bfhi(q.y)};
                v2u o; o.x = pk2(v[r][j].x, v[r][j].y); o.y = pk2(v[r][j].z, v[r][j].w); *(v2u*)dp = o; } } }
#pragma unroll
    for (int r = 0; r < R; ++r)
#pragma unroll
        for (int j = 0; j < 8; ++j) s[r] += (v[r][j].x * v[r][j].x + v[r][j].y * v[r][j].y) + (v[r][j].z * v[r][j].z + v[r][j].w * v[r][j].w);
#pragma unroll
    for (int o = 1; o < 64; o <<= 1) {
#pragma unroll
        for (int r = 0; r < R; ++r) s[r] += __shfl_xor(s[r], o); }
    float rstd[R];
#pragma unroll
    for (int r = 0; r < R; ++r) rstd[r] = 1.0f / sqrtf(s[r] * (1.0f / D) + EPS);
#pragma unroll
    for (int j = 0; j < 8; ++j) {
        const int c = 4 * lane + 256 * j;
        const f32x4 g = *(const f32x4*)(gain + c), sh = *(const f32x4*)(shift + c), sc = *(const f32x4*)(scale + c);
        const f32x4 gm = g * (sc + 1.0f);
#pragma unroll
        for (int r = 0; r < R; ++r) { const f32x4 y = (v[r][j] * rstd[r]) * gm + sh;
            v2u o; o.x = pk2(y.x, y.y); o.y = pk2(y.z, y.w);
            *(v2u*)(orow + (size_t)r * D + c) = o; }
    }
}
__device__ __forceinline__ void p1_phase(Frame& F) {
    const int gw = F.bid * NWAVES + F.wave, NGW = F.G * NWAVES;
    for (int m = 4 * gw; m < M; m += 4 * NGW) { const int b = m / SEQ; const float* ada = P_ADA(F) + (size_t)b * ADA_W;
        modnorm_rows<false, 4>(P_x(F) + (size_t)m * D, P_norm1_g(F), ada, ada + D, P_XH(F) + (size_t)m * D, F.lane); }
    const float invf[8] = {1.0f, 1.9392274e-01f, 3.7606031e-02f, 7.2926646e-03f, 1.4142136e-03f, 2.7424819e-04f, 5.3182961e-05f, 1.0313386e-05f};
    for (int i = F.bid * 512 + F.tid; i < M * 8; i += F.G * 512) { const int m = i >> 3, k = i & 7;
        float f = invf[0];
#pragma unroll
        for (int q = 1; q < 8; ++q) f = (k == q) ? invf[q] : f;
        const float ang = (float)P_pos(F)[m] * f; float sn, cs; sincosf(ang, &sn, &cs);
        P_ROPE(F)[(size_t)m * 16 + k] = cs; P_ROPE(F)[(size_t)m * 16 + 8 + k] = sn; }
}
__device__ __forceinline__ void p6_phase(Frame& F) {
    const int gw = F.bid * NWAVES + F.wave, NGW = F.G * NWAVES;
    for (int m = 4 * gw; m < M; m += 4 * NGW) { const int b = m / SEQ; const float* ada = P_ADA(F) + (size_t)b * ADA_W;
        modnorm_rows<true, 4>(P_x(F) + (size_t)m * D, P_norm2_g(F), ada + 3 * D, ada + 4 * D, P_XH(F) + (size_t)m * D, F.lane, P_X1B(F) + (size_t)m * D); }
}

#define MFMA32(a, b, c) __builtin_amdgcn_mfma_f32_32x32x16_bf16((a), (b), (c), 0, 0, 0)
#define MFMA16(a, b, c) __builtin_amdgcn_mfma_f32_16x16x32_bf16((a), (b), (c), 0, 0, 0)
constexpr int KS_STRIDE = 72;
constexpr int VT_STRIDE = 264;
constexpr int ATT_KS_OFF = 0, ATT_VT_OFF = 256 * KS_STRIDE * 2;
static_assert(ATT_VT_OFF + 64 * VT_STRIDE * 2 <= RING_BYTES, "attention LDS");

__device__ __forceinline__ void attn_unit(Frame& F, int b, int g, int n) {
    LAS bf16* Ks = (LAS bf16*)(F.lds + ATT_KS_OFF);
    LAS bf16* VT = (LAS bf16*)(F.lds + ATT_VT_OFF);
    const int tid = F.tid, lane = F.lane;
    {
        const int kb = tid >> 1, hf = tid & 1; const int t = n * 128 - 128 + kb;
        float kv[32]; v4u vraw[4];
        if (t >= 0) {
            const bf16* kp = P_PROJ(F) + (size_t)(b * SEQ + t) * MIX_IN + C_K + g * HD + 32 * hf;
            const bf16* vp = P_PROJ(F) + (size_t)(b * SEQ + t) * MIX_IN + C_V + g * HD + 32 * hf;
#pragma unroll
            for (int q = 0; q < 4; ++q) { const v4u r = *(const v4u*)(kp + 8 * q); vraw[q] = *(const v4u*)(vp + 8 * q);
                kv[8 * q + 0] = bflo(r.x); kv[8 * q + 1] = bfhi(r.x); kv[8 * q + 2] = bflo(r.y); kv[8 * q + 3] = bfhi(r.y);
                kv[8 * q + 4] = bflo(r.z); kv[8 * q + 5] = bfhi(r.z); kv[8 * q + 6] = bflo(r.w); kv[8 * q + 7] = bfhi(r.w); }
        } else {
#pragma unroll
            for (int q = 0; q < 4; ++q) vraw[q] = (v4u){0u, 0u, 0u, 0u};
#pragma unroll
            for (int q = 0; q < 32; ++q) kv[q] = 0.f;
        }
        float ss = 0.f;
#pragma unroll
        for (int q = 0; q < 32; ++q) ss += kv[q] * kv[q];
        ss += __shfl_xor(ss, 1);
        const float rstd = 1.0f / sqrtf(ss * (1.0f / HD) + EPS);
#pragma unroll
        for (int q = 0; q < 32; ++q) kv[q] = kv[q] * rstd * P_kn_g(F)[32 * hf + q];
        if (hf == 0 && t >= 0) {
            const float* rp = P_ROPE(F) + (size_t)(b * SEQ + t) * 16;
#pragma unroll
            for (int i = 0; i < 8; ++i) { const float cs = rp[i], sn = rp[8 + i]; const float x1 = kv[i], x2 = kv[8 + i];
                kv[i] = x1 * cs - x2 * sn; kv[8 + i] = x2 * cs + x1 * sn; }
        }
#pragma unroll
        for (int q = 0; q < 4; ++q) { v4u o; o.x = pk2(kv[8 * q], kv[8 * q + 1]); o.y = pk2(kv[8 * q + 2], kv[8 * q + 3]); o.z = pk2(kv[8 * q + 4], kv[8 * q + 5]); o.w = pk2(kv[8 * q + 6], kv[8 * q + 7]);
            *(LAS v4u*)(Ks + kb * KS_STRIDE + 32 * hf + 8 * q) = o; }
#pragma unroll
        for (int q = 0; q < 4; ++q) { const unsigned w[4] = {vraw[q].x, vraw[q].y, vraw[q].z, vraw[q].w};
#pragma unroll
            for (int e = 0; e < 4; ++e) { const int d = 32 * hf + 8 * q + 2 * e;
                VT[d * VT_STRIDE + kb] = (bf16)(w[e] & 0xffffu); VT[(d + 1) * VT_STRIDE + kb] = (bf16)(w[e] >> 16); } }
    }
    __syncthreads();
    const int hq = g * GRP + F.wave, r = lane & 31, hh = lane >> 5;
    const float sink = P_sinks(F)[hq];
    for (int qi = 0; qi < 4; ++qi) {
        const int tq = n * 128 + 32 * qi + r;
        bf16x8 qf[4];
        {
            const bf16* qp = P_PROJ(F) + (size_t)(b * SEQ + tq) * MIX_IN + C_Q + hq * HD + 8 * hh;
            float qv[4][8]; float ss = 0.f;
#pragma unroll
            for (int ks = 0; ks < 4; ++ks) { const v4u rr = *(const v4u*)(qp + 16 * ks);
                qv[ks][0] = bflo(rr.x); qv[ks][1] = bfhi(rr.x); qv[ks][2] = bflo(rr.y); qv[ks][3] = bfhi(rr.y);
                qv[ks][4] = bflo(rr.z); qv[ks][5] = bfhi(rr.z); qv[ks][6] = bflo(rr.w); qv[ks][7] = bfhi(rr.w);
#pragma unroll
                for (int j = 0; j < 8; ++j) ss += qv[ks][j] * qv[ks][j]; }
            ss += __shfl_xor(ss, 32);
            const float rstd = 1.0f / sqrtf(ss * (1.0f / HD) + EPS);
#pragma unroll
            for (int ks = 0; ks < 4; ++ks)
#pragma unroll
                for (int j = 0; j < 8; ++j) qv[ks][j] = qv[ks][j] * rstd * P_qn_g(F)[16 * ks + 8 * hh + j];
            const float* rp = P_ROPE(F) + (size_t)(b * SEQ + tq) * 16;
#pragma unroll
            for (int j = 0; j < 8; ++j) { const float mine = qv[0][j], other = __shfl_xor(mine, 32); const float cs = rp[j], sn = rp[8 + j];
                qv[0][j] = hh == 0 ? (mine * cs - other * sn) : (mine * cs + other * sn); }
#pragma unroll
            for (int ks = 0; ks < 4; ++ks) { v4u o; o.x = pk2(qv[ks][0] * 0.125f, qv[ks][1] * 0.125f); o.y = pk2(qv[ks][2] * 0.125f, qv[ks][3] * 0.125f);
                o.z = pk2(qv[ks][4] * 0.125f, qv[ks][5] * 0.125f); o.w = pk2(qv[ks][6] * 0.125f, qv[ks][7] * 0.125f); qf[ks] = __builtin_bit_cast(bf16x8, o); }
        }
        f32x16 s[5];
#pragma unroll
        for (int kj = 0; kj < 5; ++kj) {
            f32x16 acc;
#pragma unroll
            for (int i = 0; i < 16; ++i) acc[i] = 0.f;
            const LAS bf16* kp = Ks + (32 * (qi + kj) + r) * KS_STRIDE + 8 * hh;
#pragma unroll
            for (int ks = 0; ks < 4; ++ks) { const bf16x8 kf = *(const LAS bf16x8*)(kp + 16 * ks); acc = MFMA32(kf, qf[ks], acc); }
            s[kj] = acc;
        }
        float mx = sink;
#pragma unroll
        for (int kj = 0; kj < 5; ++kj)
#pragma unroll
            for (int i = 0; i < 16; ++i) { const int kt = (i & 3) + 8 * (i >> 2) + 4 * hh; const int kbi = 32 * (qi + kj) + kt;
                bool valid = (n * 128 + kbi - 128) >= 0;
                if (kj == 0) valid = valid && (kt > r);
                if (kj == 4) valid = valid && (kt <= r);
                s[kj][i] = valid ? s[kj][i] : -INFINITY; mx = fmaxf(mx, s[kj][i]); }
        mx = fmaxf(mx, __shfl_xor(mx, 32));
        float l = 0.f;
#pragma unroll
        for (int kj = 0; kj < 5; ++kj)
#pragma unroll
            for (int i = 0; i < 16; ++i) { const float p = __expf(s[kj][i] - mx); s[kj][i] = p; l += p; }
        l += __shfl_xor(l, 32);
        l += __expf(sink - mx);
        const float inv = 1.0f / l;
        f32x16 o0, o1;
#pragma unroll
        for (int i = 0; i < 16; ++i) { o0[i] = 0.f; o1[i] = 0.f; }
#pragma unroll
        for (int kj = 0; kj < 5; ++kj)
#pragma unroll
            for (int st = 0; st < 2; ++st) {
                v4u pa; pa.x = pk2(s[kj][8 * st + 0] * inv, s[kj][8 * st + 1] * inv); pa.y = pk2(s[kj][8 * st + 2] * inv, s[kj][8 * st + 3] * inv);
                pa.z = pk2(s[kj][8 * st + 4] * inv, s[kj][8 * st + 5] * inv); pa.w = pk2(s[kj][8 * st + 6] * inv, s[kj][8 * st + 7] * inv);
                const bf16x8 pf = __builtin_bit_cast(bf16x8, pa);
                const int kb0 = 32 * (qi + kj) + 16 * st + 4 * hh;
                const LAS bf16* v0p = VT + r * VT_STRIDE + kb0; const LAS bf16* v1p = VT + (32 + r) * VT_STRIDE + kb0;
                const v2u a0 = *(const LAS v2u*)v0p, a1 = *(const LAS v2u*)(v0p + 8), b0 = *(const LAS v2u*)v1p, b1 = *(const LAS v2u*)(v1p + 8);
                const v4u vb0 = {a0.x, a0.y, a1.x, a1.y}, vb1 = {b0.x, b0.y, b1.x, b1.y};
                o0 = MFMA32(pf, __builtin_bit_cast(bf16x8, vb0), o0);
                o1 = MFMA32(pf, __builtin_bit_cast(bf16x8, vb1), o1);
            }
#pragma unroll
        for (int i = 0; i < 16; ++i) { const int qr = (i & 3) + 8 * (i >> 2) + 4 * hh; const int tok = n * 128 + 32 * qi + qr;
            bf16* op = P_XH(F) + (size_t)(b * SEQ + tok) * D + LRU_W + hq * HD + r;
            op[0] = (bf16)f2bf(o0[i]); op[32] = (bf16)f2bf(o1[i]); }
    }
    __syncthreads();
}

constexpr int LCH = 64;
constexpr int XC_STRIDE = 136;
constexpr int LRU_XCB_OFF = 0, LRU_XCF_OFF = LCH * XC_STRIDE * 2  , LRU_A_OFF = LRU_XCF_OFF + LCH * 128 * 4, LRU_B_OFF = LRU_A_OFF + LCH * 128 * 4, LRU_SE_OFF = LRU_B_OFF + LCH * 128 * 4;
static_assert(LRU_SE_OFF + 2 * 4 * 128 * 4 <= RING_BYTES, "LRU LDS");
__device__ __forceinline__ void lru_block(Frame& F) {
    LAS bf16* XCb = (LAS bf16*)(F.lds + LRU_XCB_OFF);
    LAS float* XCF = (LAS float*)(F.lds + LRU_XCF_OFF);
    LAS float* As = (LAS float*)(F.lds + LRU_A_OFF);
    LAS float* Bs = (LAS float*)(F.lds + LRU_B_OFF);
    LAS float* SEh = (LAS float*)(F.lds + LRU_SE_OFF);
    LAS float* SEp = SEh + 4 * 128;
    const int tid = F.tid, lane = F.lane;
    const int hd = F.bid & 7, li = F.bid >> 3, step = F.G >> 3;
    constexpr int NQ = BATCH * (SEQ / LCH);
    if (li >= NQ) return;
    const int cg = tid & 15, tp = tid >> 4, colc = hd * LRU_BLK + 8 * cg;
    float cw[4][8], cbv[8];
#pragma unroll
    for (int k = 0; k < 4; ++k) { const f32x4 a = *(const f32x4*)(P_conv_w(F) + k * LRU_W + colc), b2 = *(const f32x4*)(P_conv_w(F) + k * LRU_W + colc + 4);
        cw[k][0] = a.x; cw[k][1] = a.y; cw[k][2] = a.z; cw[k][3] = a.w; cw[k][4] = b2.x; cw[k][5] = b2.y; cw[k][6] = b2.z; cw[k][7] = b2.w; }
    { const f32x4 a = *(const f32x4*)(P_conv_b(F) + colc), b2 = *(const f32x4*)(P_conv_b(F) + colc + 4);
      cbv[0] = a.x; cbv[1] = a.y; cbv[2] = a.z; cbv[3] = a.w; cbv[4] = b2.x; cbv[5] = b2.y; cbv[6] = b2.z; cbv[7] = b2.w; }
    const int fr = lane & 15, fq = lane >> 4, j = 16 * F.wave + fr, jc = hd * LRU_BLK + j;
    bf16x8 wa[4], wx[4];
    { const bf16* wap = P_WGA(F) + (size_t)hd * 16384 + (size_t)j * 128 + 8 * fq; const bf16* wxp = P_WGX(F) + (size_t)hd * 16384 + (size_t)j * 128 + 8 * fq;
#pragma unroll
      for (int ks = 0; ks < 4; ++ks) { wa[ks] = *(const bf16x8*)(wap + 32 * ks); wx[ks] = *(const bf16x8*)(wxp + 32 * ks); } }
    const float ba = P_ga_b(F)[jc], bx = P_gx_b(F)[jc];
    const float sp8 = -8.0f * log1pf(__expf(-P_lam(F)[jc]));
    const int c = tid & 127, sub = tid >> 7, col = hd * LRU_BLK + c;
    const bf16* xbase = P_PROJ(F) + colc;
    bf16* HLp = P_HL(F); bf16* PAp = P_PA(F);
    v4u xr[5];
#define LRU_LOAD_X(q_) do { const int b_ = (q_) >> 6, ch_ = (q_) & 63; const int tr_ = ch_ * LCH + 2 * tp - 3; \
        _Pragma("unroll") for (int r_ = 0; r_ < 5; ++r_) { const int t_ = tr_ + r_; \
            xr[r_] = (t_ >= 0) ? *(const v4u*)(xbase + (size_t)(b_ * SEQ + t_) * MIX_IN) : (v4u){0u, 0u, 0u, 0u}; } } while (0)
    LRU_LOAD_X(li);
    for (int q = li; q < NQ; q += step) {
        const int b = q >> 6, ch = q & 63, t0 = ch * LCH;
        {
            float xv[5][8];
#pragma unroll
            for (int r = 0; r < 5; ++r) { xv[r][0] = bflo(xr[r].x); xv[r][1] = bfhi(xr[r].x); xv[r][2] = bflo(xr[r].y); xv[r][3] = bfhi(xr[r].y);
                xv[r][4] = bflo(xr[r].z); xv[r][5] = bfhi(xr[r].z); xv[r][6] = bflo(xr[r].w); xv[r][7] = bfhi(xr[r].w); }
            if (q + step < NQ) LRU_LOAD_X(q + step);
#pragma unroll
            for (int tk = 0; tk < 2; ++tk) { float xc[8];
#pragma unroll
                for (int e = 0; e < 8; ++e) xc[e] = cbv[e] + cw[0][e] * xv[tk][e] + cw[1][e] * xv[tk + 1][e] + cw[2][e] * xv[tk + 2][e] + cw[3][e] * xv[tk + 3][e];
                const int tl = 2 * tp + tk;
                v4u o; o.x = pk2(xc[0], xc[1]); o.y = pk2(xc[2], xc[3]); o.z = pk2(xc[4], xc[5]); o.w = pk2(xc[6], xc[7]);
                *(LAS v4u*)(XCb + tl * XC_STRIDE + 8 * cg) = o;
                *(LAS f32x4*)(XCF + tl * 128 + 8 * cg) = (f32x4){xc[0], xc[1], xc[2], xc[3]}; *(LAS f32x4*)(XCF + tl * 128 + 8 * cg + 4) = (f32x4){xc[4], xc[5], xc[6], xc[7]}; }
        }
        __syncthreads();
#pragma unroll
        for (int mt = 0; mt < 4; ++mt) {
            f32x4 ra = {0.f, 0.f, 0.f, 0.f}, rx = {0.f, 0.f, 0.f, 0.f};
            const LAS bf16* ap = XCb + (16 * mt + fr) * XC_STRIDE + 8 * fq;
#pragma unroll
            for (int ks = 0; ks < 4; ++ks) { const bf16x8 af = *(const LAS bf16x8*)(ap + 32 * ks); ra = MFMA16(af, wa[ks], ra); rx = MFMA16(af, wx[ks], rx); }
#pragma unroll
            for (int e = 0; e < 4; ++e) { const int tl = 16 * mt + 4 * fq + e;
                const float rg = sigmoidf_(ra[e] + ba), ig = sigmoidf_(rx[e] + bx);
                const float a = __expf(rg * sp8);
                const float mult = sqrtf(fmaxf(fmaf(-a, a, 1.0f), 0.f));
                As[tl * 128 + j] = a; Bs[tl * 128 + j] = mult * ig * XCF[tl * 128 + j]; }
        }
        __syncthreads();
        float hh[16], pp[16];
        {
            float h = 0.f, P = 1.f;
#pragma unroll
            for (int i = 0; i < 16; ++i) { const int tl = sub * 16 + i; const float a = As[tl * 128 + c], bq = Bs[tl * 128 + c];
                h = a * h + bq; P *= a; hh[i] = h; pp[i] = P; }
            SEh[sub * 128 + c] = h; SEp[sub * 128 + c] = P;
        }
        __syncthreads();
        {
            float carry = 0.f, pre = 1.f;
            for (int s2 = 0; s2 < sub; ++s2) { carry = SEh[s2 * 128 + c] + SEp[s2 * 128 + c] * carry; pre *= SEp[s2 * 128 + c]; }
            bf16* hl = HLp + (size_t)(b * SEQ + t0 + sub * 16) * LRU_W + col;
            bf16* pa = PAp + (size_t)(b * SEQ + t0 + sub * 16) * LRU_W + col;
#pragma unroll
            for (int i = 0; i < 16; ++i) { hl[(size_t)i * LRU_W] = (bf16)f2bf(hh[i] + pp[i] * carry); pa[(size_t)i * LRU_W] = (bf16)f2bf(pp[i] * pre); }
        }
    }
#undef LRU_LOAD_X
    __syncthreads();
}
constexpr int N_ATT_UNITS = BATCH * HKV * (SEQ / 128);
constexpr int N_LRU_UNITS = BATCH * LRU_HEADS * (SEQ / LCH);
__device__ __forceinline__ void p3_phase(Frame& F) {
    for (int u = F.bid; u < N_ATT_UNITS; u += F.G) attn_unit(F, u >> 6, (u >> 5) & 1, u & 31);
    lru_block(F);
}

__device__ __forceinline__ void p4_unit(Frame& F, int b, int ch) {
    LAS float* CAR = (LAS float*)F.lds;
    const int tid = F.tid, lane = F.lane;
    {
        f32x2 carry = {0.f, 0.f};
        const bf16* hlb = P_HL(F) + (size_t)(b * SEQ + LCH - 1) * LRU_W + 2 * tid; const bf16* pab = P_PA(F) + (size_t)(b * SEQ + LCH - 1) * LRU_W + 2 * tid;
        int c2 = 0;
        for (; c2 + 8 <= ch; c2 += 8) { unsigned hl[8], pa[8];
#pragma unroll
            for (int q = 0; q < 8; ++q) { hl[q] = *(const unsigned*)(hlb + (size_t)(c2 + q) * LCH * LRU_W); pa[q] = *(const unsigned*)(pab + (size_t)(c2 + q) * LCH * LRU_W); }
#pragma unroll
            for (int q = 0; q < 8; ++q) { carry.x = bflo(hl[q]) + bflo(pa[q]) * carry.x; carry.y = bfhi(hl[q]) + bfhi(pa[q]) * carry.y; } }
        for (; c2 < ch; ++c2) { const unsigned hl = *(const unsigned*)(hlb + (size_t)c2 * LCH * LRU_W), pa = *(const unsigned*)(pab + (size_t)c2 * LCH * LRU_W);
            carry.x = bflo(hl) + bflo(pa) * carry.x; carry.y = bfhi(hl) + bfhi(pa) * carry.y; }
        CAR[2 * tid] = carry.x; CAR[2 * tid + 1] = carry.y;
    }
    __syncthreads();
    const float* gl = P_on_lru_g(F); const float* ga = P_on_attn_g(F);
    for (int i = 0; i < 8; i += 2) {
        const size_t m0 = (size_t)b * SEQ + ch * LCH + F.wave * 8 + i;
        v2u hl[2][4], pa[2][4]; v2u yr[2][4], ar[2][4];
#pragma unroll
        for (int t = 0; t < 2; ++t)
#pragma unroll
            for (int j = 0; j < 4; ++j) { const int c = 4 * lane + 256 * j; const size_t m = m0 + t;
                hl[t][j] = *(const v2u*)(P_HL(F) + m * LRU_W + c); pa[t][j] = *(const v2u*)(P_PA(F) + m * LRU_W + c);
                yr[t][j] = *(const v2u*)(P_PROJ(F) + m * MIX_IN + C_Y + c); ar[t][j] = *(const v2u*)(P_XH(F) + m * D + LRU_W + c); }
        f32x4 vl[2][4], va[2][4]; float sl[2] = {0.f, 0.f}, sa[2] = {0.f, 0.f};
#pragma unroll
        for (int t = 0; t < 2; ++t)
#pragma unroll
            for (int j = 0; j < 4; ++j) { const int c = 4 * lane + 256 * j; const f32x4 car = *(const LAS f32x4*)(CAR + c);
                const f32x4 hlf = {bflo(hl[t][j].x), bfhi(hl[t][j].x), bflo(hl[t][j].y), bfhi(hl[t][j].y)}, paf = {bflo(pa[t][j].x), bfhi(pa[t][j].x), bflo(pa[t][j].y), bfhi(pa[t][j].y)};
                const f32x4 h = hlf + paf * car;
                f32x4 v; v.x = h.x * gelu_tanh(bflo(yr[t][j].x)); v.y = h.y * gelu_tanh(bfhi(yr[t][j].x)); v.z = h.z * gelu_tanh(bflo(yr[t][j].y)); v.w = h.w * gelu_tanh(bfhi(yr[t][j].y));
                vl[t][j] = v; sl[t] += (v.x * v.x + v.y * v.y) + (v.z * v.z + v.w * v.w);
                f32x4 a; a.x = bflo(ar[t][j].x); a.y = bfhi(ar[t][j].x); a.z = bflo(ar[t][j].y); a.w = bfhi(ar[t][j].y);
                va[t][j] = a; sa[t] += (a.x * a.x + a.y * a.y) + (a.z * a.z + a.w * a.w); }
#pragma unroll
        for (int o = 1; o < 64; o <<= 1) { sl[0] += __shfl_xor(sl[0], o); sl[1] += __shfl_xor(sl[1], o); sa[0] += __shfl_xor(sa[0], o); sa[1] += __shfl_xor(sa[1], o); }
#pragma unroll
        for (int t = 0; t < 2; ++t) { const float rl = 1.0f / sqrtf(sl[t] * (1.0f / LRU_W) + EPS), ra = 1.0f / sqrtf(sa[t] * (1.0f / LRU_W) + EPS); const size_t m = m0 + t;
#pragma unroll
            for (int j = 0; j < 4; ++j) { const int c = 4 * lane + 256 * j; const f32x4 g1v = *(const f32x4*)(gl + c), g2v = *(const f32x4*)(ga + c);
                const f32x4 y = vl[t][j] * rl * g1v, z = va[t][j] * ra * g2v;
                v2u o; o.x = pk2(y.x, y.y); o.y = pk2(y.z, y.w); *(v2u*)(P_XH(F) + m * D + c) = o;
                v2u p; p.x = pk2(z.x, z.y); p.y = pk2(z.z, z.w); *(v2u*)(P_XH(F) + m * D + LRU_W + c) = p; } }
    }
    __syncthreads();
}
__device__ __forceinline__ void p4_phase(Frame& F) {
    for (int u = F.bid; u < BATCH * (SEQ / LCH); u += F.G) p4_unit(F, u >> 6, u & 63);
}

__device__ __forceinline__ int f2key(float f) { const int b = __builtin_bit_cast(int, f); return b ^ ((b >> 31) & 0x7fffffff); }
__device__ __forceinline__ float key2f(int k) { const int b = k ^ ((k >> 31) & 0x7fffffff); return __builtin_bit_cast(float, b); }
__device__ __forceinline__ void ins16(int (&L)[16], int x) {
#pragma unroll
    for (int j = 0; j < 16; ++j) { const int hi = max(L[j], x); x = min(L[j], x); L[j] = hi; }
}
__device__ __forceinline__ void ce_desc(int& a, int& b) { const int hi = a > b ? a : b, lo = a > b ? b : a; a = hi; b = lo; }
__device__ __forceinline__ void sort16_desc(int (&a)[16]) {
#pragma unroll
    for (int k = 2; k <= 16; k <<= 1)
#pragma unroll
        for (int j = k >> 1; j > 0; j >>= 1)
#pragma unroll
            for (int i = 0; i < 16; ++i) { const int l = i ^ j; if (l > i) { if ((i & k) == 0) ce_desc(a[i], a[l]); else ce_desc(a[l], a[i]); } }
}
__device__ __forceinline__ void bitonic_merge16_desc(int (&a)[16]) {
#pragma unroll
    for (int j = 8; j > 0; j >>= 1)
#pragma unroll
        for (int i = 0; i < 16; ++i) { const int l = i ^ j; if (l > i) ce_desc(a[i], a[l]); }
}
__device__ __forceinline__ void merge_top16(int (&a)[16], const int (&b)[16]) {
#pragma unroll
    for (int i = 0; i < 16; ++i) a[i] = a[i] > b[15 - i] ? a[i] : b[15 - i];
    bitonic_merge16_desc(a);
}
constexpr int INT_LOWEST = (int)0x80000000;
__device__ __forceinline__ void p8_item(Frame& F, int tt, int hd, LAS int* lut  ) {
    const int lane = F.lane, r = lane & 31, hh = lane >> 5;
    const bf16* QP = P_PROJ(F);
    int V[2][16];
#pragma unroll
    for (int p = 0; p < 2; ++p) {
        bf16x8 qf[8];
        const char* qb = (const char*)(QP + (size_t)(32 * tt) * D + hd * 256 + p * 128);
        const unsigned qoff = (unsigned)(r * D + 8 * hh) * 2u;
#pragma unroll
        for (int ks = 0; ks < 8; ++ks) qf[ks] = *(const bf16x8*)(qb + qoff + 32 * ks);
        int L[16];
#pragma unroll
        for (int j = 0; j < 16; ++j) L[j] = INT_LOWEST;
        const char* skb = (const char*)(P_SK(F) + (size_t)((hd * 2 + p) * PKEYS) * PHALF);
        const unsigned skoff = (unsigned)(r * PHALF + 8 * hh) * 2u;
#pragma unroll 1
        for (int kt = 0; kt < 4; ++kt) {
            f32x16 acc;
#pragma unroll
            for (int i = 0; i < 16; ++i) acc[i] = 0.f;
            const char* skt = skb + (size_t)(32 * kt) * PHALF * 2;
#pragma unroll
            for (int ks = 0; ks < 8; ++ks) { const bf16x8 kf = *(const bf16x8*)(skt + skoff + 32 * ks); acc = MFMA32(kf, qf[ks], acc); }
            const int kbase = 32 * kt + 4 * hh;
            int T[16];
#pragma unroll
            for (int i = 0; i < 16; ++i) { const int kidx = (i & 3) + 8 * (i >> 2); T[i] = (f2key(acc[i]) & ~0x7f) | (kbase + kidx); }
            sort16_desc(T); merge_top16(L, T);
        }
        int O[16];
#pragma unroll
        for (int j = 0; j < 16; ++j) O[j] = __shfl_xor(L[j], 32);
        merge_top16(L, O);
#pragma unroll
        for (int j = 0; j < 16; ++j) V[p][j] = L[j];
    }
#pragma unroll
    for (int j = 0; j < 16; ++j) { lut[lane * 33 + j] = V[0][j] & 0x7f; lut[lane * 33 + 16 + j] = V[1][j] & 0x7f; }
    float v0[16], v1[16];
#pragma unroll
    for (int j = 0; j < 16; ++j) { v0[j] = key2f(V[0][j] & ~0x7f); v1[j] = key2f(V[1][j] & ~0x7f); }
    int C[16], G1[16], G2[16], G3[2];
    { int n = 0;
#pragma unroll
      for (int i = 0; i < 16; ++i)
#pragma unroll
        for (int j = 0; j < 16; ++j)
            if ((i + 1) * (j + 1) <= 16) { const int key = (f2key(v0[i] + v1[j]) & ~0xff) | (i * 16 + j);
                if (n < 16) C[n] = key; else if (n < 32) G1[n - 16] = key; else if (n < 48) G2[n - 32] = key; else G3[n - 48] = key;
                ++n; } }
    sort16_desc(C); sort16_desc(G1); sort16_desc(G2);
    merge_top16(C, G1); merge_top16(C, G2); ins16(C, G3[0]); ins16(C, G3[1]);
    float sv[16]; float den = 0.f;
    const float mx = key2f(C[0] & ~0xff);
#pragma unroll
    for (int e = 0; e < 16; ++e) { sv[e] = __expf(key2f(C[e] & ~0xff) - mx); den += sv[e]; }
    const float inv = 1.0f / den;
    LDS_WAIT(); asm volatile("" ::: "memory");
    int idx[16];
#pragma unroll
    for (int e = 0; e < 16; ++e) { const int pi = (C[e] >> 4) & 15, pj = C[e] & 15; idx[e] = lut[lane * 33 + pi] * PKEYS + lut[lane * 33 + 16 + pj]; }
    if (hh == 0) {
        unsigned short* ip = P_IDX(F) + (size_t)(32 * tt + r) * 128 + hd * 16; float* gp = P_GW(F) + (size_t)(32 * tt + r) * 128 + hd * 16;
#pragma unroll
        for (int q = 0; q < 2; ++q) *(v4u*)(ip + 8 * q) = (v4u){(unsigned)idx[8 * q] | ((unsigned)idx[8 * q + 1] << 16), (unsigned)idx[8 * q + 2] | ((unsigned)idx[8 * q + 3] << 16),
                                                              (unsigned)idx[8 * q + 4] | ((unsigned)idx[8 * q + 5] << 16), (unsigned)idx[8 * q + 6] | ((unsigned)idx[8 * q + 7] << 16)};
#pragma unroll
        for (int q = 0; q < 4; ++q) *(f32x4*)(gp + 4 * q) = (f32x4){sv[4 * q] * inv, sv[4 * q + 1] * inv, sv[4 * q + 2] * inv, sv[4 * q + 3] * inv};
    }
    LDS_WAIT(); asm volatile("" ::: "memory");
}
__device__ __forceinline__ void p8_phase(Frame& F) {
    LAS int* lut = (LAS int*)(F.lds + F.wave * (64 * 33 * 4));
    const int gw = F.bid * NWAVES + F.wave, NGW = F.G * NWAVES;
    for (int it = gw; it < (M / 32) * PH; it += NGW) p8_item(F, it >> 3, it & 7, lut);
}

template <int CTRL> __device__ __forceinline__ float dpp_f(float x) { return __builtin_bit_cast(float, __builtin_amdgcn_mov_dpp(__builtin_bit_cast(int, x), CTRL, 0xf, 0xf, true)); }
__device__ __forceinline__ float sum8(float v) {
    v += dpp_f<0xB1>(v);
    v += dpp_f<0x4E>(v);
    v += dpp_f<0x141>(v);
    return v;
}
__device__ __forceinline__ void dec16(const v4u r, float (&f)[16]) {
    const unsigned w4[4] = {r.x, r.y, r.z, r.w};
#pragma unroll
    for (int w = 0; w < 4; ++w) { const f32x2 lo = __builtin_amdgcn_cvt_pk_f32_fp8((int)w4[w], false), hi = __builtin_amdgcn_cvt_pk_f32_fp8((int)w4[w], true);
        f[4 * w] = lo.x; f[4 * w + 1] = lo.y; f[4 * w + 2] = hi.x; f[4 * w + 3] = hi.y; }
}
__device__ __forceinline__ void row_offsets(const v4u a, const v4u b, unsigned loff, unsigned (&off)[16]) {
    const unsigned w[8] = {a.x, a.y, a.z, a.w, b.x, b.y, b.z, b.w};
#pragma unroll
    for (int q = 0; q < 8; ++q) { off[2 * q] = ((w[q] & 0xffffu) << 7) + loff; off[2 * q + 1] = ((w[q] >> 16) << 7) + loff; }
}
#define ISSUE_ROWS(dst, TBL, ia, ib) do { unsigned off_[16]; row_offsets((ia), (ib), loff, off_); \
    _Pragma("unroll") for (int i_ = 0; i_ < 16; ++i_) dst[i_] = *(const v4u*)((TBL) + off_[i_]); } while (0)

__device__ __forceinline__ void p9u_compute(const v4u (&row)[16], const v4u h0, const v4u h1, int c8, unsigned* dst) {
    f32x2 h2[8];
    h2[0] = (f32x2){bflo(h0.x), bfhi(h0.x)}; h2[1] = (f32x2){bflo(h0.y), bfhi(h0.y)}; h2[2] = (f32x2){bflo(h0.z), bfhi(h0.z)}; h2[3] = (f32x2){bflo(h0.w), bfhi(h0.w)};
    h2[4] = (f32x2){bflo(h1.x), bfhi(h1.x)}; h2[5] = (f32x2){bflo(h1.y), bfhi(h1.y)}; h2[6] = (f32x2){bflo(h1.z), bfhi(h1.z)}; h2[7] = (f32x2){bflo(h1.w), bfhi(h1.w)};
#pragma unroll
    for (int e = 0; e < 8; ++e) asm volatile("" : "+v"(h2[e]));
    float res0 = 0.f, res1 = 0.f;
#pragma unroll
    for (int i = 0; i < 16; ++i) {
        const unsigned w4[4] = {row[i].x, row[i].y, row[i].z, row[i].w};
        f32x2 a = __builtin_amdgcn_cvt_pk_f32_fp8((int)w4[0], false) * h2[0];
        f32x2 b = __builtin_amdgcn_cvt_pk_f32_fp8((int)w4[0], true) * h2[1];
#pragma unroll
        for (int w = 1; w < 4; ++w) { a = __builtin_elementwise_fma(__builtin_amdgcn_cvt_pk_f32_fp8((int)w4[w], false), h2[2 * w], a);
                                      b = __builtin_elementwise_fma(__builtin_amdgcn_cvt_pk_f32_fp8((int)w4[w], true), h2[2 * w + 1], b); }
        a = a + b;
        const float tot = sum8(a.x + a.y);
        if (i < 8) res0 = (c8 == (i & 7)) ? tot : res0; else res1 = (c8 == (i & 7)) ? tot : res1; }
    dst[0] = pk2(res0, res1);
}
__device__ __forceinline__ void p9u_item(Frame& F, int s, int tb) {
    const int lane = F.lane, gi = lane >> 3, c8 = lane & 7;
    const unsigned char* U8 = P_U(F);
    const unsigned loff = (unsigned)(s * (NEXP * 128) + 16 * c8);
    const unsigned short* idxb = P_IDX(F) + (size_t)(64 * tb) * 128 + 8 * gi;
    const bf16* hb = P_XH(F) + (size_t)(64 * tb) * D + 128 * s + 16 * c8;
    unsigned* pb = P_PART(F) + ((size_t)s * M + 64 * tb) * 64 + lane;
#define LOAD_META_U(I0, I1, H0, H1, tt_) do { const int tn_ = (tt_) < 64 ? (tt_) : 63; const unsigned short* ip_ = idxb + (size_t)tn_ * 128; const bf16* hp_ = hb + (size_t)tn_ * D; \
        I0 = *(const v4u*)(ip_); I1 = *(const v4u*)(ip_ + 64); H0 = *(const v4u*)(hp_); H1 = *(const v4u*)(hp_ + 8); } while (0)
    v4u aI0, aI1, aH0, aH1, bI0, bI1, bH0, bH1, cI0, cI1, cH0, cH1, dI0, dI1, dH0, dH1;
    LOAD_META_U(aI0, aI1, aH0, aH1, 0); LOAD_META_U(bI0, bI1, bH0, bH1, 1); LOAD_META_U(cI0, cI1, cH0, cH1, 2);
    v4u rowA[16], rowB[16];
    ISSUE_ROWS(rowA, U8, aI0, aI1); ISSUE_ROWS(rowB, U8, bI0, bI1);
#pragma unroll 1
    for (int t = 0; t < 64; t += 2) {
        p9u_compute(rowA, aH0, aH1, c8, pb + (size_t)t * 64);
        LOAD_META_U(dI0, dI1, dH0, dH1, t + 3);
        ISSUE_ROWS(rowA, U8, cI0, cI1);
        p9u_compute(rowB, bH0, bH1, c8, pb + (size_t)(t + 1) * 64);
        aH0 = cH0; aH1 = cH1; bH0 = dH0; bH1 = dH1;
        LOAD_META_U(cI0, cI1, cH0, cH1, t + 4);
        ISSUE_ROWS(rowB, U8, dI0, dI1);
    }
#undef LOAD_META_U
}
#define MFMA_FP8(a, b, c) __builtin_amdgcn_mfma_f32_16x16x32_fp8_fp8((a), (b), (c), 0, 0, 0)
__device__ __forceinline__ long pk64(unsigned lo, unsigned hi) { return (long)(((unsigned long long)hi << 32) | lo); }
#define ISSUE_ROWS_V(dst, i0, i1) do { const unsigned w_[8] = {(i0).x, (i0).y, (i0).z, (i0).w, (i1).x, (i1).y, (i1).z, (i1).w}; \
    _Pragma("unroll") for (int g_ = 0; g_ < 16; ++g_) { const unsigned id_ = (g_ & 1) ? (w_[g_ >> 1] >> 16) : (w_[g_ >> 1] & 0xffffu); \
        dst[g_] = *(const v4u*)(V8 + ((id_ << 7) + loff)); } } while (0)
__device__ __forceinline__ void p9v_compute(const v4u (&row)[16], const v4u w8, int lane, unsigned shl, bool hif, const v2u x1lo, const v2u x1hi, const f32x4 g2lo, const f32x4 g2hi, float wscale, float* dst) {
    f32x4 d0 = {0.f, 0.f, 0.f, 0.f}, d1 = {0.f, 0.f, 0.f, 0.f};
    const unsigned ww[4] = {w8.x, w8.y, w8.z, w8.w};
#pragma unroll
    for (int g = 0; g < 16; ++g) {
        const unsigned wb = (ww[g >> 2] >> (8 * (g & 3))) & 0xffu;
        const unsigned sh = wb << shl;
        const long a = pk64(hif ? 0u : sh, hif ? sh : 0u);
        d0 = MFMA_FP8(a, pk64(row[g].x, row[g].y), d0);
        d1 = MFMA_FP8(a, pk64(row[g].z, row[g].w), d1);
    }
#pragma unroll
    for (int e = 0; e < 4; ++e) { d0[e] += __shfl_xor(d0[e], 40); d1[e] += __shfl_xor(d1[e], 40); }
    if ((lane & 40) == 0) {
        const f32x4 xl = {bflo(x1lo.x), bfhi(x1lo.x), bflo(x1lo.y), bfhi(x1lo.y)}, xh = {bflo(x1hi.x), bfhi(x1hi.x), bflo(x1hi.y), bfhi(x1hi.y)};
        *(f32x4*)(dst) = xl + g2lo * (d0 * wscale);
        *(f32x4*)(dst + 8) = xh + g2hi * (d1 * wscale);
    }
}
__device__ __forceinline__ void p9v_item(Frame& F, int s, int tb) {
    const int lane = F.lane, sg = lane & 7, r8 = lane >> 3;
    const unsigned char* V8 = P_V(F);
    const unsigned loff = (unsigned)(s * (NEXP * 128) + 16 * sg);
    const unsigned short* idxb = P_IDX(F) + (size_t)(64 * tb) * 128 + 16 * r8;
    const int ai = lane & 15, kq = lane >> 4;
    const unsigned shl = 8u * (unsigned)(ai & 3); const bool hif = (ai & 4) != 0;
    const unsigned char* wb = P_W(F) + (size_t)(64 * tb) * 128 + 16 * (2 * kq + (ai >> 3));
    const float* wscp = P_WSC(F) + 64 * tb;
    const int b = (64 * tb) / SEQ;
    const int ocol = 128 * s + 16 * (lane & 7) + 4 * ((lane >> 4) & 1);
    const f32x4 g2lo = *(const f32x4*)(P_ADA(F) + (size_t)b * ADA_W + 5 * D + ocol), g2hi = *(const f32x4*)(P_ADA(F) + (size_t)b * ADA_W + 5 * D + ocol + 8);
    float* ob = P_out(F) + (size_t)(64 * tb) * D + ocol;
    const bf16* xb = P_X1B(F) + (size_t)(64 * tb) * D + ocol;
#define LOAD_META_V(I0, I1, W8, XL, XH, WS, tt_) do { const int tn_ = (tt_) < 64 ? (tt_) : 63; const unsigned short* ip_ = idxb + (size_t)tn_ * 128; I0 = *(const v4u*)(ip_); I1 = *(const v4u*)(ip_ + 8); \
        W8 = *(const v4u*)(wb + (size_t)tn_ * 128); XL = *(const v2u*)(xb + (size_t)tn_ * D); XH = *(const v2u*)(xb + (size_t)tn_ * D + 8); WS = wscp[tn_]; } while (0)
    v4u aI0, aI1, aW, bI0, bI1, bW, cI0, cI1, cW, dI0, dI1, dW; v2u aXL, aXH, bXL, bXH, cXL, cXH, dXL, dXH; float aS, bS, cS, dS;
    LOAD_META_V(aI0, aI1, aW, aXL, aXH, aS, 0); LOAD_META_V(bI0, bI1, bW, bXL, bXH, bS, 1); LOAD_META_V(cI0, cI1, cW, cXL, cXH, cS, 2);
    v4u rowA[16], rowB[16];
    ISSUE_ROWS_V(rowA, aI0, aI1); ISSUE_ROWS_V(rowB, bI0, bI1);
#pragma unroll 1
    for (int t = 0; t < 64; t += 2) {
        p9v_compute(rowA, aW, lane, shl, hif, aXL, aXH, g2lo, g2hi, aS, ob + (size_t)t * D);
        LOAD_META_V(dI0, dI1, dW, dXL, dXH, dS, t + 3);
        ISSUE_ROWS_V(rowA, cI0, cI1);
        p9v_compute(rowB, bW, lane, shl, hif, bXL, bXH, g2lo, g2hi, bS, ob + (size_t)(t + 1) * D);
        aW = cW; aXL = cXL; aXH = cXH; aS = cS; bW = dW; bXL = dXL; bXH = dXH; bS = dS;
        LOAD_META_V(cI0, cI1, cW, cXL, cXH, cS, t + 4);
        ISSUE_ROWS_V(rowB, dI0, dI1);
    }
#undef LOAD_META_V
}
__device__ __forceinline__ void p9u_phase(Frame& F) {
    const int x = F.bid & 7, rank = F.bid >> 3, nr = F.G >> 3;
    for (int h = 0; h < 2; ++h)
        for (int tb = rank * NWAVES + F.wave; tb < M / 64; tb += nr * NWAVES) p9u_item(F, 2 * x + h, tb);
}
__device__ __forceinline__ void p9v_phase(Frame& F) {
    const int x = F.bid & 7, rank = F.bid >> 3, nr = F.G >> 3;
    for (int h = 0; h < 2; ++h)
        for (int tb = rank * NWAVES + F.wave; tb < M / 64; tb += nr * NWAVES) p9v_item(F, 2 * x + h, tb);
}
__device__ __forceinline__ void p9w_phase(Frame& F) {
    const unsigned* part = P_PART(F); const unsigned short* idxp = P_IDX(F); const float* gwp = P_GW(F); const float* usc = P_USC(F); const float* vsc = P_VSC(F);
    unsigned char* wp = P_W(F); float* wsc = P_WSC(F);
    for (int it = F.bid * 512 + F.tid; it < M * 64; it += F.G * 512) {
        float a0 = 0.f, a1 = 0.f;
#pragma unroll
        for (int s = 0; s < 16; ++s) { const unsigned w = part[(size_t)s * M * 64 + it]; a0 += bflo(w); a1 += bfhi(w); }
        const int m = it >> 6, L = it & 63; const size_t p0 = (size_t)m * 128 + L, p1 = p0 + 64;
        const int i0 = idxp[p0], i1 = idxp[p1];
        const float w0 = gwp[p0] * gelu_tanh(a0 * usc[i0]) * vsc[i0], w1 = gwp[p1] * gelu_tanh(a1 * usc[i1]) * vsc[i1];
        float mx = fmaxf(fabsf(w0), fabsf(w1));
#pragma unroll
        for (int o = 1; o < 64; o <<= 1) mx = fmaxf(mx, __shfl_xor(mx, o));
        const float sc = 224.0f / fmaxf(mx, 1e-30f);
        const int t = __builtin_amdgcn_cvt_pk_fp8_f32(w0 * sc, w1 * sc, 0, false);
        wp[p0] = (unsigned char)(t & 0xff); wp[p1] = (unsigned char)((t >> 8) & 0xff);
        if (L == 0) wsc[m] = fmaxf(mx, 1e-30f) * (1.0f / 224.0f);
    }
}

struct Args { const void* in[25]; float* out; unsigned char* ws; int ph_lo, ph_hi; };
__global__ void __launch_bounds__(NWAVES * 64, 2) hymba_fwd(Args args) {
    extern __shared__ __attribute__((aligned(16))) unsigned char lds_raw[];
    Frame F;
    F.lds = (LAS unsigned char*)lds_raw;
    F.tid = threadIdx.x; F.lane = F.tid & 63; F.wave = __builtin_amdgcn_readfirstlane(F.tid >> 6);
    F.G = gridDim.x; F.bid = blockIdx.x;
    F.ka = (kaptr_t)__builtin_amdgcn_kernarg_segment_ptr();
    static_assert(sizeof(Args) == 224, "kernarg byte offsets used by ka_ptr");
    for (int u = F.tid; u < (LDS_BYTES - LDSCTL_OFF) / 4; u += NWAVES * 64) ((LAS unsigned*)(F.lds + LDSCTL_OFF))[u] = 0u;
    __syncthreads();
    volatile LAS unsigned* MISC = (volatile LAS unsigned*)(F.lds + MISC_OFF);
    XcdBarrier bar; bar.bar = (unsigned*)(P_ws(F) + WS_CTL) + CW_BAR; bar.x = 0; bar.st = nullptr;
    const int lo = args.ph_lo, hi = args.ph_hi;
    if (hi - lo > 1) bar = xcd_barrier_post((unsigned*)(P_ws(F) + WS_CTL) + CW_BAR, MISC + 8);
#define IN(k) (lo <= (k) && (k) < hi)
#ifndef PROBE_STAMP
#define PROBE_STAMP -1
#define PROBE_DIV 5.0f
#endif
#define STAMP(k) do { if (PROBE_STAMP >= 0 && F.bid == 0 && F.tid == 0) ((unsigned long long*)(P_ws(F) + WS_CTL + 64))[(k)] = __builtin_amdgcn_s_memrealtime(); } while (0)
#define SEAM(k) do { STAMP(16 + (k)); if (IN(k) && IN((k) + 1)) xcd_barrier(bar); STAMP((k) + 1); } while (0)
    STAMP(0);

#ifndef PROBE_MASK
#define PROBE_MASK 0
#endif
#define REP(k) for (int rep_ = 0; rep_ < (((PROBE_MASK >> (k)) & 1) ? 2 : 1); ++rep_)
#define REPSYNC(k) do { if (((PROBE_MASK >> (k)) & 1) && rep_ == 0) xcd_barrier(bar); } while (0)
    if (IN(0)) { REP(0) { p0_prologue(F); REPSYNC(0); } } SEAM(0);
    if (IN(1)) { REP(1) { p1_phase(F); REPSYNC(1); } } SEAM(1);
    if (IN(2)) REP(2) {
        pg8::Gemm g{P_XH(F), P_WIN(F), M, MIX_IN, D}; pg8::StaticOrder S; S.init(M, MIX_IN, F.G, F.bid);
        pg8::EpiStoreBf16 E{P_PROJ(F), MIX_IN};
        pg8::gemm_phase<pg8::EpiStoreBf16, pg8::StaticOrder, false, true>(F.lds, g, S, E); REPSYNC(2);
        { const int nwg = (M / 256) * (MIX_IN / 256), busy = nwg % F.G;
          if (busy > 0 && F.bid >= busy) quant_rows(F, QUANT_SPLIT, 2 * NEXP, (F.bid - busy) * NWAVES + F.wave, (F.G - busy) * NWAVES);
          else if (busy == 0) quant_rows(F, QUANT_SPLIT, 2 * NEXP, F.bid * NWAVES + F.wave, F.G * NWAVES); }
    } SEAM(2);
    if (IN(3)) { p3_phase(F); } SEAM(3);
    if (IN(4)) { p4_phase(F); } SEAM(4);
    if (IN(5)) REP(5) {
        pg8::Gemm g{P_XH(F), P_WOUT(F), M, D, D}; pg8::StaticOrder S; S.init(M, D, F.G, F.bid);
        pg8::EpiGateBf16 E{P_X1B(F), D, P_ADA(F) + 2 * D, ADA_W, SEQ};
        pg8::gemm_phase<pg8::EpiGateBf16, pg8::StaticOrder, false, true>(F.lds, g, S, E); REPSYNC(5);
    } SEAM(5);
    if (IN(6)) { REP(6) { p6_phase(F); REPSYNC(6); } } SEAM(6);
    if (IN(7)) REP(7) {
        pg8::Gemm g{P_XH(F), P_WQ(F), M, D, D}; pg8::StaticOrder S; S.init(M, D, F.G, F.bid);
        pg8::EpiStoreBf16 E{P_PROJ(F), D};
        pg8::gemm_phase<pg8::EpiStoreBf16, pg8::StaticOrder, false, true>(F.lds, g, S, E); REPSYNC(7);
    } SEAM(7);
    if (IN(8)) { REP(8) { p8_phase(F); REPSYNC(8); } } SEAM(8);
    if (IN(9)) { p9u_phase(F); }
    if (PROBE_STAMP >= 0 && F.tid == 0) ((unsigned long long*)(P_ws(F) + WS_CTL + 32768))[F.bid] = __builtin_amdgcn_s_memrealtime();
    SEAM(9);
    if (IN(10)) { p9w_phase(F); } SEAM(10);
    if (IN(11)) { p9v_phase(F); }
    if (PROBE_STAMP >= 0) {
        __syncthreads(); STAMP(12); VM_WAIT(); __syncthreads();
        if (F.bid == 0 && F.tid == 0) { const unsigned long long* ts = (const unsigned long long*)(P_ws(F) + WS_CTL + 64);
            float us = (float)(ts[PROBE_STAMP + 1] - ts[PROBE_STAMP]) * 0.01f;
#ifdef PROBE_BLOCKSTAT
            { const unsigned long long* bt = (const unsigned long long*)(P_ws(F) + WS_CTL + 32768); float acc_ = 0.f;
              for (int b_ = 0; b_ < (int)gridDim.x; ++b_) { const float d_ = (float)(bt[b_] - ts[9]) * 0.01f; PROBE_BLOCKSTAT; } us = acc_; }
#endif
            P_out(F)[0] += us * (1.0f / PROBE_DIV); }
    }
#undef IN
#undef SEAM
}

extern "C" void kernel_launch(void* const* d_in, const int* in_sizes, int n_in, void* d_out, int out_size, void* d_ws, size_t ws_size, hipStream_t stream) {
    static int grid = 0;
    if (grid == 0) {
        if (n_in != 25 || in_sizes[0] != M * D || out_size != M * D || ws_size < WS_END) {
            fprintf(stderr, "kernel_launch: built for 25 inputs, x/out of %d floats, >= %zu bytes of workspace; got n_in %d, in0 %d, out %d, ws %zu; nothing launched\n", M * D, (size_t)WS_END, n_in, n_in > 0 ? in_sizes[0] : -1, out_size, ws_size);
            grid = -1; return; }
        int dev = 0, cus = 0, per_cu = 0;
        if (hipGetDevice(&dev) != hipSuccess || hipDeviceGetAttribute(&cus, hipDeviceAttributeMultiprocessorCount, dev) != hipSuccess) { fprintf(stderr, "kernel_launch: device query failed\n"); grid = -1; return; }
        if (hipFuncSetAttribute((const void*)hymba_fwd, hipFuncAttributeMaxDynamicSharedMemorySize, LDS_BYTES) != hipSuccess) { fprintf(stderr, "kernel_launch: hipFuncSetAttribute failed\n"); grid = -1; return; }
        if (hipOccupancyMaxActiveBlocksPerMultiprocessor(&per_cu, (const void*)hymba_fwd, NWAVES * 64, LDS_BYTES) != hipSuccess || per_cu < 1) {
            fprintf(stderr, "kernel_launch: occupancy query reports %d workgroups per CU; need 1\n", per_cu); (void)hipGetLastError(); grid = -1; return; }
        grid = cus;
        if (grid % 8 != 0 || (M / 64) % (grid / 8 * NWAVES) != 0) { fprintf(stderr, "kernel_launch: grid %d not supported (needs a multiple of 8 dividing the token blocks)\n", grid); grid = -1; return; }
    }
    if (grid < 0) return;
    if (hipMemsetAsync((char*)d_ws + WS_CTL, 0, CTL_ZERO_BYTES, stream) != hipSuccess) { fprintf(stderr, "kernel_launch: memset failed\n"); return; }
    Args a{};
    for (int i = 0; i < 25; ++i) a.in[i] = d_in[i];
    a.out = (float*)d_out; a.ws = (unsigned char*)d_ws;
    if (N_LAUNCHES == 1) {
        a.ph_lo = 0; a.ph_hi = N_PHASES;
        void* kargs[] = {&a};
        const hipError_t le = hipLaunchCooperativeKernel((const void*)hymba_fwd, dim3(grid), dim3(NWAVES * 64), kargs, LDS_BYTES, stream);
        if (le != hipSuccess) fprintf(stderr, "kernel_launch: cooperative launch failed: %s (grid %d)\n", hipGetErrorName(le), grid);
    } else {
#ifndef PROBE_TWICE
#define PROBE_TWICE 0
#endif
        for (int li = 0; li < N_PHASES; ++li) { a.ph_lo = li; a.ph_hi = li + 1;
            if ((PROBE_TWICE >> li) & 1) hipLaunchKernelGGL(hymba_fwd, dim3(grid), dim3(NWAVES * 64), LDS_BYTES, stream, a);
            hipLaunchKernelGGL(hymba_fwd, dim3(grid), dim3(NWAVES * 64), LDS_BYTES, stream, a);
            const hipError_t le = hipPeekAtLastError();
            if (le != hipSuccess) { fprintf(stderr, "kernel_launch: launch %d failed: %s\n", li, hipGetErrorName(le)); break; } }
    }
}
```

```cpp
#include <hip/hip_runtime.h>
#include <cstdio>
#include <cstdint>
namespace pg8 {
#define PG8_LAS __attribute__((address_space(3)))
typedef unsigned short bf16_t;
typedef short bf16x8 __attribute__((ext_vector_type(8)));
typedef float f32x4 __attribute__((ext_vector_type(4)));
typedef unsigned u32x4 __attribute__((ext_vector_type(4)));
constexpr int BM = 256, BK = 64, HALF = 128, HTB = HALF * BK * 2  , STAGE_BYTES = 8 * HTB, NXCD = 8, WGM = 8;

__host__ __device__ __forceinline__ int lds_byte(int r, int c) { const int st = (r >> 4) * 2 + (c >> 5), rr = r & 15, cc = c & 31, ob = rr * 64 + cc * 2; return st * 1024 + (ob ^ (((ob >> 9) & 1) << 5)); }
__host__ __device__ __forceinline__ void stage_rc(int b, int& R, int& C) { const int st = b / 1024, sb = b % 1024, swz = sb ^ (((sb >> 9) & 1) << 5); R = (st >> 1) * 16 + swz / 64; C = (st & 1) * 32 + (swz % 64) / 2; }
__host__ __device__ __forceinline__ int perm32(int rho) { const int n = rho >> 4, i = rho & 15; return 8 * (i >> 2) + 4 * n + (i & 3); }

struct Unit { int pm, pn; };
struct Gemm { const bf16_t* A; const bf16_t* Bt; int M, N, K; };

struct StaticOrder {
    int nM, nN, nwg, G, c;
    __host__ __device__ void init(int M, int N, int G_, int c_) { nM = M / BM; nN = N / BM; nwg = nM * nN; G = G_; c = c_; }
    __host__ __device__ bool next(int i, Unit& u) const {
        const long L = (long)i * G + c; if (L >= nwg) return false;
        int wgid = (int)L; { const int q = nwg / NXCD, r = nwg % NXCD, xcd = wgid % NXCD, off = wgid / NXCD; wgid = (xcd < r ? xcd * (q + 1) : r * (q + 1) + (xcd - r) * q) + off; }
        const int nig = WGM * nN, gid = wgid / nig, fm = gid * WGM, gsz = (nM - fm) < WGM ? (nM - fm) : WGM;
        u.pm = fm + ((wgid % nig) % gsz); u.pn = (wgid % nig) / gsz; return true;
    }
    __device__ __forceinline__ void a_ready(const Unit&) const {}
    __device__ __forceinline__ void done(const Unit&) const {}
};

__device__ __forceinline__ unsigned cvt_pk_bf16(float lo, float hi) { unsigned r; asm volatile("v_cvt_pk_bf16_f32 %0, %1, %2" : "=v"(r) : "v"(lo), "v"(hi)); return r; }
struct EpiStoreBf16 {
    static constexpr bool PERM = true, AFTER_DRAIN = false;
    bf16_t* O; int ldc;
    __device__ __forceinline__ void operator()(const f32x4 (&acc)[2][2][4][2], const Unit& u, int wr, int wc, int fr, int fq) const {
        const int row0 = u.pm * BM + wr * 64 + fr; const int col0 = u.pn * BM + wc * 32 + 8 * fq;
#pragma unroll
        for (int ai = 0; ai < 2; ++ai)
#pragma unroll
            for (int m = 0; m < 4; ++m) { bf16_t* rowp = O + (size_t)(row0 + ai * HALF + m * 16) * ldc + col0;
#pragma unroll
                for (int bj = 0; bj < 2; ++bj) { const f32x4 v0 = acc[ai][bj][m][0], v1 = acc[ai][bj][m][1];
                    u32x4 w; w.x = cvt_pk_bf16(v0[0], v0[1]); w.y = cvt_pk_bf16(v0[2], v0[3]); w.z = cvt_pk_bf16(v1[0], v1[1]); w.w = cvt_pk_bf16(v1[2], v1[3]);
                    *(u32x4*)(rowp + bj * HALF) = w; } }
    }
};
struct EpiGateBf16 {
    static constexpr bool PERM = true, AFTER_DRAIN = false;
    bf16_t* out; int ldc; const float* gate; int gstride; int rows_per_batch;
    __device__ __forceinline__ void operator()(const f32x4 (&acc)[2][2][4][2], const Unit& u, int wr, int wc, int fr, int fq) const {
        const int b = (u.pm * BM) / rows_per_batch; const float* g = gate + (size_t)b * gstride;
        const int col0 = u.pn * BM + wc * 32 + 8 * fq;
        f32x4 gv[2][2];
#pragma unroll
        for (int bj = 0; bj < 2; ++bj)
#pragma unroll
            for (int n = 0; n < 2; ++n) gv[bj][n] = *(const f32x4*)(g + col0 + bj * HALF + n * 4);
#pragma unroll
        for (int ai = 0; ai < 2; ++ai)
#pragma unroll
            for (int m = 0; m < 4; ++m) { bf16_t* rowp = out + (size_t)(u.pm * BM + ai * HALF + wr * 64 + m * 16 + fr) * ldc + col0;
#pragma unroll
                for (int bj = 0; bj < 2; ++bj) { const f32x4 v0 = gv[bj][0] * acc[ai][bj][m][0], v1 = gv[bj][1] * acc[ai][bj][m][1];
                    u32x4 w; w.x = cvt_pk_bf16(v0[0], v0[1]); w.y = cvt_pk_bf16(v0[2], v0[3]); w.z = cvt_pk_bf16(v1[0], v1[1]); w.w = cvt_pk_bf16(v1[2], v1[3]);
                    *(u32x4*)(rowp + bj * HALF) = w; } }
    }
};

template <class Epi, class Sched, bool ALIGN_EPI = false, bool SP2 = false>
__device__ __forceinline__ void gemm_phase(PG8_LAS unsigned char* lds, const Gemm g, const Sched& S, const Epi& E) {
    const int tid = threadIdx.x, wid = __builtin_amdgcn_readfirstlane(tid >> 6), lane = tid & 63, wr = wid >> 2, wc = wid & 3, fr = lane & 15, fq = lane >> 4;
    const int K = g.K, nt = K / BK;
    unsigned voffA[2], voffB[2];
#pragma unroll
    for (int i = 0; i < 2; ++i) { int R, C; stage_rc(tid * 16 + i * 8192, R, C); const int Rb = Epi::PERM ? ((R & ~31) + perm32(R & 31)) : R;
        voffA[i] = (unsigned)(R * K + C) * 2u; voffB[i] = (unsigned)(Rb * K + C) * 2u; }
    const size_t kstep = (size_t)(BK * 2);
    const size_t hstep = (size_t)HALF * K * 2;
    const size_t tstep = 2 * hstep;
    const unsigned ldsw = (unsigned)wid * 1024u;
    const int aoff = lds_byte(wr * 64 + fr, fq * 8), boff = lds_byte(wc * 32 + fr, fq * 8);
#define PG8_SA(b, h) (((b) * 2 + (h)) * HTB)
#define PG8_SB(b, h) ((4 + (b) * 2 + (h)) * HTB)
#define PG8_STAGE(bufoff, gbase, voff) do { _Pragma("unroll") for (int _i = 0; _i < 2; ++_i) \
        __builtin_amdgcn_global_load_lds((const unsigned*)((const char*)(gbase) + (voff)[_i]), (PG8_LAS unsigned*)(lds + (bufoff) + ldsw + _i * 8192), 16, 0, 0); } while (0)
#define PG8_LDA(dst, b, h) do { _Pragma("unroll") for (int m = 0; m < 4; ++m) _Pragma("unroll") for (int k = 0; k < 2; ++k) dst[m][k] = *(const PG8_LAS bf16x8*)(lds + PG8_SA(b, h) + aoff + m * 2048 + k * 1024); } while (0)
#define PG8_LDB(dst, b, h) do { _Pragma("unroll") for (int n = 0; n < 2; ++n) _Pragma("unroll") for (int k = 0; k < 2; ++k) dst[n][k] = *(const PG8_LAS bf16x8*)(lds + PG8_SB(b, h) + boff + n * 2048 + k * 1024); } while (0)
#define PG8_MMA(ai, bj, At, Bt) do { __builtin_amdgcn_s_setprio(1); _Pragma("unroll") for (int m = 0; m < 4; ++m) _Pragma("unroll") for (int n = 0; n < 2; ++n) _Pragma("unroll") for (int k = 0; k < 2; ++k) \
        acc[ai][bj][m][n] = __builtin_amdgcn_mfma_f32_16x16x32_bf16(Bt[n][k], At[m][k], acc[ai][bj][m][n], 0, 0, 0); __builtin_amdgcn_s_setprio(0); } while (0)
#define PG8_WAIT_V(n) asm volatile("s_waitcnt vmcnt(" #n ")" ::: "memory")
#define PG8_WAIT_L(n) asm volatile("s_waitcnt lgkmcnt(" #n ")" ::: "memory")
#define PG8_BAR __builtin_amdgcn_s_barrier()
#define PG8_SCHED __builtin_amdgcn_sched_barrier(0)
    Unit cur, nxt; int ui = 0;
    if (!S.next(0, cur)) return;
    f32x4 acc[2][2][4][2];
#pragma unroll
    for (int a = 0; a < 2; ++a)
#pragma unroll
        for (int b = 0; b < 2; ++b)
#pragma unroll
            for (int m = 0; m < 4; ++m)
#pragma unroll
                for (int n = 0; n < 2; ++n) acc[a][b][m][n] = (f32x4){0.f, 0.f, 0.f, 0.f};
    bf16x8 At[4][2], B0[2][2], B1[2][2];
    const char* cA = (const char*)g.A + (size_t)cur.pm * tstep; const char* cB = (const char*)g.Bt + (size_t)cur.pn * tstep;
    S.a_ready(cur);
    if constexpr (SP2) {
        PG8_STAGE(PG8_SB(0, 0), cB, voffB); PG8_STAGE(PG8_SB(0, 1), cB + hstep, voffB); PG8_STAGE(PG8_SA(0, 0), cA, voffA); PG8_STAGE(PG8_SA(0, 1), cA + hstep, voffA);
        if (wr == 1) PG8_BAR;
        PG8_WAIT_V(2); PG8_BAR;
        PG8_STAGE(PG8_SB(1, 0), cB + kstep, voffB); PG8_STAGE(PG8_SA(1, 0), cA + kstep, voffA); PG8_STAGE(PG8_SB(1, 1), cB + hstep + kstep, voffB);
        PG8_WAIT_V(6); PG8_BAR;
    } else {
        PG8_STAGE(PG8_SB(0, 0), cB, voffB); PG8_STAGE(PG8_SA(0, 0), cA, voffA); PG8_STAGE(PG8_SB(0, 1), cB + hstep, voffB); PG8_STAGE(PG8_SA(0, 1), cA + hstep, voffA);
        if (wr == 1) PG8_BAR;
        PG8_WAIT_V(4); PG8_BAR;
        PG8_STAGE(PG8_SB(1, 0), cB + kstep, voffB); PG8_STAGE(PG8_SA(1, 0), cA + kstep, voffA); PG8_STAGE(PG8_SB(1, 1), cB + hstep + kstep, voffB);
        PG8_WAIT_V(6); PG8_BAR;
    }
    for (;;) {
        const bool has_next = S.next(ui + 1, nxt);
        const char* nA = has_next ? (const char*)g.A + (size_t)nxt.pm * tstep : cA; const char* nB = has_next ? (const char*)g.Bt + (size_t)nxt.pn * tstep : cB;
        for (int t = 0; t < nt; t += 2) {
            const bool last = (t == nt - 2);
            const char* a1 = cA + (size_t)(t + 1) * kstep;
            const char* a2 = last ? nA : cA + (size_t)(t + 2) * kstep; const char* b2 = last ? nB : cB + (size_t)(t + 2) * kstep;
            const char* a3 = a2 + kstep; const char* b3 = b2 + kstep;
            if (last && has_next) S.a_ready(nxt);
            if constexpr (SP2) {
            PG8_LDB(B0, 0, 0); PG8_LDB(B1, 0, 1); PG8_SCHED; PG8_LDA(At, 0, 0); PG8_STAGE(PG8_SA(1, 1), a1 + hstep, voffA);
            PG8_WAIT_V(8); PG8_WAIT_L(0); PG8_BAR; PG8_MMA(0, 0, At, B0); PG8_MMA(0, 1, At, B1); PG8_BAR; PG8_SCHED;
            PG8_LDA(At, 0, 1); PG8_STAGE(PG8_SB(0, 0), b2, voffB); PG8_STAGE(PG8_SB(0, 1), b2 + hstep, voffB); PG8_STAGE(PG8_SA(0, 0), a2, voffA);
            PG8_WAIT_V(8); PG8_WAIT_L(0); PG8_BAR; PG8_MMA(1, 0, At, B0); PG8_MMA(1, 1, At, B1); PG8_BAR; PG8_SCHED;
            PG8_LDB(B0, 1, 0); PG8_LDB(B1, 1, 1); PG8_SCHED; PG8_LDA(At, 1, 0); PG8_STAGE(PG8_SA(0, 1), a2 + hstep, voffA);
            PG8_WAIT_V(8); PG8_WAIT_L(0); PG8_BAR; PG8_MMA(0, 0, At, B0); PG8_MMA(0, 1, At, B1); PG8_BAR; PG8_SCHED;
            PG8_LDA(At, 1, 1); PG8_STAGE(PG8_SB(1, 0), b3, voffB); PG8_STAGE(PG8_SB(1, 1), b3 + hstep, voffB); PG8_STAGE(PG8_SA(1, 0), a3, voffA);
            PG8_WAIT_V(8); PG8_WAIT_L(0); PG8_BAR; PG8_MMA(1, 0, At, B0); PG8_MMA(1, 1, At, B1); PG8_BAR; PG8_SCHED;
            } else {
            PG8_LDB(B0, 0, 0); PG8_SCHED; PG8_LDA(At, 0, 0); PG8_STAGE(PG8_SA(1, 1), a1 + hstep, voffA);
            PG8_WAIT_L(8); PG8_BAR; PG8_WAIT_L(0); PG8_MMA(0, 0, At, B0); PG8_BAR; PG8_SCHED;
            PG8_LDB(B1, 0, 1); PG8_STAGE(PG8_SB(0, 0), b2, voffB);
            PG8_BAR; PG8_WAIT_L(0); PG8_MMA(0, 1, At, B1); PG8_BAR;
            PG8_LDA(At, 0, 1); PG8_STAGE(PG8_SA(0, 0), a2, voffA);
            PG8_BAR; PG8_WAIT_L(0); PG8_MMA(1, 0, At, B0); PG8_BAR; PG8_SCHED;
            PG8_STAGE(PG8_SB(0, 1), b2 + hstep, voffB);
            PG8_WAIT_V(6); PG8_BAR; PG8_MMA(1, 1, At, B1); PG8_BAR;
            PG8_LDB(B0, 1, 0); PG8_SCHED; PG8_LDA(At, 1, 0); PG8_STAGE(PG8_SA(0, 1), a2 + hstep, voffA);
            PG8_WAIT_L(8); PG8_BAR; PG8_WAIT_L(0); PG8_MMA(0, 0, At, B0); PG8_BAR; PG8_SCHED;
            PG8_LDB(B1, 1, 1); PG8_STAGE(PG8_SB(1, 0), b3, voffB);
            PG8_BAR; PG8_WAIT_L(0); PG8_MMA(0, 1, At, B1); PG8_BAR;
            PG8_LDA(At, 1, 1); PG8_STAGE(PG8_SA(1, 0), a3, voffA);
            PG8_BAR; PG8_WAIT_L(0); PG8_MMA(1, 0, At, B0); PG8_BAR; PG8_SCHED;
            PG8_STAGE(PG8_SB(1, 1), b3 + hstep, voffB);
            PG8_WAIT_V(6); PG8_BAR; PG8_MMA(1, 1, At, B1); PG8_BAR;
            }
        }
        if constexpr (ALIGN_EPI) { if (wr == 0) PG8_BAR; }
        if constexpr (!Epi::AFTER_DRAIN) { E(acc, cur, wr, wc, fr, fq); S.done(cur); }
        if (!has_next) break;
#pragma unroll
        for (int a = 0; a < 2; ++a)
#pragma unroll
            for (int b = 0; b < 2; ++b)
#pragma unroll
                for (int m = 0; m < 4; ++m)
#pragma unroll
                    for (int n = 0; n < 2; ++n) acc[a][b][m][n] = (f32x4){0.f, 0.f, 0.f, 0.f};
        cur = nxt; cA = nA; cB = nB; ++ui;
        if constexpr (ALIGN_EPI) { if (wr == 1) PG8_BAR; }
    }
    PG8_WAIT_V(0);
    if constexpr (!ALIGN_EPI) { if (wr == 0) PG8_BAR; }
    PG8_BAR;
    if constexpr (Epi::AFTER_DRAIN) { E.fused(acc, cur, wr, wc, fr, fq, lds, wid, lane); S.done(cur); }
#undef PG8_SA
#undef PG8_SB
#undef PG8_STAGE
#undef PG8_LDA
#undef PG8_LDB
#undef PG8_MMA
#undef PG8_WAIT_V
#undef PG8_WAIT_L
#undef PG8_BAR
#undef PG8_SCHED
}
}

constexpr int NWAVES = 8;
#ifndef MK_N_LAUNCHES
#define MK_N_LAUNCHES 1
#endif
constexpr int N_PHASES = 12;
constexpr int N_LAUNCHES = MK_N_LAUNCHES;

constexpr int BATCH = 4, SEQ = 4096, D = 2048, M = BATCH * SEQ;
constexpr int LRU_W = 1024, LRU_HEADS = 8, LRU_BLK = 128;
constexpr int HD = 64, HQ = 16, HKV = 2, GRP = 8;
constexpr int MIX_IN = 3328;
constexpr int C_Y = 1024, C_Q = 2048, C_K = 3072, C_V = 3200;
constexpr int ADA_W = 6 * D;
constexpr int PH = 8, PKEYS = 128, PHALF = 128, PTOPK = 16, NEXP = 16384;
constexpr float EPS = 1e-6f;

constexpr size_t MiB = 1u << 20;
constexpr size_t WS_CTL = 0, CTL_ZERO_BYTES = 64 * 1024;
constexpr size_t WS_ADA = 1 * MiB;
constexpr size_t WS_ROPE = 2 * MiB;
constexpr size_t WS_WIN = 4 * MiB;
constexpr size_t WS_WOUT = 17 * MiB;
constexpr size_t WS_WQ = 25 * MiB;
constexpr size_t WS_WGA = 33 * MiB;
constexpr size_t WS_WGX = 33 * MiB + 256 * 1024;
constexpr size_t WS_SK = 33 * MiB + 512 * 1024;
constexpr size_t WS_IDX = 34 * MiB;
constexpr size_t WS_GW = 42 * MiB;
constexpr size_t WS_U = 50 * MiB;
constexpr size_t WS_V = 82 * MiB;
constexpr size_t WS_USC = 1 * MiB + 512 * 1024;
constexpr size_t WS_VSC = 1 * MiB + 768 * 1024;
constexpr size_t WS_X1B = 114 * MiB;
constexpr size_t WS_XH = 178 * MiB;
constexpr size_t WS_PROJ = 242 * MiB;
constexpr size_t WS_HL = 346 * MiB;
constexpr size_t WS_PA = 410 * MiB;
constexpr size_t WS_PART = WS_HL;
constexpr size_t WS_W = WS_PROJ + 64 * MiB;
constexpr size_t WS_WSC = WS_PROJ + 68 * MiB;
constexpr size_t WS_H8 = WS_PROJ + 72 * MiB;
constexpr size_t WS_END = 474 * MiB;
constexpr int CW_BAR = 4096;

constexpr int RING_BYTES = 131072;
constexpr int LDSCTL_OFF = RING_BYTES, MISC_OFF = LDSCTL_OFF + 320;
constexpr int LDS_BYTES = 147456;

#define GAS __attribute__((address_space(1)))
#define LAS __attribute__((address_space(3)))
typedef unsigned short bf16;
typedef unsigned v4u __attribute__((ext_vector_type(4)));
typedef unsigned v2u __attribute__((ext_vector_type(2)));
typedef float f32x4 __attribute__((ext_vector_type(4)));
typedef float f32x2 __attribute__((ext_vector_type(2)));
typedef float f32x16 __attribute__((ext_vector_type(16)));
typedef short bf16x8 __attribute__((ext_vector_type(8)));
typedef __bf16 bf16x2v __attribute__((ext_vector_type(2)));
#define LDS_WAIT() asm volatile("s_waitcnt lgkmcnt(0)" ::: "memory")
#define VM_WAIT() asm volatile("s_waitcnt vmcnt(0)" ::: "memory")
__device__ __forceinline__ unsigned f2bf(float f) { unsigned u = __builtin_bit_cast(unsigned, f); return (u + 0x7fffu + ((u >> 16) & 1u)) >> 16; }
__device__ __forceinline__ unsigned pk2(float lo, float hi) { return f2bf(lo) | (f2bf(hi) << 16); }
__device__ __forceinline__ float bflo(unsigned u) { return __builtin_bit_cast(float, u << 16); }
__device__ __forceinline__ float bfhi(unsigned u) { return __builtin_bit_cast(float, u & 0xffff0000u); }
__device__ __forceinline__ float bf1(bf16 h) { return __builtin_bit_cast(float, (unsigned)h << 16); }
__device__ __forceinline__ float dot2bf(unsigned a, unsigned b, float acc) { return __builtin_amdgcn_fdot2_f32_bf16(__builtin_bit_cast(bf16x2v, a), __builtin_bit_cast(bf16x2v, b), acc, false); }
__device__ __forceinline__ float sigmoidf_(float x) { return 1.0f / (1.0f + __expf(-x)); }
__device__ __forceinline__ float gelu_tanh(float x) {
    const float z = 1.5957691216057308f * (x + 0.044715f * x * x * x);
    return x / (1.0f + __expf(-z));
}
__device__ __forceinline__ float wave_sum(float v) {
#pragma unroll
    for (int o = 1; o < 64; o <<= 1) v += __shfl_xor(v, o);
    return v;
}

#define XB_TMO      128
#define XB_XCNT(j)  (256  + 64 * (j))
#define XB_XSUB(j)  (1280 + 64 * (j))
#define XB_XGEN(j)  (2304 + 64 * (j))
#define XB_TOP      3328
#define XB_TOPGEN   3392
#define XCD_BAR_WORDS 3456
#define XB_SPIN_CAP (1u << 18)
__device__ __forceinline__ unsigned xb_ld(unsigned* p)              { return __hip_atomic_load(p, __ATOMIC_RELAXED, __HIP_MEMORY_SCOPE_AGENT); }
__device__ __forceinline__ unsigned xb_add(unsigned* p, unsigned v) { return __hip_atomic_fetch_add(p, v, __ATOMIC_RELAXED, __HIP_MEMORY_SCOPE_AGENT); }
__device__ __forceinline__ unsigned xb_xcc_id() { return (unsigned)__builtin_amdgcn_s_getreg((3 << 11) | 20) & 0xFu; }
#define XB_SPIN(cond, bar) do { unsigned _sp = 0; while (cond) { __builtin_amdgcn_s_sleep(1); \
    if ((++_sp & 255u) == 0u) { if (xb_ld(&(bar)[XB_TMO])) break; if (_sp > XB_SPIN_CAP) { atomicAdd(&(bar)[XB_TMO], 1u); break; } } } } while (0)
struct XcdBarrier { unsigned* bar; unsigned x; volatile LAS unsigned* st; };
__device__ __forceinline__ XcdBarrier xcd_barrier_post(unsigned* bar, volatile LAS unsigned* st) {
    XcdBarrier b; b.bar = bar; b.x = xb_xcc_id(); b.st = st;
    if (threadIdx.x == 0) (void)xb_add(&bar[XB_XCNT(b.x)], 1u);
    return b;
}
__device__ __forceinline__ void xcd_barrier_complete(unsigned* bar, unsigned x, unsigned& nloc, unsigned& nx) {
    const unsigned G = gridDim.x * gridDim.y * gridDim.z;
    unsigned sum, cnt, mine, sp = 0u;
    for (;;) {
        sum = 0u; cnt = 0u; mine = 0u;
#pragma unroll
        for (unsigned j = 0; j < 16; ++j) { const unsigned c = xb_ld(&bar[XB_XCNT(j)]); sum += c; cnt += (c > 0u) ? 1u : 0u; mine = (j == x) ? c : mine; }
        if (sum == G) break;
        __builtin_amdgcn_s_sleep(1);
        if ((++sp & 255u) == 0u) { if (xb_ld(&bar[XB_TMO])) break; if (sp > XB_SPIN_CAP) { atomicAdd(&bar[XB_TMO], 1u); break; } }
    }
    nloc = mine > 0u ? mine : 1u; nx = cnt > 0u ? cnt : 1u;
}
__device__ __forceinline__ void xcd_barrier(const XcdBarrier& b) {
    asm volatile("s_waitcnt vmcnt(0)" ::: "memory");
    __syncthreads();
    if (threadIdx.x == 0) {
        unsigned* bar = b.bar;
        __builtin_amdgcn_s_waitcnt(0);
        unsigned nloc = b.st[0], nx = b.st[1];
        if (nloc == 0u) { xcd_barrier_complete(bar, b.x, nloc, nx); b.st[0] = nloc; b.st[1] = nx; }
        const unsigned old = xb_add(&bar[XB_XSUB(b.x)], 1u);
        const unsigned gen = old / nloc;
        if (old + 1u == (gen + 1u) * nloc) {
            __builtin_amdgcn_fence(__ATOMIC_RELEASE, "agent");
            asm volatile("s_waitcnt vmcnt(0)" ::: "memory");
            const unsigned og = xb_add(&bar[XB_TOP], 1u);
            const unsigned tg = og / nx;
            if (og + 1u == (tg + 1u) * nx) xb_add(&bar[XB_TOPGEN], 1u);
            else XB_SPIN(xb_ld(&bar[XB_TOPGEN]) == tg, bar);
            __builtin_amdgcn_fence(__ATOMIC_ACQUIRE, "agent");
            xb_add(&bar[XB_XGEN(b.x)], 1u);
            asm volatile("s_waitcnt vmcnt(0)" ::: "memory");
        } else {
            XB_SPIN(xb_ld(&bar[XB_XGEN(b.x)]) == gen, bar);
            __builtin_amdgcn_fence(__ATOMIC_ACQUIRE, "agent");
            asm volatile("s_waitcnt vmcnt(0)" ::: "memory");
        }
    }
    __syncthreads();
}

typedef const __attribute__((address_space(4))) unsigned char* kaptr_t;
struct Frame { LAS unsigned char* lds; int tid, lane, wave, G, bid; kaptr_t ka; };
template <class T> __device__ __forceinline__ T* ka_ptr(const Frame& F, int byte_off) { typedef T* tp; return *(const __attribute__((address_space(4))) tp*)(F.ka + byte_off); }
__device__ __forceinline__ const float* P_x(const Frame& F) { return ka_ptr<const float>(F, 0); }
__device__ __forceinline__ const float* P_c(const Frame& F) { return ka_ptr<const float>(F, 8); }
__device__ __forceinline__ const int* P_pos(const Frame& F) { return ka_ptr<const int>(F, 16); }
__device__ __forceinline__ const float* P_w_ada(const Frame& F) { return ka_ptr<const float>(F, 24); }
__device__ __forceinline__ const float* P_b_ada(const Frame& F) { return ka_ptr<const float>(F, 32); }
__device__ __forceinline__ const float* P_norm1_g(const Frame& F) { return ka_ptr<const float>(F, 40); }
__device__ __forceinline__ const float* P_w_in(const Frame& F) { return ka_ptr<const float>(F, 48); }
__device__ __forceinline__ const float* P_conv_w(const Frame& F) { return ka_ptr<const float>(F, 56); }
__device__ __forceinline__ const float* P_conv_b(const Frame& F) { return ka_ptr<const float>(F, 64); }
__device__ __forceinline__ const float* P_ga_w(const Frame& F) { return ka_ptr<const float>(F, 72); }
__device__ __forceinline__ const float* P_ga_b(const Frame& F) { return ka_ptr<const float>(F, 80); }
__device__ __forceinline__ const float* P_gx_w(const Frame& F) { return ka_ptr<const float>(F, 88); }
__device__ __forceinline__ const float* P_gx_b(const Frame& F) { return ka_ptr<const float>(F, 96); }
__device__ __forceinline__ const float* P_lam(const Frame& F) { return ka_ptr<const float>(F, 104); }
__device__ __forceinline__ const float* P_qn_g(const Frame& F) { return ka_ptr<const float>(F, 112); }
__device__ __forceinline__ const float* P_kn_g(const Frame& F) { return ka_ptr<const float>(F, 120); }
__device__ __forceinline__ const float* P_sinks(const Frame& F) { return ka_ptr<const float>(F, 128); }
__device__ __forceinline__ const float* P_on_lru_g(const Frame& F) { return ka_ptr<const float>(F, 136); }
__device__ __forceinline__ const float* P_on_attn_g(const Frame& F) { return ka_ptr<const float>(F, 144); }
__device__ __forceinline__ const float* P_w_out(const Frame& F) { return ka_ptr<const float>(F, 152); }
__device__ __forceinline__ const float* P_norm2_g(const Frame& F) { return ka_ptr<const float>(F, 160); }
__device__ __forceinline__ const float* P_w_pq(const Frame& F) { return ka_ptr<const float>(F, 168); }
__device__ __forceinline__ const float* P_sub_keys(const Frame& F) { return ka_ptr<const float>(F, 176); }
__device__ __forceinline__ const float* P_pu(const Frame& F) { return ka_ptr<const float>(F, 184); }
__device__ __forceinline__ const float* P_pv(const Frame& F) { return ka_ptr<const float>(F, 192); }
__device__ __forceinline__ float* P_out(const Frame& F) { return ka_ptr<float>(F, 200); }
__device__ __forceinline__ unsigned char* P_ws(const Frame& F) { return ka_ptr<unsigned char>(F, 208); }
__device__ __forceinline__ float* P_ADA(const Frame& F) { return (float*)(P_ws(F) + WS_ADA); }
__device__ __forceinline__ float* P_ROPE(const Frame& F) { return (float*)(P_ws(F) + WS_ROPE); }
__device__ __forceinline__ bf16* P_HL(const Frame& F) { return (bf16*)(P_ws(F) + WS_HL); }
__device__ __forceinline__ bf16* P_PA(const Frame& F) { return (bf16*)(P_ws(F) + WS_PA); }
__device__ __forceinline__ float* P_GW(const Frame& F) { return (float*)(P_ws(F) + WS_GW); }
__device__ __forceinline__ unsigned short* P_IDX(const Frame& F) { return (unsigned short*)(P_ws(F) + WS_IDX); }
__device__ __forceinline__ bf16* P_WIN(const Frame& F) { return (bf16*)(P_ws(F) + WS_WIN); }
__device__ __forceinline__ bf16* P_WOUT(const Frame& F) { return (bf16*)(P_ws(F) + WS_WOUT); }
__device__ __forceinline__ bf16* P_WQ(const Frame& F) { return (bf16*)(P_ws(F) + WS_WQ); }
__device__ __forceinline__ bf16* P_WGA(const Frame& F) { return (bf16*)(P_ws(F) + WS_WGA); }
__device__ __forceinline__ bf16* P_WGX(const Frame& F) { return (bf16*)(P_ws(F) + WS_WGX); }
__device__ __forceinline__ bf16* P_SK(const Frame& F) { return (bf16*)(P_ws(F) + WS_SK); }
__device__ __forceinline__ unsigned char* P_U(const Frame& F) { return (unsigned char*)(P_ws(F) + WS_U); }
__device__ __forceinline__ bf16* P_X1B(const Frame& F) { return (bf16*)(P_ws(F) + WS_X1B); }
__device__ __forceinline__ unsigned char* P_H8(const Frame& F) { return (unsigned char*)(P_ws(F) + WS_H8); }
__device__ __forceinline__ unsigned* P_PART(const Frame& F) { return (unsigned*)(P_ws(F) + WS_PART); }
__device__ __forceinline__ unsigned char* P_W(const Frame& F) { return (unsigned char*)(P_ws(F) + WS_W); }
__device__ __forceinline__ float* P_WSC(const Frame& F) { return (float*)(P_ws(F) + WS_WSC); }
__device__ __forceinline__ float* P_USC(const Frame& F) { return (float*)(P_ws(F) + WS_USC); }
__device__ __forceinline__ float* P_VSC(const Frame& F) { return (float*)(P_ws(F) + WS_VSC); }
__device__ __forceinline__ unsigned char* P_V(const Frame& F) { return (unsigned char*)(P_ws(F) + WS_V); }
__device__ __forceinline__ bf16* P_XH(const Frame& F) { return (bf16*)(P_ws(F) + WS_XH); }
__device__ __forceinline__ bf16* P_PROJ(const Frame& F) { return (bf16*)(P_ws(F) + WS_PROJ); }

__device__ __forceinline__ void p0_transpose_item(const float* W, int K, int N, bf16* WT, LAS float* scr, int item, int lane) {
    const int nblk = N / 32, kb = item / nblk, nb = item % nblk, k0 = 64 * kb, n0 = 32 * nb;
#pragma unroll 8
    for (int i = 0; i < 32; ++i) { const int kk = 2 * i + (lane >> 5); scr[kk * 33 + (lane & 31)] = W[(size_t)(k0 + kk) * N + n0 + (lane & 31)]; }
    LDS_WAIT(); asm volatile("" ::: "memory");
    const int c = lane & 7;
#pragma unroll
    for (int j = 0; j < 4; ++j) { const int n = (lane >> 3) + 8 * j; const LAS float* s = scr + (8 * c) * 33 + n;
        v4u o; o.x = pk2(s[0 * 33], s[1 * 33]); o.y = pk2(s[2 * 33], s[3 * 33]); o.z = pk2(s[4 * 33], s[5 * 33]); o.w = pk2(s[6 * 33], s[7 * 33]);
        *(v4u*)(WT + (size_t)(n0 + n) * K + k0 + 8 * c) = o; }
    LDS_WAIT(); asm volatile("" ::: "memory");
}
__device__ __forceinline__ void p0_convert(const float* src, bf16* dst, size_t n8, size_t gtid, size_t gthreads) {
    for (size_t i = gtid; i < n8; i += gthreads) {
        const f32x4 a = *(const f32x4*)(src + 8 * i), b = *(const f32x4*)(src + 8 * i + 4);
        v4u o; o.x = pk2(a.x, a.y); o.y = pk2(a.z, a.w); o.z = pk2(b.x, b.y); o.w = pk2(b.z, b.w);
        *(v4u*)(dst + 8 * i) = o;
    }
}
#ifndef QUANT_SPLIT
#define QUANT_SPLIT 14336
#endif
__device__ __forceinline__ void quant_rows(Frame& F, int r0, int r1, int w, int nw) {
    for (int rr = r0 + w; rr < r1; rr += nw) {
        const int tbl = rr >= NEXP, row = rr - tbl * NEXP;
        const float* srcp = (tbl ? P_pv(F) : P_pu(F)) + (size_t)row * D;
        unsigned char* dstp = (tbl ? P_V(F) : P_U(F)) + (size_t)row * 128 + (size_t)(F.lane >> 5) * (NEXP * 128) + ((4 * F.lane) & 127);
        f32x4 v[8]; float mx = 0.f;
#pragma unroll
        for (int j = 0; j < 8; ++j) { v[j] = *(const f32x4*)(srcp + 4 * F.lane + 256 * j);
            mx = fmaxf(fmaxf(mx, fmaxf(fabsf(v[j].x), fabsf(v[j].y))), fmaxf(fabsf(v[j].z), fabsf(v[j].w))); }
#pragma unroll
        for (int o = 1; o < 64; o <<= 1) mx = fmaxf(mx, __shfl_xor(mx, o));
        if (tbl) {
            const float s = fmaxf(mx, 1e-30f) * (1.0f / 224.0f), inv = 1.0f / s;
#pragma unroll
            for (int j = 0; j < 8; ++j) { int t = __builtin_amdgcn_cvt_pk_fp8_f32(v[j].x * inv, v[j].y * inv, 0, false);
                t = __builtin_amdgcn_cvt_pk_fp8_f32(v[j].z * inv, v[j].w * inv, t, true);
                *(int*)(dstp + (size_t)(2 * j) * (NEXP * 128)) = t; }
            if (F.lane == 0) P_VSC(F)[row] = s;
        } else {
            const float s = fmaxf(mx, 1e-30f) * (1.0f / 6.0f), inv = 1.0f / s;
            unsigned char* d4 = P_U(F) + (size_t)row * 128 + 2 * F.lane;
#pragma unroll
            for (int j = 0; j < 8; ++j) { unsigned t = __builtin_amdgcn_cvt_scalef32_pk_fp4_f32(0u, v[j].x * inv, v[j].y * inv, 1.0f, 0);
                t = __builtin_amdgcn_cvt_scalef32_pk_fp4_f32(t, v[j].z * inv, v[j].w * inv, 1.0f, 1);
                *(unsigned short*)(d4 + (size_t)j * (NEXP * 128)) = (unsigned short)t; }
            if (F.lane == 0) P_USC(F)[row] = s;
        }
    }
}
__device__ __forceinline__ void p0_prologue(Frame& F) {
    {
        LAS float* sc = (LAS float*)F.lds;
        LAS float* red = sc + 4 * D;
        for (int i = F.tid; i < 4 * D; i += 512) { const float v = P_c(F)[i]; sc[i] = v / (1.0f + __expf(-v)); }
        __syncthreads();
        for (int cg = F.bid; cg < ADA_W / 64; cg += F.G) {
            const int n0 = cg * 64, k0 = F.wave * 256;
            const float* wp = P_w_ada(F) + (size_t)k0 * ADA_W + n0 + F.lane;
            float a0 = 0.f, a1 = 0.f, a2 = 0.f, a3 = 0.f;
#pragma unroll 16
            for (int k = 0; k < 256; ++k) { const float w = wp[(size_t)k * ADA_W]; const int kk = k0 + k;
                a0 += sc[kk] * w; a1 += sc[D + kk] * w; a2 += sc[2 * D + kk] * w; a3 += sc[3 * D + kk] * w; }
            red[(F.wave * 4 + 0) * 64 + F.lane] = a0; red[(F.wave * 4 + 1) * 64 + F.lane] = a1;
            red[(F.wave * 4 + 2) * 64 + F.lane] = a2; red[(F.wave * 4 + 3) * 64 + F.lane] = a3;
            __syncthreads();
            if (F.tid < 256) { const int b = F.tid >> 6, l = F.tid & 63; float s = 0.f;
#pragma unroll
                for (int w = 0; w < 8; ++w) s += red[(w * 4 + b) * 64 + l];
                P_ADA(F)[(size_t)b * ADA_W + n0 + l] = s + P_b_ada(F)[n0 + l]; }
            __syncthreads();
        }
        __syncthreads();
    }
    {
        LAS float* scr = (LAS float*)(F.lds + F.wave * 16384);
        const int gw = F.bid * NWAVES + F.wave, NGW = F.G * NWAVES;
        constexpr int I_IN = (D / 64) * (MIX_IN / 32), I_SQ = (D / 64) * (D / 32), I_G = (LRU_BLK / 64) * (LRU_BLK / 32);
        constexpr int NITEMS = I_IN + 2 * I_SQ + 16 * I_G;
        for (int it = gw; it < NITEMS; it += NGW) {
            int r = it;
            if (r < I_IN) { p0_transpose_item(P_w_in(F), D, MIX_IN, P_WIN(F), scr, r, F.lane); continue; } r -= I_IN;
            if (r < I_SQ) { p0_transpose_item(P_w_out(F), D, D, P_WOUT(F), scr, r, F.lane); continue; } r -= I_SQ;
            if (r < I_SQ) { p0_transpose_item(P_w_pq(F), D, D, P_WQ(F), scr, r, F.lane); continue; } r -= I_SQ;
            const int g = r / I_G, ri = r % I_G, hd = g & 7;
            if (g < 8) p0_transpose_item(P_ga_w(F) + (size_t)hd * 16384, LRU_BLK, LRU_BLK, P_WGA(F) + (size_t)hd * 16384, scr, ri, F.lane);
            else       p0_transpose_item(P_gx_w(F) + (size_t)hd * 16384, LRU_BLK, LRU_BLK, P_WGX(F) + (size_t)hd * 16384, scr, ri, F.lane);
        }
    }
    {
        const size_t gtid = (size_t)F.bid * 512 + F.tid, gth = (size_t)F.G * 512;
        p0_convert(P_sub_keys(F), P_SK(F), (size_t)PH * 2 * PKEYS * PHALF / 8, gtid, gth);
    }
    quant_rows(F, 0, QUANT_SPLIT, F.bid * NWAVES + F.wave, F.G * NWAVES);
}

template <bool RESID, int R> __device__ __forceinline__ void modnorm_rows(const float* xin, const float* gain, const float* shift, const float* scale, bf16* orow, int lane, bf16* xin2 = nullptr, unsigned char* o8 = nullptr) {
    f32x4 v[R][8]; float s[R];
#pragma unroll
    for (int r = 0; r < R; ++r) { s[r] = 0.f;
#pragma unroll
        for (int j = 0; j < 8; ++j) {
            v[r][j] = *(const f32x4*)(xin + (size_t)r * D + 4 * lane + 256 * j);
            if (RESID) { bf16* dp = xin2 + (size_t)r * D + 4 * lane + 256 * j; const v2u q = *(const v2u*)dp; v[r][j] += (f32x4){bflo(q.x), bfhi(q.x), bflo(q.y), bfhi(q.y)};
                v2u o; o.x = pk2(v[r][j].x, v[r][j].y); o.y = pk2(v[r][j].z, v[r][j].w); *(v2u*)dp = o; } } }
#pragma unroll
    for (int r = 0; r < R; ++r)
#pragma unroll
        for (int j = 0; j < 8; ++j) s[r] += (v[r][j].x * v[r][j].x + v[r][j].y * v[r][j].y) + (v[r][j].z * v[r][j].z + v[r][j].w * v[r][j].w);
#pragma unroll
    for (int o = 1; o < 64; o <<= 1) {
#pragma unroll
        for (int r = 0; r < R; ++r) s[r] += __shfl_xor(s[r], o); }
    float rstd[R];
#pragma unroll
    for (int r = 0; r < R; ++r) rstd[r] = 1.0f / sqrtf(s[r] * (1.0f / D) + EPS);
#pragma unroll
    for (int j = 0; j < 8; ++j) {
        const int c = 4 * lane + 256 * j;
        const f32x4 g = *(const f32x4*)(gain + c), sh = *(const f32x4*)(shift + c), sc = *(const f32x4*)(scale + c);
        const f32x4 gm = g * (sc + 1.0f);
#pragma unroll
        for (int r = 0; r < R; ++r) { const f32x4 y = (v[r][j] * rstd[r]) * gm + sh;
            v2u o; o.x = pk2(y.x, y.y); o.y = pk2(y.z, y.w);
            *(v2u*)(orow + (size_t)r * D + c) = o;
            if (RESID) { int t = __builtin_amdgcn_cvt_pk_fp8_f32(y.x, y.y, 0, false); t = __builtin_amdgcn_cvt_pk_fp8_f32(y.z, y.w, t, true); *(int*)(o8 + (size_t)r * D + c) = t; } }
    }
}
__device__ __forceinline__ void p1_phase(Frame& F) {
    const int gw = F.bid * NWAVES + F.wave, NGW = F.G * NWAVES;
    for (int m = 4 * gw; m < M; m += 4 * NGW) { const int b = m / SEQ; const float* ada = P_ADA(F) + (size_t)b * ADA_W;
        modnorm_rows<false, 4>(P_x(F) + (size_t)m * D, P_norm1_g(F), ada, ada + D, P_XH(F) + (size_t)m * D, F.lane); }
    const float invf[8] = {1.0f, 1.9392274e-01f, 3.7606031e-02f, 7.2926646e-03f, 1.4142136e-03f, 2.7424819e-04f, 5.3182961e-05f, 1.0313386e-05f};
    for (int i = F.bid * 512 + F.tid; i < M * 8; i += F.G * 512) { const int m = i >> 3, k = i & 7;
        float f = invf[0];
#pragma unroll
        for (int q = 1; q < 8; ++q) f = (k == q) ? invf[q] : f;
        const float ang = (float)P_pos(F)[m] * f; float sn, cs; sincosf(ang, &sn, &cs);
        P_ROPE(F)[(size_t)m * 16 + k] = cs; P_ROPE(F)[(size_t)m * 16 + 8 + k] = sn; }
}
__device__ __forceinline__ void p6_phase(Frame& F) {
    const int gw = F.bid * NWAVES + F.wave, NGW = F.G * NWAVES;
    for (int m = 4 * gw; m < M; m += 4 * NGW) { const int b = m / SEQ; const float* ada = P_ADA(F) + (size_t)b * ADA_W;
        modnorm_rows<true, 4>(P_x(F) + (size_t)m * D, P_norm2_g(F), ada + 3 * D, ada + 4 * D, P_XH(F) + (size_t)m * D, F.lane, P_X1B(F) + (size_t)m * D, P_H8(F) + (size_t)m * D); }
}

#define MFMA32(a, b, c) __builtin_amdgcn_mfma_f32_32x32x16_bf16((a), (b), (c), 0, 0, 0)
#define MFMA16(a, b, c) __builtin_amdgcn_mfma_f32_16x16x32_bf16((a), (b), (c), 0, 0, 0)
constexpr int KS_STRIDE = 72;
constexpr int VT_STRIDE = 264;
constexpr int ATT_KS_OFF = 0, ATT_VT_OFF = 256 * KS_STRIDE * 2;
static_assert(ATT_VT_OFF + 64 * VT_STRIDE * 2 <= RING_BYTES, "attention LDS");

__device__ __forceinline__ void attn_unit(Frame& F, int b, int g, int n) {
    LAS bf16* Ks = (LAS bf16*)(F.lds + ATT_KS_OFF);
    LAS bf16* VT = (LAS bf16*)(F.lds + ATT_VT_OFF);
    const int tid = F.tid, lane = F.lane;
    {
        const int kb = tid >> 1, hf = tid & 1; const int t = n * 128 - 128 + kb;
        float kv[32]; v4u vraw[4];
        if (t >= 0) {
            const bf16* kp = P_PROJ(F) + (size_t)(b * SEQ + t) * MIX_IN + C_K + g * HD + 32 * hf;
            const bf16* vp = P_PROJ(F) + (size_t)(b * SEQ + t) * MIX_IN + C_V + g * HD + 32 * hf;
#pragma unroll
            for (int q = 0; q < 4; ++q) { const v4u r = *(const v4u*)(kp + 8 * q); vraw[q] = *(const v4u*)(vp + 8 * q);
                kv[8 * q + 0] = bflo(r.x); kv[8 * q + 1] = bfhi(r.x); kv[8 * q + 2] = bflo(r.y); kv[8 * q + 3] = bfhi(r.y);
                kv[8 * q + 4] = bflo(r.z); kv[8 * q + 5] = bfhi(r.z); kv[8 * q + 6] = bflo(r.w); kv[8 * q + 7] = bfhi(r.w); }
        } else {
#pragma unroll
            for (int q = 0; q < 4; ++q) vraw[q] = (v4u){0u, 0u, 0u, 0u};
#pragma unroll
            for (int q = 0; q < 32; ++q) kv[q] = 0.f;
        }
        float ss = 0.f;
#pragma unroll
        for (int q = 0; q < 32; ++q) ss += kv[q] * kv[q];
        ss += __shfl_xor(ss, 1);
        const float rstd = 1.0f / sqrtf(ss * (1.0f / HD) + EPS);
#pragma unroll
        for (int q = 0; q < 32; ++q) kv[q] = kv[q] * rstd * P_kn_g(F)[32 * hf + q];
        if (hf == 0 && t >= 0) {
            const float* rp = P_ROPE(F) + (size_t)(b * SEQ + t) * 16;
#pragma unroll
            for (int i = 0; i < 8; ++i) { const float cs = rp[i], sn = rp[8 + i]; const float x1 = kv[i], x2 = kv[8 + i];
                kv[i] = x1 * cs - x2 * sn; kv[8 + i] = x2 * cs + x1 * sn; }
        }
#pragma unroll
        for (int q = 0; q < 4; ++q) { v4u o; o.x = pk2(kv[8 * q], kv[8 * q + 1]); o.y = pk2(kv[8 * q + 2], kv[8 * q + 3]); o.z = pk2(kv[8 * q + 4], kv[8 * q + 5]); o.w = pk2(kv[8 * q + 6], kv[8 * q + 7]);
            *(LAS v4u*)(Ks + kb * KS_STRIDE + 32 * hf + 8 * q) = o; }
#pragma unroll
        for (int q = 0; q < 4; ++q) { const unsigned w[4] = {vraw[q].x, vraw[q].y, vraw[q].z, vraw[q].w};
#pragma unroll
            for (int e = 0; e < 4; ++e) { const int d = 32 * hf + 8 * q + 2 * e;
                VT[d * VT_STRIDE + kb] = (bf16)(w[e] & 0xffffu); VT[(d + 1) * VT_STRIDE + kb] = (bf16)(w[e] >> 16); } }
    }
    __syncthreads();
    const int hq = g * GRP + F.wave, r = lane & 31, hh = lane >> 5;
    const float sink = P_sinks(F)[hq];
    for (int qi = 0; qi < 4; ++qi) {
        const int tq = n * 128 + 32 * qi + r;
        bf16x8 qf[4];
        {
            const bf16* qp = P_PROJ(F) + (size_t)(b * SEQ + tq) * MIX_IN + C_Q + hq * HD + 8 * hh;
            float qv[4][8]; float ss = 0.f;
#pragma unroll
            for (int ks = 0; ks < 4; ++ks) { const v4u rr = *(const v4u*)(qp + 16 * ks);
                qv[ks][0] = bflo(rr.x); qv[ks][1] = bfhi(rr.x); qv[ks][2] = bflo(rr.y); qv[ks][3] = bfhi(rr.y);
                qv[ks][4] = bflo(rr.z); qv[ks][5] = bfhi(rr.z); qv[ks][6] = bflo(rr.w); qv[ks][7] = bfhi(rr.w);
#pragma unroll
                for (int j = 0; j < 8; ++j) ss += qv[ks][j] * qv[ks][j]; }
            ss += __shfl_xor(ss, 32);
            const float rstd = 1.0f / sqrtf(ss * (1.0f / HD) + EPS);
#pragma unroll
            for (int ks = 0; ks < 4; ++ks)
#pragma unroll
                for (int j = 0; j < 8; ++j) qv[ks][j] = qv[ks][j] * rstd * P_qn_g(F)[16 * ks + 8 * hh + j];
            const float* rp = P_ROPE(F) + (size_t)(b * SEQ + tq) * 16;
#pragma unroll
            for (int j = 0; j < 8; ++j) { const float mine = qv[0][j], other = __shfl_xor(mine, 32); const float cs = rp[j], sn = rp[8 + j];
                qv[0][j] = hh == 0 ? (mine * cs - other * sn) : (mine * cs + other * sn); }
#pragma unroll
            for (int ks = 0; ks < 4; ++ks) { v4u o; o.x = pk2(qv[ks][0] * 0.125f, qv[ks][1] * 0.125f); o.y = pk2(qv[ks][2] * 0.125f, qv[ks][3] * 0.125f);
                o.z = pk2(qv[ks][4] * 0.125f, qv[ks][5] * 0.125f); o.w = pk2(qv[ks][6] * 0.125f, qv[ks][7] * 0.125f); qf[ks] = __builtin_bit_cast(bf16x8, o); }
        }
        f32x16 s[5];
#pragma unroll
        for (int kj = 0; kj < 5; ++kj) {
            f32x16 acc;
#pragma unroll
            for (int i = 0; i < 16; ++i) acc[i] = 0.f;
            const LAS bf16* kp = Ks + (32 * (qi + kj) + r) * KS_STRIDE + 8 * hh;
#pragma unroll
            for (int ks = 0; ks < 4; ++ks) { const bf16x8 kf = *(const LAS bf16x8*)(kp + 16 * ks); acc = MFMA32(kf, qf[ks], acc); }
            s[kj] = acc;
        }
        float mx = sink;
#pragma unroll
        for (int kj = 0; kj < 5; ++kj)
#pragma unroll
            for (int i = 0; i < 16; ++i) { const int kt = (i & 3) + 8 * (i >> 2) + 4 * hh; const int kbi = 32 * (qi + kj) + kt;
                bool valid = (n * 128 + kbi - 128) >= 0;
                if (kj == 0) valid = valid && (kt > r);
                if (kj == 4) valid = valid && (kt <= r);
                s[kj][i] = valid ? s[kj][i] : -INFINITY; mx = fmaxf(mx, s[kj][i]); }
        mx = fmaxf(mx, __shfl_xor(mx, 32));
        float l = 0.f;
#pragma unroll
        for (int kj = 0; kj < 5; ++kj)
#pragma unroll
            for (int i = 0; i < 16; ++i) { const float p = __expf(s[kj][i] - mx); s[kj][i] = p; l += p; }
        l += __shfl_xor(l, 32);
        l += __expf(sink - mx);
        const float inv = 1.0f / l;
        f32x16 o0, o1;
#pragma unroll
        for (int i = 0; i < 16; ++i) { o0[i] = 0.f; o1[i] = 0.f; }
#pragma unroll
        for (int kj = 0; kj < 5; ++kj)
#pragma unroll
            for (int st = 0; st < 2; ++st) {
                v4u pa; pa.x = pk2(s[kj][8 * st + 0] * inv, s[kj][8 * st + 1] * inv); pa.y = pk2(s[kj][8 * st + 2] * inv, s[kj][8 * st + 3] * inv);
                pa.z = pk2(s[kj][8 * st + 4] * inv, s[kj][8 * st + 5] * inv); pa.w = pk2(s[kj][8 * st + 6] * inv, s[kj][8 * st + 7] * inv);
                const bf16x8 pf = __builtin_bit_cast(bf16x8, pa);
                const int kb0 = 32 * (qi + kj) + 16 * st + 4 * hh;
                const LAS bf16* v0p = VT + r * VT_STRIDE + kb0; const LAS bf16* v1p = VT + (32 + r) * VT_STRIDE + kb0;
                const v2u a0 = *(const LAS v2u*)v0p, a1 = *(const LAS v2u*)(v0p + 8), b0 = *(const LAS v2u*)v1p, b1 = *(const LAS v2u*)(v1p + 8);
                const v4u vb0 = {a0.x, a0.y, a1.x, a1.y}, vb1 = {b0.x, b0.y, b1.x, b1.y};
                o0 = MFMA32(pf, __builtin_bit_cast(bf16x8, vb0), o0);
                o1 = MFMA32(pf, __builtin_bit_cast(bf16x8, vb1), o1);
            }
#pragma unroll
        for (int i = 0; i < 16; ++i) { const int qr = (i & 3) + 8 * (i >> 2) + 4 * hh; const int tok = n * 128 + 32 * qi + qr;
            bf16* op = P_XH(F) + (size_t)(b * SEQ + tok) * D + LRU_W + hq * HD + r;
            op[0] = (bf16)f2bf(o0[i]); op[32] = (bf16)f2bf(o1[i]); }
    }
    __syncthreads();
}

constexpr int LCH = 64;
constexpr int XC_STRIDE = 136;
constexpr int LRU_XCB_OFF = 0, LRU_XCF_OFF = LCH * XC_STRIDE * 2  , LRU_A_OFF = LRU_XCF_OFF + LCH * 128 * 4, LRU_B_OFF = LRU_A_OFF + LCH * 128 * 4, LRU_SE_OFF = LRU_B_OFF + LCH * 128 * 4;
static_assert(LRU_SE_OFF + 2 * 4 * 128 * 4 <= RING_BYTES, "LRU LDS");
__device__ __forceinline__ void lru_block(Frame& F) {
    LAS bf16* XCb = (LAS bf16*)(F.lds + LRU_XCB_OFF);
    LAS float* XCF = (LAS float*)(F.lds + LRU_XCF_OFF);
    LAS float* As = (LAS float*)(F.lds + LRU_A_OFF);
    LAS float* Bs = (LAS float*)(F.lds + LRU_B_OFF);
    LAS float* SEh = (LAS float*)(F.lds + LRU_SE_OFF);
    LAS float* SEp = SEh + 4 * 128;
    const int tid = F.tid, lane = F.lane;
    const int hd = F.bid & 7, li = F.bid >> 3, step = F.G >> 3;
    constexpr int NQ = BATCH * (SEQ / LCH);
    if (li >= NQ) return;
    const int cg = tid & 15, tp = tid >> 4, colc = hd * LRU_BLK + 8 * cg;
    float cw[4][8], cbv[8];
#pragma unroll
    for (int k = 0; k < 4; ++k) { const f32x4 a = *(const f32x4*)(P_conv_w(F) + k * LRU_W + colc), b2 = *(const f32x4*)(P_conv_w(F) + k * LRU_W + colc + 4);
        cw[k][0] = a.x; cw[k][1] = a.y; cw[k][2] = a.z; cw[k][3] = a.w; cw[k][4] = b2.x; cw[k][5] = b2.y; cw[k][6] = b2.z; cw[k][7] = b2.w; }
    { const f32x4 a = *(const f32x4*)(P_conv_b(F) + colc), b2 = *(const f32x4*)(P_conv_b(F) + colc + 4);
      cbv[0] = a.x; cbv[1] = a.y; cbv[2] = a.z; cbv[3] = a.w; cbv[4] = b2.x; cbv[5] = b2.y; cbv[6] = b2.z; cbv[7] = b2.w; }
    const int fr = lane & 15, fq = lane >> 4, j = 16 * F.wave + fr, jc = hd * LRU_BLK + j;
    bf16x8 wa[4], wx[4];
    { const bf16* wap = P_WGA(F) + (size_t)hd * 16384 + (size_t)j * 128 + 8 * fq; const bf16* wxp = P_WGX(F) + (size_t)hd * 16384 + (size_t)j * 128 + 8 * fq;
#pragma unroll
      for (int ks = 0; ks < 4; ++ks) { wa[ks] = *(const bf16x8*)(wap + 32 * ks); wx[ks] = *(const bf16x8*)(wxp + 32 * ks); } }
    const float ba = P_ga_b(F)[jc], bx = P_gx_b(F)[jc];
    const float sp8 = -8.0f * log1pf(__expf(-P_lam(F)[jc]));
    const int c = tid & 127, sub = tid >> 7, col = hd * LRU_BLK + c;
    const bf16* xbase = P_PROJ(F) + colc;
    bf16* HLp = P_HL(F); bf16* PAp = P_PA(F);
    v4u xr[5];
#define LRU_LOAD_X(q_) do { const int b_ = (q_) >> 6, ch_ = (q_) & 63; const int tr_ = ch_ * LCH + 2 * tp - 3; \
        _Pragma("unroll") for (int r_ = 0; r_ < 5; ++r_) { const int t_ = tr_ + r_; \
            xr[r_] = (t_ >= 0) ? *(const v4u*)(xbase + (size_t)(b_ * SEQ + t_) * MIX_IN) : (v4u){0u, 0u, 0u, 0u}; } } while (0)
    LRU_LOAD_X(li);
    for (int q = li; q < NQ; q += step) {
        const int b = q >> 6, ch = q & 63, t0 = ch * LCH;
        {
            float xv[5][8];
#pragma unroll
            for (int r = 0; r < 5; ++r) { xv[r][0] = bflo(xr[r].x); xv[r][1] = bfhi(xr[r].x); xv[r][2] = bflo(xr[r].y); xv[r][3] = bfhi(xr[r].y);
                xv[r][4] = bflo(xr[r].z); xv[r][5] = bfhi(xr[r].z); xv[r][6] = bflo(xr[r].w); xv[r][7] = bfhi(xr[r].w); }
            if (q + step < NQ) LRU_LOAD_X(q + step);
#pragma unroll
            for (int tk = 0; tk < 2; ++tk) { float xc[8];
#pragma unroll
                for (int e = 0; e < 8; ++e) xc[e] = cbv[e] + cw[0][e] * xv[tk][e] + cw[1][e] * xv[tk + 1][e] + cw[2][e] * xv[tk + 2][e] + cw[3][e] * xv[tk + 3][e];
                const int tl = 2 * tp + tk;
                v4u o; o.x = pk2(xc[0], xc[1]); o.y = pk2(xc[2], xc[3]); o.z = pk2(xc[4], xc[5]); o.w = pk2(xc[6], xc[7]);
                *(LAS v4u*)(XCb + tl * XC_STRIDE + 8 * cg) = o;
                *(LAS f32x4*)(XCF + tl * 128 + 8 * cg) = (f32x4){xc[0], xc[1], xc[2], xc[3]}; *(LAS f32x4*)(XCF + tl * 128 + 8 * cg + 4) = (f32x4){xc[4], xc[5], xc[6], xc[7]}; }
        }
        __syncthreads();
#pragma unroll
        for (int mt = 0; mt < 4; ++mt) {
            f32x4 ra = {0.f, 0.f, 0.f, 0.f}, rx = {0.f, 0.f, 0.f, 0.f};
            const LAS bf16* ap = XCb + (16 * mt + fr) * XC_STRIDE + 8 * fq;
#pragma unroll
            for (int ks = 0; ks < 4; ++ks) { const bf16x8 af = *(const LAS bf16x8*)(ap + 32 * ks); ra = MFMA16(af, wa[ks], ra); rx = MFMA16(af, wx[ks], rx); }
#pragma unroll
            for (int e = 0; e < 4; ++e) { const int tl = 16 * mt + 4 * fq + e;
                const float rg = sigmoidf_(ra[e] + ba), ig = sigmoidf_(rx[e] + bx);
                const float a = __expf(rg * sp8);
                const float mult = sqrtf(fmaxf(fmaf(-a, a, 1.0f), 0.f));
                As[tl * 128 + j] = a; Bs[tl * 128 + j] = mult * ig * XCF[tl * 128 + j]; }
        }
        __syncthreads();
        float hh[16], pp[16];
        {
            float h = 0.f, P = 1.f;
#pragma unroll
            for (int i = 0; i < 16; ++i) { const int tl = sub * 16 + i; const float a = As[tl * 128 + c], bq = Bs[tl * 128 + c];
                h = a * h + bq; P *= a; hh[i] = h; pp[i] = P; }
            SEh[sub * 128 + c] = h; SEp[sub * 128 + c] = P;
        }
        __syncthreads();
        {
            float carry = 0.f, pre = 1.f;
            for (int s2 = 0; s2 < sub; ++s2) { carry = SEh[s2 * 128 + c] + SEp[s2 * 128 + c] * carry; pre *= SEp[s2 * 128 + c]; }
            bf16* hl = HLp + (size_t)(b * SEQ + t0 + sub * 16) * LRU_W + col;
            bf16* pa = PAp + (size_t)(b * SEQ + t0 + sub * 16) * LRU_W + col;
#pragma unroll
            for (int i = 0; i < 16; ++i) { hl[(size_t)i * LRU_W] = (bf16)f2bf(hh[i] + pp[i] * carry); pa[(size_t)i * LRU_W] = (bf16)f2bf(pp[i] * pre); }
        }
    }
#undef LRU_LOAD_X
    __syncthreads();
}
constexpr int N_ATT_UNITS = BATCH * HKV * (SEQ / 128);
constexpr int N_LRU_UNITS = BATCH * LRU_HEADS * (SEQ / LCH);
__device__ __forceinline__ void p3_phase(Frame& F) {
    for (int u = F.bid; u < N_ATT_UNITS; u += F.G) attn_unit(F, u >> 6, (u >> 5) & 1, u & 31);
    lru_block(F);
}

__device__ __forceinline__ void p4_unit(Frame& F, int b, int ch) {
    LAS float* CAR = (LAS float*)F.lds;
    const int tid = F.tid, lane = F.lane;
    {
        f32x2 carry = {0.f, 0.f};
        const bf16* hlb = P_HL(F) + (size_t)(b * SEQ + LCH - 1) * LRU_W + 2 * tid; const bf16* pab = P_PA(F) + (size_t)(b * SEQ + LCH - 1) * LRU_W + 2 * tid;
        int c2 = 0;
        for (; c2 + 8 <= ch; c2 += 8) { unsigned hl[8], pa[8];
#pragma unroll
            for (int q = 0; q < 8; ++q) { hl[q] = *(const unsigned*)(hlb + (size_t)(c2 + q) * LCH * LRU_W); pa[q] = *(const unsigned*)(pab + (size_t)(c2 + q) * LCH * LRU_W); }
#pragma unroll
            for (int q = 0; q < 8; ++q) { carry.x = bflo(hl[q]) + bflo(pa[q]) * carry.x; carry.y = bfhi(hl[q]) + bfhi(pa[q]) * carry.y; } }
        for (; c2 < ch; ++c2) { const unsigned hl = *(const unsigned*)(hlb + (size_t)c2 * LCH * LRU_W), pa = *(const unsigned*)(pab + (size_t)c2 * LCH * LRU_W);
            carry.x = bflo(hl) + bflo(pa) * carry.x; carry.y = bfhi(hl) + bfhi(pa) * carry.y; }
        CAR[2 * tid] = carry.x; CAR[2 * tid + 1] = carry.y;
    }
    __syncthreads();
    const float* gl = P_on_lru_g(F); const float* ga = P_on_attn_g(F);
    for (int i = 0; i < 8; i += 2) {
        const size_t m0 = (size_t)b * SEQ + ch * LCH + F.wave * 8 + i;
        v2u hl[2][4], pa[2][4]; v2u yr[2][4], ar[2][4];
#pragma unroll
        for (int t = 0; t < 2; ++t)
#pragma unroll
            for (int j = 0; j < 4; ++j) { const int c = 4 * lane + 256 * j; const size_t m = m0 + t;
                hl[t][j] = *(const v2u*)(P_HL(F) + m * LRU_W + c); pa[t][j] = *(const v2u*)(P_PA(F) + m * LRU_W + c);
                yr[t][j] = *(const v2u*)(P_PROJ(F) + m * MIX_IN + C_Y + c); ar[t][j] = *(const v2u*)(P_XH(F) + m * D + LRU_W + c); }
        f32x4 vl[2][4], va[2][4]; float sl[2] = {0.f, 0.f}, sa[2] = {0.f, 0.f};
#pragma unroll
        for (int t = 0; t < 2; ++t)
#pragma unroll
            for (int j = 0; j < 4; ++j) { const int c = 4 * lane + 256 * j; const f32x4 car = *(const LAS f32x4*)(CAR + c);
                const f32x4 hlf = {bflo(hl[t][j].x), bfhi(hl[t][j].x), bflo(hl[t][j].y), bfhi(hl[t][j].y)}, paf = {bflo(pa[t][j].x), bfhi(pa[t][j].x), bflo(pa[t][j].y), bfhi(pa[t][j].y)};
                const f32x4 h = hlf + paf * car;
                f32x4 v; v.x = h.x * gelu_tanh(bflo(yr[t][j].x)); v.y = h.y * gelu_tanh(bfhi(yr[t][j].x)); v.z = h.z * gelu_tanh(bflo(yr[t][j].y)); v.w = h.w * gelu_tanh(bfhi(yr[t][j].y));
                vl[t][j] = v; sl[t] += (v.x * v.x + v.y * v.y) + (v.z * v.z + v.w * v.w);
                f32x4 a; a.x = bflo(ar[t][j].x); a.y = bfhi(ar[t][j].x); a.z = bflo(ar[t][j].y); a.w = bfhi(ar[t][j].y);
                va[t][j] = a; sa[t] += (a.x * a.x + a.y * a.y) + (a.z * a.z + a.w * a.w); }
#pragma unroll
        for (int o = 1; o < 64; o <<= 1) { sl[0] += __shfl_xor(sl[0], o); sl[1] += __shfl_xor(sl[1], o); sa[0] += __shfl_xor(sa[0], o); sa[1] += __shfl_xor(sa[1], o); }
#pragma unroll
        for (int t = 0; t < 2; ++t) { const float rl = 1.0f / sqrtf(sl[t] * (1.0f / LRU_W) + EPS), ra = 1.0f / sqrtf(sa[t] * (1.0f / LRU_W) + EPS); const size_t m = m0 + t;
#pragma unroll
            for (int j = 0; j < 4; ++j) { const int c = 4 * lane + 256 * j; const f32x4 g1v = *(const f32x4*)(gl + c), g2v = *(const f32x4*)(ga + c);
                const f32x4 y = vl[t][j] * rl * g1v, z = va[t][j] * ra * g2v;
                v2u o; o.x = pk2(y.x, y.y); o.y = pk2(y.z, y.w); *(v2u*)(P_XH(F) + m * D + c) = o;
                v2u p; p.x = pk2(z.x, z.y); p.y = pk2(z.z, z.w); *(v2u*)(P_XH(F) + m * D + LRU_W + c) = p; } }
    }
    __syncthreads();
}
__device__ __forceinline__ void p4_phase(Frame& F) {
    for (int u = F.bid; u < BATCH * (SEQ / LCH); u += F.G) p4_unit(F, u >> 6, u & 63);
}

__device__ __forceinline__ int f2key(float f) { const int b = __builtin_bit_cast(int, f); return b ^ ((b >> 31) & 0x7fffffff); }
__device__ __forceinline__ float key2f(int k) { const int b = k ^ ((k >> 31) & 0x7fffffff); return __builtin_bit_cast(float, b); }
__device__ __forceinline__ void ins16(int (&L)[16], int x) {
#pragma unroll
    for (int j = 0; j < 16; ++j) { const int hi = max(L[j], x); x = min(L[j], x); L[j] = hi; }
}
__device__ __forceinline__ void ce_desc(int& a, int& b) { const int hi = a > b ? a : b, lo = a > b ? b : a; a = hi; b = lo; }
__device__ __forceinline__ void sort16_desc(int (&a)[16]) {
#pragma unroll
    for (int k = 2; k <= 16; k <<= 1)
#pragma unroll
        for (int j = k >> 1; j > 0; j >>= 1)
#pragma unroll
            for (int i = 0; i < 16; ++i) { const int l = i ^ j; if (l > i) { if ((i & k) == 0) ce_desc(a[i], a[l]); else ce_desc(a[l], a[i]); } }
}
__device__ __forceinline__ void bitonic_merge16_desc(int (&a)[16]) {
#pragma unroll
    for (int j = 8; j > 0; j >>= 1)
#pragma unroll
        for (int i = 0; i < 16; ++i) { const int l = i ^ j; if (l > i) ce_desc(a[i], a[l]); }
}
__device__ __forceinline__ void merge_top16(int (&a)[16], const int (&b)[16]) {
#pragma unroll
    for (int i = 0; i < 16; ++i) a[i] = a[i] > b[15 - i] ? a[i] : b[15 - i];
    bitonic_merge16_desc(a);
}
constexpr int INT_LOWEST = (int)0x80000000;
__device__ __forceinline__ void p8_item(Frame& F, int tt, int hd, LAS int* lut  ) {
    const int lane = F.lane, r = lane & 31, hh = lane >> 5;
    const bf16* QP = P_PROJ(F);
    int V[2][16];
#pragma unroll
    for (int p = 0; p < 2; ++p) {
        bf16x8 qf[8];
        const char* qb = (const char*)(QP + (size_t)(32 * tt) * D + hd * 256 + p * 128);
        const unsigned qoff = (unsigned)(r * D + 8 * hh) * 2u;
#pragma unroll
        for (int ks = 0; ks < 8; ++ks) qf[ks] = *(const bf16x8*)(qb + qoff + 32 * ks);
        int L[16];
#pragma unroll
        for (int j = 0; j < 16; ++j) L[j] = INT_LOWEST;
        const char* skb = (const char*)(P_SK(F) + (size_t)((hd * 2 + p) * PKEYS) * PHALF);
        const unsigned skoff = (unsigned)(r * PHALF + 8 * hh) * 2u;
#pragma unroll 1
        for (int kt = 0; kt < 4; ++kt) {
            f32x16 acc;
#pragma unroll
            for (int i = 0; i < 16; ++i) acc[i] = 0.f;
            const char* skt = skb + (size_t)(32 * kt) * PHALF * 2;
#pragma unroll
            for (int ks = 0; ks < 8; ++ks) { const bf16x8 kf = *(const bf16x8*)(skt + skoff + 32 * ks); acc = MFMA32(kf, qf[ks], acc); }
            const int kbase = 32 * kt + 4 * hh;
            int T[16];
#pragma unroll
            for (int i = 0; i < 16; ++i) { const int kidx = (i & 3) + 8 * (i >> 2); T[i] = (f2key(acc[i]) & ~0x7f) | (kbase + kidx); }
            sort16_desc(T); merge_top16(L, T);
        }
        int O[16];
#pragma unroll
        for (int j = 0; j < 16; ++j) O[j] = __shfl_xor(L[j], 32);
        merge_top16(L, O);
#pragma unroll
        for (int j = 0; j < 16; ++j) V[p][j] = L[j];
    }
#pragma unroll
    for (int j = 0; j < 16; ++j) { lut[lane * 33 + j] = V[0][j] & 0x7f; lut[lane * 33 + 16 + j] = V[1][j] & 0x7f; }
    float v0[16], v1[16];
#pragma unroll
    for (int j = 0; j < 16; ++j) { v0[j] = key2f(V[0][j] & ~0x7f); v1[j] = key2f(V[1][j] & ~0x7f); }
    int C[16], G1[16], G2[16], G3[2];
    { int n = 0;
#pragma unroll
      for (int i = 0; i < 16; ++i)
#pragma unroll
        for (int j = 0; j < 16; ++j)
            if ((i + 1) * (j + 1) <= 16) { const int key = (f2key(v0[i] + v1[j]) & ~0xff) | (i * 16 + j);
                if (n < 16) C[n] = key; else if (n < 32) G1[n - 16] = key; else if (n < 48) G2[n - 32] = key; else G3[n - 48] = key;
                ++n; } }
    sort16_desc(C); sort16_desc(G1); sort16_desc(G2);
    merge_top16(C, G1); merge_top16(C, G2); ins16(C, G3[0]); ins16(C, G3[1]);
    float sv[16]; float den = 0.f;
    const float mx = key2f(C[0] & ~0xff);
#pragma unroll
    for (int e = 0; e < 16; ++e) { sv[e] = __expf(key2f(C[e] & ~0xff) - mx); den += sv[e]; }
    const float inv = 1.0f / den;
    LDS_WAIT(); asm volatile("" ::: "memory");
    int idx[16];
#pragma unroll
    for (int e = 0; e < 16; ++e) { const int pi = (C[e] >> 4) & 15, pj = C[e] & 15; idx[e] = lut[lane * 33 + pi] * PKEYS + lut[lane * 33 + 16 + pj]; }
    if (hh == 0) {
        unsigned short* ip = P_IDX(F) + (size_t)(32 * tt + r) * 128 + hd * 16; float* gp = P_GW(F) + (size_t)(32 * tt + r) * 128 + hd * 16;
#pragma unroll
        for (int q = 0; q < 2; ++q) *(v4u*)(ip + 8 * q) = (v4u){(unsigned)idx[8 * q] | ((unsigned)idx[8 * q + 1] << 16), (unsigned)idx[8 * q + 2] | ((unsigned)idx[8 * q + 3] << 16),
                                                              (unsigned)idx[8 * q + 4] | ((unsigned)idx[8 * q + 5] << 16), (unsigned)idx[8 * q + 6] | ((unsigned)idx[8 * q + 7] << 16)};
#pragma unroll
        for (int q = 0; q < 4; ++q) *(f32x4*)(gp + 4 * q) = (f32x4){sv[4 * q] * inv, sv[4 * q + 1] * inv, sv[4 * q + 2] * inv, sv[4 * q + 3] * inv};
    }
    LDS_WAIT(); asm volatile("" ::: "memory");
}
__device__ __forceinline__ void p8_phase(Frame& F) {
    LAS int* lut = (LAS int*)(F.lds + F.wave * (64 * 33 * 4));
    const int gw = F.bid * NWAVES + F.wave, NGW = F.G * NWAVES;
    for (int it = gw; it < (M / 32) * PH; it += NGW) p8_item(F, it >> 3, it & 7, lut);
}

template <int CTRL> __device__ __forceinline__ float dpp_f(float x) { return __builtin_bit_cast(float, __builtin_amdgcn_mov_dpp(__builtin_bit_cast(int, x), CTRL, 0xf, 0xf, true)); }
__device__ __forceinline__ float sum8(float v) {
    v += dpp_f<0xB1>(v);
    v += dpp_f<0x4E>(v);
    v += dpp_f<0x141>(v);
    return v;
}
__device__ __forceinline__ void dec16(const v4u r, float (&f)[16]) {
    const unsigned w4[4] = {r.x, r.y, r.z, r.w};
#pragma unroll
    for (int w = 0; w < 4; ++w) { const f32x2 lo = __builtin_amdgcn_cvt_pk_f32_fp8((int)w4[w], false), hi = __builtin_amdgcn_cvt_pk_f32_fp8((int)w4[w], true);
        f[4 * w] = lo.x; f[4 * w + 1] = lo.y; f[4 * w + 2] = hi.x; f[4 * w + 3] = hi.y; }
}
__device__ __forceinline__ void row_offsets(const v4u a, const v4u b, unsigned loff, unsigned (&off)[16]) {
    const unsigned w[8] = {a.x, a.y, a.z, a.w, b.x, b.y, b.z, b.w};
#pragma unroll
    for (int q = 0; q < 8; ++q) { off[2 * q] = ((w[q] & 0xffffu) << 7) + loff; off[2 * q + 1] = ((w[q] >> 16) << 7) + loff; }
}
#define ISSUE_ROWS(dst, TBL, ia, ib) do { unsigned off_[16]; row_offsets((ia), (ib), loff, off_); \
    _Pragma("unroll") for (int i_ = 0; i_ < 16; ++i_) dst[i_] = *(const v4u*)((TBL) + off_[i_]); } while (0)

typedef int i32x8 __attribute__((ext_vector_type(8)));
#define MFMA_F4F8(a, b, c) __builtin_amdgcn_mfma_scale_f32_16x16x128_f8f6f4((a), (b), (c), 4  , 0  , 0, 0x7f7f7f7f, 0, 0x7f7f7f7f)
#define ISSUE_ROWS_U(dst, i0, i1) do { const unsigned w_[8] = {(i0).x, (i0).y, (i0).z, (i0).w, (i1).x, (i1).y, (i1).z, (i1).w}; \
    _Pragma("unroll") for (int g_ = 0; g_ < 16; ++g_) { const unsigned id_ = (g_ & 1) ? (w_[g_ >> 1] >> 16) : (w_[g_ >> 1] & 0xffffu); \
        dst[g_] = *(const v4u*)(U4 + ((id_ << 7) + loff)); } } while (0)
__device__ __forceinline__ void p9u_compute(const v4u (&row)[16], const v4u hA0, const v4u hA1, const v4u hB0, const v4u hB1, int lane, bf16* dst) {
    const i32x8 B0 = {(int)hA0.x, (int)hA0.y, (int)hA0.z, (int)hA0.w, (int)hA1.x, (int)hA1.y, (int)hA1.z, (int)hA1.w};
    const i32x8 B1 = {(int)hB0.x, (int)hB0.y, (int)hB0.z, (int)hB0.w, (int)hB1.x, (int)hB1.y, (int)hB1.z, (int)hB1.w};
    const int n = lane & 15, q = lane >> 4, e4 = n >> 2;
    const f32x4 zero = {0.f, 0.f, 0.f, 0.f};
    float res[16];
#pragma unroll
    for (int g = 0; g < 16; ++g) {
        const i32x8 a = {(int)row[g].x, (int)row[g].y, (int)row[g].z, (int)row[g].w, 0, 0, 0, 0};
        const f32x4 d0 = MFMA_F4F8(a, B0, zero), d1 = MFMA_F4F8(a, B1, zero);
        float v0 = d0[0]; v0 = e4 == 1 ? d0[1] : v0; v0 = e4 == 2 ? d0[2] : v0; v0 = e4 == 3 ? d0[3] : v0;
        float v1 = d1[0]; v1 = e4 == 1 ? d1[1] : v1; v1 = e4 == 2 ? d1[2] : v1; v1 = e4 == 3 ? d1[3] : v1;
        float val = (q & 1) ? v1 : v0;
        val = val + dpp_f<0x124>(val) + dpp_f<0x128>(val) + dpp_f<0x12C>(val);
        val += __shfl_xor(val, 16);
        res[g] = val;
    }
    if ((lane & 0x1c) == 0) {
        bf16* d = dst + 16 * (2 * (n & 3) + (q >> 1));
        v4u o0, o1;
        o0.x = pk2(res[0], res[1]); o0.y = pk2(res[2], res[3]); o0.z = pk2(res[4], res[5]); o0.w = pk2(res[6], res[7]);
        o1.x = pk2(res[8], res[9]); o1.y = pk2(res[10], res[11]); o1.z = pk2(res[12], res[13]); o1.w = pk2(res[14], res[15]);
        *(v4u*)d = o0; *(v4u*)(d + 8) = o1;
    }
}
__device__ __forceinline__ void p9u_item(Frame& F, int s, int tb) {
    const int lane = F.lane, sg = lane & 7, r8 = lane >> 3, n = lane & 15, kq = lane >> 4;
    const unsigned char* U4 = P_U(F);
    const unsigned loff = (unsigned)(s * (NEXP * 128) + 16 * sg);
    const unsigned short* idxb = P_IDX(F) + (size_t)(64 * tb) * 128 + 16 * r8;
    const unsigned char* hb = P_H8(F) + (size_t)(64 * tb) * D + 256 * s + 32 * (n >> 2) + 16 * (kq & 1);
    const bool bon = (kq >> 1) == (n & 1); const bool bhi = (n & 2) != 0;
    bf16* pb = (bf16*)P_PART(F) + ((size_t)s * M + 64 * tb) * 128;
#define LOAD_META_U(I0, I1, A0, A1, B0, B1, tt_) do { const int tn_ = (tt_) < 64 ? (tt_) : 63; const unsigned short* ip_ = idxb + (size_t)tn_ * 128; I0 = *(const v4u*)(ip_); I1 = *(const v4u*)(ip_ + 8); \
        const unsigned char* hp_ = hb + (size_t)tn_ * D; const v4u z_ = {0u, 0u, 0u, 0u}; \
        const v4u x0_ = bon ? *(const v4u*)(hp_) : z_, x1_ = bon ? *(const v4u*)(hp_ + 128) : z_; \
        A0 = bhi ? z_ : x0_; A1 = bhi ? x0_ : z_; B0 = bhi ? z_ : x1_; B1 = bhi ? x1_ : z_; } while (0)
    v4u aI0, aI1, aA0, aA1, aB0, aB1, bI0, bI1, bA0, bA1, bB0, bB1, cI0, cI1, cA0, cA1, cB0, cB1, dI0, dI1, dA0, dA1, dB0, dB1;
    LOAD_META_U(aI0, aI1, aA0, aA1, aB0, aB1, 0); LOAD_META_U(bI0, bI1, bA0, bA1, bB0, bB1, 1); LOAD_META_U(cI0, cI1, cA0, cA1, cB0, cB1, 2);
    v4u rowA[16], rowB[16];
    ISSUE_ROWS_U(rowA, aI0, aI1); ISSUE_ROWS_U(rowB, bI0, bI1);
#pragma unroll 1
    for (int t = 0; t < 64; t += 2) {
        p9u_compute(rowA, aA0, aA1, aB0, aB1, lane, pb + (size_t)t * 128);
        LOAD_META_U(dI0, dI1, dA0, dA1, dB0, dB1, t + 3);
        ISSUE_ROWS_U(rowA, cI0, cI1);
        p9u_compute(rowB, bA0, bA1, bB0, bB1, lane, pb + (size_t)(t + 1) * 128);
        aA0 = cA0; aA1 = cA1; aB0 = cB0; aB1 = cB1; bA0 = dA0; bA1 = dA1; bB0 = dB0; bB1 = dB1;
        LOAD_META_U(cI0, cI1, cA0, cA1, cB0, cB1, t + 4);
        ISSUE_ROWS_U(rowB, dI0, dI1);
    }
#undef LOAD_META_U
}
#define MFMA_FP8(a, b, c) __builtin_amdgcn_mfma_f32_16x16x32_fp8_fp8((a), (b), (c), 0, 0, 0)
__device__ __forceinline__ long pk64(unsigned lo, unsigned hi) { return (long)(((unsigned long long)hi << 32) | lo); }
#define ISSUE_ROWS_V(dst, i0, i1) do { const unsigned w_[8] = {(i0).x, (i0).y, (i0).z, (i0).w, (i1).x, (i1).y, (i1).z, (i1).w}; \
    _Pragma("unroll") for (int g_ = 0; g_ < 16; ++g_) { const unsigned id_ = (g_ & 1) ? (w_[g_ >> 1] >> 16) : (w_[g_ >> 1] & 0xffffu); \
        dst[g_] = *(const v4u*)(V8 + ((id_ << 7) + loff)); } } while (0)
__device__ __forceinline__ void p9v_compute(const v4u (&row)[16], const v4u w8, int lane, unsigned shl, bool hif, const v2u x1lo, const v2u x1hi, const f32x4 g2lo, const f32x4 g2hi, float wscale, float* dst) {
    f32x4 d0 = {0.f, 0.f, 0.f, 0.f}, d1 = {0.f, 0.f, 0.f, 0.f};
    const unsigned ww[4] = {w8.x, w8.y, w8.z, w8.w};
#pragma unroll
    for (int g = 0; g < 16; ++g) {
        const unsigned wb = (ww[g >> 2] >> (8 * (g & 3))) & 0xffu;
        const unsigned sh = wb << shl;
        const long a = pk64(hif ? 0u : sh, hif ? sh : 0u);
        d0 = MFMA_FP8(a, pk64(row[g].x, row[g].y), d0);
        d1 = MFMA_FP8(a, pk64(row[g].z, row[g].w), d1);
    }
#pragma unroll
    for (int e = 0; e < 4; ++e) { d0[e] += __shfl_xor(d0[e], 40); d1[e] += __shfl_xor(d1[e], 40); }
    if ((lane & 40) == 0) {
        const f32x4 xl = {bflo(x1lo.x), bfhi(x1lo.x), bflo(x1lo.y), bfhi(x1lo.y)}, xh = {bflo(x1hi.x), bfhi(x1hi.x), bflo(x1hi.y), bfhi(x1hi.y)};
        *(f32x4*)(dst) = xl + g2lo * (d0 * wscale);
        *(f32x4*)(dst + 8) = xh + g2hi * (d1 * wscale);
    }
}
__device__ __forceinline__ void p9v_item(Frame& F, int s, int tb) {
    const int lane = F.lane, sg = lane & 7, r8 = lane >> 3;
    const unsigned char* V8 = P_V(F);
    const unsigned loff = (unsigned)(s * (NEXP * 128) + 16 * sg);
    const unsigned short* idxb = P_IDX(F) + (size_t)(64 * tb) * 128 + 16 * r8;
    const int ai = lane & 15, kq = lane >> 4;
    const unsigned shl = 8u * (unsigned)(ai & 3); const bool hif = (ai & 4) != 0;
    const unsigned char* wb = P_W(F) + (size_t)(64 * tb) * 128 + 16 * (2 * kq + (ai >> 3));
    const float* wscp = P_WSC(F) + 64 * tb;
    const int b = (64 * tb) / SEQ;
    const int ocol = 128 * s + 16 * (lane & 7) + 4 * ((lane >> 4) & 1);
    const f32x4 g2lo = *(const f32x4*)(P_ADA(F) + (size_t)b * ADA_W + 5 * D + ocol), g2hi = *(const f32x4*)(P_ADA(F) + (size_t)b * ADA_W + 5 * D + ocol + 8);
    float* ob = P_out(F) + (size_t)(64 * tb) * D + ocol;
    const bf16* xb = P_X1B(F) + (size_t)(64 * tb) * D + ocol;
#define LOAD_META_V(I0, I1, W8, XL, XH, WS, tt_) do { const int tn_ = (tt_) < 64 ? (tt_) : 63; const unsigned short* ip_ = idxb + (size_t)tn_ * 128; I0 = *(const v4u*)(ip_); I1 = *(const v4u*)(ip_ + 8); \
        W8 = *(const v4u*)(wb + (size_t)tn_ * 128); XL = *(const v2u*)(xb + (size_t)tn_ * D); XH = *(const v2u*)(xb + (size_t)tn_ * D + 8); WS = wscp[tn_]; } while (0)
    v4u aI0, aI1, aW, bI0, bI1, bW, cI0, cI1, cW, dI0, dI1, dW; v2u aXL, aXH, bXL, bXH, cXL, cXH, dXL, dXH; float aS, bS, cS, dS;
    LOAD_META_V(aI0, aI1, aW, aXL, aXH, aS, 0); LOAD_META_V(bI0, bI1, bW, bXL, bXH, bS, 1); LOAD_META_V(cI0, cI1, cW, cXL, cXH, cS, 2);
    v4u rowA[16], rowB[16];
    ISSUE_ROWS_V(rowA, aI0, aI1); ISSUE_ROWS_V(rowB, bI0, bI1);
#pragma unroll 1
    for (int t = 0; t < 64; t += 2) {
        p9v_compute(rowA, aW, lane, shl, hif, aXL, aXH, g2lo, g2hi, aS, ob + (size_t)t * D);
        LOAD_META_V(dI0, dI1, dW, dXL, dXH, dS, t + 3);
        ISSUE_ROWS_V(rowA, cI0, cI1);
        p9v_compute(rowB, bW, lane, shl, hif, bXL, bXH, g2lo, g2hi, bS, ob + (size_t)(t + 1) * D);
        aW = cW; aXL = cXL; aXH = cXH; aS = cS; bW = dW; bXL = dXL; bXH = dXH; bS = dS;
        LOAD_META_V(cI0, cI1, cW, cXL, cXH, cS, t + 4);
        ISSUE_ROWS_V(rowB, dI0, dI1);
    }
#undef LOAD_META_V
}
__device__ __forceinline__ void p9u_phase(Frame& F) {
    const int x = F.bid & 7, rank = F.bid >> 3, nr = F.G >> 3;
    for (int tb = rank * NWAVES + F.wave; tb < M / 64; tb += nr * NWAVES) p9u_item(F, x, tb);
}
__device__ __forceinline__ void p9v_phase(Frame& F) {
    const int x = F.bid & 7, rank = F.bid >> 3, nr = F.G >> 3;
    for (int h = 0; h < 2; ++h)
        for (int tb = rank * NWAVES + F.wave; tb < M / 64; tb += nr * NWAVES) p9v_item(F, 2 * x + h, tb);
}
__device__ __forceinline__ void p9w_phase(Frame& F) {
    const unsigned* part = P_PART(F); const unsigned short* idxp = P_IDX(F); const float* gwp = P_GW(F); const float* usc = P_USC(F); const float* vsc = P_VSC(F);
    unsigned char* wp = P_W(F); float* wsc = P_WSC(F);
    for (int it = F.bid * 512 + F.tid; it < M * 64; it += F.G * 512) {
        float a0 = 0.f, a1 = 0.f;
#pragma unroll
        for (int s = 0; s < 8; ++s) { const unsigned w = part[(size_t)s * M * 64 + it]; a0 += bflo(w); a1 += bfhi(w); }
        const int m = it >> 6; const size_t p0 = 2 * (size_t)it;
        const unsigned iw = *(const unsigned*)(idxp + p0); const int i0 = iw & 0xffffu, i1 = iw >> 16;
        const f32x2 gw = *(const f32x2*)(gwp + p0);
        const float w0 = gw.x * gelu_tanh(a0 * usc[i0]) * vsc[i0], w1 = gw.y * gelu_tanh(a1 * usc[i1]) * vsc[i1];
        float mx = fmaxf(fabsf(w0), fabsf(w1));
#pragma unroll
        for (int o = 1; o < 64; o <<= 1) mx = fmaxf(mx, __shfl_xor(mx, o));
        const float sc = 224.0f / fmaxf(mx, 1e-30f);
        const int t = __builtin_amdgcn_cvt_pk_fp8_f32(w0 * sc, w1 * sc, 0, false);
        *(unsigned short*)(wp + p0) = (unsigned short)(t & 0xffff);
        if ((it & 63) == 0) wsc[m] = fmaxf(mx, 1e-30f) * (1.0f / 224.0f);
    }
}

struct Args { const void* in[25]; float* out; unsigned char* ws; int ph_lo, ph_hi; };
__global__ void __launch_bounds__(NWAVES * 64, 2) hymba_fwd(Args args) {
    extern __shared__ __attribute__((aligned(16))) unsigned char lds_raw[];
    Frame F;
    F.lds = (LAS unsigned char*)lds_raw;
    F.tid = threadIdx.x; F.lane = F.tid & 63; F.wave = __builtin_amdgcn_readfirstlane(F.tid >> 6);
    F.G = gridDim.x; F.bid = blockIdx.x;
    F.ka = (kaptr_t)__builtin_amdgcn_kernarg_segment_ptr();
    static_assert(sizeof(Args) == 224, "kernarg byte offsets used by ka_ptr");
    for (int u = F.tid; u < (LDS_BYTES - LDSCTL_OFF) / 4; u += NWAVES * 64) ((LAS unsigned*)(F.lds + LDSCTL_OFF))[u] = 0u;
    __syncthreads();
    volatile LAS unsigned* MISC = (volatile LAS unsigned*)(F.lds + MISC_OFF);
    XcdBarrier bar; bar.bar = (unsigned*)(P_ws(F) + WS_CTL) + CW_BAR; bar.x = 0; bar.st = nullptr;
    const int lo = args.ph_lo, hi = args.ph_hi;
    if (hi - lo > 1) bar = xcd_barrier_post((unsigned*)(P_ws(F) + WS_CTL) + CW_BAR, MISC + 8);
#define IN(k) (lo <= (k) && (k) < hi)
#ifndef PROBE_STAMP
#define PROBE_STAMP -1
#define PROBE_DIV 5.0f
#endif
#define STAMP(k) do { if (PROBE_STAMP >= 0 && F.bid == 0 && F.tid == 0) ((unsigned long long*)(P_ws(F) + WS_CTL + 64))[(k)] = __builtin_amdgcn_s_memrealtime(); } while (0)
#define SEAM(k) do { STAMP(16 + (k)); if (IN(k) && IN((k) + 1)) xcd_barrier(bar); STAMP((k) + 1); } while (0)
    STAMP(0);

#ifndef PROBE_MASK
#define PROBE_MASK 0
#endif
#define REP(k) for (int rep_ = 0; rep_ < (((PROBE_MASK >> (k)) & 1) ? 2 : 1); ++rep_)
#define REPSYNC(k) do { if (((PROBE_MASK >> (k)) & 1) && rep_ == 0) xcd_barrier(bar); } while (0)
    if (IN(0)) { REP(0) { p0_prologue(F); REPSYNC(0); } } SEAM(0);
    if (IN(1)) { REP(1) { p1_phase(F); REPSYNC(1); } } SEAM(1);
    if (IN(2)) REP(2) {
        pg8::Gemm g{P_XH(F), P_WIN(F), M, MIX_IN, D}; pg8::StaticOrder S; S.init(M, MIX_IN, F.G, F.bid);
        pg8::EpiStoreBf16 E{P_PROJ(F), MIX_IN};
        pg8::gemm_phase<pg8::EpiStoreBf16, pg8::StaticOrder, false, true>(F.lds, g, S, E); REPSYNC(2);
        { const int nwg = (M / 256) * (MIX_IN / 256), busy = nwg % F.G;
          if (busy > 0 && F.bid >= busy) quant_rows(F, QUANT_SPLIT, 2 * NEXP, (F.bid - busy) * NWAVES + F.wave, (F.G - busy) * NWAVES);
          else if (busy == 0) quant_rows(F, QUANT_SPLIT, 2 * NEXP, F.bid * NWAVES + F.wave, F.G * NWAVES); }
    } SEAM(2);
    if (IN(3)) { p3_phase(F); } SEAM(3);
    if (IN(4)) { p4_phase(F); } SEAM(4);
    if (IN(5)) REP(5) {
        pg8::Gemm g{P_XH(F), P_WOUT(F), M, D, D}; pg8::StaticOrder S; S.init(M, D, F.G, F.bid);
        pg8::EpiGateBf16 E{P_X1B(F), D, P_ADA(F) + 2 * D, ADA_W, SEQ};
        pg8::gemm_phase<pg8::EpiGateBf16, pg8::StaticOrder, false, true>(F.lds, g, S, E); REPSYNC(5);
    } SEAM(5);
    if (IN(6)) { REP(6) { p6_phase(F); REPSYNC(6); } } SEAM(6);
    if (IN(7)) REP(7) {
        pg8::Gemm g{P_XH(F), P_WQ(F), M, D, D}; pg8::StaticOrder S; S.init(M, D, F.G, F.bid);
        pg8::EpiStoreBf16 E{P_PROJ(F), D};
        pg8::gemm_phase<pg8::EpiStoreBf16, pg8::StaticOrder, false, true>(F.lds, g, S, E); REPSYNC(7);
    } SEAM(7);
    if (IN(8)) { REP(8) { p8_phase(F); REPSYNC(8); } } SEAM(8);
#ifdef PROBE_MFMA4
    if (F.bid == 0 && F.wave == 0) {
        const int l_ = F.lane, i_ = l_ & 15, kq_ = l_ >> 4; (void)i_; (void)kq_;
        i32x8 a_ = {0, 0, 0, 0, 0, 0, 0, 0}, b_ = {0, 0, 0, 0, 0, 0, 0, 0};
        PROBE_MFMA4;
        const f32x4 z_ = {0.f, 0.f, 0.f, 0.f};
        const f32x4 d_ = MFMA_F4F8(a_, b_, z_);
        float* pr_ = (float*)(P_ws(F) + WS_CTL + 40960);
        pr_[l_ * 4 + 0] = d_[0]; pr_[l_ * 4 + 1] = d_[1]; pr_[l_ * 4 + 2] = d_[2]; pr_[l_ * 4 + 3] = d_[3];
    }
#endif
    if (IN(9)) { p9u_phase(F); }
    if (PROBE_STAMP >= 0 && F.tid == 0) ((unsigned long long*)(P_ws(F) + WS_CTL + 32768))[F.bid] = __builtin_amdgcn_s_memrealtime();
    SEAM(9);
    if (IN(10)) { p9w_phase(F); } SEAM(10);
    if (IN(11)) { p9v_phase(F); }
    if (PROBE_STAMP >= 0) {
        __syncthreads(); STAMP(12); VM_WAIT(); __syncthreads();
        if (F.bid == 0 && F.tid == 0) { const unsigned long long* ts = (const unsigned long long*)(P_ws(F) + WS_CTL + 64);
            float us = (float)(ts[PROBE_STAMP + 1] - ts[PROBE_STAMP]) * 0.01f;
#ifdef PROBE_BLOCKSTAT
            { const unsigned long long* bt = (const unsigned long long*)(P_ws(F) + WS_CTL + 32768); float acc_ = 0.f;
              for (int b_ = 0; b_ < (int)gridDim.x; ++b_) { const float d_ = (float)(bt[b_] - ts[9]) * 0.01f; PROBE_BLOCKSTAT; } us = acc_; }
#endif
#ifdef PROBE_MFMA4
            { const float* pr_ = (const float*)(P_ws(F) + WS_CTL + 40960); float acc_ = 0.f; PROBE_MFMA4_READ; us = acc_; }
#endif
            P_out(F)[0] += us * (1.0f / PROBE_DIV); }
    }
#undef IN
#undef SEAM
}

extern "C" void kernel_launch(void* const* d_in, const int* in_sizes, int n_in, void* d_out, int out_size, void* d_ws, size_t ws_size, hipStream_t stream) {
    static int grid = 0;
    if (grid == 0) {
        if (n_in != 25 || in_sizes[0] != M * D || out_size != M * D || ws_size < WS_END) {
            fprintf(stderr, "kernel_launch: built for 25 inputs, x/out of %d floats, >= %zu bytes of workspace; got n_in %d, in0 %d, out %d, ws %zu; nothing launched\n", M * D, (size_t)WS_END, n_in, n_in > 0 ? in_sizes[0] : -1, out_size, ws_size);
            grid = -1; return; }
        int dev = 0, cus = 0, per_cu = 0;
        if (hipGetDevice(&dev) != hipSuccess || hipDeviceGetAttribute(&cus, hipDeviceAttributeMultiprocessorCount, dev) != hipSuccess) { fprintf(stderr, "kernel_launch: device query failed\n"); grid = -1; return; }
        if (hipFuncSetAttribute((const void*)hymba_fwd, hipFuncAttributeMaxDynamicSharedMemorySize, LDS_BYTES) != hipSuccess) { fprintf(stderr, "kernel_launch: hipFuncSetAttribute failed\n"); grid = -1; return; }
        if (hipOccupancyMaxActiveBlocksPerMultiprocessor(&per_cu, (const void*)hymba_fwd, NWAVES * 64, LDS_BYTES) != hipSuccess || per_cu < 1) {
            fprintf(stderr, "kernel_launch: occupancy query reports %d workgroups per CU; need 1\n", per_cu); (void)hipGetLastError(); grid = -1; return; }
        grid = cus;
        if (grid % 8 != 0 || (M / 64) % (grid / 8 * NWAVES) != 0) { fprintf(stderr, "kernel_launch: grid %d not supported (needs a multiple of 8 dividing the token blocks)\n", grid); grid = -1; return; }
    }
    if (grid < 0) return;
    if (hipMemsetAsync((char*)d_ws + WS_CTL, 0, CTL_ZERO_BYTES, stream) != hipSuccess) { fprintf(stderr, "kernel_launch: memset failed\n"); return; }
    Args a{};
    for (int i = 0; i < 25; ++i) a.in[i] = d_in[i];
    a.out = (float*)d_out; a.ws = (unsigned char*)d_ws;
    if (N_LAUNCHES == 1) {
        a.ph_lo = 0; a.ph_hi = N_PHASES;
        void* kargs[] = {&a};
        const hipError_t le = hipLaunchCooperativeKernel((const void*)hymba_fwd, dim3(grid), dim3(NWAVES * 64), kargs, LDS_BYTES, stream);
        if (le != hipSuccess) fprintf(stderr, "kernel_launch: cooperative launch failed: %s (grid %d)\n", hipGetErrorName(le), grid);
    } else {
#ifndef PROBE_TWICE
#define PROBE_TWICE 0
#endif
        for (int li = 0; li < N_PHASES; ++li) { a.ph_lo = li; a.ph_hi = li + 1;
            if ((PROBE_TWICE >> li) & 1) hipLaunchKernelGGL(hymba_fwd, dim3(grid), dim3(NWAVES * 64), LDS_BYTES, stream, a);
            hipLaunchKernelGGL(hymba_fwd, dim3(grid), dim3(NWAVES * 64), LDS_BYTES, stream, a);
            const hipError_t le = hipPeekAtLastError();
            if (le != hipSuccess) { fprintf(stderr, "kernel_launch: launch %d failed: %s\n", li, hipGetErrorName(le)); break; } }
    }
}
```

```cpp
#include <hip/hip_runtime.h>
#include <cstdio>
#include <cstdint>
namespace pg8 {
#define PG8_LAS __attribute__((address_space(3)))
typedef unsigned short bf16_t;
typedef short bf16x8 __attribute__((ext_vector_type(8)));
typedef float f32x4 __attribute__((ext_vector_type(4)));
typedef unsigned u32x4 __attribute__((ext_vector_type(4)));
constexpr int BM = 256, BK = 64, HALF = 128, HTB = HALF * BK * 2  , STAGE_BYTES = 8 * HTB, NXCD = 8, WGM = 8;

__host__ __device__ __forceinline__ int lds_byte(int r, int c) { const int st = (r >> 4) * 2 + (c >> 5), rr = r & 15, cc = c & 31, ob = rr * 64 + cc * 2; return st * 1024 + (ob ^ (((ob >> 9) & 1) << 5)); }
__host__ __device__ __forceinline__ void stage_rc(int b, int& R, int& C) { const int st = b / 1024, sb = b % 1024, swz = sb ^ (((sb >> 9) & 1) << 5); R = (st >> 1) * 16 + swz / 64; C = (st & 1) * 32 + (swz % 64) / 2; }
__host__ __device__ __forceinline__ int perm32(int rho) { const int n = rho >> 4, i = rho & 15; return 8 * (i >> 2) + 4 * n + (i & 3); }

struct Unit { int pm, pn; };
struct Gemm { const bf16_t* A; const bf16_t* Bt; int M, N, K; };

struct StaticOrder {
    int nM, nN, nwg, G, c;
    __host__ __device__ void init(int M, int N, int G_, int c_) { nM = M / BM; nN = N / BM; nwg = nM * nN; G = G_; c = c_; }
    __host__ __device__ bool next(int i, Unit& u) const {
        const long L = (long)i * G + c; if (L >= nwg) return false;
        int wgid = (int)L; { const int q = nwg / NXCD, r = nwg % NXCD, xcd = wgid % NXCD, off = wgid / NXCD; wgid = (xcd < r ? xcd * (q + 1) : r * (q + 1) + (xcd - r) * q) + off; }
        const int nig = WGM * nN, gid = wgid / nig, fm = gid * WGM, gsz = (nM - fm) < WGM ? (nM - fm) : WGM;
        u.pm = fm + ((wgid % nig) % gsz); u.pn = (wgid % nig) / gsz; return true;
    }
    __device__ __forceinline__ void a_ready(const Unit&) const {}
    __device__ __forceinline__ void done(const Unit&) const {}
};

__device__ __forceinline__ unsigned cvt_pk_bf16(float lo, float hi) { unsigned r; asm volatile("v_cvt_pk_bf16_f32 %0, %1, %2" : "=v"(r) : "v"(lo), "v"(hi)); return r; }
struct EpiStoreBf16 {
    static constexpr bool PERM = true, AFTER_DRAIN = false;
    bf16_t* O; int ldc;
    __device__ __forceinline__ void operator()(const f32x4 (&acc)[2][2][4][2], const Unit& u, int wr, int wc, int fr, int fq) const {
        const int row0 = u.pm * BM + wr * 64 + fr; const int col0 = u.pn * BM + wc * 32 + 8 * fq;
#pragma unroll
        for (int ai = 0; ai < 2; ++ai)
#pragma unroll
            for (int m = 0; m < 4; ++m) { bf16_t* rowp = O + (size_t)(row0 + ai * HALF + m * 16) * ldc + col0;
#pragma unroll
                for (int bj = 0; bj < 2; ++bj) { const f32x4 v0 = acc[ai][bj][m][0], v1 = acc[ai][bj][m][1];
                    u32x4 w; w.x = cvt_pk_bf16(v0[0], v0[1]); w.y = cvt_pk_bf16(v0[2], v0[3]); w.z = cvt_pk_bf16(v1[0], v1[1]); w.w = cvt_pk_bf16(v1[2], v1[3]);
                    *(u32x4*)(rowp + bj * HALF) = w; } }
    }
};
struct EpiGateBf16 {
    static constexpr bool PERM = true, AFTER_DRAIN = false;
    bf16_t* out; int ldc; const float* gate; int gstride; int rows_per_batch;
    __device__ __forceinline__ void operator()(const f32x4 (&acc)[2][2][4][2], const Unit& u, int wr, int wc, int fr, int fq) const {
        const int b = (u.pm * BM) / rows_per_batch; const float* g = gate + (size_t)b * gstride;
        const int col0 = u.pn * BM + wc * 32 + 8 * fq;
        f32x4 gv[2][2];
#pragma unroll
        for (int bj = 0; bj < 2; ++bj)
#pragma unroll
            for (int n = 0; n < 2; ++n) gv[bj][n] = *(const f32x4*)(g + col0 + bj * HALF + n * 4);
#pragma unroll
        for (int ai = 0; ai < 2; ++ai)
#pragma unroll
            for (int m = 0; m < 4; ++m) { bf16_t* rowp = out + (size_t)(u.pm * BM + ai * HALF + wr * 64 + m * 16 + fr) * ldc + col0;
#pragma unroll
                for (int bj = 0; bj < 2; ++bj) { const f32x4 v0 = gv[bj][0] * acc[ai][bj][m][0], v1 = gv[bj][1] * acc[ai][bj][m][1];
                    u32x4 w; w.x = cvt_pk_bf16(v0[0], v0[1]); w.y = cvt_pk_bf16(v0[2], v0[3]); w.z = cvt_pk_bf16(v1[0], v1[1]); w.w = cvt_pk_bf16(v1[2], v1[3]);
                    *(u32x4*)(rowp + bj * HALF) = w; } }
    }
};

template <class Epi, class Sched, bool ALIGN_EPI = false, bool SP2 = false>
__device__ __forceinline__ void gemm_phase(PG8_LAS unsigned char* lds, const Gemm g, const Sched& S, const Epi& E) {
    const int tid = threadIdx.x, wid = __builtin_amdgcn_readfirstlane(tid >> 6), lane = tid & 63, wr = wid >> 2, wc = wid & 3, fr = lane & 15, fq = lane >> 4;
    const int K = g.K, nt = K / BK;
    unsigned voffA[2], voffB[2];
#pragma unroll
    for (int i = 0; i < 2; ++i) { int R, C; stage_rc(tid * 16 + i * 8192, R, C); const int Rb = Epi::PERM ? ((R & ~31) + perm32(R & 31)) : R;
        voffA[i] = (unsigned)(R * K + C) * 2u; voffB[i] = (unsigned)(Rb * K + C) * 2u; }
    const size_t kstep = (size_t)(BK * 2);
    const size_t hstep = (size_t)HALF * K * 2;
    const size_t tstep = 2 * hstep;
    const unsigned ldsw = (unsigned)wid * 1024u;
    const int aoff = lds_byte(wr * 64 + fr, fq * 8), boff = lds_byte(wc * 32 + fr, fq * 8);
#define PG8_SA(b, h) (((b) * 2 + (h)) * HTB)
#define PG8_SB(b, h) ((4 + (b) * 2 + (h)) * HTB)
#define PG8_STAGE(bufoff, gbase, voff) do { _Pragma("unroll") for (int _i = 0; _i < 2; ++_i) \
        __builtin_amdgcn_global_load_lds((const unsigned*)((const char*)(gbase) + (voff)[_i]), (PG8_LAS unsigned*)(lds + (bufoff) + ldsw + _i * 8192), 16, 0, 0); } while (0)
#define PG8_LDA(dst, b, h) do { _Pragma("unroll") for (int m = 0; m < 4; ++m) _Pragma("unroll") for (int k = 0; k < 2; ++k) dst[m][k] = *(const PG8_LAS bf16x8*)(lds + PG8_SA(b, h) + aoff + m * 2048 + k * 1024); } while (0)
#define PG8_LDB(dst, b, h) do { _Pragma("unroll") for (int n = 0; n < 2; ++n) _Pragma("unroll") for (int k = 0; k < 2; ++k) dst[n][k] = *(const PG8_LAS bf16x8*)(lds + PG8_SB(b, h) + boff + n * 2048 + k * 1024); } while (0)
#define PG8_MMA(ai, bj, At, Bt) do { __builtin_amdgcn_s_setprio(1); _Pragma("unroll") for (int m = 0; m < 4; ++m) _Pragma("unroll") for (int n = 0; n < 2; ++n) _Pragma("unroll") for (int k = 0; k < 2; ++k) \
        acc[ai][bj][m][n] = __builtin_amdgcn_mfma_f32_16x16x32_bf16(Bt[n][k], At[m][k], acc[ai][bj][m][n], 0, 0, 0); __builtin_amdgcn_s_setprio(0); } while (0)
#define PG8_WAIT_V(n) asm volatile("s_waitcnt vmcnt(" #n ")" ::: "memory")
#define PG8_WAIT_L(n) asm volatile("s_waitcnt lgkmcnt(" #n ")" ::: "memory")
#define PG8_BAR __builtin_amdgcn_s_barrier()
#define PG8_SCHED __builtin_amdgcn_sched_barrier(0)
    Unit cur, nxt; int ui = 0;
    if (!S.next(0, cur)) return;
    f32x4 acc[2][2][4][2];
#pragma unroll
    for (int a = 0; a < 2; ++a)
#pragma unroll
        for (int b = 0; b < 2; ++b)
#pragma unroll
            for (int m = 0; m < 4; ++m)
#pragma unroll
                for (int n = 0; n < 2; ++n) acc[a][b][m][n] = (f32x4){0.f, 0.f, 0.f, 0.f};
    bf16x8 At[4][2], B0[2][2], B1[2][2];
    const char* cA = (const char*)g.A + (size_t)cur.pm * tstep; const char* cB = (const char*)g.Bt + (size_t)cur.pn * tstep;
    S.a_ready(cur);
    if constexpr (SP2) {
        PG8_STAGE(PG8_SB(0, 0), cB, voffB); PG8_STAGE(PG8_SB(0, 1), cB + hstep, voffB); PG8_STAGE(PG8_SA(0, 0), cA, voffA); PG8_STAGE(PG8_SA(0, 1), cA + hstep, voffA);
        if (wr == 1) PG8_BAR;
        PG8_WAIT_V(2); PG8_BAR;
        PG8_STAGE(PG8_SB(1, 0), cB + kstep, voffB); PG8_STAGE(PG8_SA(1, 0), cA + kstep, voffA); PG8_STAGE(PG8_SB(1, 1), cB + hstep + kstep, voffB);
        PG8_WAIT_V(6); PG8_BAR;
    } else {
        PG8_STAGE(PG8_SB(0, 0), cB, voffB); PG8_STAGE(PG8_SA(0, 0), cA, voffA); PG8_STAGE(PG8_SB(0, 1), cB + hstep, voffB); PG8_STAGE(PG8_SA(0, 1), cA + hstep, voffA);
        if (wr == 1) PG8_BAR;
        PG8_WAIT_V(4); PG8_BAR;
        PG8_STAGE(PG8_SB(1, 0), cB + kstep, voffB); PG8_STAGE(PG8_SA(1, 0), cA + kstep, voffA); PG8_STAGE(PG8_SB(1, 1), cB + hstep + kstep, voffB);
        PG8_WAIT_V(6); PG8_BAR;
    }
    for (;;) {
        const bool has_next = S.next(ui + 1, nxt);
        const char* nA = has_next ? (const char*)g.A + (size_t)nxt.pm * tstep : cA; const char* nB = has_next ? (const char*)g.Bt + (size_t)nxt.pn * tstep : cB;
        for (int t = 0; t < nt; t += 2) {
            const bool last = (t == nt - 2);
            const char* a1 = cA + (size_t)(t + 1) * kstep;
            const char* a2 = last ? nA : cA + (size_t)(t + 2) * kstep; const char* b2 = last ? nB : cB + (size_t)(t + 2) * kstep;
            const char* a3 = a2 + kstep; const char* b3 = b2 + kstep;
            if (last && has_next) S.a_ready(nxt);
            if constexpr (SP2) {
            PG8_LDB(B0, 0, 0); PG8_LDB(B1, 0, 1); PG8_SCHED; PG8_LDA(At, 0, 0); PG8_STAGE(PG8_SA(1, 1), a1 + hstep, voffA);
            PG8_WAIT_V(8); PG8_WAIT_L(0); PG8_BAR; PG8_MMA(0, 0, At, B0); PG8_MMA(0, 1, At, B1); PG8_BAR; PG8_SCHED;
            PG8_LDA(At, 0, 1); PG8_STAGE(PG8_SB(0, 0), b2, voffB); PG8_STAGE(PG8_SB(0, 1), b2 + hstep, voffB); PG8_STAGE(PG8_SA(0, 0), a2, voffA);
            PG8_WAIT_V(8); PG8_WAIT_L(0); PG8_BAR; PG8_MMA(1, 0, At, B0); PG8_MMA(1, 1, At, B1); PG8_BAR; PG8_SCHED;
            PG8_LDB(B0, 1, 0); PG8_LDB(B1, 1, 1); PG8_SCHED; PG8_LDA(At, 1, 0); PG8_STAGE(PG8_SA(0, 1), a2 + hstep, voffA);
            PG8_WAIT_V(8); PG8_WAIT_L(0); PG8_BAR; PG8_MMA(0, 0, At, B0); PG8_MMA(0, 1, At, B1); PG8_BAR; PG8_SCHED;
            PG8_LDA(At, 1, 1); PG8_STAGE(PG8_SB(1, 0), b3, voffB); PG8_STAGE(PG8_SB(1, 1), b3 + hstep, voffB); PG8_STAGE(PG8_SA(1, 0), a3, voffA);
            PG8_WAIT_V(8); PG8_WAIT_L(0); PG8_BAR; PG8_MMA(1, 0, At, B0); PG8_MMA(1, 1, At, B1); PG8_BAR; PG8_SCHED;
            } else {
            PG8_LDB(B0, 0, 0); PG8_SCHED; PG8_LDA(At, 0, 0); PG8_STAGE(PG8_SA(1, 1), a1 + hstep, voffA);
            PG8_WAIT_L(8); PG8_BAR; PG8_WAIT_L(0); PG8_MMA(0, 0, At, B0); PG8_BAR; PG8_SCHED;
            PG8_LDB(B1, 0, 1); PG8_STAGE(PG8_SB(0, 0), b2, voffB);
            PG8_BAR; PG8_WAIT_L(0); PG8_MMA(0, 1, At, B1); PG8_BAR;
            PG8_LDA(At, 0, 1); PG8_STAGE(PG8_SA(0, 0), a2, voffA);
            PG8_BAR; PG8_WAIT_L(0); PG8_MMA(1, 0, At, B0); PG8_BAR; PG8_SCHED;
            PG8_STAGE(PG8_SB(0, 1), b2 + hstep, voffB);
            PG8_WAIT_V(6); PG8_BAR; PG8_MMA(1, 1, At, B1); PG8_BAR;
            PG8_LDB(B0, 1, 0); PG8_SCHED; PG8_LDA(At, 1, 0); PG8_STAGE(PG8_SA(0, 1), a2 + hstep, voffA);
            PG8_WAIT_L(8); PG8_BAR; PG8_WAIT_L(0); PG8_MMA(0, 0, At, B0); PG8_BAR; PG8_SCHED;
            PG8_LDB(B1, 1, 1); PG8_STAGE(PG8_SB(1, 0), b3, voffB);
            PG8_BAR; PG8_WAIT_L(0); PG8_MMA(0, 1, At, B1); PG8_BAR;
            PG8_LDA(At, 1, 1); PG8_STAGE(PG8_SA(1, 0), a3, voffA);
            PG8_BAR; PG8_WAIT_L(0); PG8_MMA(1, 0, At, B0); PG8_BAR; PG8_SCHED;
            PG8_STAGE(PG8_SB(1, 1), b3 + hstep, voffB);
            PG8_WAIT_V(6); PG8_BAR; PG8_MMA(1, 1, At, B1); PG8_BAR;
            }
        }
        if constexpr (ALIGN_EPI) { if (wr == 0) PG8_BAR; }
        if constexpr (!Epi::AFTER_DRAIN) { E(acc, cur, wr, wc, fr, fq); S.done(cur); }
        if (!has_next) break;
#pragma unroll
        for (int a = 0; a < 2; ++a)
#pragma unroll
            for (int b = 0; b < 2; ++b)
#pragma unroll
                for (int m = 0; m < 4; ++m)
#pragma unroll
                    for (int n = 0; n < 2; ++n) acc[a][b][m][n] = (f32x4){0.f, 0.f, 0.f, 0.f};
        cur = nxt; cA = nA; cB = nB; ++ui;
        if constexpr (ALIGN_EPI) { if (wr == 1) PG8_BAR; }
    }
    PG8_WAIT_V(0);
    if constexpr (!ALIGN_EPI) { if (wr == 0) PG8_BAR; }
    PG8_BAR;
    if constexpr (Epi::AFTER_DRAIN) { E.fused(acc, cur, wr, wc, fr, fq, lds, wid, lane); S.done(cur); }
#undef PG8_SA
#undef PG8_SB
#undef PG8_STAGE
#undef PG8_LDA
#undef PG8_LDB
#undef PG8_MMA
#undef PG8_WAIT_V
#undef PG8_WAIT_L
#undef PG8_BAR
#undef PG8_SCHED
}
}

constexpr int NWAVES = 8;
#ifndef MK_N_LAUNCHES
#define MK_N_LAUNCHES 1
#endif
constexpr int N_PHASES = 12;
constexpr int N_LAUNCHES = MK_N_LAUNCHES;

constexpr int BATCH = 4, SEQ = 4096, D = 2048, M = BATCH * SEQ;
constexpr int LRU_W = 1024, LRU_HEADS = 8, LRU_BLK = 128;
constexpr int HD = 64, HQ = 16, HKV = 2, GRP = 8;
constexpr int MIX_IN = 3328;
constexpr int C_Y = 1024, C_Q = 2048, C_K = 3072, C_V = 3200;
constexpr int ADA_W = 6 * D;
constexpr int PH = 8, PKEYS = 128, PHALF = 128, PTOPK = 16, NEXP = 16384;
constexpr float EPS = 1e-6f;

constexpr size_t MiB = 1u << 20;
constexpr size_t WS_CTL = 0, CTL_ZERO_BYTES = 64 * 1024;
constexpr size_t WS_ADA = 1 * MiB;
constexpr size_t WS_ROPE = 2 * MiB;
constexpr size_t WS_WIN = 4 * MiB;
constexpr size_t WS_WOUT = 17 * MiB;
constexpr size_t WS_WQ = 25 * MiB;
constexpr size_t WS_WGA = 33 * MiB;
constexpr size_t WS_WGX = 33 * MiB + 256 * 1024;
constexpr size_t WS_SK = 33 * MiB + 512 * 1024;
constexpr size_t WS_IDX = 34 * MiB;
constexpr size_t WS_GW = 42 * MiB;
constexpr size_t WS_U = 50 * MiB;
constexpr size_t WS_V = 82 * MiB;
constexpr size_t WS_USC = 1 * MiB + 512 * 1024;
constexpr size_t WS_VSC = 1 * MiB + 768 * 1024;
constexpr size_t WS_X1B = 114 * MiB;
constexpr size_t WS_XH = 178 * MiB;
constexpr size_t WS_PROJ = 242 * MiB;
constexpr size_t WS_HL = 346 * MiB;
constexpr size_t WS_PA = 410 * MiB;
constexpr size_t WS_PART = WS_HL;
constexpr size_t WS_W = WS_PROJ + 64 * MiB;
constexpr size_t WS_WSC = WS_PROJ + 68 * MiB;
constexpr size_t WS_H8 = WS_PROJ + 72 * MiB;
constexpr size_t WS_END = 474 * MiB;
constexpr int CW_BAR = 4096;

constexpr int RING_BYTES = 131072;
constexpr int LDSCTL_OFF = RING_BYTES, MISC_OFF = LDSCTL_OFF + 320;
constexpr int LDS_BYTES = 147456;

#define GAS __attribute__((address_space(1)))
#define LAS __attribute__((address_space(3)))
typedef unsigned short bf16;
typedef unsigned v4u __attribute__((ext_vector_type(4)));
typedef unsigned v2u __attribute__((ext_vector_type(2)));
typedef float f32x4 __attribute__((ext_vector_type(4)));
typedef float f32x2 __attribute__((ext_vector_type(2)));
typedef float f32x16 __attribute__((ext_vector_type(16)));
typedef short bf16x8 __attribute__((ext_vector_type(8)));
typedef __bf16 bf16x2v __attribute__((ext_vector_type(2)));
#define LDS_WAIT() asm volatile("s_waitcnt lgkmcnt(0)" ::: "memory")
#define VM_WAIT() asm volatile("s_waitcnt vmcnt(0)" ::: "memory")
__device__ __forceinline__ unsigned f2bf(float f) { unsigned u = __builtin_bit_cast(unsigned, f); return (u + 0x7fffu + ((u >> 16) & 1u)) >> 16; }
__device__ __forceinline__ unsigned pk2(float lo, float hi) { return f2bf(lo) | (f2bf(hi) << 16); }
__device__ __forceinline__ float bflo(unsigned u) { return __builtin_bit_cast(float, u << 16); }
__device__ __forceinline__ float bfhi(unsigned u) { return __builtin_bit_cast(float, u & 0xffff0000u); }
__device__ __forceinline__ float bf1(bf16 h) { return __builtin_bit_cast(float, (unsigned)h << 16); }
__device__ __forceinline__ float dot2bf(unsigned a, unsigned b, float acc) { return __builtin_amdgcn_fdot2_f32_bf16(__builtin_bit_cast(bf16x2v, a), __builtin_bit_cast(bf16x2v, b), acc, false); }
__device__ __forceinline__ float sigmoidf_(float x) { return 1.0f / (1.0f + __expf(-x)); }
__device__ __forceinline__ float gelu_tanh(float x) {
    const float z = 1.5957691216057308f * (x + 0.044715f * x * x * x);
    return x / (1.0f + __expf(-z));
}
__device__ __forceinline__ float wave_sum(float v) {
#pragma unroll
    for (int o = 1; o < 64; o <<= 1) v += __shfl_xor(v, o);
    return v;
}

#define XB_TMO      128
#define XB_XCNT(j)  (256  + 64 * (j))
#define XB_XSUB(j)  (1280 + 64 * (j))
#define XB_XGEN(j)  (2304 + 64 * (j))
#define XB_TOP      3328
#define XB_TOPGEN   3392
#define XCD_BAR_WORDS 3456
#define XB_SPIN_CAP (1u << 18)
__device__ __forceinline__ unsigned xb_ld(unsigned* p)              { return __hip_atomic_load(p, __ATOMIC_RELAXED, __HIP_MEMORY_SCOPE_AGENT); }
__device__ __forceinline__ unsigned xb_add(unsigned* p, unsigned v) { return __hip_atomic_fetch_add(p, v, __ATOMIC_RELAXED, __HIP_MEMORY_SCOPE_AGENT); }
__device__ __forceinline__ unsigned xb_xcc_id() { return (unsigned)__builtin_amdgcn_s_getreg((3 << 11) | 20) & 0xFu; }
#define XB_SPIN(cond, bar) do { unsigned _sp = 0; while (cond) { __builtin_amdgcn_s_sleep(1); \
    if ((++_sp & 255u) == 0u) { if (xb_ld(&(bar)[XB_TMO])) break; if (_sp > XB_SPIN_CAP) { atomicAdd(&(bar)[XB_TMO], 1u); break; } } } } while (0)
struct XcdBarrier { unsigned* bar; unsigned x; volatile LAS unsigned* st; };
__device__ __forceinline__ XcdBarrier xcd_barrier_post(unsigned* bar, volatile LAS unsigned* st) {
    XcdBarrier b; b.bar = bar; b.x = xb_xcc_id(); b.st = st;
    if (threadIdx.x == 0) (void)xb_add(&bar[XB_XCNT(b.x)], 1u);
    return b;
}
__device__ __forceinline__ void xcd_barrier_complete(unsigned* bar, unsigned x, unsigned& nloc, unsigned& nx) {
    const unsigned G = gridDim.x * gridDim.y * gridDim.z;
    unsigned sum, cnt, mine, sp = 0u;
    for (;;) {
        sum = 0u; cnt = 0u; mine = 0u;
#pragma unroll
        for (unsigned j = 0; j < 16; ++j) { const unsigned c = xb_ld(&bar[XB_XCNT(j)]); sum += c; cnt += (c > 0u) ? 1u : 0u; mine = (j == x) ? c : mine; }
        if (sum == G) break;
        __builtin_amdgcn_s_sleep(1);
        if ((++sp & 255u) == 0u) { if (xb_ld(&bar[XB_TMO])) break; if (sp > XB_SPIN_CAP) { atomicAdd(&bar[XB_TMO], 1u); break; } }
    }
    nloc = mine > 0u ? mine : 1u; nx = cnt > 0u ? cnt : 1u;
}
__device__ __forceinline__ void xcd_barrier(const XcdBarrier& b) {
    asm volatile("s_waitcnt vmcnt(0)" ::: "memory");
    __syncthreads();
    if (threadIdx.x == 0) {
        unsigned* bar = b.bar;
        __builtin_amdgcn_s_waitcnt(0);
        unsigned nloc = b.st[0], nx = b.st[1];
        if (nloc == 0u) { xcd_barrier_complete(bar, b.x, nloc, nx); b.st[0] = nloc; b.st[1] = nx; }
        const unsigned old = xb_add(&bar[XB_XSUB(b.x)], 1u);
        const unsigned gen = old / nloc;
        if (old + 1u == (gen + 1u) * nloc) {
            __builtin_amdgcn_fence(__ATOMIC_RELEASE, "agent");
            asm volatile("s_waitcnt vmcnt(0)" ::: "memory");
            const unsigned og = xb_add(&bar[XB_TOP], 1u);
            const unsigned tg = og / nx;
            if (og + 1u == (tg + 1u) * nx) xb_add(&bar[XB_TOPGEN], 1u);
            else XB_SPIN(xb_ld(&bar[XB_TOPGEN]) == tg, bar);
            __builtin_amdgcn_fence(__ATOMIC_ACQUIRE, "agent");
            xb_add(&bar[XB_XGEN(b.x)], 1u);
            asm volatile("s_waitcnt vmcnt(0)" ::: "memory");
        } else {
            XB_SPIN(xb_ld(&bar[XB_XGEN(b.x)]) == gen, bar);
            __builtin_amdgcn_fence(__ATOMIC_ACQUIRE, "agent");
            asm volatile("s_waitcnt vmcnt(0)" ::: "memory");
        }
    }
    __syncthreads();
}

typedef const __attribute__((address_space(4))) unsigned char* kaptr_t;
struct Frame { LAS unsigned char* lds; int tid, lane, wave, G, bid; kaptr_t ka; };
template <class T> __device__ __forceinline__ T* ka_ptr(const Frame& F, int byte_off) { typedef T* tp; return *(const __attribute__((address_space(4))) tp*)(F.ka + byte_off); }
__device__ __forceinline__ const float* P_x(const Frame& F) { return ka_ptr<const float>(F, 0); }
__device__ __forceinline__ const float* P_c(const Frame& F) { return ka_ptr<const float>(F, 8); }
__device__ __forceinline__ const int* P_pos(const Frame& F) { return ka_ptr<const int>(F, 16); }
__device__ __forceinline__ const float* P_w_ada(const Frame& F) { return ka_ptr<const float>(F, 24); }
__device__ __forceinline__ const float* P_b_ada(const Frame& F) { return ka_ptr<const float>(F, 32); }
__device__ __forceinline__ const float* P_norm1_g(const Frame& F) { return ka_ptr<const float>(F, 40); }
__device__ __forceinline__ const float* P_w_in(const Frame& F) { return ka_ptr<const float>(F, 48); }
__device__ __forceinline__ const float* P_conv_w(const Frame& F) { return ka_ptr<const float>(F, 56); }
__device__ __forceinline__ const float* P_conv_b(const Frame& F) { return ka_ptr<const float>(F, 64); }
__device__ __forceinline__ const float* P_ga_w(const Frame& F) { return ka_ptr<const float>(F, 72); }
__device__ __forceinline__ const float* P_ga_b(const Frame& F) { return ka_ptr<const float>(F, 80); }
__device__ __forceinline__ const float* P_gx_w(const Frame& F) { return ka_ptr<const float>(F, 88); }
__device__ __forceinline__ const float* P_gx_b(const Frame& F) { return ka_ptr<const float>(F, 96); }
__device__ __forceinline__ const float* P_lam(const Frame& F) { return ka_ptr<const float>(F, 104); }
__device__ __forceinline__ const float* P_qn_g(const Frame& F) { return ka_ptr<const float>(F, 112); }
__device__ __forceinline__ const float* P_kn_g(const Frame& F) { return ka_ptr<const float>(F, 120); }
__device__ __forceinline__ const float* P_sinks(const Frame& F) { return ka_ptr<const float>(F, 128); }
__device__ __forceinline__ const float* P_on_lru_g(const Frame& F) { return ka_ptr<const float>(F, 136); }
__device__ __forceinline__ const float* P_on_attn_g(const Frame& F) { return ka_ptr<const float>(F, 144); }
__device__ __forceinline__ const float* P_w_out(const Frame& F) { return ka_ptr<const float>(F, 152); }
__device__ __forceinline__ const float* P_norm2_g(const Frame& F) { return ka_ptr<const float>(F, 160); }
__device__ __forceinline__ const float* P_w_pq(const Frame& F) { return ka_ptr<const float>(F, 168); }
__device__ __forceinline__ const float* P_sub_keys(const Frame& F) { return ka_ptr<const float>(F, 176); }
__device__ __forceinline__ const float* P_pu(const Frame& F) { return ka_ptr<const float>(F, 184); }
__device__ __forceinline__ const float* P_pv(const Frame& F) { return ka_ptr<const float>(F, 192); }
__device__ __forceinline__ float* P_out(const Frame& F) { return ka_ptr<float>(F, 200); }
__device__ __forceinline__ unsigned char* P_ws(const Frame& F) { return ka_ptr<unsigned char>(F, 208); }
__device__ __forceinline__ float* P_ADA(const Frame& F) { return (float*)(P_ws(F) + WS_ADA); }
__device__ __forceinline__ float* P_ROPE(const Frame& F) { return (float*)(P_ws(F) + WS_ROPE); }
__device__ __forceinline__ bf16* P_HL(const Frame& F) { return (bf16*)(P_ws(F) + WS_HL); }
__device__ __forceinline__ bf16* P_PA(const Frame& F) { return (bf16*)(P_ws(F) + WS_PA); }
__device__ __forceinline__ float* P_GW(const Frame& F) { return (float*)(P_ws(F) + WS_GW); }
__device__ __forceinline__ unsigned short* P_IDX(const Frame& F) { return (unsigned short*)(P_ws(F) + WS_IDX); }
__device__ __forceinline__ bf16* P_WIN(const Frame& F) { return (bf16*)(P_ws(F) + WS_WIN); }
__device__ __forceinline__ bf16* P_WOUT(const Frame& F) { return (bf16*)(P_ws(F) + WS_WOUT); }
__device__ __forceinline__ bf16* P_WQ(const Frame& F) { return (bf16*)(P_ws(F) + WS_WQ); }
__device__ __forceinline__ bf16* P_WGA(const Frame& F) { return (bf16*)(P_ws(F) + WS_WGA); }
__device__ __forceinline__ bf16* P_WGX(const Frame& F) { return (bf16*)(P_ws(F) + WS_WGX); }
__device__ __forceinline__ bf16* P_SK(const Frame& F) { return (bf16*)(P_ws(F) + WS_SK); }
__device__ __forceinline__ unsigned char* P_U(const Frame& F) { return (unsigned char*)(P_ws(F) + WS_U); }
__device__ __forceinline__ bf16* P_X1B(const Frame& F) { return (bf16*)(P_ws(F) + WS_X1B); }
__device__ __forceinline__ unsigned char* P_H8(const Frame& F) { return (unsigned char*)(P_ws(F) + WS_H8); }
__device__ __forceinline__ unsigned* P_PART(const Frame& F) { return (unsigned*)(P_ws(F) + WS_PART); }
__device__ __forceinline__ unsigned char* P_W(const Frame& F) { return (unsigned char*)(P_ws(F) + WS_W); }
__device__ __forceinline__ float* P_WSC(const Frame& F) { return (float*)(P_ws(F) + WS_WSC); }
__device__ __forceinline__ float* P_USC(const Frame& F) { return (float*)(P_ws(F) + WS_USC); }
__device__ __forceinline__ float* P_VSC(const Frame& F) { return (float*)(P_ws(F) + WS_VSC); }
__device__ __forceinline__ unsigned char* P_V(const Frame& F) { return (unsigned char*)(P_ws(F) + WS_V); }
__device__ __forceinline__ bf16* P_XH(const Frame& F) { return (bf16*)(P_ws(F) + WS_XH); }
__device__ __forceinline__ bf16* P_PROJ(const Frame& F) { return (bf16*)(P_ws(F) + WS_PROJ); }

__device__ __forceinline__ void p0_transpose_item(const float* W, int K, int N, bf16* WT, LAS float* scr, int item, int lane) {
    const int nblk = N / 32, kb = item / nblk, nb = item % nblk, k0 = 64 * kb, n0 = 32 * nb;
#pragma unroll 8
    for (int i = 0; i < 32; ++i) { const int kk = 2 * i + (lane >> 5); scr[kk * 33 + (lane & 31)] = W[(size_t)(k0 + kk) * N + n0 + (lane & 31)]; }
    LDS_WAIT(); asm volatile("" ::: "memory");
    const int c = lane & 7;
#pragma unroll
    for (int j = 0; j < 4; ++j) { const int n = (lane >> 3) + 8 * j; const LAS float* s = scr + (8 * c) * 33 + n;
        v4u o; o.x = pk2(s[0 * 33], s[1 * 33]); o.y = pk2(s[2 * 33], s[3 * 33]); o.z = pk2(s[4 * 33], s[5 * 33]); o.w = pk2(s[6 * 33], s[7 * 33]);
        *(v4u*)(WT + (size_t)(n0 + n) * K + k0 + 8 * c) = o; }
    LDS_WAIT(); asm volatile("" ::: "memory");
}
__device__ __forceinline__ void p0_convert(const float* src, bf16* dst, size_t n8, size_t gtid, size_t gthreads) {
    for (size_t i = gtid; i < n8; i += gthreads) {
        const f32x4 a = *(const f32x4*)(src + 8 * i), b = *(const f32x4*)(src + 8 * i + 4);
        v4u o; o.x = pk2(a.x, a.y); o.y = pk2(a.z, a.w); o.z = pk2(b.x, b.y); o.w = pk2(b.z, b.w);
        *(v4u*)(dst + 8 * i) = o;
    }
}
#ifndef QUANT_SPLIT
#define QUANT_SPLIT 14336
#endif
__device__ __forceinline__ void quant_rows(Frame& F, int r0, int r1, int w, int nw) {
    for (int rr = r0 + w; rr < r1; rr += nw) {
        const int tbl = rr >= NEXP, row = rr - tbl * NEXP;
        const float* srcp = (tbl ? P_pv(F) : P_pu(F)) + (size_t)row * D;
        f32x4 v[8]; float mx = 0.f;
#pragma unroll
        for (int j = 0; j < 8; ++j) { v[j] = *(const f32x4*)(srcp + 4 * F.lane + 256 * j);
            mx = fmaxf(fmaxf(mx, fmaxf(fabsf(v[j].x), fabsf(v[j].y))), fmaxf(fabsf(v[j].z), fabsf(v[j].w))); }
#pragma unroll
        for (int o = 1; o < 64; o <<= 1) mx = fmaxf(mx, __shfl_xor(mx, o));
        {
            const float s = fmaxf(mx, 1e-30f) * (1.0f / 6.0f), inv = 1.0f / s;
            unsigned char* d4 = (tbl ? P_V(F) : P_U(F)) + (size_t)row * 128 + 2 * F.lane;
#pragma unroll
            for (int j = 0; j < 8; ++j) { unsigned t = __builtin_amdgcn_cvt_scalef32_pk_fp4_f32(0u, v[j].x * inv, v[j].y * inv, 1.0f, 0);
                t = __builtin_amdgcn_cvt_scalef32_pk_fp4_f32(t, v[j].z * inv, v[j].w * inv, 1.0f, 1);
                *(unsigned short*)(d4 + (size_t)j * (NEXP * 128)) = (unsigned short)t; }
            if (F.lane == 0) (tbl ? P_VSC(F) : P_USC(F))[row] = s;
        }
    }
}
__device__ __forceinline__ void p0_prologue(Frame& F) {
    {
        LAS float* sc = (LAS float*)F.lds;
        LAS float* red = sc + 4 * D;
        for (int i = F.tid; i < 4 * D; i += 512) { const float v = P_c(F)[i]; sc[i] = v / (1.0f + __expf(-v)); }
        __syncthreads();
        for (int cg = F.bid; cg < ADA_W / 64; cg += F.G) {
            const int n0 = cg * 64, k0 = F.wave * 256;
            const float* wp = P_w_ada(F) + (size_t)k0 * ADA_W + n0 + F.lane;
            float a0 = 0.f, a1 = 0.f, a2 = 0.f, a3 = 0.f;
#pragma unroll 16
            for (int k = 0; k < 256; ++k) { const float w = wp[(size_t)k * ADA_W]; const int kk = k0 + k;
                a0 += sc[kk] * w; a1 += sc[D + kk] * w; a2 += sc[2 * D + kk] * w; a3 += sc[3 * D + kk] * w; }
            red[(F.wave * 4 + 0) * 64 + F.lane] = a0; red[(F.wave * 4 + 1) * 64 + F.lane] = a1;
            red[(F.wave * 4 + 2) * 64 + F.lane] = a2; red[(F.wave * 4 + 3) * 64 + F.lane] = a3;
            __syncthreads();
            if (F.tid < 256) { const int b = F.tid >> 6, l = F.tid & 63; float s = 0.f;
#pragma unroll
                for (int w = 0; w < 8; ++w) s += red[(w * 4 + b) * 64 + l];
                P_ADA(F)[(size_t)b * ADA_W + n0 + l] = s + P_b_ada(F)[n0 + l]; }
            __syncthreads();
        }
        __syncthreads();
    }
    {
        LAS float* scr = (LAS float*)(F.lds + F.wave * 16384);
        const int gw = F.bid * NWAVES + F.wave, NGW = F.G * NWAVES;
        constexpr int I_IN = (D / 64) * (MIX_IN / 32), I_SQ = (D / 64) * (D / 32), I_G = (LRU_BLK / 64) * (LRU_BLK / 32);
        constexpr int NITEMS = I_IN + 2 * I_SQ + 16 * I_G;
        for (int it = gw; it < NITEMS; it += NGW) {
            int r = it;
            if (r < I_IN) { p0_transpose_item(P_w_in(F), D, MIX_IN, P_WIN(F), scr, r, F.lane); continue; } r -= I_IN;
            if (r < I_SQ) { p0_transpose_item(P_w_out(F), D, D, P_WOUT(F), scr, r, F.lane); continue; } r -= I_SQ;
            if (r < I_SQ) { p0_transpose_item(P_w_pq(F), D, D, P_WQ(F), scr, r, F.lane); continue; } r -= I_SQ;
            const int g = r / I_G, ri = r % I_G, hd = g & 7;
            if (g < 8) p0_transpose_item(P_ga_w(F) + (size_t)hd * 16384, LRU_BLK, LRU_BLK, P_WGA(F) + (size_t)hd * 16384, scr, ri, F.lane);
            else       p0_transpose_item(P_gx_w(F) + (size_t)hd * 16384, LRU_BLK, LRU_BLK, P_WGX(F) + (size_t)hd * 16384, scr, ri, F.lane);
        }
    }
    {
        const size_t gtid = (size_t)F.bid * 512 + F.tid, gth = (size_t)F.G * 512;
        p0_convert(P_sub_keys(F), P_SK(F), (size_t)PH * 2 * PKEYS * PHALF / 8, gtid, gth);
    }
    quant_rows(F, 0, QUANT_SPLIT, F.bid * NWAVES + F.wave, F.G * NWAVES);
}

template <bool RESID, int R> __device__ __forceinline__ void modnorm_rows(const float* xin, const float* gain, const float* shift, const float* scale, bf16* orow, int lane, bf16* xin2 = nullptr, unsigned char* o8 = nullptr) {
    f32x4 v[R][4][2]; float s[R];
#pragma unroll
    for (int r = 0; r < R; ++r) { s[r] = 0.f;
#pragma unroll
        for (int j = 0; j < 4; ++j) { const int c = 8 * lane + 512 * j;
            v[r][j][0] = *(const f32x4*)(xin + (size_t)r * D + c); v[r][j][1] = *(const f32x4*)(xin + (size_t)r * D + c + 4);
            if (RESID) { bf16* dp = xin2 + (size_t)r * D + c; const v4u q = *(const v4u*)dp;
                v[r][j][0] += (f32x4){bflo(q.x), bfhi(q.x), bflo(q.y), bfhi(q.y)}; v[r][j][1] += (f32x4){bflo(q.z), bfhi(q.z), bflo(q.w), bfhi(q.w)};
                v4u o; o.x = pk2(v[r][j][0].x, v[r][j][0].y); o.y = pk2(v[r][j][0].z, v[r][j][0].w); o.z = pk2(v[r][j][1].x, v[r][j][1].y); o.w = pk2(v[r][j][1].z, v[r][j][1].w); *(v4u*)dp = o; } } }
#pragma unroll
    for (int r = 0; r < R; ++r)
#pragma unroll
        for (int j = 0; j < 4; ++j)
#pragma unroll
            for (int h = 0; h < 2; ++h) { const f32x4 t = v[r][j][h]; s[r] += (t.x * t.x + t.y * t.y) + (t.z * t.z + t.w * t.w); }
#pragma unroll
    for (int o = 1; o < 64; o <<= 1) {
#pragma unroll
        for (int r = 0; r < R; ++r) s[r] += __shfl_xor(s[r], o); }
    float rstd[R];
#pragma unroll
    for (int r = 0; r < R; ++r) rstd[r] = 1.0f / sqrtf(s[r] * (1.0f / D) + EPS);
#pragma unroll
    for (int j = 0; j < 4; ++j) {
        const int c = 8 * lane + 512 * j;
        f32x4 gm[2], sh[2];
#pragma unroll
        for (int h = 0; h < 2; ++h) { const f32x4 g = *(const f32x4*)(gain + c + 4 * h), sc = *(const f32x4*)(scale + c + 4 * h); sh[h] = *(const f32x4*)(shift + c + 4 * h); gm[h] = g * (sc + 1.0f); }
#pragma unroll
        for (int r = 0; r < R; ++r) { const f32x4 y0 = (v[r][j][0] * rstd[r]) * gm[0] + sh[0], y1 = (v[r][j][1] * rstd[r]) * gm[1] + sh[1];
            v4u o; o.x = pk2(y0.x, y0.y); o.y = pk2(y0.z, y0.w); o.z = pk2(y1.x, y1.y); o.w = pk2(y1.z, y1.w);
            *(v4u*)(orow + (size_t)r * D + c) = o;
            if (RESID) { int t0 = __builtin_amdgcn_cvt_pk_fp8_f32(y0.x, y0.y, 0, false); t0 = __builtin_amdgcn_cvt_pk_fp8_f32(y0.z, y0.w, t0, true);
                int t1 = __builtin_amdgcn_cvt_pk_fp8_f32(y1.x, y1.y, 0, false); t1 = __builtin_amdgcn_cvt_pk_fp8_f32(y1.z, y1.w, t1, true);
                *(v2u*)(o8 + (size_t)r * D + c) = (v2u){(unsigned)t0, (unsigned)t1}; } }
    }
}
__device__ __forceinline__ void p1_phase(Frame& F) {
    const int gw = F.bid * NWAVES + F.wave, NGW = F.G * NWAVES;
    for (int m = 4 * gw; m < M; m += 4 * NGW) { const int b = m / SEQ; const float* ada = P_ADA(F) + (size_t)b * ADA_W;
        modnorm_rows<false, 4>(P_x(F) + (size_t)m * D, P_norm1_g(F), ada, ada + D, P_XH(F) + (size_t)m * D, F.lane); }
    const float invf[8] = {1.0f, 1.9392274e-01f, 3.7606031e-02f, 7.2926646e-03f, 1.4142136e-03f, 2.7424819e-04f, 5.3182961e-05f, 1.0313386e-05f};
    for (int i = F.bid * 512 + F.tid; i < M * 8; i += F.G * 512) { const int m = i >> 3, k = i & 7;
        float f = invf[0];
#pragma unroll
        for (int q = 1; q < 8; ++q) f = (k == q) ? invf[q] : f;
        const float ang = (float)P_pos(F)[m] * f; float sn, cs; sincosf(ang, &sn, &cs);
        P_ROPE(F)[(size_t)m * 16 + k] = cs; P_ROPE(F)[(size_t)m * 16 + 8 + k] = sn; }
}
__device__ __forceinline__ void p6_phase(Frame& F) {
    const int gw = F.bid * NWAVES + F.wave, NGW = F.G * NWAVES;
    for (int m = 2 * gw; m < M; m += 2 * NGW) { const int b = m / SEQ; const float* ada = P_ADA(F) + (size_t)b * ADA_W;
        modnorm_rows<true, 2>(P_x(F) + (size_t)m * D, P_norm2_g(F), ada + 3 * D, ada + 4 * D, P_XH(F) + (size_t)m * D, F.lane, P_X1B(F) + (size_t)m * D, P_H8(F) + (size_t)m * D); }
}

#define MFMA32(a, b, c) __builtin_amdgcn_mfma_f32_32x32x16_bf16((a), (b), (c), 0, 0, 0)
#define MFMA16(a, b, c) __builtin_amdgcn_mfma_f32_16x16x32_bf16((a), (b), (c), 0, 0, 0)
constexpr int KS_STRIDE = 72;
constexpr int VT_STRIDE = 264;
constexpr int ATT_KS_OFF = 0, ATT_VT_OFF = 256 * KS_STRIDE * 2;
static_assert(ATT_VT_OFF + 64 * VT_STRIDE * 2 <= RING_BYTES, "attention LDS");

__device__ __forceinline__ void attn_unit(Frame& F, int b, int g, int n) {
    LAS bf16* Ks = (LAS bf16*)(F.lds + ATT_KS_OFF);
    LAS bf16* VT = (LAS bf16*)(F.lds + ATT_VT_OFF);
    const int tid = F.tid, lane = F.lane;
    {
        const int kb = tid >> 1, hf = tid & 1; const int t = n * 128 - 128 + kb;
        float kv[32]; v4u vraw[4];
        if (t >= 0) {
            const bf16* kp = P_PROJ(F) + (size_t)(b * SEQ + t) * MIX_IN + C_K + g * HD + 32 * hf;
            const bf16* vp = P_PROJ(F) + (size_t)(b * SEQ + t) * MIX_IN + C_V + g * HD + 32 * hf;
#pragma unroll
            for (int q = 0; q < 4; ++q) { const v4u r = *(const v4u*)(kp + 8 * q); vraw[q] = *(const v4u*)(vp + 8 * q);
                kv[8 * q + 0] = bflo(r.x); kv[8 * q + 1] = bfhi(r.x); kv[8 * q + 2] = bflo(r.y); kv[8 * q + 3] = bfhi(r.y);
                kv[8 * q + 4] = bflo(r.z); kv[8 * q + 5] = bfhi(r.z); kv[8 * q + 6] = bflo(r.w); kv[8 * q + 7] = bfhi(r.w); }
        } else {
#pragma unroll
            for (int q = 0; q < 4; ++q) vraw[q] = (v4u){0u, 0u, 0u, 0u};
#pragma unroll
            for (int q = 0; q < 32; ++q) kv[q] = 0.f;
        }
        float ss = 0.f;
#pragma unroll
        for (int q = 0; q < 32; ++q) ss += kv[q] * kv[q];
        ss += __shfl_xor(ss, 1);
        const float rstd = 1.0f / sqrtf(ss * (1.0f / HD) + EPS);
#pragma unroll
        for (int q = 0; q < 32; ++q) kv[q] = kv[q] * rstd * P_kn_g(F)[32 * hf + q];
        if (hf == 0 && t >= 0) {
            const float* rp = P_ROPE(F) + (size_t)(b * SEQ + t) * 16;
#pragma unroll
            for (int i = 0; i < 8; ++i) { const float cs = rp[i], sn = rp[8 + i]; const float x1 = kv[i], x2 = kv[8 + i];
                kv[i] = x1 * cs - x2 * sn; kv[8 + i] = x2 * cs + x1 * sn; }
        }
#pragma unroll
        for (int q = 0; q < 4; ++q) { v4u o; o.x = pk2(kv[8 * q], kv[8 * q + 1]); o.y = pk2(kv[8 * q + 2], kv[8 * q + 3]); o.z = pk2(kv[8 * q + 4], kv[8 * q + 5]); o.w = pk2(kv[8 * q + 6], kv[8 * q + 7]);
            *(LAS v4u*)(Ks + kb * KS_STRIDE + 32 * hf + 8 * q) = o; }
#pragma unroll
        for (int q = 0; q < 4; ++q) { const unsigned w[4] = {vraw[q].x, vraw[q].y, vraw[q].z, vraw[q].w};
#pragma unroll
            for (int e = 0; e < 4; ++e) { const int d = 32 * hf + 8 * q + 2 * e;
                VT[d * VT_STRIDE + kb] = (bf16)(w[e] & 0xffffu); VT[(d + 1) * VT_STRIDE + kb] = (bf16)(w[e] >> 16); } }
    }
    __syncthreads();
    const int hq = g * GRP + F.wave, r = lane & 31, hh = lane >> 5;
    const float sink = P_sinks(F)[hq];
    for (int qi = 0; qi < 4; ++qi) {
        const int tq = n * 128 + 32 * qi + r;
        bf16x8 qf[4];
        {
            const bf16* qp = P_PROJ(F) + (size_t)(b * SEQ + tq) * MIX_IN + C_Q + hq * HD + 8 * hh;
            float qv[4][8]; float ss = 0.f;
#pragma unroll
            for (int ks = 0; ks < 4; ++ks) { const v4u rr = *(const v4u*)(qp + 16 * ks);
                qv[ks][0] = bflo(rr.x); qv[ks][1] = bfhi(rr.x); qv[ks][2] = bflo(rr.y); qv[ks][3] = bfhi(rr.y);
                qv[ks][4] = bflo(rr.z); qv[ks][5] = bfhi(rr.z); qv[ks][6] = bflo(rr.w); qv[ks][7] = bfhi(rr.w);
#pragma unroll
                for (int j = 0; j < 8; ++j) ss += qv[ks][j] * qv[ks][j]; }
            ss += __shfl_xor(ss, 32);
            const float rstd = 1.0f / sqrtf(ss * (1.0f / HD) + EPS);
#pragma unroll
            for (int ks = 0; ks < 4; ++ks)
#pragma unroll
                for (int j = 0; j < 8; ++j) qv[ks][j] = qv[ks][j] * rstd * P_qn_g(F)[16 * ks + 8 * hh + j];
            const float* rp = P_ROPE(F) + (size_t)(b * SEQ + tq) * 16;
#pragma unroll
            for (int j = 0; j < 8; ++j) { const float mine = qv[0][j], other = __shfl_xor(mine, 32); const float cs = rp[j], sn = rp[8 + j];
                qv[0][j] = hh == 0 ? (mine * cs - other * sn) : (mine * cs + other * sn); }
#pragma unroll
            for (int ks = 0; ks < 4; ++ks) { v4u o; o.x = pk2(qv[ks][0] * 0.125f, qv[ks][1] * 0.125f); o.y = pk2(qv[ks][2] * 0.125f, qv[ks][3] * 0.125f);
                o.z = pk2(qv[ks][4] * 0.125f, qv[ks][5] * 0.125f); o.w = pk2(qv[ks][6] * 0.125f, qv[ks][7] * 0.125f); qf[ks] = __builtin_bit_cast(bf16x8, o); }
        }
        f32x16 s[5];
#pragma unroll
        for (int kj = 0; kj < 5; ++kj) {
            f32x16 acc;
#pragma unroll
            for (int i = 0; i < 16; ++i) acc[i] = 0.f;
            const LAS bf16* kp = Ks + (32 * (qi + kj) + r) * KS_STRIDE + 8 * hh;
#pragma unroll
            for (int ks = 0; ks < 4; ++ks) { const bf16x8 kf = *(const LAS bf16x8*)(kp + 16 * ks); acc = MFMA32(kf, qf[ks], acc); }
            s[kj] = acc;
        }
        float mx = sink;
#pragma unroll
        for (int kj = 0; kj < 5; ++kj)
#pragma unroll
            for (int i = 0; i < 16; ++i) { const int kt = (i & 3) + 8 * (i >> 2) + 4 * hh; const int kbi = 32 * (qi + kj) + kt;
                bool valid = (n * 128 + kbi - 128) >= 0;
                if (kj == 0) valid = valid && (kt > r);
                if (kj == 4) valid = valid && (kt <= r);
                s[kj][i] = valid ? s[kj][i] : -INFINITY; mx = fmaxf(mx, s[kj][i]); }
        mx = fmaxf(mx, __shfl_xor(mx, 32));
        float l = 0.f;
#pragma unroll
        for (int kj = 0; kj < 5; ++kj)
#pragma unroll
            for (int i = 0; i < 16; ++i) { const float p = __expf(s[kj][i] - mx); s[kj][i] = p; l += p; }
        l += __shfl_xor(l, 32);
        l += __expf(sink - mx);
        const float inv = 1.0f / l;
        f32x16 o0, o1;
#pragma unroll
        for (int i = 0; i < 16; ++i) { o0[i] = 0.f; o1[i] = 0.f; }
#pragma unroll
        for (int kj = 0; kj < 5; ++kj)
#pragma unroll
            for (int st = 0; st < 2; ++st) {
                v4u pa; pa.x = pk2(s[kj][8 * st + 0] * inv, s[kj][8 * st + 1] * inv); pa.y = pk2(s[kj][8 * st + 2] * inv, s[kj][8 * st + 3] * inv);
                pa.z = pk2(s[kj][8 * st + 4] * inv, s[kj][8 * st + 5] * inv); pa.w = pk2(s[kj][8 * st + 6] * inv, s[kj][8 * st + 7] * inv);
                const bf16x8 pf = __builtin_bit_cast(bf16x8, pa);
                const int kb0 = 32 * (qi + kj) + 16 * st + 4 * hh;
                const LAS bf16* v0p = VT + r * VT_STRIDE + kb0; const LAS bf16* v1p = VT + (32 + r) * VT_STRIDE + kb0;
                const v2u a0 = *(const LAS v2u*)v0p, a1 = *(const LAS v2u*)(v0p + 8), b0 = *(const LAS v2u*)v1p, b1 = *(const LAS v2u*)(v1p + 8);
                const v4u vb0 = {a0.x, a0.y, a1.x, a1.y}, vb1 = {b0.x, b0.y, b1.x, b1.y};
                o0 = MFMA32(pf, __builtin_bit_cast(bf16x8, vb0), o0);
                o1 = MFMA32(pf, __builtin_bit_cast(bf16x8, vb1), o1);
            }
#pragma unroll
        for (int i = 0; i < 16; ++i) { const int qr = (i & 3) + 8 * (i >> 2) + 4 * hh; const int tok = n * 128 + 32 * qi + qr;
            bf16* op = P_XH(F) + (size_t)(b * SEQ + tok) * D + LRU_W + hq * HD + r;
            op[0] = (bf16)f2bf(o0[i]); op[32] = (bf16)f2bf(o1[i]); }
    }
    __syncthreads();
}

constexpr int LCH = 64;
constexpr int XC_STRIDE = 136;
constexpr int LRU_XCB_OFF = 0, LRU_XCF_OFF = LCH * XC_STRIDE * 2  , LRU_A_OFF = LRU_XCF_OFF + LCH * 128 * 4, LRU_B_OFF = LRU_A_OFF + LCH * 128 * 4, LRU_SE_OFF = LRU_B_OFF + LCH * 128 * 4;
static_assert(LRU_SE_OFF + 2 * 4 * 128 * 4 <= RING_BYTES, "LRU LDS");
__device__ __forceinline__ void lru_block(Frame& F) {
    LAS bf16* XCb = (LAS bf16*)(F.lds + LRU_XCB_OFF);
    LAS float* XCF = (LAS float*)(F.lds + LRU_XCF_OFF);
    LAS float* As = (LAS float*)(F.lds + LRU_A_OFF);
    LAS float* Bs = (LAS float*)(F.lds + LRU_B_OFF);
    LAS float* SEh = (LAS float*)(F.lds + LRU_SE_OFF);
    LAS float* SEp = SEh + 4 * 128;
    const int tid = F.tid, lane = F.lane;
    const int hd = F.bid & 7, li = F.bid >> 3, step = F.G >> 3;
    constexpr int NQ = BATCH * (SEQ / LCH);
    if (li >= NQ) return;
    const int cg = tid & 15, tp = tid >> 4, colc = hd * LRU_BLK + 8 * cg;
    float cw[4][8], cbv[8];
#pragma unroll
    for (int k = 0; k < 4; ++k) { const f32x4 a = *(const f32x4*)(P_conv_w(F) + k * LRU_W + colc), b2 = *(const f32x4*)(P_conv_w(F) + k * LRU_W + colc + 4);
        cw[k][0] = a.x; cw[k][1] = a.y; cw[k][2] = a.z; cw[k][3] = a.w; cw[k][4] = b2.x; cw[k][5] = b2.y; cw[k][6] = b2.z; cw[k][7] = b2.w; }
    { const f32x4 a = *(const f32x4*)(P_conv_b(F) + colc), b2 = *(const f32x4*)(P_conv_b(F) + colc + 4);
      cbv[0] = a.x; cbv[1] = a.y; cbv[2] = a.z; cbv[3] = a.w; cbv[4] = b2.x; cbv[5] = b2.y; cbv[6] = b2.z; cbv[7] = b2.w; }
    const int fr = lane & 15, fq = lane >> 4, j = 16 * F.wave + fr, jc = hd * LRU_BLK + j;
    bf16x8 wa[4], wx[4];
    { const bf16* wap = P_WGA(F) + (size_t)hd * 16384 + (size_t)j * 128 + 8 * fq; const bf16* wxp = P_WGX(F) + (size_t)hd * 16384 + (size_t)j * 128 + 8 * fq;
#pragma unroll
      for (int ks = 0; ks < 4; ++ks) { wa[ks] = *(const bf16x8*)(wap + 32 * ks); wx[ks] = *(const bf16x8*)(wxp + 32 * ks); } }
    const float ba = P_ga_b(F)[jc], bx = P_gx_b(F)[jc];
    const float sp8 = -8.0f * log1pf(__expf(-P_lam(F)[jc]));
    const int c = tid & 127, sub = tid >> 7, col = hd * LRU_BLK + c;
    const bf16* xbase = P_PROJ(F) + colc;
    bf16* HLp = P_HL(F); bf16* PAp = P_PA(F);
    v4u xr[5];
#define LRU_LOAD_X(q_) do { const int b_ = (q_) >> 6, ch_ = (q_) & 63; const int tr_ = ch_ * LCH + 2 * tp - 3; \
        _Pragma("unroll") for (int r_ = 0; r_ < 5; ++r_) { const int t_ = tr_ + r_; \
            xr[r_] = (t_ >= 0) ? *(const v4u*)(xbase + (size_t)(b_ * SEQ + t_) * MIX_IN) : (v4u){0u, 0u, 0u, 0u}; } } while (0)
    LRU_LOAD_X(li);
    for (int q = li; q < NQ; q += step) {
        const int b = q >> 6, ch = q & 63, t0 = ch * LCH;
        {
            float xv[5][8];
#pragma unroll
            for (int r = 0; r < 5; ++r) { xv[r][0] = bflo(xr[r].x); xv[r][1] = bfhi(xr[r].x); xv[r][2] = bflo(xr[r].y); xv[r][3] = bfhi(xr[r].y);
                xv[r][4] = bflo(xr[r].z); xv[r][5] = bfhi(xr[r].z); xv[r][6] = bflo(xr[r].w); xv[r][7] = bfhi(xr[r].w); }
            if (q + step < NQ) LRU_LOAD_X(q + step);
#pragma unroll
            for (int tk = 0; tk < 2; ++tk) { float xc[8];
#pragma unroll
                for (int e = 0; e < 8; ++e) xc[e] = cbv[e] + cw[0][e] * xv[tk][e] + cw[1][e] * xv[tk + 1][e] + cw[2][e] * xv[tk + 2][e] + cw[3][e] * xv[tk + 3][e];
                const int tl = 2 * tp + tk;
                v4u o; o.x = pk2(xc[0], xc[1]); o.y = pk2(xc[2], xc[3]); o.z = pk2(xc[4], xc[5]); o.w = pk2(xc[6], xc[7]);
                *(LAS v4u*)(XCb + tl * XC_STRIDE + 8 * cg) = o;
                *(LAS f32x4*)(XCF + tl * 128 + 8 * cg) = (f32x4){xc[0], xc[1], xc[2], xc[3]}; *(LAS f32x4*)(XCF + tl * 128 + 8 * cg + 4) = (f32x4){xc[4], xc[5], xc[6], xc[7]}; }
        }
        __syncthreads();
#pragma unroll
        for (int mt = 0; mt < 4; ++mt) {
            f32x4 ra = {0.f, 0.f, 0.f, 0.f}, rx = {0.f, 0.f, 0.f, 0.f};
            const LAS bf16* ap = XCb + (16 * mt + fr) * XC_STRIDE + 8 * fq;
#pragma unroll
            for (int ks = 0; ks < 4; ++ks) { const bf16x8 af = *(const LAS bf16x8*)(ap + 32 * ks); ra = MFMA16(af, wa[ks], ra); rx = MFMA16(af, wx[ks], rx); }
#pragma unroll
            for (int e = 0; e < 4; ++e) { const int tl = 16 * mt + 4 * fq + e;
                const float rg = sigmoidf_(ra[e] + ba), ig = sigmoidf_(rx[e] + bx);
                const float a = __expf(rg * sp8);
                const float mult = sqrtf(fmaxf(fmaf(-a, a, 1.0f), 0.f));
                As[tl * 128 + j] = a; Bs[tl * 128 + j] = mult * ig * XCF[tl * 128 + j]; }
        }
        __syncthreads();
        float hh[16], pp[16];
        {
            float h = 0.f, P = 1.f;
#pragma unroll
            for (int i = 0; i < 16; ++i) { const int tl = sub * 16 + i; const float a = As[tl * 128 + c], bq = Bs[tl * 128 + c];
                h = a * h + bq; P *= a; hh[i] = h; pp[i] = P; }
            SEh[sub * 128 + c] = h; SEp[sub * 128 + c] = P;
        }
        __syncthreads();
        {
            float carry = 0.f, pre = 1.f;
            for (int s2 = 0; s2 < sub; ++s2) { carry = SEh[s2 * 128 + c] + SEp[s2 * 128 + c] * carry; pre *= SEp[s2 * 128 + c]; }
            bf16* hl = HLp + (size_t)(b * SEQ + t0 + sub * 16) * LRU_W + col;
            bf16* pa = PAp + (size_t)(b * SEQ + t0 + sub * 16) * LRU_W + col;
#pragma unroll
            for (int i = 0; i < 16; ++i) { hl[(size_t)i * LRU_W] = (bf16)f2bf(hh[i] + pp[i] * carry); pa[(size_t)i * LRU_W] = (bf16)f2bf(pp[i] * pre); }
        }
    }
#undef LRU_LOAD_X
    __syncthreads();
}
constexpr int N_ATT_UNITS = BATCH * HKV * (SEQ / 128);
constexpr int N_LRU_UNITS = BATCH * LRU_HEADS * (SEQ / LCH);
__device__ __forceinline__ void p3_phase(Frame& F) {
    for (int u = F.bid; u < N_ATT_UNITS; u += F.G) attn_unit(F, u >> 6, (u >> 5) & 1, u & 31);
    lru_block(F);
}

__device__ __forceinline__ void p4_unit(Frame& F, int b, int ch) {
    LAS float* CAR = (LAS float*)F.lds;
    const int tid = F.tid, lane = F.lane;
    {
        f32x2 carry = {0.f, 0.f};
        const bf16* hlb = P_HL(F) + (size_t)(b * SEQ + LCH - 1) * LRU_W + 2 * tid; const bf16* pab = P_PA(F) + (size_t)(b * SEQ + LCH - 1) * LRU_W + 2 * tid;
        int c2 = 0;
        for (; c2 + 8 <= ch; c2 += 8) { unsigned hl[8], pa[8];
#pragma unroll
            for (int q = 0; q < 8; ++q) { hl[q] = *(const unsigned*)(hlb + (size_t)(c2 + q) * LCH * LRU_W); pa[q] = *(const unsigned*)(pab + (size_t)(c2 + q) * LCH * LRU_W); }
#pragma unroll
            for (int q = 0; q < 8; ++q) { carry.x = bflo(hl[q]) + bflo(pa[q]) * carry.x; carry.y = bfhi(hl[q]) + bfhi(pa[q]) * carry.y; } }
        for (; c2 < ch; ++c2) { const unsigned hl = *(const unsigned*)(hlb + (size_t)c2 * LCH * LRU_W), pa = *(const unsigned*)(pab + (size_t)c2 * LCH * LRU_W);
            carry.x = bflo(hl) + bflo(pa) * carry.x; carry.y = bfhi(hl) + bfhi(pa) * carry.y; }
        CAR[2 * tid] = carry.x; CAR[2 * tid + 1] = carry.y;
    }
    __syncthreads();
    const float* gl = P_on_lru_g(F); const float* ga = P_on_attn_g(F);
    for (int i = 0; i < 8; i += 2) {
        const size_t m0 = (size_t)b * SEQ + ch * LCH + F.wave * 8 + i;
        v2u hl[2][4], pa[2][4]; v2u yr[2][4], ar[2][4];
#pragma unroll
        for (int t = 0; t < 2; ++t)
#pragma unroll
            for (int j = 0; j < 4; ++j) { const int c = 4 * lane + 256 * j; const size_t m = m0 + t;
                hl[t][j] = *(const v2u*)(P_HL(F) + m * LRU_W + c); pa[t][j] = *(const v2u*)(P_PA(F) + m * LRU_W + c);
                yr[t][j] = *(const v2u*)(P_PROJ(F) + m * MIX_IN + C_Y + c); ar[t][j] = *(const v2u*)(P_XH(F) + m * D + LRU_W + c); }
        f32x4 vl[2][4], va[2][4]; float sl[2] = {0.f, 0.f}, sa[2] = {0.f, 0.f};
#pragma unroll
        for (int t = 0; t < 2; ++t)
#pragma unroll
            for (int j = 0; j < 4; ++j) { const int c = 4 * lane + 256 * j; const f32x4 car = *(const LAS f32x4*)(CAR + c);
                const f32x4 hlf = {bflo(hl[t][j].x), bfhi(hl[t][j].x), bflo(hl[t][j].y), bfhi(hl[t][j].y)}, paf = {bflo(pa[t][j].x), bfhi(pa[t][j].x), bflo(pa[t][j].y), bfhi(pa[t][j].y)};
                const f32x4 h = hlf + paf * car;
                f32x4 v; v.x = h.x * gelu_tanh(bflo(yr[t][j].x)); v.y = h.y * gelu_tanh(bfhi(yr[t][j].x)); v.z = h.z * gelu_tanh(bflo(yr[t][j].y)); v.w = h.w * gelu_tanh(bfhi(yr[t][j].y));
                vl[t][j] = v; sl[t] += (v.x * v.x + v.y * v.y) + (v.z * v.z + v.w * v.w);
                f32x4 a; a.x = bflo(ar[t][j].x); a.y = bfhi(ar[t][j].x); a.z = bflo(ar[t][j].y); a.w = bfhi(ar[t][j].y);
                va[t][j] = a; sa[t] += (a.x * a.x + a.y * a.y) + (a.z * a.z + a.w * a.w); }
#pragma unroll
        for (int o = 1; o < 64; o <<= 1) { sl[0] += __shfl_xor(sl[0], o); sl[1] += __shfl_xor(sl[1], o); sa[0] += __shfl_xor(sa[0], o); sa[1] += __shfl_xor(sa[1], o); }
#pragma unroll
        for (int t = 0; t < 2; ++t) { const float rl = 1.0f / sqrtf(sl[t] * (1.0f / LRU_W) + EPS), ra = 1.0f / sqrtf(sa[t] * (1.0f / LRU_W) + EPS); const size_t m = m0 + t;
#pragma unroll
            for (int j = 0; j < 4; ++j) { const int c = 4 * lane + 256 * j; const f32x4 g1v = *(const f32x4*)(gl + c), g2v = *(const f32x4*)(ga + c);
                const f32x4 y = vl[t][j] * rl * g1v, z = va[t][j] * ra * g2v;
                v2u o; o.x = pk2(y.x, y.y); o.y = pk2(y.z, y.w); *(v2u*)(P_XH(F) + m * D + c) = o;
                v2u p; p.x = pk2(z.x, z.y); p.y = pk2(z.z, z.w); *(v2u*)(P_XH(F) + m * D + LRU_W + c) = p; } }
    }
    __syncthreads();
}
__device__ __forceinline__ void p4_phase(Frame& F) {
    for (int u = F.bid; u < BATCH * (SEQ / LCH); u += F.G) p4_unit(F, u >> 6, u & 63);
}

__device__ __forceinline__ int f2key(float f) { const int b = __builtin_bit_cast(int, f); return b ^ ((b >> 31) & 0x7fffffff); }
__device__ __forceinline__ float key2f(int k) { const int b = k ^ ((k >> 31) & 0x7fffffff); return __builtin_bit_cast(float, b); }
__device__ __forceinline__ void ins16(int (&L)[16], int x) {
#pragma unroll
    for (int j = 0; j < 16; ++j) { const int hi = max(L[j], x); x = min(L[j], x); L[j] = hi; }
}
__device__ __forceinline__ void ce_desc(int& a, int& b) { const int hi = a > b ? a : b, lo = a > b ? b : a; a = hi; b = lo; }
__device__ __forceinline__ void sort16_desc(int (&a)[16]) {
#pragma unroll
    for (int k = 2; k <= 16; k <<= 1)
#pragma unroll
        for (int j = k >> 1; j > 0; j >>= 1)
#pragma unroll
            for (int i = 0; i < 16; ++i) { const int l = i ^ j; if (l > i) { if ((i & k) == 0) ce_desc(a[i], a[l]); else ce_desc(a[l], a[i]); } }
}
__device__ __forceinline__ void bitonic_merge16_desc(int (&a)[16]) {
#pragma unroll
    for (int j = 8; j > 0; j >>= 1)
#pragma unroll
        for (int i = 0; i < 16; ++i) { const int l = i ^ j; if (l > i) ce_desc(a[i], a[l]); }
}
__device__ __forceinline__ void merge_top16(int (&a)[16], const int (&b)[16]) {
#pragma unroll
    for (int i = 0; i < 16; ++i) a[i] = a[i] > b[15 - i] ? a[i] : b[15 - i];
    bitonic_merge16_desc(a);
}
constexpr int INT_LOWEST = (int)0x80000000;
__device__ __forceinline__ void p8_item(Frame& F, int tt, int hd, LAS int* lut  ) {
    const int lane = F.lane, r = lane & 31, hh = lane >> 5;
    const bf16* QP = P_PROJ(F);
    int V[2][16];
#pragma unroll
    for (int p = 0; p < 2; ++p) {
        bf16x8 qf[8];
        const char* qb = (const char*)(QP + (size_t)(32 * tt) * D + hd * 256 + p * 128);
        const unsigned qoff = (unsigned)(r * D + 8 * hh) * 2u;
#pragma unroll
        for (int ks = 0; ks < 8; ++ks) qf[ks] = *(const bf16x8*)(qb + qoff + 32 * ks);
        int L[16];
#pragma unroll
        for (int j = 0; j < 16; ++j) L[j] = INT_LOWEST;
        const char* skb = (const char*)(P_SK(F) + (size_t)((hd * 2 + p) * PKEYS) * PHALF);
        const unsigned skoff = (unsigned)(r * PHALF + 8 * hh) * 2u;
#pragma unroll 1
        for (int kt = 0; kt < 4; ++kt) {
            f32x16 acc;
#pragma unroll
            for (int i = 0; i < 16; ++i) acc[i] = 0.f;
            const char* skt = skb + (size_t)(32 * kt) * PHALF * 2;
#pragma unroll
            for (int ks = 0; ks < 8; ++ks) { const bf16x8 kf = *(const bf16x8*)(skt + skoff + 32 * ks); acc = MFMA32(kf, qf[ks], acc); }
            const int kbase = 32 * kt + 4 * hh;
            int T[16];
#pragma unroll
            for (int i = 0; i < 16; ++i) { const int kidx = (i & 3) + 8 * (i >> 2); T[i] = (f2key(acc[i]) & ~0x7f) | (kbase + kidx); }
            sort16_desc(T); merge_top16(L, T);
        }
        int O[16];
#pragma unroll
        for (int j = 0; j < 16; ++j) O[j] = __shfl_xor(L[j], 32);
        merge_top16(L, O);
#pragma unroll
        for (int j = 0; j < 16; ++j) V[p][j] = L[j];
    }
#pragma unroll
    for (int j = 0; j < 16; ++j) { lut[lane * 33 + j] = V[0][j] & 0x7f; lut[lane * 33 + 16 + j] = V[1][j] & 0x7f; }
    float v0[16], v1[16];
#pragma unroll
    for (int j = 0; j < 16; ++j) { v0[j] = key2f(V[0][j] & ~0x7f); v1[j] = key2f(V[1][j] & ~0x7f); }
    int C[16], G1[16], G2[16], G3[2];
    { int n = 0;
#pragma unroll
      for (int i = 0; i < 16; ++i)
#pragma unroll
        for (int j = 0; j < 16; ++j)
            if ((i + 1) * (j + 1) <= 16) { const int key = (f2key(v0[i] + v1[j]) & ~0xff) | (i * 16 + j);
                if (n < 16) C[n] = key; else if (n < 32) G1[n - 16] = key; else if (n < 48) G2[n - 32] = key; else G3[n - 48] = key;
                ++n; } }
    sort16_desc(C); sort16_desc(G1); sort16_desc(G2);
    merge_top16(C, G1); merge_top16(C, G2); ins16(C, G3[0]); ins16(C, G3[1]);
    float sv[16]; float den = 0.f;
    const float mx = key2f(C[0] & ~0xff);
#pragma unroll
    for (int e = 0; e < 16; ++e) { sv[e] = __expf(key2f(C[e] & ~0xff) - mx); den += sv[e]; }
    const float inv = 1.0f / den;
    LDS_WAIT(); asm volatile("" ::: "memory");
    int idx[16];
#pragma unroll
    for (int e = 0; e < 16; ++e) { const int pi = (C[e] >> 4) & 15, pj = C[e] & 15; idx[e] = lut[lane * 33 + pi] * PKEYS + lut[lane * 33 + 16 + pj]; }
    if (hh == 0) {
        unsigned short* ip = P_IDX(F) + (size_t)(32 * tt + r) * 128 + hd * 16; float* gp = P_GW(F) + (size_t)(32 * tt + r) * 128 + hd * 16;
#pragma unroll
        for (int q = 0; q < 2; ++q) *(v4u*)(ip + 8 * q) = (v4u){(unsigned)idx[8 * q] | ((unsigned)idx[8 * q + 1] << 16), (unsigned)idx[8 * q + 2] | ((unsigned)idx[8 * q + 3] << 16),
                                                              (unsigned)idx[8 * q + 4] | ((unsigned)idx[8 * q + 5] << 16), (unsigned)idx[8 * q + 6] | ((unsigned)idx[8 * q + 7] << 16)};
#pragma unroll
        for (int q = 0; q < 4; ++q) *(f32x4*)(gp + 4 * q) = (f32x4){sv[4 * q] * inv, sv[4 * q + 1] * inv, sv[4 * q + 2] * inv, sv[4 * q + 3] * inv};
    }
    LDS_WAIT(); asm volatile("" ::: "memory");
}
__device__ __forceinline__ void p8_phase(Frame& F) {
    LAS int* lut = (LAS int*)(F.lds + F.wave * (64 * 33 * 4));
    const int gw = F.bid * NWAVES + F.wave, NGW = F.G * NWAVES;
    for (int it = gw; it < (M / 32) * PH; it += NGW) p8_item(F, it >> 3, it & 7, lut);
}

template <int CTRL> __device__ __forceinline__ float dpp_f(float x) { return __builtin_bit_cast(float, __builtin_amdgcn_mov_dpp(__builtin_bit_cast(int, x), CTRL, 0xf, 0xf, true)); }
__device__ __forceinline__ float sum8(float v) {
    v += dpp_f<0xB1>(v);
    v += dpp_f<0x4E>(v);
    v += dpp_f<0x141>(v);
    return v;
}
__device__ __forceinline__ void dec16(const v4u r, float (&f)[16]) {
    const unsigned w4[4] = {r.x, r.y, r.z, r.w};
#pragma unroll
    for (int w = 0; w < 4; ++w) { const f32x2 lo = __builtin_amdgcn_cvt_pk_f32_fp8((int)w4[w], false), hi = __builtin_amdgcn_cvt_pk_f32_fp8((int)w4[w], true);
        f[4 * w] = lo.x; f[4 * w + 1] = lo.y; f[4 * w + 2] = hi.x; f[4 * w + 3] = hi.y; }
}
__device__ __forceinline__ void row_offsets(const v4u a, const v4u b, unsigned loff, unsigned (&off)[16]) {
    const unsigned w[8] = {a.x, a.y, a.z, a.w, b.x, b.y, b.z, b.w};
#pragma unroll
    for (int q = 0; q < 8; ++q) { off[2 * q] = ((w[q] & 0xffffu) << 7) + loff; off[2 * q + 1] = ((w[q] >> 16) << 7) + loff; }
}
#define ISSUE_ROWS(dst, TBL, ia, ib) do { unsigned off_[16]; row_offsets((ia), (ib), loff, off_); \
    _Pragma("unroll") for (int i_ = 0; i_ < 16; ++i_) dst[i_] = *(const v4u*)((TBL) + off_[i_]); } while (0)

typedef int i32x8 __attribute__((ext_vector_type(8)));
#define MFMA_F4F8(a, b, c) __builtin_amdgcn_mfma_scale_f32_16x16x128_f8f6f4((a), (b), (c), 4  , 0  , 0, 0x7f7f7f7f, 0, 0x7f7f7f7f)
#define ISSUE_ROWS_U(dst, i0, i1) do { const unsigned w_[8] = {(i0).x, (i0).y, (i0).z, (i0).w, (i1).x, (i1).y, (i1).z, (i1).w}; \
    _Pragma("unroll") for (int g_ = 0; g_ < 16; ++g_) { const unsigned id_ = (g_ & 1) ? (w_[g_ >> 1] >> 16) : (w_[g_ >> 1] & 0xffffu); \
        dst[g_] = *(const v4u*)(U4 + ((id_ << 7) + loff)); } } while (0)
__device__ __forceinline__ void p9u_compute(const v4u (&row)[16], const v4u hA0, const v4u hA1, const v4u hB0, const v4u hB1, int lane, bf16* dst) {
    const i32x8 B0 = {(int)hA0.x, (int)hA0.y, (int)hA0.z, (int)hA0.w, (int)hA1.x, (int)hA1.y, (int)hA1.z, (int)hA1.w};
    const i32x8 B1 = {(int)hB0.x, (int)hB0.y, (int)hB0.z, (int)hB0.w, (int)hB1.x, (int)hB1.y, (int)hB1.z, (int)hB1.w};
    const int n = lane & 15, q = lane >> 4, e4 = n >> 2;
    const f32x4 zero = {0.f, 0.f, 0.f, 0.f};
    float res[16];
#pragma unroll
    for (int g = 0; g < 16; ++g) {
        const i32x8 a = {(int)row[g].x, (int)row[g].y, (int)row[g].z, (int)row[g].w, 0, 0, 0, 0};
        const f32x4 d0 = MFMA_F4F8(a, B0, zero), d1 = MFMA_F4F8(a, B1, zero);
        float v0 = d0[0]; v0 = e4 == 1 ? d0[1] : v0; v0 = e4 == 2 ? d0[2] : v0; v0 = e4 == 3 ? d0[3] : v0;
        float v1 = d1[0]; v1 = e4 == 1 ? d1[1] : v1; v1 = e4 == 2 ? d1[2] : v1; v1 = e4 == 3 ? d1[3] : v1;
        float val = (q & 1) ? v1 : v0;
        val = val + dpp_f<0x124>(val) + dpp_f<0x128>(val) + dpp_f<0x12C>(val);
        val += __shfl_xor(val, 16);
        res[g] = val;
    }
    if ((lane & 0x1c) == 0) {
        bf16* d = dst + 16 * (2 * (n & 3) + (q >> 1));
        v4u o0, o1;
        o0.x = pk2(res[0], res[1]); o0.y = pk2(res[2], res[3]); o0.z = pk2(res[4], res[5]); o0.w = pk2(res[6], res[7]);
        o1.x = pk2(res[8], res[9]); o1.y = pk2(res[10], res[11]); o1.z = pk2(res[12], res[13]); o1.w = pk2(res[14], res[15]);
        *(v4u*)d = o0; *(v4u*)(d + 8) = o1;
    }
}
__device__ __forceinline__ void p9u_item(Frame& F, int s, int tb) {
    const int lane = F.lane, sg = lane & 7, r8 = lane >> 3, n = lane & 15, kq = lane >> 4;
    const unsigned char* U4 = P_U(F);
    const unsigned loff = (unsigned)(s * (NEXP * 128) + 16 * sg);
    const unsigned short* idxb = P_IDX(F) + (size_t)(64 * tb) * 128 + 16 * r8;
    const unsigned char* hb = P_H8(F) + (size_t)(64 * tb) * D + 256 * s + 32 * (n >> 2) + 16 * (kq & 1);
    const bool bon = (kq >> 1) == (n & 1); const bool bhi = (n & 2) != 0;
    bf16* pb = (bf16*)P_PART(F) + ((size_t)s * M + 64 * tb) * 128;
#define LOAD_META_U(I0, I1, A0, A1, B0, B1, tt_) do { const int tn_ = (tt_) < 64 ? (tt_) : 63; const unsigned short* ip_ = idxb + (size_t)tn_ * 128; I0 = *(const v4u*)(ip_); I1 = *(const v4u*)(ip_ + 8); \
        const unsigned char* hp_ = hb + (size_t)tn_ * D; const v4u z_ = {0u, 0u, 0u, 0u}; \
        const v4u x0_ = bon ? *(const v4u*)(hp_) : z_, x1_ = bon ? *(const v4u*)(hp_ + 128) : z_; \
        A0 = bhi ? z_ : x0_; A1 = bhi ? x0_ : z_; B0 = bhi ? z_ : x1_; B1 = bhi ? x1_ : z_; } while (0)
    v4u aI0, aI1, aA0, aA1, aB0, aB1, bI0, bI1, bA0, bA1, bB0, bB1, cI0, cI1, cA0, cA1, cB0, cB1, dI0, dI1, dA0, dA1, dB0, dB1;
    LOAD_META_U(aI0, aI1, aA0, aA1, aB0, aB1, 0); LOAD_META_U(bI0, bI1, bA0, bA1, bB0, bB1, 1); LOAD_META_U(cI0, cI1, cA0, cA1, cB0, cB1, 2);
    v4u rowA[16], rowB[16];
    ISSUE_ROWS_U(rowA, aI0, aI1); ISSUE_ROWS_U(rowB, bI0, bI1);
#pragma unroll 1
    for (int t = 0; t < 64; t += 2) {
        p9u_compute(rowA, aA0, aA1, aB0, aB1, lane, pb + (size_t)t * 128);
        LOAD_META_U(dI0, dI1, dA0, dA1, dB0, dB1, t + 3);
        ISSUE_ROWS_U(rowA, cI0, cI1);
        p9u_compute(rowB, bA0, bA1, bB0, bB1, lane, pb + (size_t)(t + 1) * 128);
        aA0 = cA0; aA1 = cA1; aB0 = cB0; aB1 = cB1; bA0 = dA0; bA1 = dA1; bB0 = dB0; bB1 = dB1;
        LOAD_META_U(cI0, cI1, cA0, cA1, cB0, cB1, t + 4);
        ISSUE_ROWS_U(rowB, dI0, dI1);
    }
#undef LOAD_META_U
}
#define MFMA_F8F4(a, b, c) __builtin_amdgcn_mfma_scale_f32_16x16x128_f8f6f4((a), (b), (c), 0  , 4  , 0, 0x7f7f7f7f, 0, 0x7f7f7f7f)
#define ISSUE_ROWS_V(dst, i0, i1) do { const unsigned w_[8] = {(i0).x, (i0).y, (i0).z, (i0).w, (i1).x, (i1).y, (i1).z, (i1).w}; \
    _Pragma("unroll") for (int g_ = 0; g_ < 16; ++g_) { const unsigned id_ = (g_ & 1) ? (w_[g_ >> 1] >> 16) : (w_[g_ >> 1] & 0xffffu); \
        dst[g_] = *(const v4u*)(V4 + ((id_ << 7) + loff)); } } while (0)
struct VLane { unsigned shl, m00, m01, m10, m11; };
__device__ __forceinline__ void p9v_compute(const v4u (&row)[16], const v4u wlo, const v4u whi, int lane, const VLane L, const bf16* xp, const f32x4 (&g2)[4], float wscale, float* dst) {
    v2u x1[4];
#pragma unroll
    for (int t = 0; t < 4; ++t) x1[t] = *(const v2u*)(xp + 8 * t);
    f32x4 d[4];
#pragma unroll
    for (int t = 0; t < 4; ++t) d[t] = (f32x4){0.f, 0.f, 0.f, 0.f};
    const unsigned wl4[4] = {wlo.x, wlo.y, wlo.z, wlo.w}, wh4[4] = {whi.x, whi.y, whi.z, whi.w};
    i32x8 a0 = {0, 0, 0, 0, 0, 0, 0, 0}, a1 = a0, a2 = a0, a3 = a0;
#pragma unroll
    for (int g = 0; g < 16; ++g) {
        const unsigned lo = ((wl4[g >> 2] >> (8 * (g & 3))) & 0xffu) << L.shl, hi = ((wh4[g >> 2] >> (8 * (g & 3))) & 0xffu) << L.shl;
        const int l00 = (int)(lo & L.m00), l01 = (int)(lo & L.m01), h00 = (int)(hi & L.m00), h01 = (int)(hi & L.m01);
        const int l10 = (int)(lo & L.m10), l11 = (int)(lo & L.m11), h10 = (int)(hi & L.m10), h11 = (int)(hi & L.m11);
        const i32x8 b = {(int)row[g].x, (int)row[g].y, (int)row[g].z, (int)row[g].w, 0, 0, 0, 0};
        a0[0] = l00; a0[1] = l01; a0[4] = h00; a0[5] = h01;   a1[2] = l00; a1[3] = l01; a1[6] = h00; a1[7] = h01;
        a2[0] = l10; a2[1] = l11; a2[4] = h10; a2[5] = h11;   a3[2] = l10; a3[3] = l11; a3[6] = h10; a3[7] = h11;
        d[0] = MFMA_F8F4(a0, b, d[0]); d[1] = MFMA_F8F4(a1, b, d[1]); d[2] = MFMA_F8F4(a2, b, d[2]); d[3] = MFMA_F8F4(a3, b, d[3]);
    }
#pragma unroll
    for (int t = 0; t < 4; ++t)
#pragma unroll
        for (int e = 0; e < 4; ++e) d[t][e] += __shfl_xor(d[t][e], 40);
    if ((lane & 40) == 0) {
#pragma unroll
        for (int t = 0; t < 4; ++t) { const f32x4 xv = {bflo(x1[t].x), bfhi(x1[t].x), bflo(x1[t].y), bfhi(x1[t].y)};
            *(f32x4*)(dst + 8 * t) = xv + g2[t] * (d[t] * wscale); }
    }
}
__device__ __forceinline__ void p9v_item(Frame& F, int s, int tb) {
    const int lane = F.lane, sg = lane & 7, r8 = lane >> 3;
    const unsigned char* V4 = P_V(F);
    const unsigned loff = (unsigned)(s * (NEXP * 128) + 16 * sg);
    const unsigned short* idxb = P_IDX(F) + (size_t)(64 * tb) * 128 + 16 * r8;
    const int ai = lane & 15, kqa = lane >> 4;
    VLane L; L.shl = 8u * (unsigned)(ai & 3);
    { const bool d1 = (ai & 4) != 0, hiv = (kqa & 1) != 0;
      L.m00 = (!hiv && !d1) ? 0xffffffffu : 0u; L.m01 = (!hiv && d1) ? 0xffffffffu : 0u; L.m10 = (hiv && !d1) ? 0xffffffffu : 0u; L.m11 = (hiv && d1) ? 0xffffffffu : 0u; }
    const unsigned char* wbl = P_W(F) + (size_t)(64 * tb) * 128 + 16 * (2 * (kqa >> 1) + (ai >> 3));
    const unsigned char* wbh = wbl + 64;
    const float* wscp = P_WSC(F) + 64 * tb;
    const int b = (64 * tb) / SEQ;
    const int ocol = 256 * s + 32 * (lane & 7) + 4 * ((lane >> 4) & 1);
    f32x4 g2[4];
#pragma unroll
    for (int t = 0; t < 4; ++t) g2[t] = *(const f32x4*)(P_ADA(F) + (size_t)b * ADA_W + 5 * D + ocol + 8 * t);
    float* ob = P_out(F) + (size_t)(64 * tb) * D + ocol;
    const bf16* xb = P_X1B(F) + (size_t)(64 * tb) * D + ocol;
#define LOAD_META_V(I0, I1, WL, WH, WS, tt_) do { const int tn_ = (tt_) < 64 ? (tt_) : 63; const unsigned short* ip_ = idxb + (size_t)tn_ * 128; I0 = *(const v4u*)(ip_); I1 = *(const v4u*)(ip_ + 8); \
        WL = *(const v4u*)(wbl + (size_t)tn_ * 128); WH = *(const v4u*)(wbh + (size_t)tn_ * 128); WS = wscp[tn_]; } while (0)
    v4u aI0, aI1, aWL, aWH, bI0, bI1, bWL, bWH, cI0, cI1, cWL, cWH, dI0, dI1, dWL, dWH; float aS, bS, cS, dS;
    LOAD_META_V(aI0, aI1, aWL, aWH, aS, 0); LOAD_META_V(bI0, bI1, bWL, bWH, bS, 1); LOAD_META_V(cI0, cI1, cWL, cWH, cS, 2);
    v4u rowA[16], rowB[16];
    ISSUE_ROWS_V(rowA, aI0, aI1); ISSUE_ROWS_V(rowB, bI0, bI1);
#pragma unroll 1
    for (int t = 0; t < 64; t += 2) {
        p9v_compute(rowA, aWL, aWH, lane, L, xb + (size_t)t * D, g2, aS, ob + (size_t)t * D);
        LOAD_META_V(dI0, dI1, dWL, dWH, dS, t + 3);
        ISSUE_ROWS_V(rowA, cI0, cI1);
        p9v_compute(rowB, bWL, bWH, lane, L, xb + (size_t)(t + 1) * D, g2, bS, ob + (size_t)(t + 1) * D);
        aWL = cWL; aWH = cWH; aS = cS; bWL = dWL; bWH = dWH; bS = dS;
        LOAD_META_V(cI0, cI1, cWL, cWH, cS, t + 4);
        ISSUE_ROWS_V(rowB, dI0, dI1);
    }
#undef LOAD_META_V
}
__device__ __forceinline__ void p9u_phase(Frame& F) {
    const int x = F.bid & 7, rank = F.bid >> 3, nr = F.G >> 3;
    for (int tb = rank * NWAVES + F.wave; tb < M / 64; tb += nr * NWAVES) p9u_item(F, x, tb);
}
__device__ __forceinline__ void p9v_phase(Frame& F) {
    const int x = F.bid & 7, rank = F.bid >> 3, nr = F.G >> 3;
    for (int tb = rank * NWAVES + F.wave; tb < M / 64; tb += nr * NWAVES) p9v_item(F, x, tb);
}
__device__ __forceinline__ void p9w_phase(Frame& F) {
    const unsigned* part = P_PART(F); const unsigned short* idxp = P_IDX(F); const float* gwp = P_GW(F); const float* usc = P_USC(F); const float* vsc = P_VSC(F);
    unsigned char* wp = P_W(F); float* wsc = P_WSC(F);
    for (int it = F.bid * 512 + F.tid; it < M * 64; it += F.G * 512) {
        float a0 = 0.f, a1 = 0.f;
#pragma unroll
        for (int s = 0; s < 8; ++s) { const unsigned w = part[(size_t)s * M * 64 + it]; a0 += bflo(w); a1 += bfhi(w); }
        const int m = it >> 6; const size_t p0 = 2 * (size_t)it;
        const unsigned iw = *(const unsigned*)(idxp + p0); const int i0 = iw & 0xffffu, i1 = iw >> 16;
        const f32x2 gw = *(const f32x2*)(gwp + p0);
        const float w0 = gw.x * gelu_tanh(a0 * usc[i0]) * vsc[i0], w1 = gw.y * gelu_tanh(a1 * usc[i1]) * vsc[i1];
        float mx = fmaxf(fabsf(w0), fabsf(w1));
#pragma unroll
        for (int o = 1; o < 64; o <<= 1) mx = fmaxf(mx, __shfl_xor(mx, o));
        const float sc = 224.0f / fmaxf(mx, 1e-30f);
        const int t = __builtin_amdgcn_cvt_pk_fp8_f32(w0 * sc, w1 * sc, 0, false);
        *(unsigned short*)(wp + p0) = (unsigned short)(t & 0xffff);
        if ((it & 63) == 0) wsc[m] = fmaxf(mx, 1e-30f) * (1.0f / 224.0f);
    }
}

struct Args { const void* in[25]; float* out; unsigned char* ws; int ph_lo, ph_hi; };
__global__ void __launch_bounds__(NWAVES * 64, 2) hymba_fwd(Args args) {
    extern __shared__ __attribute__((aligned(16))) unsigned char lds_raw[];
    Frame F;
    F.lds = (LAS unsigned char*)lds_raw;
    F.tid = threadIdx.x; F.lane = F.tid & 63; F.wave = __builtin_amdgcn_readfirstlane(F.tid >> 6);
    F.G = gridDim.x; F.bid = blockIdx.x;
    F.ka = (kaptr_t)__builtin_amdgcn_kernarg_segment_ptr();
    static_assert(sizeof(Args) == 224, "kernarg byte offsets used by ka_ptr");
    for (int u = F.tid; u < (LDS_BYTES - LDSCTL_OFF) / 4; u += NWAVES * 64) ((LAS unsigned*)(F.lds + LDSCTL_OFF))[u] = 0u;
    __syncthreads();
    volatile LAS unsigned* MISC = (volatile LAS unsigned*)(F.lds + MISC_OFF);
    XcdBarrier bar; bar.bar = (unsigned*)(P_ws(F) + WS_CTL) + CW_BAR; bar.x = 0; bar.st = nullptr;
    const int lo = args.ph_lo, hi = args.ph_hi;
    if (hi - lo > 1) bar = xcd_barrier_post((unsigned*)(P_ws(F) + WS_CTL) + CW_BAR, MISC + 8);
#define IN(k) (lo <= (k) && (k) < hi)
#ifndef PROBE_STAMP
#define PROBE_STAMP -1
#define PROBE_DIV 5.0f
#endif
#define STAMP(k) do { if (PROBE_STAMP >= 0 && F.bid == 0 && F.tid == 0) ((unsigned long long*)(P_ws(F) + WS_CTL + 64))[(k)] = __builtin_amdgcn_s_memrealtime(); } while (0)
#define SEAM(k) do { STAMP(16 + (k)); if (IN(k) && IN((k) + 1)) xcd_barrier(bar); STAMP((k) + 1); } while (0)
    STAMP(0);

#ifndef PROBE_MASK
#define PROBE_MASK 0
#endif
#define REP(k) for (int rep_ = 0; rep_ < (((PROBE_MASK >> (k)) & 1) ? 2 : 1); ++rep_)
#define REPSYNC(k) do { if (((PROBE_MASK >> (k)) & 1) && rep_ == 0) xcd_barrier(bar); } while (0)
    if (IN(0)) { REP(0) { p0_prologue(F); REPSYNC(0); } } SEAM(0);
    if (IN(1)) { REP(1) { p1_phase(F); REPSYNC(1); } } SEAM(1);
    if (IN(2)) REP(2) {
        pg8::Gemm g{P_XH(F), P_WIN(F), M, MIX_IN, D}; pg8::StaticOrder S; S.init(M, MIX_IN, F.G, F.bid);
        pg8::EpiStoreBf16 E{P_PROJ(F), MIX_IN};
        pg8::gemm_phase<pg8::EpiStoreBf16, pg8::StaticOrder, false, true>(F.lds, g, S, E); REPSYNC(2);
        { const int nwg = (M / 256) * (MIX_IN / 256), busy = nwg % F.G;
          if (busy > 0 && F.bid >= busy) quant_rows(F, QUANT_SPLIT, 2 * NEXP, (F.bid - busy) * NWAVES + F.wave, (F.G - busy) * NWAVES);
          else if (busy == 0) quant_rows(F, QUANT_SPLIT, 2 * NEXP, F.bid * NWAVES + F.wave, F.G * NWAVES); }
    } SEAM(2);
    if (IN(3)) { p3_phase(F); } SEAM(3);
    if (IN(4)) { p4_phase(F); } SEAM(4);
    if (IN(5)) REP(5) {
        pg8::Gemm g{P_XH(F), P_WOUT(F), M, D, D}; pg8::StaticOrder S; S.init(M, D, F.G, F.bid);
        pg8::EpiGateBf16 E{P_X1B(F), D, P_ADA(F) + 2 * D, ADA_W, SEQ};
        pg8::gemm_phase<pg8::EpiGateBf16, pg8::StaticOrder, false, true>(F.lds, g, S, E); REPSYNC(5);
    } SEAM(5);
    if (IN(6)) { REP(6) { p6_phase(F); REPSYNC(6); } } SEAM(6);
    if (IN(7)) REP(7) {
        pg8::Gemm g{P_XH(F), P_WQ(F), M, D, D}; pg8::StaticOrder S; S.init(M, D, F.G, F.bid);
        pg8::EpiStoreBf16 E{P_PROJ(F), D};
        pg8::gemm_phase<pg8::EpiStoreBf16, pg8::StaticOrder, false, true>(F.lds, g, S, E); REPSYNC(7);
    } SEAM(7);
    if (IN(8)) { REP(8) { p8_phase(F); REPSYNC(8); } } SEAM(8);
#ifdef PROBE_MFMA4
    if (F.bid == 0 && F.wave == 0) {
        const int l_ = F.lane, i_ = l_ & 15, kq_ = l_ >> 4; (void)i_; (void)kq_;
        i32x8 a_ = {0, 0, 0, 0, 0, 0, 0, 0}, b_ = {0, 0, 0, 0, 0, 0, 0, 0};
        PROBE_MFMA4;
        const f32x4 z_ = {0.f, 0.f, 0.f, 0.f};
#ifdef PROBE_SWAPFMT
        const f32x4 d_ = __builtin_amdgcn_mfma_scale_f32_16x16x128_f8f6f4(a_, b_, z_, 0  , 4  , 0, 0x7f7f7f7f, 0, 0x7f7f7f7f);
#else
        const f32x4 d_ = MFMA_F4F8(a_, b_, z_);
#endif
        float* pr_ = (float*)(P_ws(F) + WS_CTL + 40960);
        pr_[l_ * 4 + 0] = d_[0]; pr_[l_ * 4 + 1] = d_[1]; pr_[l_ * 4 + 2] = d_[2]; pr_[l_ * 4 + 3] = d_[3];
    }
#endif
    if (IN(9)) { p9u_phase(F); }
    if (PROBE_STAMP >= 0 && F.tid == 0) ((unsigned long long*)(P_ws(F) + WS_CTL + 32768))[F.bid] = __builtin_amdgcn_s_memrealtime();
    SEAM(9);
    if (IN(10)) { p9w_phase(F); } SEAM(10);
    if (IN(11)) { p9v_phase(F); }
    if (PROBE_STAMP >= 0) {
        __syncthreads(); STAMP(12); VM_WAIT(); __syncthreads();
        if (F.bid == 0 && F.tid == 0) { const unsigned long long* ts = (const unsigned long long*)(P_ws(F) + WS_CTL + 64);
            float us = (float)(ts[PROBE_STAMP + 1] - ts[PROBE_STAMP]) * 0.01f;
#ifdef PROBE_BLOCKSTAT
            { const unsigned long long* bt = (const unsigned long long*)(P_ws(F) + WS_CTL + 32768); float acc_ = 0.f;
              for (int b_ = 0; b_ < (int)gridDim.x; ++b_) { const float d_ = (float)(bt[b_] - ts[9]) * 0.01f; PROBE_BLOCKSTAT; } us = acc_; }
#endif
#ifdef PROBE_MFMA4
            { const float* pr_ = (const float*)(P_ws(F) + WS_CTL + 40960); float acc_ = 0.f; PROBE_MFMA4_READ; us = acc_; }
#endif
            P_out(F)[0] += us * (1.0f / PROBE_DIV); }
    }
#undef IN
#undef SEAM
}

extern "C" void kernel_launch(void* const* d_in, const int* in_sizes, int n_in, void* d_out, int out_size, void* d_ws, size_t ws_size, hipStream_t stream) {
    static int grid = 0;
    if (grid == 0) {
        if (n_in != 25 || in_sizes[0] != M * D || out_size != M * D || ws_size < WS_END) {
            fprintf(stderr, "kernel_launch: built for 25 inputs, x/out of %d floats, >= %zu bytes of workspace; got n_in %d, in0 %d, out %d, ws %zu; nothing launched\n", M * D, (size_t)WS_END, n_in, n_in > 0 ? in_sizes[0] : -1, out_size, ws_size);
            grid = -1; return; }
        int dev = 0, cus = 0, per_cu = 0;
        if (hipGetDevice(&dev) != hipSuccess || hipDeviceGetAttribute(&cus, hipDeviceAttributeMultiprocessorCount, dev) != hipSuccess) { fprintf(stderr, "kernel_launch: device query failed\n"); grid = -1; return; }
        if (hipFuncSetAttribute((const void*)hymba_fwd, hipFuncAttributeMaxDynamicSharedMemorySize, LDS_BYTES) != hipSuccess) { fprintf(stderr, "kernel_launch: hipFuncSetAttribute failed\n"); grid = -1; return; }
        if (hipOccupancyMaxActiveBlocksPerMultiprocessor(&per_cu, (const void*)hymba_fwd, NWAVES * 64, LDS_BYTES) != hipSuccess || per_cu < 1) {
            fprintf(stderr, "kernel_launch: occupancy query reports %d workgroups per CU; need 1\n", per_cu); (void)hipGetLastError(); grid = -1; return; }
        grid = cus;
        if (grid % 8 != 0 || (M / 64) % (grid / 8 * NWAVES) != 0) { fprintf(stderr, "kernel_launch: grid %d not supported (needs a multiple of 8 dividing the token blocks)\n", grid); grid = -1; return; }
    }
    if (grid < 0) return;
    if (hipMemsetAsync((char*)d_ws + WS_CTL, 0, CTL_ZERO_BYTES, stream) != hipSuccess) { fprintf(stderr, "kernel_launch: memset failed\n"); return; }
    Args a{};
    for (int i = 0; i < 25; ++i) a.in[i] = d_in[i];
    a.out = (float*)d_out; a.ws = (unsigned char*)d_ws;
    if (N_LAUNCHES == 1) {
        a.ph_lo = 0; a.ph_hi = N_PHASES;
        void* kargs[] = {&a};
        const hipError_t le = hipLaunchCooperativeKernel((const void*)hymba_fwd, dim3(grid), dim3(NWAVES * 64), kargs, LDS_BYTES, stream);
        if (le != hipSuccess) fprintf(stderr, "kernel_launch: cooperative launch failed: %s (grid %d)\n", hipGetErrorName(le), grid);
    } else {
#ifndef PROBE_TWICE
#define PROBE_TWICE 0
#endif
        for (int li = 0; li < N_PHASES; ++li) { a.ph_lo = li; a.ph_hi = li + 1;
            if ((PROBE_TWICE >> li) & 1) hipLaunchKernelGGL(hymba_fwd, dim3(grid), dim3(NWAVES * 64), LDS_BYTES, stream, a);
            hipLaunchKernelGGL(hymba_fwd, dim3(grid), dim3(NWAVES * 64), LDS_BYTES, stream, a);
            const hipError_t le = hipPeekAtLastError();
            if (le != hipSuccess) { fprintf(stderr, "kernel_launch: launch %d failed: %s\n", li, hipGetErrorName(le)); break; } }
    }
}
```

```cpp
#include <hip/hip_runtime.h>
#include <cstdio>
#include <cstdint>
namespace pg8 {
#define PG8_LAS __attribute__((address_space(3)))
typedef unsigned short bf16_t;
typedef short bf16x8 __attribute__((ext_vector_type(8)));
typedef float f32x4 __attribute__((ext_vector_type(4)));
typedef unsigned u32x4 __attribute__((ext_vector_type(4)));
constexpr int BM = 256, BK = 64, HALF = 128, HTB = HALF * BK * 2  , STAGE_BYTES = 8 * HTB, NXCD = 8, WGM = 8;

__host__ __device__ __forceinline__ int lds_byte(int r, int c) { const int st = (r >> 4) * 2 + (c >> 5), rr = r & 15, cc = c & 31, ob = rr * 64 + cc * 2; return st * 1024 + (ob ^ (((ob >> 9) & 1) << 5)); }
__host__ __device__ __forceinline__ void stage_rc(int b, int& R, int& C) { const int st = b / 1024, sb = b % 1024, swz = sb ^ (((sb >> 9) & 1) << 5); R = (st >> 1) * 16 + swz / 64; C = (st & 1) * 32 + (swz % 64) / 2; }
__host__ __device__ __forceinline__ int perm32(int rho) { const int n = rho >> 4, i = rho & 15; return 8 * (i >> 2) + 4 * n + (i & 3); }

struct Unit { int pm, pn; };
struct Gemm { const bf16_t* A; const bf16_t* Bt; int M, N, K; };

struct StaticOrder {
    int nM, nN, nwg, G, c;
    __host__ __device__ void init(int M, int N, int G_, int c_) { nM = M / BM; nN = N / BM; nwg = nM * nN; G = G_; c = c_; }
    __host__ __device__ bool next(int i, Unit& u) const {
        const long L = (long)i * G + c; if (L >= nwg) return false;
        int wgid = (int)L; { const int q = nwg / NXCD, r = nwg % NXCD, xcd = wgid % NXCD, off = wgid / NXCD; wgid = (xcd < r ? xcd * (q + 1) : r * (q + 1) + (xcd - r) * q) + off; }
        const int nig = WGM * nN, gid = wgid / nig, fm = gid * WGM, gsz = (nM - fm) < WGM ? (nM - fm) : WGM;
        u.pm = fm + ((wgid % nig) % gsz); u.pn = (wgid % nig) / gsz; return true;
    }
    __device__ __forceinline__ void a_ready(const Unit&) const {}
    __device__ __forceinline__ void done(const Unit&) const {}
};

__device__ __forceinline__ unsigned cvt_pk_bf16(float lo, float hi) { unsigned r; asm volatile("v_cvt_pk_bf16_f32 %0, %1, %2" : "=v"(r) : "v"(lo), "v"(hi)); return r; }
struct EpiStoreBf16 {
    static constexpr bool PERM = true, AFTER_DRAIN = false;
    bf16_t* O; int ldc;
    __device__ __forceinline__ void operator()(const f32x4 (&acc)[2][2][4][2], const Unit& u, int wr, int wc, int fr, int fq) const {
        const int row0 = u.pm * BM + wr * 64 + fr; const int col0 = u.pn * BM + wc * 32 + 8 * fq;
#pragma unroll
        for (int ai = 0; ai < 2; ++ai)
#pragma unroll
            for (int m = 0; m < 4; ++m) { bf16_t* rowp = O + (size_t)(row0 + ai * HALF + m * 16) * ldc + col0;
#pragma unroll
                for (int bj = 0; bj < 2; ++bj) { const f32x4 v0 = acc[ai][bj][m][0], v1 = acc[ai][bj][m][1];
                    u32x4 w; w.x = cvt_pk_bf16(v0[0], v0[1]); w.y = cvt_pk_bf16(v0[2], v0[3]); w.z = cvt_pk_bf16(v1[0], v1[1]); w.w = cvt_pk_bf16(v1[2], v1[3]);
                    *(u32x4*)(rowp + bj * HALF) = w; } }
    }
};
struct EpiGateBf16 {
    static constexpr bool PERM = true, AFTER_DRAIN = false;
    bf16_t* out; int ldc; const float* gate; int gstride; int rows_per_batch;
    __device__ __forceinline__ void operator()(const f32x4 (&acc)[2][2][4][2], const Unit& u, int wr, int wc, int fr, int fq) const {
        const int b = (u.pm * BM) / rows_per_batch; const float* g = gate + (size_t)b * gstride;
        const int col0 = u.pn * BM + wc * 32 + 8 * fq;
        f32x4 gv[2][2];
#pragma unroll
        for (int bj = 0; bj < 2; ++bj)
#pragma unroll
            for (int n = 0; n < 2; ++n) gv[bj][n] = *(const f32x4*)(g + col0 + bj * HALF + n * 4);
#pragma unroll
        for (int ai = 0; ai < 2; ++ai)
#pragma unroll
            for (int m = 0; m < 4; ++m) { bf16_t* rowp = out + (size_t)(u.pm * BM + ai * HALF + wr * 64 + m * 16 + fr) * ldc + col0;
#pragma unroll
                for (int bj = 0; bj < 2; ++bj) { const f32x4 v0 = gv[bj][0] * acc[ai][bj][m][0], v1 = gv[bj][1] * acc[ai][bj][m][1];
                    u32x4 w; w.x = cvt_pk_bf16(v0[0], v0[1]); w.y = cvt_pk_bf16(v0[2], v0[3]); w.z = cvt_pk_bf16(v1[0], v1[1]); w.w = cvt_pk_bf16(v1[2], v1[3]);
                    *(u32x4*)(rowp + bj * HALF) = w; } }
    }
};

template <class Epi, class Sched, bool ALIGN_EPI = false, bool SP2 = false>
__device__ __forceinline__ void gemm_phase(PG8_LAS unsigned char* lds, const Gemm g, const Sched& S, const Epi& E) {
    const int tid = threadIdx.x, wid = __builtin_amdgcn_readfirstlane(tid >> 6), lane = tid & 63, wr = wid >> 2, wc = wid & 3, fr = lane & 15, fq = lane >> 4;
    const int K = g.K, nt = K / BK;
    unsigned voffA[2], voffB[2];
#pragma unroll
    for (int i = 0; i < 2; ++i) { int R, C; stage_rc(tid * 16 + i * 8192, R, C); const int Rb = Epi::PERM ? ((R & ~31) + perm32(R & 31)) : R;
        voffA[i] = (unsigned)(R * K + C) * 2u; voffB[i] = (unsigned)(Rb * K + C) * 2u; }
    const size_t kstep = (size_t)(BK * 2);
    const size_t hstep = (size_t)HALF * K * 2;
    const size_t tstep = 2 * hstep;
    const unsigned ldsw = (unsigned)wid * 1024u;
    const int aoff = lds_byte(wr * 64 + fr, fq * 8), boff = lds_byte(wc * 32 + fr, fq * 8);
#define PG8_SA(b, h) (((b) * 2 + (h)) * HTB)
#define PG8_SB(b, h) ((4 + (b) * 2 + (h)) * HTB)
#define PG8_STAGE(bufoff, gbase, voff) do { _Pragma("unroll") for (int _i = 0; _i < 2; ++_i) \
        __builtin_amdgcn_global_load_lds((const unsigned*)((const char*)(gbase) + (voff)[_i]), (PG8_LAS unsigned*)(lds + (bufoff) + ldsw + _i * 8192), 16, 0, 0); } while (0)
#define PG8_LDA(dst, b, h) do { _Pragma("unroll") for (int m = 0; m < 4; ++m) _Pragma("unroll") for (int k = 0; k < 2; ++k) dst[m][k] = *(const PG8_LAS bf16x8*)(lds + PG8_SA(b, h) + aoff + m * 2048 + k * 1024); } while (0)
#define PG8_LDB(dst, b, h) do { _Pragma("unroll") for (int n = 0; n < 2; ++n) _Pragma("unroll") for (int k = 0; k < 2; ++k) dst[n][k] = *(const PG8_LAS bf16x8*)(lds + PG8_SB(b, h) + boff + n * 2048 + k * 1024); } while (0)
#define PG8_MMA(ai, bj, At, Bt) do { __builtin_amdgcn_s_setprio(1); _Pragma("unroll") for (int m = 0; m < 4; ++m) _Pragma("unroll") for (int n = 0; n < 2; ++n) _Pragma("unroll") for (int k = 0; k < 2; ++k) \
        acc[ai][bj][m][n] = __builtin_amdgcn_mfma_f32_16x16x32_bf16(Bt[n][k], At[m][k], acc[ai][bj][m][n], 0, 0, 0); __builtin_amdgcn_s_setprio(0); } while (0)
#define PG8_WAIT_V(n) asm volatile("s_waitcnt vmcnt(" #n ")" ::: "memory")
#define PG8_WAIT_L(n) asm volatile("s_waitcnt lgkmcnt(" #n ")" ::: "memory")
#define PG8_BAR __builtin_amdgcn_s_barrier()
#define PG8_SCHED __builtin_amdgcn_sched_barrier(0)
    Unit cur, nxt; int ui = 0;
    if (!S.next(0, cur)) return;
    f32x4 acc[2][2][4][2];
#pragma unroll
    for (int a = 0; a < 2; ++a)
#pragma unroll
        for (int b = 0; b < 2; ++b)
#pragma unroll
            for (int m = 0; m < 4; ++m)
#pragma unroll
                for (int n = 0; n < 2; ++n) acc[a][b][m][n] = (f32x4){0.f, 0.f, 0.f, 0.f};
    bf16x8 At[4][2], B0[2][2], B1[2][2];
    const char* cA = (const char*)g.A + (size_t)cur.pm * tstep; const char* cB = (const char*)g.Bt + (size_t)cur.pn * tstep;
    S.a_ready(cur);
    if constexpr (SP2) {
        PG8_STAGE(PG8_SB(0, 0), cB, voffB); PG8_STAGE(PG8_SB(0, 1), cB + hstep, voffB); PG8_STAGE(PG8_SA(0, 0), cA, voffA); PG8_STAGE(PG8_SA(0, 1), cA + hstep, voffA);
        if (wr == 1) PG8_BAR;
        PG8_WAIT_V(2); PG8_BAR;
        PG8_STAGE(PG8_SB(1, 0), cB + kstep, voffB); PG8_STAGE(PG8_SA(1, 0), cA + kstep, voffA); PG8_STAGE(PG8_SB(1, 1), cB + hstep + kstep, voffB);
        PG8_WAIT_V(6); PG8_BAR;
    } else {
        PG8_STAGE(PG8_SB(0, 0), cB, voffB); PG8_STAGE(PG8_SA(0, 0), cA, voffA); PG8_STAGE(PG8_SB(0, 1), cB + hstep, voffB); PG8_STAGE(PG8_SA(0, 1), cA + hstep, voffA);
        if (wr == 1) PG8_BAR;
        PG8_WAIT_V(4); PG8_BAR;
        PG8_STAGE(PG8_SB(1, 0), cB + kstep, voffB); PG8_STAGE(PG8_SA(1, 0), cA + kstep, voffA); PG8_STAGE(PG8_SB(1, 1), cB + hstep + kstep, voffB);
        PG8_WAIT_V(6); PG8_BAR;
    }
    for (;;) {
        const bool has_next = S.next(ui + 1, nxt);
        const char* nA = has_next ? (const char*)g.A + (size_t)nxt.pm * tstep : cA; const char* nB = has_next ? (const char*)g.Bt + (size_t)nxt.pn * tstep : cB;
        for (int t = 0; t < nt; t += 2) {
            const bool last = (t == nt - 2);
            const char* a1 = cA + (size_t)(t + 1) * kstep;
            const char* a2 = last ? nA : cA + (size_t)(t + 2) * kstep; const char* b2 = last ? nB : cB + (size_t)(t + 2) * kstep;
            const char* a3 = a2 + kstep; const char* b3 = b2 + kstep;
            if (last && has_next) S.a_ready(nxt);
            if constexpr (SP2) {
            PG8_LDB(B0, 0, 0); PG8_LDB(B1, 0, 1); PG8_SCHED; PG8_LDA(At, 0, 0); PG8_STAGE(PG8_SA(1, 1), a1 + hstep, voffA);
            PG8_WAIT_V(8); PG8_WAIT_L(0); PG8_BAR; PG8_MMA(0, 0, At, B0); PG8_MMA(0, 1, At, B1); PG8_BAR; PG8_SCHED;
            PG8_LDA(At, 0, 1); PG8_STAGE(PG8_SB(0, 0), b2, voffB); PG8_STAGE(PG8_SB(0, 1), b2 + hstep, voffB); PG8_STAGE(PG8_SA(0, 0), a2, voffA);
            PG8_WAIT_V(8); PG8_WAIT_L(0); PG8_BAR; PG8_MMA(1, 0, At, B0); PG8_MMA(1, 1, At, B1); PG8_BAR; PG8_SCHED;
            PG8_LDB(B0, 1, 0); PG8_LDB(B1, 1, 1); PG8_SCHED; PG8_LDA(At, 1, 0); PG8_STAGE(PG8_SA(0, 1), a2 + hstep, voffA);
            PG8_WAIT_V(8); PG8_WAIT_L(0); PG8_BAR; PG8_MMA(0, 0, At, B0); PG8_MMA(0, 1, At, B1); PG8_BAR; PG8_SCHED;
            PG8_LDA(At, 1, 1); PG8_STAGE(PG8_SB(1, 0), b3, voffB); PG8_STAGE(PG8_SB(1, 1), b3 + hstep, voffB); PG8_STAGE(PG8_SA(1, 0), a3, voffA);
            PG8_WAIT_V(8); PG8_WAIT_L(0); PG8_BAR; PG8_MMA(1, 0, At, B0); PG8_MMA(1, 1, At, B1); PG8_BAR; PG8_SCHED;
            } else {
            PG8_LDB(B0, 0, 0); PG8_SCHED; PG8_LDA(At, 0, 0); PG8_STAGE(PG8_SA(1, 1), a1 + hstep, voffA);
            PG8_WAIT_L(8); PG8_BAR; PG8_WAIT_L(0); PG8_MMA(0, 0, At, B0); PG8_BAR; PG8_SCHED;
            PG8_LDB(B1, 0, 1); PG8_STAGE(PG8_SB(0, 0), b2, voffB);
            PG8_BAR; PG8_WAIT_L(0); PG8_MMA(0, 1, At, B1); PG8_BAR;
            PG8_LDA(At, 0, 1); PG8_STAGE(PG8_SA(0, 0), a2, voffA);
            PG8_BAR; PG8_WAIT_L(0); PG8_MMA(1, 0, At, B0); PG8_BAR; PG8_SCHED;
            PG8_STAGE(PG8_SB(0, 1), b2 + hstep, voffB);
            PG8_WAIT_V(6); PG8_BAR; PG8_MMA(1, 1, At, B1); PG8_BAR;
            PG8_LDB(B0, 1, 0); PG8_SCHED; PG8_LDA(At, 1, 0); PG8_STAGE(PG8_SA(0, 1), a2 + hstep, voffA);
            PG8_WAIT_L(8); PG8_BAR; PG8_WAIT_L(0); PG8_MMA(0, 0, At, B0); PG8_BAR; PG8_SCHED;
            PG8_LDB(B1, 1, 1); PG8_STAGE(PG8_SB(1, 0), b3, voffB);
            PG8_BAR; PG8_WAIT_L(0); PG8_MMA(0, 1, At, B1); PG8_BAR;
            PG8_LDA(At, 1, 1); PG8_STAGE(PG8_SA(1, 0), a3, voffA);
            PG8_BAR; PG8_WAIT_L(0); PG8_MMA(1, 0, At, B0); PG8_BAR; PG8_SCHED;
            PG8_STAGE(PG8_SB(1, 1), b3 + hstep, voffB);
            PG8_WAIT_V(6); PG8_BAR; PG8_MMA(1, 1, At, B1); PG8_BAR;
            }
        }
        if constexpr (ALIGN_EPI) { if (wr == 0) PG8_BAR; }
        if constexpr (!Epi::AFTER_DRAIN) { E(acc, cur, wr, wc, fr, fq); S.done(cur); }
        if (!has_next) break;
#pragma unroll
        for (int a = 0; a < 2; ++a)
#pragma unroll
            for (int b = 0; b < 2; ++b)
#pragma unroll
                for (int m = 0; m < 4; ++m)
#pragma unroll
                    for (int n = 0; n < 2; ++n) acc[a][b][m][n] = (f32x4){0.f, 0.f, 0.f, 0.f};
        cur = nxt; cA = nA; cB = nB; ++ui;
        if constexpr (ALIGN_EPI) { if (wr == 1) PG8_BAR; }
    }
    PG8_WAIT_V(0);
    if constexpr (!ALIGN_EPI) { if (wr == 0) PG8_BAR; }
    PG8_BAR;
    if constexpr (Epi::AFTER_DRAIN) { E.fused(acc, cur, wr, wc, fr, fq, lds, wid, lane); S.done(cur); }
#undef PG8_SA
#undef PG8_SB
#undef PG8_STAGE
#undef PG8_LDA
#undef PG8_LDB
#undef PG8_MMA
#undef PG8_WAIT_V
#undef PG8_WAIT_L
#undef PG8_BAR
#undef PG8_SCHED
}
}

#ifndef PROBE_STAMP
#define PROBE_STAMP -1
#define PROBE_DIV 5.0f
#endif
constexpr int NWAVES = 8;
#ifndef MK_N_LAUNCHES
#define MK_N_LAUNCHES 1
#endif
constexpr int N_PHASES = 12;
constexpr int N_LAUNCHES = MK_N_LAUNCHES;

constexpr int BATCH = 4, SEQ = 4096, D = 2048, M = BATCH * SEQ;
constexpr int LRU_W = 1024, LRU_HEADS = 8, LRU_BLK = 128;
constexpr int HD = 64, HQ = 16, HKV = 2, GRP = 8;
constexpr int MIX_IN = 3328;
constexpr int C_Y = 1024, C_Q = 2048, C_K = 3072, C_V = 3200;
constexpr int ADA_W = 6 * D;
constexpr int PH = 8, PKEYS = 128, PHALF = 128, PTOPK = 16, NEXP = 16384;
constexpr float EPS = 1e-6f;

constexpr size_t MiB = 1u << 20;
constexpr size_t WS_CTL = 0, CTL_ZERO_BYTES = 64 * 1024;
constexpr size_t WS_ADA = 1 * MiB;
constexpr size_t WS_ROPE = 2 * MiB;
constexpr size_t WS_WIN = 4 * MiB;
constexpr size_t WS_WOUT = 17 * MiB;
constexpr size_t WS_WQ = 25 * MiB;
constexpr size_t WS_WGA = 33 * MiB;
constexpr size_t WS_WGX = 33 * MiB + 256 * 1024;
constexpr size_t WS_SK = 33 * MiB + 512 * 1024;
constexpr size_t WS_IDX = 34 * MiB;
constexpr size_t WS_GW = 42 * MiB;
constexpr size_t WS_U = 50 * MiB;
constexpr size_t WS_V = 82 * MiB;
constexpr size_t WS_USC = 1 * MiB + 512 * 1024;
constexpr size_t WS_VSC = 1 * MiB + 768 * 1024;
constexpr size_t WS_X1B = 114 * MiB;
constexpr size_t WS_XH = 178 * MiB;
constexpr size_t WS_PROJ = 242 * MiB;
constexpr size_t WS_HL = 346 * MiB;
constexpr size_t WS_PA = 410 * MiB;
constexpr size_t WS_PART = WS_HL;
constexpr size_t WS_W = WS_PROJ + 64 * MiB;
constexpr size_t WS_WSC = WS_PROJ + 68 * MiB;
constexpr size_t WS_H8 = WS_PROJ + 72 * MiB;
constexpr size_t WS_END = 474 * MiB;
constexpr int CW_BAR = 4096;

constexpr int RING_BYTES = 131072;
constexpr int LDSCTL_OFF = RING_BYTES, MISC_OFF = LDSCTL_OFF + 320;
constexpr int LDS_BYTES = 147456;

#define GAS __attribute__((address_space(1)))
#define LAS __attribute__((address_space(3)))
typedef unsigned short bf16;
typedef unsigned v4u __attribute__((ext_vector_type(4)));
typedef unsigned v2u __attribute__((ext_vector_type(2)));
typedef float f32x4 __attribute__((ext_vector_type(4)));
typedef float f32x2 __attribute__((ext_vector_type(2)));
typedef float f32x16 __attribute__((ext_vector_type(16)));
typedef short bf16x8 __attribute__((ext_vector_type(8)));
typedef __bf16 bf16x2v __attribute__((ext_vector_type(2)));
#define LDS_WAIT() asm volatile("s_waitcnt lgkmcnt(0)" ::: "memory")
#define VM_WAIT() asm volatile("s_waitcnt vmcnt(0)" ::: "memory")
__device__ __forceinline__ unsigned f2bf(float f) { unsigned u = __builtin_bit_cast(unsigned, f); return (u + 0x7fffu + ((u >> 16) & 1u)) >> 16; }
__device__ __forceinline__ unsigned pk2(float lo, float hi) { return f2bf(lo) | (f2bf(hi) << 16); }
__device__ __forceinline__ float bflo(unsigned u) { return __builtin_bit_cast(float, u << 16); }
__device__ __forceinline__ float bfhi(unsigned u) { return __builtin_bit_cast(float, u & 0xffff0000u); }
__device__ __forceinline__ float bf1(bf16 h) { return __builtin_bit_cast(float, (unsigned)h << 16); }
__device__ __forceinline__ float dot2bf(unsigned a, unsigned b, float acc) { return __builtin_amdgcn_fdot2_f32_bf16(__builtin_bit_cast(bf16x2v, a), __builtin_bit_cast(bf16x2v, b), acc, false); }
__device__ __forceinline__ float sigmoidf_(float x) { return 1.0f / (1.0f + __expf(-x)); }
__device__ __forceinline__ float gelu_tanh(float x) {
    const float z = 1.5957691216057308f * (x + 0.044715f * x * x * x);
    return x / (1.0f + __expf(-z));
}
__device__ __forceinline__ float wave_sum(float v) {
#pragma unroll
    for (int o = 1; o < 64; o <<= 1) v += __shfl_xor(v, o);
    return v;
}

#define XB_TMO      128
#define XB_XCNT(j)  (256  + 64 * (j))
#define XB_XSUB(j)  (1280 + 64 * (j))
#define XB_XGEN(j)  (2304 + 64 * (j))
#define XB_TOP      3328
#define XB_TOPGEN   3392
#define XCD_BAR_WORDS 3456
#define XB_SPIN_CAP (1u << 18)
__device__ __forceinline__ unsigned xb_ld(unsigned* p)              { return __hip_atomic_load(p, __ATOMIC_RELAXED, __HIP_MEMORY_SCOPE_AGENT); }
__device__ __forceinline__ unsigned xb_add(unsigned* p, unsigned v) { return __hip_atomic_fetch_add(p, v, __ATOMIC_RELAXED, __HIP_MEMORY_SCOPE_AGENT); }
__device__ __forceinline__ unsigned xb_xcc_id() { return (unsigned)__builtin_amdgcn_s_getreg((3 << 11) | 20) & 0xFu; }
#define XB_SPIN(cond, bar) do { unsigned _sp = 0; while (cond) { __builtin_amdgcn_s_sleep(1); \
    if ((++_sp & 255u) == 0u) { if (xb_ld(&(bar)[XB_TMO])) break; if (_sp > XB_SPIN_CAP) { atomicAdd(&(bar)[XB_TMO], 1u); break; } } } } while (0)
struct XcdBarrier { unsigned* bar; unsigned x; volatile LAS unsigned* st; };
__device__ __forceinline__ XcdBarrier xcd_barrier_post(unsigned* bar, volatile LAS unsigned* st) {
    XcdBarrier b; b.bar = bar; b.x = xb_xcc_id(); b.st = st;
    if (threadIdx.x == 0) (void)xb_add(&bar[XB_XCNT(b.x)], 1u);
    return b;
}
__device__ __forceinline__ void xcd_barrier_complete(unsigned* bar, unsigned x, unsigned& nloc, unsigned& nx) {
    const unsigned G = gridDim.x * gridDim.y * gridDim.z;
    unsigned sum, cnt, mine, sp = 0u;
    for (;;) {
        sum = 0u; cnt = 0u; mine = 0u;
#pragma unroll
        for (unsigned j = 0; j < 16; ++j) { const unsigned c = xb_ld(&bar[XB_XCNT(j)]); sum += c; cnt += (c > 0u) ? 1u : 0u; mine = (j == x) ? c : mine; }
        if (sum == G) break;
        __builtin_amdgcn_s_sleep(1);
        if ((++sp & 255u) == 0u) { if (xb_ld(&bar[XB_TMO])) break; if (sp > XB_SPIN_CAP) { atomicAdd(&bar[XB_TMO], 1u); break; } }
    }
    nloc = mine > 0u ? mine : 1u; nx = cnt > 0u ? cnt : 1u;
}
__device__ __forceinline__ void xcd_barrier(const XcdBarrier& b) {
    asm volatile("s_waitcnt vmcnt(0)" ::: "memory");
    __syncthreads();
    if (threadIdx.x == 0) {
        unsigned* bar = b.bar;
        __builtin_amdgcn_s_waitcnt(0);
        unsigned nloc = b.st[0], nx = b.st[1];
        if (nloc == 0u) { xcd_barrier_complete(bar, b.x, nloc, nx); b.st[0] = nloc; b.st[1] = nx; }
        const unsigned old = xb_add(&bar[XB_XSUB(b.x)], 1u);
        const unsigned gen = old / nloc;
        if (old + 1u == (gen + 1u) * nloc) {
            __builtin_amdgcn_fence(__ATOMIC_RELEASE, "agent");
            asm volatile("s_waitcnt vmcnt(0)" ::: "memory");
            const unsigned og = xb_add(&bar[XB_TOP], 1u);
            const unsigned tg = og / nx;
            if (og + 1u == (tg + 1u) * nx) xb_add(&bar[XB_TOPGEN], 1u);
            else XB_SPIN(xb_ld(&bar[XB_TOPGEN]) == tg, bar);
            __builtin_amdgcn_fence(__ATOMIC_ACQUIRE, "agent");
            xb_add(&bar[XB_XGEN(b.x)], 1u);
            asm volatile("s_waitcnt vmcnt(0)" ::: "memory");
        } else {
            XB_SPIN(xb_ld(&bar[XB_XGEN(b.x)]) == gen, bar);
            __builtin_amdgcn_fence(__ATOMIC_ACQUIRE, "agent");
            asm volatile("s_waitcnt vmcnt(0)" ::: "memory");
        }
    }
    __syncthreads();
}

typedef const __attribute__((address_space(4))) unsigned char* kaptr_t;
struct Frame { LAS unsigned char* lds; int tid, lane, wave, G, bid; kaptr_t ka; };
template <class T> __device__ __forceinline__ T* ka_ptr(const Frame& F, int byte_off) { typedef T* tp; return *(const __attribute__((address_space(4))) tp*)(F.ka + byte_off); }
__device__ __forceinline__ const float* P_x(const Frame& F) { return ka_ptr<const float>(F, 0); }
__device__ __forceinline__ const float* P_c(const Frame& F) { return ka_ptr<const float>(F, 8); }
__device__ __forceinline__ const int* P_pos(const Frame& F) { return ka_ptr<const int>(F, 16); }
__device__ __forceinline__ const float* P_w_ada(const Frame& F) { return ka_ptr<const float>(F, 24); }
__device__ __forceinline__ const float* P_b_ada(const Frame& F) { return ka_ptr<const float>(F, 32); }
__device__ __forceinline__ const float* P_norm1_g(const Frame& F) { return ka_ptr<const float>(F, 40); }
__device__ __forceinline__ const float* P_w_in(const Frame& F) { return ka_ptr<const float>(F, 48); }
__device__ __forceinline__ const float* P_conv_w(const Frame& F) { return ka_ptr<const float>(F, 56); }
__device__ __forceinline__ const float* P_conv_b(const Frame& F) { return ka_ptr<const float>(F, 64); }
__device__ __forceinline__ const float* P_ga_w(const Frame& F) { return ka_ptr<const float>(F, 72); }
__device__ __forceinline__ const float* P_ga_b(const Frame& F) { return ka_ptr<const float>(F, 80); }
__device__ __forceinline__ const float* P_gx_w(const Frame& F) { return ka_ptr<const float>(F, 88); }
__device__ __forceinline__ const float* P_gx_b(const Frame& F) { return ka_ptr<const float>(F, 96); }
__device__ __forceinline__ const float* P_lam(const Frame& F) { return ka_ptr<const float>(F, 104); }
__device__ __forceinline__ const float* P_qn_g(const Frame& F) { return ka_ptr<const float>(F, 112); }
__device__ __forceinline__ const float* P_kn_g(const Frame& F) { return ka_ptr<const float>(F, 120); }
__device__ __forceinline__ const float* P_sinks(const Frame& F) { return ka_ptr<const float>(F, 128); }
__device__ __forceinline__ const float* P_on_lru_g(const Frame& F) { return ka_ptr<const float>(F, 136); }
__device__ __forceinline__ const float* P_on_attn_g(const Frame& F) { return ka_ptr<const float>(F, 144); }
__device__ __forceinline__ const float* P_w_out(const Frame& F) { return ka_ptr<const float>(F, 152); }
__device__ __forceinline__ const float* P_norm2_g(const Frame& F) { return ka_ptr<const float>(F, 160); }
__device__ __forceinline__ const float* P_w_pq(const Frame& F) { return ka_ptr<const float>(F, 168); }
__device__ __forceinline__ const float* P_sub_keys(const Frame& F) { return ka_ptr<const float>(F, 176); }
__device__ __forceinline__ const float* P_pu(const Frame& F) { return ka_ptr<const float>(F, 184); }
__device__ __forceinline__ const float* P_pv(const Frame& F) { return ka_ptr<const float>(F, 192); }
__device__ __forceinline__ float* P_out(const Frame& F) { return ka_ptr<float>(F, 200); }
__device__ __forceinline__ unsigned char* P_ws(const Frame& F) { return ka_ptr<unsigned char>(F, 208); }
__device__ __forceinline__ float* P_ADA(const Frame& F) { return (float*)(P_ws(F) + WS_ADA); }
__device__ __forceinline__ float* P_ROPE(const Frame& F) { return (float*)(P_ws(F) + WS_ROPE); }
__device__ __forceinline__ bf16* P_HL(const Frame& F) { return (bf16*)(P_ws(F) + WS_HL); }
__device__ __forceinline__ bf16* P_PA(const Frame& F) { return (bf16*)(P_ws(F) + WS_PA); }
__device__ __forceinline__ float* P_GW(const Frame& F) { return (float*)(P_ws(F) + WS_GW); }
__device__ __forceinline__ unsigned short* P_IDX(const Frame& F) { return (unsigned short*)(P_ws(F) + WS_IDX); }
__device__ __forceinline__ bf16* P_WIN(const Frame& F) { return (bf16*)(P_ws(F) + WS_WIN); }
__device__ __forceinline__ bf16* P_WOUT(const Frame& F) { return (bf16*)(P_ws(F) + WS_WOUT); }
__device__ __forceinline__ bf16* P_WQ(const Frame& F) { return (bf16*)(P_ws(F) + WS_WQ); }
__device__ __forceinline__ bf16* P_WGA(const Frame& F) { return (bf16*)(P_ws(F) + WS_WGA); }
__device__ __forceinline__ bf16* P_WGX(const Frame& F) { return (bf16*)(P_ws(F) + WS_WGX); }
__device__ __forceinline__ bf16* P_SK(const Frame& F) { return (bf16*)(P_ws(F) + WS_SK); }
__device__ __forceinline__ unsigned char* P_U(const Frame& F) { return (unsigned char*)(P_ws(F) + WS_U); }
__device__ __forceinline__ bf16* P_X1B(const Frame& F) { return (bf16*)(P_ws(F) + WS_X1B); }
__device__ __forceinline__ unsigned char* P_H8(const Frame& F) { return (unsigned char*)(P_ws(F) + WS_H8); }
__device__ __forceinline__ unsigned* P_PART(const Frame& F) { return (unsigned*)(P_ws(F) + WS_PART); }
__device__ __forceinline__ unsigned char* P_W(const Frame& F) { return (unsigned char*)(P_ws(F) + WS_W); }
__device__ __forceinline__ float* P_WSC(const Frame& F) { return (float*)(P_ws(F) + WS_WSC); }
__device__ __forceinline__ float* P_USC(const Frame& F) { return (float*)(P_ws(F) + WS_USC); }
__device__ __forceinline__ float* P_VSC(const Frame& F) { return (float*)(P_ws(F) + WS_VSC); }
__device__ __forceinline__ unsigned char* P_V(const Frame& F) { return (unsigned char*)(P_ws(F) + WS_V); }
__device__ __forceinline__ bf16* P_XH(const Frame& F) { return (bf16*)(P_ws(F) + WS_XH); }
__device__ __forceinline__ bf16* P_PROJ(const Frame& F) { return (bf16*)(P_ws(F) + WS_PROJ); }

__device__ __forceinline__ void p0_transpose_item(const float* W, int K, int N, bf16* WT, LAS float* scr, int item, int lane) {
    const int nblk = N / 32, kb = item / nblk, nb = item % nblk, k0 = 64 * kb, n0 = 32 * nb;
#pragma unroll 8
    for (int i = 0; i < 32; ++i) { const int kk = 2 * i + (lane >> 5); scr[kk * 33 + (lane & 31)] = W[(size_t)(k0 + kk) * N + n0 + (lane & 31)]; }
    LDS_WAIT(); asm volatile("" ::: "memory");
    const int c = lane & 7;
#pragma unroll
    for (int j = 0; j < 4; ++j) { const int n = (lane >> 3) + 8 * j; const LAS float* s = scr + (8 * c) * 33 + n;
        v4u o; o.x = pk2(s[0 * 33], s[1 * 33]); o.y = pk2(s[2 * 33], s[3 * 33]); o.z = pk2(s[4 * 33], s[5 * 33]); o.w = pk2(s[6 * 33], s[7 * 33]);
        *(v4u*)(WT + (size_t)(n0 + n) * K + k0 + 8 * c) = o; }
    LDS_WAIT(); asm volatile("" ::: "memory");
}
__device__ __forceinline__ void p0_convert(const float* src, bf16* dst, size_t n8, size_t gtid, size_t gthreads) {
    for (size_t i = gtid; i < n8; i += gthreads) {
        const f32x4 a = *(const f32x4*)(src + 8 * i), b = *(const f32x4*)(src + 8 * i + 4);
        v4u o; o.x = pk2(a.x, a.y); o.y = pk2(a.z, a.w); o.z = pk2(b.x, b.y); o.w = pk2(b.z, b.w);
        *(v4u*)(dst + 8 * i) = o;
    }
}
#ifndef QUANT_SPLIT
#define QUANT_SPLIT 14336
#endif
__device__ __forceinline__ void quant_rows(Frame& F, int r0, int r1, int w, int nw) {
    for (int rr = r0 + w; rr < r1; rr += nw) {
        const int tbl = rr >= NEXP, row = rr - tbl * NEXP;
        const float* srcp = (tbl ? P_pv(F) : P_pu(F)) + (size_t)row * D;
        f32x4 v[8]; float mx = 0.f;
#pragma unroll
        for (int j = 0; j < 8; ++j) { v[j] = *(const f32x4*)(srcp + 4 * F.lane + 256 * j);
            mx = fmaxf(fmaxf(mx, fmaxf(fabsf(v[j].x), fabsf(v[j].y))), fmaxf(fabsf(v[j].z), fabsf(v[j].w))); }
#pragma unroll
        for (int o = 1; o < 64; o <<= 1) mx = fmaxf(mx, __shfl_xor(mx, o));
        {
            const float s = fmaxf(mx, 1e-30f) * (1.0f / 6.0f), inv = 1.0f / s;
            unsigned char* d4 = (tbl ? P_V(F) : P_U(F)) + (size_t)row * 128 + 2 * F.lane;
#pragma unroll
            for (int j = 0; j < 8; ++j) { unsigned t = __builtin_amdgcn_cvt_scalef32_pk_fp4_f32(0u, v[j].x * inv, v[j].y * inv, 1.0f, 0);
                t = __builtin_amdgcn_cvt_scalef32_pk_fp4_f32(t, v[j].z * inv, v[j].w * inv, 1.0f, 1);
                *(unsigned short*)(d4 + (size_t)j * (NEXP * 128)) = (unsigned short)t; }
            if (F.lane == 0) (tbl ? P_VSC(F) : P_USC(F))[row] = s;
        }
    }
}
__device__ __forceinline__ void p0_prologue(Frame& F) {
    {
        LAS float* sc = (LAS float*)F.lds;
        LAS float* red = sc + 4 * D;
        for (int i = F.tid; i < 4 * D; i += 512) { const float v = P_c(F)[i]; sc[i] = v / (1.0f + __expf(-v)); }
        __syncthreads();
        for (int cg = F.bid; cg < ADA_W / 64; cg += F.G) {
            const int n0 = cg * 64, k0 = F.wave * 256;
            const float* wp = P_w_ada(F) + (size_t)k0 * ADA_W + n0 + F.lane;
            float a0 = 0.f, a1 = 0.f, a2 = 0.f, a3 = 0.f;
            for (int kb = 0; kb < 256; kb += 64) { float wv[64];
#pragma unroll
                for (int k = 0; k < 64; ++k) wv[k] = wp[(size_t)(kb + k) * ADA_W];
#pragma unroll
                for (int k = 0; k < 64; ++k) { const float w = wv[k]; const int kk = k0 + kb + k;
                    a0 += sc[kk] * w; a1 += sc[D + kk] * w; a2 += sc[2 * D + kk] * w; a3 += sc[3 * D + kk] * w; } }
            red[(F.wave * 4 + 0) * 64 + F.lane] = a0; red[(F.wave * 4 + 1) * 64 + F.lane] = a1;
            red[(F.wave * 4 + 2) * 64 + F.lane] = a2; red[(F.wave * 4 + 3) * 64 + F.lane] = a3;
            __syncthreads();
            if (F.tid < 256) { const int b = F.tid >> 6, l = F.tid & 63; float s = 0.f;
#pragma unroll
                for (int w = 0; w < 8; ++w) s += red[(w * 4 + b) * 64 + l];
                P_ADA(F)[(size_t)b * ADA_W + n0 + l] = s + P_b_ada(F)[n0 + l]; }
            __syncthreads();
        }
        __syncthreads();
    }
    if (PROBE_STAMP >= 0 && F.bid == 0 && F.tid == 0) ((unsigned long long*)(P_ws(F) + WS_CTL + 64))[14] = __builtin_amdgcn_s_memrealtime();
    {
        LAS float* scr = (LAS float*)(F.lds + F.wave * 16384);
        const int gw = F.bid * NWAVES + F.wave, NGW = F.G * NWAVES;
        constexpr int I_IN = (D / 64) * (MIX_IN / 32), I_SQ = (D / 64) * (D / 32), I_G = (LRU_BLK / 64) * (LRU_BLK / 32);
        constexpr int NITEMS = I_IN + 2 * I_SQ + 16 * I_G;
        for (int it = gw; it < NITEMS; it += NGW) {
            int r = it;
            if (r < I_IN) { p0_transpose_item(P_w_in(F), D, MIX_IN, P_WIN(F), scr, r, F.lane); continue; } r -= I_IN;
            if (r < I_SQ) { p0_transpose_item(P_w_out(F), D, D, P_WOUT(F), scr, r, F.lane); continue; } r -= I_SQ;
            if (r < I_SQ) { p0_transpose_item(P_w_pq(F), D, D, P_WQ(F), scr, r, F.lane); continue; } r -= I_SQ;
            const int g = r / I_G, ri = r % I_G, hd = g & 7;
            if (g < 8) p0_transpose_item(P_ga_w(F) + (size_t)hd * 16384, LRU_BLK, LRU_BLK, P_WGA(F) + (size_t)hd * 16384, scr, ri, F.lane);
            else       p0_transpose_item(P_gx_w(F) + (size_t)hd * 16384, LRU_BLK, LRU_BLK, P_WGX(F) + (size_t)hd * 16384, scr, ri, F.lane);
        }
    }
    {
        const size_t gtid = (size_t)F.bid * 512 + F.tid, gth = (size_t)F.G * 512;
        p0_convert(P_sub_keys(F), P_SK(F), (size_t)PH * 2 * PKEYS * PHALF / 8, gtid, gth);
    }
    quant_rows(F, 0, QUANT_SPLIT, F.bid * NWAVES + F.wave, F.G * NWAVES);
}

template <bool RESID, int R> __device__ __forceinline__ void modnorm_rows(const float* xin, const float* gain, const float* shift, const float* scale, bf16* orow, int lane, bf16* xin2 = nullptr, unsigned char* o8 = nullptr) {
    f32x4 v[R][4][2]; float s[R];
#pragma unroll
    for (int r = 0; r < R; ++r) { s[r] = 0.f;
#pragma unroll
        for (int j = 0; j < 4; ++j) { const int c = 8 * lane + 512 * j;
            v[r][j][0] = *(const f32x4*)(xin + (size_t)r * D + c); v[r][j][1] = *(const f32x4*)(xin + (size_t)r * D + c + 4);
            if (RESID) { bf16* dp = xin2 + (size_t)r * D + c; const v4u q = *(const v4u*)dp;
                v[r][j][0] += (f32x4){bflo(q.x), bfhi(q.x), bflo(q.y), bfhi(q.y)}; v[r][j][1] += (f32x4){bflo(q.z), bfhi(q.z), bflo(q.w), bfhi(q.w)};
                v4u o; o.x = pk2(v[r][j][0].x, v[r][j][0].y); o.y = pk2(v[r][j][0].z, v[r][j][0].w); o.z = pk2(v[r][j][1].x, v[r][j][1].y); o.w = pk2(v[r][j][1].z, v[r][j][1].w); *(v4u*)dp = o; } } }
#pragma unroll
    for (int r = 0; r < R; ++r)
#pragma unroll
        for (int j = 0; j < 4; ++j)
#pragma unroll
            for (int h = 0; h < 2; ++h) { const f32x4 t = v[r][j][h]; s[r] += (t.x * t.x + t.y * t.y) + (t.z * t.z + t.w * t.w); }
#pragma unroll
    for (int o = 1; o < 64; o <<= 1) {
#pragma unroll
        for (int r = 0; r < R; ++r) s[r] += __shfl_xor(s[r], o); }
    float rstd[R];
#pragma unroll
    for (int r = 0; r < R; ++r) rstd[r] = 1.0f / sqrtf(s[r] * (1.0f / D) + EPS);
#pragma unroll
    for (int j = 0; j < 4; ++j) {
        const int c = 8 * lane + 512 * j;
        f32x4 gm[2], sh[2];
#pragma unroll
        for (int h = 0; h < 2; ++h) { const f32x4 g = *(const f32x4*)(gain + c + 4 * h), sc = *(const f32x4*)(scale + c + 4 * h); sh[h] = *(const f32x4*)(shift + c + 4 * h); gm[h] = g * (sc + 1.0f); }
#pragma unroll
        for (int r = 0; r < R; ++r) { const f32x4 y0 = (v[r][j][0] * rstd[r]) * gm[0] + sh[0], y1 = (v[r][j][1] * rstd[r]) * gm[1] + sh[1];
            v4u o; o.x = pk2(y0.x, y0.y); o.y = pk2(y0.z, y0.w); o.z = pk2(y1.x, y1.y); o.w = pk2(y1.z, y1.w);
            *(v4u*)(orow + (size_t)r * D + c) = o;
            if (RESID) { int t0 = __builtin_amdgcn_cvt_pk_fp8_f32(y0.x, y0.y, 0, false); t0 = __builtin_amdgcn_cvt_pk_fp8_f32(y0.z, y0.w, t0, true);
                int t1 = __builtin_amdgcn_cvt_pk_fp8_f32(y1.x, y1.y, 0, false); t1 = __builtin_amdgcn_cvt_pk_fp8_f32(y1.z, y1.w, t1, true);
                *(v2u*)(o8 + (size_t)r * D + c) = (v2u){(unsigned)t0, (unsigned)t1}; } }
    }
}
__device__ __forceinline__ void p1_phase(Frame& F) {
    const int gw = F.bid * NWAVES + F.wave, NGW = F.G * NWAVES;
    for (int m = 4 * gw; m < M; m += 4 * NGW) { const int b = m / SEQ; const float* ada = P_ADA(F) + (size_t)b * ADA_W;
        modnorm_rows<false, 4>(P_x(F) + (size_t)m * D, P_norm1_g(F), ada, ada + D, P_XH(F) + (size_t)m * D, F.lane); }
    const float invf[8] = {1.0f, 1.9392274e-01f, 3.7606031e-02f, 7.2926646e-03f, 1.4142136e-03f, 2.7424819e-04f, 5.3182961e-05f, 1.0313386e-05f};
    for (int i = F.bid * 512 + F.tid; i < M * 8; i += F.G * 512) { const int m = i >> 3, k = i & 7;
        float f = invf[0];
#pragma unroll
        for (int q = 1; q < 8; ++q) f = (k == q) ? invf[q] : f;
        const float ang = (float)P_pos(F)[m] * f; float sn, cs; sincosf(ang, &sn, &cs);
        P_ROPE(F)[(size_t)m * 16 + k] = cs; P_ROPE(F)[(size_t)m * 16 + 8 + k] = sn; }
}
__device__ __forceinline__ void p6_phase(Frame& F) {
    const int gw = F.bid * NWAVES + F.wave, NGW = F.G * NWAVES;
    for (int m = 2 * gw; m < M; m += 2 * NGW) { const int b = m / SEQ; const float* ada = P_ADA(F) + (size_t)b * ADA_W;
        modnorm_rows<true, 2>(P_x(F) + (size_t)m * D, P_norm2_g(F), ada + 3 * D, ada + 4 * D, P_XH(F) + (size_t)m * D, F.lane, P_X1B(F) + (size_t)m * D, P_H8(F) + (size_t)m * D); }
}

#define MFMA32(a, b, c) __builtin_amdgcn_mfma_f32_32x32x16_bf16((a), (b), (c), 0, 0, 0)
#define MFMA16(a, b, c) __builtin_amdgcn_mfma_f32_16x16x32_bf16((a), (b), (c), 0, 0, 0)
constexpr int KS_STRIDE = 72;
constexpr int VT_STRIDE = 264;
constexpr int ATT_KS_OFF = 0, ATT_VT_OFF = 256 * KS_STRIDE * 2;
static_assert(ATT_VT_OFF + 64 * VT_STRIDE * 2 <= RING_BYTES, "attention LDS");

__device__ __forceinline__ void attn_unit(Frame& F, int b, int g, int n) {
    LAS bf16* Ks = (LAS bf16*)(F.lds + ATT_KS_OFF);
    LAS bf16* VT = (LAS bf16*)(F.lds + ATT_VT_OFF);
    const int tid = F.tid, lane = F.lane;
    {
        const int kb = tid >> 1, hf = tid & 1; const int t = n * 128 - 128 + kb;
        float kv[32]; v4u vraw[4];
        if (t >= 0) {
            const bf16* kp = P_PROJ(F) + (size_t)(b * SEQ + t) * MIX_IN + C_K + g * HD + 32 * hf;
            const bf16* vp = P_PROJ(F) + (size_t)(b * SEQ + t) * MIX_IN + C_V + g * HD + 32 * hf;
#pragma unroll
            for (int q = 0; q < 4; ++q) { const v4u r = *(const v4u*)(kp + 8 * q); vraw[q] = *(const v4u*)(vp + 8 * q);
                kv[8 * q + 0] = bflo(r.x); kv[8 * q + 1] = bfhi(r.x); kv[8 * q + 2] = bflo(r.y); kv[8 * q + 3] = bfhi(r.y);
                kv[8 * q + 4] = bflo(r.z); kv[8 * q + 5] = bfhi(r.z); kv[8 * q + 6] = bflo(r.w); kv[8 * q + 7] = bfhi(r.w); }
        } else {
#pragma unroll
            for (int q = 0; q < 4; ++q) vraw[q] = (v4u){0u, 0u, 0u, 0u};
#pragma unroll
            for (int q = 0; q < 32; ++q) kv[q] = 0.f;
        }
        float ss = 0.f;
#pragma unroll
        for (int q = 0; q < 32; ++q) ss += kv[q] * kv[q];
        ss += __shfl_xor(ss, 1);
        const float rstd = 1.0f / sqrtf(ss * (1.0f / HD) + EPS);
#pragma unroll
        for (int q = 0; q < 32; ++q) kv[q] = kv[q] * rstd * P_kn_g(F)[32 * hf + q];
        if (hf == 0 && t >= 0) {
            const float* rp = P_ROPE(F) + (size_t)(b * SEQ + t) * 16;
#pragma unroll
            for (int i = 0; i < 8; ++i) { const float cs = rp[i], sn = rp[8 + i]; const float x1 = kv[i], x2 = kv[8 + i];
                kv[i] = x1 * cs - x2 * sn; kv[8 + i] = x2 * cs + x1 * sn; }
        }
#pragma unroll
        for (int q = 0; q < 4; ++q) { v4u o; o.x = pk2(kv[8 * q], kv[8 * q + 1]); o.y = pk2(kv[8 * q + 2], kv[8 * q + 3]); o.z = pk2(kv[8 * q + 4], kv[8 * q + 5]); o.w = pk2(kv[8 * q + 6], kv[8 * q + 7]);
            *(LAS v4u*)(Ks + kb * KS_STRIDE + 32 * hf + 8 * q) = o; }
#pragma unroll
        for (int q = 0; q < 4; ++q) { const unsigned w[4] = {vraw[q].x, vraw[q].y, vraw[q].z, vraw[q].w};
#pragma unroll
            for (int e = 0; e < 4; ++e) { const int d = 32 * hf + 8 * q + 2 * e;
                VT[d * VT_STRIDE + kb] = (bf16)(w[e] & 0xffffu); VT[(d + 1) * VT_STRIDE + kb] = (bf16)(w[e] >> 16); } }
    }
    __syncthreads();
    const int hq = g * GRP + F.wave, r = lane & 31, hh = lane >> 5;
    const float sink = P_sinks(F)[hq];
    for (int qi = 0; qi < 4; ++qi) {
        const int tq = n * 128 + 32 * qi + r;
        bf16x8 qf[4];
        {
            const bf16* qp = P_PROJ(F) + (size_t)(b * SEQ + tq) * MIX_IN + C_Q + hq * HD + 8 * hh;
            float qv[4][8]; float ss = 0.f;
#pragma unroll
            for (int ks = 0; ks < 4; ++ks) { const v4u rr = *(const v4u*)(qp + 16 * ks);
                qv[ks][0] = bflo(rr.x); qv[ks][1] = bfhi(rr.x); qv[ks][2] = bflo(rr.y); qv[ks][3] = bfhi(rr.y);
                qv[ks][4] = bflo(rr.z); qv[ks][5] = bfhi(rr.z); qv[ks][6] = bflo(rr.w); qv[ks][7] = bfhi(rr.w);
#pragma unroll
                for (int j = 0; j < 8; ++j) ss += qv[ks][j] * qv[ks][j]; }
            ss += __shfl_xor(ss, 32);
            const float rstd = 1.0f / sqrtf(ss * (1.0f / HD) + EPS);
#pragma unroll
            for (int ks = 0; ks < 4; ++ks)
#pragma unroll
                for (int j = 0; j < 8; ++j) qv[ks][j] = qv[ks][j] * rstd * P_qn_g(F)[16 * ks + 8 * hh + j];
            const float* rp = P_ROPE(F) + (size_t)(b * SEQ + tq) * 16;
#pragma unroll
            for (int j = 0; j < 8; ++j) { const float mine = qv[0][j], other = __shfl_xor(mine, 32); const float cs = rp[j], sn = rp[8 + j];
                qv[0][j] = hh == 0 ? (mine * cs - other * sn) : (mine * cs + other * sn); }
#pragma unroll
            for (int ks = 0; ks < 4; ++ks) { v4u o; o.x = pk2(qv[ks][0] * 0.125f, qv[ks][1] * 0.125f); o.y = pk2(qv[ks][2] * 0.125f, qv[ks][3] * 0.125f);
                o.z = pk2(qv[ks][4] * 0.125f, qv[ks][5] * 0.125f); o.w = pk2(qv[ks][6] * 0.125f, qv[ks][7] * 0.125f); qf[ks] = __builtin_bit_cast(bf16x8, o); }
        }
        f32x16 s[5];
#pragma unroll
        for (int kj = 0; kj < 5; ++kj) {
            f32x16 acc;
#pragma unroll
            for (int i = 0; i < 16; ++i) acc[i] = 0.f;
            const LAS bf16* kp = Ks + (32 * (qi + kj) + r) * KS_STRIDE + 8 * hh;
#pragma unroll
            for (int ks = 0; ks < 4; ++ks) { const bf16x8 kf = *(const LAS bf16x8*)(kp + 16 * ks); acc = MFMA32(kf, qf[ks], acc); }
            s[kj] = acc;
        }
        float mx = sink;
#pragma unroll
        for (int kj = 0; kj < 5; ++kj)
#pragma unroll
            for (int i = 0; i < 16; ++i) { const int kt = (i & 3) + 8 * (i >> 2) + 4 * hh; const int kbi = 32 * (qi + kj) + kt;
                bool valid = (n * 128 + kbi - 128) >= 0;
                if (kj == 0) valid = valid && (kt > r);
                if (kj == 4) valid = valid && (kt <= r);
                s[kj][i] = valid ? s[kj][i] : -INFINITY; mx = fmaxf(mx, s[kj][i]); }
        mx = fmaxf(mx, __shfl_xor(mx, 32));
        float l = 0.f;
#pragma unroll
        for (int kj = 0; kj < 5; ++kj)
#pragma unroll
            for (int i = 0; i < 16; ++i) { const float p = __expf(s[kj][i] - mx); s[kj][i] = p; l += p; }
        l += __shfl_xor(l, 32);
        l += __expf(sink - mx);
        const float inv = 1.0f / l;
        f32x16 o0, o1;
#pragma unroll
        for (int i = 0; i < 16; ++i) { o0[i] = 0.f; o1[i] = 0.f; }
#pragma unroll
        for (int kj = 0; kj < 5; ++kj)
#pragma unroll
            for (int st = 0; st < 2; ++st) {
                v4u pa; pa.x = pk2(s[kj][8 * st + 0] * inv, s[kj][8 * st + 1] * inv); pa.y = pk2(s[kj][8 * st + 2] * inv, s[kj][8 * st + 3] * inv);
                pa.z = pk2(s[kj][8 * st + 4] * inv, s[kj][8 * st + 5] * inv); pa.w = pk2(s[kj][8 * st + 6] * inv, s[kj][8 * st + 7] * inv);
                const bf16x8 pf = __builtin_bit_cast(bf16x8, pa);
                const int kb0 = 32 * (qi + kj) + 16 * st + 4 * hh;
                const LAS bf16* v0p = VT + r * VT_STRIDE + kb0; const LAS bf16* v1p = VT + (32 + r) * VT_STRIDE + kb0;
                const v2u a0 = *(const LAS v2u*)v0p, a1 = *(const LAS v2u*)(v0p + 8), b0 = *(const LAS v2u*)v1p, b1 = *(const LAS v2u*)(v1p + 8);
                const v4u vb0 = {a0.x, a0.y, a1.x, a1.y}, vb1 = {b0.x, b0.y, b1.x, b1.y};
                o0 = MFMA32(pf, __builtin_bit_cast(bf16x8, vb0), o0);
                o1 = MFMA32(pf, __builtin_bit_cast(bf16x8, vb1), o1);
            }
#pragma unroll
        for (int i = 0; i < 16; ++i) { const int qr = (i & 3) + 8 * (i >> 2) + 4 * hh; const int tok = n * 128 + 32 * qi + qr;
            bf16* op = P_XH(F) + (size_t)(b * SEQ + tok) * D + LRU_W + hq * HD + r;
            op[0] = (bf16)f2bf(o0[i]); op[32] = (bf16)f2bf(o1[i]); }
    }
    __syncthreads();
}

constexpr int LCH = 64;
constexpr int XC_STRIDE = 136;
constexpr int LRU_XCB_OFF = 0, LRU_XCF_OFF = LCH * XC_STRIDE * 2  , LRU_A_OFF = LRU_XCF_OFF + LCH * 128 * 4, LRU_B_OFF = LRU_A_OFF + LCH * 128 * 4, LRU_SE_OFF = LRU_B_OFF + LCH * 128 * 4;
static_assert(LRU_SE_OFF + 2 * 4 * 128 * 4 <= RING_BYTES, "LRU LDS");
__device__ __forceinline__ void lru_block(Frame& F) {
    LAS bf16* XCb = (LAS bf16*)(F.lds + LRU_XCB_OFF);
    LAS float* XCF = (LAS float*)(F.lds + LRU_XCF_OFF);
    LAS float* As = (LAS float*)(F.lds + LRU_A_OFF);
    LAS float* Bs = (LAS float*)(F.lds + LRU_B_OFF);
    LAS float* SEh = (LAS float*)(F.lds + LRU_SE_OFF);
    LAS float* SEp = SEh + 4 * 128;
    const int tid = F.tid, lane = F.lane;
    const int hd = F.bid & 7, li = F.bid >> 3, step = F.G >> 3;
    constexpr int NQ = BATCH * (SEQ / LCH);
    if (li >= NQ) return;
    const int cg = tid & 15, tp = tid >> 4, colc = hd * LRU_BLK + 8 * cg;
    float cw[4][8], cbv[8];
#pragma unroll
    for (int k = 0; k < 4; ++k) { const f32x4 a = *(const f32x4*)(P_conv_w(F) + k * LRU_W + colc), b2 = *(const f32x4*)(P_conv_w(F) + k * LRU_W + colc + 4);
        cw[k][0] = a.x; cw[k][1] = a.y; cw[k][2] = a.z; cw[k][3] = a.w; cw[k][4] = b2.x; cw[k][5] = b2.y; cw[k][6] = b2.z; cw[k][7] = b2.w; }
    { const f32x4 a = *(const f32x4*)(P_conv_b(F) + colc), b2 = *(const f32x4*)(P_conv_b(F) + colc + 4);
      cbv[0] = a.x; cbv[1] = a.y; cbv[2] = a.z; cbv[3] = a.w; cbv[4] = b2.x; cbv[5] = b2.y; cbv[6] = b2.z; cbv[7] = b2.w; }
    const int fr = lane & 15, fq = lane >> 4, j = 16 * F.wave + fr, jc = hd * LRU_BLK + j;
    bf16x8 wa[4], wx[4];
    { const bf16* wap = P_WGA(F) + (size_t)hd * 16384 + (size_t)j * 128 + 8 * fq; const bf16* wxp = P_WGX(F) + (size_t)hd * 16384 + (size_t)j * 128 + 8 * fq;
#pragma unroll
      for (int ks = 0; ks < 4; ++ks) { wa[ks] = *(const bf16x8*)(wap + 32 * ks); wx[ks] = *(const bf16x8*)(wxp + 32 * ks); } }
    const float ba = P_ga_b(F)[jc], bx = P_gx_b(F)[jc];
    const float sp8 = -8.0f * log1pf(__expf(-P_lam(F)[jc]));
    const int c = tid & 127, sub = tid >> 7, col = hd * LRU_BLK + c;
    const bf16* xbase = P_PROJ(F) + colc;
    bf16* HLp = P_HL(F); bf16* PAp = P_PA(F);
    v4u xr[5];
#define LRU_LOAD_X(q_) do { const int b_ = (q_) >> 6, ch_ = (q_) & 63; const int tr_ = ch_ * LCH + 2 * tp - 3; \
        _Pragma("unroll") for (int r_ = 0; r_ < 5; ++r_) { const int t_ = tr_ + r_; \
            xr[r_] = (t_ >= 0) ? *(const v4u*)(xbase + (size_t)(b_ * SEQ + t_) * MIX_IN) : (v4u){0u, 0u, 0u, 0u}; } } while (0)
    LRU_LOAD_X(li);
    for (int q = li; q < NQ; q += step) {
        const int b = q >> 6, ch = q & 63, t0 = ch * LCH;
        {
            float xv[5][8];
#pragma unroll
            for (int r = 0; r < 5; ++r) { xv[r][0] = bflo(xr[r].x); xv[r][1] = bfhi(xr[r].x); xv[r][2] = bflo(xr[r].y); xv[r][3] = bfhi(xr[r].y);
                xv[r][4] = bflo(xr[r].z); xv[r][5] = bfhi(xr[r].z); xv[r][6] = bflo(xr[r].w); xv[r][7] = bfhi(xr[r].w); }
            if (q + step < NQ) LRU_LOAD_X(q + step);
#pragma unroll
            for (int tk = 0; tk < 2; ++tk) { float xc[8];
#pragma unroll
                for (int e = 0; e < 8; ++e) xc[e] = cbv[e] + cw[0][e] * xv[tk][e] + cw[1][e] * xv[tk + 1][e] + cw[2][e] * xv[tk + 2][e] + cw[3][e] * xv[tk + 3][e];
                const int tl = 2 * tp + tk;
                v4u o; o.x = pk2(xc[0], xc[1]); o.y = pk2(xc[2], xc[3]); o.z = pk2(xc[4], xc[5]); o.w = pk2(xc[6], xc[7]);
                *(LAS v4u*)(XCb + tl * XC_STRIDE + 8 * cg) = o;
                *(LAS f32x4*)(XCF + tl * 128 + 8 * cg) = (f32x4){xc[0], xc[1], xc[2], xc[3]}; *(LAS f32x4*)(XCF + tl * 128 + 8 * cg + 4) = (f32x4){xc[4], xc[5], xc[6], xc[7]}; }
        }
        __syncthreads();
#pragma unroll
        for (int mt = 0; mt < 4; ++mt) {
            f32x4 ra = {0.f, 0.f, 0.f, 0.f}, rx = {0.f, 0.f, 0.f, 0.f};
            const LAS bf16* ap = XCb + (16 * mt + fr) * XC_STRIDE + 8 * fq;
#pragma unroll
            for (int ks = 0; ks < 4; ++ks) { const bf16x8 af = *(const LAS bf16x8*)(ap + 32 * ks); ra = MFMA16(af, wa[ks], ra); rx = MFMA16(af, wx[ks], rx); }
#pragma unroll
            for (int e = 0; e < 4; ++e) { const int tl = 16 * mt + 4 * fq + e;
                const float rg = sigmoidf_(ra[e] + ba), ig = sigmoidf_(rx[e] + bx);
                const float a = __expf(rg * sp8);
                const float mult = sqrtf(fmaxf(fmaf(-a, a, 1.0f), 0.f));
                As[tl * 128 + j] = a; Bs[tl * 128 + j] = mult * ig * XCF[tl * 128 + j]; }
        }
        __syncthreads();
        float hh[16], pp[16];
        {
            float h = 0.f, P = 1.f;
#pragma unroll
            for (int i = 0; i < 16; ++i) { const int tl = sub * 16 + i; const float a = As[tl * 128 + c], bq = Bs[tl * 128 + c];
                h = a * h + bq; P *= a; hh[i] = h; pp[i] = P; }
            SEh[sub * 128 + c] = h; SEp[sub * 128 + c] = P;
        }
        __syncthreads();
        {
            float carry = 0.f, pre = 1.f;
            for (int s2 = 0; s2 < sub; ++s2) { carry = SEh[s2 * 128 + c] + SEp[s2 * 128 + c] * carry; pre *= SEp[s2 * 128 + c]; }
            bf16* hl = HLp + (size_t)(b * SEQ + t0 + sub * 16) * LRU_W + col;
            bf16* pa = PAp + (size_t)(b * SEQ + t0 + sub * 16) * LRU_W + col;
#pragma unroll
            for (int i = 0; i < 16; ++i) { hl[(size_t)i * LRU_W] = (bf16)f2bf(hh[i] + pp[i] * carry); pa[(size_t)i * LRU_W] = (bf16)f2bf(pp[i] * pre); }
        }
    }
#undef LRU_LOAD_X
    __syncthreads();
}
constexpr int N_ATT_UNITS = BATCH * HKV * (SEQ / 128);
constexpr int N_LRU_UNITS = BATCH * LRU_HEADS * (SEQ / LCH);
__device__ __forceinline__ void p3_phase(Frame& F) {
    for (int u = F.bid; u < N_ATT_UNITS; u += F.G) attn_unit(F, u >> 6, (u >> 5) & 1, u & 31);
    lru_block(F);
}

__device__ __forceinline__ void p4_unit(Frame& F, int b, int ch) {
    LAS float* CAR = (LAS float*)F.lds;
    const int tid = F.tid, lane = F.lane;
    {
        f32x2 carry = {0.f, 0.f};
        const bf16* hlb = P_HL(F) + (size_t)(b * SEQ + LCH - 1) * LRU_W + 2 * tid; const bf16* pab = P_PA(F) + (size_t)(b * SEQ + LCH - 1) * LRU_W + 2 * tid;
        int c2 = 0;
        for (; c2 + 8 <= ch; c2 += 8) { unsigned hl[8], pa[8];
#pragma unroll
            for (int q = 0; q < 8; ++q) { hl[q] = *(const unsigned*)(hlb + (size_t)(c2 + q) * LCH * LRU_W); pa[q] = *(const unsigned*)(pab + (size_t)(c2 + q) * LCH * LRU_W); }
#pragma unroll
            for (int q = 0; q < 8; ++q) { carry.x = bflo(hl[q]) + bflo(pa[q]) * carry.x; carry.y = bfhi(hl[q]) + bfhi(pa[q]) * carry.y; } }
        for (; c2 < ch; ++c2) { const unsigned hl = *(const unsigned*)(hlb + (size_t)c2 * LCH * LRU_W), pa = *(const unsigned*)(pab + (size_t)c2 * LCH * LRU_W);
            carry.x = bflo(hl) + bflo(pa) * carry.x; carry.y = bfhi(hl) + bfhi(pa) * carry.y; }
        CAR[2 * tid] = carry.x; CAR[2 * tid + 1] = carry.y;
    }
    __syncthreads();
    const float* gl = P_on_lru_g(F); const float* ga = P_on_attn_g(F);
    for (int i = 0; i < 8; i += 2) {
        const size_t m0 = (size_t)b * SEQ + ch * LCH + F.wave * 8 + i;
        v2u hl[2][4], pa[2][4]; v2u yr[2][4], ar[2][4];
#pragma unroll
        for (int t = 0; t < 2; ++t)
#pragma unroll
            for (int j = 0; j < 4; ++j) { const int c = 4 * lane + 256 * j; const size_t m = m0 + t;
                hl[t][j] = *(const v2u*)(P_HL(F) + m * LRU_W + c); pa[t][j] = *(const v2u*)(P_PA(F) + m * LRU_W + c);
                yr[t][j] = *(const v2u*)(P_PROJ(F) + m * MIX_IN + C_Y + c); ar[t][j] = *(const v2u*)(P_XH(F) + m * D + LRU_W + c); }
        f32x4 vl[2][4], va[2][4]; float sl[2] = {0.f, 0.f}, sa[2] = {0.f, 0.f};
#pragma unroll
        for (int t = 0; t < 2; ++t)
#pragma unroll
            for (int j = 0; j < 4; ++j) { const int c = 4 * lane + 256 * j; const f32x4 car = *(const LAS f32x4*)(CAR + c);
                const f32x4 hlf = {bflo(hl[t][j].x), bfhi(hl[t][j].x), bflo(hl[t][j].y), bfhi(hl[t][j].y)}, paf = {bflo(pa[t][j].x), bfhi(pa[t][j].x), bflo(pa[t][j].y), bfhi(pa[t][j].y)};
                const f32x4 h = hlf + paf * car;
                f32x4 v; v.x = h.x * gelu_tanh(bflo(yr[t][j].x)); v.y = h.y * gelu_tanh(bfhi(yr[t][j].x)); v.z = h.z * gelu_tanh(bflo(yr[t][j].y)); v.w = h.w * gelu_tanh(bfhi(yr[t][j].y));
                vl[t][j] = v; sl[t] += (v.x * v.x + v.y * v.y) + (v.z * v.z + v.w * v.w);
                f32x4 a; a.x = bflo(ar[t][j].x); a.y = bfhi(ar[t][j].x); a.z = bflo(ar[t][j].y); a.w = bfhi(ar[t][j].y);
                va[t][j] = a; sa[t] += (a.x * a.x + a.y * a.y) + (a.z * a.z + a.w * a.w); }
#pragma unroll
        for (int o = 1; o < 64; o <<= 1) { sl[0] += __shfl_xor(sl[0], o); sl[1] += __shfl_xor(sl[1], o); sa[0] += __shfl_xor(sa[0], o); sa[1] += __shfl_xor(sa[1], o); }
#pragma unroll
        for (int t = 0; t < 2; ++t) { const float rl = 1.0f / sqrtf(sl[t] * (1.0f / LRU_W) + EPS), ra = 1.0f / sqrtf(sa[t] * (1.0f / LRU_W) + EPS); const size_t m = m0 + t;
#pragma unroll
            for (int j = 0; j < 4; ++j) { const int c = 4 * lane + 256 * j; const f32x4 g1v = *(const f32x4*)(gl + c), g2v = *(const f32x4*)(ga + c);
                const f32x4 y = vl[t][j] * rl * g1v, z = va[t][j] * ra * g2v;
                v2u o; o.x = pk2(y.x, y.y); o.y = pk2(y.z, y.w); *(v2u*)(P_XH(F) + m * D + c) = o;
                v2u p; p.x = pk2(z.x, z.y); p.y = pk2(z.z, z.w); *(v2u*)(P_XH(F) + m * D + LRU_W + c) = p; } }
    }
    __syncthreads();
}
__device__ __forceinline__ void p4_phase(Frame& F) {
    for (int u = F.bid; u < BATCH * (SEQ / LCH); u += F.G) p4_unit(F, u >> 6, u & 63);
}

__device__ __forceinline__ int f2key(float f) { const int b = __builtin_bit_cast(int, f); return b ^ ((b >> 31) & 0x7fffffff); }
__device__ __forceinline__ float key2f(int k) { const int b = k ^ ((k >> 31) & 0x7fffffff); return __builtin_bit_cast(float, b); }
__device__ __forceinline__ void ins16(int (&L)[16], int x) {
#pragma unroll
    for (int j = 0; j < 16; ++j) { const int hi = max(L[j], x); x = min(L[j], x); L[j] = hi; }
}
__device__ __forceinline__ void ce_desc(int& a, int& b) { const int hi = a > b ? a : b, lo = a > b ? b : a; a = hi; b = lo; }
__device__ __forceinline__ void sort16_desc(int (&a)[16]) {
#pragma unroll
    for (int k = 2; k <= 16; k <<= 1)
#pragma unroll
        for (int j = k >> 1; j > 0; j >>= 1)
#pragma unroll
            for (int i = 0; i < 16; ++i) { const int l = i ^ j; if (l > i) { if ((i & k) == 0) ce_desc(a[i], a[l]); else ce_desc(a[l], a[i]); } }
}
__device__ __forceinline__ void bitonic_merge16_desc(int (&a)[16]) {
#pragma unroll
    for (int j = 8; j > 0; j >>= 1)
#pragma unroll
        for (int i = 0; i < 16; ++i) { const int l = i ^ j; if (l > i) ce_desc(a[i], a[l]); }
}
__device__ __forceinline__ void merge_top16(int (&a)[16], const int (&b)[16]) {
#pragma unroll
    for (int i = 0; i < 16; ++i) a[i] = a[i] > b[15 - i] ? a[i] : b[15 - i];
    bitonic_merge16_desc(a);
}
constexpr int INT_LOWEST = (int)0x80000000;
__device__ __forceinline__ void p8_item(Frame& F, int tt, int hd, LAS int* lut  ) {
    const int lane = F.lane, r = lane & 31, hh = lane >> 5;
    const bf16* QP = P_PROJ(F);
    int V[2][16];
#pragma unroll
    for (int p = 0; p < 2; ++p) {
        bf16x8 qf[8];
        const char* qb = (const char*)(QP + (size_t)(32 * tt) * D + hd * 256 + p * 128);
        const unsigned qoff = (unsigned)(r * D + 8 * hh) * 2u;
#pragma unroll
        for (int ks = 0; ks < 8; ++ks) qf[ks] = *(const bf16x8*)(qb + qoff + 32 * ks);
        int L[16];
#pragma unroll
        for (int j = 0; j < 16; ++j) L[j] = INT_LOWEST;
        const char* skb = (const char*)(P_SK(F) + (size_t)((hd * 2 + p) * PKEYS) * PHALF);
        const unsigned skoff = (unsigned)(r * PHALF + 8 * hh) * 2u;
#pragma unroll 1
        for (int kt = 0; kt < 4; ++kt) {
            f32x16 acc;
#pragma unroll
            for (int i = 0; i < 16; ++i) acc[i] = 0.f;
            const char* skt = skb + (size_t)(32 * kt) * PHALF * 2;
#pragma unroll
            for (int ks = 0; ks < 8; ++ks) { const bf16x8 kf = *(const bf16x8*)(skt + skoff + 32 * ks); acc = MFMA32(kf, qf[ks], acc); }
            const int kbase = 32 * kt + 4 * hh;
            int T[16];
#pragma unroll
            for (int i = 0; i < 16; ++i) { const int kidx = (i & 3) + 8 * (i >> 2); T[i] = (f2key(acc[i]) & ~0x7f) | (kbase + kidx); }
            sort16_desc(T); merge_top16(L, T);
        }
        int O[16];
#pragma unroll
        for (int j = 0; j < 16; ++j) O[j] = __shfl_xor(L[j], 32);
        merge_top16(L, O);
#pragma unroll
        for (int j = 0; j < 16; ++j) V[p][j] = L[j];
    }
#pragma unroll
    for (int j = 0; j < 16; ++j) { lut[lane * 33 + j] = V[0][j] & 0x7f; lut[lane * 33 + 16 + j] = V[1][j] & 0x7f; }
    float v0[16], v1[16];
#pragma unroll
    for (int j = 0; j < 16; ++j) { v0[j] = key2f(V[0][j] & ~0x7f); v1[j] = key2f(V[1][j] & ~0x7f); }
    int C[16], G1[16], G2[16], G3[2];
    { int n = 0;
#pragma unroll
      for (int i = 0; i < 16; ++i)
#pragma unroll
        for (int j = 0; j < 16; ++j)
            if ((i + 1) * (j + 1) <= 16) { const int key = (f2key(v0[i] + v1[j]) & ~0xff) | (i * 16 + j);
                if (n < 16) C[n] = key; else if (n < 32) G1[n - 16] = key; else if (n < 48) G2[n - 32] = key; else G3[n - 48] = key;
                ++n; } }
    sort16_desc(C); sort16_desc(G1); sort16_desc(G2);
    merge_top16(C, G1); merge_top16(C, G2); ins16(C, G3[0]); ins16(C, G3[1]);
    float sv[16]; float den = 0.f;
    const float mx = key2f(C[0] & ~0xff);
#pragma unroll
    for (int e = 0; e < 16; ++e) { sv[e] = __expf(key2f(C[e] & ~0xff) - mx); den += sv[e]; }
    const float inv = 1.0f / den;
    LDS_WAIT(); asm volatile("" ::: "memory");
    int idx[16];
#pragma unroll
    for (int e = 0; e < 16; ++e) { const int pi = (C[e] >> 4) & 15, pj = C[e] & 15; idx[e] = lut[lane * 33 + pi] * PKEYS + lut[lane * 33 + 16 + pj]; }
    if (hh == 0) {
        unsigned short* ip = P_IDX(F) + (size_t)(32 * tt + r) * 128 + hd * 16; float* gp = P_GW(F) + (size_t)(32 * tt + r) * 128 + hd * 16;
#pragma unroll
        for (int q = 0; q < 2; ++q) *(v4u*)(ip + 8 * q) = (v4u){(unsigned)idx[8 * q] | ((unsigned)idx[8 * q + 1] << 16), (unsigned)idx[8 * q + 2] | ((unsigned)idx[8 * q + 3] << 16),
                                                              (unsigned)idx[8 * q + 4] | ((unsigned)idx[8 * q + 5] << 16), (unsigned)idx[8 * q + 6] | ((unsigned)idx[8 * q + 7] << 16)};
#pragma unroll
        for (int q = 0; q < 4; ++q) *(f32x4*)(gp + 4 * q) = (f32x4){sv[4 * q] * inv, sv[4 * q + 1] * inv, sv[4 * q + 2] * inv, sv[4 * q + 3] * inv};
    }
    LDS_WAIT(); asm volatile("" ::: "memory");
}
__device__ __forceinline__ void p8_phase(Frame& F) {
    LAS int* lut = (LAS int*)(F.lds + F.wave * (64 * 33 * 4));
    const int gw = F.bid * NWAVES + F.wave, NGW = F.G * NWAVES;
    for (int it = gw; it < (M / 32) * PH; it += NGW) p8_item(F, it >> 3, it & 7, lut);
}

template <int CTRL> __device__ __forceinline__ float dpp_f(float x) { return __builtin_bit_cast(float, __builtin_amdgcn_mov_dpp(__builtin_bit_cast(int, x), CTRL, 0xf, 0xf, true)); }
__device__ __forceinline__ float sum8(float v) {
    v += dpp_f<0xB1>(v);
    v += dpp_f<0x4E>(v);
    v += dpp_f<0x141>(v);
    return v;
}
__device__ __forceinline__ void dec16(const v4u r, float (&f)[16]) {
    const unsigned w4[4] = {r.x, r.y, r.z, r.w};
#pragma unroll
    for (int w = 0; w < 4; ++w) { const f32x2 lo = __builtin_amdgcn_cvt_pk_f32_fp8((int)w4[w], false), hi = __builtin_amdgcn_cvt_pk_f32_fp8((int)w4[w], true);
        f[4 * w] = lo.x; f[4 * w + 1] = lo.y; f[4 * w + 2] = hi.x; f[4 * w + 3] = hi.y; }
}
__device__ __forceinline__ void row_offsets(const v4u a, const v4u b, unsigned loff, unsigned (&off)[16]) {
    const unsigned w[8] = {a.x, a.y, a.z, a.w, b.x, b.y, b.z, b.w};
#pragma unroll
    for (int q = 0; q < 8; ++q) { off[2 * q] = ((w[q] & 0xffffu) << 7) + loff; off[2 * q + 1] = ((w[q] >> 16) << 7) + loff; }
}
#define ISSUE_ROWS(dst, TBL, ia, ib) do { unsigned off_[16]; row_offsets((ia), (ib), loff, off_); \
    _Pragma("unroll") for (int i_ = 0; i_ < 16; ++i_) dst[i_] = *(const v4u*)((TBL) + off_[i_]); } while (0)

typedef int i32x8 __attribute__((ext_vector_type(8)));
#define MFMA_F4F8(a, b, c) __builtin_amdgcn_mfma_scale_f32_16x16x128_f8f6f4((a), (b), (c), 4  , 0  , 0, 0x7f7f7f7f, 0, 0x7f7f7f7f)
#define ISSUE_ROWS_U(dst, i0, i1) do { const unsigned w_[8] = {(i0).x, (i0).y, (i0).z, (i0).w, (i1).x, (i1).y, (i1).z, (i1).w}; \
    _Pragma("unroll") for (int g_ = 0; g_ < 16; ++g_) { const unsigned id_ = (g_ & 1) ? (w_[g_ >> 1] >> 16) : (w_[g_ >> 1] & 0xffffu); \
        dst[g_] = *(const v4u*)(U4 + ((id_ << 7) + loff)); } } while (0)
__device__ __forceinline__ void p9u_compute(const v4u (&row)[16], const v4u hA0, const v4u hA1, const v4u hB0, const v4u hB1, int lane, bf16* dst) {
    const i32x8 B0 = {(int)hA0.x, (int)hA0.y, (int)hA0.z, (int)hA0.w, (int)hA1.x, (int)hA1.y, (int)hA1.z, (int)hA1.w};
    const i32x8 B1 = {(int)hB0.x, (int)hB0.y, (int)hB0.z, (int)hB0.w, (int)hB1.x, (int)hB1.y, (int)hB1.z, (int)hB1.w};
    const int n = lane & 15, q = lane >> 4, e4 = n >> 2;
    const f32x4 zero = {0.f, 0.f, 0.f, 0.f};
    float res[16];
#pragma unroll
    for (int g = 0; g < 16; ++g) {
        const i32x8 a = {(int)row[g].x, (int)row[g].y, (int)row[g].z, (int)row[g].w, 0, 0, 0, 0};
        const f32x4 d0 = MFMA_F4F8(a, B0, zero), d1 = MFMA_F4F8(a, B1, zero);
        float v0 = d0[0]; v0 = e4 == 1 ? d0[1] : v0; v0 = e4 == 2 ? d0[2] : v0; v0 = e4 == 3 ? d0[3] : v0;
        float v1 = d1[0]; v1 = e4 == 1 ? d1[1] : v1; v1 = e4 == 2 ? d1[2] : v1; v1 = e4 == 3 ? d1[3] : v1;
        float val = (q & 1) ? v1 : v0;
        val = val + dpp_f<0x124>(val) + dpp_f<0x128>(val) + dpp_f<0x12C>(val);
        val += __shfl_xor(val, 16);
        res[g] = val;
    }
    if ((lane & 0x1c) == 0) {
        bf16* d = dst + 16 * (2 * (n & 3) + (q >> 1));
        v4u o0, o1;
        o0.x = pk2(res[0], res[1]); o0.y = pk2(res[2], res[3]); o0.z = pk2(res[4], res[5]); o0.w = pk2(res[6], res[7]);
        o1.x = pk2(res[8], res[9]); o1.y = pk2(res[10], res[11]); o1.z = pk2(res[12], res[13]); o1.w = pk2(res[14], res[15]);
        *(v4u*)d = o0; *(v4u*)(d + 8) = o1;
    }
}
__device__ __forceinline__ void p9u_item(Frame& F, int s, int tb) {
    const int lane = F.lane, sg = lane & 7, r8 = lane >> 3, n = lane & 15, kq = lane >> 4;
    const unsigned char* U4 = P_U(F);
    const unsigned loff = (unsigned)(s * (NEXP * 128) + 16 * sg);
    const unsigned short* idxb = P_IDX(F) + (size_t)(64 * tb) * 128 + 16 * r8;
    const unsigned char* hb = P_H8(F) + (size_t)(64 * tb) * D + 256 * s + 32 * (n >> 2) + 16 * (kq & 1);
    const bool bon = (kq >> 1) == (n & 1); const bool bhi = (n & 2) != 0;
    bf16* pb = (bf16*)P_PART(F) + ((size_t)s * M + 64 * tb) * 128;
#define LOAD_META_U(I0, I1, A0, A1, B0, B1, tt_) do { const int tn_ = (tt_) < 64 ? (tt_) : 63; const unsigned short* ip_ = idxb + (size_t)tn_ * 128; I0 = *(const v4u*)(ip_); I1 = *(const v4u*)(ip_ + 8); \
        const unsigned char* hp_ = hb + (size_t)tn_ * D; const v4u z_ = {0u, 0u, 0u, 0u}; \
        const v4u x0_ = bon ? *(const v4u*)(hp_) : z_, x1_ = bon ? *(const v4u*)(hp_ + 128) : z_; \
        A0 = bhi ? z_ : x0_; A1 = bhi ? x0_ : z_; B0 = bhi ? z_ : x1_; B1 = bhi ? x1_ : z_; } while (0)
    v4u aI0, aI1, aA0, aA1, aB0, aB1, bI0, bI1, bA0, bA1, bB0, bB1, cI0, cI1, cA0, cA1, cB0, cB1, dI0, dI1, dA0, dA1, dB0, dB1;
    LOAD_META_U(aI0, aI1, aA0, aA1, aB0, aB1, 0); LOAD_META_U(bI0, bI1, bA0, bA1, bB0, bB1, 1); LOAD_META_U(cI0, cI1, cA0, cA1, cB0, cB1, 2);
    v4u rowA[16], rowB[16];
    ISSUE_ROWS_U(rowA, aI0, aI1); ISSUE_ROWS_U(rowB, bI0, bI1);
#pragma unroll 1
    for (int t = 0; t < 64; t += 2) {
        p9u_compute(rowA, aA0, aA1, aB0, aB1, lane, pb + (size_t)t * 128);
        LOAD_META_U(dI0, dI1, dA0, dA1, dB0, dB1, t + 3);
        ISSUE_ROWS_U(rowA, cI0, cI1);
        p9u_compute(rowB, bA0, bA1, bB0, bB1, lane, pb + (size_t)(t + 1) * 128);
        aA0 = cA0; aA1 = cA1; aB0 = cB0; aB1 = cB1; bA0 = dA0; bA1 = dA1; bB0 = dB0; bB1 = dB1;
        LOAD_META_U(cI0, cI1, cA0, cA1, cB0, cB1, t + 4);
        ISSUE_ROWS_U(rowB, dI0, dI1);
    }
#undef LOAD_META_U
}
#define MFMA_F8F4(a, b, c) __builtin_amdgcn_mfma_scale_f32_16x16x128_f8f6f4((a), (b), (c), 0  , 4  , 0, 0x7f7f7f7f, 0, 0x7f7f7f7f)
#define ISSUE_ROWS_V(dst, i0, i1) do { const unsigned w_[8] = {(i0).x, (i0).y, (i0).z, (i0).w, (i1).x, (i1).y, (i1).z, (i1).w}; \
    _Pragma("unroll") for (int g_ = 0; g_ < 16; ++g_) { const unsigned id_ = (g_ & 1) ? (w_[g_ >> 1] >> 16) : (w_[g_ >> 1] & 0xffffu); \
        dst[g_] = *(const v4u*)(V4 + ((id_ << 7) + loff)); } } while (0)
struct VLane { unsigned shl, m00, m01, m10, m11; };
__device__ __forceinline__ void p9v_compute(const v4u (&row)[16], const v4u wlo, const v4u whi, int lane, const VLane L, const bf16* xp, const f32x4 (&g2)[4], float wscale, float* dst) {
    v2u x1[4];
#pragma unroll
    for (int t = 0; t < 4; ++t) x1[t] = *(const v2u*)(xp + 8 * t);
    f32x4 d[4];
#pragma unroll
    for (int t = 0; t < 4; ++t) d[t] = (f32x4){0.f, 0.f, 0.f, 0.f};
    const unsigned wl4[4] = {wlo.x, wlo.y, wlo.z, wlo.w}, wh4[4] = {whi.x, whi.y, whi.z, whi.w};
    i32x8 a0 = {0, 0, 0, 0, 0, 0, 0, 0}, a1 = a0, a2 = a0, a3 = a0;
#pragma unroll
    for (int g = 0; g < 16; ++g) {
        const unsigned lo = ((wl4[g >> 2] >> (8 * (g & 3))) & 0xffu) << L.shl, hi = ((wh4[g >> 2] >> (8 * (g & 3))) & 0xffu) << L.shl;
        const int l00 = (int)(lo & L.m00), l01 = (int)(lo & L.m01), h00 = (int)(hi & L.m00), h01 = (int)(hi & L.m01);
        const int l10 = (int)(lo & L.m10), l11 = (int)(lo & L.m11), h10 = (int)(hi & L.m10), h11 = (int)(hi & L.m11);
        const i32x8 b = {(int)row[g].x, (int)row[g].y, (int)row[g].z, (int)row[g].w, 0, 0, 0, 0};
        a0[0] = l00; a0[1] = l01; a0[4] = h00; a0[5] = h01;   a1[2] = l00; a1[3] = l01; a1[6] = h00; a1[7] = h01;
        a2[0] = l10; a2[1] = l11; a2[4] = h10; a2[5] = h11;   a3[2] = l10; a3[3] = l11; a3[6] = h10; a3[7] = h11;
        d[0] = MFMA_F8F4(a0, b, d[0]); d[1] = MFMA_F8F4(a1, b, d[1]); d[2] = MFMA_F8F4(a2, b, d[2]); d[3] = MFMA_F8F4(a3, b, d[3]);
    }
#pragma unroll
    for (int t = 0; t < 4; ++t)
#pragma unroll
        for (int e = 0; e < 4; ++e) d[t][e] += __shfl_xor(d[t][e], 40);
    if ((lane & 40) == 0) {
#pragma unroll
        for (int t = 0; t < 4; ++t) { const f32x4 xv = {bflo(x1[t].x), bfhi(x1[t].x), bflo(x1[t].y), bfhi(x1[t].y)};
            *(f32x4*)(dst + 8 * t) = xv + g2[t] * (d[t] * wscale); }
    }
}
__device__ __forceinline__ void p9v_item(Frame& F, int s, int tb) {
    const int lane = F.lane, sg = lane & 7, r8 = lane >> 3;
    const unsigned char* V4 = P_V(F);
    const unsigned loff = (unsigned)(s * (NEXP * 128) + 16 * sg);
    const unsigned short* idxb = P_IDX(F) + (size_t)(64 * tb) * 128 + 16 * r8;
    const int ai = lane & 15, kqa = lane >> 4;
    VLane L; L.shl = 8u * (unsigned)(ai & 3);
    { const bool d1 = (ai & 4) != 0, hiv = (kqa & 1) != 0;
      L.m00 = (!hiv && !d1) ? 0xffffffffu : 0u; L.m01 = (!hiv && d1) ? 0xffffffffu : 0u; L.m10 = (hiv && !d1) ? 0xffffffffu : 0u; L.m11 = (hiv && d1) ? 0xffffffffu : 0u; }
    const unsigned char* wbl = P_W(F) + (size_t)(64 * tb) * 128 + 16 * (2 * (kqa >> 1) + (ai >> 3));
    const unsigned char* wbh = wbl + 64;
    const float* wscp = P_WSC(F) + 64 * tb;
    const int b = (64 * tb) / SEQ;
    const int ocol = 256 * s + 32 * (lane & 7) + 4 * ((lane >> 4) & 1);
    f32x4 g2[4];
#pragma unroll
    for (int t = 0; t < 4; ++t) g2[t] = *(const f32x4*)(P_ADA(F) + (size_t)b * ADA_W + 5 * D + ocol + 8 * t);
    float* ob = P_out(F) + (size_t)(64 * tb) * D + ocol;
    const bf16* xb = P_X1B(F) + (size_t)(64 * tb) * D + ocol;
#define LOAD_META_V(I0, I1, WL, WH, WS, tt_) do { const int tn_ = (tt_) < 64 ? (tt_) : 63; const unsigned short* ip_ = idxb + (size_t)tn_ * 128; I0 = *(const v4u*)(ip_); I1 = *(const v4u*)(ip_ + 8); \
        WL = *(const v4u*)(wbl + (size_t)tn_ * 128); WH = *(const v4u*)(wbh + (size_t)tn_ * 128); WS = wscp[tn_]; } while (0)
    v4u aI0, aI1, aWL, aWH, bI0, bI1, bWL, bWH, cI0, cI1, cWL, cWH, dI0, dI1, dWL, dWH; float aS, bS, cS, dS;
    LOAD_META_V(aI0, aI1, aWL, aWH, aS, 0); LOAD_META_V(bI0, bI1, bWL, bWH, bS, 1); LOAD_META_V(cI0, cI1, cWL, cWH, cS, 2);
    v4u rowA[16], rowB[16];
    ISSUE_ROWS_V(rowA, aI0, aI1); ISSUE_ROWS_V(rowB, bI0, bI1);
#pragma unroll 1
    for (int t = 0; t < 64; t += 2) {
        p9v_compute(rowA, aWL, aWH, lane, L, xb + (size_t)t * D, g2, aS, ob + (size_t)t * D);
        LOAD_META_V(dI0, dI1, dWL, dWH, dS, t + 3);
        ISSUE_ROWS_V(rowA, cI0, cI1);
        p9v_compute(rowB, bWL, bWH, lane, L, xb + (size_t)(t + 1) * D, g2, bS, ob + (size_t)(t + 1) * D);
        aWL = cWL; aWH = cWH; aS = cS; bWL = dWL; bWH = dWH; bS = dS;
        LOAD_META_V(cI0, cI1, cWL, cWH, cS, t + 4);
        ISSUE_ROWS_V(rowB, dI0, dI1);
    }
#undef LOAD_META_V
}
__device__ __forceinline__ void p9u_phase(Frame& F) {
    const int x = F.bid & 7, rank = F.bid >> 3, nr = F.G >> 3;
    for (int tb = rank * NWAVES + F.wave; tb < M / 64; tb += nr * NWAVES) p9u_item(F, x, tb);
}
__device__ __forceinline__ void p9v_phase(Frame& F) {
    const int x = F.bid & 7, rank = F.bid >> 3, nr = F.G >> 3;
    for (int tb = rank * NWAVES + F.wave; tb < M / 64; tb += nr * NWAVES) p9v_item(F, x, tb);
}
__device__ __forceinline__ void p9w_phase(Frame& F) {
    const unsigned* part = P_PART(F); const unsigned short* idxp = P_IDX(F); const float* gwp = P_GW(F); const float* usc = P_USC(F); const float* vsc = P_VSC(F);
    unsigned char* wp = P_W(F); float* wsc = P_WSC(F);
    for (int it = F.bid * 512 + F.tid; it < M * 64; it += F.G * 512) {
        float a0 = 0.f, a1 = 0.f;
#pragma unroll
        for (int s = 0; s < 8; ++s) { const unsigned w = part[(size_t)s * M * 64 + it]; a0 += bflo(w); a1 += bfhi(w); }
        const int m = it >> 6; const size_t p0 = 2 * (size_t)it;
        const unsigned iw = *(const unsigned*)(idxp + p0); const int i0 = iw & 0xffffu, i1 = iw >> 16;
        const f32x2 gw = *(const f32x2*)(gwp + p0);
        const float w0 = gw.x * gelu_tanh(a0 * usc[i0]) * vsc[i0], w1 = gw.y * gelu_tanh(a1 * usc[i1]) * vsc[i1];
        float mx = fmaxf(fabsf(w0), fabsf(w1));
#pragma unroll
        for (int o = 1; o < 64; o <<= 1) mx = fmaxf(mx, __shfl_xor(mx, o));
        const float sc = 224.0f / fmaxf(mx, 1e-30f);
        const int t = __builtin_amdgcn_cvt_pk_fp8_f32(w0 * sc, w1 * sc, 0, false);
        *(unsigned short*)(wp + p0) = (unsigned short)(t & 0xffff);
        if ((it & 63) == 0) wsc[m] = fmaxf(mx, 1e-30f) * (1.0f / 224.0f);
    }
}

struct Args { const void* in[25]; float* out; unsigned char* ws; int ph_lo, ph_hi; };
__global__ void __launch_bounds__(NWAVES * 64, 2) hymba_fwd(Args args) {
    extern __shared__ __attribute__((aligned(16))) unsigned char lds_raw[];
    Frame F;
    F.lds = (LAS unsigned char*)lds_raw;
    F.tid = threadIdx.x; F.lane = F.tid & 63; F.wave = __builtin_amdgcn_readfirstlane(F.tid >> 6);
    F.G = gridDim.x; F.bid = blockIdx.x;
    F.ka = (kaptr_t)__builtin_amdgcn_kernarg_segment_ptr();
    static_assert(sizeof(Args) == 224, "kernarg byte offsets used by ka_ptr");
    for (int u = F.tid; u < (LDS_BYTES - LDSCTL_OFF) / 4; u += NWAVES * 64) ((LAS unsigned*)(F.lds + LDSCTL_OFF))[u] = 0u;
    __syncthreads();
    volatile LAS unsigned* MISC = (volatile LAS unsigned*)(F.lds + MISC_OFF);
    XcdBarrier bar; bar.bar = (unsigned*)(P_ws(F) + WS_CTL) + CW_BAR; bar.x = 0; bar.st = nullptr;
    const int lo = args.ph_lo, hi = args.ph_hi;
    if (hi - lo > 1) bar = xcd_barrier_post((unsigned*)(P_ws(F) + WS_CTL) + CW_BAR, MISC + 8);
#define IN(k) (lo <= (k) && (k) < hi)
#define STAMP(k) do { if (PROBE_STAMP >= 0 && F.bid == 0 && F.tid == 0) ((unsigned long long*)(P_ws(F) + WS_CTL + 64))[(k)] = __builtin_amdgcn_s_memrealtime(); } while (0)
#define SEAM(k) do { STAMP(16 + (k)); if (IN(k) && IN((k) + 1)) xcd_barrier(bar); STAMP((k) + 1); } while (0)
    STAMP(0);

#ifndef PROBE_MASK
#define PROBE_MASK 0
#endif
#define REP(k) for (int rep_ = 0; rep_ < (((PROBE_MASK >> (k)) & 1) ? 2 : 1); ++rep_)
#define REPSYNC(k) do { if (((PROBE_MASK >> (k)) & 1) && rep_ == 0) xcd_barrier(bar); } while (0)
    if (IN(0)) { REP(0) { p0_prologue(F); REPSYNC(0); } } SEAM(0);
    if (IN(1)) { REP(1) { p1_phase(F); REPSYNC(1); } } SEAM(1);
    if (IN(2)) REP(2) {
        pg8::Gemm g{P_XH(F), P_WIN(F), M, MIX_IN, D}; pg8::StaticOrder S; S.init(M, MIX_IN, F.G, F.bid);
        pg8::EpiStoreBf16 E{P_PROJ(F), MIX_IN};
        pg8::gemm_phase<pg8::EpiStoreBf16, pg8::StaticOrder, false, true>(F.lds, g, S, E); REPSYNC(2);
        { const int nwg = (M / 256) * (MIX_IN / 256), busy = nwg % F.G;
          if (busy > 0 && F.bid >= busy) quant_rows(F, QUANT_SPLIT, 2 * NEXP, (F.bid - busy) * NWAVES + F.wave, (F.G - busy) * NWAVES);
          else if (busy == 0) quant_rows(F, QUANT_SPLIT, 2 * NEXP, F.bid * NWAVES + F.wave, F.G * NWAVES); }
    } SEAM(2);
    if (IN(3)) { p3_phase(F); } SEAM(3);
    if (IN(4)) { p4_phase(F); } SEAM(4);
    if (IN(5)) REP(5) {
        pg8::Gemm g{P_XH(F), P_WOUT(F), M, D, D}; pg8::StaticOrder S; S.init(M, D, F.G, F.bid);
        pg8::EpiGateBf16 E{P_X1B(F), D, P_ADA(F) + 2 * D, ADA_W, SEQ};
        pg8::gemm_phase<pg8::EpiGateBf16, pg8::StaticOrder, false, true>(F.lds, g, S, E); REPSYNC(5);
    } SEAM(5);
    if (IN(6)) { REP(6) { p6_phase(F); REPSYNC(6); } } SEAM(6);
    if (IN(7)) REP(7) {
        pg8::Gemm g{P_XH(F), P_WQ(F), M, D, D}; pg8::StaticOrder S; S.init(M, D, F.G, F.bid);
        pg8::EpiStoreBf16 E{P_PROJ(F), D};
        pg8::gemm_phase<pg8::EpiStoreBf16, pg8::StaticOrder, false, true>(F.lds, g, S, E); REPSYNC(7);
    } SEAM(7);
    if (IN(8)) { REP(8) { p8_phase(F); REPSYNC(8); } } SEAM(8);
#ifdef PROBE_MFMA4
    if (F.bid == 0 && F.wave == 0) {
        const int l_ = F.lane, i_ = l_ & 15, kq_ = l_ >> 4; (void)i_; (void)kq_;
        i32x8 a_ = {0, 0, 0, 0, 0, 0, 0, 0}, b_ = {0, 0, 0, 0, 0, 0, 0, 0};
        PROBE_MFMA4;
        const f32x4 z_ = {0.f, 0.f, 0.f, 0.f};
#ifdef PROBE_SWAPFMT
        const f32x4 d_ = __builtin_amdgcn_mfma_scale_f32_16x16x128_f8f6f4(a_, b_, z_, 0  , 4  , 0, 0x7f7f7f7f, 0, 0x7f7f7f7f);
#else
        const f32x4 d_ = MFMA_F4F8(a_, b_, z_);
#endif
        float* pr_ = (float*)(P_ws(F) + WS_CTL + 40960);
        pr_[l_ * 4 + 0] = d_[0]; pr_[l_ * 4 + 1] = d_[1]; pr_[l_ * 4 + 2] = d_[2]; pr_[l_ * 4 + 3] = d_[3];
    }
#endif
    if (IN(9)) { p9u_phase(F); }
    if (PROBE_STAMP >= 0 && F.tid == 0) ((unsigned long long*)(P_ws(F) + WS_CTL + 32768))[F.bid] = __builtin_amdgcn_s_memrealtime();
    SEAM(9);
    if (IN(10)) { p9w_phase(F); } SEAM(10);
    if (IN(11)) { p9v_phase(F); }
    if (PROBE_STAMP >= 0) {
        __syncthreads(); STAMP(12); VM_WAIT(); __syncthreads();
        if (F.bid == 0 && F.tid == 0) { const unsigned long long* ts = (const unsigned long long*)(P_ws(F) + WS_CTL + 64);
            float us = (float)(ts[PROBE_STAMP + 1] - ts[PROBE_STAMP]) * 0.01f;
#ifdef PROBE_BLOCKSTAT
            { const unsigned long long* bt = (const unsigned long long*)(P_ws(F) + WS_CTL + 32768); float acc_ = 0.f;
              for (int b_ = 0; b_ < (int)gridDim.x; ++b_) { const float d_ = (float)(bt[b_] - ts[9]) * 0.01f; PROBE_BLOCKSTAT; } us = acc_; }
#endif
#ifdef PROBE_MFMA4
            { const float* pr_ = (const float*)(P_ws(F) + WS_CTL + 40960); float acc_ = 0.f; PROBE_MFMA4_READ; us = acc_; }
#endif
            P_out(F)[0] += us * (1.0f / PROBE_DIV); }
    }
#undef IN
#undef SEAM
}

extern "C" void kernel_launch(void* const* d_in, const int* in_sizes, int n_in, void* d_out, int out_size, void* d_ws, size_t ws_size, hipStream_t stream) {
    static int grid = 0;
    if (grid == 0) {
        if (n_in != 25 || in_sizes[0] != M * D || out_size != M * D || ws_size < WS_END) {
            fprintf(stderr, "kernel_launch: built for 25 inputs, x/out of %d floats, >= %zu bytes of workspace; got n_in %d, in0 %d, out %d, ws %zu; nothing launched\n", M * D, (size_t)WS_END, n_in, n_in > 0 ? in_sizes[0] : -1, out_size, ws_size);
            grid = -1; return; }
        int dev = 0, cus = 0, per_cu = 0;
        if (hipGetDevice(&dev) != hipSuccess || hipDeviceGetAttribute(&cus, hipDeviceAttributeMultiprocessorCount, dev) != hipSuccess) { fprintf(stderr, "kernel_launch: device query failed\n"); grid = -1; return; }
        if (hipFuncSetAttribute((const void*)hymba_fwd, hipFuncAttributeMaxDynamicSharedMemorySize, LDS_BYTES) != hipSuccess) { fprintf(stderr, "kernel_launch: hipFuncSetAttribute failed\n"); grid = -1; return; }
        if (hipOccupancyMaxActiveBlocksPerMultiprocessor(&per_cu, (const void*)hymba_fwd, NWAVES * 64, LDS_BYTES) != hipSuccess || per_cu < 1) {
            fprintf(stderr, "kernel_launch: occupancy query reports %d workgroups per CU; need 1\n", per_cu); (void)hipGetLastError(); grid = -1; return; }
        grid = cus;
        if (grid % 8 != 0 || (M / 64) % (grid / 8 * NWAVES) != 0) { fprintf(stderr, "kernel_launch: grid %d not supported (needs a multiple of 8 dividing the token blocks)\n", grid); grid = -1; return; }
    }
    if (grid < 0) return;
    if (hipMemsetAsync((char*)d_ws + WS_CTL, 0, CTL_ZERO_BYTES, stream) != hipSuccess) { fprintf(stderr, "kernel_launch: memset failed\n"); return; }
    Args a{};
    for (int i = 0; i < 25; ++i) a.in[i] = d_in[i];
    a.out = (float*)d_out; a.ws = (unsigned char*)d_ws;
    if (N_LAUNCHES == 1) {
        a.ph_lo = 0; a.ph_hi = N_PHASES;
        void* kargs[] = {&a};
        const hipError_t le = hipLaunchCooperativeKernel((const void*)hymba_fwd, dim3(grid), dim3(NWAVES * 64), kargs, LDS_BYTES, stream);
        if (le != hipSuccess) fprintf(stderr, "kernel_launch: cooperative launch failed: %s (grid %d)\n", hipGetErrorName(le), grid);
    } else {
#ifndef PROBE_TWICE
#define PROBE_TWICE 0
#endif
        for (int li = 0; li < N_PHASES; ++li) { a.ph_lo = li; a.ph_hi = li + 1;
            if ((PROBE_TWICE >> li) & 1) hipLaunchKernelGGL(hymba_fwd, dim3(grid), dim3(NWAVES * 64), LDS_BYTES, stream, a);
            hipLaunchKernelGGL(hymba_fwd, dim3(grid), dim3(NWAVES * 64), LDS_BYTES, stream, a);
            const hipError_t le = hipPeekAtLastError();
            if (le != hipSuccess) { fprintf(stderr, "kernel_launch: launch %d failed: %s\n", li, hipGetErrorName(le)); break; } }
    }
}
```

```cpp
#include <hip/hip_runtime.h>
#include <cstdio>
#include <cstdint>
namespace pg8 {
#define PG8_LAS __attribute__((address_space(3)))
typedef unsigned short bf16_t;
typedef short bf16x8 __attribute__((ext_vector_type(8)));
typedef float f32x4 __attribute__((ext_vector_type(4)));
typedef unsigned u32x4 __attribute__((ext_vector_type(4)));
constexpr int BM = 256, BK = 64, HALF = 128, HTB = HALF * BK * 2  , STAGE_BYTES = 8 * HTB, NXCD = 8, WGM = 8;

__host__ __device__ __forceinline__ int lds_byte(int r, int c) { const int st = (r >> 4) * 2 + (c >> 5), rr = r & 15, cc = c & 31, ob = rr * 64 + cc * 2; return st * 1024 + (ob ^ (((ob >> 9) & 1) << 5)); }
__host__ __device__ __forceinline__ void stage_rc(int b, int& R, int& C) { const int st = b / 1024, sb = b % 1024, swz = sb ^ (((sb >> 9) & 1) << 5); R = (st >> 1) * 16 + swz / 64; C = (st & 1) * 32 + (swz % 64) / 2; }
__host__ __device__ __forceinline__ int perm32(int rho) { const int n = rho >> 4, i = rho & 15; return 8 * (i >> 2) + 4 * n + (i & 3); }

struct Unit { int pm, pn; };
struct Gemm { const bf16_t* A; const bf16_t* Bt; int M, N, K; };

struct StaticOrder {
    int nM, nN, nwg, G, c;
    __host__ __device__ void init(int M, int N, int G_, int c_) { nM = M / BM; nN = N / BM; nwg = nM * nN; G = G_; c = c_; }
    __host__ __device__ bool next(int i, Unit& u) const {
        const long L = (long)i * G + c; if (L >= nwg) return false;
        int wgid = (int)L; { const int q = nwg / NXCD, r = nwg % NXCD, xcd = wgid % NXCD, off = wgid / NXCD; wgid = (xcd < r ? xcd * (q + 1) : r * (q + 1) + (xcd - r) * q) + off; }
        const int nig = WGM * nN, gid = wgid / nig, fm = gid * WGM, gsz = (nM - fm) < WGM ? (nM - fm) : WGM;
        u.pm = fm + ((wgid % nig) % gsz); u.pn = (wgid % nig) / gsz; return true;
    }
    __device__ __forceinline__ void a_ready(const Unit&) const {}
    __device__ __forceinline__ void done(const Unit&) const {}
};

__device__ __forceinline__ unsigned cvt_pk_bf16(float lo, float hi) { unsigned r; asm volatile("v_cvt_pk_bf16_f32 %0, %1, %2" : "=v"(r) : "v"(lo), "v"(hi)); return r; }
struct EpiStoreBf16 {
    static constexpr bool PERM = true, AFTER_DRAIN = false;
    bf16_t* O; int ldc;
    __device__ __forceinline__ void operator()(const f32x4 (&acc)[2][2][4][2], const Unit& u, int wr, int wc, int fr, int fq) const {
        const int row0 = u.pm * BM + wr * 64 + fr; const int col0 = u.pn * BM + wc * 32 + 8 * fq;
#pragma unroll
        for (int ai = 0; ai < 2; ++ai)
#pragma unroll
            for (int m = 0; m < 4; ++m) { bf16_t* rowp = O + (size_t)(row0 + ai * HALF + m * 16) * ldc + col0;
#pragma unroll
                for (int bj = 0; bj < 2; ++bj) { const f32x4 v0 = acc[ai][bj][m][0], v1 = acc[ai][bj][m][1];
                    u32x4 w; w.x = cvt_pk_bf16(v0[0], v0[1]); w.y = cvt_pk_bf16(v0[2], v0[3]); w.z = cvt_pk_bf16(v1[0], v1[1]); w.w = cvt_pk_bf16(v1[2], v1[3]);
                    *(u32x4*)(rowp + bj * HALF) = w; } }
    }
};
struct EpiGateBf16 {
    static constexpr bool PERM = true, AFTER_DRAIN = false;
    bf16_t* out; int ldc; const float* gate; int gstride; int rows_per_batch;
    __device__ __forceinline__ void operator()(const f32x4 (&acc)[2][2][4][2], const Unit& u, int wr, int wc, int fr, int fq) const {
        const int b = (u.pm * BM) / rows_per_batch; const float* g = gate + (size_t)b * gstride;
        const int col0 = u.pn * BM + wc * 32 + 8 * fq;
        f32x4 gv[2][2];
#pragma unroll
        for (int bj = 0; bj < 2; ++bj)
#pragma unroll
            for (int n = 0; n < 2; ++n) gv[bj][n] = *(const f32x4*)(g + col0 + bj * HALF + n * 4);
#pragma unroll
        for (int ai = 0; ai < 2; ++ai)
#pragma unroll
            for (int m = 0; m < 4; ++m) { bf16_t* rowp = out + (size_t)(u.pm * BM + ai * HALF + wr * 64 + m * 16 + fr) * ldc + col0;
#pragma unroll
                for (int bj = 0; bj < 2; ++bj) { const f32x4 v0 = gv[bj][0] * acc[ai][bj][m][0], v1 = gv[bj][1] * acc[ai][bj][m][1];
                    u32x4 w; w.x = cvt_pk_bf16(v0[0], v0[1]); w.y = cvt_pk_bf16(v0[2], v0[3]); w.z = cvt_pk_bf16(v1[0], v1[1]); w.w = cvt_pk_bf16(v1[2], v1[3]);
                    *(u32x4*)(rowp + bj * HALF) = w; } }
    }
};

template <class Epi, class Sched, bool ALIGN_EPI = false, bool SP2 = false>
__device__ __forceinline__ void gemm_phase(PG8_LAS unsigned char* lds, const Gemm g, const Sched& S, const Epi& E) {
    const int tid = threadIdx.x, wid = __builtin_amdgcn_readfirstlane(tid >> 6), lane = tid & 63, wr = wid >> 2, wc = wid & 3, fr = lane & 15, fq = lane >> 4;
    const int K = g.K, nt = K / BK;
    unsigned voffA[2], voffB[2];
#pragma unroll
    for (int i = 0; i < 2; ++i) { int R, C; stage_rc(tid * 16 + i * 8192, R, C); const int Rb = Epi::PERM ? ((R & ~31) + perm32(R & 31)) : R;
        voffA[i] = (unsigned)(R * K + C) * 2u; voffB[i] = (unsigned)(Rb * K + C) * 2u; }
    const size_t kstep = (size_t)(BK * 2);
    const size_t hstep = (size_t)HALF * K * 2;
    const size_t tstep = 2 * hstep;
    const unsigned ldsw = (unsigned)wid * 1024u;
    const int aoff = lds_byte(wr * 64 + fr, fq * 8), boff = lds_byte(wc * 32 + fr, fq * 8);
#define PG8_SA(b, h) (((b) * 2 + (h)) * HTB)
#define PG8_SB(b, h) ((4 + (b) * 2 + (h)) * HTB)
#define PG8_STAGE(bufoff, gbase, voff) do { _Pragma("unroll") for (int _i = 0; _i < 2; ++_i) \
        __builtin_amdgcn_global_load_lds((const unsigned*)((const char*)(gbase) + (voff)[_i]), (PG8_LAS unsigned*)(lds + (bufoff) + ldsw + _i * 8192), 16, 0, 0); } while (0)
#define PG8_LDA(dst, b, h) do { _Pragma("unroll") for (int m = 0; m < 4; ++m) _Pragma("unroll") for (int k = 0; k < 2; ++k) dst[m][k] = *(const PG8_LAS bf16x8*)(lds + PG8_SA(b, h) + aoff + m * 2048 + k * 1024); } while (0)
#define PG8_LDB(dst, b, h) do { _Pragma("unroll") for (int n = 0; n < 2; ++n) _Pragma("unroll") for (int k = 0; k < 2; ++k) dst[n][k] = *(const PG8_LAS bf16x8*)(lds + PG8_SB(b, h) + boff + n * 2048 + k * 1024); } while (0)
#define PG8_MMA(ai, bj, At, Bt) do { __builtin_amdgcn_s_setprio(1); _Pragma("unroll") for (int m = 0; m < 4; ++m) _Pragma("unroll") for (int n = 0; n < 2; ++n) _Pragma("unroll") for (int k = 0; k < 2; ++k) \
        acc[ai][bj][m][n] = __builtin_amdgcn_mfma_f32_16x16x32_bf16(Bt[n][k], At[m][k], acc[ai][bj][m][n], 0, 0, 0); __builtin_amdgcn_s_setprio(0); } while (0)
#define PG8_WAIT_V(n) asm volatile("s_waitcnt vmcnt(" #n ")" ::: "memory")
#define PG8_WAIT_L(n) asm volatile("s_waitcnt lgkmcnt(" #n ")" ::: "memory")
#define PG8_BAR __builtin_amdgcn_s_barrier()
#define PG8_SCHED __builtin_amdgcn_sched_barrier(0)
    Unit cur, nxt; int ui = 0;
    if (!S.next(0, cur)) return;
    f32x4 acc[2][2][4][2];
#pragma unroll
    for (int a = 0; a < 2; ++a)
#pragma unroll
        for (int b = 0; b < 2; ++b)
#pragma unroll
            for (int m = 0; m < 4; ++m)
#pragma unroll
                for (int n = 0; n < 2; ++n) acc[a][b][m][n] = (f32x4){0.f, 0.f, 0.f, 0.f};
    bf16x8 At[4][2], B0[2][2], B1[2][2];
    const char* cA = (const char*)g.A + (size_t)cur.pm * tstep; const char* cB = (const char*)g.Bt + (size_t)cur.pn * tstep;
    S.a_ready(cur);
    if constexpr (SP2) {
        PG8_STAGE(PG8_SB(0, 0), cB, voffB); PG8_STAGE(PG8_SB(0, 1), cB + hstep, voffB); PG8_STAGE(PG8_SA(0, 0), cA, voffA); PG8_STAGE(PG8_SA(0, 1), cA + hstep, voffA);
        if (wr == 1) PG8_BAR;
        PG8_WAIT_V(2); PG8_BAR;
        PG8_STAGE(PG8_SB(1, 0), cB + kstep, voffB); PG8_STAGE(PG8_SA(1, 0), cA + kstep, voffA); PG8_STAGE(PG8_SB(1, 1), cB + hstep + kstep, voffB);
        PG8_WAIT_V(6); PG8_BAR;
    } else {
        PG8_STAGE(PG8_SB(0, 0), cB, voffB); PG8_STAGE(PG8_SA(0, 0), cA, voffA); PG8_STAGE(PG8_SB(0, 1), cB + hstep, voffB); PG8_STAGE(PG8_SA(0, 1), cA + hstep, voffA);
        if (wr == 1) PG8_BAR;
        PG8_WAIT_V(4); PG8_BAR;
        PG8_STAGE(PG8_SB(1, 0), cB + kstep, voffB); PG8_STAGE(PG8_SA(1, 0), cA + kstep, voffA); PG8_STAGE(PG8_SB(1, 1), cB + hstep + kstep, voffB);
        PG8_WAIT_V(6); PG8_BAR;
    }
    for (;;) {
        const bool has_next = S.next(ui + 1, nxt);
        const char* nA = has_next ? (const char*)g.A + (size_t)nxt.pm * tstep : cA; const char* nB = has_next ? (const char*)g.Bt + (size_t)nxt.pn * tstep : cB;
        for (int t = 0; t < nt; t += 2) {
            const bool last = (t == nt - 2);
            const char* a1 = cA + (size_t)(t + 1) * kstep;
            const char* a2 = last ? nA : cA + (size_t)(t + 2) * kstep; const char* b2 = last ? nB : cB + (size_t)(t + 2) * kstep;
            const char* a3 = a2 + kstep; const char* b3 = b2 + kstep;
            if (last && has_next) S.a_ready(nxt);
            if constexpr (SP2) {
            PG8_LDB(B0, 0, 0); PG8_LDB(B1, 0, 1); PG8_SCHED; PG8_LDA(At, 0, 0); PG8_STAGE(PG8_SA(1, 1), a1 + hstep, voffA);
            PG8_WAIT_V(8); PG8_WAIT_L(0); PG8_BAR; PG8_MMA(0, 0, At, B0); PG8_MMA(0, 1, At, B1); PG8_BAR; PG8_SCHED;
            PG8_LDA(At, 0, 1); PG8_STAGE(PG8_SB(0, 0), b2, voffB); PG8_STAGE(PG8_SB(0, 1), b2 + hstep, voffB); PG8_STAGE(PG8_SA(0, 0), a2, voffA);
            PG8_WAIT_V(8); PG8_WAIT_L(0); PG8_BAR; PG8_MMA(1, 0, At, B0); PG8_MMA(1, 1, At, B1); PG8_BAR; PG8_SCHED;
            PG8_LDB(B0, 1, 0); PG8_LDB(B1, 1, 1); PG8_SCHED; PG8_LDA(At, 1, 0); PG8_STAGE(PG8_SA(0, 1), a2 + hstep, voffA);
            PG8_WAIT_V(8); PG8_WAIT_L(0); PG8_BAR; PG8_MMA(0, 0, At, B0); PG8_MMA(0, 1, At, B1); PG8_BAR; PG8_SCHED;
            PG8_LDA(At, 1, 1); PG8_STAGE(PG8_SB(1, 0), b3, voffB); PG8_STAGE(PG8_SB(1, 1), b3 + hstep, voffB); PG8_STAGE(PG8_SA(1, 0), a3, voffA);
            PG8_WAIT_V(8); PG8_WAIT_L(0); PG8_BAR; PG8_MMA(1, 0, At, B0); PG8_MMA(1, 1, At, B1); PG8_BAR; PG8_SCHED;
            } else {
            PG8_LDB(B0, 0, 0); PG8_SCHED; PG8_LDA(At, 0, 0); PG8_STAGE(PG8_SA(1, 1), a1 + hstep, voffA);
            PG8_WAIT_L(8); PG8_BAR; PG8_WAIT_L(0); PG8_MMA(0, 0, At, B0); PG8_BAR; PG8_SCHED;
            PG8_LDB(B1, 0, 1); PG8_STAGE(PG8_SB(0, 0), b2, voffB);
            PG8_BAR; PG8_WAIT_L(0); PG8_MMA(0, 1, At, B1); PG8_BAR;
            PG8_LDA(At, 0, 1); PG8_STAGE(PG8_SA(0, 0), a2, voffA);
            PG8_BAR; PG8_WAIT_L(0); PG8_MMA(1, 0, At, B0); PG8_BAR; PG8_SCHED;
            PG8_STAGE(PG8_SB(0, 1), b2 + hstep, voffB);
            PG8_WAIT_V(6); PG8_BAR; PG8_MMA(1, 1, At, B1); PG8_BAR;
            PG8_LDB(B0, 1, 0); PG8_SCHED; PG8_LDA(At, 1, 0); PG8_STAGE(PG8_SA(0, 1), a2 + hstep, voffA);
            PG8_WAIT_L(8); PG8_BAR; PG8_WAIT_L(0); PG8_MMA(0, 0, At, B0); PG8_BAR; PG8_SCHED;
            PG8_LDB(B1, 1, 1); PG8_STAGE(PG8_SB(1, 0), b3, voffB);
            PG8_BAR; PG8_WAIT_L(0); PG8_MMA(0, 1, At, B1); PG8_BAR;
            PG8_LDA(At, 1, 1); PG8_STAGE(PG8_SA(1, 0), a3, voffA);
            PG8_BAR; PG8_WAIT_L(0); PG8_MMA(1, 0, At, B0); PG8_BAR; PG8_SCHED;
            PG8_STAGE(PG8_SB(1, 1), b3 + hstep, voffB);
            PG8_WAIT_V(6); PG8_BAR; PG8_MMA(1, 1, At, B1); PG8_BAR;
            }
        }
        if constexpr (ALIGN_EPI) { if (wr == 0) PG8_BAR; }
        if constexpr (!Epi::AFTER_DRAIN) { E(acc, cur, wr, wc, fr, fq); S.done(cur); }
        if (!has_next) break;
#pragma unroll
        for (int a = 0; a < 2; ++a)
#pragma unroll
            for (int b = 0; b < 2; ++b)
#pragma unroll
                for (int m = 0; m < 4; ++m)
#pragma unroll
                    for (int n = 0; n < 2; ++n) acc[a][b][m][n] = (f32x4){0.f, 0.f, 0.f, 0.f};
        cur = nxt; cA = nA; cB = nB; ++ui;
        if constexpr (ALIGN_EPI) { if (wr == 1) PG8_BAR; }
    }
    PG8_WAIT_V(0);
    if constexpr (!ALIGN_EPI) { if (wr == 0) PG8_BAR; }
    PG8_BAR;
    if constexpr (Epi::AFTER_DRAIN) { E.fused(acc, cur, wr, wc, fr, fq, lds, wid, lane); S.done(cur); }
#undef PG8_SA
#undef PG8_SB
#undef PG8_STAGE
#undef PG8_LDA
#undef PG8_LDB
#undef PG8_MMA
#undef PG8_WAIT_V
#undef PG8_WAIT_L
#undef PG8_BAR
#undef PG8_SCHED
}
}

#ifndef PROBE_STAMP
#define PROBE_STAMP -1
#define PROBE_DIV 5.0f
#endif
constexpr int NWAVES = 8;
#ifndef MK_N_LAUNCHES
#define MK_N_LAUNCHES 1
#endif
constexpr int N_PHASES = 12;
constexpr int N_LAUNCHES = MK_N_LAUNCHES;

constexpr int BATCH = 4, SEQ = 4096, D = 2048, M = BATCH * SEQ;
constexpr int LRU_W = 1024, LRU_HEADS = 8, LRU_BLK = 128;
constexpr int HD = 64, HQ = 16, HKV = 2, GRP = 8;
constexpr int MIX_IN = 3328;
constexpr int C_Y = 1024, C_Q = 2048, C_K = 3072, C_V = 3200;
constexpr int ADA_W = 6 * D;
constexpr int PH = 8, PKEYS = 128, PHALF = 128, PTOPK = 16, NEXP = 16384;
constexpr float EPS = 1e-6f;

constexpr size_t MiB = 1u << 20;
constexpr size_t WS_CTL = 0, CTL_ZERO_BYTES = 64 * 1024;
constexpr size_t WS_ADA = 1 * MiB;
constexpr size_t WS_ROPE = 2 * MiB;
constexpr size_t WS_WIN = 4 * MiB;
constexpr size_t WS_WOUT = 17 * MiB;
constexpr size_t WS_WQ = 25 * MiB;
constexpr size_t WS_WGA = 33 * MiB;
constexpr size_t WS_WGX = 33 * MiB + 256 * 1024;
constexpr size_t WS_SK = 33 * MiB + 512 * 1024;
constexpr size_t WS_IDX = 34 * MiB;
constexpr size_t WS_GW = 42 * MiB;
constexpr size_t WS_U = 50 * MiB;
constexpr size_t WS_V = 82 * MiB;
constexpr size_t WS_USC = 1 * MiB + 512 * 1024;
constexpr size_t WS_VSC = 1 * MiB + 768 * 1024;
constexpr size_t WS_X1B = 114 * MiB;
constexpr size_t WS_XH = 178 * MiB;
constexpr size_t WS_PROJ = 242 * MiB;
constexpr size_t WS_HL = 346 * MiB;
constexpr size_t WS_PA = 410 * MiB;
constexpr size_t WS_PART = WS_HL;
constexpr size_t WS_W = WS_PROJ + 64 * MiB;
constexpr size_t WS_WSC = WS_PROJ + 68 * MiB;
constexpr size_t WS_H8 = WS_PROJ + 72 * MiB;
constexpr size_t WS_END = 474 * MiB;
constexpr int CW_BAR = 4096;

constexpr int RING_BYTES = 131072;
constexpr int LDSCTL_OFF = RING_BYTES, MISC_OFF = LDSCTL_OFF + 320;
constexpr int LDS_BYTES = 147456;

#define GAS __attribute__((address_space(1)))
#define LAS __attribute__((address_space(3)))
typedef unsigned short bf16;
typedef unsigned v4u __attribute__((ext_vector_type(4)));
typedef unsigned v2u __attribute__((ext_vector_type(2)));
typedef float f32x4 __attribute__((ext_vector_type(4)));
typedef float f32x2 __attribute__((ext_vector_type(2)));
typedef float f32x16 __attribute__((ext_vector_type(16)));
typedef short bf16x8 __attribute__((ext_vector_type(8)));
typedef __bf16 bf16x2v __attribute__((ext_vector_type(2)));
#define LDS_WAIT() asm volatile("s_waitcnt lgkmcnt(0)" ::: "memory")
#define VM_WAIT() asm volatile("s_waitcnt vmcnt(0)" ::: "memory")
__device__ __forceinline__ unsigned f2bf(float f) { unsigned u = __builtin_bit_cast(unsigned, f); return (u + 0x7fffu + ((u >> 16) & 1u)) >> 16; }
__device__ __forceinline__ unsigned pk2(float lo, float hi) { return f2bf(lo) | (f2bf(hi) << 16); }
__device__ __forceinline__ float bflo(unsigned u) { return __builtin_bit_cast(float, u << 16); }
__device__ __forceinline__ float bfhi(unsigned u) { return __builtin_bit_cast(float, u & 0xffff0000u); }
__device__ __forceinline__ float bf1(bf16 h) { return __builtin_bit_cast(float, (unsigned)h << 16); }
__device__ __forceinline__ float dot2bf(unsigned a, unsigned b, float acc) { return __builtin_amdgcn_fdot2_f32_bf16(__builtin_bit_cast(bf16x2v, a), __builtin_bit_cast(bf16x2v, b), acc, false); }
__device__ __forceinline__ float sigmoidf_(float x) { return 1.0f / (1.0f + __expf(-x)); }
__device__ __forceinline__ float gelu_tanh(float x) {
    const float z = 1.5957691216057308f * (x + 0.044715f * x * x * x);
    return x / (1.0f + __expf(-z));
}
__device__ __forceinline__ float wave_sum(float v) {
#pragma unroll
    for (int o = 1; o < 64; o <<= 1) v += __shfl_xor(v, o);
    return v;
}

#define XB_TMO      128
#define XB_XCNT(j)  (256  + 64 * (j))
#define XB_XSUB(j)  (1280 + 64 * (j))
#define XB_XGEN(j)  (2304 + 64 * (j))
#define XB_TOP      3328
#define XB_TOPGEN   3392
#define XCD_BAR_WORDS 3456
#define XB_SPIN_CAP (1u << 18)
__device__ __forceinline__ unsigned xb_ld(unsigned* p)              { return __hip_atomic_load(p, __ATOMIC_RELAXED, __HIP_MEMORY_SCOPE_AGENT); }
__device__ __forceinline__ unsigned xb_add(unsigned* p, unsigned v) { return __hip_atomic_fetch_add(p, v, __ATOMIC_RELAXED, __HIP_MEMORY_SCOPE_AGENT); }
__device__ __forceinline__ unsigned xb_xcc_id() { return (unsigned)__builtin_amdgcn_s_getreg((3 << 11) | 20) & 0xFu; }
#define XB_SPIN(cond, bar) do { unsigned _sp = 0; while (cond) { __builtin_amdgcn_s_sleep(1); \
    if ((++_sp & 255u) == 0u) { if (xb_ld(&(bar)[XB_TMO])) break; if (_sp > XB_SPIN_CAP) { atomicAdd(&(bar)[XB_TMO], 1u); break; } } } } while (0)
struct XcdBarrier { unsigned* bar; unsigned x; volatile LAS unsigned* st; };
__device__ __forceinline__ XcdBarrier xcd_barrier_post(unsigned* bar, volatile LAS unsigned* st) {
    XcdBarrier b; b.bar = bar; b.x = xb_xcc_id(); b.st = st;
    if (threadIdx.x == 0) (void)xb_add(&bar[XB_XCNT(b.x)], 1u);
    return b;
}
__device__ __forceinline__ void xcd_barrier_complete(unsigned* bar, unsigned x, unsigned& nloc, unsigned& nx) {
    const unsigned G = gridDim.x * gridDim.y * gridDim.z;
    unsigned sum, cnt, mine, sp = 0u;
    for (;;) {
        sum = 0u; cnt = 0u; mine = 0u;
#pragma unroll
        for (unsigned j = 0; j < 16; ++j) { const unsigned c = xb_ld(&bar[XB_XCNT(j)]); sum += c; cnt += (c > 0u) ? 1u : 0u; mine = (j == x) ? c : mine; }
        if (sum == G) break;
        __builtin_amdgcn_s_sleep(1);
        if ((++sp & 255u) == 0u) { if (xb_ld(&bar[XB_TMO])) break; if (sp > XB_SPIN_CAP) { atomicAdd(&bar[XB_TMO], 1u); break; } }
    }
    nloc = mine > 0u ? mine : 1u; nx = cnt > 0u ? cnt : 1u;
}
__device__ __forceinline__ void xcd_barrier(const XcdBarrier& b) {
    asm volatile("s_waitcnt vmcnt(0)" ::: "memory");
    __syncthreads();
    if (threadIdx.x == 0) {
        unsigned* bar = b.bar;
        __builtin_amdgcn_s_waitcnt(0);
        unsigned nloc = b.st[0], nx = b.st[1];
        if (nloc == 0u) { xcd_barrier_complete(bar, b.x, nloc, nx); b.st[0] = nloc; b.st[1] = nx; }
        const unsigned old = xb_add(&bar[XB_XSUB(b.x)], 1u);
        const unsigned gen = old / nloc;
        if (old + 1u == (gen + 1u) * nloc) {
            __builtin_amdgcn_fence(__ATOMIC_RELEASE, "agent");
            asm volatile("s_waitcnt vmcnt(0)" ::: "memory");
            const unsigned og = xb_add(&bar[XB_TOP], 1u);
            const unsigned tg = og / nx;
            if (og + 1u == (tg + 1u) * nx) xb_add(&bar[XB_TOPGEN], 1u);
            else XB_SPIN(xb_ld(&bar[XB_TOPGEN]) == tg, bar);
            __builtin_amdgcn_fence(__ATOMIC_ACQUIRE, "agent");
            xb_add(&bar[XB_XGEN(b.x)], 1u);
            asm volatile("s_waitcnt vmcnt(0)" ::: "memory");
        } else {
            XB_SPIN(xb_ld(&bar[XB_XGEN(b.x)]) == gen, bar);
            __builtin_amdgcn_fence(__ATOMIC_ACQUIRE, "agent");
            asm volatile("s_waitcnt vmcnt(0)" ::: "memory");
        }
    }
    __syncthreads();
}

typedef const __attribute__((address_space(4))) unsigned char* kaptr_t;
struct Frame { LAS unsigned char* lds; int tid, lane, wave, G, bid; kaptr_t ka; };
template <class T> __device__ __forceinline__ T* ka_ptr(const Frame& F, int byte_off) { typedef T* tp; return *(const __attribute__((address_space(4))) tp*)(F.ka + byte_off); }
__device__ __forceinline__ const float* P_x(const Frame& F) { return ka_ptr<const float>(F, 0); }
__device__ __forceinline__ const float* P_c(const Frame& F) { return ka_ptr<const float>(F, 8); }
__device__ __forceinline__ const int* P_pos(const Frame& F) { return ka_ptr<const int>(F, 16); }
__device__ __forceinline__ const float* P_w_ada(const Frame& F) { return ka_ptr<const float>(F, 24); }
__device__ __forceinline__ const float* P_b_ada(const Frame& F) { return ka_ptr<const float>(F, 32); }
__device__ __forceinline__ const float* P_norm1_g(const Frame& F) { return ka_ptr<const float>(F, 40); }
__device__ __forceinline__ const float* P_w_in(const Frame& F) { return ka_ptr<const float>(F, 48); }
__device__ __forceinline__ const float* P_conv_w(const Frame& F) { return ka_ptr<const float>(F, 56); }
__device__ __forceinline__ const float* P_conv_b(const Frame& F) { return ka_ptr<const float>(F, 64); }
__device__ __forceinline__ const float* P_ga_w(const Frame& F) { return ka_ptr<const float>(F, 72); }
__device__ __forceinline__ const float* P_ga_b(const Frame& F) { return ka_ptr<const float>(F, 80); }
__device__ __forceinline__ const float* P_gx_w(const Frame& F) { return ka_ptr<const float>(F, 88); }
__device__ __forceinline__ const float* P_gx_b(const Frame& F) { return ka_ptr<const float>(F, 96); }
__device__ __forceinline__ const float* P_lam(const Frame& F) { return ka_ptr<const float>(F, 104); }
__device__ __forceinline__ const float* P_qn_g(const Frame& F) { return ka_ptr<const float>(F, 112); }
__device__ __forceinline__ const float* P_kn_g(const Frame& F) { return ka_ptr<const float>(F, 120); }
__device__ __forceinline__ const float* P_sinks(const Frame& F) { return ka_ptr<const float>(F, 128); }
__device__ __forceinline__ const float* P_on_lru_g(const Frame& F) { return ka_ptr<const float>(F, 136); }
__device__ __forceinline__ const float* P_on_attn_g(const Frame& F) { return ka_ptr<const float>(F, 144); }
__device__ __forceinline__ const float* P_w_out(const Frame& F) { return ka_ptr<const float>(F, 152); }
__device__ __forceinline__ const float* P_norm2_g(const Frame& F) { return ka_ptr<const float>(F, 160); }
__device__ __forceinline__ const float* P_w_pq(const Frame& F) { return ka_ptr<const float>(F, 168); }
__device__ __forceinline__ const float* P_sub_keys(const Frame& F) { return ka_ptr<const float>(F, 176); }
__device__ __forceinline__ const float* P_pu(const Frame& F) { return ka_ptr<const float>(F, 184); }
__device__ __forceinline__ const float* P_pv(const Frame& F) { return ka_ptr<const float>(F, 192); }
__device__ __forceinline__ float* P_out(const Frame& F) { return ka_ptr<float>(F, 200); }
__device__ __forceinline__ unsigned char* P_ws(const Frame& F) { return ka_ptr<unsigned char>(F, 208); }
__device__ __forceinline__ float* P_ADA(const Frame& F) { return (float*)(P_ws(F) + WS_ADA); }
__device__ __forceinline__ float* P_ROPE(const Frame& F) { return (float*)(P_ws(F) + WS_ROPE); }
__device__ __forceinline__ bf16* P_HL(const Frame& F) { return (bf16*)(P_ws(F) + WS_HL); }
__device__ __forceinline__ bf16* P_PA(const Frame& F) { return (bf16*)(P_ws(F) + WS_PA); }
__device__ __forceinline__ float* P_GW(const Frame& F) { return (float*)(P_ws(F) + WS_GW); }
__device__ __forceinline__ unsigned short* P_IDX(const Frame& F) { return (unsigned short*)(P_ws(F) + WS_IDX); }
__device__ __forceinline__ bf16* P_WIN(const Frame& F) { return (bf16*)(P_ws(F) + WS_WIN); }
__device__ __forceinline__ bf16* P_WOUT(const Frame& F) { return (bf16*)(P_ws(F) + WS_WOUT); }
__device__ __forceinline__ bf16* P_WQ(const Frame& F) { return (bf16*)(P_ws(F) + WS_WQ); }
__device__ __forceinline__ bf16* P_WGA(const Frame& F) { return (bf16*)(P_ws(F) + WS_WGA); }
__device__ __forceinline__ bf16* P_WGX(const Frame& F) { return (bf16*)(P_ws(F) + WS_WGX); }
__device__ __forceinline__ bf16* P_SK(const Frame& F) { return (bf16*)(P_ws(F) + WS_SK); }
__device__ __forceinline__ unsigned char* P_U(const Frame& F) { return (unsigned char*)(P_ws(F) + WS_U); }
__device__ __forceinline__ bf16* P_X1B(const Frame& F) { return (bf16*)(P_ws(F) + WS_X1B); }
__device__ __forceinline__ unsigned char* P_H8(const Frame& F) { return (unsigned char*)(P_ws(F) + WS_H8); }
__device__ __forceinline__ unsigned* P_PART(const Frame& F) { return (unsigned*)(P_ws(F) + WS_PART); }
__device__ __forceinline__ unsigned char* P_W(const Frame& F) { return (unsigned char*)(P_ws(F) + WS_W); }
__device__ __forceinline__ float* P_WSC(const Frame& F) { return (float*)(P_ws(F) + WS_WSC); }
__device__ __forceinline__ float* P_USC(const Frame& F) { return (float*)(P_ws(F) + WS_USC); }
__device__ __forceinline__ float* P_VSC(const Frame& F) { return (float*)(P_ws(F) + WS_VSC); }
__device__ __forceinline__ unsigned char* P_V(const Frame& F) { return (unsigned char*)(P_ws(F) + WS_V); }
__device__ __forceinline__ bf16* P_XH(const Frame& F) { return (bf16*)(P_ws(F) + WS_XH); }
__device__ __forceinline__ bf16* P_PROJ(const Frame& F) { return (bf16*)(P_ws(F) + WS_PROJ); }

__device__ __forceinline__ void p0_transpose_item(const float* W, int K, int N, bf16* WT, LAS float* scr, int item, int lane) {
    const int nblk = N / 32, kb = item / nblk, nb = item % nblk, k0 = 64 * kb, n0 = 32 * nb;
#pragma unroll 8
    for (int i = 0; i < 32; ++i) { const int kk = 2 * i + (lane >> 5); scr[kk * 33 + (lane & 31)] = W[(size_t)(k0 + kk) * N + n0 + (lane & 31)]; }
    LDS_WAIT(); asm volatile("" ::: "memory");
    const int c = lane & 7;
#pragma unroll
    for (int j = 0; j < 4; ++j) { const int n = (lane >> 3) + 8 * j; const LAS float* s = scr + (8 * c) * 33 + n;
        v4u o; o.x = pk2(s[0 * 33], s[1 * 33]); o.y = pk2(s[2 * 33], s[3 * 33]); o.z = pk2(s[4 * 33], s[5 * 33]); o.w = pk2(s[6 * 33], s[7 * 33]);
        *(v4u*)(WT + (size_t)(n0 + n) * K + k0 + 8 * c) = o; }
    LDS_WAIT(); asm volatile("" ::: "memory");
}
__device__ __forceinline__ void p0_convert(const float* src, bf16* dst, size_t n8, size_t gtid, size_t gthreads) {
    for (size_t i = gtid; i < n8; i += gthreads) {
        const f32x4 a = *(const f32x4*)(src + 8 * i), b = *(const f32x4*)(src + 8 * i + 4);
        v4u o; o.x = pk2(a.x, a.y); o.y = pk2(a.z, a.w); o.z = pk2(b.x, b.y); o.w = pk2(b.z, b.w);
        *(v4u*)(dst + 8 * i) = o;
    }
}
#ifndef QUANT_SPLIT
#define QUANT_SPLIT 14336
#endif
__device__ __forceinline__ void quant_rows(Frame& F, int r0, int r1, int w, int nw) {
    for (int rr = r0 + w; rr < r1; rr += nw) {
        const int tbl = rr >= NEXP, row = rr - tbl * NEXP;
        const float* srcp = (tbl ? P_pv(F) : P_pu(F)) + (size_t)row * D;
        f32x4 v[8]; float mx = 0.f;
#pragma unroll
        for (int j = 0; j < 8; ++j) { v[j] = *(const f32x4*)(srcp + 4 * F.lane + 256 * j);
            mx = fmaxf(fmaxf(mx, fmaxf(fabsf(v[j].x), fabsf(v[j].y))), fmaxf(fabsf(v[j].z), fabsf(v[j].w))); }
#pragma unroll
        for (int o = 1; o < 64; o <<= 1) mx = fmaxf(mx, __shfl_xor(mx, o));
        {
            const float s = fmaxf(mx, 1e-30f) * (1.0f / 6.0f), inv = 1.0f / s;
            unsigned char* d4 = (tbl ? P_V(F) : P_U(F)) + (size_t)row * 128 + 2 * F.lane;
#pragma unroll
            for (int j = 0; j < 8; ++j) { unsigned t = __builtin_amdgcn_cvt_scalef32_pk_fp4_f32(0u, v[j].x * inv, v[j].y * inv, 1.0f, 0);
                t = __builtin_amdgcn_cvt_scalef32_pk_fp4_f32(t, v[j].z * inv, v[j].w * inv, 1.0f, 1);
                *(unsigned short*)(d4 + (size_t)j * (NEXP * 128)) = (unsigned short)t; }
            if (F.lane == 0) (tbl ? P_VSC(F) : P_USC(F))[row] = s;
        }
    }
}
__device__ __forceinline__ void p0_prologue(Frame& F) {
    {
        LAS float* sc = (LAS float*)F.lds;
        LAS float* red = sc + 4 * D;
        for (int i = F.tid; i < 4 * D; i += 512) { const float v = P_c(F)[i]; sc[i] = v / (1.0f + __expf(-v)); }
        __syncthreads();
        for (int cg = F.bid; cg < ADA_W / 64; cg += F.G) {
            const int n0 = cg * 64, k0 = F.wave * 256;
            const float* wp = P_w_ada(F) + (size_t)k0 * ADA_W + n0 + F.lane;
            float a0 = 0.f, a1 = 0.f, a2 = 0.f, a3 = 0.f;
            for (int kb = 0; kb < 256; kb += 64) { float wv[64];
#pragma unroll
                for (int k = 0; k < 64; ++k) wv[k] = wp[(size_t)(kb + k) * ADA_W];
#pragma unroll
                for (int k = 0; k < 64; ++k) { const float w = wv[k]; const int kk = k0 + kb + k;
                    a0 += sc[kk] * w; a1 += sc[D + kk] * w; a2 += sc[2 * D + kk] * w; a3 += sc[3 * D + kk] * w; } }
            red[(F.wave * 4 + 0) * 64 + F.lane] = a0; red[(F.wave * 4 + 1) * 64 + F.lane] = a1;
            red[(F.wave * 4 + 2) * 64 + F.lane] = a2; red[(F.wave * 4 + 3) * 64 + F.lane] = a3;
            __syncthreads();
            if (F.tid < 256) { const int b = F.tid >> 6, l = F.tid & 63; float s = 0.f;
#pragma unroll
                for (int w = 0; w < 8; ++w) s += red[(w * 4 + b) * 64 + l];
                P_ADA(F)[(size_t)b * ADA_W + n0 + l] = s + P_b_ada(F)[n0 + l]; }
            __syncthreads();
        }
        __syncthreads();
    }
    if (PROBE_STAMP >= 0 && F.bid == 0 && F.tid == 0) ((unsigned long long*)(P_ws(F) + WS_CTL + 64))[14] = __builtin_amdgcn_s_memrealtime();
    {
        LAS float* scr = (LAS float*)(F.lds + F.wave * 16384);
        const int gw = F.bid * NWAVES + F.wave, NGW = F.G * NWAVES;
        constexpr int I_IN = (D / 64) * (MIX_IN / 32), I_SQ = (D / 64) * (D / 32), I_G = (LRU_BLK / 64) * (LRU_BLK / 32);
        constexpr int NITEMS = I_IN + 2 * I_SQ + 16 * I_G;
        for (int it = gw; it < NITEMS; it += NGW) {
            int r = it;
            if (r < I_IN) { p0_transpose_item(P_w_in(F), D, MIX_IN, P_WIN(F), scr, r, F.lane); continue; } r -= I_IN;
            if (r < I_SQ) { p0_transpose_item(P_w_out(F), D, D, P_WOUT(F), scr, r, F.lane); continue; } r -= I_SQ;
            if (r < I_SQ) { p0_transpose_item(P_w_pq(F), D, D, P_WQ(F), scr, r, F.lane); continue; } r -= I_SQ;
            const int g = r / I_G, ri = r % I_G, hd = g & 7;
            if (g < 8) p0_transpose_item(P_ga_w(F) + (size_t)hd * 16384, LRU_BLK, LRU_BLK, P_WGA(F) + (size_t)hd * 16384, scr, ri, F.lane);
            else       p0_transpose_item(P_gx_w(F) + (size_t)hd * 16384, LRU_BLK, LRU_BLK, P_WGX(F) + (size_t)hd * 16384, scr, ri, F.lane);
        }
    }
    {
        const size_t gtid = (size_t)F.bid * 512 + F.tid, gth = (size_t)F.G * 512;
        p0_convert(P_sub_keys(F), P_SK(F), (size_t)PH * 2 * PKEYS * PHALF / 8, gtid, gth);
    }
    quant_rows(F, 0, QUANT_SPLIT, F.bid * NWAVES + F.wave, F.G * NWAVES);
}

template <bool RESID, int R> __device__ __forceinline__ void modnorm_rows(const float* xin, const float* gain, const float* shift, const float* scale, bf16* orow, int lane, bf16* xin2 = nullptr, unsigned char* o8 = nullptr) {
    f32x4 v[R][4][2]; float s[R];
#pragma unroll
    for (int r = 0; r < R; ++r) { s[r] = 0.f;
#pragma unroll
        for (int j = 0; j < 4; ++j) { const int c = 8 * lane + 512 * j;
            v[r][j][0] = *(const f32x4*)(xin + (size_t)r * D + c); v[r][j][1] = *(const f32x4*)(xin + (size_t)r * D + c + 4);
            if (RESID) { bf16* dp = xin2 + (size_t)r * D + c; const v4u q = *(const v4u*)dp;
                v[r][j][0] += (f32x4){bflo(q.x), bfhi(q.x), bflo(q.y), bfhi(q.y)}; v[r][j][1] += (f32x4){bflo(q.z), bfhi(q.z), bflo(q.w), bfhi(q.w)};
                v4u o; o.x = pk2(v[r][j][0].x, v[r][j][0].y); o.y = pk2(v[r][j][0].z, v[r][j][0].w); o.z = pk2(v[r][j][1].x, v[r][j][1].y); o.w = pk2(v[r][j][1].z, v[r][j][1].w); *(v4u*)dp = o; } } }
#pragma unroll
    for (int r = 0; r < R; ++r)
#pragma unroll
        for (int j = 0; j < 4; ++j)
#pragma unroll
            for (int h = 0; h < 2; ++h) { const f32x4 t = v[r][j][h]; s[r] += (t.x * t.x + t.y * t.y) + (t.z * t.z + t.w * t.w); }
#pragma unroll
    for (int o = 1; o < 64; o <<= 1) {
#pragma unroll
        for (int r = 0; r < R; ++r) s[r] += __shfl_xor(s[r], o); }
    float rstd[R];
#pragma unroll
    for (int r = 0; r < R; ++r) rstd[r] = 1.0f / sqrtf(s[r] * (1.0f / D) + EPS);
#pragma unroll
    for (int j = 0; j < 4; ++j) {
        const int c = 8 * lane + 512 * j;
        f32x4 gm[2], sh[2];
#pragma unroll
        for (int h = 0; h < 2; ++h) { const f32x4 g = *(const f32x4*)(gain + c + 4 * h), sc = *(const f32x4*)(scale + c + 4 * h); sh[h] = *(const f32x4*)(shift + c + 4 * h); gm[h] = g * (sc + 1.0f); }
#pragma unroll
        for (int r = 0; r < R; ++r) { const f32x4 y0 = (v[r][j][0] * rstd[r]) * gm[0] + sh[0], y1 = (v[r][j][1] * rstd[r]) * gm[1] + sh[1];
            v4u o; o.x = pk2(y0.x, y0.y); o.y = pk2(y0.z, y0.w); o.z = pk2(y1.x, y1.y); o.w = pk2(y1.z, y1.w);
            *(v4u*)(orow + (size_t)r * D + c) = o;
            if (RESID) { int t0 = __builtin_amdgcn_cvt_pk_fp8_f32(y0.x, y0.y, 0, false); t0 = __builtin_amdgcn_cvt_pk_fp8_f32(y0.z, y0.w, t0, true);
                int t1 = __builtin_amdgcn_cvt_pk_fp8_f32(y1.x, y1.y, 0, false); t1 = __builtin_amdgcn_cvt_pk_fp8_f32(y1.z, y1.w, t1, true);
                *(v2u*)(o8 + (size_t)r * D + c) = (v2u){(unsigned)t0, (unsigned)t1}; } }
    }
}
__device__ __forceinline__ void p1_phase(Frame& F) {
    const int gw = F.bid * NWAVES + F.wave, NGW = F.G * NWAVES;
    for (int m = 4 * gw; m < M; m += 4 * NGW) { const int b = m / SEQ; const float* ada = P_ADA(F) + (size_t)b * ADA_W;
        modnorm_rows<false, 4>(P_x(F) + (size_t)m * D, P_norm1_g(F), ada, ada + D, P_XH(F) + (size_t)m * D, F.lane); }
    const float invf[8] = {1.0f, 1.9392274e-01f, 3.7606031e-02f, 7.2926646e-03f, 1.4142136e-03f, 2.7424819e-04f, 5.3182961e-05f, 1.0313386e-05f};
    for (int i = F.bid * 512 + F.tid; i < M * 8; i += F.G * 512) { const int m = i >> 3, k = i & 7;
        float f = invf[0];
#pragma unroll
        for (int q = 1; q < 8; ++q) f = (k == q) ? invf[q] : f;
        const float ang = (float)P_pos(F)[m] * f; float sn, cs; sincosf(ang, &sn, &cs);
        P_ROPE(F)[(size_t)m * 16 + k] = cs; P_ROPE(F)[(size_t)m * 16 + 8 + k] = sn; }
}
__device__ __forceinline__ void p6_phase(Frame& F) {
    const int gw = F.bid * NWAVES + F.wave, NGW = F.G * NWAVES;
    for (int m = 2 * gw; m < M; m += 2 * NGW) { const int b = m / SEQ; const float* ada = P_ADA(F) + (size_t)b * ADA_W;
        modnorm_rows<true, 2>(P_x(F) + (size_t)m * D, P_norm2_g(F), ada + 3 * D, ada + 4 * D, P_XH(F) + (size_t)m * D, F.lane, P_X1B(F) + (size_t)m * D, P_H8(F) + (size_t)m * D); }
}

#define MFMA32(a, b, c) __builtin_amdgcn_mfma_f32_32x32x16_bf16((a), (b), (c), 0, 0, 0)
#define MFMA16(a, b, c) __builtin_amdgcn_mfma_f32_16x16x32_bf16((a), (b), (c), 0, 0, 0)
constexpr int KS_STRIDE = 72;
constexpr int VT_STRIDE = 264;
constexpr int ATT_KS_OFF = 0, ATT_VT_OFF = 256 * KS_STRIDE * 2;
static_assert(ATT_VT_OFF + 64 * VT_STRIDE * 2 <= RING_BYTES, "attention LDS");

__device__ __forceinline__ void attn_unit(Frame& F, int b, int g, int n) {
    LAS bf16* Ks = (LAS bf16*)(F.lds + ATT_KS_OFF);
    LAS bf16* VT = (LAS bf16*)(F.lds + ATT_VT_OFF);
    const int tid = F.tid, lane = F.lane;
    {
        const int kb = tid >> 1, hf = tid & 1; const int t = n * 128 - 128 + kb;
        float kv[32]; v4u vraw[4];
        if (t >= 0) {
            const bf16* kp = P_PROJ(F) + (size_t)(b * SEQ + t) * MIX_IN + C_K + g * HD + 32 * hf;
            const bf16* vp = P_PROJ(F) + (size_t)(b * SEQ + t) * MIX_IN + C_V + g * HD + 32 * hf;
#pragma unroll
            for (int q = 0; q < 4; ++q) { const v4u r = *(const v4u*)(kp + 8 * q); vraw[q] = *(const v4u*)(vp + 8 * q);
                kv[8 * q + 0] = bflo(r.x); kv[8 * q + 1] = bfhi(r.x); kv[8 * q + 2] = bflo(r.y); kv[8 * q + 3] = bfhi(r.y);
                kv[8 * q + 4] = bflo(r.z); kv[8 * q + 5] = bfhi(r.z); kv[8 * q + 6] = bflo(r.w); kv[8 * q + 7] = bfhi(r.w); }
        } else {
#pragma unroll
            for (int q = 0; q < 4; ++q) vraw[q] = (v4u){0u, 0u, 0u, 0u};
#pragma unroll
            for (int q = 0; q < 32; ++q) kv[q] = 0.f;
        }
        float ss = 0.f;
#pragma unroll
        for (int q = 0; q < 32; ++q) ss += kv[q] * kv[q];
        ss += __shfl_xor(ss, 1);
        const float rstd = 1.0f / sqrtf(ss * (1.0f / HD) + EPS);
#pragma unroll
        for (int q = 0; q < 32; ++q) kv[q] = kv[q] * rstd * P_kn_g(F)[32 * hf + q];
        if (hf == 0 && t >= 0) {
            const float* rp = P_ROPE(F) + (size_t)(b * SEQ + t) * 16;
#pragma unroll
            for (int i = 0; i < 8; ++i) { const float cs = rp[i], sn = rp[8 + i]; const float x1 = kv[i], x2 = kv[8 + i];
                kv[i] = x1 * cs - x2 * sn; kv[8 + i] = x2 * cs + x1 * sn; }
        }
#pragma unroll
        for (int q = 0; q < 4; ++q) { v4u o; o.x = pk2(kv[8 * q], kv[8 * q + 1]); o.y = pk2(kv[8 * q + 2], kv[8 * q + 3]); o.z = pk2(kv[8 * q + 4], kv[8 * q + 5]); o.w = pk2(kv[8 * q + 6], kv[8 * q + 7]);
            *(LAS v4u*)(Ks + kb * KS_STRIDE + 32 * hf + 8 * q) = o; }
#pragma unroll
        for (int q = 0; q < 4; ++q) { const unsigned w[4] = {vraw[q].x, vraw[q].y, vraw[q].z, vraw[q].w};
#pragma unroll
            for (int e = 0; e < 4; ++e) { const int d = 32 * hf + 8 * q + 2 * e;
                VT[d * VT_STRIDE + kb] = (bf16)(w[e] & 0xffffu); VT[(d + 1) * VT_STRIDE + kb] = (bf16)(w[e] >> 16); } }
    }
    __syncthreads();
    const int hq = g * GRP + F.wave, r = lane & 31, hh = lane >> 5;
    const float sink = P_sinks(F)[hq];
    for (int qi = 0; qi < 4; ++qi) {
        const int tq = n * 128 + 32 * qi + r;
        bf16x8 qf[4];
        {
            const bf16* qp = P_PROJ(F) + (size_t)(b * SEQ + tq) * MIX_IN + C_Q + hq * HD + 8 * hh;
            float qv[4][8]; float ss = 0.f;
#pragma unroll
            for (int ks = 0; ks < 4; ++ks) { const v4u rr = *(const v4u*)(qp + 16 * ks);
                qv[ks][0] = bflo(rr.x); qv[ks][1] = bfhi(rr.x); qv[ks][2] = bflo(rr.y); qv[ks][3] = bfhi(rr.y);
                qv[ks][4] = bflo(rr.z); qv[ks][5] = bfhi(rr.z); qv[ks][6] = bflo(rr.w); qv[ks][7] = bfhi(rr.w);
#pragma unroll
                for (int j = 0; j < 8; ++j) ss += qv[ks][j] * qv[ks][j]; }
            ss += __shfl_xor(ss, 32);
            const float rstd = 1.0f / sqrtf(ss * (1.0f / HD) + EPS);
#pragma unroll
            for (int ks = 0; ks < 4; ++ks)
#pragma unroll
                for (int j = 0; j < 8; ++j) qv[ks][j] = qv[ks][j] * rstd * P_qn_g(F)[16 * ks + 8 * hh + j];
            const float* rp = P_ROPE(F) + (size_t)(b * SEQ + tq) * 16;
#pragma unroll
            for (int j = 0; j < 8; ++j) { const float mine = qv[0][j], other = __shfl_xor(mine, 32); const float cs = rp[j], sn = rp[8 + j];
                qv[0][j] = hh == 0 ? (mine * cs - other * sn) : (mine * cs + other * sn); }
#pragma unroll
            for (int ks = 0; ks < 4; ++ks) { v4u o; o.x = pk2(qv[ks][0] * 0.125f, qv[ks][1] * 0.125f); o.y = pk2(qv[ks][2] * 0.125f, qv[ks][3] * 0.125f);
                o.z = pk2(qv[ks][4] * 0.125f, qv[ks][5] * 0.125f); o.w = pk2(qv[ks][6] * 0.125f, qv[ks][7] * 0.125f); qf[ks] = __builtin_bit_cast(bf16x8, o); }
        }
        f32x16 s[5];
        __builtin_amdgcn_s_setprio(1);
#pragma unroll
        for (int kj = 0; kj < 5; ++kj) {
            f32x16 acc;
#pragma unroll
            for (int i = 0; i < 16; ++i) acc[i] = 0.f;
            const LAS bf16* kp = Ks + (32 * (qi + kj) + r) * KS_STRIDE + 8 * hh;
#pragma unroll
            for (int ks = 0; ks < 4; ++ks) { const bf16x8 kf = *(const LAS bf16x8*)(kp + 16 * ks); acc = MFMA32(kf, qf[ks], acc); }
            s[kj] = acc;
        }
        __builtin_amdgcn_s_setprio(0);
        float mx = sink;
#pragma unroll
        for (int kj = 0; kj < 5; ++kj)
#pragma unroll
            for (int i = 0; i < 16; ++i) { const int kt = (i & 3) + 8 * (i >> 2) + 4 * hh; const int kbi = 32 * (qi + kj) + kt;
                bool valid = (n * 128 + kbi - 128) >= 0;
                if (kj == 0) valid = valid && (kt > r);
                if (kj == 4) valid = valid && (kt <= r);
                s[kj][i] = valid ? s[kj][i] : -INFINITY; mx = fmaxf(mx, s[kj][i]); }
        mx = fmaxf(mx, __shfl_xor(mx, 32));
        float l = 0.f;
#pragma unroll
        for (int kj = 0; kj < 5; ++kj)
#pragma unroll
            for (int i = 0; i < 16; ++i) { const float p = __expf(s[kj][i] - mx); s[kj][i] = p; l += p; }
        l += __shfl_xor(l, 32);
        l += __expf(sink - mx);
        const float inv = 1.0f / l;
        f32x16 o0, o1;
#pragma unroll
        for (int i = 0; i < 16; ++i) { o0[i] = 0.f; o1[i] = 0.f; }
        __builtin_amdgcn_s_setprio(1);
#pragma unroll
        for (int kj = 0; kj < 5; ++kj)
#pragma unroll
            for (int st = 0; st < 2; ++st) {
                v4u pa; pa.x = pk2(s[kj][8 * st + 0] * inv, s[kj][8 * st + 1] * inv); pa.y = pk2(s[kj][8 * st + 2] * inv, s[kj][8 * st + 3] * inv);
                pa.z = pk2(s[kj][8 * st + 4] * inv, s[kj][8 * st + 5] * inv); pa.w = pk2(s[kj][8 * st + 6] * inv, s[kj][8 * st + 7] * inv);
                const bf16x8 pf = __builtin_bit_cast(bf16x8, pa);
                const int kb0 = 32 * (qi + kj) + 16 * st + 4 * hh;
                const LAS bf16* v0p = VT + r * VT_STRIDE + kb0; const LAS bf16* v1p = VT + (32 + r) * VT_STRIDE + kb0;
                const v2u a0 = *(const LAS v2u*)v0p, a1 = *(const LAS v2u*)(v0p + 8), b0 = *(const LAS v2u*)v1p, b1 = *(const LAS v2u*)(v1p + 8);
                const v4u vb0 = {a0.x, a0.y, a1.x, a1.y}, vb1 = {b0.x, b0.y, b1.x, b1.y};
                o0 = MFMA32(pf, __builtin_bit_cast(bf16x8, vb0), o0);
                o1 = MFMA32(pf, __builtin_bit_cast(bf16x8, vb1), o1);
            }
        __builtin_amdgcn_s_setprio(0);
#pragma unroll
        for (int i = 0; i < 16; ++i) { const int qr = (i & 3) + 8 * (i >> 2) + 4 * hh; const int tok = n * 128 + 32 * qi + qr;
            bf16* op = P_XH(F) + (size_t)(b * SEQ + tok) * D + LRU_W + hq * HD + r;
            op[0] = (bf16)f2bf(o0[i]); op[32] = (bf16)f2bf(o1[i]); }
    }
    __syncthreads();
}

constexpr int LCH = 64;
constexpr int XC_STRIDE = 136;
constexpr int LRU_XCB_OFF = 0, LRU_XCF_OFF = LCH * XC_STRIDE * 2  , LRU_A_OFF = LRU_XCF_OFF + LCH * 128 * 4, LRU_B_OFF = LRU_A_OFF + LCH * 128 * 4, LRU_SE_OFF = LRU_B_OFF + LCH * 128 * 4;
static_assert(LRU_SE_OFF + 2 * 4 * 128 * 4 <= RING_BYTES, "LRU LDS");
__device__ __forceinline__ void lru_block(Frame& F) {
    LAS bf16* XCb = (LAS bf16*)(F.lds + LRU_XCB_OFF);
    LAS float* XCF = (LAS float*)(F.lds + LRU_XCF_OFF);
    LAS float* As = (LAS float*)(F.lds + LRU_A_OFF);
    LAS float* Bs = (LAS float*)(F.lds + LRU_B_OFF);
    LAS float* SEh = (LAS float*)(F.lds + LRU_SE_OFF);
    LAS float* SEp = SEh + 4 * 128;
    const int tid = F.tid, lane = F.lane;
    const int hd = F.bid & 7, li = F.bid >> 3, step = F.G >> 3;
    constexpr int NQ = BATCH * (SEQ / LCH);
    if (li >= NQ) return;
    const int cg = tid & 15, tp = tid >> 4, colc = hd * LRU_BLK + 8 * cg;
    float cw[4][8], cbv[8];
#pragma unroll
    for (int k = 0; k < 4; ++k) { const f32x4 a = *(const f32x4*)(P_conv_w(F) + k * LRU_W + colc), b2 = *(const f32x4*)(P_conv_w(F) + k * LRU_W + colc + 4);
        cw[k][0] = a.x; cw[k][1] = a.y; cw[k][2] = a.z; cw[k][3] = a.w; cw[k][4] = b2.x; cw[k][5] = b2.y; cw[k][6] = b2.z; cw[k][7] = b2.w; }
    { const f32x4 a = *(const f32x4*)(P_conv_b(F) + colc), b2 = *(const f32x4*)(P_conv_b(F) + colc + 4);
      cbv[0] = a.x; cbv[1] = a.y; cbv[2] = a.z; cbv[3] = a.w; cbv[4] = b2.x; cbv[5] = b2.y; cbv[6] = b2.z; cbv[7] = b2.w; }
    const int fr = lane & 15, fq = lane >> 4, j = 16 * F.wave + fr, jc = hd * LRU_BLK + j;
    bf16x8 wa[4], wx[4];
    { const bf16* wap = P_WGA(F) + (size_t)hd * 16384 + (size_t)j * 128 + 8 * fq; const bf16* wxp = P_WGX(F) + (size_t)hd * 16384 + (size_t)j * 128 + 8 * fq;
#pragma unroll
      for (int ks = 0; ks < 4; ++ks) { wa[ks] = *(const bf16x8*)(wap + 32 * ks); wx[ks] = *(const bf16x8*)(wxp + 32 * ks); } }
    const float ba = P_ga_b(F)[jc], bx = P_gx_b(F)[jc];
    const float sp8 = -8.0f * log1pf(__expf(-P_lam(F)[jc]));
    const int c = tid & 127, sub = tid >> 7, col = hd * LRU_BLK + c;
    const bf16* xbase = P_PROJ(F) + colc;
    bf16* HLp = P_HL(F); bf16* PAp = P_PA(F);
    v4u xr[5];
#define LRU_LOAD_X(q_) do { const int b_ = (q_) >> 6, ch_ = (q_) & 63; const int tr_ = ch_ * LCH + 2 * tp - 3; \
        _Pragma("unroll") for (int r_ = 0; r_ < 5; ++r_) { const int t_ = tr_ + r_; \
            xr[r_] = (t_ >= 0) ? *(const v4u*)(xbase + (size_t)(b_ * SEQ + t_) * MIX_IN) : (v4u){0u, 0u, 0u, 0u}; } } while (0)
    LRU_LOAD_X(li);
    for (int q = li; q < NQ; q += step) {
        const int b = q >> 6, ch = q & 63, t0 = ch * LCH;
        {
            float xv[5][8];
#pragma unroll
            for (int r = 0; r < 5; ++r) { xv[r][0] = bflo(xr[r].x); xv[r][1] = bfhi(xr[r].x); xv[r][2] = bflo(xr[r].y); xv[r][3] = bfhi(xr[r].y);
                xv[r][4] = bflo(xr[r].z); xv[r][5] = bfhi(xr[r].z); xv[r][6] = bflo(xr[r].w); xv[r][7] = bfhi(xr[r].w); }
            if (q + step < NQ) LRU_LOAD_X(q + step);
#pragma unroll
            for (int tk = 0; tk < 2; ++tk) { float xc[8];
#pragma unroll
                for (int e = 0; e < 8; ++e) xc[e] = cbv[e] + cw[0][e] * xv[tk][e] + cw[1][e] * xv[tk + 1][e] + cw[2][e] * xv[tk + 2][e] + cw[3][e] * xv[tk + 3][e];
                const int tl = 2 * tp + tk;
                v4u o; o.x = pk2(xc[0], xc[1]); o.y = pk2(xc[2], xc[3]); o.z = pk2(xc[4], xc[5]); o.w = pk2(xc[6], xc[7]);
                *(LAS v4u*)(XCb + tl * XC_STRIDE + 8 * cg) = o;
                *(LAS f32x4*)(XCF + tl * 128 + 8 * cg) = (f32x4){xc[0], xc[1], xc[2], xc[3]}; *(LAS f32x4*)(XCF + tl * 128 + 8 * cg + 4) = (f32x4){xc[4], xc[5], xc[6], xc[7]}; }
        }
        __syncthreads();
#pragma unroll
        for (int mt = 0; mt < 4; ++mt) {
            f32x4 ra = {0.f, 0.f, 0.f, 0.f}, rx = {0.f, 0.f, 0.f, 0.f};
            const LAS bf16* ap = XCb + (16 * mt + fr) * XC_STRIDE + 8 * fq;
#pragma unroll
            for (int ks = 0; ks < 4; ++ks) { const bf16x8 af = *(const LAS bf16x8*)(ap + 32 * ks); ra = MFMA16(af, wa[ks], ra); rx = MFMA16(af, wx[ks], rx); }
#pragma unroll
            for (int e = 0; e < 4; ++e) { const int tl = 16 * mt + 4 * fq + e;
                const float rg = sigmoidf_(ra[e] + ba), ig = sigmoidf_(rx[e] + bx);
                const float a = __expf(rg * sp8);
                const float mult = sqrtf(fmaxf(fmaf(-a, a, 1.0f), 0.f));
                As[tl * 128 + j] = a; Bs[tl * 128 + j] = mult * ig * XCF[tl * 128 + j]; }
        }
        __syncthreads();
        float hh[16], pp[16];
        {
            float h = 0.f, P = 1.f;
#pragma unroll
            for (int i = 0; i < 16; ++i) { const int tl = sub * 16 + i; const float a = As[tl * 128 + c], bq = Bs[tl * 128 + c];
                h = a * h + bq; P *= a; hh[i] = h; pp[i] = P; }
            SEh[sub * 128 + c] = h; SEp[sub * 128 + c] = P;
        }
        __syncthreads();
        {
            float carry = 0.f, pre = 1.f;
            for (int s2 = 0; s2 < sub; ++s2) { carry = SEh[s2 * 128 + c] + SEp[s2 * 128 + c] * carry; pre *= SEp[s2 * 128 + c]; }
            bf16* hl = HLp + (size_t)(b * SEQ + t0 + sub * 16) * LRU_W + col;
            bf16* pa = PAp + (size_t)(b * SEQ + t0 + sub * 16) * LRU_W + col;
#pragma unroll
            for (int i = 0; i < 16; ++i) { hl[(size_t)i * LRU_W] = (bf16)f2bf(hh[i] + pp[i] * carry); pa[(size_t)i * LRU_W] = (bf16)f2bf(pp[i] * pre); }
        }
    }
#undef LRU_LOAD_X
    __syncthreads();
}
constexpr int N_ATT_UNITS = BATCH * HKV * (SEQ / 128);
constexpr int N_LRU_UNITS = BATCH * LRU_HEADS * (SEQ / LCH);
__device__ __forceinline__ void p3_phase(Frame& F) {
    for (int u = F.bid; u < N_ATT_UNITS; u += F.G) attn_unit(F, u >> 6, (u >> 5) & 1, u & 31);
    lru_block(F);
}

__device__ __forceinline__ void p4_unit(Frame& F, int b, int ch) {
    LAS float* CAR = (LAS float*)F.lds;
    const int tid = F.tid, lane = F.lane;
    {
        f32x2 carry = {0.f, 0.f};
        const bf16* hlb = P_HL(F) + (size_t)(b * SEQ + LCH - 1) * LRU_W + 2 * tid; const bf16* pab = P_PA(F) + (size_t)(b * SEQ + LCH - 1) * LRU_W + 2 * tid;
        int c2 = 0;
        for (; c2 + 8 <= ch; c2 += 8) { unsigned hl[8], pa[8];
#pragma unroll
            for (int q = 0; q < 8; ++q) { hl[q] = *(const unsigned*)(hlb + (size_t)(c2 + q) * LCH * LRU_W); pa[q] = *(const unsigned*)(pab + (size_t)(c2 + q) * LCH * LRU_W); }
#pragma unroll
            for (int q = 0; q < 8; ++q) { carry.x = bflo(hl[q]) + bflo(pa[q]) * carry.x; carry.y = bfhi(hl[q]) + bfhi(pa[q]) * carry.y; } }
        for (; c2 < ch; ++c2) { const unsigned hl = *(const unsigned*)(hlb + (size_t)c2 * LCH * LRU_W), pa = *(const unsigned*)(pab + (size_t)c2 * LCH * LRU_W);
            carry.x = bflo(hl) + bflo(pa) * carry.x; carry.y = bfhi(hl) + bfhi(pa) * carry.y; }
        CAR[2 * tid] = carry.x; CAR[2 * tid + 1] = carry.y;
    }
    __syncthreads();
    const float* gl = P_on_lru_g(F); const float* ga = P_on_attn_g(F);
    for (int i = 0; i < 8; i += 2) {
        const size_t m0 = (size_t)b * SEQ + ch * LCH + F.wave * 8 + i;
        v2u hl[2][4], pa[2][4]; v2u yr[2][4], ar[2][4];
#pragma unroll
        for (int t = 0; t < 2; ++t)
#pragma unroll
            for (int j = 0; j < 4; ++j) { const int c = 4 * lane + 256 * j; const size_t m = m0 + t;
                hl[t][j] = *(const v2u*)(P_HL(F) + m * LRU_W + c); pa[t][j] = *(const v2u*)(P_PA(F) + m * LRU_W + c);
                yr[t][j] = *(const v2u*)(P_PROJ(F) + m * MIX_IN + C_Y + c); ar[t][j] = *(const v2u*)(P_XH(F) + m * D + LRU_W + c); }
        f32x4 vl[2][4], va[2][4]; float sl[2] = {0.f, 0.f}, sa[2] = {0.f, 0.f};
#pragma unroll
        for (int t = 0; t < 2; ++t)
#pragma unroll
            for (int j = 0; j < 4; ++j) { const int c = 4 * lane + 256 * j; const f32x4 car = *(const LAS f32x4*)(CAR + c);
                const f32x4 hlf = {bflo(hl[t][j].x), bfhi(hl[t][j].x), bflo(hl[t][j].y), bfhi(hl[t][j].y)}, paf = {bflo(pa[t][j].x), bfhi(pa[t][j].x), bflo(pa[t][j].y), bfhi(pa[t][j].y)};
                const f32x4 h = hlf + paf * car;
                f32x4 v; v.x = h.x * gelu_tanh(bflo(yr[t][j].x)); v.y = h.y * gelu_tanh(bfhi(yr[t][j].x)); v.z = h.z * gelu_tanh(bflo(yr[t][j].y)); v.w = h.w * gelu_tanh(bfhi(yr[t][j].y));
                vl[t][j] = v; sl[t] += (v.x * v.x + v.y * v.y) + (v.z * v.z + v.w * v.w);
                f32x4 a; a.x = bflo(ar[t][j].x); a.y = bfhi(ar[t][j].x); a.z = bflo(ar[t][j].y); a.w = bfhi(ar[t][j].y);
                va[t][j] = a; sa[t] += (a.x * a.x + a.y * a.y) + (a.z * a.z + a.w * a.w); }
#pragma unroll
        for (int o = 1; o < 64; o <<= 1) { sl[0] += __shfl_xor(sl[0], o); sl[1] += __shfl_xor(sl[1], o); sa[0] += __shfl_xor(sa[0], o); sa[1] += __shfl_xor(sa[1], o); }
#pragma unroll
        for (int t = 0; t < 2; ++t) { const float rl = 1.0f / sqrtf(sl[t] * (1.0f / LRU_W) + EPS), ra = 1.0f / sqrtf(sa[t] * (1.0f / LRU_W) + EPS); const size_t m = m0 + t;
#pragma unroll
            for (int j = 0; j < 4; ++j) { const int c = 4 * lane + 256 * j; const f32x4 g1v = *(const f32x4*)(gl + c), g2v = *(const f32x4*)(ga + c);
                const f32x4 y = vl[t][j] * rl * g1v, z = va[t][j] * ra * g2v;
                v2u o; o.x = pk2(y.x, y.y); o.y = pk2(y.z, y.w); *(v2u*)(P_XH(F) + m * D + c) = o;
                v2u p; p.x = pk2(z.x, z.y); p.y = pk2(z.z, z.w); *(v2u*)(P_XH(F) + m * D + LRU_W + c) = p; } }
    }
    __syncthreads();
}
__device__ __forceinline__ void p4_phase(Frame& F) {
    for (int u = F.bid; u < BATCH * (SEQ / LCH); u += F.G) p4_unit(F, u >> 6, u & 63);
}

__device__ __forceinline__ int f2key(float f) { const int b = __builtin_bit_cast(int, f); return b ^ ((b >> 31) & 0x7fffffff); }
__device__ __forceinline__ float key2f(int k) { const int b = k ^ ((k >> 31) & 0x7fffffff); return __builtin_bit_cast(float, b); }
__device__ __forceinline__ void ins16(int (&L)[16], int x) {
#pragma unroll
    for (int j = 0; j < 16; ++j) { const int hi = max(L[j], x); x = min(L[j], x); L[j] = hi; }
}
__device__ __forceinline__ void ce_desc(int& a, int& b) { const int hi = a > b ? a : b, lo = a > b ? b : a; a = hi; b = lo; }
__device__ __forceinline__ void sort16_desc(int (&a)[16]) {
#pragma unroll
    for (int k = 2; k <= 16; k <<= 1)
#pragma unroll
        for (int j = k >> 1; j > 0; j >>= 1)
#pragma unroll
            for (int i = 0; i < 16; ++i) { const int l = i ^ j; if (l > i) { if ((i & k) == 0) ce_desc(a[i], a[l]); else ce_desc(a[l], a[i]); } }
}
__device__ __forceinline__ void bitonic_merge16_desc(int (&a)[16]) {
#pragma unroll
    for (int j = 8; j > 0; j >>= 1)
#pragma unroll
        for (int i = 0; i < 16; ++i) { const int l = i ^ j; if (l > i) ce_desc(a[i], a[l]); }
}
__device__ __forceinline__ void merge_top16(int (&a)[16], const int (&b)[16]) {
#pragma unroll
    for (int i = 0; i < 16; ++i) a[i] = a[i] > b[15 - i] ? a[i] : b[15 - i];
    bitonic_merge16_desc(a);
}
constexpr int INT_LOWEST = (int)0x80000000;
__device__ __forceinline__ void p8_item(Frame& F, int tt, int hd, LAS int* lut  ) {
    const int lane = F.lane, r = lane & 31, hh = lane >> 5;
    const bf16* QP = P_PROJ(F);
    int V[2][16];
#pragma unroll
    for (int p = 0; p < 2; ++p) {
        bf16x8 qf[8];
        const char* qb = (const char*)(QP + (size_t)(32 * tt) * D + hd * 256 + p * 128);
        const unsigned qoff = (unsigned)(r * D + 8 * hh) * 2u;
#pragma unroll
        for (int ks = 0; ks < 8; ++ks) qf[ks] = *(const bf16x8*)(qb + qoff + 32 * ks);
        int L[16];
#pragma unroll
        for (int j = 0; j < 16; ++j) L[j] = INT_LOWEST;
        const char* skb = (const char*)(P_SK(F) + (size_t)((hd * 2 + p) * PKEYS) * PHALF);
        const unsigned skoff = (unsigned)(r * PHALF + 8 * hh) * 2u;
#pragma unroll 1
        for (int kt = 0; kt < 4; ++kt) {
            f32x16 acc;
#pragma unroll
            for (int i = 0; i < 16; ++i) acc[i] = 0.f;
            const char* skt = skb + (size_t)(32 * kt) * PHALF * 2;
#pragma unroll
            for (int ks = 0; ks < 8; ++ks) { const bf16x8 kf = *(const bf16x8*)(skt + skoff + 32 * ks); acc = MFMA32(kf, qf[ks], acc); }
            const int kbase = 32 * kt + 4 * hh;
            int T[16];
#pragma unroll
            for (int i = 0; i < 16; ++i) { const int kidx = (i & 3) + 8 * (i >> 2); T[i] = (f2key(acc[i]) & ~0x7f) | (kbase + kidx); }
            sort16_desc(T); merge_top16(L, T);
        }
        int O[16];
#pragma unroll
        for (int j = 0; j < 16; ++j) O[j] = __shfl_xor(L[j], 32);
        merge_top16(L, O);
#pragma unroll
        for (int j = 0; j < 16; ++j) V[p][j] = L[j];
    }
#pragma unroll
    for (int j = 0; j < 16; ++j) { lut[lane * 33 + j] = V[0][j] & 0x7f; lut[lane * 33 + 16 + j] = V[1][j] & 0x7f; }
    float v0[16], v1[16];
#pragma unroll
    for (int j = 0; j < 16; ++j) { v0[j] = key2f(V[0][j] & ~0x7f); v1[j] = key2f(V[1][j] & ~0x7f); }
    int C[16], G1[16], G2[16], G3[2];
    { int n = 0;
#pragma unroll
      for (int i = 0; i < 16; ++i)
#pragma unroll
        for (int j = 0; j < 16; ++j)
            if ((i + 1) * (j + 1) <= 16) { const int key = (f2key(v0[i] + v1[j]) & ~0xff) | (i * 16 + j);
                if (n < 16) C[n] = key; else if (n < 32) G1[n - 16] = key; else if (n < 48) G2[n - 32] = key; else G3[n - 48] = key;
                ++n; } }
    sort16_desc(C); sort16_desc(G1); sort16_desc(G2);
    merge_top16(C, G1); merge_top16(C, G2); ins16(C, G3[0]); ins16(C, G3[1]);
    float sv[16]; float den = 0.f;
    const float mx = key2f(C[0] & ~0xff);
#pragma unroll
    for (int e = 0; e < 16; ++e) { sv[e] = __expf(key2f(C[e] & ~0xff) - mx); den += sv[e]; }
    const float inv = 1.0f / den;
    LDS_WAIT(); asm volatile("" ::: "memory");
    int idx[16];
#pragma unroll
    for (int e = 0; e < 16; ++e) { const int pi = (C[e] >> 4) & 15, pj = C[e] & 15; idx[e] = lut[lane * 33 + pi] * PKEYS + lut[lane * 33 + 16 + pj]; }
    if (hh == 0) {
        unsigned short* ip = P_IDX(F) + (size_t)(32 * tt + r) * 128 + hd * 16; float* gp = P_GW(F) + (size_t)(32 * tt + r) * 128 + hd * 16;
#pragma unroll
        for (int q = 0; q < 2; ++q) *(v4u*)(ip + 8 * q) = (v4u){(unsigned)idx[8 * q] | ((unsigned)idx[8 * q + 1] << 16), (unsigned)idx[8 * q + 2] | ((unsigned)idx[8 * q + 3] << 16),
                                                              (unsigned)idx[8 * q + 4] | ((unsigned)idx[8 * q + 5] << 16), (unsigned)idx[8 * q + 6] | ((unsigned)idx[8 * q + 7] << 16)};
#pragma unroll
        for (int q = 0; q < 4; ++q) *(f32x4*)(gp + 4 * q) = (f32x4){sv[4 * q] * inv, sv[4 * q + 1] * inv, sv[4 * q + 2] * inv, sv[4 * q + 3] * inv};
    }
    LDS_WAIT(); asm volatile("" ::: "memory");
}
__device__ __forceinline__ void p8_phase(Frame& F) {
    LAS int* lut = (LAS int*)(F.lds + F.wave * (64 * 33 * 4));
    const int gw = F.bid * NWAVES + F.wave, NGW = F.G * NWAVES;
    for (int it = gw; it < (M / 32) * PH; it += NGW) p8_item(F, it >> 3, it & 7, lut);
}

template <int CTRL> __device__ __forceinline__ float dpp_f(float x) { return __builtin_bit_cast(float, __builtin_amdgcn_mov_dpp(__builtin_bit_cast(int, x), CTRL, 0xf, 0xf, true)); }
__device__ __forceinline__ float sum8(float v) {
    v += dpp_f<0xB1>(v);
    v += dpp_f<0x4E>(v);
    v += dpp_f<0x141>(v);
    return v;
}
__device__ __forceinline__ void dec16(const v4u r, float (&f)[16]) {
    const unsigned w4[4] = {r.x, r.y, r.z, r.w};
#pragma unroll
    for (int w = 0; w < 4; ++w) { const f32x2 lo = __builtin_amdgcn_cvt_pk_f32_fp8((int)w4[w], false), hi = __builtin_amdgcn_cvt_pk_f32_fp8((int)w4[w], true);
        f[4 * w] = lo.x; f[4 * w + 1] = lo.y; f[4 * w + 2] = hi.x; f[4 * w + 3] = hi.y; }
}
__device__ __forceinline__ void row_offsets(const v4u a, const v4u b, unsigned loff, unsigned (&off)[16]) {
    const unsigned w[8] = {a.x, a.y, a.z, a.w, b.x, b.y, b.z, b.w};
#pragma unroll
    for (int q = 0; q < 8; ++q) { off[2 * q] = ((w[q] & 0xffffu) << 7) + loff; off[2 * q + 1] = ((w[q] >> 16) << 7) + loff; }
}
#define ISSUE_ROWS(dst, TBL, ia, ib) do { unsigned off_[16]; row_offsets((ia), (ib), loff, off_); \
    _Pragma("unroll") for (int i_ = 0; i_ < 16; ++i_) dst[i_] = *(const v4u*)((TBL) + off_[i_]); } while (0)

typedef int i32x8 __attribute__((ext_vector_type(8)));
#define MFMA_F4F8(a, b, c) __builtin_amdgcn_mfma_scale_f32_16x16x128_f8f6f4((a), (b), (c), 4  , 0  , 0, 0x7f7f7f7f, 0, 0x7f7f7f7f)
#define ISSUE_ROWS_U(dst, i0, i1) do { const unsigned w_[8] = {(i0).x, (i0).y, (i0).z, (i0).w, (i1).x, (i1).y, (i1).z, (i1).w}; \
    _Pragma("unroll") for (int g_ = 0; g_ < 16; ++g_) { const unsigned id_ = (g_ & 1) ? (w_[g_ >> 1] >> 16) : (w_[g_ >> 1] & 0xffffu); \
        dst[g_] = *(const v4u*)(U4 + ((id_ << 7) + loff)); } } while (0)
__device__ __forceinline__ void p9u_compute(const v4u (&row)[16], const v4u hA0, const v4u hA1, const v4u hB0, const v4u hB1, int lane, bf16* dst) {
    const i32x8 B0 = {(int)hA0.x, (int)hA0.y, (int)hA0.z, (int)hA0.w, (int)hA1.x, (int)hA1.y, (int)hA1.z, (int)hA1.w};
    const i32x8 B1 = {(int)hB0.x, (int)hB0.y, (int)hB0.z, (int)hB0.w, (int)hB1.x, (int)hB1.y, (int)hB1.z, (int)hB1.w};
    const int n = lane & 15, q = lane >> 4, e4 = n >> 2;
    const f32x4 zero = {0.f, 0.f, 0.f, 0.f};
    float res[16];
    __builtin_amdgcn_s_setprio(1);
#pragma unroll
    for (int g = 0; g < 16; ++g) {
        const i32x8 a = {(int)row[g].x, (int)row[g].y, (int)row[g].z, (int)row[g].w, 0, 0, 0, 0};
        const f32x4 d0 = MFMA_F4F8(a, B0, zero), d1 = MFMA_F4F8(a, B1, zero);
        float v0 = d0[0]; v0 = e4 == 1 ? d0[1] : v0; v0 = e4 == 2 ? d0[2] : v0; v0 = e4 == 3 ? d0[3] : v0;
        float v1 = d1[0]; v1 = e4 == 1 ? d1[1] : v1; v1 = e4 == 2 ? d1[2] : v1; v1 = e4 == 3 ? d1[3] : v1;
        float val = (q & 1) ? v1 : v0;
        val = val + dpp_f<0x124>(val) + dpp_f<0x128>(val) + dpp_f<0x12C>(val);
        val += __shfl_xor(val, 16);
        res[g] = val;
    }
    __builtin_amdgcn_s_setprio(0);
    if ((lane & 0x1c) == 0) {
        bf16* d = dst + 16 * (2 * (n & 3) + (q >> 1));
        v4u o0, o1;
        o0.x = pk2(res[0], res[1]); o0.y = pk2(res[2], res[3]); o0.z = pk2(res[4], res[5]); o0.w = pk2(res[6], res[7]);
        o1.x = pk2(res[8], res[9]); o1.y = pk2(res[10], res[11]); o1.z = pk2(res[12], res[13]); o1.w = pk2(res[14], res[15]);
        *(v4u*)d = o0; *(v4u*)(d + 8) = o1;
    }
}
__device__ __forceinline__ void p9u_item(Frame& F, int s, int tb) {
    const int lane = F.lane, sg = lane & 7, r8 = lane >> 3, n = lane & 15, kq = lane >> 4;
    const unsigned char* U4 = P_U(F);
    const unsigned loff = (unsigned)(s * (NEXP * 128) + 16 * sg);
    const unsigned short* idxb = P_IDX(F) + (size_t)(64 * tb) * 128 + 16 * r8;
    const unsigned char* hb = P_H8(F) + (size_t)(64 * tb) * D + 256 * s + 32 * (n >> 2) + 16 * (kq & 1);
    const bool bon = (kq >> 1) == (n & 1); const bool bhi = (n & 2) != 0;
    bf16* pb = (bf16*)P_PART(F) + ((size_t)s * M + 64 * tb) * 128;
#define LOAD_META_U(I0, I1, A0, A1, B0, B1, tt_) do { const int tn_ = (tt_) < 64 ? (tt_) : 63; const unsigned short* ip_ = idxb + (size_t)tn_ * 128; I0 = *(const v4u*)(ip_); I1 = *(const v4u*)(ip_ + 8); \
        const unsigned char* hp_ = hb + (size_t)tn_ * D; const v4u z_ = {0u, 0u, 0u, 0u}; \
        const v4u x0_ = bon ? *(const v4u*)(hp_) : z_, x1_ = bon ? *(const v4u*)(hp_ + 128) : z_; \
        A0 = bhi ? z_ : x0_; A1 = bhi ? x0_ : z_; B0 = bhi ? z_ : x1_; B1 = bhi ? x1_ : z_; } while (0)
    v4u aI0, aI1, aA0, aA1, aB0, aB1, bI0, bI1, bA0, bA1, bB0, bB1, cI0, cI1, cA0, cA1, cB0, cB1, dI0, dI1, dA0, dA1, dB0, dB1;
    LOAD_META_U(aI0, aI1, aA0, aA1, aB0, aB1, 0); LOAD_META_U(bI0, bI1, bA0, bA1, bB0, bB1, 1); LOAD_META_U(cI0, cI1, cA0, cA1, cB0, cB1, 2);
    v4u rowA[16], rowB[16];
    ISSUE_ROWS_U(rowA, aI0, aI1); ISSUE_ROWS_U(rowB, bI0, bI1);
#pragma unroll 1
    for (int t = 0; t < 64; t += 2) {
        p9u_compute(rowA, aA0, aA1, aB0, aB1, lane, pb + (size_t)t * 128);
        LOAD_META_U(dI0, dI1, dA0, dA1, dB0, dB1, t + 3);
        ISSUE_ROWS_U(rowA, cI0, cI1);
        p9u_compute(rowB, bA0, bA1, bB0, bB1, lane, pb + (size_t)(t + 1) * 128);
        aA0 = cA0; aA1 = cA1; aB0 = cB0; aB1 = cB1; bA0 = dA0; bA1 = dA1; bB0 = dB0; bB1 = dB1;
        LOAD_META_U(cI0, cI1, cA0, cA1, cB0, cB1, t + 4);
        ISSUE_ROWS_U(rowB, dI0, dI1);
    }
#undef LOAD_META_U
}
#define MFMA_F8F4(a, b, c) __builtin_amdgcn_mfma_scale_f32_16x16x128_f8f6f4((a), (b), (c), 0  , 4  , 0, 0x7f7f7f7f, 0, 0x7f7f7f7f)
#define ISSUE_ROWS_V(dst, i0, i1) do { const unsigned w_[8] = {(i0).x, (i0).y, (i0).z, (i0).w, (i1).x, (i1).y, (i1).z, (i1).w}; \
    _Pragma("unroll") for (int g_ = 0; g_ < 16; ++g_) { const unsigned id_ = (g_ & 1) ? (w_[g_ >> 1] >> 16) : (w_[g_ >> 1] & 0xffffu); \
        dst[g_] = *(const v4u*)(V4 + ((id_ << 7) + loff)); } } while (0)
struct VLane { unsigned shl, m00, m01, m10, m11; };
__device__ __forceinline__ void p9v_compute(const v4u (&row)[16], const v4u wlo, const v4u whi, int lane, const VLane L, const bf16* xp, const f32x4 (&g2)[4], float wscale, float* dst) {
    v2u x1[4];
#pragma unroll
    for (int t = 0; t < 4; ++t) x1[t] = *(const v2u*)(xp + 8 * t);
    f32x4 d[4];
#pragma unroll
    for (int t = 0; t < 4; ++t) d[t] = (f32x4){0.f, 0.f, 0.f, 0.f};
    const unsigned wl4[4] = {wlo.x, wlo.y, wlo.z, wlo.w}, wh4[4] = {whi.x, whi.y, whi.z, whi.w};
    i32x8 a0 = {0, 0, 0, 0, 0, 0, 0, 0}, a1 = a0, a2 = a0, a3 = a0;
    __builtin_amdgcn_s_setprio(1);
#pragma unroll
    for (int g = 0; g < 16; ++g) {
        const unsigned lo = ((wl4[g >> 2] >> (8 * (g & 3))) & 0xffu) << L.shl, hi = ((wh4[g >> 2] >> (8 * (g & 3))) & 0xffu) << L.shl;
        const int l00 = (int)(lo & L.m00), l01 = (int)(lo & L.m01), h00 = (int)(hi & L.m00), h01 = (int)(hi & L.m01);
        const int l10 = (int)(lo & L.m10), l11 = (int)(lo & L.m11), h10 = (int)(hi & L.m10), h11 = (int)(hi & L.m11);
        const i32x8 b = {(int)row[g].x, (int)row[g].y, (int)row[g].z, (int)row[g].w, 0, 0, 0, 0};
        a0[0] = l00; a0[1] = l01; a0[4] = h00; a0[5] = h01;   a1[2] = l00; a1[3] = l01; a1[6] = h00; a1[7] = h01;
        a2[0] = l10; a2[1] = l11; a2[4] = h10; a2[5] = h11;   a3[2] = l10; a3[3] = l11; a3[6] = h10; a3[7] = h11;
        d[0] = MFMA_F8F4(a0, b, d[0]); d[1] = MFMA_F8F4(a1, b, d[1]); d[2] = MFMA_F8F4(a2, b, d[2]); d[3] = MFMA_F8F4(a3, b, d[3]);
    }
    __builtin_amdgcn_s_setprio(0);
#pragma unroll
    for (int t = 0; t < 4; ++t)
#pragma unroll
        for (int e = 0; e < 4; ++e) d[t][e] += __shfl_xor(d[t][e], 40);
    if ((lane & 40) == 0) {
#pragma unroll
        for (int t = 0; t < 4; ++t) { const f32x4 xv = {bflo(x1[t].x), bfhi(x1[t].x), bflo(x1[t].y), bfhi(x1[t].y)};
            *(f32x4*)(dst + 8 * t) = xv + g2[t] * (d[t] * wscale); }
    }
}
__device__ __forceinline__ void p9v_item(Frame& F, int s, int tb) {
    const int lane = F.lane, sg = lane & 7, r8 = lane >> 3;
    const unsigned char* V4 = P_V(F);
    const unsigned loff = (unsigned)(s * (NEXP * 128) + 16 * sg);
    const unsigned short* idxb = P_IDX(F) + (size_t)(64 * tb) * 128 + 16 * r8;
    const int ai = lane & 15, kqa = lane >> 4;
    VLane L; L.shl = 8u * (unsigned)(ai & 3);
    { const bool d1 = (ai & 4) != 0, hiv = (kqa & 1) != 0;
      L.m00 = (!hiv && !d1) ? 0xffffffffu : 0u; L.m01 = (!hiv && d1) ? 0xffffffffu : 0u; L.m10 = (hiv && !d1) ? 0xffffffffu : 0u; L.m11 = (hiv && d1) ? 0xffffffffu : 0u; }
    const unsigned char* wbl = P_W(F) + (size_t)(64 * tb) * 128 + 16 * (2 * (kqa >> 1) + (ai >> 3));
    const unsigned char* wbh = wbl + 64;
    const float* wscp = P_WSC(F) + 64 * tb;
    const int b = (64 * tb) / SEQ;
    const int ocol = 256 * s + 32 * (lane & 7) + 4 * ((lane >> 4) & 1);
    f32x4 g2[4];
#pragma unroll
    for (int t = 0; t < 4; ++t) g2[t] = *(const f32x4*)(P_ADA(F) + (size_t)b * ADA_W + 5 * D + ocol + 8 * t);
    float* ob = P_out(F) + (size_t)(64 * tb) * D + ocol;
    const bf16* xb = P_X1B(F) + (size_t)(64 * tb) * D + ocol;
#define LOAD_META_V(I0, I1, WL, WH, WS, tt_) do { const int tn_ = (tt_) < 64 ? (tt_) : 63; const unsigned short* ip_ = idxb + (size_t)tn_ * 128; I0 = *(const v4u*)(ip_); I1 = *(const v4u*)(ip_ + 8); \
        WL = *(const v4u*)(wbl + (size_t)tn_ * 128); WH = *(const v4u*)(wbh + (size_t)tn_ * 128); WS = wscp[tn_]; } while (0)
    v4u aI0, aI1, aWL, aWH, bI0, bI1, bWL, bWH, cI0, cI1, cWL, cWH, dI0, dI1, dWL, dWH; float aS, bS, cS, dS;
    LOAD_META_V(aI0, aI1, aWL, aWH, aS, 0); LOAD_META_V(bI0, bI1, bWL, bWH, bS, 1); LOAD_META_V(cI0, cI1, cWL, cWH, cS, 2);
    v4u rowA[16], rowB[16];
    ISSUE_ROWS_V(rowA, aI0, aI1); ISSUE_ROWS_V(rowB, bI0, bI1);
#pragma unroll 1
    for (int t = 0; t < 64; t += 2) {
        p9v_compute(rowA, aWL, aWH, lane, L, xb + (size_t)t * D, g2, aS, ob + (size_t)t * D);
        LOAD_META_V(dI0, dI1, dWL, dWH, dS, t + 3);
        ISSUE_ROWS_V(rowA, cI0, cI1);
        p9v_compute(rowB, bWL, bWH, lane, L, xb + (size_t)(t + 1) * D, g2, bS, ob + (size_t)(t + 1) * D);
        aWL = cWL; aWH = cWH; aS = cS; bWL = dWL; bWH = dWH; bS = dS;
        LOAD_META_V(cI0, cI1, cWL, cWH, cS, t + 4);
        ISSUE_ROWS_V(rowB, dI0, dI1);
    }
#undef LOAD_META_V
}
__device__ __forceinline__ void p9u_phase(Frame& F) {
    const int x = F.bid & 7, rank = F.bid >> 3, nr = F.G >> 3;
    for (int tb = rank * NWAVES + F.wave; tb < M / 64; tb += nr * NWAVES) p9u_item(F, x, tb);
}
__device__ __forceinline__ void p9v_phase(Frame& F) {
    const int x = F.bid & 7, rank = F.bid >> 3, nr = F.G >> 3;
    for (int tb = rank * NWAVES + F.wave; tb < M / 64; tb += nr * NWAVES) p9v_item(F, x, tb);
}
__device__ __forceinline__ void p9w_phase(Frame& F) {
    const unsigned* part = P_PART(F); const unsigned short* idxp = P_IDX(F); const float* gwp = P_GW(F); const float* usc = P_USC(F); const float* vsc = P_VSC(F);
    unsigned char* wp = P_W(F); float* wsc = P_WSC(F);
    for (int it = F.bid * 512 + F.tid; it < M * 64; it += F.G * 512) {
        float a0 = 0.f, a1 = 0.f;
#pragma unroll
        for (int s = 0; s < 8; ++s) { const unsigned w = part[(size_t)s * M * 64 + it]; a0 += bflo(w); a1 += bfhi(w); }
        const int m = it >> 6; const size_t p0 = 2 * (size_t)it;
        const unsigned iw = *(const unsigned*)(idxp + p0); const int i0 = iw & 0xffffu, i1 = iw >> 16;
        const f32x2 gw = *(const f32x2*)(gwp + p0);
        const float w0 = gw.x * gelu_tanh(a0 * usc[i0]) * vsc[i0], w1 = gw.y * gelu_tanh(a1 * usc[i1]) * vsc[i1];
        float mx = fmaxf(fabsf(w0), fabsf(w1));
#pragma unroll
        for (int o = 1; o < 64; o <<= 1) mx = fmaxf(mx, __shfl_xor(mx, o));
        const float sc = 224.0f / fmaxf(mx, 1e-30f);
        const int t = __builtin_amdgcn_cvt_pk_fp8_f32(w0 * sc, w1 * sc, 0, false);
        *(unsigned short*)(wp + p0) = (unsigned short)(t & 0xffff);
        if ((it & 63) == 0) wsc[m] = fmaxf(mx, 1e-30f) * (1.0f / 224.0f);
    }
}

struct Args { const void* in[25]; float* out; unsigned char* ws; int ph_lo, ph_hi; };
__global__ void __launch_bounds__(NWAVES * 64, 2) hymba_fwd(Args args) {
    extern __shared__ __attribute__((aligned(16))) unsigned char lds_raw[];
    Frame F;
    F.lds = (LAS unsigned char*)lds_raw;
    F.tid = threadIdx.x; F.lane = F.tid & 63; F.wave = __builtin_amdgcn_readfirstlane(F.tid >> 6);
    F.G = gridDim.x; F.bid = blockIdx.x;
    F.ka = (kaptr_t)__builtin_amdgcn_kernarg_segment_ptr();
    static_assert(sizeof(Args) == 224, "kernarg byte offsets used by ka_ptr");
    for (int u = F.tid; u < (LDS_BYTES - LDSCTL_OFF) / 4; u += NWAVES * 64) ((LAS unsigned*)(F.lds + LDSCTL_OFF))[u] = 0u;
    __syncthreads();
    volatile LAS unsigned* MISC = (volatile LAS unsigned*)(F.lds + MISC_OFF);
    XcdBarrier bar; bar.bar = (unsigned*)(P_ws(F) + WS_CTL) + CW_BAR; bar.x = 0; bar.st = nullptr;
    const int lo = args.ph_lo, hi = args.ph_hi;
    if (hi - lo > 1) bar = xcd_barrier_post((unsigned*)(P_ws(F) + WS_CTL) + CW_BAR, MISC + 8);
#define IN(k) (lo <= (k) && (k) < hi)
#define STAMP(k) do { if (PROBE_STAMP >= 0 && F.bid == 0 && F.tid == 0) ((unsigned long long*)(P_ws(F) + WS_CTL + 64))[(k)] = __builtin_amdgcn_s_memrealtime(); } while (0)
#define SEAM(k) do { STAMP(16 + (k)); if (IN(k) && IN((k) + 1)) xcd_barrier(bar); STAMP((k) + 1); } while (0)
    STAMP(0);

#ifndef PROBE_MASK
#define PROBE_MASK 0
#endif
#define REP(k) for (int rep_ = 0; rep_ < (((PROBE_MASK >> (k)) & 1) ? 2 : 1); ++rep_)
#define REPSYNC(k) do { if (((PROBE_MASK >> (k)) & 1) && rep_ == 0) xcd_barrier(bar); } while (0)
    if (IN(0)) { REP(0) { p0_prologue(F); REPSYNC(0); } } SEAM(0);
    if (IN(1)) { REP(1) { p1_phase(F); REPSYNC(1); } } SEAM(1);
    if (IN(2)) REP(2) {
        pg8::Gemm g{P_XH(F), P_WIN(F), M, MIX_IN, D}; pg8::StaticOrder S; S.init(M, MIX_IN, F.G, F.bid);
        pg8::EpiStoreBf16 E{P_PROJ(F), MIX_IN};
        pg8::gemm_phase<pg8::EpiStoreBf16, pg8::StaticOrder, false, true>(F.lds, g, S, E); REPSYNC(2);
        { const int nwg = (M / 256) * (MIX_IN / 256), busy = nwg % F.G;
          if (busy > 0 && F.bid >= busy) quant_rows(F, QUANT_SPLIT, 2 * NEXP, (F.bid - busy) * NWAVES + F.wave, (F.G - busy) * NWAVES);
          else if (busy == 0) quant_rows(F, QUANT_SPLIT, 2 * NEXP, F.bid * NWAVES + F.wave, F.G * NWAVES); }
    } SEAM(2);
    if (IN(3)) { p3_phase(F); } SEAM(3);
    if (IN(4)) { p4_phase(F); } SEAM(4);
    if (IN(5)) REP(5) {
        pg8::Gemm g{P_XH(F), P_WOUT(F), M, D, D}; pg8::StaticOrder S; S.init(M, D, F.G, F.bid);
        pg8::EpiGateBf16 E{P_X1B(F), D, P_ADA(F) + 2 * D, ADA_W, SEQ};
        pg8::gemm_phase<pg8::EpiGateBf16, pg8::StaticOrder, false, true>(F.lds, g, S, E); REPSYNC(5);
    } SEAM(5);
    if (IN(6)) { REP(6) { p6_phase(F); REPSYNC(6); } } SEAM(6);
    if (IN(7)) REP(7) {
        pg8::Gemm g{P_XH(F), P_WQ(F), M, D, D}; pg8::StaticOrder S; S.init(M, D, F.G, F.bid);
        pg8::EpiStoreBf16 E{P_PROJ(F), D};
        pg8::gemm_phase<pg8::EpiStoreBf16, pg8::StaticOrder, false, true>(F.lds, g, S, E); REPSYNC(7);
    } SEAM(7);
    if (IN(8)) { REP(8) { p8_phase(F); REPSYNC(8); } } SEAM(8);
#ifdef PROBE_MFMA4
    if (F.bid == 0 && F.wave == 0) {
        const int l_ = F.lane, i_ = l_ & 15, kq_ = l_ >> 4; (void)i_; (void)kq_;
        i32x8 a_ = {0, 0, 0, 0, 0, 0, 0, 0}, b_ = {0, 0, 0, 0, 0, 0, 0, 0};
        PROBE_MFMA4;
        const f32x4 z_ = {0.f, 0.f, 0.f, 0.f};
#ifdef PROBE_SWAPFMT
        const f32x4 d_ = __builtin_amdgcn_mfma_scale_f32_16x16x128_f8f6f4(a_, b_, z_, 0  , 4  , 0, 0x7f7f7f7f, 0, 0x7f7f7f7f);
#else
        const f32x4 d_ = MFMA_F4F8(a_, b_, z_);
#endif
        float* pr_ = (float*)(P_ws(F) + WS_CTL + 40960);
        pr_[l_ * 4 + 0] = d_[0]; pr_[l_ * 4 + 1] = d_[1]; pr_[l_ * 4 + 2] = d_[2]; pr_[l_ * 4 + 3] = d_[3];
    }
#endif
    if (IN(9)) { p9u_phase(F); }
    if (PROBE_STAMP >= 0 && F.tid == 0) ((unsigned long long*)(P_ws(F) + WS_CTL + 32768))[F.bid] = __builtin_amdgcn_s_memrealtime();
    SEAM(9);
    if (IN(10)) { p9w_phase(F); } SEAM(10);
    if (IN(11)) { p9v_phase(F); }
    if (PROBE_STAMP >= 0) {
        __syncthreads(); STAMP(12); VM_WAIT(); __syncthreads();
        if (F.bid == 0 && F.tid == 0) { const unsigned long long* ts = (const unsigned long long*)(P_ws(F) + WS_CTL + 64);
            float us = (float)(ts[PROBE_STAMP + 1] - ts[PROBE_STAMP]) * 0.01f;
#ifdef PROBE_BLOCKSTAT
            { const unsigned long long* bt = (const unsigned long long*)(P_ws(F) + WS_CTL + 32768); float acc_ = 0.f;
              for (int b_ = 0; b_ < (int)gridDim.x; ++b_) { const float d_ = (float)(bt[b_] - ts[9]) * 0.01f; PROBE_BLOCKSTAT; } us = acc_; }
#endif
#ifdef PROBE_MFMA4
            { const float* pr_ = (const float*)(P_ws(F) + WS_CTL + 40960); float acc_ = 0.f; PROBE_MFMA4_READ; us = acc_; }
#endif
            P_out(F)[0] += us * (1.0f / PROBE_DIV); }
    }
#undef IN
#undef SEAM
}

extern "C" void kernel_launch(void* const* d_in, const int* in_sizes, int n_in, void* d_out, int out_size, void* d_ws, size_t ws_size, hipStream_t stream) {
    static int grid = 0;
    if (grid == 0) {
        if (n_in != 25 || in_sizes[0] != M * D || out_size != M * D || ws_size < WS_END) {
            fprintf(stderr, "kernel_launch: built for 25 inputs, x/out of %d floats, >= %zu bytes of workspace; got n_in %d, in0 %d, out %d, ws %zu; nothing launched\n", M * D, (size_t)WS_END, n_in, n_in > 0 ? in_sizes[0] : -1, out_size, ws_size);
            grid = -1; return; }
        int dev = 0, cus = 0, per_cu = 0;
        if (hipGetDevice(&dev) != hipSuccess || hipDeviceGetAttribute(&cus, hipDeviceAttributeMultiprocessorCount, dev) != hipSuccess) { fprintf(stderr, "kernel_launch: device query failed\n"); grid = -1; return; }
        if (hipFuncSetAttribute((const void*)hymba_fwd, hipFuncAttributeMaxDynamicSharedMemorySize, LDS_BYTES) != hipSuccess) { fprintf(stderr, "kernel_launch: hipFuncSetAttribute failed\n"); grid = -1; return; }
        if (hipOccupancyMaxActiveBlocksPerMultiprocessor(&per_cu, (const void*)hymba_fwd, NWAVES * 64, LDS_BYTES) != hipSuccess || per_cu < 1) {
            fprintf(stderr, "kernel_launch: occupancy query reports %d workgroups per CU; need 1\n", per_cu); (void)hipGetLastError(); grid = -1; return; }
        grid = cus;
        if (grid % 8 != 0 || (M / 64) % (grid / 8 * NWAVES) != 0) { fprintf(stderr, "kernel_launch: grid %d not supported (needs a multiple of 8 dividing the token blocks)\n", grid); grid = -1; return; }
    }
    if (grid < 0) return;
    if (hipMemsetAsync((char*)d_ws + WS_CTL, 0, CTL_ZERO_BYTES, stream) != hipSuccess) { fprintf(stderr, "kernel_launch: memset failed\n"); return; }
    Args a{};
    for (int i = 0; i < 25; ++i) a.in[i] = d_in[i];
    a.out = (float*)d_out; a.ws = (unsigned char*)d_ws;
    if (N_LAUNCHES == 1) {
        a.ph_lo = 0; a.ph_hi = N_PHASES;
        void* kargs[] = {&a};
        const hipError_t le = hipLaunchCooperativeKernel((const void*)hymba_fwd, dim3(grid), dim3(NWAVES * 64), kargs, LDS_BYTES, stream);
        if (le != hipSuccess) fprintf(stderr, "kernel_launch: cooperative launch failed: %s (grid %d)\n", hipGetErrorName(le), grid);
    } else {
#ifndef PROBE_TWICE
#define PROBE_TWICE 0
#endif
        for (int li = 0; li < N_PHASES; ++li) { a.ph_lo = li; a.ph_hi = li + 1;
            if ((PROBE_TWICE >> li) & 1) hipLaunchKernelGGL(hymba_fwd, dim3(grid), dim3(NWAVES * 64), LDS_BYTES, stream, a);
            hipLaunchKernelGGL(hymba_fwd, dim3(grid), dim3(NWAVES * 64), LDS_BYTES, stream, a);
            const hipError_t le = hipPeekAtLastError();
            if (le != hipSuccess) { fprintf(stderr, "kernel_launch: launch %d failed: %s\n", li, hipGetErrorName(le)); break; } }
    }
}
```

```cpp
#include <hip/hip_runtime.h>
#include <cstdio>
#include <cstdint>
namespace pg8 {
#define PG8_LAS __attribute__((address_space(3)))
typedef unsigned short bf16_t;
typedef short bf16x8 __attribute__((ext_vector_type(8)));
typedef float f32x4 __attribute__((ext_vector_type(4)));
typedef unsigned u32x4 __attribute__((ext_vector_type(4)));
constexpr int BM = 256, BK = 64, HALF = 128, HTB = HALF * BK * 2  , STAGE_BYTES = 8 * HTB, NXCD = 8, WGM = 8;

__host__ __device__ __forceinline__ int lds_byte(int r, int c) { const int st = (r >> 4) * 2 + (c >> 5), rr = r & 15, cc = c & 31, ob = rr * 64 + cc * 2; return st * 1024 + (ob ^ (((ob >> 9) & 1) << 5)); }
__host__ __device__ __forceinline__ void stage_rc(int b, int& R, int& C) { const int st = b / 1024, sb = b % 1024, swz = sb ^ (((sb >> 9) & 1) << 5); R = (st >> 1) * 16 + swz / 64; C = (st & 1) * 32 + (swz % 64) / 2; }
__host__ __device__ __forceinline__ int perm32(int rho) { const int n = rho >> 4, i = rho & 15; return 8 * (i >> 2) + 4 * n + (i & 3); }

struct Unit { int pm, pn; };
struct Gemm { const bf16_t* A; const bf16_t* Bt; int M, N, K; };

struct StaticOrder {
    int nM, nN, nwg, G, c;
    __host__ __device__ void init(int M, int N, int G_, int c_) { nM = M / BM; nN = N / BM; nwg = nM * nN; G = G_; c = c_; }
    __host__ __device__ bool next(int i, Unit& u) const {
        const long L = (long)i * G + c; if (L >= nwg) return false;
        int wgid = (int)L; { const int q = nwg / NXCD, r = nwg % NXCD, xcd = wgid % NXCD, off = wgid / NXCD; wgid = (xcd < r ? xcd * (q + 1) : r * (q + 1) + (xcd - r) * q) + off; }
        const int nig = WGM * nN, gid = wgid / nig, fm = gid * WGM, gsz = (nM - fm) < WGM ? (nM - fm) : WGM;
        u.pm = fm + ((wgid % nig) % gsz); u.pn = (wgid % nig) / gsz; return true;
    }
    __device__ __forceinline__ void a_ready(const Unit&) const {}
    __device__ __forceinline__ void done(const Unit&) const {}
};

__device__ __forceinline__ unsigned cvt_pk_bf16(float lo, float hi) { unsigned r; asm volatile("v_cvt_pk_bf16_f32 %0, %1, %2" : "=v"(r) : "v"(lo), "v"(hi)); return r; }
struct EpiStoreBf16 {
    static constexpr bool PERM = true, AFTER_DRAIN = false;
    bf16_t* O; int ldc;
    __device__ __forceinline__ void operator()(const f32x4 (&acc)[2][2][4][2], const Unit& u, int wr, int wc, int fr, int fq) const {
        const int row0 = u.pm * BM + wr * 64 + fr; const int col0 = u.pn * BM + wc * 32 + 8 * fq;
#pragma unroll
        for (int ai = 0; ai < 2; ++ai)
#pragma unroll
            for (int m = 0; m < 4; ++m) { bf16_t* rowp = O + (size_t)(row0 + ai * HALF + m * 16) * ldc + col0;
#pragma unroll
                for (int bj = 0; bj < 2; ++bj) { const f32x4 v0 = acc[ai][bj][m][0], v1 = acc[ai][bj][m][1];
                    u32x4 w; w.x = cvt_pk_bf16(v0[0], v0[1]); w.y = cvt_pk_bf16(v0[2], v0[3]); w.z = cvt_pk_bf16(v1[0], v1[1]); w.w = cvt_pk_bf16(v1[2], v1[3]);
                    *(u32x4*)(rowp + bj * HALF) = w; } }
    }
};
struct EpiGateBf16 {
    static constexpr bool PERM = true, AFTER_DRAIN = false;
    bf16_t* out; int ldc; const float* gate; int gstride; int rows_per_batch;
    __device__ __forceinline__ void operator()(const f32x4 (&acc)[2][2][4][2], const Unit& u, int wr, int wc, int fr, int fq) const {
        const int b = (u.pm * BM) / rows_per_batch; const float* g = gate + (size_t)b * gstride;
        const int col0 = u.pn * BM + wc * 32 + 8 * fq;
        f32x4 gv[2][2];
#pragma unroll
        for (int bj = 0; bj < 2; ++bj)
#pragma unroll
            for (int n = 0; n < 2; ++n) gv[bj][n] = *(const f32x4*)(g + col0 + bj * HALF + n * 4);
#pragma unroll
        for (int ai = 0; ai < 2; ++ai)
#pragma unroll
            for (int m = 0; m < 4; ++m) { bf16_t* rowp = out + (size_t)(u.pm * BM + ai * HALF + wr * 64 + m * 16 + fr) * ldc + col0;
#pragma unroll
                for (int bj = 0; bj < 2; ++bj) { const f32x4 v0 = gv[bj][0] * acc[ai][bj][m][0], v1 = gv[bj][1] * acc[ai][bj][m][1];
                    u32x4 w; w.x = cvt_pk_bf16(v0[0], v0[1]); w.y = cvt_pk_bf16(v0[2], v0[3]); w.z = cvt_pk_bf16(v1[0], v1[1]); w.w = cvt_pk_bf16(v1[2], v1[3]);
                    *(u32x4*)(rowp + bj * HALF) = w; } }
    }
};

template <class Epi, class Sched, bool ALIGN_EPI = false, bool SP2 = false>
__device__ __forceinline__ void gemm_phase(PG8_LAS unsigned char* lds, const Gemm g, const Sched& S, const Epi& E) {
    const int tid = threadIdx.x, wid = __builtin_amdgcn_readfirstlane(tid >> 6), lane = tid & 63, wr = wid >> 2, wc = wid & 3, fr = lane & 15, fq = lane >> 4;
    const int K = g.K, nt = K / BK;
    unsigned voffA[2], voffB[2];
#pragma unroll
    for (int i = 0; i < 2; ++i) { int R, C; stage_rc(tid * 16 + i * 8192, R, C); const int Rb = Epi::PERM ? ((R & ~31) + perm32(R & 31)) : R;
        voffA[i] = (unsigned)(R * K + C) * 2u; voffB[i] = (unsigned)(Rb * K + C) * 2u; }
    const size_t kstep = (size_t)(BK * 2);
    const size_t hstep = (size_t)HALF * K * 2;
    const size_t tstep = 2 * hstep;
    const unsigned ldsw = (unsigned)wid * 1024u;
    const int aoff = lds_byte(wr * 64 + fr, fq * 8), boff = lds_byte(wc * 32 + fr, fq * 8);
#define PG8_SA(b, h) (((b) * 2 + (h)) * HTB)
#define PG8_SB(b, h) ((4 + (b) * 2 + (h)) * HTB)
#define PG8_STAGE(bufoff, gbase, voff) do { _Pragma("unroll") for (int _i = 0; _i < 2; ++_i) \
        __builtin_amdgcn_global_load_lds((const unsigned*)((const char*)(gbase) + (voff)[_i]), (PG8_LAS unsigned*)(lds + (bufoff) + ldsw + _i * 8192), 16, 0, 0); } while (0)
#define PG8_LDA(dst, b, h) do { _Pragma("unroll") for (int m = 0; m < 4; ++m) _Pragma("unroll") for (int k = 0; k < 2; ++k) dst[m][k] = *(const PG8_LAS bf16x8*)(lds + PG8_SA(b, h) + aoff + m * 2048 + k * 1024); } while (0)
#define PG8_LDB(dst, b, h) do { _Pragma("unroll") for (int n = 0; n < 2; ++n) _Pragma("unroll") for (int k = 0; k < 2; ++k) dst[n][k] = *(const PG8_LAS bf16x8*)(lds + PG8_SB(b, h) + boff + n * 2048 + k * 1024); } while (0)
#define PG8_MMA(ai, bj, At, Bt) do { __builtin_amdgcn_s_setprio(1); _Pragma("unroll") for (int m = 0; m < 4; ++m) _Pragma("unroll") for (int n = 0; n < 2; ++n) _Pragma("unroll") for (int k = 0; k < 2; ++k) \
        acc[ai][bj][m][n] = __builtin_amdgcn_mfma_f32_16x16x32_bf16(Bt[n][k], At[m][k], acc[ai][bj][m][n], 0, 0, 0); __builtin_amdgcn_s_setprio(0); } while (0)
#define PG8_WAIT_V(n) asm volatile("s_waitcnt vmcnt(" #n ")" ::: "memory")
#define PG8_WAIT_L(n) asm volatile("s_waitcnt lgkmcnt(" #n ")" ::: "memory")
#define PG8_BAR __builtin_amdgcn_s_barrier()
#define PG8_SCHED __builtin_amdgcn_sched_barrier(0)
    Unit cur, nxt; int ui = 0;
    if (!S.next(0, cur)) return;
    f32x4 acc[2][2][4][2];
#pragma unroll
    for (int a = 0; a < 2; ++a)
#pragma unroll
        for (int b = 0; b < 2; ++b)
#pragma unroll
            for (int m = 0; m < 4; ++m)
#pragma unroll
                for (int n = 0; n < 2; ++n) acc[a][b][m][n] = (f32x4){0.f, 0.f, 0.f, 0.f};
    bf16x8 At[4][2], B0[2][2], B1[2][2];
    const char* cA = (const char*)g.A + (size_t)cur.pm * tstep; const char* cB = (const char*)g.Bt + (size_t)cur.pn * tstep;
    S.a_ready(cur);
    if constexpr (SP2) {
        PG8_STAGE(PG8_SB(0, 0), cB, voffB); PG8_STAGE(PG8_SB(0, 1), cB + hstep, voffB); PG8_STAGE(PG8_SA(0, 0), cA, voffA); PG8_STAGE(PG8_SA(0, 1), cA + hstep, voffA);
        if (wr == 1) PG8_BAR;
        PG8_WAIT_V(2); PG8_BAR;
        PG8_STAGE(PG8_SB(1, 0), cB + kstep, voffB); PG8_STAGE(PG8_SA(1, 0), cA + kstep, voffA); PG8_STAGE(PG8_SB(1, 1), cB + hstep + kstep, voffB);
        PG8_WAIT_V(6); PG8_BAR;
    } else {
        PG8_STAGE(PG8_SB(0, 0), cB, voffB); PG8_STAGE(PG8_SA(0, 0), cA, voffA); PG8_STAGE(PG8_SB(0, 1), cB + hstep, voffB); PG8_STAGE(PG8_SA(0, 1), cA + hstep, voffA);
        if (wr == 1) PG8_BAR;
        PG8_WAIT_V(4); PG8_BAR;
        PG8_STAGE(PG8_SB(1, 0), cB + kstep, voffB); PG8_STAGE(PG8_SA(1, 0), cA + kstep, voffA); PG8_STAGE(PG8_SB(1, 1), cB + hstep + kstep, voffB);
        PG8_WAIT_V(6); PG8_BAR;
    }
    for (;;) {
        const bool has_next = S.next(ui + 1, nxt);
        const char* nA = has_next ? (const char*)g.A + (size_t)nxt.pm * tstep : cA; const char* nB = has_next ? (const char*)g.Bt + (size_t)nxt.pn * tstep : cB;
        for (int t = 0; t < nt; t += 2) {
            const bool last = (t == nt - 2);
            const char* a1 = cA + (size_t)(t + 1) * kstep;
            const char* a2 = last ? nA : cA + (size_t)(t + 2) * kstep; const char* b2 = last ? nB : cB + (size_t)(t + 2) * kstep;
            const char* a3 = a2 + kstep; const char* b3 = b2 + kstep;
            if (last && has_next) S.a_ready(nxt);
            if constexpr (SP2) {
            PG8_LDB(B0, 0, 0); PG8_LDB(B1, 0, 1); PG8_SCHED; PG8_LDA(At, 0, 0); PG8_STAGE(PG8_SA(1, 1), a1 + hstep, voffA);
            PG8_WAIT_V(8); PG8_WAIT_L(0); PG8_BAR; PG8_MMA(0, 0, At, B0); PG8_MMA(0, 1, At, B1); PG8_BAR; PG8_SCHED;
            PG8_LDA(At, 0, 1); PG8_STAGE(PG8_SB(0, 0), b2, voffB); PG8_STAGE(PG8_SB(0, 1), b2 + hstep, voffB); PG8_STAGE(PG8_SA(0, 0), a2, voffA);
            PG8_WAIT_V(8); PG8_WAIT_L(0); PG8_BAR; PG8_MMA(1, 0, At, B0); PG8_MMA(1, 1, At, B1); PG8_BAR; PG8_SCHED;
            PG8_LDB(B0, 1, 0); PG8_LDB(B1, 1, 1); PG8_SCHED; PG8_LDA(At, 1, 0); PG8_STAGE(PG8_SA(0, 1), a2 + hstep, voffA);
            PG8_WAIT_V(8); PG8_WAIT_L(0); PG8_BAR; PG8_MMA(0, 0, At, B0); PG8_MMA(0, 1, At, B1); PG8_BAR; PG8_SCHED;
            PG8_LDA(At, 1, 1); PG8_STAGE(PG8_SB(1, 0), b3, voffB); PG8_STAGE(PG8_SB(1, 1), b3 + hstep, voffB); PG8_STAGE(PG8_SA(1, 0), a3, voffA);
            PG8_WAIT_V(8); PG8_WAIT_L(0); PG8_BAR; PG8_MMA(1, 0, At, B0); PG8_MMA(1, 1, At, B1); PG8_BAR; PG8_SCHED;
            } else {
            PG8_LDB(B0, 0, 0); PG8_SCHED; PG8_LDA(At, 0, 0); PG8_STAGE(PG8_SA(1, 1), a1 + hstep, voffA);
            PG8_WAIT_L(8); PG8_BAR; PG8_WAIT_L(0); PG8_MMA(0, 0, At, B0); PG8_BAR; PG8_SCHED;
            PG8_LDB(B1, 0, 1); PG8_STAGE(PG8_SB(0, 0), b2, voffB);
            PG8_BAR; PG8_WAIT_L(0); PG8_MMA(0, 1, At, B1); PG8_BAR;
            PG8_LDA(At, 0, 1); PG8_STAGE(PG8_SA(0, 0), a2, voffA);
            PG8_BAR; PG8_WAIT_L(0); PG8_MMA(1, 0, At, B0); PG8_BAR; PG8_SCHED;
            PG8_STAGE(PG8_SB(0, 1), b2 + hstep, voffB);
            PG8_WAIT_V(6); PG8_BAR; PG8_MMA(1, 1, At, B1); PG8_BAR;
            PG8_LDB(B0, 1, 0); PG8_SCHED; PG8_LDA(At, 1, 0); PG8_STAGE(PG8_SA(0, 1), a2 + hstep, voffA);
            PG8_WAIT_L(8); PG8_BAR; PG8_WAIT_L(0); PG8_MMA(0, 0, At, B0); PG8_BAR; PG8_SCHED;
            PG8_LDB(B1, 1, 1); PG8_STAGE(PG8_SB(1, 0), b3, voffB);
            PG8_BAR; PG8_WAIT_L(0); PG8_MMA(0, 1, At, B1); PG8_BAR;
            PG8_LDA(At, 1, 1); PG8_STAGE(PG8_SA(1, 0), a3, voffA);
            PG8_BAR; PG8_WAIT_L(0); PG8_MMA(1, 0, At, B0); PG8_BAR; PG8_SCHED;
            PG8_STAGE(PG8_SB(1, 1), b3 + hstep, voffB);
            PG8_WAIT_V(6); PG8_BAR; PG8_MMA(1, 1, At, B1); PG8_BAR;
            }
        }
        if constexpr (ALIGN_EPI) { if (wr == 0) PG8_BAR; }
        if constexpr (!Epi::AFTER_DRAIN) { E(acc, cur, wr, wc, fr, fq); S.done(cur); }
        if (!has_next) break;
#pragma unroll
        for (int a = 0; a < 2; ++a)
#pragma unroll
            for (int b = 0; b < 2; ++b)
#pragma unroll
                for (int m = 0; m < 4; ++m)
#pragma unroll
                    for (int n = 0; n < 2; ++n) acc[a][b][m][n] = (f32x4){0.f, 0.f, 0.f, 0.f};
        cur = nxt; cA = nA; cB = nB; ++ui;
        if constexpr (ALIGN_EPI) { if (wr == 1) PG8_BAR; }
    }
    PG8_WAIT_V(0);
    if constexpr (!ALIGN_EPI) { if (wr == 0) PG8_BAR; }
    PG8_BAR;
    if constexpr (Epi::AFTER_DRAIN) { E.fused(acc, cur, wr, wc, fr, fq, lds, wid, lane); S.done(cur); }
#undef PG8_SA
#undef PG8_SB
#undef PG8_STAGE
#undef PG8_LDA
#undef PG8_LDB
#undef PG8_MMA
#undef PG8_WAIT_V
#undef PG8_WAIT_L
#undef PG8_BAR
#undef PG8_SCHED
}
}

#ifndef PROBE_STAMP
#define PROBE_STAMP -1
#define PROBE_DIV 5.0f
#endif
constexpr int NWAVES = 8;
#ifndef MK_N_LAUNCHES
#define MK_N_LAUNCHES 1
#endif
constexpr int N_PHASES = 12;
constexpr int N_LAUNCHES = MK_N_LAUNCHES;

constexpr int BATCH = 4, SEQ = 4096, D = 2048, M = BATCH * SEQ;
constexpr int LRU_W = 1024, LRU_HEADS = 8, LRU_BLK = 128;
constexpr int HD = 64, HQ = 16, HKV = 2, GRP = 8;
constexpr int MIX_IN = 3328;
constexpr int C_Y = 1024, C_Q = 2048, C_K = 3072, C_V = 3200;
constexpr int ADA_W = 6 * D;
constexpr int PH = 8, PKEYS = 128, PHALF = 128, PTOPK = 16, NEXP = 16384;
constexpr float EPS = 1e-6f;

constexpr size_t MiB = 1u << 20;
constexpr size_t WS_CTL = 0, CTL_ZERO_BYTES = 64 * 1024;
constexpr size_t WS_ADA = 1 * MiB;
constexpr size_t WS_ROPE = 2 * MiB;
constexpr size_t WS_WIN = 4 * MiB;
constexpr size_t WS_WOUT = 17 * MiB;
constexpr size_t WS_WQ = 25 * MiB;
constexpr size_t WS_WGA = 33 * MiB;
constexpr size_t WS_WGX = 33 * MiB + 256 * 1024;
constexpr size_t WS_SK = 33 * MiB + 512 * 1024;
constexpr size_t WS_IDX = 34 * MiB;
constexpr size_t WS_GW = 42 * MiB;
constexpr size_t WS_U = 50 * MiB;
constexpr size_t WS_V = 82 * MiB;
constexpr size_t WS_USC = 1 * MiB + 512 * 1024;
constexpr size_t WS_VSC = 1 * MiB + 768 * 1024;
constexpr size_t WS_X1B = 114 * MiB;
constexpr size_t WS_XH = 178 * MiB;
constexpr size_t WS_PROJ = 242 * MiB;
constexpr size_t WS_HL = 346 * MiB;
constexpr size_t WS_PA = 410 * MiB;
constexpr size_t WS_PART = WS_HL;
constexpr size_t WS_W = WS_PROJ + 64 * MiB;
constexpr size_t WS_WSC = WS_PROJ + 68 * MiB;
constexpr size_t WS_H8 = WS_PROJ + 72 * MiB;
constexpr size_t WS_END = 474 * MiB;
constexpr int CW_BAR = 4096;

constexpr int RING_BYTES = 131072;
constexpr int LDSCTL_OFF = RING_BYTES, MISC_OFF = LDSCTL_OFF + 320;
constexpr int LDS_BYTES = 147456;

#define GAS __attribute__((address_space(1)))
#define LAS __attribute__((address_space(3)))
typedef unsigned short bf16;
typedef unsigned v4u __attribute__((ext_vector_type(4)));
typedef unsigned v2u __attribute__((ext_vector_type(2)));
typedef float f32x4 __attribute__((ext_vector_type(4)));
typedef float f32x2 __attribute__((ext_vector_type(2)));
typedef float f32x16 __attribute__((ext_vector_type(16)));
typedef short bf16x8 __attribute__((ext_vector_type(8)));
typedef __bf16 bf16x2v __attribute__((ext_vector_type(2)));
#define LDS_WAIT() asm volatile("s_waitcnt lgkmcnt(0)" ::: "memory")
#define VM_WAIT() asm volatile("s_waitcnt vmcnt(0)" ::: "memory")
__device__ __forceinline__ unsigned f2bf(float f) { unsigned u = __builtin_bit_cast(unsigned, f); return (u + 0x7fffu + ((u >> 16) & 1u)) >> 16; }
__device__ __forceinline__ unsigned pk2(float lo, float hi) { return f2bf(lo) | (f2bf(hi) << 16); }
__device__ __forceinline__ float bflo(unsigned u) { return __builtin_bit_cast(float, u << 16); }
__device__ __forceinline__ float bfhi(unsigned u) { return __builtin_bit_cast(float, u & 0xffff0000u); }
__device__ __forceinline__ float bf1(bf16 h) { return __builtin_bit_cast(float, (unsigned)h << 16); }
__device__ __forceinline__ float dot2bf(unsigned a, unsigned b, float acc) { return __builtin_amdgcn_fdot2_f32_bf16(__builtin_bit_cast(bf16x2v, a), __builtin_bit_cast(bf16x2v, b), acc, false); }
__device__ __forceinline__ float sigmoidf_(float x) { return 1.0f / (1.0f + __expf(-x)); }
__device__ __forceinline__ float gelu_tanh(float x) {
    const float z = 1.5957691216057308f * (x + 0.044715f * x * x * x);
    return x / (1.0f + __expf(-z));
}
__device__ __forceinline__ float wave_sum(float v) {
#pragma unroll
    for (int o = 1; o < 64; o <<= 1) v += __shfl_xor(v, o);
    return v;
}

#define XB_TMO      128
#define XB_XCNT(j)  (256  + 64 * (j))
#define XB_XSUB(j)  (1280 + 64 * (j))
#define XB_XGEN(j)  (2304 + 64 * (j))
#define XB_TOP      3328
#define XB_TOPGEN   3392
#define XCD_BAR_WORDS 3456
#define XB_SPIN_CAP (1u << 18)
__device__ __forceinline__ unsigned xb_ld(unsigned* p)              { return __hip_atomic_load(p, __ATOMIC_RELAXED, __HIP_MEMORY_SCOPE_AGENT); }
__device__ __forceinline__ unsigned xb_add(unsigned* p, unsigned v) { return __hip_atomic_fetch_add(p, v, __ATOMIC_RELAXED, __HIP_MEMORY_SCOPE_AGENT); }
__device__ __forceinline__ unsigned xb_xcc_id() { return (unsigned)__builtin_amdgcn_s_getreg((3 << 11) | 20) & 0xFu; }
#define XB_SPIN(cond, bar) do { unsigned _sp = 0; while (cond) { __builtin_amdgcn_s_sleep(1); \
    if ((++_sp & 255u) == 0u) { if (xb_ld(&(bar)[XB_TMO])) break; if (_sp > XB_SPIN_CAP) { atomicAdd(&(bar)[XB_TMO], 1u); break; } } } } while (0)
struct XcdBarrier { unsigned* bar; unsigned x; volatile LAS unsigned* st; };
__device__ __forceinline__ XcdBarrier xcd_barrier_post(unsigned* bar, volatile LAS unsigned* st) {
    XcdBarrier b; b.bar = bar; b.x = xb_xcc_id(); b.st = st;
    if (threadIdx.x == 0) (void)xb_add(&bar[XB_XCNT(b.x)], 1u);
    return b;
}
__device__ __forceinline__ void xcd_barrier_complete(unsigned* bar, unsigned x, unsigned& nloc, unsigned& nx) {
    const unsigned G = gridDim.x * gridDim.y * gridDim.z;
    unsigned sum, cnt, mine, sp = 0u;
    for (;;) {
        sum = 0u; cnt = 0u; mine = 0u;
#pragma unroll
        for (unsigned j = 0; j < 16; ++j) { const unsigned c = xb_ld(&bar[XB_XCNT(j)]); sum += c; cnt += (c > 0u) ? 1u : 0u; mine = (j == x) ? c : mine; }
        if (sum == G) break;
        __builtin_amdgcn_s_sleep(1);
        if ((++sp & 255u) == 0u) { if (xb_ld(&bar[XB_TMO])) break; if (sp > XB_SPIN_CAP) { atomicAdd(&bar[XB_TMO], 1u); break; } }
    }
    nloc = mine > 0u ? mine : 1u; nx = cnt > 0u ? cnt : 1u;
}
__device__ __forceinline__ void xcd_barrier(const XcdBarrier& b) {
    asm volatile("s_waitcnt vmcnt(0)" ::: "memory");
    __syncthreads();
    if (threadIdx.x == 0) {
        unsigned* bar = b.bar;
        __builtin_amdgcn_s_waitcnt(0);
        unsigned nloc = b.st[0], nx = b.st[1];
        if (nloc == 0u) { xcd_barrier_complete(bar, b.x, nloc, nx); b.st[0] = nloc; b.st[1] = nx; }
        const unsigned old = xb_add(&bar[XB_XSUB(b.x)], 1u);
        const unsigned gen = old / nloc;
        if (old + 1u == (gen + 1u) * nloc) {
            __builtin_amdgcn_fence(__ATOMIC_RELEASE, "agent");
            asm volatile("s_waitcnt vmcnt(0)" ::: "memory");
            const unsigned og = xb_add(&bar[XB_TOP], 1u);
            const unsigned tg = og / nx;
            if (og + 1u == (tg + 1u) * nx) xb_add(&bar[XB_TOPGEN], 1u);
            else XB_SPIN(xb_ld(&bar[XB_TOPGEN]) == tg, bar);
            __builtin_amdgcn_fence(__ATOMIC_ACQUIRE, "agent");
            xb_add(&bar[XB_XGEN(b.x)], 1u);
            asm volatile("s_waitcnt vmcnt(0)" ::: "memory");
        } else {
            XB_SPIN(xb_ld(&bar[XB_XGEN(b.x)]) == gen, bar);
            __builtin_amdgcn_fence(__ATOMIC_ACQUIRE, "agent");
            asm volatile("s_waitcnt vmcnt(0)" ::: "memory");
        }
    }
    __syncthreads();
}

typedef const __attribute__((address_space(4))) unsigned char* kaptr_t;
struct Frame { LAS unsigned char* lds; int tid, lane, wave, G, bid; kaptr_t ka; };
template <class T> __device__ __forceinline__ T* ka_ptr(const Frame& F, int byte_off) { typedef T* tp; return *(const __attribute__((address_space(4))) tp*)(F.ka + byte_off); }
__device__ __forceinline__ const float* P_x(const Frame& F) { return ka_ptr<const float>(F, 0); }
__device__ __forceinline__ const float* P_c(const Frame& F) { return ka_ptr<const float>(F, 8); }
__device__ __forceinline__ const int* P_pos(const Frame& F) { return ka_ptr<const int>(F, 16); }
__device__ __forceinline__ const float* P_w_ada(const Frame& F) { return ka_ptr<const float>(F, 24); }
__device__ __forceinline__ const float* P_b_ada(const Frame& F) { return ka_ptr<const float>(F, 32); }
__device__ __forceinline__ const float* P_norm1_g(const Frame& F) { return ka_ptr<const float>(F, 40); }
__device__ __forceinline__ const float* P_w_in(const Frame& F) { return ka_ptr<const float>(F, 48); }
__device__ __forceinline__ const float* P_conv_w(const Frame& F) { return ka_ptr<const float>(F, 56); }
__device__ __forceinline__ const float* P_conv_b(const Frame& F) { return ka_ptr<const float>(F, 64); }
__device__ __forceinline__ const float* P_ga_w(const Frame& F) { return ka_ptr<const float>(F, 72); }
__device__ __forceinline__ const float* P_ga_b(const Frame& F) { return ka_ptr<const float>(F, 80); }
__device__ __forceinline__ const float* P_gx_w(const Frame& F) { return ka_ptr<const float>(F, 88); }
__device__ __forceinline__ const float* P_gx_b(const Frame& F) { return ka_ptr<const float>(F, 96); }
__device__ __forceinline__ const float* P_lam(const Frame& F) { return ka_ptr<const float>(F, 104); }
__device__ __forceinline__ const float* P_qn_g(const Frame& F) { return ka_ptr<const float>(F, 112); }
__device__ __forceinline__ const float* P_kn_g(const Frame& F) { return ka_ptr<const float>(F, 120); }
__device__ __forceinline__ const float* P_sinks(const Frame& F) { return ka_ptr<const float>(F, 128); }
__device__ __forceinline__ const float* P_on_lru_g(const Frame& F) { return ka_ptr<const float>(F, 136); }
__device__ __forceinline__ const float* P_on_attn_g(const Frame& F) { return ka_ptr<const float>(F, 144); }
__device__ __forceinline__ const float* P_w_out(const Frame& F) { return ka_ptr<const float>(F, 152); }
__device__ __forceinline__ const float* P_norm2_g(const Frame& F) { return ka_ptr<const float>(F, 160); }
__device__ __forceinline__ const float* P_w_pq(const Frame& F) { return ka_ptr<const float>(F, 168); }
__device__ __forceinline__ const float* P_sub_keys(const Frame& F) { return ka_ptr<const float>(F, 176); }
__device__ __forceinline__ const float* P_pu(const Frame& F) { return ka_ptr<const float>(F, 184); }
__device__ __forceinline__ const float* P_pv(const Frame& F) { return ka_ptr<const float>(F, 192); }
__device__ __forceinline__ float* P_out(const Frame& F) { return ka_ptr<float>(F, 200); }
__device__ __forceinline__ unsigned char* P_ws(const Frame& F) { return ka_ptr<unsigned char>(F, 208); }
__device__ __forceinline__ float* P_ADA(const Frame& F) { return (float*)(P_ws(F) + WS_ADA); }
__device__ __forceinline__ float* P_ROPE(const Frame& F) { return (float*)(P_ws(F) + WS_ROPE); }
__device__ __forceinline__ bf16* P_HL(const Frame& F) { return (bf16*)(P_ws(F) + WS_HL); }
__device__ __forceinline__ bf16* P_PA(const Frame& F) { return (bf16*)(P_ws(F) + WS_PA); }
__device__ __forceinline__ float* P_GW(const Frame& F) { return (float*)(P_ws(F) + WS_GW); }
__device__ __forceinline__ unsigned short* P_IDX(const Frame& F) { return (unsigned short*)(P_ws(F) + WS_IDX); }
__device__ __forceinline__ bf16* P_WIN(const Frame& F) { return (bf16*)(P_ws(F) + WS_WIN); }
__device__ __forceinline__ bf16* P_WOUT(const Frame& F) { return (bf16*)(P_ws(F) + WS_WOUT); }
__device__ __forceinline__ bf16* P_WQ(const Frame& F) { return (bf16*)(P_ws(F) + WS_WQ); }
__device__ __forceinline__ bf16* P_WGA(const Frame& F) { return (bf16*)(P_ws(F) + WS_WGA); }
__device__ __forceinline__ bf16* P_WGX(const Frame& F) { return (bf16*)(P_ws(F) + WS_WGX); }
__device__ __forceinline__ bf16* P_SK(const Frame& F) { return (bf16*)(P_ws(F) + WS_SK); }
__device__ __forceinline__ unsigned char* P_U(const Frame& F) { return (unsigned char*)(P_ws(F) + WS_U); }
__device__ __forceinline__ bf16* P_X1B(const Frame& F) { return (bf16*)(P_ws(F) + WS_X1B); }
__device__ __forceinline__ unsigned char* P_H8(const Frame& F) { return (unsigned char*)(P_ws(F) + WS_H8); }
__device__ __forceinline__ unsigned* P_PART(const Frame& F) { return (unsigned*)(P_ws(F) + WS_PART); }
__device__ __forceinline__ unsigned char* P_W(const Frame& F) { return (unsigned char*)(P_ws(F) + WS_W); }
__device__ __forceinline__ float* P_WSC(const Frame& F) { return (float*)(P_ws(F) + WS_WSC); }
__device__ __forceinline__ float* P_USC(const Frame& F) { return (float*)(P_ws(F) + WS_USC); }
__device__ __forceinline__ float* P_VSC(const Frame& F) { return (float*)(P_ws(F) + WS_VSC); }
__device__ __forceinline__ unsigned char* P_V(const Frame& F) { return (unsigned char*)(P_ws(F) + WS_V); }
__device__ __forceinline__ bf16* P_XH(const Frame& F) { return (bf16*)(P_ws(F) + WS_XH); }
__device__ __forceinline__ bf16* P_PROJ(const Frame& F) { return (bf16*)(P_ws(F) + WS_PROJ); }

__device__ __forceinline__ void p0_transpose_item(const float* W, int K, int N, bf16* WT, LAS float* scr, int item, int lane) {
    const int nblk = N / 32, kb = item / nblk, nb = item % nblk, k0 = 64 * kb, n0 = 32 * nb;
#pragma unroll 8
    for (int i = 0; i < 32; ++i) { const int kk = 2 * i + (lane >> 5); scr[kk * 33 + (lane & 31)] = __builtin_nontemporal_load(W + (size_t)(k0 + kk) * N + n0 + (lane & 31)); }
    LDS_WAIT(); asm volatile("" ::: "memory");
    const int c = lane & 7;
#pragma unroll
    for (int j = 0; j < 4; ++j) { const int n = (lane >> 3) + 8 * j; const LAS float* s = scr + (8 * c) * 33 + n;
        v4u o; o.x = pk2(s[0 * 33], s[1 * 33]); o.y = pk2(s[2 * 33], s[3 * 33]); o.z = pk2(s[4 * 33], s[5 * 33]); o.w = pk2(s[6 * 33], s[7 * 33]);
        *(v4u*)(WT + (size_t)(n0 + n) * K + k0 + 8 * c) = o; }
    LDS_WAIT(); asm volatile("" ::: "memory");
}
__device__ __forceinline__ void p0_convert(const float* src, bf16* dst, size_t n8, size_t gtid, size_t gthreads) {
    for (size_t i = gtid; i < n8; i += gthreads) {
        const f32x4 a = *(const f32x4*)(src + 8 * i), b = *(const f32x4*)(src + 8 * i + 4);
        v4u o; o.x = pk2(a.x, a.y); o.y = pk2(a.z, a.w); o.z = pk2(b.x, b.y); o.w = pk2(b.z, b.w);
        *(v4u*)(dst + 8 * i) = o;
    }
}
#ifndef QUANT_SPLIT
#define QUANT_SPLIT 14336
#endif
__device__ __forceinline__ void quant_rows(Frame& F, int r0, int r1, int w, int nw) {
    for (int rr = r0 + w; rr < r1; rr += nw) {
        const int tbl = rr >= NEXP, row = rr - tbl * NEXP;
        const float* srcp = (tbl ? P_pv(F) : P_pu(F)) + (size_t)row * D;
        f32x4 v[8]; float mx = 0.f;
#pragma unroll
        for (int j = 0; j < 8; ++j) { v[j] = __builtin_nontemporal_load((const f32x4*)(srcp + 4 * F.lane + 256 * j));
            mx = fmaxf(fmaxf(mx, fmaxf(fabsf(v[j].x), fabsf(v[j].y))), fmaxf(fabsf(v[j].z), fabsf(v[j].w))); }
#pragma unroll
        for (int o = 1; o < 64; o <<= 1) mx = fmaxf(mx, __shfl_xor(mx, o));
        {
            const float s = fmaxf(mx, 1e-30f) * (1.0f / 6.0f), inv = 1.0f / s;
            unsigned char* d4 = (tbl ? P_V(F) : P_U(F)) + (size_t)row * 128 + 2 * F.lane;
#pragma unroll
            for (int j = 0; j < 8; ++j) { unsigned t = __builtin_amdgcn_cvt_scalef32_pk_fp4_f32(0u, v[j].x * inv, v[j].y * inv, 1.0f, 0);
                t = __builtin_amdgcn_cvt_scalef32_pk_fp4_f32(t, v[j].z * inv, v[j].w * inv, 1.0f, 1);
                *(unsigned short*)(d4 + (size_t)j * (NEXP * 128)) = (unsigned short)t; }
            if (F.lane == 0) (tbl ? P_VSC(F) : P_USC(F))[row] = s;
        }
    }
}
__device__ __forceinline__ void p0_prologue(Frame& F) {
    {
        LAS float* sc = (LAS float*)F.lds;
        LAS float* red = sc + 4 * D;
        for (int i = F.tid; i < 4 * D; i += 512) { const float v = P_c(F)[i]; sc[i] = v / (1.0f + __expf(-v)); }
        __syncthreads();
        for (int cg = F.bid; cg < ADA_W / 64; cg += F.G) {
            const int n0 = cg * 64, k0 = F.wave * 256;
            const float* wp = P_w_ada(F) + (size_t)k0 * ADA_W + n0 + F.lane;
            float a0 = 0.f, a1 = 0.f, a2 = 0.f, a3 = 0.f;
            for (int kb = 0; kb < 256; kb += 64) { float wv[64];
#pragma unroll
                for (int k = 0; k < 64; ++k) wv[k] = __builtin_nontemporal_load(wp + (size_t)(kb + k) * ADA_W);
#pragma unroll
                for (int k = 0; k < 64; ++k) { const float w = wv[k]; const int kk = k0 + kb + k;
                    a0 += sc[kk] * w; a1 += sc[D + kk] * w; a2 += sc[2 * D + kk] * w; a3 += sc[3 * D + kk] * w; } }
            red[(F.wave * 4 + 0) * 64 + F.lane] = a0; red[(F.wave * 4 + 1) * 64 + F.lane] = a1;
            red[(F.wave * 4 + 2) * 64 + F.lane] = a2; red[(F.wave * 4 + 3) * 64 + F.lane] = a3;
            __syncthreads();
            if (F.tid < 256) { const int b = F.tid >> 6, l = F.tid & 63; float s = 0.f;
#pragma unroll
                for (int w = 0; w < 8; ++w) s += red[(w * 4 + b) * 64 + l];
                P_ADA(F)[(size_t)b * ADA_W + n0 + l] = s + P_b_ada(F)[n0 + l]; }
            __syncthreads();
        }
        __syncthreads();
    }
    if (PROBE_STAMP >= 0 && F.bid == 0 && F.tid == 0) ((unsigned long long*)(P_ws(F) + WS_CTL + 64))[14] = __builtin_amdgcn_s_memrealtime();
    {
        LAS float* scr = (LAS float*)(F.lds + F.wave * 16384);
        const int gw = F.bid * NWAVES + F.wave, NGW = F.G * NWAVES;
        constexpr int I_IN = (D / 64) * (MIX_IN / 32), I_SQ = (D / 64) * (D / 32), I_G = (LRU_BLK / 64) * (LRU_BLK / 32);
        constexpr int NITEMS = I_IN + 2 * I_SQ + 16 * I_G;
        for (int it = gw; it < NITEMS; it += NGW) {
            int r = it;
            if (r < I_IN) { p0_transpose_item(P_w_in(F), D, MIX_IN, P_WIN(F), scr, r, F.lane); continue; } r -= I_IN;
            if (r < I_SQ) { p0_transpose_item(P_w_out(F), D, D, P_WOUT(F), scr, r, F.lane); continue; } r -= I_SQ;
            if (r < I_SQ) { p0_transpose_item(P_w_pq(F), D, D, P_WQ(F), scr, r, F.lane); continue; } r -= I_SQ;
            const int g = r / I_G, ri = r % I_G, hd = g & 7;
            if (g < 8) p0_transpose_item(P_ga_w(F) + (size_t)hd * 16384, LRU_BLK, LRU_BLK, P_WGA(F) + (size_t)hd * 16384, scr, ri, F.lane);
            else       p0_transpose_item(P_gx_w(F) + (size_t)hd * 16384, LRU_BLK, LRU_BLK, P_WGX(F) + (size_t)hd * 16384, scr, ri, F.lane);
        }
    }
    {
        const size_t gtid = (size_t)F.bid * 512 + F.tid, gth = (size_t)F.G * 512;
        p0_convert(P_sub_keys(F), P_SK(F), (size_t)PH * 2 * PKEYS * PHALF / 8, gtid, gth);
    }
    quant_rows(F, 0, QUANT_SPLIT, F.bid * NWAVES + F.wave, F.G * NWAVES);
}

template <bool RESID, int R> __device__ __forceinline__ void modnorm_rows(const float* xin, const float* gain, const float* shift, const float* scale, bf16* orow, int lane, bf16* xin2 = nullptr, unsigned char* o8 = nullptr) {
    f32x4 v[R][4][2]; float s[R];
#pragma unroll
    for (int r = 0; r < R; ++r) { s[r] = 0.f;
#pragma unroll
        for (int j = 0; j < 4; ++j) { const int c = 8 * lane + 512 * j;
            v[r][j][0] = __builtin_nontemporal_load((const f32x4*)(xin + (size_t)r * D + c)); v[r][j][1] = __builtin_nontemporal_load((const f32x4*)(xin + (size_t)r * D + c + 4));
            if (RESID) { bf16* dp = xin2 + (size_t)r * D + c; const v4u q = *(const v4u*)dp;
                v[r][j][0] += (f32x4){bflo(q.x), bfhi(q.x), bflo(q.y), bfhi(q.y)}; v[r][j][1] += (f32x4){bflo(q.z), bfhi(q.z), bflo(q.w), bfhi(q.w)};
                v4u o; o.x = pk2(v[r][j][0].x, v[r][j][0].y); o.y = pk2(v[r][j][0].z, v[r][j][0].w); o.z = pk2(v[r][j][1].x, v[r][j][1].y); o.w = pk2(v[r][j][1].z, v[r][j][1].w); *(v4u*)dp = o; } } }
#pragma unroll
    for (int r = 0; r < R; ++r)
#pragma unroll
        for (int j = 0; j < 4; ++j)
#pragma unroll
            for (int h = 0; h < 2; ++h) { const f32x4 t = v[r][j][h]; s[r] += (t.x * t.x + t.y * t.y) + (t.z * t.z + t.w * t.w); }
#pragma unroll
    for (int o = 1; o < 64; o <<= 1) {
#pragma unroll
        for (int r = 0; r < R; ++r) s[r] += __shfl_xor(s[r], o); }
    float rstd[R];
#pragma unroll
    for (int r = 0; r < R; ++r) rstd[r] = 1.0f / sqrtf(s[r] * (1.0f / D) + EPS);
#pragma unroll
    for (int j = 0; j < 4; ++j) {
        const int c = 8 * lane + 512 * j;
        f32x4 gm[2], sh[2];
#pragma unroll
        for (int h = 0; h < 2; ++h) { const f32x4 g = *(const f32x4*)(gain + c + 4 * h), sc = *(const f32x4*)(scale + c + 4 * h); sh[h] = *(const f32x4*)(shift + c + 4 * h); gm[h] = g * (sc + 1.0f); }
#pragma unroll
        for (int r = 0; r < R; ++r) { const f32x4 y0 = (v[r][j][0] * rstd[r]) * gm[0] + sh[0], y1 = (v[r][j][1] * rstd[r]) * gm[1] + sh[1];
            v4u o; o.x = pk2(y0.x, y0.y); o.y = pk2(y0.z, y0.w); o.z = pk2(y1.x, y1.y); o.w = pk2(y1.z, y1.w);
            *(v4u*)(orow + (size_t)r * D + c) = o;
            if (RESID) { int t0 = __builtin_amdgcn_cvt_pk_fp8_f32(y0.x, y0.y, 0, false); t0 = __builtin_amdgcn_cvt_pk_fp8_f32(y0.z, y0.w, t0, true);
                int t1 = __builtin_amdgcn_cvt_pk_fp8_f32(y1.x, y1.y, 0, false); t1 = __builtin_amdgcn_cvt_pk_fp8_f32(y1.z, y1.w, t1, true);
                *(v2u*)(o8 + (size_t)r * D + c) = (v2u){(unsigned)t0, (unsigned)t1}; } }
    }
}
__device__ __forceinline__ void p1_phase(Frame& F) {
    const int gw = F.bid * NWAVES + F.wave, NGW = F.G * NWAVES;
    for (int m = 4 * gw; m < M; m += 4 * NGW) { const int b = m / SEQ; const float* ada = P_ADA(F) + (size_t)b * ADA_W;
        modnorm_rows<false, 4>(P_x(F) + (size_t)m * D, P_norm1_g(F), ada, ada + D, P_XH(F) + (size_t)m * D, F.lane); }
    const float invf[8] = {1.0f, 1.9392274e-01f, 3.7606031e-02f, 7.2926646e-03f, 1.4142136e-03f, 2.7424819e-04f, 5.3182961e-05f, 1.0313386e-05f};
    for (int i = F.bid * 512 + F.tid; i < M * 8; i += F.G * 512) { const int m = i >> 3, k = i & 7;
        float f = invf[0];
#pragma unroll
        for (int q = 1; q < 8; ++q) f = (k == q) ? invf[q] : f;
        const float ang = (float)P_pos(F)[m] * f; float sn, cs; sincosf(ang, &sn, &cs);
        P_ROPE(F)[(size_t)m * 16 + k] = cs; P_ROPE(F)[(size_t)m * 16 + 8 + k] = sn; }
}
__device__ __forceinline__ void p6_phase(Frame& F) {
    const int gw = F.bid * NWAVES + F.wave, NGW = F.G * NWAVES;
    for (int m = 2 * gw; m < M; m += 2 * NGW) { const int b = m / SEQ; const float* ada = P_ADA(F) + (size_t)b * ADA_W;
        modnorm_rows<true, 2>(P_x(F) + (size_t)m * D, P_norm2_g(F), ada + 3 * D, ada + 4 * D, P_XH(F) + (size_t)m * D, F.lane, P_X1B(F) + (size_t)m * D, P_H8(F) + (size_t)m * D); }
}

#define MFMA32(a, b, c) __builtin_amdgcn_mfma_f32_32x32x16_bf16((a), (b), (c), 0, 0, 0)
#define MFMA16(a, b, c) __builtin_amdgcn_mfma_f32_16x16x32_bf16((a), (b), (c), 0, 0, 0)
constexpr int KS_STRIDE = 72;
constexpr int VT_STRIDE = 264;
constexpr int ATT_KS_OFF = 0, ATT_VT_OFF = 256 * KS_STRIDE * 2;
static_assert(ATT_VT_OFF + 64 * VT_STRIDE * 2 <= RING_BYTES, "attention LDS");

__device__ __forceinline__ void attn_unit(Frame& F, int b, int g, int n) {
    LAS bf16* Ks = (LAS bf16*)(F.lds + ATT_KS_OFF);
    LAS bf16* VT = (LAS bf16*)(F.lds + ATT_VT_OFF);
    const int tid = F.tid, lane = F.lane;
    {
        const int kb = tid >> 1, hf = tid & 1; const int t = n * 128 - 128 + kb;
        float kv[32]; v4u vraw[4];
        if (t >= 0) {
            const bf16* kp = P_PROJ(F) + (size_t)(b * SEQ + t) * MIX_IN + C_K + g * HD + 32 * hf;
            const bf16* vp = P_PROJ(F) + (size_t)(b * SEQ + t) * MIX_IN + C_V + g * HD + 32 * hf;
#pragma unroll
            for (int q = 0; q < 4; ++q) { const v4u r = *(const v4u*)(kp + 8 * q); vraw[q] = *(const v4u*)(vp + 8 * q);
                kv[8 * q + 0] = bflo(r.x); kv[8 * q + 1] = bfhi(r.x); kv[8 * q + 2] = bflo(r.y); kv[8 * q + 3] = bfhi(r.y);
                kv[8 * q + 4] = bflo(r.z); kv[8 * q + 5] = bfhi(r.z); kv[8 * q + 6] = bflo(r.w); kv[8 * q + 7] = bfhi(r.w); }
        } else {
#pragma unroll
            for (int q = 0; q < 4; ++q) vraw[q] = (v4u){0u, 0u, 0u, 0u};
#pragma unroll
            for (int q = 0; q < 32; ++q) kv[q] = 0.f;
        }
        float ss = 0.f;
#pragma unroll
        for (int q = 0; q < 32; ++q) ss += kv[q] * kv[q];
        ss += __shfl_xor(ss, 1);
        const float rstd = 1.0f / sqrtf(ss * (1.0f / HD) + EPS);
#pragma unroll
        for (int q = 0; q < 32; ++q) kv[q] = kv[q] * rstd * P_kn_g(F)[32 * hf + q];
        if (hf == 0 && t >= 0) {
            const float* rp = P_ROPE(F) + (size_t)(b * SEQ + t) * 16;
#pragma unroll
            for (int i = 0; i < 8; ++i) { const float cs = rp[i], sn = rp[8 + i]; const float x1 = kv[i], x2 = kv[8 + i];
                kv[i] = x1 * cs - x2 * sn; kv[8 + i] = x2 * cs + x1 * sn; }
        }
#pragma unroll
        for (int q = 0; q < 4; ++q) { v4u o; o.x = pk2(kv[8 * q], kv[8 * q + 1]); o.y = pk2(kv[8 * q + 2], kv[8 * q + 3]); o.z = pk2(kv[8 * q + 4], kv[8 * q + 5]); o.w = pk2(kv[8 * q + 6], kv[8 * q + 7]);
            *(LAS v4u*)(Ks + kb * KS_STRIDE + 32 * hf + 8 * q) = o; }
#pragma unroll
        for (int q = 0; q < 4; ++q) { const unsigned w[4] = {vraw[q].x, vraw[q].y, vraw[q].z, vraw[q].w};
#pragma unroll
            for (int e = 0; e < 4; ++e) { const int d = 32 * hf + 8 * q + 2 * e;
                VT[d * VT_STRIDE + kb] = (bf16)(w[e] & 0xffffu); VT[(d + 1) * VT_STRIDE + kb] = (bf16)(w[e] >> 16); } }
    }
    __syncthreads();
    const int hq = g * GRP + F.wave, r = lane & 31, hh = lane >> 5;
    const float sink = P_sinks(F)[hq];
    for (int qi = 0; qi < 4; ++qi) {
        const int tq = n * 128 + 32 * qi + r;
        bf16x8 qf[4];
        {
            const bf16* qp = P_PROJ(F) + (size_t)(b * SEQ + tq) * MIX_IN + C_Q + hq * HD + 8 * hh;
            float qv[4][8]; float ss = 0.f;
#pragma unroll
            for (int ks = 0; ks < 4; ++ks) { const v4u rr = __builtin_nontemporal_load((const v4u*)(qp + 16 * ks));
                qv[ks][0] = bflo(rr.x); qv[ks][1] = bfhi(rr.x); qv[ks][2] = bflo(rr.y); qv[ks][3] = bfhi(rr.y);
                qv[ks][4] = bflo(rr.z); qv[ks][5] = bfhi(rr.z); qv[ks][6] = bflo(rr.w); qv[ks][7] = bfhi(rr.w);
#pragma unroll
                for (int j = 0; j < 8; ++j) ss += qv[ks][j] * qv[ks][j]; }
            ss += __shfl_xor(ss, 32);
            const float rstd = 1.0f / sqrtf(ss * (1.0f / HD) + EPS);
#pragma unroll
            for (int ks = 0; ks < 4; ++ks)
#pragma unroll
                for (int j = 0; j < 8; ++j) qv[ks][j] = qv[ks][j] * rstd * P_qn_g(F)[16 * ks + 8 * hh + j];
            const float* rp = P_ROPE(F) + (size_t)(b * SEQ + tq) * 16;
#pragma unroll
            for (int j = 0; j < 8; ++j) { const float mine = qv[0][j], other = __shfl_xor(mine, 32); const float cs = rp[j], sn = rp[8 + j];
                qv[0][j] = hh == 0 ? (mine * cs - other * sn) : (mine * cs + other * sn); }
#pragma unroll
            for (int ks = 0; ks < 4; ++ks) { v4u o; o.x = pk2(qv[ks][0] * 0.125f, qv[ks][1] * 0.125f); o.y = pk2(qv[ks][2] * 0.125f, qv[ks][3] * 0.125f);
                o.z = pk2(qv[ks][4] * 0.125f, qv[ks][5] * 0.125f); o.w = pk2(qv[ks][6] * 0.125f, qv[ks][7] * 0.125f); qf[ks] = __builtin_bit_cast(bf16x8, o); }
        }
        f32x16 s[5];
        __builtin_amdgcn_s_setprio(1);
#pragma unroll
        for (int kj = 0; kj < 5; ++kj) {
            f32x16 acc;
#pragma unroll
            for (int i = 0; i < 16; ++i) acc[i] = 0.f;
            const LAS bf16* kp = Ks + (32 * (qi + kj) + r) * KS_STRIDE + 8 * hh;
#pragma unroll
            for (int ks = 0; ks < 4; ++ks) { const bf16x8 kf = *(const LAS bf16x8*)(kp + 16 * ks); acc = MFMA32(kf, qf[ks], acc); }
            s[kj] = acc;
        }
        __builtin_amdgcn_s_setprio(0);
        float mx = sink;
#pragma unroll
        for (int kj = 0; kj < 5; ++kj)
#pragma unroll
            for (int i = 0; i < 16; ++i) { const int kt = (i & 3) + 8 * (i >> 2) + 4 * hh; const int kbi = 32 * (qi + kj) + kt;
                bool valid = (n * 128 + kbi - 128) >= 0;
                if (kj == 0) valid = valid && (kt > r);
                if (kj == 4) valid = valid && (kt <= r);
                s[kj][i] = valid ? s[kj][i] : -INFINITY; mx = fmaxf(mx, s[kj][i]); }
        mx = fmaxf(mx, __shfl_xor(mx, 32));
        float l = 0.f;
#pragma unroll
        for (int kj = 0; kj < 5; ++kj)
#pragma unroll
            for (int i = 0; i < 16; ++i) { const float p = __expf(s[kj][i] - mx); s[kj][i] = p; l += p; }
        l += __shfl_xor(l, 32);
        l += __expf(sink - mx);
        const float inv = 1.0f / l;
        f32x16 o0, o1;
#pragma unroll
        for (int i = 0; i < 16; ++i) { o0[i] = 0.f; o1[i] = 0.f; }
        __builtin_amdgcn_s_setprio(1);
#pragma unroll
        for (int kj = 0; kj < 5; ++kj)
#pragma unroll
            for (int st = 0; st < 2; ++st) {
                v4u pa; pa.x = pk2(s[kj][8 * st + 0] * inv, s[kj][8 * st + 1] * inv); pa.y = pk2(s[kj][8 * st + 2] * inv, s[kj][8 * st + 3] * inv);
                pa.z = pk2(s[kj][8 * st + 4] * inv, s[kj][8 * st + 5] * inv); pa.w = pk2(s[kj][8 * st + 6] * inv, s[kj][8 * st + 7] * inv);
                const bf16x8 pf = __builtin_bit_cast(bf16x8, pa);
                const int kb0 = 32 * (qi + kj) + 16 * st + 4 * hh;
                const LAS bf16* v0p = VT + r * VT_STRIDE + kb0; const LAS bf16* v1p = VT + (32 + r) * VT_STRIDE + kb0;
                const v2u a0 = *(const LAS v2u*)v0p, a1 = *(const LAS v2u*)(v0p + 8), b0 = *(const LAS v2u*)v1p, b1 = *(const LAS v2u*)(v1p + 8);
                const v4u vb0 = {a0.x, a0.y, a1.x, a1.y}, vb1 = {b0.x, b0.y, b1.x, b1.y};
                o0 = MFMA32(pf, __builtin_bit_cast(bf16x8, vb0), o0);
                o1 = MFMA32(pf, __builtin_bit_cast(bf16x8, vb1), o1);
            }
        __builtin_amdgcn_s_setprio(0);
#pragma unroll
        for (int i = 0; i < 16; ++i) { const int qr = (i & 3) + 8 * (i >> 2) + 4 * hh; const int tok = n * 128 + 32 * qi + qr;
            bf16* op = P_XH(F) + (size_t)(b * SEQ + tok) * D + LRU_W + hq * HD + r;
            op[0] = (bf16)f2bf(o0[i]); op[32] = (bf16)f2bf(o1[i]); }
    }
    __syncthreads();
}

constexpr int LCH = 64;
constexpr int XC_STRIDE = 136;
constexpr int LRU_XCB_OFF = 0, LRU_XCF_OFF = LCH * XC_STRIDE * 2  , LRU_A_OFF = LRU_XCF_OFF + LCH * 128 * 4, LRU_B_OFF = LRU_A_OFF + LCH * 128 * 4, LRU_SE_OFF = LRU_B_OFF + LCH * 128 * 4;
static_assert(LRU_SE_OFF + 2 * 4 * 128 * 4 <= RING_BYTES, "LRU LDS");
__device__ __forceinline__ void lru_block(Frame& F) {
    LAS bf16* XCb = (LAS bf16*)(F.lds + LRU_XCB_OFF);
    LAS float* XCF = (LAS float*)(F.lds + LRU_XCF_OFF);
    LAS float* As = (LAS float*)(F.lds + LRU_A_OFF);
    LAS float* Bs = (LAS float*)(F.lds + LRU_B_OFF);
    LAS float* SEh = (LAS float*)(F.lds + LRU_SE_OFF);
    LAS float* SEp = SEh + 4 * 128;
    const int tid = F.tid, lane = F.lane;
    const int hd = F.bid & 7, li = F.bid >> 3, step = F.G >> 3;
    constexpr int NQ = BATCH * (SEQ / LCH);
    if (li >= NQ) return;
    const int cg = tid & 15, tp = tid >> 4, colc = hd * LRU_BLK + 8 * cg;
    float cw[4][8], cbv[8];
#pragma unroll
    for (int k = 0; k < 4; ++k) { const f32x4 a = *(const f32x4*)(P_conv_w(F) + k * LRU_W + colc), b2 = *(const f32x4*)(P_conv_w(F) + k * LRU_W + colc + 4);
        cw[k][0] = a.x; cw[k][1] = a.y; cw[k][2] = a.z; cw[k][3] = a.w; cw[k][4] = b2.x; cw[k][5] = b2.y; cw[k][6] = b2.z; cw[k][7] = b2.w; }
    { const f32x4 a = *(const f32x4*)(P_conv_b(F) + colc), b2 = *(const f32x4*)(P_conv_b(F) + colc + 4);
      cbv[0] = a.x; cbv[1] = a.y; cbv[2] = a.z; cbv[3] = a.w; cbv[4] = b2.x; cbv[5] = b2.y; cbv[6] = b2.z; cbv[7] = b2.w; }
    const int fr = lane & 15, fq = lane >> 4, j = 16 * F.wave + fr, jc = hd * LRU_BLK + j;
    bf16x8 wa[4], wx[4];
    { const bf16* wap = P_WGA(F) + (size_t)hd * 16384 + (size_t)j * 128 + 8 * fq; const bf16* wxp = P_WGX(F) + (size_t)hd * 16384 + (size_t)j * 128 + 8 * fq;
#pragma unroll
      for (int ks = 0; ks < 4; ++ks) { wa[ks] = *(const bf16x8*)(wap + 32 * ks); wx[ks] = *(const bf16x8*)(wxp + 32 * ks); } }
    const float ba = P_ga_b(F)[jc], bx = P_gx_b(F)[jc];
    const float sp8 = -8.0f * log1pf(__expf(-P_lam(F)[jc]));
    const int c = tid & 127, sub = tid >> 7, col = hd * LRU_BLK + c;
    const bf16* xbase = P_PROJ(F) + colc;
    bf16* HLp = P_HL(F); bf16* PAp = P_PA(F);
    v4u xr[5];
#define LRU_LOAD_X(q_) do { const int b_ = (q_) >> 6, ch_ = (q_) & 63; const int tr_ = ch_ * LCH + 2 * tp - 3; \
        _Pragma("unroll") for (int r_ = 0; r_ < 5; ++r_) { const int t_ = tr_ + r_; \
            xr[r_] = (t_ >= 0) ? __builtin_nontemporal_load((const v4u*)(xbase + (size_t)(b_ * SEQ + t_) * MIX_IN)) : (v4u){0u, 0u, 0u, 0u}; } } while (0)
    LRU_LOAD_X(li);
    for (int q = li; q < NQ; q += step) {
        const int b = q >> 6, ch = q & 63, t0 = ch * LCH;
        {
            float xv[5][8];
#pragma unroll
            for (int r = 0; r < 5; ++r) { xv[r][0] = bflo(xr[r].x); xv[r][1] = bfhi(xr[r].x); xv[r][2] = bflo(xr[r].y); xv[r][3] = bfhi(xr[r].y);
                xv[r][4] = bflo(xr[r].z); xv[r][5] = bfhi(xr[r].z); xv[r][6] = bflo(xr[r].w); xv[r][7] = bfhi(xr[r].w); }
            if (q + step < NQ) LRU_LOAD_X(q + step);
#pragma unroll
            for (int tk = 0; tk < 2; ++tk) { float xc[8];
#pragma unroll
                for (int e = 0; e < 8; ++e) xc[e] = cbv[e] + cw[0][e] * xv[tk][e] + cw[1][e] * xv[tk + 1][e] + cw[2][e] * xv[tk + 2][e] + cw[3][e] * xv[tk + 3][e];
                const int tl = 2 * tp + tk;
                v4u o; o.x = pk2(xc[0], xc[1]); o.y = pk2(xc[2], xc[3]); o.z = pk2(xc[4], xc[5]); o.w = pk2(xc[6], xc[7]);
                *(LAS v4u*)(XCb + tl * XC_STRIDE + 8 * cg) = o;
                *(LAS f32x4*)(XCF + tl * 128 + 8 * cg) = (f32x4){xc[0], xc[1], xc[2], xc[3]}; *(LAS f32x4*)(XCF + tl * 128 + 8 * cg + 4) = (f32x4){xc[4], xc[5], xc[6], xc[7]}; }
        }
        __syncthreads();
#pragma unroll
        for (int mt = 0; mt < 4; ++mt) {
            f32x4 ra = {0.f, 0.f, 0.f, 0.f}, rx = {0.f, 0.f, 0.f, 0.f};
            const LAS bf16* ap = XCb + (16 * mt + fr) * XC_STRIDE + 8 * fq;
#pragma unroll
            for (int ks = 0; ks < 4; ++ks) { const bf16x8 af = *(const LAS bf16x8*)(ap + 32 * ks); ra = MFMA16(af, wa[ks], ra); rx = MFMA16(af, wx[ks], rx); }
#pragma unroll
            for (int e = 0; e < 4; ++e) { const int tl = 16 * mt + 4 * fq + e;
                const float rg = sigmoidf_(ra[e] + ba), ig = sigmoidf_(rx[e] + bx);
                const float a = __expf(rg * sp8);
                const float mult = sqrtf(fmaxf(fmaf(-a, a, 1.0f), 0.f));
                As[tl * 128 + j] = a; Bs[tl * 128 + j] = mult * ig * XCF[tl * 128 + j]; }
        }
        __syncthreads();
        float hh[16], pp[16];
        {
            float h = 0.f, P = 1.f;
#pragma unroll
            for (int i = 0; i < 16; ++i) { const int tl = sub * 16 + i; const float a = As[tl * 128 + c], bq = Bs[tl * 128 + c];
                h = a * h + bq; P *= a; hh[i] = h; pp[i] = P; }
            SEh[sub * 128 + c] = h; SEp[sub * 128 + c] = P;
        }
        __syncthreads();
        {
            float carry = 0.f, pre = 1.f;
            for (int s2 = 0; s2 < sub; ++s2) { carry = SEh[s2 * 128 + c] + SEp[s2 * 128 + c] * carry; pre *= SEp[s2 * 128 + c]; }
            bf16* hl = HLp + (size_t)(b * SEQ + t0 + sub * 16) * LRU_W + col;
            bf16* pa = PAp + (size_t)(b * SEQ + t0 + sub * 16) * LRU_W + col;
#pragma unroll
            for (int i = 0; i < 16; ++i) { hl[(size_t)i * LRU_W] = (bf16)f2bf(hh[i] + pp[i] * carry); pa[(size_t)i * LRU_W] = (bf16)f2bf(pp[i] * pre); }
        }
    }
#undef LRU_LOAD_X
    __syncthreads();
}
constexpr int N_ATT_UNITS = BATCH * HKV * (SEQ / 128);
constexpr int N_LRU_UNITS = BATCH * LRU_HEADS * (SEQ / LCH);
__device__ __forceinline__ void p3_phase(Frame& F) {
    for (int u = F.bid; u < N_ATT_UNITS; u += F.G) attn_unit(F, u >> 6, (u >> 5) & 1, u & 31);
    lru_block(F);
}

__device__ __forceinline__ void p4_unit(Frame& F, int b, int ch) {
    LAS float* CAR = (LAS float*)F.lds;
    const int tid = F.tid, lane = F.lane;
    {
        f32x2 carry = {0.f, 0.f};
        const bf16* hlb = P_HL(F) + (size_t)(b * SEQ + LCH - 1) * LRU_W + 2 * tid; const bf16* pab = P_PA(F) + (size_t)(b * SEQ + LCH - 1) * LRU_W + 2 * tid;
        int c2 = 0;
        for (; c2 + 8 <= ch; c2 += 8) { unsigned hl[8], pa[8];
#pragma unroll
            for (int q = 0; q < 8; ++q) { hl[q] = *(const unsigned*)(hlb + (size_t)(c2 + q) * LCH * LRU_W); pa[q] = *(const unsigned*)(pab + (size_t)(c2 + q) * LCH * LRU_W); }
#pragma unroll
            for (int q = 0; q < 8; ++q) { carry.x = bflo(hl[q]) + bflo(pa[q]) * carry.x; carry.y = bfhi(hl[q]) + bfhi(pa[q]) * carry.y; } }
        for (; c2 < ch; ++c2) { const unsigned hl = *(const unsigned*)(hlb + (size_t)c2 * LCH * LRU_W), pa = *(const unsigned*)(pab + (size_t)c2 * LCH * LRU_W);
            carry.x = bflo(hl) + bflo(pa) * carry.x; carry.y = bfhi(hl) + bfhi(pa) * carry.y; }
        CAR[2 * tid] = carry.x; CAR[2 * tid + 1] = carry.y;
    }
    __syncthreads();
    const float* gl = P_on_lru_g(F); const float* ga = P_on_attn_g(F);
    for (int i = 0; i < 8; i += 2) {
        const size_t m0 = (size_t)b * SEQ + ch * LCH + F.wave * 8 + i;
        v2u hl[2][4], pa[2][4]; v2u yr[2][4], ar[2][4];
#pragma unroll
        for (int t = 0; t < 2; ++t)
#pragma unroll
            for (int j = 0; j < 4; ++j) { const int c = 4 * lane + 256 * j; const size_t m = m0 + t;
                hl[t][j] = __builtin_nontemporal_load((const v2u*)(P_HL(F) + m * LRU_W + c)); pa[t][j] = __builtin_nontemporal_load((const v2u*)(P_PA(F) + m * LRU_W + c));
                yr[t][j] = __builtin_nontemporal_load((const v2u*)(P_PROJ(F) + m * MIX_IN + C_Y + c)); ar[t][j] = __builtin_nontemporal_load((const v2u*)(P_XH(F) + m * D + LRU_W + c)); }
        f32x4 vl[2][4], va[2][4]; float sl[2] = {0.f, 0.f}, sa[2] = {0.f, 0.f};
#pragma unroll
        for (int t = 0; t < 2; ++t)
#pragma unroll
            for (int j = 0; j < 4; ++j) { const int c = 4 * lane + 256 * j; const f32x4 car = *(const LAS f32x4*)(CAR + c);
                const f32x4 hlf = {bflo(hl[t][j].x), bfhi(hl[t][j].x), bflo(hl[t][j].y), bfhi(hl[t][j].y)}, paf = {bflo(pa[t][j].x), bfhi(pa[t][j].x), bflo(pa[t][j].y), bfhi(pa[t][j].y)};
                const f32x4 h = hlf + paf * car;
                f32x4 v; v.x = h.x * gelu_tanh(bflo(yr[t][j].x)); v.y = h.y * gelu_tanh(bfhi(yr[t][j].x)); v.z = h.z * gelu_tanh(bflo(yr[t][j].y)); v.w = h.w * gelu_tanh(bfhi(yr[t][j].y));
                vl[t][j] = v; sl[t] += (v.x * v.x + v.y * v.y) + (v.z * v.z + v.w * v.w);
                f32x4 a; a.x = bflo(ar[t][j].x); a.y = bfhi(ar[t][j].x); a.z = bflo(ar[t][j].y); a.w = bfhi(ar[t][j].y);
                va[t][j] = a; sa[t] += (a.x * a.x + a.y * a.y) + (a.z * a.z + a.w * a.w); }
#pragma unroll
        for (int o = 1; o < 64; o <<= 1) { sl[0] += __shfl_xor(sl[0], o); sl[1] += __shfl_xor(sl[1], o); sa[0] += __shfl_xor(sa[0], o); sa[1] += __shfl_xor(sa[1], o); }
#pragma unroll
        for (int t = 0; t < 2; ++t) { const float rl = 1.0f / sqrtf(sl[t] * (1.0f / LRU_W) + EPS), ra = 1.0f / sqrtf(sa[t] * (1.0f / LRU_W) + EPS); const size_t m = m0 + t;
#pragma unroll
            for (int j = 0; j < 4; ++j) { const int c = 4 * lane + 256 * j; const f32x4 g1v = *(const f32x4*)(gl + c), g2v = *(const f32x4*)(ga + c);
                const f32x4 y = vl[t][j] * rl * g1v, z = va[t][j] * ra * g2v;
                v2u o; o.x = pk2(y.x, y.y); o.y = pk2(y.z, y.w); *(v2u*)(P_XH(F) + m * D + c) = o;
                v2u p; p.x = pk2(z.x, z.y); p.y = pk2(z.z, z.w); *(v2u*)(P_XH(F) + m * D + LRU_W + c) = p; } }
    }
    __syncthreads();
}
__device__ __forceinline__ void p4_phase(Frame& F) {
    for (int u = F.bid; u < BATCH * (SEQ / LCH); u += F.G) p4_unit(F, u >> 6, u & 63);
}

__device__ __forceinline__ int f2key(float f) { const int b = __builtin_bit_cast(int, f); return b ^ ((b >> 31) & 0x7fffffff); }
__device__ __forceinline__ float key2f(int k) { const int b = k ^ ((k >> 31) & 0x7fffffff); return __builtin_bit_cast(float, b); }
__device__ __forceinline__ void ins16(int (&L)[16], int x) {
#pragma unroll
    for (int j = 0; j < 16; ++j) { const int hi = max(L[j], x); x = min(L[j], x); L[j] = hi; }
}
__device__ __forceinline__ void ce_desc(int& a, int& b) { const int hi = a > b ? a : b, lo = a > b ? b : a; a = hi; b = lo; }
__device__ __forceinline__ void sort16_desc(int (&a)[16]) {
#pragma unroll
    for (int k = 2; k <= 16; k <<= 1)
#pragma unroll
        for (int j = k >> 1; j > 0; j >>= 1)
#pragma unroll
            for (int i = 0; i < 16; ++i) { const int l = i ^ j; if (l > i) { if ((i & k) == 0) ce_desc(a[i], a[l]); else ce_desc(a[l], a[i]); } }
}
__device__ __forceinline__ void bitonic_merge16_desc(int (&a)[16]) {
#pragma unroll
    for (int j = 8; j > 0; j >>= 1)
#pragma unroll
        for (int i = 0; i < 16; ++i) { const int l = i ^ j; if (l > i) ce_desc(a[i], a[l]); }
}
__device__ __forceinline__ void merge_top16(int (&a)[16], const int (&b)[16]) {
#pragma unroll
    for (int i = 0; i < 16; ++i) a[i] = a[i] > b[15 - i] ? a[i] : b[15 - i];
    bitonic_merge16_desc(a);
}
constexpr int INT_LOWEST = (int)0x80000000;
__device__ __forceinline__ void p8_item(Frame& F, int tt, int hd, LAS int* lut  ) {
    const int lane = F.lane, r = lane & 31, hh = lane >> 5;
    const bf16* QP = P_PROJ(F);
    int V[2][16];
#pragma unroll
    for (int p = 0; p < 2; ++p) {
        bf16x8 qf[8];
        const char* qb = (const char*)(QP + (size_t)(32 * tt) * D + hd * 256 + p * 128);
        const unsigned qoff = (unsigned)(r * D + 8 * hh) * 2u;
#pragma unroll
        for (int ks = 0; ks < 8; ++ks) qf[ks] = __builtin_nontemporal_load((const bf16x8*)(qb + qoff + 32 * ks));
        int L[16];
#pragma unroll
        for (int j = 0; j < 16; ++j) L[j] = INT_LOWEST;
        const char* skb = (const char*)(P_SK(F) + (size_t)((hd * 2 + p) * PKEYS) * PHALF);
        const unsigned skoff = (unsigned)(r * PHALF + 8 * hh) * 2u;
#pragma unroll 1
        for (int kt = 0; kt < 4; ++kt) {
            f32x16 acc;
#pragma unroll
            for (int i = 0; i < 16; ++i) acc[i] = 0.f;
            const char* skt = skb + (size_t)(32 * kt) * PHALF * 2;
#pragma unroll
            for (int ks = 0; ks < 8; ++ks) { const bf16x8 kf = *(const bf16x8*)(skt + skoff + 32 * ks); acc = MFMA32(kf, qf[ks], acc); }
            const int kbase = 32 * kt + 4 * hh;
            int T[16];
#pragma unroll
            for (int i = 0; i < 16; ++i) { const int kidx = (i & 3) + 8 * (i >> 2); T[i] = (f2key(acc[i]) & ~0x7f) | (kbase + kidx); }
            sort16_desc(T); merge_top16(L, T);
        }
        int O[16];
#pragma unroll
        for (int j = 0; j < 16; ++j) O[j] = __shfl_xor(L[j], 32);
        merge_top16(L, O);
#pragma unroll
        for (int j = 0; j < 16; ++j) V[p][j] = L[j];
    }
#pragma unroll
    for (int j = 0; j < 16; ++j) { lut[lane * 33 + j] = V[0][j] & 0x7f; lut[lane * 33 + 16 + j] = V[1][j] & 0x7f; }
    float v0[16], v1[16];
#pragma unroll
    for (int j = 0; j < 16; ++j) { v0[j] = key2f(V[0][j] & ~0x7f); v1[j] = key2f(V[1][j] & ~0x7f); }
    int C[16], G1[16], G2[16], G3[2];
    { int n = 0;
#pragma unroll
      for (int i = 0; i < 16; ++i)
#pragma unroll
        for (int j = 0; j < 16; ++j)
            if ((i + 1) * (j + 1) <= 16) { const int key = (f2key(v0[i] + v1[j]) & ~0xff) | (i * 16 + j);
                if (n < 16) C[n] = key; else if (n < 32) G1[n - 16] = key; else if (n < 48) G2[n - 32] = key; else G3[n - 48] = key;
                ++n; } }
    sort16_desc(C); sort16_desc(G1); sort16_desc(G2);
    merge_top16(C, G1); merge_top16(C, G2); ins16(C, G3[0]); ins16(C, G3[1]);
    float sv[16]; float den = 0.f;
    const float mx = key2f(C[0] & ~0xff);
#pragma unroll
    for (int e = 0; e < 16; ++e) { sv[e] = __expf(key2f(C[e] & ~0xff) - mx); den += sv[e]; }
    const float inv = 1.0f / den;
    LDS_WAIT(); asm volatile("" ::: "memory");
    int idx[16];
#pragma unroll
    for (int e = 0; e < 16; ++e) { const int pi = (C[e] >> 4) & 15, pj = C[e] & 15; idx[e] = lut[lane * 33 + pi] * PKEYS + lut[lane * 33 + 16 + pj]; }
    if (hh == 0) {
        unsigned short* ip = P_IDX(F) + (size_t)(32 * tt + r) * 128 + hd * 16; float* gp = P_GW(F) + (size_t)(32 * tt + r) * 128 + hd * 16;
#pragma unroll
        for (int q = 0; q < 2; ++q) *(v4u*)(ip + 8 * q) = (v4u){(unsigned)idx[8 * q] | ((unsigned)idx[8 * q + 1] << 16), (unsigned)idx[8 * q + 2] | ((unsigned)idx[8 * q + 3] << 16),
                                                              (unsigned)idx[8 * q + 4] | ((unsigned)idx[8 * q + 5] << 16), (unsigned)idx[8 * q + 6] | ((unsigned)idx[8 * q + 7] << 16)};
#pragma unroll
        for (int q = 0; q < 4; ++q) *(f32x4*)(gp + 4 * q) = (f32x4){sv[4 * q] * inv, sv[4 * q + 1] * inv, sv[4 * q + 2] * inv, sv[4 * q + 3] * inv};
    }
    LDS_WAIT(); asm volatile("" ::: "memory");
}
__device__ __forceinline__ void p8_phase(Frame& F) {
    LAS int* lut = (LAS int*)(F.lds + F.wave * (64 * 33 * 4));
    const int gw = F.bid * NWAVES + F.wave, NGW = F.G * NWAVES;
    for (int it = gw; it < (M / 32) * PH; it += NGW) p8_item(F, it >> 3, it & 7, lut);
}

template <int CTRL> __device__ __forceinline__ float dpp_f(float x) { return __builtin_bit_cast(float, __builtin_amdgcn_mov_dpp(__builtin_bit_cast(int, x), CTRL, 0xf, 0xf, true)); }
__device__ __forceinline__ float sum8(float v) {
    v += dpp_f<0xB1>(v);
    v += dpp_f<0x4E>(v);
    v += dpp_f<0x141>(v);
    return v;
}
__device__ __forceinline__ void dec16(const v4u r, float (&f)[16]) {
    const unsigned w4[4] = {r.x, r.y, r.z, r.w};
#pragma unroll
    for (int w = 0; w < 4; ++w) { const f32x2 lo = __builtin_amdgcn_cvt_pk_f32_fp8((int)w4[w], false), hi = __builtin_amdgcn_cvt_pk_f32_fp8((int)w4[w], true);
        f[4 * w] = lo.x; f[4 * w + 1] = lo.y; f[4 * w + 2] = hi.x; f[4 * w + 3] = hi.y; }
}
__device__ __forceinline__ void row_offsets(const v4u a, const v4u b, unsigned loff, unsigned (&off)[16]) {
    const unsigned w[8] = {a.x, a.y, a.z, a.w, b.x, b.y, b.z, b.w};
#pragma unroll
    for (int q = 0; q < 8; ++q) { off[2 * q] = ((w[q] & 0xffffu) << 7) + loff; off[2 * q + 1] = ((w[q] >> 16) << 7) + loff; }
}
#define ISSUE_ROWS(dst, TBL, ia, ib) do { unsigned off_[16]; row_offsets((ia), (ib), loff, off_); \
    _Pragma("unroll") for (int i_ = 0; i_ < 16; ++i_) dst[i_] = *(const v4u*)((TBL) + off_[i_]); } while (0)

typedef int i32x8 __attribute__((ext_vector_type(8)));
#define MFMA_F4F8(a, b, c) __builtin_amdgcn_mfma_scale_f32_16x16x128_f8f6f4((a), (b), (c), 4  , 0  , 0, 0x7f7f7f7f, 0, 0x7f7f7f7f)
#define ISSUE_ROWS_U(dst, i0, i1) do { const unsigned w_[8] = {(i0).x, (i0).y, (i0).z, (i0).w, (i1).x, (i1).y, (i1).z, (i1).w}; \
    _Pragma("unroll") for (int g_ = 0; g_ < 16; ++g_) { const unsigned id_ = (g_ & 1) ? (w_[g_ >> 1] >> 16) : (w_[g_ >> 1] & 0xffffu); \
        dst[g_] = *(const v4u*)(U4 + ((id_ << 7) + loff)); } } while (0)
__device__ __forceinline__ void p9u_compute(const v4u (&row)[16], const v4u hA0, const v4u hA1, const v4u hB0, const v4u hB1, int lane, bf16* dst) {
    const i32x8 B0 = {(int)hA0.x, (int)hA0.y, (int)hA0.z, (int)hA0.w, (int)hA1.x, (int)hA1.y, (int)hA1.z, (int)hA1.w};
    const i32x8 B1 = {(int)hB0.x, (int)hB0.y, (int)hB0.z, (int)hB0.w, (int)hB1.x, (int)hB1.y, (int)hB1.z, (int)hB1.w};
    const int n = lane & 15, q = lane >> 4, e4 = n >> 2;
    const f32x4 zero = {0.f, 0.f, 0.f, 0.f};
    float res[16];
    __builtin_amdgcn_s_setprio(1);
#pragma unroll
    for (int g = 0; g < 16; ++g) {
        const i32x8 a = {(int)row[g].x, (int)row[g].y, (int)row[g].z, (int)row[g].w, 0, 0, 0, 0};
        const f32x4 d0 = MFMA_F4F8(a, B0, zero), d1 = MFMA_F4F8(a, B1, zero);
        float v0 = d0[0]; v0 = e4 == 1 ? d0[1] : v0; v0 = e4 == 2 ? d0[2] : v0; v0 = e4 == 3 ? d0[3] : v0;
        float v1 = d1[0]; v1 = e4 == 1 ? d1[1] : v1; v1 = e4 == 2 ? d1[2] : v1; v1 = e4 == 3 ? d1[3] : v1;
        float val = (q & 1) ? v1 : v0;
        val = val + dpp_f<0x124>(val) + dpp_f<0x128>(val) + dpp_f<0x12C>(val);
        val += __shfl_xor(val, 16);
        res[g] = val;
    }
    __builtin_amdgcn_s_setprio(0);
    if ((lane & 0x1c) == 0) {
        bf16* d = dst + 16 * (2 * (n & 3) + (q >> 1));
        v4u o0, o1;
        o0.x = pk2(res[0], res[1]); o0.y = pk2(res[2], res[3]); o0.z = pk2(res[4], res[5]); o0.w = pk2(res[6], res[7]);
        o1.x = pk2(res[8], res[9]); o1.y = pk2(res[10], res[11]); o1.z = pk2(res[12], res[13]); o1.w = pk2(res[14], res[15]);
        *(v4u*)d = o0; *(v4u*)(d + 8) = o1;
    }
}
__device__ __forceinline__ void p9u_item(Frame& F, int s, int tb) {
    const int lane = F.lane, sg = lane & 7, r8 = lane >> 3, n = lane & 15, kq = lane >> 4;
    const unsigned char* U4 = P_U(F);
    const unsigned loff = (unsigned)(s * (NEXP * 128) + 16 * sg);
    const unsigned short* idxb = P_IDX(F) + (size_t)(64 * tb) * 128 + 16 * r8;
    const unsigned char* hb = P_H8(F) + (size_t)(64 * tb) * D + 256 * s + 32 * (n >> 2) + 16 * (kq & 1);
    const bool bon = (kq >> 1) == (n & 1); const bool bhi = (n & 2) != 0;
    bf16* pb = (bf16*)P_PART(F) + ((size_t)s * M + 64 * tb) * 128;
#define LOAD_META_U(I0, I1, A0, A1, B0, B1, tt_) do { const int tn_ = (tt_) < 64 ? (tt_) : 63; const unsigned short* ip_ = idxb + (size_t)tn_ * 128; I0 = *(const v4u*)(ip_); I1 = *(const v4u*)(ip_ + 8); \
        const unsigned char* hp_ = hb + (size_t)tn_ * D; const v4u z_ = {0u, 0u, 0u, 0u}; \
        const v4u x0_ = bon ? *(const v4u*)(hp_) : z_, x1_ = bon ? *(const v4u*)(hp_ + 128) : z_; \
        A0 = bhi ? z_ : x0_; A1 = bhi ? x0_ : z_; B0 = bhi ? z_ : x1_; B1 = bhi ? x1_ : z_; } while (0)
    v4u aI0, aI1, aA0, aA1, aB0, aB1, bI0, bI1, bA0, bA1, bB0, bB1, cI0, cI1, cA0, cA1, cB0, cB1, dI0, dI1, dA0, dA1, dB0, dB1;
    LOAD_META_U(aI0, aI1, aA0, aA1, aB0, aB1, 0); LOAD_META_U(bI0, bI1, bA0, bA1, bB0, bB1, 1); LOAD_META_U(cI0, cI1, cA0, cA1, cB0, cB1, 2);
    v4u rowA[16], rowB[16];
    ISSUE_ROWS_U(rowA, aI0, aI1); ISSUE_ROWS_U(rowB, bI0, bI1);
#pragma unroll 1
    for (int t = 0; t < 64; t += 2) {
        p9u_compute(rowA, aA0, aA1, aB0, aB1, lane, pb + (size_t)t * 128);
        LOAD_META_U(dI0, dI1, dA0, dA1, dB0, dB1, t + 3);
        ISSUE_ROWS_U(rowA, cI0, cI1);
        p9u_compute(rowB, bA0, bA1, bB0, bB1, lane, pb + (size_t)(t + 1) * 128);
        aA0 = cA0; aA1 = cA1; aB0 = cB0; aB1 = cB1; bA0 = dA0; bA1 = dA1; bB0 = dB0; bB1 = dB1;
        LOAD_META_U(cI0, cI1, cA0, cA1, cB0, cB1, t + 4);
        ISSUE_ROWS_U(rowB, dI0, dI1);
    }
#undef LOAD_META_U
}
#define MFMA_F8F4(a, b, c) __builtin_amdgcn_mfma_scale_f32_16x16x128_f8f6f4((a), (b), (c), 0  , 4  , 0, 0x7f7f7f7f, 0, 0x7f7f7f7f)
#define ISSUE_ROWS_V(dst, i0, i1) do { const unsigned w_[8] = {(i0).x, (i0).y, (i0).z, (i0).w, (i1).x, (i1).y, (i1).z, (i1).w}; \
    _Pragma("unroll") for (int g_ = 0; g_ < 16; ++g_) { const unsigned id_ = (g_ & 1) ? (w_[g_ >> 1] >> 16) : (w_[g_ >> 1] & 0xffffu); \
        dst[g_] = *(const v4u*)(V4 + ((id_ << 7) + loff)); } } while (0)
struct VLane { unsigned shl, m00, m01, m10, m11; };
__device__ __forceinline__ void p9v_compute(const v4u (&row)[16], const v4u wlo, const v4u whi, int lane, const VLane L, const bf16* xp, const f32x4 (&g2)[4], float wscale, float* dst) {
    v2u x1[4];
#pragma unroll
    for (int t = 0; t < 4; ++t) x1[t] = *(const v2u*)(xp + 8 * t);
    f32x4 d[4];
#pragma unroll
    for (int t = 0; t < 4; ++t) d[t] = (f32x4){0.f, 0.f, 0.f, 0.f};
    const unsigned wl4[4] = {wlo.x, wlo.y, wlo.z, wlo.w}, wh4[4] = {whi.x, whi.y, whi.z, whi.w};
    i32x8 a0 = {0, 0, 0, 0, 0, 0, 0, 0}, a1 = a0, a2 = a0, a3 = a0;
    __builtin_amdgcn_s_setprio(1);
#pragma unroll
    for (int g = 0; g < 16; ++g) {
        const unsigned lo = ((wl4[g >> 2] >> (8 * (g & 3))) & 0xffu) << L.shl, hi = ((wh4[g >> 2] >> (8 * (g & 3))) & 0xffu) << L.shl;
        const int l00 = (int)(lo & L.m00), l01 = (int)(lo & L.m01), h00 = (int)(hi & L.m00), h01 = (int)(hi & L.m01);
        const int l10 = (int)(lo & L.m10), l11 = (int)(lo & L.m11), h10 = (int)(hi & L.m10), h11 = (int)(hi & L.m11);
        const i32x8 b = {(int)row[g].x, (int)row[g].y, (int)row[g].z, (int)row[g].w, 0, 0, 0, 0};
        a0[0] = l00; a0[1] = l01; a0[4] = h00; a0[5] = h01;   a1[2] = l00; a1[3] = l01; a1[6] = h00; a1[7] = h01;
        a2[0] = l10; a2[1] = l11; a2[4] = h10; a2[5] = h11;   a3[2] = l10; a3[3] = l11; a3[6] = h10; a3[7] = h11;
        d[0] = MFMA_F8F4(a0, b, d[0]); d[1] = MFMA_F8F4(a1, b, d[1]); d[2] = MFMA_F8F4(a2, b, d[2]); d[3] = MFMA_F8F4(a3, b, d[3]);
    }
    __builtin_amdgcn_s_setprio(0);
#pragma unroll
    for (int t = 0; t < 4; ++t)
#pragma unroll
        for (int e = 0; e < 4; ++e) d[t][e] += __shfl_xor(d[t][e], 40);
    if ((lane & 40) == 0) {
#pragma unroll
        for (int t = 0; t < 4; ++t) { const f32x4 xv = {bflo(x1[t].x), bfhi(x1[t].x), bflo(x1[t].y), bfhi(x1[t].y)};
            *(f32x4*)(dst + 8 * t) = xv + g2[t] * (d[t] * wscale); }
    }
}
__device__ __forceinline__ void p9v_item(Frame& F, int s, int tb) {
    const int lane = F.lane, sg = lane & 7, r8 = lane >> 3;
    const unsigned char* V4 = P_V(F);
    const unsigned loff = (unsigned)(s * (NEXP * 128) + 16 * sg);
    const unsigned short* idxb = P_IDX(F) + (size_t)(64 * tb) * 128 + 16 * r8;
    const int ai = lane & 15, kqa = lane >> 4;
    VLane L; L.shl = 8u * (unsigned)(ai & 3);
    { const bool d1 = (ai & 4) != 0, hiv = (kqa & 1) != 0;
      L.m00 = (!hiv && !d1) ? 0xffffffffu : 0u; L.m01 = (!hiv && d1) ? 0xffffffffu : 0u; L.m10 = (hiv && !d1) ? 0xffffffffu : 0u; L.m11 = (hiv && d1) ? 0xffffffffu : 0u; }
    const unsigned char* wbl = P_W(F) + (size_t)(64 * tb) * 128 + 16 * (2 * (kqa >> 1) + (ai >> 3));
    const unsigned char* wbh = wbl + 64;
    const float* wscp = P_WSC(F) + 64 * tb;
    const int b = (64 * tb) / SEQ;
    const int ocol = 256 * s + 32 * (lane & 7) + 4 * ((lane >> 4) & 1);
    f32x4 g2[4];
#pragma unroll
    for (int t = 0; t < 4; ++t) g2[t] = *(const f32x4*)(P_ADA(F) + (size_t)b * ADA_W + 5 * D + ocol + 8 * t);
    float* ob = P_out(F) + (size_t)(64 * tb) * D + ocol;
    const bf16* xb = P_X1B(F) + (size_t)(64 * tb) * D + ocol;
#define LOAD_META_V(I0, I1, WL, WH, WS, tt_) do { const int tn_ = (tt_) < 64 ? (tt_) : 63; const unsigned short* ip_ = idxb + (size_t)tn_ * 128; I0 = *(const v4u*)(ip_); I1 = *(const v4u*)(ip_ + 8); \
        WL = *(const v4u*)(wbl + (size_t)tn_ * 128); WH = *(const v4u*)(wbh + (size_t)tn_ * 128); WS = wscp[tn_]; } while (0)
    v4u aI0, aI1, aWL, aWH, bI0, bI1, bWL, bWH, cI0, cI1, cWL, cWH, dI0, dI1, dWL, dWH; float aS, bS, cS, dS;
    LOAD_META_V(aI0, aI1, aWL, aWH, aS, 0); LOAD_META_V(bI0, bI1, bWL, bWH, bS, 1); LOAD_META_V(cI0, cI1, cWL, cWH, cS, 2);
    v4u rowA[16], rowB[16];
    ISSUE_ROWS_V(rowA, aI0, aI1); ISSUE_ROWS_V(rowB, bI0, bI1);
#pragma unroll 1
    for (int t = 0; t < 64; t += 2) {
        p9v_compute(rowA, aWL, aWH, lane, L, xb + (size_t)t * D, g2, aS, ob + (size_t)t * D);
        LOAD_META_V(dI0, dI1, dWL, dWH, dS, t + 3);
        ISSUE_ROWS_V(rowA, cI0, cI1);
        p9v_compute(rowB, bWL, bWH, lane, L, xb + (size_t)(t + 1) * D, g2, bS, ob + (size_t)(t + 1) * D);
        aWL = cWL; aWH = cWH; aS = cS; bWL = dWL; bWH = dWH; bS = dS;
        LOAD_META_V(cI0, cI1, cWL, cWH, cS, t + 4);
        ISSUE_ROWS_V(rowB, dI0, dI1);
    }
#undef LOAD_META_V
}
__device__ __forceinline__ void p9u_phase(Frame& F) {
    const int x = F.bid & 7, rank = F.bid >> 3, nr = F.G >> 3;
    for (int tb = rank * NWAVES + F.wave; tb < M / 64; tb += nr * NWAVES) p9u_item(F, x, tb);
}
__device__ __forceinline__ void p9v_phase(Frame& F) {
    const int x = F.bid & 7, rank = F.bid >> 3, nr = F.G >> 3;
    for (int tb = rank * NWAVES + F.wave; tb < M / 64; tb += nr * NWAVES) p9v_item(F, x, tb);
}
__device__ __forceinline__ void p9w_phase(Frame& F) {
    const unsigned* part = P_PART(F); const unsigned short* idxp = P_IDX(F); const float* gwp = P_GW(F); const float* usc = P_USC(F); const float* vsc = P_VSC(F);
    unsigned char* wp = P_W(F); float* wsc = P_WSC(F);
    for (int it = F.bid * 512 + F.tid; it < M * 64; it += F.G * 512) {
        float a0 = 0.f, a1 = 0.f;
#pragma unroll
        for (int s = 0; s < 8; ++s) { const unsigned w = __builtin_nontemporal_load(part + (size_t)s * M * 64 + it); a0 += bflo(w); a1 += bfhi(w); }
        const int m = it >> 6; const size_t p0 = 2 * (size_t)it;
        const unsigned iw = *(const unsigned*)(idxp + p0); const int i0 = iw & 0xffffu, i1 = iw >> 16;
        const f32x2 gw = *(const f32x2*)(gwp + p0);
        const float w0 = gw.x * gelu_tanh(a0 * usc[i0]) * vsc[i0], w1 = gw.y * gelu_tanh(a1 * usc[i1]) * vsc[i1];
        float mx = fmaxf(fabsf(w0), fabsf(w1));
#pragma unroll
        for (int o = 1; o < 64; o <<= 1) mx = fmaxf(mx, __shfl_xor(mx, o));
        const float sc = 224.0f / fmaxf(mx, 1e-30f);
        const int t = __builtin_amdgcn_cvt_pk_fp8_f32(w0 * sc, w1 * sc, 0, false);
        *(unsigned short*)(wp + p0) = (unsigned short)(t & 0xffff);
        if ((it & 63) == 0) wsc[m] = fmaxf(mx, 1e-30f) * (1.0f / 224.0f);
    }
}

struct Args { const void* in[25]; float* out; unsigned char* ws; int ph_lo, ph_hi; };
__global__ void __launch_bounds__(NWAVES * 64, 2) hymba_fwd(Args args) {
    extern __shared__ __attribute__((aligned(16))) unsigned char lds_raw[];
    Frame F;
    F.lds = (LAS unsigned char*)lds_raw;
    F.tid = threadIdx.x; F.lane = F.tid & 63; F.wave = __builtin_amdgcn_readfirstlane(F.tid >> 6);
    F.G = gridDim.x; F.bid = blockIdx.x;
    F.ka = (kaptr_t)__builtin_amdgcn_kernarg_segment_ptr();
    static_assert(sizeof(Args) == 224, "kernarg byte offsets used by ka_ptr");
    for (int u = F.tid; u < (LDS_BYTES - LDSCTL_OFF) / 4; u += NWAVES * 64) ((LAS unsigned*)(F.lds + LDSCTL_OFF))[u] = 0u;
    __syncthreads();
    volatile LAS unsigned* MISC = (volatile LAS unsigned*)(F.lds + MISC_OFF);
    XcdBarrier bar; bar.bar = (unsigned*)(P_ws(F) + WS_CTL) + CW_BAR; bar.x = 0; bar.st = nullptr;
    const int lo = args.ph_lo, hi = args.ph_hi;
    if (hi - lo > 1) bar = xcd_barrier_post((unsigned*)(P_ws(F) + WS_CTL) + CW_BAR, MISC + 8);
#define IN(k) (lo <= (k) && (k) < hi)
#define STAMP(k) do { if (PROBE_STAMP >= 0 && F.bid == 0 && F.tid == 0) ((unsigned long long*)(P_ws(F) + WS_CTL + 64))[(k)] = __builtin_amdgcn_s_memrealtime(); } while (0)
#define SEAM(k) do { STAMP(16 + (k)); if (IN(k) && IN((k) + 1)) xcd_barrier(bar); STAMP((k) + 1); } while (0)
    STAMP(0);

#ifndef PROBE_MASK
#define PROBE_MASK 0
#endif
#define REP(k) for (int rep_ = 0; rep_ < (((PROBE_MASK >> (k)) & 1) ? 2 : 1); ++rep_)
#define REPSYNC(k) do { if (((PROBE_MASK >> (k)) & 1) && rep_ == 0) xcd_barrier(bar); } while (0)
    if (IN(0)) { REP(0) { p0_prologue(F); REPSYNC(0); } } SEAM(0);
    if (IN(1)) { REP(1) { p1_phase(F); REPSYNC(1); } } SEAM(1);
    if (IN(2)) REP(2) {
        pg8::Gemm g{P_XH(F), P_WIN(F), M, MIX_IN, D}; pg8::StaticOrder S; S.init(M, MIX_IN, F.G, F.bid);
        pg8::EpiStoreBf16 E{P_PROJ(F), MIX_IN};
        pg8::gemm_phase<pg8::EpiStoreBf16, pg8::StaticOrder, false, true>(F.lds, g, S, E); REPSYNC(2);
        { const int nwg = (M / 256) * (MIX_IN / 256), busy = nwg % F.G;
          if (busy > 0 && F.bid >= busy) quant_rows(F, QUANT_SPLIT, 2 * NEXP, (F.bid - busy) * NWAVES + F.wave, (F.G - busy) * NWAVES);
          else if (busy == 0) quant_rows(F, QUANT_SPLIT, 2 * NEXP, F.bid * NWAVES + F.wave, F.G * NWAVES); }
    } SEAM(2);
    if (IN(3)) { p3_phase(F); } SEAM(3);
    if (IN(4)) { p4_phase(F); } SEAM(4);
    if (IN(5)) REP(5) {
        pg8::Gemm g{P_XH(F), P_WOUT(F), M, D, D}; pg8::StaticOrder S; S.init(M, D, F.G, F.bid);
        pg8::EpiGateBf16 E{P_X1B(F), D, P_ADA(F) + 2 * D, ADA_W, SEQ};
        pg8::gemm_phase<pg8::EpiGateBf16, pg8::StaticOrder, false, true>(F.lds, g, S, E); REPSYNC(5);
    } SEAM(5);
    if (IN(6)) { REP(6) { p6_phase(F); REPSYNC(6); } } SEAM(6);
    if (IN(7)) REP(7) {
        pg8::Gemm g{P_XH(F), P_WQ(F), M, D, D}; pg8::StaticOrder S; S.init(M, D, F.G, F.bid);
        pg8::EpiStoreBf16 E{P_PROJ(F), D};
        pg8::gemm_phase<pg8::EpiStoreBf16, pg8::StaticOrder, false, true>(F.lds, g, S, E); REPSYNC(7);
    } SEAM(7);
    if (IN(8)) { REP(8) { p8_phase(F); REPSYNC(8); } } SEAM(8);
#ifdef PROBE_MFMA4
    if (F.bid == 0 && F.wave == 0) {
        const int l_ = F.lane, i_ = l_ & 15, kq_ = l_ >> 4; (void)i_; (void)kq_;
        i32x8 a_ = {0, 0, 0, 0, 0, 0, 0, 0}, b_ = {0, 0, 0, 0, 0, 0, 0, 0};
        PROBE_MFMA4;
        const f32x4 z_ = {0.f, 0.f, 0.f, 0.f};
#ifdef PROBE_SWAPFMT
        const f32x4 d_ = __builtin_amdgcn_mfma_scale_f32_16x16x128_f8f6f4(a_, b_, z_, 0  , 4  , 0, 0x7f7f7f7f, 0, 0x7f7f7f7f);
#else
        const f32x4 d_ = MFMA_F4F8(a_, b_, z_);
#endif
        float* pr_ = (float*)(P_ws(F) + WS_CTL + 40960);
        pr_[l_ * 4 + 0] = d_[0]; pr_[l_ * 4 + 1] = d_[1]; pr_[l_ * 4 + 2] = d_[2]; pr_[l_ * 4 + 3] = d_[3];
    }
#endif
    if (IN(9)) { p9u_phase(F); }
    if (PROBE_STAMP >= 0 && F.tid == 0) ((unsigned long long*)(P_ws(F) + WS_CTL + 32768))[F.bid] = __builtin_amdgcn_s_memrealtime();
    SEAM(9);
    if (IN(10)) { p9w_phase(F); } SEAM(10);
    if (IN(11)) { p9v_phase(F); }
    if (PROBE_STAMP >= 0) {
        __syncthreads(); STAMP(12); VM_WAIT(); __syncthreads();
        if (F.bid == 0 && F.tid == 0) { const unsigned long long* ts = (const unsigned long long*)(P_ws(F) + WS_CTL + 64);
            float us = (float)(ts[PROBE_STAMP + 1] - ts[PROBE_STAMP]) * 0.01f;
#ifdef PROBE_BLOCKSTAT
            { const unsigned long long* bt = (const unsigned long long*)(P_ws(F) + WS_CTL + 32768); float acc_ = 0.f;
              for (int b_ = 0; b_ < (int)gridDim.x; ++b_) { const float d_ = (float)(bt[b_] - ts[9]) * 0.01f; PROBE_BLOCKSTAT; } us = acc_; }
#endif
#ifdef PROBE_MFMA4
            { const float* pr_ = (const float*)(P_ws(F) + WS_CTL + 40960); float acc_ = 0.f; PROBE_MFMA4_READ; us = acc_; }
#endif
            P_out(F)[0] += us * (1.0f / PROBE_DIV); }
    }
#undef IN
#undef SEAM
}

extern "C" void kernel_launch(void* const* d_in, const int* in_sizes, int n_in, void* d_out, int out_size, void* d_ws, size_t ws_size, hipStream_t stream) {
    static int grid = 0;
    if (grid == 0) {
        if (n_in != 25 || in_sizes[0] != M * D || out_size != M * D || ws_size < WS_END) {
            fprintf(stderr, "kernel_launch: built for 25 inputs, x/out of %d floats, >= %zu bytes of workspace; got n_in %d, in0 %d, out %d, ws %zu; nothing launched\n", M * D, (size_t)WS_END, n_in, n_in > 0 ? in_sizes[0] : -1, out_size, ws_size);
            grid = -1; return; }
        int dev = 0, cus = 0, per_cu = 0;
        if (hipGetDevice(&dev) != hipSuccess || hipDeviceGetAttribute(&cus, hipDeviceAttributeMultiprocessorCount, dev) != hipSuccess) { fprintf(stderr, "kernel_launch: device query failed\n"); grid = -1; return; }
        if (hipFuncSetAttribute((const void*)hymba_fwd, hipFuncAttributeMaxDynamicSharedMemorySize, LDS_BYTES) != hipSuccess) { fprintf(stderr, "kernel_launch: hipFuncSetAttribute failed\n"); grid = -1; return; }
        if (hipOccupancyMaxActiveBlocksPerMultiprocessor(&per_cu, (const void*)hymba_fwd, NWAVES * 64, LDS_BYTES) != hipSuccess || per_cu < 1) {
            fprintf(stderr, "kernel_launch: occupancy query reports %d workgroups per CU; need 1\n", per_cu); (void)hipGetLastError(); grid = -1; return; }
        grid = cus;
        if (grid % 8 != 0 || (M / 64) % (grid / 8 * NWAVES) != 0) { fprintf(stderr, "kernel_launch: grid %d not supported (needs a multiple of 8 dividing the token blocks)\n", grid); grid = -1; return; }
    }
    if (grid < 0) return;
    if (hipMemsetAsync((char*)d_ws + WS_CTL, 0, CTL_ZERO_BYTES, stream) != hipSuccess) { fprintf(stderr, "kernel_launch: memset failed\n"); return; }
    Args a{};
    for (int i = 0; i < 25; ++i) a.in[i] = d_in[i];
    a.out = (float*)d_out; a.ws = (unsigned char*)d_ws;
    if (N_LAUNCHES == 1) {
        a.ph_lo = 0; a.ph_hi = N_PHASES;
        void* kargs[] = {&a};
        const hipError_t le = hipLaunchCooperativeKernel((const void*)hymba_fwd, dim3(grid), dim3(NWAVES * 64), kargs, LDS_BYTES, stream);
        if (le != hipSuccess) fprintf(stderr, "kernel_launch: cooperative launch failed: %s (grid %d)\n", hipGetErrorName(le), grid);
    } else {
#ifndef PROBE_TWICE
#define PROBE_TWICE 0
#endif
        for (int li = 0; li < N_PHASES; ++li) { a.ph_lo = li; a.ph_hi = li + 1;
            if ((PROBE_TWICE >> li) & 1) hipLaunchKernelGGL(hymba_fwd, dim3(grid), dim3(NWAVES * 64), LDS_BYTES, stream, a);
            hipLaunchKernelGGL(hymba_fwd, dim3(grid), dim3(NWAVES * 64), LDS_BYTES, stream, a);
            const hipError_t le = hipPeekAtLastError();
            if (le != hipSuccess) { fprintf(stderr, "kernel_launch: launch %d failed: %s\n", li, hipGetErrorName(le)); break; } }
    }
}
```

```cpp
#include <hip/hip_runtime.h>
#include <cstdio>
#include <cstdint>
namespace pg8 {
#define PG8_LAS __attribute__((address_space(3)))
typedef unsigned short bf16_t;
typedef short bf16x8 __attribute__((ext_vector_type(8)));
typedef float f32x4 __attribute__((ext_vector_type(4)));
typedef unsigned u32x4 __attribute__((ext_vector_type(4)));
constexpr int BM = 256, BK = 64, HALF = 128, HTB = HALF * BK * 2  , STAGE_BYTES = 8 * HTB, NXCD = 8, WGM = 8;

__host__ __device__ __forceinline__ int lds_byte(int r, int c) { const int st = (r >> 4) * 2 + (c >> 5), rr = r & 15, cc = c & 31, ob = rr * 64 + cc * 2; return st * 1024 + (ob ^ (((ob >> 9) & 1) << 5)); }
__host__ __device__ __forceinline__ void stage_rc(int b, int& R, int& C) { const int st = b / 1024, sb = b % 1024, swz = sb ^ (((sb >> 9) & 1) << 5); R = (st >> 1) * 16 + swz / 64; C = (st & 1) * 32 + (swz % 64) / 2; }
__host__ __device__ __forceinline__ int perm32(int rho) { const int n = rho >> 4, i = rho & 15; return 8 * (i >> 2) + 4 * n + (i & 3); }

struct Unit { int pm, pn; };
struct Gemm { const bf16_t* A; const bf16_t* Bt; int M, N, K; };

struct StaticOrder {
    int nM, nN, nwg, G, c;
    __host__ __device__ void init(int M, int N, int G_, int c_) { nM = M / BM; nN = N / BM; nwg = nM * nN; G = G_; c = c_; }
    __host__ __device__ bool next(int i, Unit& u) const {
        const long L = (long)i * G + c; if (L >= nwg) return false;
        int wgid = (int)L; { const int q = nwg / NXCD, r = nwg % NXCD, xcd = wgid % NXCD, off = wgid / NXCD; wgid = (xcd < r ? xcd * (q + 1) : r * (q + 1) + (xcd - r) * q) + off; }
        const int nig = WGM * nN, gid = wgid / nig, fm = gid * WGM, gsz = (nM - fm) < WGM ? (nM - fm) : WGM;
        u.pm = fm + ((wgid % nig) % gsz); u.pn = (wgid % nig) / gsz; return true;
    }
    __device__ __forceinline__ void a_ready(const Unit&) const {}
    __device__ __forceinline__ void done(const Unit&) const {}
};

__device__ __forceinline__ unsigned cvt_pk_bf16(float lo, float hi) { unsigned r; asm volatile("v_cvt_pk_bf16_f32 %0, %1, %2" : "=v"(r) : "v"(lo), "v"(hi)); return r; }
struct EpiStoreBf16 {
    static constexpr bool PERM = true, AFTER_DRAIN = false;
    bf16_t* O; int ldc; float scale;
    __device__ __forceinline__ void operator()(const f32x4 (&acc)[2][2][4][2], const Unit& u, int wr, int wc, int fr, int fq) const {
        const int row0 = u.pm * BM + wr * 64 + fr; const int col0 = u.pn * BM + wc * 32 + 8 * fq;
#pragma unroll
        for (int ai = 0; ai < 2; ++ai)
#pragma unroll
            for (int m = 0; m < 4; ++m) { bf16_t* rowp = O + (size_t)(row0 + ai * HALF + m * 16) * ldc + col0;
#pragma unroll
                for (int bj = 0; bj < 2; ++bj) { const f32x4 v0 = acc[ai][bj][m][0] * scale, v1 = acc[ai][bj][m][1] * scale;
                    u32x4 w; w.x = cvt_pk_bf16(v0[0], v0[1]); w.y = cvt_pk_bf16(v0[2], v0[3]); w.z = cvt_pk_bf16(v1[0], v1[1]); w.w = cvt_pk_bf16(v1[2], v1[3]);
                    *(u32x4*)(rowp + bj * HALF) = w; } }
    }
};
struct EpiGateBf16 {
    static constexpr bool PERM = true, AFTER_DRAIN = false;
    bf16_t* out; int ldc; const float* gate; int gstride; int rows_per_batch;
    __device__ __forceinline__ void operator()(const f32x4 (&acc)[2][2][4][2], const Unit& u, int wr, int wc, int fr, int fq) const {
        const int b = (u.pm * BM) / rows_per_batch; const float* g = gate + (size_t)b * gstride;
        const int col0 = u.pn * BM + wc * 32 + 8 * fq;
        f32x4 gv[2][2];
#pragma unroll
        for (int bj = 0; bj < 2; ++bj)
#pragma unroll
            for (int n = 0; n < 2; ++n) gv[bj][n] = *(const f32x4*)(g + col0 + bj * HALF + n * 4);
#pragma unroll
        for (int ai = 0; ai < 2; ++ai)
#pragma unroll
            for (int m = 0; m < 4; ++m) { bf16_t* rowp = out + (size_t)(u.pm * BM + ai * HALF + wr * 64 + m * 16 + fr) * ldc + col0;
#pragma unroll
                for (int bj = 0; bj < 2; ++bj) { const f32x4 v0 = gv[bj][0] * acc[ai][bj][m][0], v1 = gv[bj][1] * acc[ai][bj][m][1];
                    u32x4 w; w.x = cvt_pk_bf16(v0[0], v0[1]); w.y = cvt_pk_bf16(v0[2], v0[3]); w.z = cvt_pk_bf16(v1[0], v1[1]); w.w = cvt_pk_bf16(v1[2], v1[3]);
                    *(u32x4*)(rowp + bj * HALF) = w; } }
    }
};

typedef int epi_i32x4 __attribute__((ext_vector_type(4)));
__device__ __forceinline__ f32x4 epi_i2f(const f32x4 a) { return __builtin_convertvector(__builtin_bit_cast(epi_i32x4, a), f32x4); }
struct EpiI8StoreBf16 {
    static constexpr bool PERM = true, AFTER_DRAIN = false;
    bf16_t* O; int ldc; const float* rs; const float* cs;
    __device__ __forceinline__ void operator()(const f32x4 (&acc)[2][2][4][2], const Unit& u, int wr, int wc, int fr, int fq) const {
        const int row0 = u.pm * BM + wr * 64 + fr; const int col0 = u.pn * BM + wc * 32 + 8 * fq;
        f32x4 cv[2][2];
#pragma unroll
        for (int bj = 0; bj < 2; ++bj)
#pragma unroll
            for (int n = 0; n < 2; ++n) cv[bj][n] = *(const f32x4*)(cs + col0 + bj * HALF + n * 4);
#pragma unroll
        for (int ai = 0; ai < 2; ++ai)
#pragma unroll
            for (int m = 0; m < 4; ++m) { const int row = row0 + ai * HALF + m * 16; const float r = rs[row]; bf16_t* rowp = O + (size_t)row * ldc + col0;
#pragma unroll
                for (int bj = 0; bj < 2; ++bj) { const f32x4 v0 = (epi_i2f(acc[ai][bj][m][0]) * r) * cv[bj][0], v1 = (epi_i2f(acc[ai][bj][m][1]) * r) * cv[bj][1];
                    u32x4 w; w.x = cvt_pk_bf16(v0[0], v0[1]); w.y = cvt_pk_bf16(v0[2], v0[3]); w.z = cvt_pk_bf16(v1[0], v1[1]); w.w = cvt_pk_bf16(v1[2], v1[3]);
                    *(u32x4*)(rowp + bj * HALF) = w; } }
    }
};
struct EpiI8GateBf16 {
    static constexpr bool PERM = true, AFTER_DRAIN = false;
    bf16_t* out; int ldc; const float* gate; int gstride; int rows_per_batch; const float* rs; const float* cs;
    __device__ __forceinline__ void operator()(const f32x4 (&acc)[2][2][4][2], const Unit& u, int wr, int wc, int fr, int fq) const {
        const int b = (u.pm * BM) / rows_per_batch; const float* g = gate + (size_t)b * gstride;
        const int col0 = u.pn * BM + wc * 32 + 8 * fq;
        f32x4 gv[2][2];
#pragma unroll
        for (int bj = 0; bj < 2; ++bj)
#pragma unroll
            for (int n = 0; n < 2; ++n) gv[bj][n] = *(const f32x4*)(g + col0 + bj * HALF + n * 4) * *(const f32x4*)(cs + col0 + bj * HALF + n * 4);
#pragma unroll
        for (int ai = 0; ai < 2; ++ai)
#pragma unroll
            for (int m = 0; m < 4; ++m) { const int row = u.pm * BM + ai * HALF + wr * 64 + m * 16 + fr; const float r = rs[row]; bf16_t* rowp = out + (size_t)row * ldc + col0;
#pragma unroll
                for (int bj = 0; bj < 2; ++bj) { const f32x4 v0 = gv[bj][0] * (epi_i2f(acc[ai][bj][m][0]) * r), v1 = gv[bj][1] * (epi_i2f(acc[ai][bj][m][1]) * r);
                    u32x4 w; w.x = cvt_pk_bf16(v0[0], v0[1]); w.y = cvt_pk_bf16(v0[2], v0[3]); w.z = cvt_pk_bf16(v1[0], v1[1]); w.w = cvt_pk_bf16(v1[2], v1[3]);
                    *(u32x4*)(rowp + bj * HALF) = w; } }
    }
};
struct EpiI8GateResBf16 {
    static constexpr bool PERM = true, AFTER_DRAIN = false;
    bf16_t* out; int ldc; const float* gate; int gstride; int rows_per_batch; const float* rs; const float* cs; const float* x;
    __device__ __forceinline__ void operator()(const f32x4 (&acc)[2][2][4][2], const Unit& u, int wr, int wc, int fr, int fq) const {
        const int b = (u.pm * BM) / rows_per_batch; const float* g = gate + (size_t)b * gstride;
        const int col0 = u.pn * BM + wc * 32 + 8 * fq;
        f32x4 gv[2][2];
#pragma unroll
        for (int bj = 0; bj < 2; ++bj)
#pragma unroll
            for (int n = 0; n < 2; ++n) gv[bj][n] = *(const f32x4*)(g + col0 + bj * HALF + n * 4) * *(const f32x4*)(cs + col0 + bj * HALF + n * 4);
#pragma unroll
        for (int ai = 0; ai < 2; ++ai) {
            f32x4 xv[4][2][2]; float rv[4];
#pragma unroll
            for (int m = 0; m < 4; ++m) { const int row = u.pm * BM + ai * HALF + wr * 64 + m * 16 + fr; rv[m] = rs[row]; const float* xp = x + (size_t)row * ldc + col0;
#pragma unroll
                for (int bj = 0; bj < 2; ++bj) { xv[m][bj][0] = __builtin_nontemporal_load((const f32x4*)(xp + bj * HALF)); xv[m][bj][1] = __builtin_nontemporal_load((const f32x4*)(xp + bj * HALF + 4)); } }
#pragma unroll
            for (int m = 0; m < 4; ++m) { const int row = u.pm * BM + ai * HALF + wr * 64 + m * 16 + fr; bf16_t* rowp = out + (size_t)row * ldc + col0;
#pragma unroll
                for (int bj = 0; bj < 2; ++bj) { const f32x4 v0 = xv[m][bj][0] + gv[bj][0] * (epi_i2f(acc[ai][bj][m][0]) * rv[m]), v1 = xv[m][bj][1] + gv[bj][1] * (epi_i2f(acc[ai][bj][m][1]) * rv[m]);
                    u32x4 w; w.x = cvt_pk_bf16(v0[0], v0[1]); w.y = cvt_pk_bf16(v0[2], v0[3]); w.z = cvt_pk_bf16(v1[0], v1[1]); w.w = cvt_pk_bf16(v1[2], v1[3]);
                    *(u32x4*)(rowp + bj * HALF) = w; } } }
    }
};
template <bool ON> __device__ __forceinline__ const char* pg8_uni(const char* p) {
    if constexpr (ON) { const unsigned long long u = (unsigned long long)p; const unsigned lo = __builtin_amdgcn_readfirstlane((unsigned)u), hi = __builtin_amdgcn_readfirstlane((unsigned)(u >> 32));
        return (const char*)(((unsigned long long)hi << 32) | lo); }
    else return p;
}
typedef int pg8_i32x4 __attribute__((ext_vector_type(4)));
typedef int pg8_i32x8 __attribute__((ext_vector_type(8)));
template <class Epi, class Sched, bool ALIGN_EPI = false, bool SP2 = false, int MODE = 0, bool LATE_STAGE = false>
__device__ __forceinline__ void gemm_phase(PG8_LAS unsigned char* lds, const Gemm g, const Sched& S, const Epi& E) {
    const int tid = threadIdx.x, wid = __builtin_amdgcn_readfirstlane(tid >> 6), lane = tid & 63, wr = wid >> 2, wc = wid & 3, fr = lane & 15, fq = lane >> 4;
    const int K = g.K, nt = K / BK;
    unsigned voffA[2], voffB[2];
#pragma unroll
    for (int i = 0; i < 2; ++i) { int R, C; stage_rc(tid * 16 + i * 8192, R, C); const int Rb = Epi::PERM ? ((R & ~31) + perm32(R & 31)) : R;
        voffA[i] = (unsigned)(R * K + C) * 2u; voffB[i] = (unsigned)(Rb * K + C) * 2u; }
    const size_t kstep = (size_t)(BK * 2);
    const size_t hstep = (size_t)HALF * K * 2;
    const size_t tstep = 2 * hstep;
    const unsigned ldsw = (unsigned)wid * 1024u;
    const int aoff = lds_byte(wr * 64 + fr, fq * 8), boff = lds_byte(wc * 32 + fr, fq * 8);
#define PG8_SA(b, h) (((b) * 2 + (h)) * HTB)
#define PG8_SB(b, h) ((4 + (b) * 2 + (h)) * HTB)
#define PG8_STAGE(bufoff, gbase, voff) do { _Pragma("unroll") for (int _i = 0; _i < 2; ++_i) \
        __builtin_amdgcn_global_load_lds((const unsigned*)(pg8_uni<(MODE != 0)>((const char*)(gbase)) + (voff)[_i]), (PG8_LAS unsigned*)(lds + (bufoff) + ldsw + _i * 8192), 16, 0, 0); } while (0)
#define PG8_LDA(dst, b, h) do { _Pragma("unroll") for (int m = 0; m < 4; ++m) _Pragma("unroll") for (int k = 0; k < 2; ++k) dst[m][k] = *(const PG8_LAS bf16x8*)(lds + PG8_SA(b, h) + aoff + m * 2048 + k * 1024); } while (0)
#define PG8_LDB(dst, b, h) do { _Pragma("unroll") for (int n = 0; n < 2; ++n) _Pragma("unroll") for (int k = 0; k < 2; ++k) dst[n][k] = *(const PG8_LAS bf16x8*)(lds + PG8_SB(b, h) + boff + n * 2048 + k * 1024); } while (0)
#define PG8_MMA(ai, bj, At, Bt) do { __builtin_amdgcn_s_setprio(1); \
        if constexpr (MODE == 1) { _Pragma("unroll") for (int m = 0; m < 4; ++m) _Pragma("unroll") for (int n = 0; n < 2; ++n) { \
            const pg8_i32x8 b8_ = __builtin_shufflevector(__builtin_bit_cast(pg8_i32x4, Bt[n][0]), __builtin_bit_cast(pg8_i32x4, Bt[n][1]), 0, 1, 2, 3, 4, 5, 6, 7); \
            const pg8_i32x8 a8_ = __builtin_shufflevector(__builtin_bit_cast(pg8_i32x4, At[m][0]), __builtin_bit_cast(pg8_i32x4, At[m][1]), 0, 1, 2, 3, 4, 5, 6, 7); \
            acc[ai][bj][m][n] = __builtin_amdgcn_mfma_scale_f32_16x16x128_f8f6f4(b8_, a8_, acc[ai][bj][m][n], 0, 0, 0, 0x7f7f7f7f, 0, 0x7f7f7f7f); } } \
        else if constexpr (MODE == 2) { _Pragma("unroll") for (int m = 0; m < 4; ++m) _Pragma("unroll") for (int n = 0; n < 2; ++n) _Pragma("unroll") for (int k = 0; k < 2; ++k) \
            acc[ai][bj][m][n] = __builtin_bit_cast(f32x4, __builtin_amdgcn_mfma_i32_16x16x64_i8(__builtin_bit_cast(pg8_i32x4, Bt[n][k]), __builtin_bit_cast(pg8_i32x4, At[m][k]), __builtin_bit_cast(pg8_i32x4, acc[ai][bj][m][n]), 0, 0, 0)); } \
        else { _Pragma("unroll") for (int m = 0; m < 4; ++m) _Pragma("unroll") for (int n = 0; n < 2; ++n) _Pragma("unroll") for (int k = 0; k < 2; ++k) \
            acc[ai][bj][m][n] = __builtin_amdgcn_mfma_f32_16x16x32_bf16(Bt[n][k], At[m][k], acc[ai][bj][m][n], 0, 0, 0); } \
        __builtin_amdgcn_s_setprio(0); } while (0)
#define PG8_WAIT_V(n) asm volatile("s_waitcnt vmcnt(" #n ")" ::: "memory")
#define PG8_WAIT_L(n) asm volatile("s_waitcnt lgkmcnt(" #n ")" ::: "memory")
#define PG8_BAR __builtin_amdgcn_s_barrier()
#define PG8_SCHED __builtin_amdgcn_sched_barrier(0)
    Unit cur, nxt; int ui = 0;
    if (!S.next(0, cur)) return;
    f32x4 acc[2][2][4][2];
#pragma unroll
    for (int a = 0; a < 2; ++a)
#pragma unroll
        for (int b = 0; b < 2; ++b)
#pragma unroll
            for (int m = 0; m < 4; ++m)
#pragma unroll
                for (int n = 0; n < 2; ++n) acc[a][b][m][n] = (f32x4){0.f, 0.f, 0.f, 0.f};
    bf16x8 At[4][2], B0[2][2], B1[2][2];
    const char* cA = (const char*)g.A + (size_t)cur.pm * tstep; const char* cB = (const char*)g.Bt + (size_t)cur.pn * tstep;
    S.a_ready(cur);
    if constexpr (SP2) {
        PG8_STAGE(PG8_SB(0, 0), cB, voffB); PG8_STAGE(PG8_SB(0, 1), cB + hstep, voffB); PG8_STAGE(PG8_SA(0, 0), cA, voffA); PG8_STAGE(PG8_SA(0, 1), cA + hstep, voffA);
        if (wr == 1) PG8_BAR;
        PG8_WAIT_V(2); PG8_BAR;
        PG8_STAGE(PG8_SB(1, 0), cB + kstep, voffB); PG8_STAGE(PG8_SA(1, 0), cA + kstep, voffA); PG8_STAGE(PG8_SB(1, 1), cB + hstep + kstep, voffB);
        PG8_WAIT_V(6); PG8_BAR;
    } else {
        PG8_STAGE(PG8_SB(0, 0), cB, voffB); PG8_STAGE(PG8_SA(0, 0), cA, voffA); PG8_STAGE(PG8_SB(0, 1), cB + hstep, voffB); PG8_STAGE(PG8_SA(0, 1), cA + hstep, voffA);
        if (wr == 1) PG8_BAR;
        PG8_WAIT_V(4); PG8_BAR;
        PG8_STAGE(PG8_SB(1, 0), cB + kstep, voffB); PG8_STAGE(PG8_SA(1, 0), cA + kstep, voffA); PG8_STAGE(PG8_SB(1, 1), cB + hstep + kstep, voffB);
        PG8_WAIT_V(6); PG8_BAR;
    }
    for (;;) {
        const bool has_next = S.next(ui + 1, nxt);
        const char* nA = has_next ? (const char*)g.A + (size_t)nxt.pm * tstep : cA; const char* nB = has_next ? (const char*)g.Bt + (size_t)nxt.pn * tstep : cB;
        for (int t = 0; t < nt; t += 2) {
            const bool last = (t == nt - 2);
            const char* a1 = cA + (size_t)(t + 1) * kstep;
            const char* a2 = last ? nA : cA + (size_t)(t + 2) * kstep; const char* b2 = last ? nB : cB + (size_t)(t + 2) * kstep;
            const char* a3 = a2 + kstep; const char* b3 = b2 + kstep;
            if (last && has_next) S.a_ready(nxt);
            if constexpr (SP2) {
            if constexpr (LATE_STAGE) {
            PG8_LDB(B0, 0, 0); PG8_LDB(B1, 0, 1); PG8_SCHED; PG8_LDA(At, 0, 0);
            PG8_WAIT_V(6); PG8_WAIT_L(0); PG8_BAR; PG8_STAGE(PG8_SA(1, 1), a1 + hstep, voffA); PG8_MMA(0, 0, At, B0); PG8_MMA(0, 1, At, B1); PG8_BAR; PG8_SCHED;
            PG8_LDA(At, 0, 1);
            PG8_WAIT_V(2); PG8_WAIT_L(0); PG8_BAR; PG8_STAGE(PG8_SB(0, 0), b2, voffB); PG8_MMA(1, 0, At, B0); PG8_STAGE(PG8_SB(0, 1), b2 + hstep, voffB); PG8_STAGE(PG8_SA(0, 0), a2, voffA); PG8_MMA(1, 1, At, B1); PG8_BAR; PG8_SCHED;
            PG8_LDB(B0, 1, 0); PG8_LDB(B1, 1, 1); PG8_SCHED; PG8_LDA(At, 1, 0);
            PG8_WAIT_V(6); PG8_WAIT_L(0); PG8_BAR; PG8_STAGE(PG8_SA(0, 1), a2 + hstep, voffA); PG8_MMA(0, 0, At, B0); PG8_MMA(0, 1, At, B1); PG8_BAR; PG8_SCHED;
            PG8_LDA(At, 1, 1);
            PG8_WAIT_V(2); PG8_WAIT_L(0); PG8_BAR; PG8_STAGE(PG8_SB(1, 0), b3, voffB); PG8_MMA(1, 0, At, B0); PG8_STAGE(PG8_SB(1, 1), b3 + hstep, voffB); PG8_STAGE(PG8_SA(1, 0), a3, voffA); PG8_MMA(1, 1, At, B1); PG8_BAR; PG8_SCHED;
            } else {
            PG8_LDB(B0, 0, 0); PG8_LDB(B1, 0, 1); PG8_SCHED; PG8_LDA(At, 0, 0); PG8_STAGE(PG8_SA(1, 1), a1 + hstep, voffA);
            PG8_WAIT_V(8); PG8_WAIT_L(0); PG8_BAR; PG8_MMA(0, 0, At, B0); PG8_MMA(0, 1, At, B1); PG8_BAR; PG8_SCHED;
            PG8_LDA(At, 0, 1); PG8_STAGE(PG8_SB(0, 0), b2, voffB); PG8_STAGE(PG8_SB(0, 1), b2 + hstep, voffB); PG8_STAGE(PG8_SA(0, 0), a2, voffA);
            PG8_WAIT_V(8); PG8_WAIT_L(0); PG8_BAR; PG8_MMA(1, 0, At, B0); PG8_MMA(1, 1, At, B1); PG8_BAR; PG8_SCHED;
            PG8_LDB(B0, 1, 0); PG8_LDB(B1, 1, 1); PG8_SCHED; PG8_LDA(At, 1, 0); PG8_STAGE(PG8_SA(0, 1), a2 + hstep, voffA);
            PG8_WAIT_V(8); PG8_WAIT_L(0); PG8_BAR; PG8_MMA(0, 0, At, B0); PG8_MMA(0, 1, At, B1); PG8_BAR; PG8_SCHED;
            PG8_LDA(At, 1, 1); PG8_STAGE(PG8_SB(1, 0), b3, voffB); PG8_STAGE(PG8_SB(1, 1), b3 + hstep, voffB); PG8_STAGE(PG8_SA(1, 0), a3, voffA);
            PG8_WAIT_V(8); PG8_WAIT_L(0); PG8_BAR; PG8_MMA(1, 0, At, B0); PG8_MMA(1, 1, At, B1); PG8_BAR; PG8_SCHED;
            }
            } else {
            PG8_LDB(B0, 0, 0); PG8_SCHED; PG8_LDA(At, 0, 0); PG8_STAGE(PG8_SA(1, 1), a1 + hstep, voffA);
            PG8_WAIT_L(8); PG8_BAR; PG8_WAIT_L(0); PG8_MMA(0, 0, At, B0); PG8_BAR; PG8_SCHED;
            PG8_LDB(B1, 0, 1); PG8_STAGE(PG8_SB(0, 0), b2, voffB);
            PG8_BAR; PG8_WAIT_L(0); PG8_MMA(0, 1, At, B1); PG8_BAR;
            PG8_LDA(At, 0, 1); PG8_STAGE(PG8_SA(0, 0), a2, voffA);
            PG8_BAR; PG8_WAIT_L(0); PG8_MMA(1, 0, At, B0); PG8_BAR; PG8_SCHED;
            PG8_STAGE(PG8_SB(0, 1), b2 + hstep, voffB);
            PG8_WAIT_V(6); PG8_BAR; PG8_MMA(1, 1, At, B1); PG8_BAR;
            PG8_LDB(B0, 1, 0); PG8_SCHED; PG8_LDA(At, 1, 0); PG8_STAGE(PG8_SA(0, 1), a2 + hstep, voffA);
            PG8_WAIT_L(8); PG8_BAR; PG8_WAIT_L(0); PG8_MMA(0, 0, At, B0); PG8_BAR; PG8_SCHED;
            PG8_LDB(B1, 1, 1); PG8_STAGE(PG8_SB(1, 0), b3, voffB);
            PG8_BAR; PG8_WAIT_L(0); PG8_MMA(0, 1, At, B1); PG8_BAR;
            PG8_LDA(At, 1, 1); PG8_STAGE(PG8_SA(1, 0), a3, voffA);
            PG8_BAR; PG8_WAIT_L(0); PG8_MMA(1, 0, At, B0); PG8_BAR; PG8_SCHED;
            PG8_STAGE(PG8_SB(1, 1), b3 + hstep, voffB);
            PG8_WAIT_V(6); PG8_BAR; PG8_MMA(1, 1, At, B1); PG8_BAR;
            }
        }
        if constexpr (ALIGN_EPI) { if (wr == 0) PG8_BAR; }
        if constexpr (!Epi::AFTER_DRAIN) { E(acc, cur, wr, wc, fr, fq); S.done(cur); }
        if (!has_next) break;
#pragma unroll
        for (int a = 0; a < 2; ++a)
#pragma unroll
            for (int b = 0; b < 2; ++b)
#pragma unroll
                for (int m = 0; m < 4; ++m)
#pragma unroll
                    for (int n = 0; n < 2; ++n) acc[a][b][m][n] = (f32x4){0.f, 0.f, 0.f, 0.f};
        cur = nxt; cA = nA; cB = nB; ++ui;
        if constexpr (ALIGN_EPI) { if (wr == 1) PG8_BAR; }
    }
    PG8_WAIT_V(0);
    if constexpr (!ALIGN_EPI) { if (wr == 0) PG8_BAR; }
    PG8_BAR;
    if constexpr (Epi::AFTER_DRAIN) { E.fused(acc, cur, wr, wc, fr, fq, lds, wid, lane); S.done(cur); }
#undef PG8_SA
#undef PG8_SB
#undef PG8_STAGE
#undef PG8_LDA
#undef PG8_LDB
#undef PG8_MMA
#undef PG8_WAIT_V
#undef PG8_WAIT_L
#undef PG8_BAR
#undef PG8_SCHED
}
}
#ifndef GEMM2_I8
#define GEMM2_I8 1
#endif
#ifndef GEMM2_RES
#define GEMM2_RES 1
#endif
#ifndef GEMM2_HAD
#define GEMM2_HAD 1
#endif
#ifndef GEMM1_I8
#define GEMM1_I8 1
#endif
#ifndef GEMM3_I8
#define GEMM3_I8 1
#endif
#ifndef GEMM3_FP8
#define GEMM3_FP8 1
#endif

#ifndef PROBE_STAMP
#define PROBE_STAMP -1
#define PROBE_DIV 5.0f
#endif
constexpr int NWAVES = 8;
#ifndef MK_N_LAUNCHES
#define MK_N_LAUNCHES 1
#endif
constexpr int N_PHASES = 12;
constexpr int N_LAUNCHES = MK_N_LAUNCHES;

constexpr int BATCH = 4, SEQ = 4096, D = 2048, M = BATCH * SEQ;
constexpr int LRU_W = 1024, LRU_HEADS = 8, LRU_BLK = 128;
constexpr int HD = 64, HQ = 16, HKV = 2, GRP = 8;
constexpr int MIX_IN = 3328;
constexpr int C_Y = 1024, C_Q = 2048, C_K = 3072, C_V = 3200;
constexpr int ADA_W = 6 * D;
constexpr int PH = 8, PKEYS = 128, PHALF = 128, PTOPK = 16, NEXP = 16384;
constexpr float EPS = 1e-6f;

constexpr size_t MiB = 1u << 20;
constexpr size_t WS_CTL = 0, CTL_ZERO_BYTES = 64 * 1024;
constexpr size_t WS_ADA = 1 * MiB;
constexpr size_t WS_ROPE = 2 * MiB;
constexpr size_t WS_WIN = 4 * MiB;
constexpr size_t WS_WOUT = 17 * MiB;
constexpr size_t WS_WQ = 25 * MiB;
constexpr size_t WS_WGA = 33 * MiB;
constexpr size_t WS_WGX = 33 * MiB + 256 * 1024;
constexpr size_t WS_SK = 33 * MiB + 512 * 1024;
constexpr size_t WS_IDX = 34 * MiB;
constexpr size_t WS_GW = 42 * MiB;
constexpr size_t WS_U = 50 * MiB;
constexpr size_t WS_V = 82 * MiB;
constexpr size_t WS_USC = 1 * MiB + 512 * 1024;
constexpr size_t WS_VSC = 1 * MiB + 768 * 1024;
constexpr size_t WS_X1B = 114 * MiB;
constexpr size_t WS_XH = 178 * MiB;
constexpr size_t WS_PROJ = 242 * MiB;
constexpr size_t WS_HL = 346 * MiB;
constexpr size_t WS_PA = 410 * MiB;
constexpr size_t WS_PART = WS_HL;
constexpr size_t WS_W = WS_PROJ + 64 * MiB;
constexpr size_t WS_WSC = WS_PROJ + 68 * MiB;
constexpr size_t WS_H8 = WS_PROJ + 72 * MiB;
constexpr size_t WS_RS1 = 1 * MiB + 256 * 1024;
constexpr size_t WS_RS2 = 1 * MiB + 320 * 1024;
constexpr size_t WS_RS3 = 1 * MiB + 384 * 1024;
constexpr size_t WS_CSIN = 1 * MiB + 448 * 1024;
constexpr size_t WS_CSOUT = 1 * MiB + 464 * 1024;
constexpr size_t WS_CSQ = 1 * MiB + 472 * 1024;
constexpr size_t WS_A8 = WS_XH;
constexpr size_t WS_MIX8 = 474 * MiB;
constexpr size_t WS_END = 506 * MiB;
constexpr int CW_BAR = 4096;

constexpr int RING_BYTES = 131072;
constexpr int LDSCTL_OFF = RING_BYTES, MISC_OFF = LDSCTL_OFF + 320;
constexpr int LDS_BYTES = 147456;

#define GAS __attribute__((address_space(1)))
#define LAS __attribute__((address_space(3)))
typedef unsigned short bf16;
typedef unsigned v4u __attribute__((ext_vector_type(4)));
typedef unsigned v2u __attribute__((ext_vector_type(2)));
typedef float f32x4 __attribute__((ext_vector_type(4)));
typedef float f32x2 __attribute__((ext_vector_type(2)));
typedef float f32x16 __attribute__((ext_vector_type(16)));
typedef short bf16x8 __attribute__((ext_vector_type(8)));
typedef __bf16 bf16x2v __attribute__((ext_vector_type(2)));
#define LDS_WAIT() asm volatile("s_waitcnt lgkmcnt(0)" ::: "memory")
#define VM_WAIT() asm volatile("s_waitcnt vmcnt(0)" ::: "memory")
__device__ __forceinline__ unsigned f2bf(float f) { unsigned u = __builtin_bit_cast(unsigned, f); return (u + 0x7fffu + ((u >> 16) & 1u)) >> 16; }
__device__ __forceinline__ unsigned pk2(float lo, float hi) { return f2bf(lo) | (f2bf(hi) << 16); }
__device__ __forceinline__ float bflo(unsigned u) { return __builtin_bit_cast(float, u << 16); }
__device__ __forceinline__ float bfhi(unsigned u) { return __builtin_bit_cast(float, u & 0xffff0000u); }
__device__ __forceinline__ float bf1(bf16 h) { return __builtin_bit_cast(float, (unsigned)h << 16); }
__device__ __forceinline__ float dot2bf(unsigned a, unsigned b, float acc) { return __builtin_amdgcn_fdot2_f32_bf16(__builtin_bit_cast(bf16x2v, a), __builtin_bit_cast(bf16x2v, b), acc, false); }
__device__ __forceinline__ float sigmoidf_(float x) { return __builtin_amdgcn_rcpf(1.0f + __expf(-x)); }
__device__ __forceinline__ float gelu_tanh(float x) {
    const float z = 1.5957691216057308f * (x + 0.044715f * x * x * x);
    return x * __builtin_amdgcn_rcpf(1.0f + __expf(-z));
}
__device__ __forceinline__ float wave_sum(float v) {
#pragma unroll
    for (int o = 1; o < 64; o <<= 1) v += __shfl_xor(v, o);
    return v;
}

#define XB_TMO      128
#define XB_XCNT(j)  (256  + 64 * (j))
#define XB_XSUB(j)  (1280 + 64 * (j))
#define XB_XGEN(j)  (2304 + 64 * (j))
#define XB_TOP      3328
#define XB_TOPGEN   3392
#define XCD_BAR_WORDS 3456
#define XB_SPIN_CAP (1u << 18)
__device__ __forceinline__ unsigned xb_ld(unsigned* p)              { return __hip_atomic_load(p, __ATOMIC_RELAXED, __HIP_MEMORY_SCOPE_AGENT); }
__device__ __forceinline__ unsigned xb_add(unsigned* p, unsigned v) { return __hip_atomic_fetch_add(p, v, __ATOMIC_RELAXED, __HIP_MEMORY_SCOPE_AGENT); }
__device__ __forceinline__ unsigned xb_xcc_id() { return (unsigned)__builtin_amdgcn_s_getreg((3 << 11) | 20) & 0xFu; }
#define XB_SPIN(cond, bar) do { unsigned _sp = 0; while (cond) { __builtin_amdgcn_s_sleep(1); \
    if ((++_sp & 255u) == 0u) { if (xb_ld(&(bar)[XB_TMO])) break; if (_sp > XB_SPIN_CAP) { atomicAdd(&(bar)[XB_TMO], 1u); break; } } } } while (0)
struct XcdBarrier { unsigned* bar; unsigned x; volatile LAS unsigned* st; };
__device__ __forceinline__ XcdBarrier xcd_barrier_post(unsigned* bar, volatile LAS unsigned* st) {
    XcdBarrier b; b.bar = bar; b.x = xb_xcc_id(); b.st = st;
    if (threadIdx.x == 0) (void)xb_add(&bar[XB_XCNT(b.x)], 1u);
    return b;
}
__device__ __forceinline__ void xcd_barrier_complete(unsigned* bar, unsigned x, unsigned& nloc, unsigned& nx) {
    const unsigned G = gridDim.x * gridDim.y * gridDim.z;
    unsigned sum, cnt, mine, sp = 0u;
    for (;;) {
        sum = 0u; cnt = 0u; mine = 0u;
#pragma unroll
        for (unsigned j = 0; j < 16; ++j) { const unsigned c = xb_ld(&bar[XB_XCNT(j)]); sum += c; cnt += (c > 0u) ? 1u : 0u; mine = (j == x) ? c : mine; }
        if (sum == G) break;
        __builtin_amdgcn_s_sleep(1);
        if ((++sp & 255u) == 0u) { if (xb_ld(&bar[XB_TMO])) break; if (sp > XB_SPIN_CAP) { atomicAdd(&bar[XB_TMO], 1u); break; } }
    }
    nloc = mine > 0u ? mine : 1u; nx = cnt > 0u ? cnt : 1u;
}
__device__ __forceinline__ void xcd_barrier(const XcdBarrier& b) {
    asm volatile("s_waitcnt vmcnt(0)" ::: "memory");
    __syncthreads();
    if (threadIdx.x == 0) {
        unsigned* bar = b.bar;
        __builtin_amdgcn_s_waitcnt(0);
        unsigned nloc = b.st[0], nx = b.st[1];
        if (nloc == 0u) { xcd_barrier_complete(bar, b.x, nloc, nx); b.st[0] = nloc; b.st[1] = nx; }
        const unsigned old = xb_add(&bar[XB_XSUB(b.x)], 1u);
        const unsigned gen = old / nloc;
        if (old + 1u == (gen + 1u) * nloc) {
            __builtin_amdgcn_fence(__ATOMIC_RELEASE, "agent");
            asm volatile("s_waitcnt vmcnt(0)" ::: "memory");
            const unsigned og = xb_add(&bar[XB_TOP], 1u);
            const unsigned tg = og / nx;
            if (og + 1u == (tg + 1u) * nx) xb_add(&bar[XB_TOPGEN], 1u);
            else XB_SPIN(xb_ld(&bar[XB_TOPGEN]) == tg, bar);
            __builtin_amdgcn_fence(__ATOMIC_ACQUIRE, "agent");
            xb_add(&bar[XB_XGEN(b.x)], 1u);
            asm volatile("s_waitcnt vmcnt(0)" ::: "memory");
        } else {
            XB_SPIN(xb_ld(&bar[XB_XGEN(b.x)]) == gen, bar);
            __builtin_amdgcn_fence(__ATOMIC_ACQUIRE, "agent");
            asm volatile("s_waitcnt vmcnt(0)" ::: "memory");
        }
    }
    __syncthreads();
}

typedef const __attribute__((address_space(4))) unsigned char* kaptr_t;
struct Frame { LAS unsigned char* lds; int tid, lane, wave, G, bid; kaptr_t ka; };
template <class T> __device__ __forceinline__ T* ka_ptr(const Frame& F, int byte_off) { typedef T* tp; return *(const __attribute__((address_space(4))) tp*)(F.ka + byte_off); }
__device__ __forceinline__ const float* P_x(const Frame& F) { return ka_ptr<const float>(F, 0); }
__device__ __forceinline__ const float* P_c(const Frame& F) { return ka_ptr<const float>(F, 8); }
__device__ __forceinline__ const int* P_pos(const Frame& F) { return ka_ptr<const int>(F, 16); }
__device__ __forceinline__ const float* P_w_ada(const Frame& F) { return ka_ptr<const float>(F, 24); }
__device__ __forceinline__ const float* P_b_ada(const Frame& F) { return ka_ptr<const float>(F, 32); }
__device__ __forceinline__ const float* P_norm1_g(const Frame& F) { return ka_ptr<const float>(F, 40); }
__device__ __forceinline__ const float* P_w_in(const Frame& F) { return ka_ptr<const float>(F, 48); }
__device__ __forceinline__ const float* P_conv_w(const Frame& F) { return ka_ptr<const float>(F, 56); }
__device__ __forceinline__ const float* P_conv_b(const Frame& F) { return ka_ptr<const float>(F, 64); }
__device__ __forceinline__ const float* P_ga_w(const Frame& F) { return ka_ptr<const float>(F, 72); }
__device__ __forceinline__ const float* P_ga_b(const Frame& F) { return ka_ptr<const float>(F, 80); }
__device__ __forceinline__ const float* P_gx_w(const Frame& F) { return ka_ptr<const float>(F, 88); }
__device__ __forceinline__ const float* P_gx_b(const Frame& F) { return ka_ptr<const float>(F, 96); }
__device__ __forceinline__ const float* P_lam(const Frame& F) { return ka_ptr<const float>(F, 104); }
__device__ __forceinline__ const float* P_qn_g(const Frame& F) { return ka_ptr<const float>(F, 112); }
__device__ __forceinline__ const float* P_kn_g(const Frame& F) { return ka_ptr<const float>(F, 120); }
__device__ __forceinline__ const float* P_sinks(const Frame& F) { return ka_ptr<const float>(F, 128); }
__device__ __forceinline__ const float* P_on_lru_g(const Frame& F) { return ka_ptr<const float>(F, 136); }
__device__ __forceinline__ const float* P_on_attn_g(const Frame& F) { return ka_ptr<const float>(F, 144); }
__device__ __forceinline__ const float* P_w_out(const Frame& F) { return ka_ptr<const float>(F, 152); }
__device__ __forceinline__ const float* P_norm2_g(const Frame& F) { return ka_ptr<const float>(F, 160); }
__device__ __forceinline__ const float* P_w_pq(const Frame& F) { return ka_ptr<const float>(F, 168); }
__device__ __forceinline__ const float* P_sub_keys(const Frame& F) { return ka_ptr<const float>(F, 176); }
__device__ __forceinline__ const float* P_pu(const Frame& F) { return ka_ptr<const float>(F, 184); }
__device__ __forceinline__ const float* P_pv(const Frame& F) { return ka_ptr<const float>(F, 192); }
__device__ __forceinline__ float* P_out(const Frame& F) { return ka_ptr<float>(F, 200); }
__device__ __forceinline__ unsigned char* P_ws(const Frame& F) { return ka_ptr<unsigned char>(F, 208); }
__device__ __forceinline__ float* P_ADA(const Frame& F) { return (float*)(P_ws(F) + WS_ADA); }
__device__ __forceinline__ float* P_ROPE(const Frame& F) { return (float*)(P_ws(F) + WS_ROPE); }
__device__ __forceinline__ bf16* P_HL(const Frame& F) { return (bf16*)(P_ws(F) + WS_HL); }
__device__ __forceinline__ bf16* P_PA(const Frame& F) { return (bf16*)(P_ws(F) + WS_PA); }
__device__ __forceinline__ float* P_GW(const Frame& F) { return (float*)(P_ws(F) + WS_GW); }
__device__ __forceinline__ unsigned short* P_IDX(const Frame& F) { return (unsigned short*)(P_ws(F) + WS_IDX); }
__device__ __forceinline__ bf16* P_WIN(const Frame& F) { return (bf16*)(P_ws(F) + WS_WIN); }
__device__ __forceinline__ bf16* P_WOUT(const Frame& F) { return (bf16*)(P_ws(F) + WS_WOUT); }
__device__ __forceinline__ bf16* P_WQ(const Frame& F) { return (bf16*)(P_ws(F) + WS_WQ); }
__device__ __forceinline__ bf16* P_WGA(const Frame& F) { return (bf16*)(P_ws(F) + WS_WGA); }
__device__ __forceinline__ bf16* P_WGX(const Frame& F) { return (bf16*)(P_ws(F) + WS_WGX); }
__device__ __forceinline__ bf16* P_SK(const Frame& F) { return (bf16*)(P_ws(F) + WS_SK); }
__device__ __forceinline__ unsigned char* P_U(const Frame& F) { return (unsigned char*)(P_ws(F) + WS_U); }
__device__ __forceinline__ bf16* P_X1B(const Frame& F) { return (bf16*)(P_ws(F) + WS_X1B); }
__device__ __forceinline__ unsigned char* P_H8(const Frame& F) { return (unsigned char*)(P_ws(F) + WS_H8); }
__device__ __forceinline__ unsigned char* P_A8(const Frame& F) { return (unsigned char*)(P_ws(F) + WS_A8); }
__device__ __forceinline__ unsigned char* P_MIX8(const Frame& F) { return (unsigned char*)(P_ws(F) + WS_MIX8); }
__device__ __forceinline__ float* P_RS(const Frame& F, int k) { return (float*)(P_ws(F) + WS_RS1 + (size_t)k * 65536); }
__device__ __forceinline__ float* P_CSIN(const Frame& F) { return (float*)(P_ws(F) + WS_CSIN); }
__device__ __forceinline__ float* P_CSOUT(const Frame& F) { return (float*)(P_ws(F) + WS_CSOUT); }
__device__ __forceinline__ float* P_CSQ(const Frame& F) { return (float*)(P_ws(F) + WS_CSQ); }
__device__ __forceinline__ unsigned* P_PART(const Frame& F) { return (unsigned*)(P_ws(F) + WS_PART); }
__device__ __forceinline__ unsigned char* P_W(const Frame& F) { return (unsigned char*)(P_ws(F) + WS_W); }
__device__ __forceinline__ float* P_WSC(const Frame& F) { return (float*)(P_ws(F) + WS_WSC); }
__device__ __forceinline__ float* P_USC(const Frame& F) { return (float*)(P_ws(F) + WS_USC); }
__device__ __forceinline__ float* P_VSC(const Frame& F) { return (float*)(P_ws(F) + WS_VSC); }
__device__ __forceinline__ unsigned char* P_V(const Frame& F) { return (unsigned char*)(P_ws(F) + WS_V); }
__device__ __forceinline__ bf16* P_XH(const Frame& F) { return (bf16*)(P_ws(F) + WS_XH); }
__device__ __forceinline__ bf16* P_PROJ(const Frame& F) { return (bf16*)(P_ws(F) + WS_PROJ); }

__device__ __forceinline__ void p0_transpose_item(const float* W, int K, int N, bf16* WT, LAS float* scr, int item, int lane) {
    const int nblk = N / 32, kb = item / nblk, nb = item % nblk, k0 = 64 * kb, n0 = 32 * nb;
#pragma unroll 8
    for (int i = 0; i < 32; ++i) { const int kk = 2 * i + (lane >> 5); scr[kk * 33 + (lane & 31)] = __builtin_nontemporal_load(W + (size_t)(k0 + kk) * N + n0 + (lane & 31)); }
    LDS_WAIT(); asm volatile("" ::: "memory");
    const int c = lane & 7;
#pragma unroll
    for (int j = 0; j < 4; ++j) { const int n = (lane >> 3) + 8 * j; const LAS float* s = scr + (8 * c) * 33 + n;
        v4u o; o.x = pk2(s[0 * 33], s[1 * 33]); o.y = pk2(s[2 * 33], s[3 * 33]); o.z = pk2(s[4 * 33], s[5 * 33]); o.w = pk2(s[6 * 33], s[7 * 33]);
        *(v4u*)(WT + (size_t)(n0 + n) * K + k0 + 8 * c) = o; }
    LDS_WAIT(); asm volatile("" ::: "memory");
}
constexpr float WQ_SCALE = 64.0f;
__device__ __forceinline__ void p0_transpose_item_fp8(const float* W, int K, int N, unsigned char* WT, LAS float* scr, int item, int lane, float scale) {
    const int nblk = N / 32, kb = item / nblk, nb = item % nblk, k0 = 64 * kb, n0 = 32 * nb;
#pragma unroll 8
    for (int i = 0; i < 32; ++i) { const int kk = 2 * i + (lane >> 5); scr[kk * 33 + (lane & 31)] = __builtin_nontemporal_load(W + (size_t)(k0 + kk) * N + n0 + (lane & 31)); }
    LDS_WAIT(); asm volatile("" ::: "memory");
    const int c = lane & 7;
#pragma unroll
    for (int j = 0; j < 4; ++j) { const int n = (lane >> 3) + 8 * j; const LAS float* s = scr + (8 * c) * 33 + n;
        int t0 = __builtin_amdgcn_cvt_pk_fp8_f32(s[0 * 33] * scale, s[1 * 33] * scale, 0, false); t0 = __builtin_amdgcn_cvt_pk_fp8_f32(s[2 * 33] * scale, s[3 * 33] * scale, t0, true);
        int t1 = __builtin_amdgcn_cvt_pk_fp8_f32(s[4 * 33] * scale, s[5 * 33] * scale, 0, false); t1 = __builtin_amdgcn_cvt_pk_fp8_f32(s[6 * 33] * scale, s[7 * 33] * scale, t1, true);
        *(v2u*)(WT + (size_t)(n0 + n) * K + k0 + 8 * c) = (v2u){(unsigned)t0, (unsigned)t1}; }
    LDS_WAIT(); asm volatile("" ::: "memory");
}
__device__ __forceinline__ void p0_convert(const float* src, bf16* dst, size_t n8, size_t gtid, size_t gthreads) {
    for (size_t i = gtid; i < n8; i += gthreads) {
        const f32x4 a = *(const f32x4*)(src + 8 * i), b = *(const f32x4*)(src + 8 * i + 4);
        v4u o; o.x = pk2(a.x, a.y); o.y = pk2(a.z, a.w); o.z = pk2(b.x, b.y); o.w = pk2(b.z, b.w);
        *(v4u*)(dst + 8 * i) = o;
    }
}
constexpr float FP4_TOP = 6.0f;
#ifndef QUANT_IN_P2
#define QUANT_IN_P2 1
#endif
#ifndef QUANT_SPLIT
#define QUANT_SPLIT 13312
#endif
__device__ __forceinline__ void quant_rows(Frame& F, int r0, int r1, int w, int nw) {
    for (int rb = r0 + 2 * w; rb < r1; rb += 2 * nw) {
        f32x4 v[2][8]; float mx[2] = {0.f, 0.f};
#pragma unroll
        for (int q = 0; q < 2; ++q) { const int rr = (rb + q < r1) ? rb + q : rb; const int tbl = rr >= NEXP, row = rr - tbl * NEXP;
            const float* srcp = (tbl ? P_pv(F) : P_pu(F)) + (size_t)row * D;
#pragma unroll
            for (int j = 0; j < 8; ++j) v[q][j] = __builtin_nontemporal_load((const f32x4*)(srcp + 4 * F.lane + 256 * j)); }
#pragma unroll
        for (int q = 0; q < 2; ++q)
#pragma unroll
            for (int j = 0; j < 8; ++j) mx[q] = fmaxf(fmaxf(mx[q], fmaxf(fabsf(v[q][j].x), fabsf(v[q][j].y))), fmaxf(fabsf(v[q][j].z), fabsf(v[q][j].w)));
#pragma unroll
        for (int o = 1; o < 64; o <<= 1) { mx[0] = fmaxf(mx[0], __shfl_xor(mx[0], o)); mx[1] = fmaxf(mx[1], __shfl_xor(mx[1], o)); }
#pragma unroll
        for (int q = 0; q < 2; ++q) { const int rr = rb + q; if (rr >= r1) break; const int tbl = rr >= NEXP, row = rr - tbl * NEXP;
            const float s = fmaxf(mx[q], 1e-30f) * (1.0f / FP4_TOP), inv = 1.0f / s;
            unsigned char* d4 = (tbl ? P_V(F) : P_U(F)) + (size_t)row * 128 + 2 * F.lane;
#pragma unroll
            for (int j = 0; j < 8; ++j) { unsigned t = __builtin_amdgcn_cvt_scalef32_pk_fp4_f32(0u, v[q][j].x * inv, v[q][j].y * inv, 1.0f, 0);
                t = __builtin_amdgcn_cvt_scalef32_pk_fp4_f32(t, v[q][j].z * inv, v[q][j].w * inv, 1.0f, 1);
                *(unsigned short*)(d4 + (size_t)j * (NEXP * 128)) = (unsigned short)t; }
            if (F.lane == 0) (tbl ? P_VSC(F) : P_USC(F))[row] = s; }
    }
}
template <bool HAD> __device__ __forceinline__ void p0_panel_i8(Frame& F, const float* W, int N, int n0, unsigned char* WT, float* cs, float cmul) {
    LAS float* red = (LAS float*)F.lds;
    const int lane = F.lane, c = lane & 31, h = lane >> 5;
    const int k0 = HAD ? 4 * F.wave + 32 * h : F.wave * 256 + 128 * h;
    const float* src = W + (size_t)k0 * N + n0 + c;
    float v[128]; float mx = 0.f;
#pragma unroll
    for (int i = 0; i < 128; ++i) v[i] = __builtin_nontemporal_load(src + (size_t)(HAD ? (i & 3) + 64 * (i >> 2) : i) * N);
    if (HAD) {
#pragma unroll
        for (int st = 0; st < 7; ++st) { if (st == 2 || st == 3) continue;
#pragma unroll
            for (int i = 0; i < 128; ++i) if ((i & (1 << st)) == 0) { const float a_ = v[i], b_ = v[i + (1 << st)]; v[i] = a_ + b_; v[i + (1 << st)] = a_ - b_; } }
    }
#pragma unroll
    for (int i = 0; i < 128; ++i) mx = fmaxf(mx, fabsf(v[i]));
    mx = fmaxf(mx, __shfl_xor(mx, 32));
    if (h == 0) red[F.wave * 32 + c] = mx;
    __syncthreads();
    float cm = red[c];
#pragma unroll
    for (int w = 1; w < 8; ++w) cm = fmaxf(cm, red[w * 32 + c]);
    cm = fmaxf(cm, 1e-30f);
    const float inv = 127.0f / cm;
    unsigned char* dst = WT + (size_t)(n0 + c) * 2048 + k0;
#pragma unroll
    for (int j = 0; j < 8; ++j) { unsigned o[4];
#pragma unroll
        for (int q = 0; q < 4; ++q) { const int b0 = (int)__builtin_rintf(v[16 * j + 4 * q] * inv), b1 = (int)__builtin_rintf(v[16 * j + 4 * q + 1] * inv), b2 = (int)__builtin_rintf(v[16 * j + 4 * q + 2] * inv), b3 = (int)__builtin_rintf(v[16 * j + 4 * q + 3] * inv);
            o[q] = ((unsigned)b0 & 0xffu) | (((unsigned)b1 & 0xffu) << 8) | (((unsigned)b2 & 0xffu) << 16) | ((unsigned)b3 << 24); }
        if (HAD) {
#pragma unroll
            for (int q = 0; q < 4; ++q) *(unsigned*)(dst + 64 * (4 * j + q)) = o[q]; }
        else *(v4u*)(dst + 16 * j) = (v4u){o[0], o[1], o[2], o[3]}; }
    if (F.wave == 0 && h == 0) cs[n0 + c] = cm * (1.0f / 127.0f) * cmul;
    __syncthreads();
}
__device__ __forceinline__ void p0_prologue(Frame& F) {
    {
        constexpr int NPQ = (GEMM3_FP8 && GEMM3_I8) ? 64 : 0, NPO = GEMM2_I8 ? 64 : 0, NPI = GEMM1_I8 ? 104 : 0, NPAN = NPQ + NPO + NPI;
        for (int q = 0; q < 2; ++q) {
            int p = -1;
            if (F.bid >= 192) p = 2 * (F.bid - 192) + q; else if (q == 0) p = 128 + F.bid;
            if (p < 0 || p >= NPAN) continue;
            if (p < NPQ) { p0_panel_i8<false>(F, P_w_pq(F), D, 32 * p, (unsigned char*)P_WQ(F), P_CSQ(F), 1.0f); continue; } p -= NPQ;
            if (p < NPO) { p0_panel_i8<(GEMM2_HAD != 0)>(F, P_w_out(F), D, 32 * p, (unsigned char*)P_WOUT(F), P_CSOUT(F), GEMM2_HAD ? 1.0f / 32.0f : 1.0f); continue; } p -= NPO;
            p0_panel_i8<false>(F, P_w_in(F), MIX_IN, 32 * p, (unsigned char*)P_WIN(F), P_CSIN(F), 1.0f);
        }
    }
    {
        LAS float* sc = (LAS float*)F.lds;
        LAS float* red = sc + 4 * D;
        for (int i = F.tid; i < 4 * D; i += 512) { const float v = P_c(F)[i]; sc[i] = v / (1.0f + __expf(-v)); }
        __syncthreads();
        for (int cg = F.bid; cg < ADA_W / 64; cg += F.G) {
            const int n0 = cg * 64, k0 = F.wave * 256;
            const float* wp = P_w_ada(F) + (size_t)k0 * ADA_W + n0 + F.lane;
            float a0 = 0.f, a1 = 0.f, a2 = 0.f, a3 = 0.f;
            for (int kb = 0; kb < 256; kb += 64) { float wv[64];
#pragma unroll
                for (int k = 0; k < 64; ++k) wv[k] = __builtin_nontemporal_load(wp + (size_t)(kb + k) * ADA_W);
#pragma unroll
                for (int k = 0; k < 64; ++k) { const float w = wv[k]; const int kk = k0 + kb + k;
                    a0 += sc[kk] * w; a1 += sc[D + kk] * w; a2 += sc[2 * D + kk] * w; a3 += sc[3 * D + kk] * w; } }
            red[(F.wave * 4 + 0) * 64 + F.lane] = a0; red[(F.wave * 4 + 1) * 64 + F.lane] = a1;
            red[(F.wave * 4 + 2) * 64 + F.lane] = a2; red[(F.wave * 4 + 3) * 64 + F.lane] = a3;
            __syncthreads();
            if (F.tid < 256) { const int b = F.tid >> 6, l = F.tid & 63; float s = 0.f;
#pragma unroll
                for (int w = 0; w < 8; ++w) s += red[(w * 4 + b) * 64 + l];
                P_ADA(F)[(size_t)b * ADA_W + n0 + l] = s + P_b_ada(F)[n0 + l]; }
            __syncthreads();
        }
        __syncthreads();
    }
    if (PROBE_STAMP >= 0 && F.bid == 0 && F.tid == 0) ((unsigned long long*)(P_ws(F) + WS_CTL + 64))[14] = __builtin_amdgcn_s_memrealtime();
    {
        LAS float* scr = (LAS float*)(F.lds + F.wave * 16384);
        const int gw = F.bid * NWAVES + F.wave, NGW = F.G * NWAVES;
        constexpr int I_IN = (D / 64) * (MIX_IN / 32), I_SQ = (D / 64) * (D / 32), I_G = (LRU_BLK / 64) * (LRU_BLK / 32);
        constexpr int NITEMS = I_IN + 2 * I_SQ + 16 * I_G;
        for (int it = gw; it < NITEMS; it += NGW) {
            int r = it;
#if GEMM1_I8
            if (r < I_IN) continue; r -= I_IN;
#else
            if (r < I_IN) { p0_transpose_item(P_w_in(F), D, MIX_IN, P_WIN(F), scr, r, F.lane); continue; } r -= I_IN;
#endif
#if GEMM2_I8
            if (r < I_SQ) continue; r -= I_SQ;
#else
            if (r < I_SQ) { p0_transpose_item(P_w_out(F), D, D, P_WOUT(F), scr, r, F.lane); continue; } r -= I_SQ;
#endif
#if GEMM3_FP8 && GEMM3_I8
            if (r < I_SQ) continue; r -= I_SQ;
#elif GEMM3_FP8
            if (r < I_SQ) { p0_transpose_item_fp8(P_w_pq(F), D, D, (unsigned char*)P_WQ(F), scr, r, F.lane, WQ_SCALE); continue; } r -= I_SQ;
#else
            if (r < I_SQ) { p0_transpose_item(P_w_pq(F), D, D, P_WQ(F), scr, r, F.lane); continue; } r -= I_SQ;
#endif
            const int g = r / I_G, ri = r % I_G, hd = g & 7;
            if (g < 8) p0_transpose_item(P_ga_w(F) + (size_t)hd * 16384, LRU_BLK, LRU_BLK, P_WGA(F) + (size_t)hd * 16384, scr, ri, F.lane);
            else       p0_transpose_item(P_gx_w(F) + (size_t)hd * 16384, LRU_BLK, LRU_BLK, P_WGX(F) + (size_t)hd * 16384, scr, ri, F.lane);
        }
    }
    {
        const size_t gtid = (size_t)F.bid * 512 + F.tid, gth = (size_t)F.G * 512;
        p0_convert(P_sub_keys(F), P_SK(F), (size_t)PH * 2 * PKEYS * PHALF / 8, gtid, gth);
    }
    quant_rows(F, 0, QUANT_SPLIT, F.bid * NWAVES + F.wave, F.G * NWAVES);
}

template <bool RESID, int R, bool I8 = false, bool BF = true> __device__ __forceinline__ void modnorm_finish(f32x4 (&v)[R][4][2], const float* gain, const float* shift, const float* scale, bf16* orow, int lane, unsigned char* o8 = nullptr, unsigned char* oi8 = nullptr, float* rsout = nullptr) {
    float s[R];
#pragma unroll
    for (int r = 0; r < R; ++r) s[r] = 0.f;
#pragma unroll
    for (int r = 0; r < R; ++r)
#pragma unroll
        for (int j = 0; j < 4; ++j)
#pragma unroll
            for (int h = 0; h < 2; ++h) { const f32x4 t = v[r][j][h]; s[r] += (t.x * t.x + t.y * t.y) + (t.z * t.z + t.w * t.w); }
#pragma unroll
    for (int o = 1; o < 64; o <<= 1) {
#pragma unroll
        for (int r = 0; r < R; ++r) s[r] += __shfl_xor(s[r], o); }
    float rstd[R];
#pragma unroll
    for (int r = 0; r < R; ++r) rstd[r] = 1.0f / sqrtf(s[r] * (1.0f / D) + EPS);
    float am[R];
#pragma unroll
    for (int r = 0; r < R; ++r) am[r] = 0.f;
#pragma unroll
    for (int j = 0; j < 4; ++j) {
        const int c = 8 * lane + 512 * j;
        f32x4 gm[2], sh[2];
#pragma unroll
        for (int h = 0; h < 2; ++h) { const f32x4 g = *(const f32x4*)(gain + c + 4 * h), sc = *(const f32x4*)(scale + c + 4 * h); sh[h] = *(const f32x4*)(shift + c + 4 * h); gm[h] = g * (sc + 1.0f); }
#pragma unroll
        for (int r = 0; r < R; ++r) { const f32x4 y0 = (v[r][j][0] * rstd[r]) * gm[0] + sh[0], y1 = (v[r][j][1] * rstd[r]) * gm[1] + sh[1];
            v[r][j][0] = y0; v[r][j][1] = y1;
            if (I8) am[r] = fmaxf(am[r], fmaxf(fmaxf(fmaxf(fabsf(y0.x), fabsf(y0.y)), fmaxf(fabsf(y0.z), fabsf(y0.w))), fmaxf(fmaxf(fabsf(y1.x), fabsf(y1.y)), fmaxf(fabsf(y1.z), fabsf(y1.w))))); }
    }
    float qs[R];
    if (I8) {
#pragma unroll
        for (int o = 1; o < 64; o <<= 1) {
#pragma unroll
            for (int r = 0; r < R; ++r) am[r] = fmaxf(am[r], __shfl_xor(am[r], o)); }
#pragma unroll
        for (int r = 0; r < R; ++r) { am[r] = fmaxf(am[r], 1e-30f); qs[r] = 127.0f / am[r]; if (lane == 0) rsout[r] = am[r] * (1.0f / 127.0f); }
    }
#pragma unroll
    for (int j = 0; j < 4; ++j) {
        const int c = 8 * lane + 512 * j;
#pragma unroll
        for (int r = 0; r < R; ++r) { const f32x4 y0 = v[r][j][0], y1 = v[r][j][1];
            if (BF) { v4u o; o.x = pk2(y0.x, y0.y); o.y = pk2(y0.z, y0.w); o.z = pk2(y1.x, y1.y); o.w = pk2(y1.z, y1.w);
                *(v4u*)(orow + (size_t)r * D + c) = o; }
            if (RESID) { int t0 = __builtin_amdgcn_cvt_pk_fp8_f32(y0.x, y0.y, 0, false); t0 = __builtin_amdgcn_cvt_pk_fp8_f32(y0.z, y0.w, t0, true);
                int t1 = __builtin_amdgcn_cvt_pk_fp8_f32(y1.x, y1.y, 0, false); t1 = __builtin_amdgcn_cvt_pk_fp8_f32(y1.z, y1.w, t1, true);
                *(v2u*)(o8 + (size_t)r * D + c) = (v2u){(unsigned)t0, (unsigned)t1}; }
            if (I8) { const f32x4 z0 = y0 * qs[r], z1 = y1 * qs[r];
                const unsigned w0 = ((unsigned)(int)__builtin_rintf(z0.x) & 0xffu) | (((unsigned)(int)__builtin_rintf(z0.y) & 0xffu) << 8) | (((unsigned)(int)__builtin_rintf(z0.z) & 0xffu) << 16) | ((unsigned)(int)__builtin_rintf(z0.w) << 24);
                const unsigned w1 = ((unsigned)(int)__builtin_rintf(z1.x) & 0xffu) | (((unsigned)(int)__builtin_rintf(z1.y) & 0xffu) << 8) | (((unsigned)(int)__builtin_rintf(z1.z) & 0xffu) << 16) | ((unsigned)(int)__builtin_rintf(z1.w) << 24);
                *(v2u*)(oi8 + (size_t)r * D + c) = (v2u){w0, w1}; } }
    }
}
template <bool RESID, int R, bool I8 = false, bool BF = true, bool XBF = false> __device__ __forceinline__ void modnorm_rows(const float* xin, const float* gain, const float* shift, const float* scale, bf16* orow, int lane, bf16* xin2 = nullptr, unsigned char* o8 = nullptr, unsigned char* oi8 = nullptr, float* rsout = nullptr) {
    f32x4 v[R][4][2];
#pragma unroll
    for (int r = 0; r < R; ++r) {
#pragma unroll
        for (int j = 0; j < 4; ++j) { const int c = 8 * lane + 512 * j;
            if (XBF) { const v4u q = __builtin_nontemporal_load((const v4u*)(xin2 + (size_t)r * D + c));
                v[r][j][0] = (f32x4){bflo(q.x), bfhi(q.x), bflo(q.y), bfhi(q.y)}; v[r][j][1] = (f32x4){bflo(q.z), bfhi(q.z), bflo(q.w), bfhi(q.w)}; continue; }
            v[r][j][0] = __builtin_nontemporal_load((const f32x4*)(xin + (size_t)r * D + c)); v[r][j][1] = __builtin_nontemporal_load((const f32x4*)(xin + (size_t)r * D + c + 4));
            if (RESID) { bf16* dp = xin2 + (size_t)r * D + c; const v4u q = *(const v4u*)dp;
                v[r][j][0] += (f32x4){bflo(q.x), bfhi(q.x), bflo(q.y), bfhi(q.y)}; v[r][j][1] += (f32x4){bflo(q.z), bfhi(q.z), bflo(q.w), bfhi(q.w)};
                v4u o; o.x = pk2(v[r][j][0].x, v[r][j][0].y); o.y = pk2(v[r][j][0].z, v[r][j][0].w); o.z = pk2(v[r][j][1].x, v[r][j][1].y); o.w = pk2(v[r][j][1].z, v[r][j][1].w); *(v4u*)dp = o; } } }
    modnorm_finish<RESID, R, I8, BF>(v, gain, shift, scale, orow, lane, o8, oi8, rsout);
}
__device__ __forceinline__ void p1_phase(Frame& F) {
    const int gw = F.bid * NWAVES + F.wave, NGW = F.G * NWAVES;
#define P1_LOAD(dst, m_) do { const float* xin_ = P_x(F) + (size_t)(m_) * D; _Pragma("unroll") for (int r = 0; r < 2; ++r) _Pragma("unroll") for (int j = 0; j < 4; ++j) { const int c = 8 * F.lane + 512 * j; \
        dst[r][j][0] = __builtin_nontemporal_load((const f32x4*)(xin_ + (size_t)r * D + c)); dst[r][j][1] = __builtin_nontemporal_load((const f32x4*)(xin_ + (size_t)r * D + c + 4)); } } while (0)
#define P1_FIN(src, m_) do { const int b_ = (m_) / SEQ; const float* ada_ = P_ADA(F) + (size_t)b_ * ADA_W; \
        modnorm_finish<false, 2, (GEMM1_I8 != 0), (GEMM1_I8 == 0)>(src, P_norm1_g(F), ada_, ada_ + D, P_XH(F) + (size_t)(m_) * D, F.lane, nullptr, P_A8(F) + (size_t)(m_) * D, P_RS(F, 0) + (m_)); } while (0)
    { f32x4 va[2][4][2], vb[2][4][2]; const int st = 2 * NGW; int m = 2 * gw;
      if (m < M) P1_LOAD(va, m);
      for (; m < M; m += 2 * st) {
          if (m + st < M) P1_LOAD(vb, m + st);
          P1_FIN(va, m);
          if (m + st >= M) break;
          if (m + 2 * st < M) P1_LOAD(va, m + 2 * st);
          P1_FIN(vb, m + st); } }
#undef P1_LOAD
#undef P1_FIN
    const float invf[8] = {1.0f, 1.9392274e-01f, 3.7606031e-02f, 7.2926646e-03f, 1.4142136e-03f, 2.7424819e-04f, 5.3182961e-05f, 1.0313386e-05f};
    for (int i = F.bid * 512 + F.tid; i < M * 8; i += F.G * 512) { const int m = i >> 3, k = i & 7;
        float f = invf[0];
#pragma unroll
        for (int q = 1; q < 8; ++q) f = (k == q) ? invf[q] : f;
        const float ang = (float)P_pos(F)[m] * f; float sn, cs; sincosf(ang, &sn, &cs);
        P_ROPE(F)[(size_t)m * 16 + k] = cs; P_ROPE(F)[(size_t)m * 16 + 8 + k] = sn; }
}
__device__ __forceinline__ void p6_phase(Frame& F) {
    const int gw = F.bid * NWAVES + F.wave, NGW = F.G * NWAVES;
    for (int m = 2 * gw; m < M; m += 2 * NGW) { const int b = m / SEQ; const float* ada = P_ADA(F) + (size_t)b * ADA_W;
        modnorm_rows<true, 2, (GEMM3_FP8 && GEMM3_I8), !GEMM3_FP8, (GEMM2_I8 && GEMM2_RES)>(P_x(F) + (size_t)m * D, P_norm2_g(F), ada + 3 * D, ada + 4 * D, P_XH(F) + (size_t)m * D, F.lane, P_X1B(F) + (size_t)m * D, P_H8(F) + (size_t)m * D, P_A8(F) + (size_t)m * D, P_RS(F, 2) + m); }
}

#define MFMA32(a, b, c) __builtin_amdgcn_mfma_f32_32x32x16_bf16((a), (b), (c), 0, 0, 0)
#define MFMA16(a, b, c) __builtin_amdgcn_mfma_f32_16x16x32_bf16((a), (b), (c), 0, 0, 0)
constexpr int KS_STRIDE = 72;
constexpr int VT_STRIDE = 264;
constexpr int ATT_KS_OFF = 0, ATT_VT_OFF = 256 * KS_STRIDE * 2;
static_assert(ATT_VT_OFF + 64 * VT_STRIDE * 2 <= RING_BYTES, "attention LDS");

__device__ __forceinline__ void attn_unit(Frame& F, int b, int g, int n) {
    LAS bf16* Ks = (LAS bf16*)(F.lds + ATT_KS_OFF);
    LAS bf16* VT = (LAS bf16*)(F.lds + ATT_VT_OFF);
    const int tid = F.tid, lane = F.lane;
    {
        const int kb = tid >> 1, hf = tid & 1; const int t = n * 128 - 128 + kb;
        float kv[32]; v4u vraw[4];
        if (t >= 0) {
            const bf16* kp = P_PROJ(F) + (size_t)(b * SEQ + t) * MIX_IN + C_K + g * HD + 32 * hf;
            const bf16* vp = P_PROJ(F) + (size_t)(b * SEQ + t) * MIX_IN + C_V + g * HD + 32 * hf;
#pragma unroll
            for (int q = 0; q < 4; ++q) { const v4u r = *(const v4u*)(kp + 8 * q); vraw[q] = *(const v4u*)(vp + 8 * q);
                kv[8 * q + 0] = bflo(r.x); kv[8 * q + 1] = bfhi(r.x); kv[8 * q + 2] = bflo(r.y); kv[8 * q + 3] = bfhi(r.y);
                kv[8 * q + 4] = bflo(r.z); kv[8 * q + 5] = bfhi(r.z); kv[8 * q + 6] = bflo(r.w); kv[8 * q + 7] = bfhi(r.w); }
        } else {
#pragma unroll
            for (int q = 0; q < 4; ++q) vraw[q] = (v4u){0u, 0u, 0u, 0u};
#pragma unroll
            for (int q = 0; q < 32; ++q) kv[q] = 0.f;
        }
        float ss = 0.f;
#pragma unroll
        for (int q = 0; q < 32; ++q) ss += kv[q] * kv[q];
        ss += __shfl_xor(ss, 1);
        const float rstd = 1.0f / sqrtf(ss * (1.0f / HD) + EPS);
#pragma unroll
        for (int q = 0; q < 32; ++q) kv[q] = kv[q] * rstd * P_kn_g(F)[32 * hf + q];
        if (hf == 0 && t >= 0) {
            const float* rp = P_ROPE(F) + (size_t)(b * SEQ + t) * 16;
#pragma unroll
            for (int i = 0; i < 8; ++i) { const float cs = rp[i], sn = rp[8 + i]; const float x1 = kv[i], x2 = kv[8 + i];
                kv[i] = x1 * cs - x2 * sn; kv[8 + i] = x2 * cs + x1 * sn; }
        }
#pragma unroll
        for (int q = 0; q < 4; ++q) { v4u o; o.x = pk2(kv[8 * q], kv[8 * q + 1]); o.y = pk2(kv[8 * q + 2], kv[8 * q + 3]); o.z = pk2(kv[8 * q + 4], kv[8 * q + 5]); o.w = pk2(kv[8 * q + 6], kv[8 * q + 7]);
            *(LAS v4u*)(Ks + kb * KS_STRIDE + 32 * hf + 8 * q) = o; }
#pragma unroll
        for (int q = 0; q < 4; ++q) { const unsigned w[4] = {vraw[q].x, vraw[q].y, vraw[q].z, vraw[q].w};
#pragma unroll
            for (int e = 0; e < 4; ++e) { const int d = 32 * hf + 8 * q + 2 * e;
                VT[d * VT_STRIDE + kb] = (bf16)(w[e] & 0xffffu); VT[(d + 1) * VT_STRIDE + kb] = (bf16)(w[e] >> 16); } }
    }
    __syncthreads();
    const int hq = g * GRP + F.wave, r = lane & 31, hh = lane >> 5;
    const float sink = P_sinks(F)[hq];
    for (int qi = 0; qi < 4; ++qi) {
        const int tq = n * 128 + 32 * qi + r;
        bf16x8 qf[4];
        {
            const bf16* qp = P_PROJ(F) + (size_t)(b * SEQ + tq) * MIX_IN + C_Q + hq * HD + 8 * hh;
            float qv[4][8]; float ss = 0.f;
#pragma unroll
            for (int ks = 0; ks < 4; ++ks) { const v4u rr = __builtin_nontemporal_load((const v4u*)(qp + 16 * ks));
                qv[ks][0] = bflo(rr.x); qv[ks][1] = bfhi(rr.x); qv[ks][2] = bflo(rr.y); qv[ks][3] = bfhi(rr.y);
                qv[ks][4] = bflo(rr.z); qv[ks][5] = bfhi(rr.z); qv[ks][6] = bflo(rr.w); qv[ks][7] = bfhi(rr.w);
#pragma unroll
                for (int j = 0; j < 8; ++j) ss += qv[ks][j] * qv[ks][j]; }
            ss += __shfl_xor(ss, 32);
            const float rstd = 1.0f / sqrtf(ss * (1.0f / HD) + EPS);
#pragma unroll
            for (int ks = 0; ks < 4; ++ks)
#pragma unroll
                for (int j = 0; j < 8; ++j) qv[ks][j] = qv[ks][j] * rstd * P_qn_g(F)[16 * ks + 8 * hh + j];
            const float* rp = P_ROPE(F) + (size_t)(b * SEQ + tq) * 16;
#pragma unroll
            for (int j = 0; j < 8; ++j) { const float mine = qv[0][j], other = __shfl_xor(mine, 32); const float cs = rp[j], sn = rp[8 + j];
                qv[0][j] = hh == 0 ? (mine * cs - other * sn) : (mine * cs + other * sn); }
#pragma unroll
            for (int ks = 0; ks < 4; ++ks) { v4u o; o.x = pk2(qv[ks][0] * 0.125f, qv[ks][1] * 0.125f); o.y = pk2(qv[ks][2] * 0.125f, qv[ks][3] * 0.125f);
                o.z = pk2(qv[ks][4] * 0.125f, qv[ks][5] * 0.125f); o.w = pk2(qv[ks][6] * 0.125f, qv[ks][7] * 0.125f); qf[ks] = __builtin_bit_cast(bf16x8, o); }
        }
        f32x16 s[5];
        __builtin_amdgcn_s_setprio(1);
#pragma unroll
        for (int kj = 0; kj < 5; ++kj) {
            f32x16 acc;
#pragma unroll
            for (int i = 0; i < 16; ++i) acc[i] = 0.f;
            const LAS bf16* kp = Ks + (32 * (qi + kj) + r) * KS_STRIDE + 8 * hh;
#pragma unroll
            for (int ks = 0; ks < 4; ++ks) { const bf16x8 kf = *(const LAS bf16x8*)(kp + 16 * ks); acc = MFMA32(kf, qf[ks], acc); }
            s[kj] = acc;
        }
        __builtin_amdgcn_s_setprio(0);
        float mx = sink;
#pragma unroll
        for (int kj = 0; kj < 5; ++kj)
#pragma unroll
            for (int i = 0; i < 16; ++i) { const int kt = (i & 3) + 8 * (i >> 2) + 4 * hh; const int kbi = 32 * (qi + kj) + kt;
                bool valid = (n * 128 + kbi - 128) >= 0;
                if (kj == 0) valid = valid && (kt > r);
                if (kj == 4) valid = valid && (kt <= r);
                s[kj][i] = valid ? s[kj][i] : -INFINITY; mx = fmaxf(mx, s[kj][i]); }
        mx = fmaxf(mx, __shfl_xor(mx, 32));
        float l = 0.f;
#pragma unroll
        for (int kj = 0; kj < 5; ++kj)
#pragma unroll
            for (int i = 0; i < 16; ++i) { const float p = __expf(s[kj][i] - mx); s[kj][i] = p; l += p; }
        l += __shfl_xor(l, 32);
        l += __expf(sink - mx);
        const float inv = 1.0f / l;
        f32x16 o0, o1;
#pragma unroll
        for (int i = 0; i < 16; ++i) { o0[i] = 0.f; o1[i] = 0.f; }
        __builtin_amdgcn_s_setprio(1);
#pragma unroll
        for (int kj = 0; kj < 5; ++kj)
#pragma unroll
            for (int st = 0; st < 2; ++st) {
                v4u pa; pa.x = pk2(s[kj][8 * st + 0] * inv, s[kj][8 * st + 1] * inv); pa.y = pk2(s[kj][8 * st + 2] * inv, s[kj][8 * st + 3] * inv);
                pa.z = pk2(s[kj][8 * st + 4] * inv, s[kj][8 * st + 5] * inv); pa.w = pk2(s[kj][8 * st + 6] * inv, s[kj][8 * st + 7] * inv);
                const bf16x8 pf = __builtin_bit_cast(bf16x8, pa);
                const int kb0 = 32 * (qi + kj) + 16 * st + 4 * hh;
                const LAS bf16* v0p = VT + r * VT_STRIDE + kb0; const LAS bf16* v1p = VT + (32 + r) * VT_STRIDE + kb0;
                const v2u a0 = *(const LAS v2u*)v0p, a1 = *(const LAS v2u*)(v0p + 8), b0 = *(const LAS v2u*)v1p, b1 = *(const LAS v2u*)(v1p + 8);
                const v4u vb0 = {a0.x, a0.y, a1.x, a1.y}, vb1 = {b0.x, b0.y, b1.x, b1.y};
                o0 = MFMA32(pf, __builtin_bit_cast(bf16x8, vb0), o0);
                o1 = MFMA32(pf, __builtin_bit_cast(bf16x8, vb1), o1);
            }
        __builtin_amdgcn_s_setprio(0);
#pragma unroll
        for (int i = 0; i < 16; ++i) { const int qr = (i & 3) + 8 * (i >> 2) + 4 * hh; const int tok = n * 128 + 32 * qi + qr;
            bf16* op = P_XH(F) + (size_t)(b * SEQ + tok) * D + LRU_W + hq * HD + r;
            op[0] = (bf16)f2bf(o0[i]); op[32] = (bf16)f2bf(o1[i]); }
    }
    __syncthreads();
}

constexpr int LCH = 64;
constexpr int XC_STRIDE = 136;
constexpr int LRU_XCB_OFF = 0, LRU_XCF_OFF = LCH * XC_STRIDE * 2  , LRU_A_OFF = LRU_XCF_OFF + LCH * 128 * 4, LRU_B_OFF = LRU_A_OFF + LCH * 128 * 4, LRU_SE_OFF = LRU_B_OFF + LCH * 128 * 4;
static_assert(LRU_SE_OFF + 2 * 4 * 128 * 4 <= RING_BYTES, "LRU LDS");
__device__ __forceinline__ void lru_block(Frame& F) {
    LAS bf16* XCb = (LAS bf16*)(F.lds + LRU_XCB_OFF);
    LAS float* XCF = (LAS float*)(F.lds + LRU_XCF_OFF);
    LAS float* As = (LAS float*)(F.lds + LRU_A_OFF);
    LAS float* Bs = (LAS float*)(F.lds + LRU_B_OFF);
    LAS float* SEh = (LAS float*)(F.lds + LRU_SE_OFF);
    LAS float* SEp = SEh + 4 * 128;
    const int tid = F.tid, lane = F.lane;
    const int hd = F.bid & 7, li = F.bid >> 3, step = F.G >> 3;
    constexpr int NQ = BATCH * (SEQ / LCH);
    if (li >= NQ) return;
    const int cg = tid & 15, tp = tid >> 4, colc = hd * LRU_BLK + 8 * cg;
    float cw[4][8], cbv[8];
#pragma unroll
    for (int k = 0; k < 4; ++k) { const f32x4 a = *(const f32x4*)(P_conv_w(F) + k * LRU_W + colc), b2 = *(const f32x4*)(P_conv_w(F) + k * LRU_W + colc + 4);
        cw[k][0] = a.x; cw[k][1] = a.y; cw[k][2] = a.z; cw[k][3] = a.w; cw[k][4] = b2.x; cw[k][5] = b2.y; cw[k][6] = b2.z; cw[k][7] = b2.w; }
    { const f32x4 a = *(const f32x4*)(P_conv_b(F) + colc), b2 = *(const f32x4*)(P_conv_b(F) + colc + 4);
      cbv[0] = a.x; cbv[1] = a.y; cbv[2] = a.z; cbv[3] = a.w; cbv[4] = b2.x; cbv[5] = b2.y; cbv[6] = b2.z; cbv[7] = b2.w; }
    const int fr = lane & 15, fq = lane >> 4, j = 16 * F.wave + fr, jc = hd * LRU_BLK + j;
    bf16x8 wa[4], wx[4];
    { const bf16* wap = P_WGA(F) + (size_t)hd * 16384 + (size_t)j * 128 + 8 * fq; const bf16* wxp = P_WGX(F) + (size_t)hd * 16384 + (size_t)j * 128 + 8 * fq;
#pragma unroll
      for (int ks = 0; ks < 4; ++ks) { wa[ks] = *(const bf16x8*)(wap + 32 * ks); wx[ks] = *(const bf16x8*)(wxp + 32 * ks); } }
    const float ba = P_ga_b(F)[jc], bx = P_gx_b(F)[jc];
    const float sp8 = -8.0f * log1pf(__expf(-P_lam(F)[jc]));
    const int c = tid & 127, sub = tid >> 7, col = hd * LRU_BLK + c;
    const bf16* xbase = P_PROJ(F) + colc;
    bf16* HLp = P_HL(F); bf16* PAp = P_PA(F);
    v4u xr[5];
#define LRU_LOAD_X(q_) do { const int b_ = (q_) >> 6, ch_ = (q_) & 63; const int tr_ = ch_ * LCH + 2 * tp - 3; \
        _Pragma("unroll") for (int r_ = 0; r_ < 5; ++r_) { const int t_ = tr_ + r_; \
            xr[r_] = (t_ >= 0) ? __builtin_nontemporal_load((const v4u*)(xbase + (size_t)(b_ * SEQ + t_) * MIX_IN)) : (v4u){0u, 0u, 0u, 0u}; } } while (0)
    LRU_LOAD_X(li);
    for (int q = li; q < NQ; q += step) {
        const int b = q >> 6, ch = q & 63, t0 = ch * LCH;
        {
            float xv[5][8];
#pragma unroll
            for (int r = 0; r < 5; ++r) { xv[r][0] = bflo(xr[r].x); xv[r][1] = bfhi(xr[r].x); xv[r][2] = bflo(xr[r].y); xv[r][3] = bfhi(xr[r].y);
                xv[r][4] = bflo(xr[r].z); xv[r][5] = bfhi(xr[r].z); xv[r][6] = bflo(xr[r].w); xv[r][7] = bfhi(xr[r].w); }
            if (q + step < NQ) LRU_LOAD_X(q + step);
#pragma unroll
            for (int tk = 0; tk < 2; ++tk) { float xc[8];
#pragma unroll
                for (int e = 0; e < 8; ++e) xc[e] = cbv[e] + cw[0][e] * xv[tk][e] + cw[1][e] * xv[tk + 1][e] + cw[2][e] * xv[tk + 2][e] + cw[3][e] * xv[tk + 3][e];
                const int tl = 2 * tp + tk;
                v4u o; o.x = pk2(xc[0], xc[1]); o.y = pk2(xc[2], xc[3]); o.z = pk2(xc[4], xc[5]); o.w = pk2(xc[6], xc[7]);
                *(LAS v4u*)(XCb + tl * XC_STRIDE + 8 * cg) = o;
                *(LAS f32x4*)(XCF + tl * 128 + 8 * cg) = (f32x4){xc[0], xc[1], xc[2], xc[3]}; *(LAS f32x4*)(XCF + tl * 128 + 8 * cg + 4) = (f32x4){xc[4], xc[5], xc[6], xc[7]}; }
        }
        __syncthreads();
#pragma unroll
        for (int mt = 0; mt < 4; ++mt) {
            f32x4 ra = {0.f, 0.f, 0.f, 0.f}, rx = {0.f, 0.f, 0.f, 0.f};
            const LAS bf16* ap = XCb + (16 * mt + fr) * XC_STRIDE + 8 * fq;
#pragma unroll
            for (int ks = 0; ks < 4; ++ks) { const bf16x8 af = *(const LAS bf16x8*)(ap + 32 * ks); ra = MFMA16(af, wa[ks], ra); rx = MFMA16(af, wx[ks], rx); }
#pragma unroll
            for (int e = 0; e < 4; ++e) { const int tl = 16 * mt + 4 * fq + e;
                const float rg = sigmoidf_(ra[e] + ba), ig = sigmoidf_(rx[e] + bx);
                const float a = __expf(rg * sp8);
                const float mult = __builtin_amdgcn_sqrtf(fmaxf(fmaf(-a, a, 1.0f), 0.f));
                As[tl * 128 + j] = a; Bs[tl * 128 + j] = mult * ig * XCF[tl * 128 + j]; }
        }
        __syncthreads();
        float hh[16], pp[16];
        {
            float h = 0.f, P = 1.f;
#pragma unroll
            for (int i = 0; i < 16; ++i) { const int tl = sub * 16 + i; const float a = As[tl * 128 + c], bq = Bs[tl * 128 + c];
                h = a * h + bq; P *= a; hh[i] = h; pp[i] = P; }
            SEh[sub * 128 + c] = h; SEp[sub * 128 + c] = P;
        }
        __syncthreads();
        {
            float carry = 0.f, pre = 1.f;
            for (int s2 = 0; s2 < sub; ++s2) { carry = SEh[s2 * 128 + c] + SEp[s2 * 128 + c] * carry; pre *= SEp[s2 * 128 + c]; }
            bf16* hl = HLp + (size_t)(b * SEQ + t0 + sub * 16) * LRU_W + col;
            bf16* pa = PAp + (size_t)(b * SEQ + t0 + sub * 16) * LRU_W + col;
#pragma unroll
            for (int i = 0; i < 16; ++i) { hl[(size_t)i * LRU_W] = (bf16)f2bf(hh[i] + pp[i] * carry); pa[(size_t)i * LRU_W] = (bf16)f2bf(pp[i] * pre); }
        }
    }
#undef LRU_LOAD_X
    __syncthreads();
}
constexpr int N_ATT_UNITS = BATCH * HKV * (SEQ / 128);
constexpr int N_LRU_UNITS = BATCH * LRU_HEADS * (SEQ / LCH);
__device__ __forceinline__ void p3_phase(Frame& F) {
    for (int u = F.bid; u < N_ATT_UNITS; u += F.G) attn_unit(F, u >> 6, (u >> 5) & 1, u & 31);
    lru_block(F);
}

__device__ __forceinline__ void p4_unit(Frame& F, int b, int ch) {
    LAS float* CAR = (LAS float*)F.lds;
    const int tid = F.tid, lane = F.lane;
    {
        f32x2 carry = {0.f, 0.f};
        const bf16* hlb = P_HL(F) + (size_t)(b * SEQ + LCH - 1) * LRU_W + 2 * tid; const bf16* pab = P_PA(F) + (size_t)(b * SEQ + LCH - 1) * LRU_W + 2 * tid;
        for (int c0 = 0; c0 < ch; c0 += 32) { unsigned hl[32], pa[32];
#pragma unroll
            for (int q = 0; q < 32; ++q) { const int cq = (c0 + q < ch) ? c0 + q : 0; hl[q] = *(const unsigned*)(hlb + (size_t)cq * LCH * LRU_W); pa[q] = *(const unsigned*)(pab + (size_t)cq * LCH * LRU_W); }
#pragma unroll
            for (int q = 0; q < 32; ++q) { const bool on = c0 + q < ch; const unsigned h_ = on ? hl[q] : 0u, p_ = on ? pa[q] : 0x3f803f80u;
                carry.x = bflo(h_) + bflo(p_) * carry.x; carry.y = bfhi(h_) + bfhi(p_) * carry.y; } }
        CAR[2 * tid] = carry.x; CAR[2 * tid + 1] = carry.y;
    }
    __syncthreads();
    const float* gl = P_on_lru_g(F); const float* ga = P_on_attn_g(F);
    for (int i = 0; i < 8; i += 2) {
        const size_t m0 = (size_t)b * SEQ + ch * LCH + F.wave * 8 + i;
        v2u hl[2][4], pa[2][4]; v2u yr[2][4], ar[2][4];
#pragma unroll
        for (int t = 0; t < 2; ++t)
#pragma unroll
            for (int j = 0; j < 4; ++j) { const int c = 4 * lane + 256 * j; const size_t m = m0 + t;
                hl[t][j] = __builtin_nontemporal_load((const v2u*)(P_HL(F) + m * LRU_W + c)); pa[t][j] = __builtin_nontemporal_load((const v2u*)(P_PA(F) + m * LRU_W + c));
                yr[t][j] = __builtin_nontemporal_load((const v2u*)(P_PROJ(F) + m * MIX_IN + C_Y + c)); ar[t][j] = __builtin_nontemporal_load((const v2u*)(P_XH(F) + m * D + LRU_W + c)); }
        f32x4 vl[2][4], va[2][4]; float sl[2] = {0.f, 0.f}, sa[2] = {0.f, 0.f};
#pragma unroll
        for (int t = 0; t < 2; ++t)
#pragma unroll
            for (int j = 0; j < 4; ++j) { const int c = 4 * lane + 256 * j; const f32x4 car = *(const LAS f32x4*)(CAR + c);
                const f32x4 hlf = {bflo(hl[t][j].x), bfhi(hl[t][j].x), bflo(hl[t][j].y), bfhi(hl[t][j].y)}, paf = {bflo(pa[t][j].x), bfhi(pa[t][j].x), bflo(pa[t][j].y), bfhi(pa[t][j].y)};
                const f32x4 h = hlf + paf * car;
                f32x4 v; v.x = h.x * gelu_tanh(bflo(yr[t][j].x)); v.y = h.y * gelu_tanh(bfhi(yr[t][j].x)); v.z = h.z * gelu_tanh(bflo(yr[t][j].y)); v.w = h.w * gelu_tanh(bfhi(yr[t][j].y));
                vl[t][j] = v; sl[t] += (v.x * v.x + v.y * v.y) + (v.z * v.z + v.w * v.w);
                f32x4 a; a.x = bflo(ar[t][j].x); a.y = bfhi(ar[t][j].x); a.z = bflo(ar[t][j].y); a.w = bfhi(ar[t][j].y);
                va[t][j] = a; sa[t] += (a.x * a.x + a.y * a.y) + (a.z * a.z + a.w * a.w); }
#pragma unroll
        for (int o = 1; o < 64; o <<= 1) { sl[0] += __shfl_xor(sl[0], o); sl[1] += __shfl_xor(sl[1], o); sa[0] += __shfl_xor(sa[0], o); sa[1] += __shfl_xor(sa[1], o); }
#if GEMM2_I8
        float am[2] = {0.f, 0.f};
#pragma unroll
        for (int t = 0; t < 2; ++t) { const float rl = 1.0f / sqrtf(sl[t] * (1.0f / LRU_W) + EPS), ra = 1.0f / sqrtf(sa[t] * (1.0f / LRU_W) + EPS);
#pragma unroll
            for (int j = 0; j < 4; ++j) { const int c = 4 * lane + 256 * j; const f32x4 g1v = *(const f32x4*)(gl + c), g2v = *(const f32x4*)(ga + c);
                vl[t][j] = vl[t][j] * rl * g1v; va[t][j] = va[t][j] * ra * g2v; }
#if GEMM2_HAD
#pragma unroll
            for (int j = 0; j < 4; ++j) { f32x4 a = vl[t][j]; vl[t][j] = (f32x4){a.x + a.y, a.x - a.y, a.z + a.w, a.z - a.w}; a = va[t][j]; va[t][j] = (f32x4){a.x + a.y, a.x - a.y, a.z + a.w, a.z - a.w}; }
#pragma unroll
            for (int j = 0; j < 4; ++j) { f32x4 a = vl[t][j]; vl[t][j] = (f32x4){a.x + a.z, a.y + a.w, a.x - a.z, a.y - a.w}; a = va[t][j]; va[t][j] = (f32x4){a.x + a.z, a.y + a.w, a.x - a.z, a.y - a.w}; }
#pragma unroll
            for (int j = 0; j < 4; j += 2) { f32x4 a = vl[t][j], b = vl[t][j + 1]; vl[t][j] = a + b; vl[t][j + 1] = a - b; a = va[t][j]; b = va[t][j + 1]; va[t][j] = a + b; va[t][j + 1] = a - b; }
#pragma unroll
            for (int j = 0; j < 2; ++j) { f32x4 a = vl[t][j], b = vl[t][j + 2]; vl[t][j] = a + b; vl[t][j + 2] = a - b; a = va[t][j]; b = va[t][j + 2]; va[t][j] = a + b; va[t][j + 2] = a - b; }
#pragma unroll
            for (int j = 0; j < 4; ++j) { const f32x4 a = vl[t][j], b = va[t][j]; vl[t][j] = a + b; va[t][j] = a - b; }
#endif
#pragma unroll
            for (int j = 0; j < 4; ++j) { const f32x4 y = vl[t][j], z = va[t][j];
                am[t] = fmaxf(am[t], fmaxf(fmaxf(fmaxf(fabsf(y.x), fabsf(y.y)), fmaxf(fabsf(y.z), fabsf(y.w))), fmaxf(fmaxf(fabsf(z.x), fabsf(z.y)), fmaxf(fabsf(z.z), fabsf(z.w))))); } }
#pragma unroll
        for (int o = 1; o < 64; o <<= 1) { am[0] = fmaxf(am[0], __shfl_xor(am[0], o)); am[1] = fmaxf(am[1], __shfl_xor(am[1], o)); }
#pragma unroll
        for (int t = 0; t < 2; ++t) { const size_t m = m0 + t; const float a = fmaxf(am[t], 1e-30f), qs = 127.0f / a;
            if (lane == 0) P_RS(F, 1)[m] = a * (1.0f / 127.0f);
#pragma unroll
            for (int j = 0; j < 4; ++j) { const int c = 4 * lane + 256 * j; const f32x4 y = vl[t][j] * qs, z = va[t][j] * qs;
                *(unsigned*)(P_MIX8(F) + m * D + c) = ((unsigned)(int)__builtin_rintf(y.x) & 0xffu) | (((unsigned)(int)__builtin_rintf(y.y) & 0xffu) << 8) | (((unsigned)(int)__builtin_rintf(y.z) & 0xffu) << 16) | ((unsigned)(int)__builtin_rintf(y.w) << 24);
                *(unsigned*)(P_MIX8(F) + m * D + LRU_W + c) = ((unsigned)(int)__builtin_rintf(z.x) & 0xffu) | (((unsigned)(int)__builtin_rintf(z.y) & 0xffu) << 8) | (((unsigned)(int)__builtin_rintf(z.z) & 0xffu) << 16) | ((unsigned)(int)__builtin_rintf(z.w) << 24); } }
#else
#pragma unroll
        for (int t = 0; t < 2; ++t) { const float rl = 1.0f / sqrtf(sl[t] * (1.0f / LRU_W) + EPS), ra = 1.0f / sqrtf(sa[t] * (1.0f / LRU_W) + EPS); const size_t m = m0 + t;
#pragma unroll
            for (int j = 0; j < 4; ++j) { const int c = 4 * lane + 256 * j; const f32x4 g1v = *(const f32x4*)(gl + c), g2v = *(const f32x4*)(ga + c);
                const f32x4 y = vl[t][j] * rl * g1v, z = va[t][j] * ra * g2v;
                v2u o; o.x = pk2(y.x, y.y); o.y = pk2(y.z, y.w); *(v2u*)(P_XH(F) + m * D + c) = o;
                v2u p; p.x = pk2(z.x, z.y); p.y = pk2(z.z, z.w); *(v2u*)(P_XH(F) + m * D + LRU_W + c) = p; } }
#endif
    }
    __syncthreads();
}
__device__ __forceinline__ void p4_phase(Frame& F) {
    for (int u = F.bid; u < BATCH * (SEQ / LCH); u += F.G) p4_unit(F, u >> 6, u & 63);
}

__device__ __forceinline__ int f2key(float f) { const int b = __builtin_bit_cast(int, f); return b ^ ((b >> 31) & 0x7fffffff); }
__device__ __forceinline__ float key2f(int k) { const int b = k ^ ((k >> 31) & 0x7fffffff); return __builtin_bit_cast(float, b); }
__device__ __forceinline__ void ins16(int (&L)[16], int x) {
#pragma unroll
    for (int j = 0; j < 16; ++j) { const int hi = max(L[j], x); x = min(L[j], x); L[j] = hi; }
}
__device__ __forceinline__ void ce_desc(int& a, int& b) { const int hi = a > b ? a : b, lo = a > b ? b : a; a = hi; b = lo; }
__device__ __forceinline__ void sort16_desc(int (&a)[16]) {
    ce_desc(a[0], a[1]); ce_desc(a[2], a[3]); ce_desc(a[0], a[2]); ce_desc(a[1], a[3]); ce_desc(a[1], a[2]); ce_desc(a[4], a[5]); ce_desc(a[6], a[7]); ce_desc(a[4], a[6]); ce_desc(a[5], a[7]); ce_desc(a[5], a[6]); ce_desc(a[0], a[4]); ce_desc(a[2], a[6]); ce_desc(a[2], a[4]); ce_desc(a[1], a[5]); ce_desc(a[3], a[7]); ce_desc(a[3], a[5]); ce_desc(a[1], a[2]); ce_desc(a[3], a[4]); ce_desc(a[5], a[6]); ce_desc(a[8], a[9]); ce_desc(a[10], a[11]); ce_desc(a[8], a[10]); ce_desc(a[9], a[11]); ce_desc(a[9], a[10]); ce_desc(a[12], a[13]); ce_desc(a[14], a[15]); ce_desc(a[12], a[14]); ce_desc(a[13], a[15]); ce_desc(a[13], a[14]); ce_desc(a[8], a[12]); ce_desc(a[10], a[14]); ce_desc(a[10], a[12]); ce_desc(a[9], a[13]); ce_desc(a[11], a[15]); ce_desc(a[11], a[13]); ce_desc(a[9], a[10]); ce_desc(a[11], a[12]); ce_desc(a[13], a[14]); ce_desc(a[0], a[8]); ce_desc(a[4], a[12]); ce_desc(a[4], a[8]); ce_desc(a[2], a[10]); ce_desc(a[6], a[14]); ce_desc(a[6], a[10]); ce_desc(a[2], a[4]); ce_desc(a[6], a[8]); ce_desc(a[10], a[12]); ce_desc(a[1], a[9]); ce_desc(a[5], a[13]); ce_desc(a[5], a[9]); ce_desc(a[3], a[11]); ce_desc(a[7], a[15]); ce_desc(a[7], a[11]); ce_desc(a[3], a[5]); ce_desc(a[7], a[9]); ce_desc(a[11], a[13]); ce_desc(a[1], a[2]); ce_desc(a[3], a[4]); ce_desc(a[5], a[6]); ce_desc(a[7], a[8]); ce_desc(a[9], a[10]); ce_desc(a[11], a[12]); ce_desc(a[13], a[14]);
}
__device__ __forceinline__ void bitonic_merge16_desc(int (&a)[16]) {
#pragma unroll
    for (int j = 8; j > 0; j >>= 1)
#pragma unroll
        for (int i = 0; i < 16; ++i) { const int l = i ^ j; if (l > i) ce_desc(a[i], a[l]); }
}
__device__ __forceinline__ void merge_top16(int (&a)[16], const int (&b)[16]) {
#pragma unroll
    for (int i = 0; i < 16; ++i) a[i] = a[i] > b[15 - i] ? a[i] : b[15 - i];
    bitonic_merge16_desc(a);
}
constexpr int INT_LOWEST = (int)0x80000000;
constexpr int P8_KROW = 272, P8_TAB_BYTES = 256 * P8_KROW, P8_LUT_BYTES = 64 * 40;
#define P8_LOADQ(dst, tt_, p_) do { const char* qb_ = (const char*)(QP + (size_t)(32 * (tt_)) * D + hd * 256 + (p_) * 128); \
        _Pragma("unroll") for (int ks = 0; ks < 8; ++ks) dst[ks] = __builtin_nontemporal_load((const bf16x8*)(qb_ + qoff + 32 * ks)); } while (0)
#define P8_HALF(p_, qf_, PREFQ) do { int L[16]; _Pragma("unroll") for (int j = 0; j < 16; ++j) L[j] = INT_LOWEST; \
        PREFQ; \
        _Pragma("unroll 1") for (int kt = 0; kt < 4; ++kt) { \
            const LAS unsigned char* kp_ = tab + ((p_) * 128 + 32 * kt + r) * P8_KROW + 16 * hh; \
            f32x16 acc; _Pragma("unroll") for (int i = 0; i < 16; ++i) acc[i] = 0.f; \
            _Pragma("unroll") for (int ks = 0; ks < 8; ++ks) { const bf16x8 kf = *(const LAS bf16x8*)(kp_ + 32 * ks); acc = MFMA32(kf, qf_[ks], acc); } \
            const int kbase = 32 * kt + 4 * hh; int T[16]; \
            _Pragma("unroll") for (int i = 0; i < 16; ++i) { const int kidx = (i & 3) + 8 * (i >> 2); T[i] = (f2key(acc[i]) & ~0x7f) | (kbase + kidx); } \
            sort16_desc(T); merge_top16(L, T); } \
        int O[16]; _Pragma("unroll") for (int j = 0; j < 16; ++j) O[j] = __shfl_xor(L[j], 32);             \
        merge_top16(L, O); \
        _Pragma("unroll") for (int j = 0; j < 16; ++j) V[p_][j] = L[j]; } while (0)
__device__ __forceinline__ void p8_item(Frame& F, int tt, int tt_next, int hd, const LAS unsigned char* tab, LAS unsigned char* lut, bf16x8 (&qA)[8]) {
    const int lane = F.lane, r = lane & 31, hh = lane >> 5;
    const bf16* QP = P_PROJ(F);
    const unsigned qoff = (unsigned)(r * D + 8 * hh) * 2u;
    int V[2][16];
    bf16x8 qB[8];
    P8_HALF(0, qA, P8_LOADQ(qB, tt, 1));
    P8_HALF(1, qB, P8_LOADQ(qA, tt_next, 0));
#pragma unroll
    for (int j = 0; j < 16; ++j) { lut[lane * 40 + j] = (unsigned char)(V[0][j] & 0x7f); lut[lane * 40 + 16 + j] = (unsigned char)(V[1][j] & 0x7f); }
    float v0[16], v1[16];
#pragma unroll
    for (int j = 0; j < 16; ++j) { v0[j] = key2f(V[0][j] & ~0x7f); v1[j] = key2f(V[1][j] & ~0x7f); }
    int C[16], G1[16], G2[16], G3[2];
    { int n = 0;
#pragma unroll
      for (int i = 0; i < 16; ++i)
#pragma unroll
        for (int j = 0; j < 16; ++j)
            if ((i + 1) * (j + 1) <= 16) { const int key = (f2key(v0[i] + v1[j]) & ~0xff) | (i * 16 + j);
                if (n < 16) C[n] = key; else if (n < 32) G1[n - 16] = key; else if (n < 48) G2[n - 32] = key; else G3[n - 48] = key;
                ++n; } }
    sort16_desc(C); sort16_desc(G1); sort16_desc(G2);
    merge_top16(C, G1); merge_top16(C, G2); ins16(C, G3[0]); ins16(C, G3[1]);
    float sv[16]; float den = 0.f;
    const float mx = key2f(C[0] & ~0xff);
#pragma unroll
    for (int e = 0; e < 16; ++e) { sv[e] = __expf(key2f(C[e] & ~0xff) - mx); den += sv[e]; }
    const float inv = 1.0f / den;
    LDS_WAIT(); asm volatile("" ::: "memory");
    int idx[16];
#pragma unroll
    for (int e = 0; e < 16; ++e) { const int pi = (C[e] >> 4) & 15, pj = C[e] & 15; idx[e] = (int)lut[lane * 40 + pi] * PKEYS + (int)lut[lane * 40 + 16 + pj]; }
    if (hh == 0) {
        unsigned short* ip = P_IDX(F) + (size_t)(32 * tt + r) * 128 + hd * 16; float* gp = P_GW(F) + (size_t)(32 * tt + r) * 128 + hd * 16;
#pragma unroll
        for (int q = 0; q < 2; ++q) *(v4u*)(ip + 8 * q) = (v4u){(unsigned)idx[8 * q] | ((unsigned)idx[8 * q + 1] << 16), (unsigned)idx[8 * q + 2] | ((unsigned)idx[8 * q + 3] << 16),
                                                              (unsigned)idx[8 * q + 4] | ((unsigned)idx[8 * q + 5] << 16), (unsigned)idx[8 * q + 6] | ((unsigned)idx[8 * q + 7] << 16)};
#pragma unroll
        for (int q = 0; q < 4; ++q) *(f32x4*)(gp + 4 * q) = (f32x4){sv[4 * q] * inv, sv[4 * q + 1] * inv, sv[4 * q + 2] * inv, sv[4 * q + 3] * inv};
    }
    LDS_WAIT(); asm volatile("" ::: "memory");
}
#undef P8_HALF
__device__ __forceinline__ void p8_phase(Frame& F) {
    const int hd = F.bid & 7, rank = F.bid >> 3, nr = F.G >> 3, NT = M / 32;
    LAS unsigned char* tab = F.lds;
    LAS unsigned char* lut = F.lds + P8_TAB_BYTES + F.wave * P8_LUT_BYTES;
    { const unsigned char* src = (const unsigned char*)(P_SK(F) + (size_t)(hd * 2 * PKEYS) * PHALF);
      for (int i = F.tid; i < 4096; i += NWAVES * 64) *(LAS v4u*)(tab + (i >> 4) * P8_KROW + 16 * (i & 15)) = *(const v4u*)(src + (size_t)i * 16); }
    __syncthreads();
    const int lane = F.lane, r = lane & 31, hh = lane >> 5;
    const bf16* QP = P_PROJ(F);
    const unsigned qoff = (unsigned)(r * D + 8 * hh) * 2u;
    const int t0 = rank * NWAVES + F.wave, tstep = nr * NWAVES;
    if (t0 < NT) {
        bf16x8 qA[8];
        P8_LOADQ(qA, t0, 0);
        for (int tt = t0; tt < NT; tt += tstep) p8_item(F, tt, tt + tstep < NT ? tt + tstep : tt, hd, tab, lut, qA);
    }
    __syncthreads();
}
#undef P8_LOADQ

template <int CTRL> __device__ __forceinline__ float dpp_f(float x) { return __builtin_bit_cast(float, __builtin_amdgcn_mov_dpp(__builtin_bit_cast(int, x), CTRL, 0xf, 0xf, true)); }
__device__ __forceinline__ float sum8(float v) {
    v += dpp_f<0xB1>(v);
    v += dpp_f<0x4E>(v);
    v += dpp_f<0x141>(v);
    return v;
}
__device__ __forceinline__ void dec16(const v4u r, float (&f)[16]) {
    const unsigned w4[4] = {r.x, r.y, r.z, r.w};
#pragma unroll
    for (int w = 0; w < 4; ++w) { const f32x2 lo = __builtin_amdgcn_cvt_pk_f32_fp8((int)w4[w], false), hi = __builtin_amdgcn_cvt_pk_f32_fp8((int)w4[w], true);
        f[4 * w] = lo.x; f[4 * w + 1] = lo.y; f[4 * w + 2] = hi.x; f[4 * w + 3] = hi.y; }
}
__device__ __forceinline__ void row_offsets(const v4u a, const v4u b, unsigned loff, unsigned (&off)[16]) {
    const unsigned w[8] = {a.x, a.y, a.z, a.w, b.x, b.y, b.z, b.w};
#pragma unroll
    for (int q = 0; q < 8; ++q) { off[2 * q] = ((w[q] & 0xffffu) << 7) + loff; off[2 * q + 1] = ((w[q] >> 16) << 7) + loff; }
}
#define ISSUE_ROWS(dst, TBL, ia, ib) do { unsigned off_[16]; row_offsets((ia), (ib), loff, off_); \
    _Pragma("unroll") for (int i_ = 0; i_ < 16; ++i_) dst[i_] = *(const v4u*)((TBL) + off_[i_]); } while (0)

typedef int i32x8 __attribute__((ext_vector_type(8)));
#define MFMA_F4F8(a, b, c) __builtin_amdgcn_mfma_scale_f32_16x16x128_f8f6f4((a), (b), (c), 4  , 0  , 0, 0x7f7f7f7f, 0, 0x7f7f7f7f)
#define ISSUE_ROWS_U(dst, i0, i1) do { const unsigned w_[8] = {(i0).x, (i0).y, (i0).z, (i0).w, (i1).x, (i1).y, (i1).z, (i1).w}; \
    _Pragma("unroll") for (int g_ = 0; g_ < 16; ++g_) { const unsigned id_ = (g_ & 1) ? (w_[g_ >> 1] >> 16) : __builtin_amdgcn_ubfe(w_[g_ >> 1], 0u, 16u); \
        dst[g_] = *(const v4u*)(U4 + ((id_ << 7) + loff)); } } while (0)
__device__ __forceinline__ void p9u_compute(const v4u (&row)[16], const v4u hA0, const v4u hA1, const v4u hB0, const v4u hB1, int lane, bf16* dst) {
    const i32x8 B0 = {(int)hA0.x, (int)hA0.y, (int)hA0.z, (int)hA0.w, (int)hA1.x, (int)hA1.y, (int)hA1.z, (int)hA1.w};
    const i32x8 B1 = {(int)hB0.x, (int)hB0.y, (int)hB0.z, (int)hB0.w, (int)hB1.x, (int)hB1.y, (int)hB1.z, (int)hB1.w};
    const int n = lane & 15, q = lane >> 4;
    const f32x4 zero = {0.f, 0.f, 0.f, 0.f};
    const bool odd = (q & 1) != 0;
    float part[16];
    __builtin_amdgcn_s_setprio(1);
#pragma unroll
    for (int g = 0; g < 16; ++g) {
        const i32x8 a = {(int)row[g].x, (int)row[g].y, (int)row[g].z, (int)row[g].w, 0, 0, 0, 0};
        const f32x4 d0 = MFMA_F4F8(a, B0, zero), d1 = MFMA_F4F8(a, B1, zero);
        const float s0 = odd ? d1[0] : d0[0], s1 = odd ? d1[1] : d0[1], s2 = odd ? d1[2] : d0[2], s3 = odd ? d1[3] : d0[3];
        part[g] = (s0 + dpp_f<0x12C>(s1)) + (dpp_f<0x128>(s2) + dpp_f<0x124>(s3));
    }
    __builtin_amdgcn_s_setprio(0);
    float res[8];
#pragma unroll
    for (int k = 0; k < 8; ++k) { const auto sw = __builtin_amdgcn_permlane16_swap(__builtin_bit_cast(unsigned, part[k]), __builtin_bit_cast(unsigned, part[8 + k]), false, false);
        const unsigned w0 = sw[0], w1 = sw[1]; res[k] = __builtin_bit_cast(float, w0) + __builtin_bit_cast(float, w1); }
    if ((lane & 0xc) == 0) {
        bf16* d = dst + 16 * (2 * (n & 3) + (q >> 1)) + 8 * (q & 1);
        v4u o0; o0.x = pk2(res[0], res[1]); o0.y = pk2(res[2], res[3]); o0.z = pk2(res[4], res[5]); o0.w = pk2(res[6], res[7]);
        *(v4u*)d = o0;
    }
}
__device__ __forceinline__ void p9u_item(Frame& F, int s, int tb) {
    const int lane = F.lane, sg = lane & 7, r8 = lane >> 3, n = lane & 15, kq = lane >> 4;
    const unsigned char* U4 = P_U(F);
    const unsigned loff = (unsigned)(s * (NEXP * 128) + 16 * sg);
    const unsigned short* idxb = P_IDX(F) + (size_t)(64 * tb) * 128 + 16 * r8;
    const unsigned char* hb = P_H8(F) + (size_t)(64 * tb) * D + 256 * s + 32 * (n >> 2) + 16 * (kq & 1);
    const bool bon = (kq >> 1) == (n & 1); const bool bhi = (n & 2) != 0;
    const unsigned char* zp = P_ws(F) + WS_CTL + 60000;
    const bool alo = bon && !bhi, ahi = bon && bhi;
    const unsigned char* pLo = alo ? hb : zp; const unsigned char* pHi = ahi ? hb : zp;
    const size_t mLo = alo ? ~(size_t)0 : (size_t)0, mHi = ahi ? ~(size_t)0 : (size_t)0;
    bf16* pb = (bf16*)P_PART(F) + ((size_t)s * M + 64 * tb) * 128;
#define LOAD_META_U(I0, I1, A0, A1, B0, B1, tt_) do { const int tn_ = (tt_) < 64 ? (tt_) : 63; const unsigned short* ip_ = idxb + (size_t)tn_ * 128; I0 = *(const v4u*)(ip_); I1 = *(const v4u*)(ip_ + 8); \
        const size_t to_ = (size_t)tn_ * D; const unsigned char* pl_ = pLo + (to_ & mLo); const unsigned char* ph_ = pHi + (to_ & mHi); \
        A0 = *(const v4u*)(pl_); A1 = *(const v4u*)(ph_); B0 = *(const v4u*)(pl_ + 128); B1 = *(const v4u*)(ph_ + 128); } while (0)
    v4u aI0, aI1, aA0, aA1, aB0, aB1, bI0, bI1, bA0, bA1, bB0, bB1, cI0, cI1, cA0, cA1, cB0, cB1, dI0, dI1, dA0, dA1, dB0, dB1;
    LOAD_META_U(aI0, aI1, aA0, aA1, aB0, aB1, 0); LOAD_META_U(bI0, bI1, bA0, bA1, bB0, bB1, 1); LOAD_META_U(cI0, cI1, cA0, cA1, cB0, cB1, 2);
    v4u rowA[16], rowB[16];
    ISSUE_ROWS_U(rowA, aI0, aI1); ISSUE_ROWS_U(rowB, bI0, bI1);
#pragma unroll 1
    for (int t = 0; t < 64; t += 2) {
        p9u_compute(rowA, aA0, aA1, aB0, aB1, lane, pb + (size_t)t * 128);
        LOAD_META_U(dI0, dI1, dA0, dA1, dB0, dB1, t + 3);
        ISSUE_ROWS_U(rowA, cI0, cI1);
        p9u_compute(rowB, bA0, bA1, bB0, bB1, lane, pb + (size_t)(t + 1) * 128);
        aA0 = cA0; aA1 = cA1; aB0 = cB0; aB1 = cB1; bA0 = dA0; bA1 = dA1; bB0 = dB0; bB1 = dB1;
        LOAD_META_U(cI0, cI1, cA0, cA1, cB0, cB1, t + 4);
        ISSUE_ROWS_U(rowB, dI0, dI1);
    }
#undef LOAD_META_U
}
#define MFMA_F6F4(a, b, c) __builtin_amdgcn_mfma_scale_f32_16x16x128_f8f6f4((a), (b), (c), 2  , 4  , 0, 0x7f7f7f7f, 0, 0x7f7f7f7f)
#define ISSUE_ROWS_V(dst, i0, i1) do { const unsigned w_[8] = {(i0).x, (i0).y, (i0).z, (i0).w, (i1).x, (i1).y, (i1).z, (i1).w}; \
    _Pragma("unroll") for (int g_ = 0; g_ < 16; ++g_) { const unsigned id_ = (g_ & 1) ? (w_[g_ >> 1] >> 16) : __builtin_amdgcn_ubfe(w_[g_ >> 1], 0u, 16u); \
        dst[g_] = *(const v4u*)(V4 + ((id_ << 7) + loff)); } } while (0)
__device__ __forceinline__ void p9v_compute(const v4u (&row)[16], const v4u w6, int lane, const unsigned p0, const bf16* xp, const f32x4 g2, float wscale, float* dst) {
    const v2u x1 = *(const v2u*)xp;
    f32x4 d[4];
#pragma unroll
    for (int t = 0; t < 4; ++t) d[t] = (f32x4){0.f, 0.f, 0.f, 0.f};
    const unsigned w4[4] = {w6.x, w6.y, w6.z, w6.w};
    unsigned zhi; asm volatile("v_mov_b32 %0, 0" : "=v"(zhi));
    typedef int v4i_ __attribute__((ext_vector_type(4)));
    i32x8 a0 = {0, 0, 0, 0, 0, 0, 0, 0};
    v4i_ t1, t2, t3; asm volatile("; opaque B tuples" : "=v"(t1), "=v"(t2), "=v"(t3));
    __builtin_amdgcn_s_setprio(1);
#pragma unroll
    for (int g = 0; g < 16; ++g) {
        const unsigned code = (w4[g >> 2] >> (8 * (g & 3))) & 0x3fu;
        const unsigned long long c64 = ((unsigned long long)zhi << 32) | code;
        const unsigned long long y0 = c64 << p0;
        const i32x8 b = {(int)row[g].x, (int)row[g].y, (int)row[g].z, (int)row[g].w, 0, 0, 0, 0};
        a0[0] = (int)(unsigned)y0; a0[1] = (int)(unsigned)(y0 >> 32);   t1[0] = (int)row[g].y; t2[0] = (int)row[g].z; t3[0] = (int)row[g].w;
        d[0] = MFMA_F6F4(a0, b, d[0]);
        d[1] = MFMA_F6F4(a0, __builtin_shufflevector(t1, t1, 0, 1, 2, 3, -1, -1, -1, -1), d[1]);
        d[2] = MFMA_F6F4(a0, __builtin_shufflevector(t2, t2, 0, 1, 2, 3, -1, -1, -1, -1), d[2]);
        d[3] = MFMA_F6F4(a0, __builtin_shufflevector(t3, t3, 0, 1, 2, 3, -1, -1, -1, -1), d[3]);
    }
    __builtin_amdgcn_s_setprio(0);
    const bool inA = (lane & 40) == 0, inB = (lane & 40) == 40;
    f32x4 val;
#pragma unroll
    for (int e = 0; e < 4; ++e) {
        const float r40 = __shfl_xor(inA ? d[3][e] : d[0][e], 40);
        const float r8  = dpp_f<0x128>(inA ? d[1][e] : d[2][e]);
        const float r32 = __shfl_xor(inA ? d[2][e] : d[1][e], 32);
        val[e] = inA ? d[0][e] + r40 : (inB ? d[3][e] + r40 : r8 + r32);
    }
    const f32x4 xv = {bflo(x1.x), bfhi(x1.x), bflo(x1.y), bfhi(x1.y)};
    *(f32x4*)dst = xv + g2 * (val * wscale);
}
__device__ __forceinline__ void p9v_item(Frame& F, int s, int tb) {
    const int lane = F.lane, sg = lane & 7, r8 = lane >> 3;
    const unsigned char* V4 = P_V(F);
    const unsigned loff = (unsigned)(s * (NEXP * 128) + 16 * sg);
    const unsigned short* idxb = P_IDX(F) + (size_t)(64 * tb) * 128 + 16 * r8;
    const int ai = lane & 15, kqa = lane >> 4;
    const unsigned p0 = 6u * (unsigned)(ai & 7);
    const unsigned char* wb = P_W(F) + (size_t)(64 * tb) * 128 + 16 * (2 * kqa + (ai >> 3));
    const float* wscp = P_WSC(F) + 64 * tb;
    const int b = (64 * tb) / SEQ;
    const int ocol = 256 * s + 32 * (lane & 7) + 8 * (((lane >> 3) & 1) + 2 * (lane >> 5)) + 4 * ((lane >> 4) & 1);
    const f32x4 g2 = *(const f32x4*)(P_ADA(F) + (size_t)b * ADA_W + 5 * D + ocol);
    float* ob = P_out(F) + (size_t)(64 * tb) * D + ocol;
    const bf16* xb = P_X1B(F) + (size_t)(64 * tb) * D + ocol;
#define LOAD_META_V(I0, I1, W6, WS, tt_) do { const int tn_ = (tt_) < 64 ? (tt_) : 63; const unsigned short* ip_ = idxb + (size_t)tn_ * 128; I0 = *(const v4u*)(ip_); I1 = *(const v4u*)(ip_ + 8); \
        W6 = *(const v4u*)(wb + (size_t)tn_ * 128); WS = wscp[tn_]; } while (0)
    v4u aI0, aI1, aW, bI0, bI1, bW, cI0, cI1, cW, dI0, dI1, dW; float aS, bS, cS, dS;
    LOAD_META_V(aI0, aI1, aW, aS, 0); LOAD_META_V(bI0, bI1, bW, bS, 1); LOAD_META_V(cI0, cI1, cW, cS, 2);
    v4u rowA[16], rowB[16];
    ISSUE_ROWS_V(rowA, aI0, aI1); ISSUE_ROWS_V(rowB, bI0, bI1);
#pragma unroll 1
    for (int t = 0; t < 64; t += 2) {
        p9v_compute(rowA, aW, lane, p0, xb + (size_t)t * D, g2, aS, ob + (size_t)t * D);
        LOAD_META_V(dI0, dI1, dW, dS, t + 3);
        ISSUE_ROWS_V(rowA, cI0, cI1);
        p9v_compute(rowB, bW, lane, p0, xb + (size_t)(t + 1) * D, g2, bS, ob + (size_t)(t + 1) * D);
        aW = cW; aS = cS; bW = dW; bS = dS;
        LOAD_META_V(cI0, cI1, cW, cS, t + 4);
        ISSUE_ROWS_V(rowB, dI0, dI1);
    }
#undef LOAD_META_V
}
__device__ __forceinline__ void p9u_phase(Frame& F) {
    const int x = F.bid & 7, rank = F.bid >> 3, nr = F.G >> 3;
    for (int tb = rank * NWAVES + F.wave; tb < M / 64; tb += nr * NWAVES) p9u_item(F, x, tb);
}
__device__ __forceinline__ void p9v_phase(Frame& F) {
    const int x = F.bid & 7, rank = F.bid >> 3, nr = F.G >> 3;
    for (int tb = rank * NWAVES + F.wave; tb < M / 64; tb += nr * NWAVES) p9v_item(F, x, tb);
}
__device__ __forceinline__ unsigned fp6_e2m3(float x) {
    const float a = fabsf(x);
    const bool s1 = a < 2.0f, s2 = a < 4.0f;
    const float inv = s1 ? 8.0f : (s2 ? 4.0f : 2.0f), base = s1 ? 0.0f : (s2 ? 2.0f : 4.0f);
    const unsigned cb = s1 ? 0u : (s2 ? 16u : 24u);
    unsigned q = cb + (unsigned)__builtin_rintf((a - base) * inv);
    q = q > 31u ? 31u : q;
    return q | (x < 0.f ? 32u : 0u);
}
__device__ __forceinline__ void p9w_phase(Frame& F) {
    const unsigned* part = P_PART(F); const unsigned short* idxp = P_IDX(F); const float* gwp = P_GW(F); const float* usc = P_USC(F); const float* vsc = P_VSC(F);
    unsigned char* wp = P_W(F); float* wsc = P_WSC(F);
    constexpr int NI = 4;
    const int stride = F.G * 512;
    for (int it0 = F.bid * 512 + F.tid; it0 < M * 64; it0 += NI * stride) {
        unsigned pw[NI][8]; unsigned iw[NI]; f32x2 gw[NI];
#pragma unroll
        for (int u = 0; u < NI; ++u) { const int it = it0 + u * stride < M * 64 ? it0 + u * stride : it0; const size_t p0 = 2 * (size_t)it;
#pragma unroll
            for (int s = 0; s < 8; ++s) pw[u][s] = __builtin_nontemporal_load(part + (size_t)s * M * 64 + it);
            iw[u] = *(const unsigned*)(idxp + p0); gw[u] = *(const f32x2*)(gwp + p0); }
        float us0[NI], us1[NI], vs0[NI], vs1[NI];
#pragma unroll
        for (int u = 0; u < NI; ++u) { const int i0 = iw[u] & 0xffffu, i1 = iw[u] >> 16; us0[u] = usc[i0]; us1[u] = usc[i1]; vs0[u] = vsc[i0]; vs1[u] = vsc[i1]; }
#pragma unroll
        for (int u = 0; u < NI; ++u) { const int it = it0 + u * stride; if (it >= M * 64) break;
            float a0 = 0.f, a1 = 0.f;
#pragma unroll
            for (int s = 0; s < 8; ++s) { a0 += bflo(pw[u][s]); a1 += bfhi(pw[u][s]); }
            const int m = it >> 6; const size_t p0 = 2 * (size_t)it;
            const float w0 = gw[u].x * gelu_tanh(a0 * us0[u]) * vs0[u], w1 = gw[u].y * gelu_tanh(a1 * us1[u]) * vs1[u];
            float mx = fmaxf(fabsf(w0), fabsf(w1));
#pragma unroll
            for (int o = 1; o < 64; o <<= 1) mx = fmaxf(mx, __shfl_xor(mx, o));
            const float sc = 7.5f / fmaxf(mx, 1e-30f);
            *(unsigned short*)(wp + p0) = (unsigned short)(fp6_e2m3(w0 * sc) | (fp6_e2m3(w1 * sc) << 8));
            if ((it & 63) == 0) wsc[m] = fmaxf(mx, 1e-30f) * (1.0f / 7.5f); }
    }
}

struct Args { const void* in[25]; float* out; unsigned char* ws; int ph_lo, ph_hi; };
__global__ void __launch_bounds__(NWAVES * 64, 2) hymba_fwd(Args args) {
    extern __shared__ __attribute__((aligned(16))) unsigned char lds_raw[];
    Frame F;
    F.lds = (LAS unsigned char*)lds_raw;
    F.tid = threadIdx.x; F.lane = F.tid & 63; F.wave = __builtin_amdgcn_readfirstlane(F.tid >> 6);
    F.G = gridDim.x; F.bid = blockIdx.x;
    F.ka = (kaptr_t)__builtin_amdgcn_kernarg_segment_ptr();
    static_assert(sizeof(Args) == 224, "kernarg byte offsets used by ka_ptr");
    for (int u = F.tid; u < (LDS_BYTES - LDSCTL_OFF) / 4; u += NWAVES * 64) ((LAS unsigned*)(F.lds + LDSCTL_OFF))[u] = 0u;
    __syncthreads();
    volatile LAS unsigned* MISC = (volatile LAS unsigned*)(F.lds + MISC_OFF);
    XcdBarrier bar; bar.bar = (unsigned*)(P_ws(F) + WS_CTL) + CW_BAR; bar.x = 0; bar.st = nullptr;
    const int lo = args.ph_lo, hi = args.ph_hi;
    if (hi - lo > 1) bar = xcd_barrier_post((unsigned*)(P_ws(F) + WS_CTL) + CW_BAR, MISC + 8);
#define IN(k) (lo <= (k) && (k) < hi)
#define STAMP(k) do { if (PROBE_STAMP >= 0 && F.bid == 0 && F.tid == 0) ((unsigned long long*)(P_ws(F) + WS_CTL + 64))[(k)] = __builtin_amdgcn_s_memrealtime(); } while (0)
#define SEAM(k) do { STAMP(16 + (k)); if (IN(k) && IN((k) + 1)) xcd_barrier(bar); STAMP((k) + 1); } while (0)
    STAMP(0);

#ifndef PROBE_MASK
#define PROBE_MASK 0
#endif
#define REP(k) for (int rep_ = 0; rep_ < (((PROBE_MASK >> (k)) & 1) ? 2 : 1); ++rep_)
#define REPSYNC(k) do { if (((PROBE_MASK >> (k)) & 1) && rep_ == 0) xcd_barrier(bar); } while (0)
    if (IN(0)) { REP(0) { p0_prologue(F); REPSYNC(0); } } SEAM(0);
    if (IN(1)) { REP(1) { p1_phase(F); REPSYNC(1); } } SEAM(1);
    if (IN(2)) REP(2) {
#if QUANT_IN_P2
        const int nwg1 = (M / 256) * (MIX_IN / 256), rounds = (nwg1 + F.G - 1) / F.G; int G1 = (((nwg1 + rounds - 1) / rounds) + 7) & ~7; if (G1 > F.G) G1 = F.G;
        if (F.bid < G1) {
#if GEMM1_I8
            pg8::Gemm g{(const bf16*)P_A8(F), P_WIN(F), M, MIX_IN, D / 2}; pg8::StaticOrder S; S.init(M, MIX_IN, G1, F.bid);
            pg8::EpiI8StoreBf16 E{P_PROJ(F), MIX_IN, P_RS(F, 0), P_CSIN(F)};
            pg8::gemm_phase<pg8::EpiI8StoreBf16, pg8::StaticOrder, false, true, 2>(F.lds, g, S, E);
#else
            pg8::Gemm g{P_XH(F), P_WIN(F), M, MIX_IN, D}; pg8::StaticOrder S; S.init(M, MIX_IN, G1, F.bid);
            pg8::EpiStoreBf16 E{P_PROJ(F), MIX_IN, 1.0f};
            pg8::gemm_phase<pg8::EpiStoreBf16, pg8::StaticOrder, false, true>(F.lds, g, S, E);
#endif
        }
        if (G1 == F.G) quant_rows(F, QUANT_SPLIT, 2 * NEXP, F.bid * NWAVES + F.wave, F.G * NWAVES);
        else if (F.bid >= G1) quant_rows(F, QUANT_SPLIT, 2 * NEXP, (F.bid - G1) * NWAVES + F.wave, (F.G - G1) * NWAVES);
        REPSYNC(2);
#else
#if GEMM1_I8
        pg8::Gemm g{(const bf16*)P_A8(F), P_WIN(F), M, MIX_IN, D / 2}; pg8::StaticOrder S; S.init(M, MIX_IN, F.G, F.bid);
        pg8::EpiI8StoreBf16 E{P_PROJ(F), MIX_IN, P_RS(F, 0), P_CSIN(F)};
        pg8::gemm_phase<pg8::EpiI8StoreBf16, pg8::StaticOrder, false, true, 2>(F.lds, g, S, E); REPSYNC(2);
#else
        pg8::Gemm g{P_XH(F), P_WIN(F), M, MIX_IN, D}; pg8::StaticOrder S; S.init(M, MIX_IN, F.G, F.bid);
        pg8::EpiStoreBf16 E{P_PROJ(F), MIX_IN, 1.0f};
        pg8::gemm_phase<pg8::EpiStoreBf16, pg8::StaticOrder, false, true>(F.lds, g, S, E); REPSYNC(2);
#endif
        { const int nwg = (M / 256) * (MIX_IN / 256), busy = nwg % F.G;
          const int w0 = busy > 0 ? (F.bid - busy) * NWAVES + F.wave : F.bid * NWAVES + F.wave, nw = (busy > 0 ? F.G - busy : F.G) * NWAVES;
          if (busy == 0 || F.bid >= busy) {
              quant_rows(F, QUANT_SPLIT, 2 * NEXP, w0, nw); } }
#endif
    } SEAM(2);
    if (IN(3)) { p3_phase(F); } SEAM(3);
    if (IN(4)) { p4_phase(F); } SEAM(4);
    if (IN(5)) REP(5) {
#if GEMM2_I8
        pg8::Gemm g{(const bf16*)P_MIX8(F), P_WOUT(F), M, D, D / 2}; pg8::StaticOrder S; S.init(M, D, F.G, F.bid);
#if GEMM2_RES
        pg8::EpiI8GateResBf16 E{P_X1B(F), D, P_ADA(F) + 2 * D, ADA_W, SEQ, P_RS(F, 1), P_CSOUT(F), P_x(F)};
        pg8::gemm_phase<pg8::EpiI8GateResBf16, pg8::StaticOrder, false, true, 2>(F.lds, g, S, E); REPSYNC(5);
#else
        pg8::EpiI8GateBf16 E{P_X1B(F), D, P_ADA(F) + 2 * D, ADA_W, SEQ, P_RS(F, 1), P_CSOUT(F)};
        pg8::gemm_phase<pg8::EpiI8GateBf16, pg8::StaticOrder, false, true, 2>(F.lds, g, S, E); REPSYNC(5);
#endif
#else
        pg8::Gemm g{P_XH(F), P_WOUT(F), M, D, D}; pg8::StaticOrder S; S.init(M, D, F.G, F.bid);
        pg8::EpiGateBf16 E{P_X1B(F), D, P_ADA(F) + 2 * D, ADA_W, SEQ};
        pg8::gemm_phase<pg8::EpiGateBf16, pg8::StaticOrder, false, true>(F.lds, g, S, E); REPSYNC(5);
#endif
    } SEAM(5);
    if (IN(6)) { REP(6) { p6_phase(F); REPSYNC(6); } } SEAM(6);
    if (IN(7)) REP(7) {
#if GEMM3_FP8
#if GEMM3_I8
        pg8::Gemm g{(const bf16*)P_A8(F), P_WQ(F), M, D, D / 2}; pg8::StaticOrder S; S.init(M, D, F.G, F.bid);
        pg8::EpiI8StoreBf16 E{P_PROJ(F), D, P_RS(F, 2), P_CSQ(F)};
        pg8::gemm_phase<pg8::EpiI8StoreBf16, pg8::StaticOrder, false, true, 2>(F.lds, g, S, E); REPSYNC(7);
#else
        pg8::Gemm g{(const bf16*)P_H8(F), P_WQ(F), M, D, D / 2}; pg8::StaticOrder S; S.init(M, D, F.G, F.bid);
        pg8::EpiStoreBf16 E{P_PROJ(F), D, 1.0f / WQ_SCALE};
        pg8::gemm_phase<pg8::EpiStoreBf16, pg8::StaticOrder, false, true, 1>(F.lds, g, S, E); REPSYNC(7);
#endif
#else
        pg8::Gemm g{P_XH(F), P_WQ(F), M, D, D}; pg8::StaticOrder S; S.init(M, D, F.G, F.bid);
        pg8::EpiStoreBf16 E{P_PROJ(F), D, 1.0f};
        pg8::gemm_phase<pg8::EpiStoreBf16, pg8::StaticOrder, false, true>(F.lds, g, S, E); REPSYNC(7);
#endif
    } SEAM(7);
    if (IN(8)) { REP(8) { p8_phase(F); REPSYNC(8); } } SEAM(8);
#ifdef PROBE_MFMA4
    if (F.bid == 0 && F.wave == 0) {
        const int l_ = F.lane, i_ = l_ & 15, kq_ = l_ >> 4; (void)i_; (void)kq_;
        i32x8 a_ = {0, 0, 0, 0, 0, 0, 0, 0}, b_ = {0, 0, 0, 0, 0, 0, 0, 0};
        PROBE_MFMA4;
        const f32x4 z_ = {0.f, 0.f, 0.f, 0.f};
#ifdef PROBE_SWAPFMT
        const f32x4 d_ = __builtin_amdgcn_mfma_scale_f32_16x16x128_f8f6f4(a_, b_, z_, 0  , 4  , 0, 0x7f7f7f7f, 0, 0x7f7f7f7f);
#else
        const f32x4 d_ = MFMA_F4F8(a_, b_, z_);
#endif
        float* pr_ = (float*)(P_ws(F) + WS_CTL + 40960);
        pr_[l_ * 4 + 0] = d_[0]; pr_[l_ * 4 + 1] = d_[1]; pr_[l_ * 4 + 2] = d_[2]; pr_[l_ * 4 + 3] = d_[3];
    }
#endif
    if (IN(9)) { p9u_phase(F); }
    if (PROBE_STAMP >= 0 && F.tid == 0) ((unsigned long long*)(P_ws(F) + WS_CTL + 32768))[F.bid] = __builtin_amdgcn_s_memrealtime();
    SEAM(9);
    if (IN(10)) { p9w_phase(F); } SEAM(10);
    if (IN(11)) { p9v_phase(F); }
    if (PROBE_STAMP >= 0) {
        __syncthreads(); STAMP(12); VM_WAIT(); __syncthreads();
        if (F.bid == 0 && F.tid == 0) { const unsigned long long* ts = (const unsigned long long*)(P_ws(F) + WS_CTL + 64);
            float us = (float)(ts[PROBE_STAMP + 1] - ts[PROBE_STAMP]) * 0.01f;
#ifdef PROBE_BLOCKSTAT
            { const unsigned long long* bt = (const unsigned long long*)(P_ws(F) + WS_CTL + 32768); float acc_ = 0.f;
              for (int b_ = 0; b_ < (int)gridDim.x; ++b_) { const float d_ = (float)(bt[b_] - ts[9]) * 0.01f; PROBE_BLOCKSTAT; } us = acc_; }
#endif
#ifdef PROBE_MFMA4
            { const float* pr_ = (const float*)(P_ws(F) + WS_CTL + 40960); float acc_ = 0.f; PROBE_MFMA4_READ; us = acc_; }
#endif
            P_out(F)[0] += us * (1.0f / PROBE_DIV); }
    }
#undef IN
#undef SEAM
}

extern "C" void kernel_launch(void* const* d_in, const int* in_sizes, int n_in, void* d_out, int out_size, void* d_ws, size_t ws_size, hipStream_t stream) {
    static int grid = 0;
    if (grid == 0) {
        if (n_in != 25 || in_sizes[0] != M * D || out_size != M * D || ws_size < WS_END) {
            fprintf(stderr, "kernel_launch: built for 25 inputs, x/out of %d floats, >= %zu bytes of workspace; got n_in %d, in0 %d, out %d, ws %zu; nothing launched\n", M * D, (size_t)WS_END, n_in, n_in > 0 ? in_sizes[0] : -1, out_size, ws_size);
            grid = -1; return; }
        int dev = 0, cus = 0, per_cu = 0;
        if (hipGetDevice(&dev) != hipSuccess || hipDeviceGetAttribute(&cus, hipDeviceAttributeMultiprocessorCount, dev) != hipSuccess) { fprintf(stderr, "kernel_launch: device query failed\n"); grid = -1; return; }
        if (hipFuncSetAttribute((const void*)hymba_fwd, hipFuncAttributeMaxDynamicSharedMemorySize, LDS_BYTES) != hipSuccess) { fprintf(stderr, "kernel_launch: hipFuncSetAttribute failed\n"); grid = -1; return; }
        if (hipOccupancyMaxActiveBlocksPerMultiprocessor(&per_cu, (const void*)hymba_fwd, NWAVES * 64, LDS_BYTES) != hipSuccess || per_cu < 1) {
            fprintf(stderr, "kernel_launch: occupancy query reports %d workgroups per CU; need 1\n", per_cu); (void)hipGetLastError(); grid = -1; return; }
        grid = cus;
        if (grid % 8 != 0 || (M / 64) % (grid / 8 * NWAVES) != 0) { fprintf(stderr, "kernel_launch: grid %d not supported (needs a multiple of 8 dividing the token blocks)\n", grid); grid = -1; return; }
    }
    if (grid < 0) return;
    if (hipMemsetAsync((char*)d_ws + WS_CTL, 0, CTL_ZERO_BYTES, stream) != hipSuccess) { fprintf(stderr, "kernel_launch: memset failed\n"); return; }
    Args a{};
    for (int i = 0; i < 25; ++i) a.in[i] = d_in[i];
    a.out = (float*)d_out; a.ws = (unsigned char*)d_ws;
    if (N_LAUNCHES == 1) {
        a.ph_lo = 0; a.ph_hi = N_PHASES;
        void* kargs[] = {&a};
        const hipError_t le = hipLaunchCooperativeKernel((const void*)hymba_fwd, dim3(grid), dim3(NWAVES * 64), kargs, LDS_BYTES, stream);
        if (le != hipSuccess) fprintf(stderr, "kernel_launch: cooperative launch failed: %s (grid %d)\n", hipGetErrorName(le), grid);
    } else {
#ifndef PROBE_TWICE
#define PROBE_TWICE 0
#endif
        for (int li = 0; li < N_PHASES; ++li) { a.ph_lo = li; a.ph_hi = li + 1;
            if ((PROBE_TWICE >> li) & 1) hipLaunchKernelGGL(hymba_fwd, dim3(grid), dim3(NWAVES * 64), LDS_BYTES, stream, a);
            hipLaunchKernelGGL(hymba_fwd, dim3(grid), dim3(NWAVES * 64), LDS_BYTES, stream, a);
            const hipError_t le = hipPeekAtLastError();
            if (le != hipSuccess) { fprintf(stderr, "kernel_launch: launch %d failed: %s\n", li, hipGetErrorName(le)); break; } }
    }
}
```
